# Optimizing an MI355X kernel written in HIP

```python
import math
import jax, jax.numpy as jnp
from jax import lax
import numpy as np

D_MODEL = 1024
BATCH = 8
SEQ = 2048
DEPTH = 2

EPS = 1e-6
HEAD_DIM = 64
ATT_HEADS = 4
ATT_WIDTH = ATT_HEADS * HEAD_DIM
DILATED_PATTERNS = ((128, 1), (512, 4), (2048, 16))
ATT_BLOCK = 128
REL_BUCKETS = 32
REL_MAX_DISTANCE = 2048
GLA_HEADS = 4
GLA_DK = 64
GLA_DV = 128
GLA_RANK = 16
GLA_TAU = 16.0
GLA_CHUNK = 64
CONV_CH = 256
CONV_WIDTH = 3
MIX_WIDTH = ATT_WIDTH + GLA_HEADS * GLA_DV + CONV_CH
SPLIT_SIZES = (ATT_WIDTH, ATT_WIDTH, ATT_WIDTH,
               GLA_HEADS * GLA_DK, GLA_HEADS * GLA_DK,
               GLA_HEADS * GLA_DV, GLA_HEADS * GLA_DV,
               GLA_RANK,
               CONV_CH, CONV_CH, CONV_CH)
IN_COLS = 3 * ATT_WIDTH + 2 * GLA_HEADS * GLA_DK + 2 * GLA_HEADS * GLA_DV + GLA_RANK + 3 * CONV_CH
FFN_DENSE = 2816
N_EXPERTS = 8
TOP_K = 2
FFN_EXPERT = 3584
N_DENSE = (DEPTH + 1) // 2
N_MOE = DEPTH // 2

kernel_name = "hybrid_dilated_gla_shortconv_moe"


def rmsnorm(x, g):
    xf = x.astype(jnp.float32)
    y = xf * lax.rsqrt(jnp.mean(xf * xf, axis=-1, keepdims=True) + EPS)
    return (y * g.astype(jnp.float32)).astype(x.dtype)


def rel_bucket(dist):
    max_exact = REL_BUCKETS // 2
    d = jnp.maximum(dist, 0)
    log_ratio = jnp.log(jnp.maximum(d, 1).astype(jnp.float32) / max_exact) / math.log(REL_MAX_DISTANCE / max_exact)
    large = jnp.minimum(max_exact + (log_ratio * (REL_BUCKETS - max_exact)).astype(jnp.int32), REL_BUCKETS - 1)
    return jnp.where(d < max_exact, d, large)


def dilated_branch(q, k, v, rel_bias, window, dilation):
    b, s, h, hd = q.shape
    span = window // dilation
    L = s // dilation
    nblk = -(-L // ATT_BLOCK)
    Lp = nblk * ATT_BLOCK
    pad_end = ((0, 0), (0, Lp - L), (0, 0), (0, 0), (0, 0))

    def sub(t):
        return jnp.pad(t.reshape(b, L, dilation, h, hd), pad_end)

    qs = sub(q).reshape(b, nblk, ATT_BLOCK, dilation, h, hd)
    pad_front = ((0, 0), (ATT_BLOCK, 0), (0, 0), (0, 0), (0, 0))
    kp = jnp.pad(sub(k), pad_front)
    vp = jnp.pad(sub(v), pad_front)

    def span_blocks(t):
        prev = t[:, :Lp].reshape(b, nblk, ATT_BLOCK, dilation, h, hd)
        cur = t[:, ATT_BLOCK:].reshape(b, nblk, ATT_BLOCK, dilation, h, hd)
        return jnp.concatenate([prev, cur], axis=2)

    ks = span_blocks(kp)
    vs = span_blocks(vp)
    logits = jnp.einsum('bnqrhd,bnkrhd->bnrhqk', qs, ks).astype(jnp.float32) * (hd ** -0.5)

    qi = jnp.arange(ATT_BLOCK)[:, None]
    kj = jnp.arange(2 * ATT_BLOCK)[None, :]
    sub_dist = qi - kj + ATT_BLOCK
    band = (sub_dist >= 0) & (sub_dist <= span)
    bias = jnp.transpose(rel_bias[rel_bucket(sub_dist * dilation)].astype(jnp.float32), (2, 0, 1))
    key_exists = ~((jnp.arange(nblk)[:, None, None] == 0) & (kj[None] < ATT_BLOCK))
    valid = band[None] & key_exists
    logits = jnp.where(valid[None, :, None, None], logits + bias[None, None, None], -jnp.inf)

    lse = jax.nn.logsumexp(logits, axis=-1)
    p = jnp.exp(logits - lse[..., None]).astype(v.dtype)
    o = jnp.einsum('bnrhqk,bnkrhd->bnqrhd', p, vs)
    o = o.reshape(b, Lp, dilation, h, hd)[:, :L].reshape(b, s, h, hd)
    lse = jnp.transpose(lse, (0, 1, 4, 2, 3)).reshape(b, Lp, dilation, h)[:, :L].reshape(b, s, h)
    return o, lse


def dilated_attention(q, k, v, rel_bias):
    outs, lses = [], []
    for window, dilation in DILATED_PATTERNS:
        o, lse = dilated_branch(q, k, v, rel_bias, window, dilation)
        outs.append(o)
        lses.append(lse)
    alpha = jax.nn.softmax(jnp.stack(lses, axis=0), axis=0)
    o = jnp.sum(alpha[..., None] * jnp.stack(outs, axis=0).astype(jnp.float32), axis=0)
    return o.astype(q.dtype)


def gla_mixer(q, k, v, log_a):
    b, s, h, dk = q.shape
    dv = v.shape[-1]
    n = s // GLA_CHUNK

    def chunks(t):
        return jnp.transpose(t.astype(jnp.float32).reshape(b, n, GLA_CHUNK, h, t.shape[-1]), (1, 0, 3, 2, 4))

    qc, kc, vc, ac = chunks(q * (dk ** -0.5)), chunks(k), chunks(v), chunks(log_a)
    causal = jnp.tril(jnp.ones((GLA_CHUNK, GLA_CHUNK), dtype=bool))

    def step(state, inp):
        qt, kt, vt, at = inp
        cum = jnp.cumsum(at, axis=2)
        o_inter = jnp.einsum('bhck,bhkv->bhcv', qt * jnp.exp(cum), state)
        rel = cum[:, :, :, None, :] - cum[:, :, None, :, :]
        decay = jnp.exp(jnp.where(causal[:, :, None], rel, -jnp.inf))
        scores = jnp.einsum('bhtk,bhsk,bhtsk->bhts', qt, kt, decay)
        o_intra = jnp.einsum('bhts,bhsv->bhtv', scores, vt)
        last = cum[:, :, -1:, :]
        new_state = jnp.exp(last[:, :, 0, :, None]) * state + jnp.einsum('bhck,bhcv->bhkv', kt * jnp.exp(last - cum), vt)
        return new_state, o_inter + o_intra

    state0 = jnp.zeros((b, h, dk, dv), jnp.float32)
    _, o = lax.scan(step, state0, (qc, kc, vc, ac))
    return jnp.transpose(o, (1, 0, 3, 2, 4)).reshape(b, s, h, dv)


def short_conv_mixer(h_in, gate_b, gate_c, conv_w):
    u = gate_c * h_in
    y = lax.conv_general_dilated(u, conv_w[:, None, :].astype(u.dtype), window_strides=(1,),
                                 padding=[(CONV_WIDTH - 1, 0)],
                                 dimension_numbers=('NWC', 'WIO', 'NWC'),
                                 feature_group_count=CONV_CH)
    return gate_b * y


def swiglu(h, w1, w3, w2):
    return (jax.nn.silu(h @ w1) * (h @ w3)) @ w2


def moe_swiglu(h, w_router, w1, w3, w2):
    logits = jnp.einsum('bsd,de->bse', h, w_router).astype(jnp.float32)
    top_val, top_idx = lax.top_k(logits, TOP_K)
    top_w = jax.nn.softmax(top_val, axis=-1)
    gates = jnp.sum(jax.nn.one_hot(top_idx, N_EXPERTS, dtype=jnp.float32) * top_w[..., None], axis=-2)
    out = jnp.zeros_like(h)
    for e in range(N_EXPERTS):
        out = out + gates[..., e:e + 1].astype(h.dtype) * swiglu(h, w1[e], w3[e], w2[e])
    return out


def setup_inputs(seed: int = 0) -> dict:
    key = jax.random.key(seed)
    ks = jax.random.split(key, 20)
    f32 = jnp.float32

    def nrm(k, shape, fan_in):
        return jax.random.normal(k, shape, f32) * fan_in ** -0.5

    def gain(k, shape):
        return 1.0 + 0.02 * jax.random.normal(k, shape, f32)

    return {
        "x": jax.random.normal(ks[0], (BATCH, SEQ, D_MODEL), f32),
        "w_mix_in": nrm(ks[1], (DEPTH, D_MODEL, IN_COLS), D_MODEL),
        "w_mix_out": nrm(ks[2], (DEPTH, MIX_WIDTH, D_MODEL), MIX_WIDTH),
        "g_mix": gain(ks[3], (DEPTH, D_MODEL)),
        "rel_bias": 0.2 * jax.random.normal(ks[4], (REL_BUCKETS, ATT_HEADS), f32),
        "gla_w_gate": nrm(ks[5], (DEPTH, GLA_RANK, GLA_HEADS * GLA_DK), GLA_RANK),
        "gla_b_gate": 0.1 * jax.random.normal(ks[6], (DEPTH, GLA_HEADS * GLA_DK), f32),
        "gla_g_norm": gain(ks[7], (DEPTH, GLA_DV)),
        "conv_w": nrm(ks[8], (DEPTH, CONV_WIDTH, CONV_CH), CONV_WIDTH),
        "g_ffn": gain(ks[9], (DEPTH, D_MODEL)),
        "ffn_w1": nrm(ks[10], (N_DENSE, D_MODEL, FFN_DENSE), D_MODEL),
        "ffn_w3": nrm(ks[11], (N_DENSE, D_MODEL, FFN_DENSE), D_MODEL),
        "ffn_w2": nrm(ks[12], (N_DENSE, FFN_DENSE, D_MODEL), FFN_DENSE),
        "moe_router": nrm(ks[13], (N_MOE, D_MODEL, N_EXPERTS), D_MODEL),
        "moe_w1": nrm(ks[14], (N_MOE, N_EXPERTS, D_MODEL, FFN_EXPERT), D_MODEL),
        "moe_w3": nrm(ks[15], (N_MOE, N_EXPERTS, D_MODEL, FFN_EXPERT), D_MODEL),
        "moe_w2": nrm(ks[16], (N_MOE, N_EXPERTS, FFN_EXPERT, D_MODEL), FFN_EXPERT),
        "g_final": gain(ks[17], (D_MODEL,)),
    }


def reference(x, w_mix_in, w_mix_out, g_mix, rel_bias, gla_w_gate, gla_b_gate, gla_g_norm, conv_w,
              g_ffn, ffn_w1, ffn_w3, ffn_w2, moe_router, moe_w1, moe_w3, moe_w2, g_final):
    b, s, _ = x.shape
    split_at = np.cumsum(SPLIT_SIZES)[:-1].tolist()
    for layer in range(DEPTH):
        h = rmsnorm(x, g_mix[layer])
        u = h @ w_mix_in[layer]
        (aq, ak, av, gq, gk, gv, gr, glr, c_in, c_b, c_c) = jnp.split(u, split_at, axis=-1)

        att = dilated_attention(aq.reshape(b, s, ATT_HEADS, HEAD_DIM),
                                ak.reshape(b, s, ATT_HEADS, HEAD_DIM),
                                av.reshape(b, s, ATT_HEADS, HEAD_DIM), rel_bias)
        att = att.reshape(b, s, ATT_WIDTH)

        log_a = jax.nn.log_sigmoid((glr @ gla_w_gate[layer] + gla_b_gate[layer]).astype(jnp.float32)) / GLA_TAU
        go = gla_mixer(gq.reshape(b, s, GLA_HEADS, GLA_DK), gk.reshape(b, s, GLA_HEADS, GLA_DK),
                       gv.reshape(b, s, GLA_HEADS, GLA_DV), log_a.reshape(b, s, GLA_HEADS, GLA_DK))
        go = rmsnorm(go.astype(x.dtype), gla_g_norm[layer]).reshape(b, s, GLA_HEADS * GLA_DV) * jax.nn.silu(gr)

        cv = short_conv_mixer(c_in, c_b, c_c, conv_w[layer])

        mixed = jnp.concatenate([att, go, cv], axis=-1)
        x = x + mixed @ w_mix_out[layer]

        h = rmsnorm(x, g_ffn[layer])
        if layer % 2 == 0:
            i = layer // 2
            f = swiglu(h, ffn_w1[i], ffn_w3[i], ffn_w2[i])
        else:
            i = layer // 2
            f = moe_swiglu(h, moe_router[i], moe_w1[i], moe_w3[i], moe_w2[i])
        x = x + f
    return rmsnorm(x, g_final)
```

```cpp
#include <hip/hip_runtime.h>
#include <cstdio>
#include <cstdint>

#ifndef MK_N_LAUNCHES
#define MK_N_LAUNCHES 1
#endif

namespace pg8 {
#define PG8_LAS __attribute__((address_space(3)))
typedef unsigned short bf16_t;
typedef short bf16x8 __attribute__((ext_vector_type(8)));
typedef float f32x4 __attribute__((ext_vector_type(4)));
typedef unsigned u32x4 __attribute__((ext_vector_type(4)));
typedef unsigned u32x2 __attribute__((ext_vector_type(2)));
constexpr int BM = 256, BK = 64, HALF = 128, HTB = HALF * BK * 2, STAGE_BYTES = 8 * HTB, NXCD = 8, WGM = 8;

__host__ __device__ __forceinline__ int lds_byte(int r, int c) { const int st = (r >> 4) * 2 + (c >> 5), rr = r & 15, cc = c & 31, ob = rr * 64 + cc * 2; return st * 1024 + (ob ^ (((ob >> 9) & 1) << 5)); }
__host__ __device__ __forceinline__ void stage_rc(int b, int& R, int& C) { const int st = b / 1024, sb = b % 1024, swz = sb ^ (((sb >> 9) & 1) << 5); R = (st >> 1) * 16 + swz / 64; C = (st & 1) * 32 + (swz % 64) / 2; }
__host__ __device__ __forceinline__ int perm32(int rho) { const int n = rho >> 4, i = rho & 15; return 8 * (i >> 2) + 4 * n + (i & 3); }

struct Unit { int pm, pn; };
struct Gemm { const bf16_t* A; const bf16_t* Bt; int M, N, K; };

struct StaticOrder {
    int nM, nN, nwg, G, c;
    __host__ __device__ void init(int M, int N, int G_, int c_) { nM = M / BM; nN = N / BM; nwg = nM * nN; G = G_; c = c_; }
    __host__ __device__ bool next(int i, Unit& u) const {
        const long L = (long)i * G + c; if (L >= nwg) return false;
        int wgid = (int)L; { const int q = nwg / NXCD, r = nwg % NXCD, xcd = wgid % NXCD, off = wgid / NXCD; wgid = (xcd < r ? xcd * (q + 1) : r * (q + 1) + (xcd - r) * q) + off; }
        const int nig = WGM * nN, gid = wgid / nig, fm = gid * WGM, gsz = (nM - fm) < WGM ? (nM - fm) : WGM;
        u.pm = fm + ((wgid % nig) % gsz); u.pn = (wgid % nig) / gsz; return true;
    }
    __device__ __forceinline__ void a_ready(const Unit&) const {}
    __device__ __forceinline__ void done(const Unit&) const {}
};
struct MoeOrder {
    const int* panel_e; int npan, NT, G, c;
    __device__ bool next(int i, Unit& u) const {
        const long L = (long)i * G + c; if (L >= (long)npan * NT) return false;
        const int p = (int)(L / NT); u.pm = p; u.pn = panel_e[p] * NT + (int)(L % NT); return true;
    }
    __device__ __forceinline__ void a_ready(const Unit&) const {}
    __device__ __forceinline__ void done(const Unit&) const {}
};

__device__ __forceinline__ unsigned cvt_pk_bf16(float lo, float hi) { unsigned r; asm volatile("v_cvt_pk_bf16_f32 %0, %1, %2" : "=v"(r) : "v"(lo), "v"(hi)); return r; }

constexpr float RMS_EPS = 1e-6f;
__device__ __forceinline__ float rstd_of(const float* ss16) {
    const f32x4 a = *(const f32x4*)ss16, b = *(const f32x4*)(ss16 + 4), c = *(const f32x4*)(ss16 + 8), d = *(const f32x4*)(ss16 + 12);
    const float s = ((a[0] + a[1]) + (a[2] + a[3])) + ((b[0] + b[1]) + (b[2] + b[3])) + ((c[0] + c[1]) + (c[2] + c[3])) + ((d[0] + d[1]) + (d[2] + d[3]));
    return 1.0f / sqrtf(s * (1.0f / 1024.0f) + RMS_EPS);
}
__device__ __forceinline__ float logsig16(float x) { return ((x < 0.f ? x : 0.f) - log1pf(__expf(-fabsf(x)))) * (1.0f / 16.0f); }
__device__ __forceinline__ float silu_f(float a) { return a / (1.0f + __expf(-a)); }

struct EpiU {
    static constexpr bool PERM = true, AFTER_DRAIN = false;
    bf16_t* U; int ldu; const float* SS; const float* bgate; float qs;
    __device__ __forceinline__ void operator()(const f32x4 (&acc)[2][2][4][2], const Unit& u, int wr, int wc, int fr, int fq) const {
        const int row0 = u.pm * BM + wr * 64 + fr, cl = wc * 32 + 8 * fq, col0 = u.pn * BM + cl;
        const float sc = (u.pn == 0) ? qs : ((u.pn == 3) ? 0.125f : 1.0f);
        const bool la = (u.pn == 12);
        f32x4 bv[2][2];
#pragma unroll
        for (int bj = 0; bj < 2; ++bj)
#pragma unroll
            for (int n = 0; n < 2; ++n) bv[bj][n] = la ? *(const f32x4*)(bgate + cl + bj * HALF + 4 * n) : (f32x4){0.f, 0.f, 0.f, 0.f};
#pragma unroll
        for (int ai = 0; ai < 2; ++ai)
#pragma unroll
            for (int m = 0; m < 4; ++m) { const int row = row0 + ai * HALF + m * 16; const float rs = rstd_of(SS + (size_t)row * 16) * sc;
                bf16_t* rowp = U + (size_t)row * ldu + col0;
#pragma unroll
                for (int bj = 0; bj < 2; ++bj) { f32x4 v0 = acc[ai][bj][m][0] * rs, v1 = acc[ai][bj][m][1] * rs;
                    if (la) {
#pragma unroll
                        for (int j = 0; j < 4; ++j) { v0[j] = logsig16(v0[j] + bv[bj][0][j]); v1[j] = logsig16(v1[j] + bv[bj][1][j]); } }
                    u32x4 w; w.x = cvt_pk_bf16(v0[0], v0[1]); w.y = cvt_pk_bf16(v0[2], v0[3]); w.z = cvt_pk_bf16(v1[0], v1[1]); w.w = cvt_pk_bf16(v1[2], v1[3]);
                    *(u32x4*)(rowp + bj * HALF) = w; } }
    }
};
struct EpiRes {
    static constexpr bool PERM = false, AFTER_DRAIN = false;
    const float* Xin; float* Xout; bf16_t* XB; float* SS;
    __device__ __forceinline__ void operator()(const f32x4 (&acc)[2][2][4][2], const Unit& u, int wr, int wc, int fr, int fq) const {
        const int row0 = u.pm * BM + wr * 64 + fr, col0 = u.pn * BM + wc * 32 + 4 * fq;
#pragma unroll
        for (int ai = 0; ai < 2; ++ai)
#pragma unroll
            for (int m = 0; m < 4; ++m) { const int row = row0 + ai * HALF + m * 16; const size_t off = (size_t)row * 1024 + col0; float ssum = 0.f;
#pragma unroll
                for (int bj = 0; bj < 2; ++bj)
#pragma unroll
                    for (int n = 0; n < 2; ++n) { const f32x4 xo = *(const f32x4*)(Xin + off + bj * HALF + n * 16); const f32x4 v = xo + acc[ai][bj][m][n];
                        *(f32x4*)(Xout + off + bj * HALF + n * 16) = v; u32x2 w; w.x = cvt_pk_bf16(v[0], v[1]); w.y = cvt_pk_bf16(v[2], v[3]);
                        *(u32x2*)(XB + off + bj * HALF + n * 16) = w; ssum += (v[0] * v[0] + v[1] * v[1]) + (v[2] * v[2] + v[3] * v[3]); }
                ssum += __shfl_xor(ssum, 16); ssum += __shfl_xor(ssum, 32);
                if (fq == 0) SS[(size_t)row * 16 + u.pn * 4 + wc] = ssum;
                asm volatile("" ::: "memory"); }
    }
};
template <bool MOE> struct EpiGlu {
    static constexpr bool PERM = true, AFTER_DRAIN = false;
    bf16_t* O; int ldo; const float* SS;
    __device__ __forceinline__ void operator()(const f32x4 (&acc)[2][2][4][2], const Unit& u, int wr, int wc, int fr, int fq) const {
        const int row0 = u.pm * BM + wr * 64 + fr; const int pnl = MOE ? (u.pn % 28) : u.pn; const int col0 = pnl * HALF + wc * 32 + 8 * fq;
#pragma unroll
        for (int ai = 0; ai < 2; ++ai)
#pragma unroll
            for (int m = 0; m < 4; ++m) { const int row = row0 + ai * HALF + m * 16; const float rs = MOE ? SS[row] : rstd_of(SS + (size_t)row * 16);
                const f32x4 a0 = acc[ai][0][m][0] * rs, a1 = acc[ai][0][m][1] * rs, b0 = acc[ai][1][m][0] * rs, b1 = acc[ai][1][m][1] * rs;
                f32x4 g0, g1;
#pragma unroll
                for (int j = 0; j < 4; ++j) { g0[j] = silu_f(a0[j]) * b0[j]; g1[j] = silu_f(a1[j]) * b1[j]; }
                u32x4 w; w.x = cvt_pk_bf16(g0[0], g0[1]); w.y = cvt_pk_bf16(g0[2], g0[3]); w.z = cvt_pk_bf16(g1[0], g1[1]); w.w = cvt_pk_bf16(g1[2], g1[3]);
                *(u32x4*)(O + (size_t)row * ldo + col0) = w; }
    }
};
struct EpiMoeDown {
    static constexpr bool PERM = true, AFTER_DRAIN = false;
    bf16_t* Y; const float* gate;
    __device__ __forceinline__ void operator()(const f32x4 (&acc)[2][2][4][2], const Unit& u, int wr, int wc, int fr, int fq) const {
        const int row0 = u.pm * BM + wr * 64 + fr, col0 = (u.pn & 3) * BM + wc * 32 + 8 * fq;
#pragma unroll
        for (int ai = 0; ai < 2; ++ai)
#pragma unroll
            for (int m = 0; m < 4; ++m) { const int row = row0 + ai * HALF + m * 16; const float g = gate[row]; bf16_t* rowp = Y + (size_t)row * 1024 + col0;
#pragma unroll
                for (int bj = 0; bj < 2; ++bj) { const f32x4 v0 = acc[ai][bj][m][0] * g, v1 = acc[ai][bj][m][1] * g;
                    u32x4 w; w.x = cvt_pk_bf16(v0[0], v0[1]); w.y = cvt_pk_bf16(v0[2], v0[3]); w.z = cvt_pk_bf16(v1[0], v1[1]); w.w = cvt_pk_bf16(v1[2], v1[3]);
                    *(u32x4*)(rowp + bj * HALF) = w; } }
    }
};

template <class Epi, class Sched, bool ALIGN_EPI = false, bool SP2 = false>
__device__ __forceinline__ void gemm_phase(PG8_LAS unsigned char* lds, const Gemm g, const Sched& S, const Epi& E) {
    const int tid = threadIdx.x, wid = __builtin_amdgcn_readfirstlane(tid >> 6), lane = tid & 63, wr = wid >> 2, wc = wid & 3, fr = lane & 15, fq = lane >> 4;
    const int K = g.K, nt = K / BK;
    unsigned voffA[2], voffB[2];
#pragma unroll
    for (int i = 0; i < 2; ++i) { int R, C; stage_rc(tid * 16 + i * 8192, R, C); const int Rb = Epi::PERM ? ((R & ~31) + perm32(R & 31)) : R;
        voffA[i] = (unsigned)(R * K + C) * 2u; voffB[i] = (unsigned)(Rb * K + C) * 2u; }
    const size_t kstep = (size_t)(BK * 2);
    const size_t hstep = (size_t)HALF * K * 2;
    const size_t tstep = 2 * hstep;
    const unsigned ldsw = (unsigned)wid * 1024u;
    const int aoff = lds_byte(wr * 64 + fr, fq * 8), boff = lds_byte(wc * 32 + fr, fq * 8);
#define PG8_SA(b, h) (((b) * 2 + (h)) * HTB)
#define PG8_SB(b, h) ((4 + (b) * 2 + (h)) * HTB)
#define PG8_STAGE(bufoff, gbase, voff) do { _Pragma("unroll") for (int _i = 0; _i < 2; ++_i) \
        __builtin_amdgcn_global_load_lds((const unsigned*)((const char*)(gbase) + (voff)[_i]), (PG8_LAS unsigned*)(lds + (bufoff) + ldsw + _i * 8192), 16, 0, 0); } while (0)
#define PG8_LDA(dst, b, h) do { _Pragma("unroll") for (int m = 0; m < 4; ++m) _Pragma("unroll") for (int k = 0; k < 2; ++k) dst[m][k] = *(const PG8_LAS bf16x8*)(lds + PG8_SA(b, h) + aoff + m * 2048 + k * 1024); } while (0)
#define PG8_LDB(dst, b, h) do { _Pragma("unroll") for (int n = 0; n < 2; ++n) _Pragma("unroll") for (int k = 0; k < 2; ++k) dst[n][k] = *(const PG8_LAS bf16x8*)(lds + PG8_SB(b, h) + boff + n * 2048 + k * 1024); } while (0)
#define PG8_MMA(ai, bj, At, Bt) do { __builtin_amdgcn_s_setprio(1); _Pragma("unroll") for (int m = 0; m < 4; ++m) _Pragma("unroll") for (int n = 0; n < 2; ++n) _Pragma("unroll") for (int k = 0; k < 2; ++k) \
        acc[ai][bj][m][n] = __builtin_amdgcn_mfma_f32_16x16x32_bf16(Bt[n][k], At[m][k], acc[ai][bj][m][n], 0, 0, 0); __builtin_amdgcn_s_setprio(0); } while (0)
#define PG8_WAIT_V(n) asm volatile("s_waitcnt vmcnt(" #n ")" ::: "memory")
#define PG8_WAIT_L(n) asm volatile("s_waitcnt lgkmcnt(" #n ")" ::: "memory")
#define PG8_BAR __builtin_amdgcn_s_barrier()
#define PG8_SCHED __builtin_amdgcn_sched_barrier(0)
    Unit cur, nxt; int ui = 0;
    if (!S.next(0, cur)) return;
    f32x4 acc[2][2][4][2];
#pragma unroll
    for (int a = 0; a < 2; ++a)
#pragma unroll
        for (int b = 0; b < 2; ++b)
#pragma unroll
            for (int m = 0; m < 4; ++m)
#pragma unroll
                for (int n = 0; n < 2; ++n) acc[a][b][m][n] = (f32x4){0.f, 0.f, 0.f, 0.f};
    bf16x8 At[4][2], B0[2][2], B1[2][2];
    const char* cA = (const char*)g.A + (size_t)cur.pm * tstep; const char* cB = (const char*)g.Bt + (size_t)cur.pn * tstep;
    S.a_ready(cur);
    if constexpr (SP2) {
        PG8_STAGE(PG8_SB(0, 0), cB, voffB); PG8_STAGE(PG8_SB(0, 1), cB + hstep, voffB); PG8_STAGE(PG8_SA(0, 0), cA, voffA); PG8_STAGE(PG8_SA(0, 1), cA + hstep, voffA);
        if (wr == 1) PG8_BAR;
        PG8_WAIT_V(2); PG8_BAR;
        PG8_STAGE(PG8_SB(1, 0), cB + kstep, voffB); PG8_STAGE(PG8_SA(1, 0), cA + kstep, voffA); PG8_STAGE(PG8_SB(1, 1), cB + hstep + kstep, voffB);
        PG8_WAIT_V(6); PG8_BAR;
    } else {
        PG8_STAGE(PG8_SB(0, 0), cB, voffB); PG8_STAGE(PG8_SA(0, 0), cA, voffA); PG8_STAGE(PG8_SB(0, 1), cB + hstep, voffB); PG8_STAGE(PG8_SA(0, 1), cA + hstep, voffA);
        if (wr == 1) PG8_BAR;
        PG8_WAIT_V(4); PG8_BAR;
        PG8_STAGE(PG8_SB(1, 0), cB + kstep, voffB); PG8_STAGE(PG8_SA(1, 0), cA + kstep, voffA); PG8_STAGE(PG8_SB(1, 1), cB + hstep + kstep, voffB);
        PG8_WAIT_V(6); PG8_BAR;
    }
    for (;;) {
        const bool has_next = S.next(ui + 1, nxt);
        const char* nA = has_next ? (const char*)g.A + (size_t)nxt.pm * tstep : cA; const char* nB = has_next ? (const char*)g.Bt + (size_t)nxt.pn * tstep : cB;
        for (int t = 0; t < nt; t += 2) {
            const bool last = (t == nt - 2);
            const char* a1 = cA + (size_t)(t + 1) * kstep;
            const char* a2 = last ? nA : cA + (size_t)(t + 2) * kstep; const char* b2 = last ? nB : cB + (size_t)(t + 2) * kstep;
            const char* a3 = a2 + kstep; const char* b3 = b2 + kstep;
            if (last && has_next) S.a_ready(nxt);
            if constexpr (SP2) {
            PG8_LDB(B0, 0, 0); PG8_LDB(B1, 0, 1); PG8_SCHED; PG8_LDA(At, 0, 0); PG8_STAGE(PG8_SA(1, 1), a1 + hstep, voffA);
            PG8_WAIT_V(8); PG8_WAIT_L(0); PG8_BAR; PG8_MMA(0, 0, At, B0); PG8_MMA(0, 1, At, B1); PG8_BAR; PG8_SCHED;
            PG8_LDA(At, 0, 1); PG8_STAGE(PG8_SB(0, 0), b2, voffB); PG8_STAGE(PG8_SB(0, 1), b2 + hstep, voffB); PG8_STAGE(PG8_SA(0, 0), a2, voffA);
            PG8_WAIT_V(8); PG8_WAIT_L(0); PG8_BAR; PG8_MMA(1, 0, At, B0); PG8_MMA(1, 1, At, B1); PG8_BAR; PG8_SCHED;
            PG8_LDB(B0, 1, 0); PG8_LDB(B1, 1, 1); PG8_SCHED; PG8_LDA(At, 1, 0); PG8_STAGE(PG8_SA(0, 1), a2 + hstep, voffA);
            PG8_WAIT_V(8); PG8_WAIT_L(0); PG8_BAR; PG8_MMA(0, 0, At, B0); PG8_MMA(0, 1, At, B1); PG8_BAR; PG8_SCHED;
            PG8_LDA(At, 1, 1); PG8_STAGE(PG8_SB(1, 0), b3, voffB); PG8_STAGE(PG8_SB(1, 1), b3 + hstep, voffB); PG8_STAGE(PG8_SA(1, 0), a3, voffA);
            PG8_WAIT_V(8); PG8_WAIT_L(0); PG8_BAR; PG8_MMA(1, 0, At, B0); PG8_MMA(1, 1, At, B1); PG8_BAR; PG8_SCHED;
            } else {
            PG8_LDB(B0, 0, 0); PG8_SCHED; PG8_LDA(At, 0, 0); PG8_STAGE(PG8_SA(1, 1), a1 + hstep, voffA);
            PG8_WAIT_L(8); PG8_BAR; PG8_WAIT_L(0); PG8_MMA(0, 0, At, B0); PG8_BAR; PG8_SCHED;
            PG8_LDB(B1, 0, 1); PG8_STAGE(PG8_SB(0, 0), b2, voffB);
            PG8_BAR; PG8_WAIT_L(0); PG8_MMA(0, 1, At, B1); PG8_BAR;
            PG8_LDA(At, 0, 1); PG8_STAGE(PG8_SA(0, 0), a2, voffA);
            PG8_BAR; PG8_WAIT_L(0); PG8_MMA(1, 0, At, B0); PG8_BAR; PG8_SCHED;
            PG8_STAGE(PG8_SB(0, 1), b2 + hstep, voffB);
            PG8_WAIT_V(6); PG8_BAR; PG8_MMA(1, 1, At, B1); PG8_BAR;
            PG8_LDB(B0, 1, 0); PG8_SCHED; PG8_LDA(At, 1, 0); PG8_STAGE(PG8_SA(0, 1), a2 + hstep, voffA);
            PG8_WAIT_L(8); PG8_BAR; PG8_WAIT_L(0); PG8_MMA(0, 0, At, B0); PG8_BAR; PG8_SCHED;
            PG8_LDB(B1, 1, 1); PG8_STAGE(PG8_SB(1, 0), b3, voffB);
            PG8_BAR; PG8_WAIT_L(0); PG8_MMA(0, 1, At, B1); PG8_BAR;
            PG8_LDA(At, 1, 1); PG8_STAGE(PG8_SA(1, 0), a3, voffA);
            PG8_BAR; PG8_WAIT_L(0); PG8_MMA(1, 0, At, B0); PG8_BAR; PG8_SCHED;
            PG8_STAGE(PG8_SB(1, 1), b3 + hstep, voffB);
            PG8_WAIT_V(6); PG8_BAR; PG8_MMA(1, 1, At, B1); PG8_BAR;
            }
        }
        if constexpr (ALIGN_EPI) { if (wr == 0) PG8_BAR; }
        if constexpr (!Epi::AFTER_DRAIN) { E(acc, cur, wr, wc, fr, fq); S.done(cur); }
        if (!has_next) break;
#pragma unroll
        for (int a = 0; a < 2; ++a)
#pragma unroll
            for (int b = 0; b < 2; ++b)
#pragma unroll
                for (int m = 0; m < 4; ++m)
#pragma unroll
                    for (int n = 0; n < 2; ++n) acc[a][b][m][n] = (f32x4){0.f, 0.f, 0.f, 0.f};
        cur = nxt; cA = nA; cB = nB; ++ui;
        if constexpr (ALIGN_EPI) { if (wr == 1) PG8_BAR; }
    }
    PG8_WAIT_V(0);
    if constexpr (!ALIGN_EPI) { if (wr == 0) PG8_BAR; }
    PG8_BAR;
#undef PG8_SA
#undef PG8_SB
#undef PG8_STAGE
#undef PG8_LDA
#undef PG8_LDB
#undef PG8_MMA
#undef PG8_WAIT_V
#undef PG8_WAIT_L
#undef PG8_BAR
#undef PG8_SCHED
}
}

constexpr int NWAVES = 8, NTHR = NWAVES * 64;
constexpr int NB = 8, SEQ = 2048, D = 1024, M = NB * SEQ;
constexpr int INC = 3088;
constexpr int NU = 3328;
constexpr int UQ = 0, UK = 256, UV = 512, UGQ = 768, UGK = 1024, UGV = 1280, UGR = 1792, UCI = 2304, UCB = 2560, UCC = 2816, ULA = 3072;
constexpr int FF = 2816, FE = 3584, NE = 8;
constexpr int MAXPAN = 136, MAXROWS = MAXPAN * 256;
constexpr float LOG2E = 1.4426950408889634f;
constexpr float QS_ATT = 0.125f * LOG2E;

constexpr size_t MiB = 1u << 20;
constexpr size_t WS_CTL = 0, CTL_ZERO_BYTES = 1 * MiB;
constexpr size_t WS_SS = 1 * MiB;
constexpr size_t WS_BL = 2 * MiB;
constexpr size_t WS_DEC = 2 * MiB + 64 * 1024;
constexpr size_t WS_TOPI = 3 * MiB;
constexpr size_t WS_TOPW = 3 * MiB + 128 * 1024;
constexpr size_t WS_POS = 3 * MiB + 256 * 1024;
constexpr size_t WS_RS3 = 3 * MiB + 384 * 1024;
constexpr size_t WS_CNT = 3 * MiB + 448 * 1024;
constexpr size_t WS_PANE = 3 * MiB + 456 * 1024;
constexpr size_t WS_ROWGATE = 4 * MiB;
constexpr size_t WS_ROWRS = 4 * MiB + 256 * 1024;
constexpr size_t WS_WE13 = 8 * MiB;
constexpr size_t WS_Y = WS_WE13;
constexpr size_t WS_XS = 120 * MiB;
constexpr size_t WS_WE2 = WS_XS;
constexpr size_t WS_HE = 188 * MiB;
constexpr size_t WS_WIN = WS_HE;
constexpr size_t WS_WOUT = WS_HE + 13 * MiB;
constexpr size_t WS_W13 = WS_HE + 17 * MiB;
constexpr size_t WS_W2 = WS_HE + 28 * MiB;
constexpr size_t WS_XB = WS_HE + 34 * MiB;
constexpr size_t WS_U = WS_HE + 66 * MiB;
constexpr size_t WS_H = WS_U;
constexpr size_t WS_MIX = WS_HE + 170 * MiB;
constexpr size_t WS_CST = WS_HE + 202 * MiB;
constexpr size_t WS_END = WS_HE + 238 * MiB;
static_assert(WS_CST + 32 * MiB <= WS_END, "ws map");
constexpr int CW_BAR = 4096;

constexpr int LDS_BYTES = 147456;
constexpr int LDSCTL_OFF = 131072 + 14 * 1024, MISC_OFF = LDSCTL_OFF + 320;

#define GAS __attribute__((address_space(1)))
#define LAS __attribute__((address_space(3)))
typedef unsigned short bf16;
typedef float f32x4 __attribute__((ext_vector_type(4)));
typedef unsigned v4u __attribute__((ext_vector_type(4)));
__device__ __forceinline__ unsigned f2bf(float f) { unsigned u = __builtin_bit_cast(unsigned, f); return (u + 0x7fffu + ((u >> 16) & 1u)) >> 16; }
__device__ __forceinline__ unsigned pk2(float lo, float hi) { return f2bf(lo) | (f2bf(hi) << 16); }
__device__ __forceinline__ float bf2f(unsigned short b) { return __builtin_bit_cast(float, (unsigned)b << 16); }
__device__ __forceinline__ float bflo(unsigned w) { return __builtin_bit_cast(float, w << 16); }
__device__ __forceinline__ float bfhi(unsigned w) { return __builtin_bit_cast(float, w & 0xffff0000u); }
__device__ __forceinline__ float wave_sum(float v) {
#pragma unroll
    for (int o = 1; o < 64; o <<= 1) v += __shfl_xor(v, o);
    return v;
}
__device__ __forceinline__ float wave_max(float v) {
#pragma unroll
    for (int o = 1; o < 64; o <<= 1) v = fmaxf(v, __shfl_xor(v, o));
    return v;
}

#define XB_TMO      128
#define XB_XCNT(j)  (256  + 64 * (j))
#define XB_XSUB(j)  (1280 + 64 * (j))
#define XB_XGEN(j)  (2304 + 64 * (j))
#define XB_TOP      3328
#define XB_TOPGEN   3392
#define XCD_BAR_WORDS 3456
#define XB_SPIN_CAP (1u << 18)
__device__ __forceinline__ unsigned xb_ld(unsigned* p)              { return __hip_atomic_load(p, __ATOMIC_RELAXED, __HIP_MEMORY_SCOPE_AGENT); }
__device__ __forceinline__ unsigned xb_add(unsigned* p, unsigned v) { return __hip_atomic_fetch_add(p, v, __ATOMIC_RELAXED, __HIP_MEMORY_SCOPE_AGENT); }
__device__ __forceinline__ unsigned xb_xcc_id() { return (unsigned)__builtin_amdgcn_s_getreg((3 << 11) | 20) & 0xFu; }
#define XB_SPIN(cond, bar) do { unsigned _sp = 0; while (cond) { __builtin_amdgcn_s_sleep(1); \
    if ((++_sp & 255u) == 0u) { if (xb_ld(&(bar)[XB_TMO])) break; if (_sp > XB_SPIN_CAP) { atomicAdd(&(bar)[XB_TMO], 1u); break; } } } } while (0)
struct XcdBarrier { unsigned* bar; unsigned x; volatile LAS unsigned* st; };
__device__ __forceinline__ XcdBarrier xcd_barrier_post(unsigned* bar, volatile LAS unsigned* st) {
    XcdBarrier b; b.bar = bar; b.x = xb_xcc_id(); b.st = st;
    if (threadIdx.x == 0) (void)xb_add(&bar[XB_XCNT(b.x)], 1u);
    return b;
}
__device__ __forceinline__ void xcd_barrier_complete(unsigned* bar, unsigned x, unsigned& nloc, unsigned& nx) {
    const unsigned G = gridDim.x * gridDim.y * gridDim.z;
    unsigned sum, cnt, mine, sp = 0u;
    for (;;) {
        sum = 0u; cnt = 0u; mine = 0u;
#pragma unroll
        for (unsigned j = 0; j < 16; ++j) { const unsigned c = xb_ld(&bar[XB_XCNT(j)]); sum += c; cnt += (c > 0u) ? 1u : 0u; mine = (j == x) ? c : mine; }
        if (sum == G) break;
        __builtin_amdgcn_s_sleep(1);
        if ((++sp & 255u) == 0u) { if (xb_ld(&bar[XB_TMO])) break; if (sp > XB_SPIN_CAP) { atomicAdd(&bar[XB_TMO], 1u); break; } }
    }
    nloc = mine > 0u ? mine : 1u; nx = cnt > 0u ? cnt : 1u;
}
__device__ __forceinline__ void xcd_barrier(const XcdBarrier& b) {
    asm volatile("s_waitcnt vmcnt(0)" ::: "memory");
    __syncthreads();
    if (threadIdx.x == 0) {
        unsigned* bar = b.bar;
        __builtin_amdgcn_s_waitcnt(0);
        unsigned nloc = b.st[0], nx = b.st[1];
        if (nloc == 0u) { xcd_barrier_complete(bar, b.x, nloc, nx); b.st[0] = nloc; b.st[1] = nx; }
        const unsigned old = xb_add(&bar[XB_XSUB(b.x)], 1u);
        const unsigned gen = old / nloc;
        if (old + 1u == (gen + 1u) * nloc) {
            __builtin_amdgcn_fence(__ATOMIC_RELEASE, "agent");
            asm volatile("s_waitcnt vmcnt(0)" ::: "memory");
            const unsigned og = xb_add(&bar[XB_TOP], 1u);
            const unsigned tg = og / nx;
            if (og + 1u == (tg + 1u) * nx) xb_add(&bar[XB_TOPGEN], 1u);
            else XB_SPIN(xb_ld(&bar[XB_TOPGEN]) == tg, bar);
            __builtin_amdgcn_fence(__ATOMIC_ACQUIRE, "agent");
            xb_add(&bar[XB_XGEN(b.x)], 1u);
            asm volatile("s_waitcnt vmcnt(0)" ::: "memory");
        } else {
            XB_SPIN(xb_ld(&bar[XB_XGEN(b.x)]) == gen, bar);
            __builtin_amdgcn_fence(__ATOMIC_ACQUIRE, "agent");
            asm volatile("s_waitcnt vmcnt(0)" ::: "memory");
        }
    }
    __syncthreads();
}

struct Args {
    const float* x; const float* w_mix_in; const float* w_mix_out; const float* g_mix; const float* rel_bias; const float* gla_w_gate; const float* gla_b_gate;
    const float* gla_g_norm; const float* conv_w; const float* g_ffn; const float* ffn_w1; const float* ffn_w3; const float* ffn_w2; const float* moe_router;
    const float* moe_w1; const float* moe_w3; const float* moe_w2; const float* g_final;
    float* out; unsigned char* ws; int ph_lo, ph_hi;
};

__device__ __forceinline__ void transpose_tile(const float* src, int ldsrc, int k0, int n0, bf16* dst, int ldd, int drow0, const float* ksc, unsigned* scr, int lane) {
    const int nq = lane & 15, kk = lane >> 4;
#pragma unroll
    for (int i = 0; i < 8; ++i) { const int k = 8 * i + 2 * kk; const float* p = src + (size_t)(k0 + k) * ldsrc + n0 + 4 * nq;
        const f32x4 r0 = *(const f32x4*)p, r1 = *(const f32x4*)(p + ldsrc);
        const float s0 = ksc ? ksc[k0 + k] : 1.f, s1 = ksc ? ksc[k0 + k + 1] : 1.f;
#pragma unroll
        for (int j = 0; j < 4; ++j) scr[(4 * nq + j) * 33 + 4 * i + kk] = pk2(r0[j] * s0, r1[j] * s1); }
    asm volatile("s_waitcnt lgkmcnt(0)" ::: "memory");
#pragma unroll 8
    for (int i2 = 0; i2 < 32; ++i2) { const int n = 2 * i2 + (lane >> 5), d = lane & 31;
        ((unsigned*)(dst + (size_t)(drow0 + n) * ldd + k0))[d] = scr[n * 33 + d]; }
    asm volatile("s_waitcnt lgkmcnt(0)" ::: "memory");
}
__device__ __forceinline__ void glr_tile(const float* win, const float* wg, const float* g, int k0, int n0, bf16* dst, int drow0, int lane) {
    float w[16];
#pragma unroll
    for (int r = 0; r < 16; ++r) w[r] = wg[r * 256 + n0 + lane];
    unsigned* drow = (unsigned*)(dst + (size_t)(drow0 + n0 + lane) * 1024 + k0);
    for (int kp = 0; kp < 32; ++kp) { float v[2];
#pragma unroll
        for (int q = 0; q < 2; ++q) { const int k = k0 + 2 * kp + q; const float* s = win + (size_t)k * INC + 2304; float a = 0.f;
#pragma unroll
            for (int r = 0; r < 16; ++r) a += s[r] * w[r];
            v[q] = a * g[k]; }
        drow[kp] = pk2(v[0], v[1]); }
}
__device__ __forceinline__ int rel_bucket(int d) {
    if (d < 16) return d;
    const float lr = logf((float)d / 16.0f) / logf(128.0f);
    int b = 16 + (int)(lr * 16.0f); return b < 31 ? b : 31;
}

struct Ctx { Args args; int tid, lane, wave, G, bx, gw, NGW, lo, hi; XcdBarrier bar; };
#define GRID_BAR() do { if (MK_N_LAUNCHES == 1) xcd_barrier(bar); } while (0)
#define IN(k) (lo <= (k) && (k) < hi)
#define SEAM(k) do { if (IN(k) && IN((k) + 1)) GRID_BAR(); } while (0)
#define WS_PTRS \
    float* SS = (float*)(ws + WS_SS); float* BL = (float*)(ws + WS_BL); float* DEC = (float*)(ws + WS_DEC); \
    bf16* XB = (bf16*)(ws + WS_XB); bf16* U = (bf16*)(ws + WS_U); bf16* MIX = (bf16*)(ws + WS_MIX); float* CST = (float*)(ws + WS_CST); \
    bf16* H = (bf16*)(ws + WS_H); bf16* W13 = (bf16*)(ws + WS_W13); bf16* W2 = (bf16*)(ws + WS_W2); \
    bf16* WE13 = (bf16*)(ws + WS_WE13); bf16* WE2 = (bf16*)(ws + WS_WE2); bf16* XS = (bf16*)(ws + WS_XS); bf16* HE = (bf16*)(ws + WS_HE); bf16* Y = (bf16*)(ws + WS_Y); \
    int* TOPI = (int*)(ws + WS_TOPI); float* TOPW = (float*)(ws + WS_TOPW); int* POS = (int*)(ws + WS_POS); float* RS3 = (float*)(ws + WS_RS3); \
    int* CNT = (int*)(ws + WS_CNT); int* PANE = (int*)(ws + WS_PANE); float* ROWGATE = (float*)(ws + WS_ROWGATE); float* ROWRS = (float*)(ws + WS_ROWRS); \
    float* X = args.out; \
    (void)SS; (void)BL; (void)DEC; (void)XB; (void)U; (void)MIX; (void)CST; (void)H; (void)W13; (void)W2; (void)WE13; (void)WE2; (void)XS; (void)HE; (void)Y; \
    (void)TOPI; (void)TOPW; (void)POS; (void)RS3; (void)CNT; (void)PANE; (void)ROWGATE; (void)ROWRS; (void)X;

template <int layer> __device__ __forceinline__ void layer_phases(const Ctx& c, unsigned char* lds) {
    const Args& args = c.args; LAS unsigned char* ldsl = (LAS unsigned char*)lds;
    const int tid = c.tid, lane = c.lane, wave = c.wave, G = c.G, bx = c.bx, gw = c.gw, NGW = c.NGW, lo = c.lo, hi = c.hi; const XcdBarrier bar = c.bar;
    unsigned char* ws = args.ws; asm volatile("" : "+s"(ws));
    WS_PTRS
    (void)tid; (void)lane; (void)wave; (void)gw; (void)NGW;
        const int pb = 1 + 16 * layer;
        if (IN(pb + 0)) {
            pg8::Gemm g{XB, (const bf16*)(ws + WS_WIN) + (size_t)layer * NU * D, M, NU, D}; pg8::StaticOrder S; S.init(M, NU, G, bx);
            pg8::EpiU E{U, NU, SS, args.gla_b_gate + layer * 256, QS_ATT};
            pg8::gemm_phase<pg8::EpiU, pg8::StaticOrder, true, true>(ldsl, g, S, E);
        }
        SEAM(pb + 0);
        if (IN(pb + 1)) {
            float* cum = (float*)lds; float* kd = cum + 4096; float* vv = kd + 4096; float* seg = vv + 8192;
            for (int u = bx; u < 1024; u += G) {
                const int h = u & 3, n = (u >> 2) & 31, b = u >> 7; const size_t row0 = (size_t)b * SEQ + n * 64;
                { float c = 0.f;
#pragma unroll
                  for (int i = 0; i < 8; ++i) { const int t = 8 * wave + i; c += bf2f(U[(row0 + t) * NU + ULA + h * 64 + lane]); cum[t * 64 + lane] = c; }
                  seg[wave * 64 + lane] = c; }
                __syncthreads();
                { float off = 0.f, last = 0.f;
#pragma unroll
                  for (int w = 0; w < 8; ++w) { const float s = seg[w * 64 + lane]; last += s; if (w < wave) off += s; }
#pragma unroll
                  for (int i = 0; i < 8; ++i) { const int t = 8 * wave + i; const float cm = cum[t * 64 + lane] + off;
                      kd[t * 64 + lane] = bf2f(U[(row0 + t) * NU + UGK + h * 64 + lane]) * __expf(last - cm); }
                  if (wave == 0) DEC[u * 64 + lane] = __expf(last);
                  const int v = tid & 127, sg = tid >> 7;
#pragma unroll
                  for (int i = 0; i < 16; ++i) { const int s = sg + 4 * i; vv[s * 128 + v] = bf2f(U[(row0 + s) * NU + UGV + h * 128 + v]); } }
                __syncthreads();
                { float acc[16];
#pragma unroll
                  for (int i = 0; i < 16; ++i) acc[i] = 0.f;
                  for (int s = 0; s < 64; ++s) { const float kdv = kd[s * 64 + lane];
#pragma unroll
                      for (int i = 0; i < 16; ++i) acc[i] += vv[s * 128 + 16 * wave + i] * kdv; }
#pragma unroll
                  for (int i = 0; i < 16; ++i) CST[((size_t)u * 128 + 16 * wave + i) * 64 + lane] = acc[i]; }
                __syncthreads();
            }
            const float* cw = args.conv_w + layer * 3 * 256;
            for (int it = bx * NTHR + tid; it < M * 32; it += G * NTHR) {
                const int row = it >> 5, c0 = (it & 31) * 8, t = row & (SEQ - 1);
                const bf16* ur = U + (size_t)row * NU;
                const v4u cb = *(const v4u*)(ur + UCB + c0);
                v4u ci[3], cc[3];
#pragma unroll
                for (int d = 0; d < 3; ++d) { if (t >= d) { ci[d] = *(const v4u*)(ur - (size_t)d * NU + UCI + c0); cc[d] = *(const v4u*)(ur - (size_t)d * NU + UCC + c0); } else { ci[d] = (v4u){0u, 0u, 0u, 0u}; cc[d] = ci[d]; } }
                float o[8];
#pragma unroll
                for (int j = 0; j < 4; ++j) {
                    float a0 = 0.f, a1 = 0.f;
#pragma unroll
                    for (int d = 0; d < 3; ++d) { const float w0 = cw[(2 - d) * 256 + c0 + 2 * j], w1 = cw[(2 - d) * 256 + c0 + 2 * j + 1];
                        a0 += w0 * (bflo(cc[d][j]) * bflo(ci[d][j])); a1 += w1 * (bfhi(cc[d][j]) * bfhi(ci[d][j])); }
                    o[2 * j] = bflo(cb[j]) * a0; o[2 * j + 1] = bfhi(cb[j]) * a1; }
                v4u w; w.x = pk2(o[0], o[1]); w.y = pk2(o[2], o[3]); w.z = pk2(o[4], o[5]); w.w = pk2(o[6], o[7]);
                *(v4u*)(MIX + (size_t)row * D + 768 + c0) = w;
            }
        }
        SEAM(pb + 1);
        if (IN(pb + 2)) {
            for (int e = bx * NTHR + tid; e < NB * 4 * 8192; e += G * NTHR) {
                const int k = e & 63, v = (e >> 6) & 127, h = (e >> 13) & 3, b = e >> 15; float S = 0.f;
                for (int n = 0; n < 32; ++n) { const int u = (b * 32 + n) * 4 + h; const size_t idx = ((size_t)u * 128 + v) * 64 + k;
                    const float c = CST[idx]; CST[idx] = S; S = DEC[u * 64 + k] * S + c; }
            }
            float* pw = (float*)lds + wave * 400;
            for (int task = gw; task < M * 4; task += NGW) {
                const int row = task >> 2, h = task & 3, t = row & (SEQ - 1);
                float q[64];
                { const v4u* qp = (const v4u*)(U + (size_t)row * NU + UQ + h * 64);
#pragma unroll
                  for (int c = 0; c < 8; ++c) { const v4u w = qp[c];
#pragma unroll
                      for (int j = 0; j < 4; ++j) { q[8 * c + 2 * j] = bflo(w[j]); q[8 * c + 2 * j + 1] = bfhi(w[j]); } } }
                float sc[3][3]; float mx = -INFINITY;
#pragma unroll
                for (int p = 0; p < 3; ++p) { const int r = (p == 0) ? 1 : ((p == 1) ? 4 : 16);
#pragma unroll
                    for (int it = 0; it < 3; ++it) { const int j = lane + 64 * it; float s = -INFINITY;
                        if (j <= 128 && t - j * r >= 0) { const v4u* kp = (const v4u*)(U + (size_t)(row - j * r) * NU + UK + h * 64); float a = 0.f;
#pragma unroll
                            for (int c = 0; c < 8; ++c) { const v4u w = kp[c];
#pragma unroll
                                for (int jj = 0; jj < 4; ++jj) a += q[8 * c + 2 * jj] * bflo(w[jj]) + q[8 * c + 2 * jj + 1] * bfhi(w[jj]); }
                            s = a + BL[(j * r) * 4 + h]; }
                        sc[p][it] = s; mx = fmaxf(mx, s); } }
                mx = wave_max(mx); float sum = 0.f;
#pragma unroll
                for (int p = 0; p < 3; ++p)
#pragma unroll
                    for (int it = 0; it < 3; ++it) { const float e = exp2f(sc[p][it] - mx); sc[p][it] = e; sum += e; }
                sum = wave_sum(sum); const float inv = 1.0f / sum;
#pragma unroll
                for (int p = 0; p < 3; ++p)
#pragma unroll
                    for (int it = 0; it < 3; ++it) { const int j = lane + 64 * it; if (j <= 128) pw[p * 132 + j] = sc[p][it] * inv; }
                asm volatile("s_waitcnt lgkmcnt(0)" ::: "memory");
                float o = 0.f;
#pragma unroll
                for (int p = 0; p < 3; ++p) { const int r = (p == 0) ? 1 : ((p == 1) ? 4 : 16); int jm = t / r; if (jm > 128) jm = 128;
                    const bf16* vp = U + (size_t)row * NU + UV + h * 64 + lane;
#pragma unroll 4
                    for (int j = 0; j <= jm; ++j) o += pw[p * 132 + j] * bf2f(vp[-(ptrdiff_t)j * r * NU]); }
                MIX[(size_t)row * D + h * 64 + lane] = (bf16)f2bf(o);
                asm volatile("s_waitcnt lgkmcnt(0)" ::: "memory");
            }
        }
        SEAM(pb + 2);
        if (IN(pb + 3)) {
            float* cum = (float*)lds; float* qe = cum + 4096; float* ke = qe + 4096;   float* vv = ke + 4224; float* st = vv + 8192;   float* seg = st + 8320; float* rsq = seg + 512;
            const float* gn = args.gla_g_norm + layer * 128;
            for (int u = bx; u < 1024; u += G) {
                const int h = u & 3, n = (u >> 2) & 31, b = u >> 7; const size_t row0 = (size_t)b * SEQ + n * 64;
                { float c = 0.f;
#pragma unroll
                  for (int i = 0; i < 8; ++i) { const int t = 8 * wave + i; c += bf2f(U[(row0 + t) * NU + ULA + h * 64 + lane]); cum[t * 64 + lane] = c; }
                  seg[wave * 64 + lane] = c; }
                __syncthreads();
                { float off = 0.f;
#pragma unroll
                  for (int w = 0; w < 8; ++w) { const float s = seg[w * 64 + lane]; if (w < wave) off += s; }
#pragma unroll
                  for (int i = 0; i < 8; ++i) { const int t = 8 * wave + i; const float cm = cum[t * 64 + lane] + off;
                      qe[t * 64 + lane] = bf2f(U[(row0 + t) * NU + UGQ + h * 64 + lane]) * __expf(cm);
                      ke[t * 65 + lane] = bf2f(U[(row0 + t) * NU + UGK + h * 64 + lane]) * __expf(-cm); }
                  const int v = tid & 127, sg = tid >> 7;
#pragma unroll
                  for (int i = 0; i < 16; ++i) { const int s = sg + 4 * i; vv[s * 128 + v] = bf2f(U[(row0 + s) * NU + UGV + h * 128 + v]); }
#pragma unroll
                  for (int i = 0; i < 16; ++i) { const int vr = 16 * wave + i; st[vr * 65 + lane] = CST[((size_t)u * 128 + vr) * 64 + lane]; } }
                __syncthreads();
                { float acc[8];
#pragma unroll
                  for (int i = 0; i < 8; ++i) acc[i] = 0.f;
                  for (int k = 0; k < 64; ++k) { const float kv = ke[lane * 65 + k];
#pragma unroll
                      for (int i = 0; i < 8; ++i) acc[i] += qe[(8 * wave + i) * 64 + k] * kv; }
#pragma unroll
                  for (int i = 0; i < 8; ++i) { const int t = 8 * wave + i; cum[t * 64 + lane] = (lane <= t) ? acc[i] : 0.f; } }
                __syncthreads();
                { const int v = tid & 127, tg = tid >> 7; float acc[16];
#pragma unroll
                  for (int i = 0; i < 16; ++i) acc[i] = 0.f;
                  for (int s = 0; s < 64; ++s) { const float x = vv[s * 128 + v];
#pragma unroll
                      for (int i = 0; i < 16; ++i) acc[i] += cum[(16 * tg + i) * 64 + s] * x; }
                  for (int k = 0; k < 64; ++k) { const float x = st[v * 65 + k];
#pragma unroll
                      for (int i = 0; i < 16; ++i) acc[i] += qe[(16 * tg + i) * 64 + k] * x; }
#pragma unroll
                  for (int i = 0; i < 16; ++i) { const float s2 = wave_sum(acc[i] * acc[i]); if (lane == 0) rsq[(16 * tg + i) * 2 + (wave & 1)] = s2; }
                  __syncthreads();
                  const float g = gn[v];
#pragma unroll
                  for (int i = 0; i < 16; ++i) { const int t = 16 * tg + i; const float rs = 1.0f / sqrtf((rsq[t * 2] + rsq[t * 2 + 1]) * (1.0f / 128.0f) + pg8::RMS_EPS);
                      const float gr = bf2f(U[(row0 + t) * NU + UGR + h * 128 + v]);
                      MIX[(row0 + t) * D + 256 + h * 128 + v] = (bf16)f2bf(acc[i] * rs * g * pg8::silu_f(gr)); } }
                __syncthreads();
            }
        }
        SEAM(pb + 3);
        if (IN(pb + 4)) {
            pg8::Gemm g{MIX, (const bf16*)(ws + WS_WOUT) + (size_t)layer * D * D, M, D, D}; pg8::StaticOrder S; S.init(M, D, G, bx);
            pg8::EpiRes E{layer == 0 ? args.x : (const float*)X, X, XB, SS};
            pg8::gemm_phase<pg8::EpiRes, pg8::StaticOrder, true, true>(ldsl, g, S, E);
        }
        SEAM(pb + 4);
        if (layer == 0) {
            if (IN(pb + 5)) {
                pg8::Gemm g{XB, W13, M, 2 * FF, D}; pg8::StaticOrder S; S.init(M, 2 * FF, G, bx);
                pg8::EpiGlu<false> E{H, FF, SS};
                pg8::gemm_phase<pg8::EpiGlu<false>, pg8::StaticOrder, true, true>(ldsl, g, S, E);
            }
            SEAM(pb + 5);
            if (IN(pb + 6)) {
                pg8::Gemm g{H, W2, M, D, FF}; pg8::StaticOrder S; S.init(M, D, G, bx);
                pg8::EpiRes E{X, X, XB, SS};
                pg8::gemm_phase<pg8::EpiRes, pg8::StaticOrder, true, true>(ldsl, g, S, E);
            }
            SEAM(pb + 6);
        } else {
            if (IN(pb + 5)) {
                float* wr_l = (float*)lds;
                int* cnt_l = (int*)(lds + 32768);
                const float* gf = args.g_ffn + D;
                for (int i = tid; i < D * 8; i += NTHR) wr_l[i] = args.moe_router[i] * gf[i >> 3];
                if (tid < 8) cnt_l[tid] = 0;
                __syncthreads();
                for (int blk = bx; blk < 256; blk += G) {
                    if (blk != bx) { __syncthreads(); if (tid < 8) cnt_l[tid] = 0; __syncthreads(); }
                    for (int i = 0; i < 8; ++i) { const int m = blk * 64 + wave * 8 + i;
                        const f32x4* xr = (const f32x4*)(X + (size_t)m * D) + lane; float lg[8];
#pragma unroll
                        for (int e = 0; e < 8; ++e) lg[e] = 0.f;
#pragma unroll
                        for (int j = 0; j < 4; ++j) { const f32x4 v = xr[64 * j]; const int k0 = 4 * (lane + 64 * j);
#pragma unroll
                            for (int q = 0; q < 4; ++q) { const f32x4 w0 = *(const f32x4*)(wr_l + (k0 + q) * 8), w1 = *(const f32x4*)(wr_l + (k0 + q) * 8 + 4);
#pragma unroll
                                for (int e = 0; e < 4; ++e) { lg[e] += v[q] * w0[e]; lg[4 + e] += v[q] * w1[e]; } } }
                        const float rs = pg8::rstd_of(SS + (size_t)m * 16);
#pragma unroll
                        for (int e = 0; e < 8; ++e) lg[e] = wave_sum(lg[e]) * rs;
                        int i0 = 0; float v0 = lg[0];
#pragma unroll
                        for (int e = 1; e < 8; ++e) if (lg[e] > v0) { v0 = lg[e]; i0 = e; }
                        int i1 = -1; float v1 = -INFINITY;
#pragma unroll
                        for (int e = 0; e < 8; ++e) if (e != i0 && lg[e] > v1) { v1 = lg[e]; i1 = e; }
                        const float w1 = 1.0f / (1.0f + __expf(v0 - v1)), w0 = 1.0f - w1;
                        if (lane == 0) { TOPI[m * 2] = i0; TOPI[m * 2 + 1] = i1; TOPW[m * 2] = w0; TOPW[m * 2 + 1] = w1; RS3[m] = rs; atomicAdd(&cnt_l[i0], 1); atomicAdd(&cnt_l[i1], 1); } }
                    __syncthreads();
                    if (tid < 8) CNT[blk * 8 + tid] = cnt_l[tid];
                }
            }
            SEAM(pb + 5);
            if (IN(pb + 6)) {
                int* base_l = (int*)lds;
                int* pre_l = base_l + 8;
                int* tot_l = pre_l + 8;
                int* pos_l = tot_l + 8;
                int* ent_l = pos_l + 128;
                for (int blk = bx; blk < 256; blk += G) {
                    __syncthreads();
                    if (tid < 8) { tot_l[tid] = 0; pre_l[tid] = 0; }
                    if (tid < 128) ent_l[tid] = TOPI[blk * 128 + tid];
                    __syncthreads();
                    { const int g2 = tid >> 1, e0 = (tid & 1) * 4; const int4 c = *(const int4*)(CNT + g2 * 8 + e0);
                      atomicAdd(&tot_l[e0], c.x); atomicAdd(&tot_l[e0 + 1], c.y); atomicAdd(&tot_l[e0 + 2], c.z); atomicAdd(&tot_l[e0 + 3], c.w);
                      if (g2 < blk) { atomicAdd(&pre_l[e0], c.x); atomicAdd(&pre_l[e0 + 1], c.y); atomicAdd(&pre_l[e0 + 2], c.z); atomicAdd(&pre_l[e0 + 3], c.w); } }
                    __syncthreads();
                    if (tid == 0) { int bs = 0; for (int e = 0; e < 8; ++e) { base_l[e] = bs; bs += (tot_l[e] + 255) & ~255; } }
                    __syncthreads();
                    if (tid < 128) { const int e = ent_l[tid]; int rank = 0; for (int j = 0; j < tid; ++j) rank += (ent_l[j] == e) ? 1 : 0;
                        const int p = base_l[e] + pre_l[e] + rank; pos_l[tid] = p; POS[blk * 128 + tid] = p; ROWGATE[p] = TOPW[blk * 128 + tid]; ROWRS[p] = RS3[blk * 64 + (tid >> 1)]; }
                    if (blk == 0) {
                        for (int e = 0; e < 8; ++e) { const int npe = (tot_l[e] + 255) >> 8; for (int p = base_l[e] + tot_l[e] + tid; p < base_l[e] + npe * 256; p += NTHR) { ROWGATE[p] = 0.f; ROWRS[p] = 0.f; } }
                        if (tid == 0) { int np = 0; for (int e = 0; e < 8; ++e) { const int npe = (tot_l[e] + 255) >> 8; for (int j = 0; j < npe; ++j) PANE[np++] = e; } PANE[MAXPAN] = np; } }
                    __syncthreads();
                    for (int i = 0; i < 16; ++i) { const int sl = wave * 16 + i; const int m = blk * 64 + (sl >> 1); const int p = pos_l[sl];
                        const v4u* s = (const v4u*)(XB + (size_t)m * D) + lane; v4u* d = (v4u*)(XS + (size_t)p * D) + lane; d[0] = s[0]; d[64] = s[64]; }
                }
            }
            SEAM(pb + 6);
            if (IN(pb + 7)) {
                pg8::Gemm g{XS, WE13, MAXROWS, 2 * FE, D}; pg8::MoeOrder S{PANE, PANE[MAXPAN], 28, G, bx};
                pg8::EpiGlu<true> E{HE, FE, ROWRS};
                pg8::gemm_phase<pg8::EpiGlu<true>, pg8::MoeOrder, true, true>(ldsl, g, S, E);
            }
            SEAM(pb + 7);
            if (IN(pb + 8)) {
                unsigned* scr = (unsigned*)(lds + wave * 8704);
                constexpr int T_J = 56 * 16;
                for (int it = gw; it < 8 * T_J; it += NGW) { const int e = it / T_J, r = it % T_J;
                    transpose_tile(args.moe_w2 + (size_t)e * FE * D, D, 64 * (r / 16), 64 * (r % 16), WE2 + (size_t)e * D * FE, FE, 64 * (r % 16), nullptr, scr, lane); }
            }
            SEAM(pb + 8);
            if (IN(pb + 9)) {
                pg8::Gemm g{HE, WE2, MAXROWS, D, FE}; pg8::MoeOrder S{PANE, PANE[MAXPAN], 4, G, bx};
                pg8::EpiMoeDown E{Y, ROWGATE};
                pg8::gemm_phase<pg8::EpiMoeDown, pg8::MoeOrder, true, true>(ldsl, g, S, E);
            }
            SEAM(pb + 9);
            if (IN(pb + 10)) {
                for (int m = gw; m < M; m += NGW) {
                    f32x4* xr = (f32x4*)(X + (size_t)m * D) + lane; const int p0 = POS[m * 2], p1 = POS[m * 2 + 1];
                    const unsigned long long* y0 = (const unsigned long long*)(Y + (size_t)p0 * D) + lane; const unsigned long long* y1 = (const unsigned long long*)(Y + (size_t)p1 * D) + lane;
                    f32x4 v[4]; float s = 0.f;
#pragma unroll
                    for (int j = 0; j < 4; ++j) { v[j] = xr[64 * j]; const unsigned long long a = y0[64 * j], c = y1[64 * j];
                        v[j][0] += bflo((unsigned)a) + bflo((unsigned)c); v[j][1] += bfhi((unsigned)a) + bfhi((unsigned)c);
                        v[j][2] += bflo((unsigned)(a >> 32)) + bflo((unsigned)(c >> 32)); v[j][3] += bfhi((unsigned)(a >> 32)) + bfhi((unsigned)(c >> 32));
                        s += (v[j][0] * v[j][0] + v[j][1] * v[j][1]) + (v[j][2] * v[j][2] + v[j][3] * v[j][3]); }
                    const float rs = 1.0f / sqrtf(wave_sum(s) * (1.0f / D) + pg8::RMS_EPS);
                    const f32x4* gf = (const f32x4*)args.g_final + lane;
#pragma unroll
                    for (int j = 0; j < 4; ++j) xr[64 * j] = v[j] * rs * gf[64 * j];
                }
            }
        }
}

__global__ void __launch_bounds__(NTHR, 2) hybrid_fwd(Args args) {
    extern __shared__ __attribute__((aligned(16))) unsigned char lds[];
    LAS unsigned char* ldsl = (LAS unsigned char*)lds;
    volatile LAS unsigned* MISC = (volatile LAS unsigned*)(ldsl + MISC_OFF);
    const int tid = threadIdx.x, lane = tid & 63, wave = __builtin_amdgcn_readfirstlane(tid >> 6);
    const int G = gridDim.x; const int bx = blockIdx.x;
    const int gw = bx * NWAVES + wave, NGW = G * NWAVES;
    unsigned char* ws = args.ws;
    for (int u = tid; u < (LDS_BYTES - LDSCTL_OFF) / 4; u += NTHR) ((LAS unsigned*)(ldsl + LDSCTL_OFF))[u] = 0u;
    __syncthreads();
    XcdBarrier bar; bar.bar = (unsigned*)(ws + WS_CTL) + CW_BAR; bar.x = 0; bar.st = nullptr;
    if (MK_N_LAUNCHES == 1) bar = xcd_barrier_post((unsigned*)(ws + WS_CTL) + CW_BAR, MISC + 8);
    const int lo = args.ph_lo, hi = args.ph_hi;

    WS_PTRS

    if (IN(0)) {
        unsigned* scr = (unsigned*)(lds + wave * 8704);
        constexpr int T_A = 16 * 36, T_B = 16 * 12, T_C = 16 * 4, T_D = 16 * 16, T_L = T_A + T_B + T_C + T_D;
        constexpr int T_F = 16 * 44, T_G = 44 * 16, T_E = 16 * 56;
        constexpr int NT0 = 2 * T_L + 2 * T_F + T_G + 16 * T_E;
        for (int it = gw; it < NT0; it += NGW) {
            int r = it;
            if (r < 2 * T_L) { const int l = r / T_L; r -= l * T_L; const float* win = args.w_mix_in + (size_t)l * D * INC; const float* gm = args.g_mix + l * D;
                bf16* WIN = (bf16*)(ws + WS_WIN) + (size_t)l * NU * D;
                if (r < T_A) { transpose_tile(win, INC, 64 * (r / 36), 64 * (r % 36), WIN, D, 64 * (r % 36), gm, scr, lane); continue; } r -= T_A;
                if (r < T_B) { transpose_tile(win, INC, 64 * (r / 12), 2320 + 64 * (r % 12), WIN, D, 2304 + 64 * (r % 12), gm, scr, lane); continue; } r -= T_B;
                if (r < T_C) { glr_tile(win, args.gla_w_gate + l * 16 * 256, gm, 64 * (r / 4), 64 * (r % 4), WIN, 3072, lane); continue; } r -= T_C;
                transpose_tile(args.w_mix_out + (size_t)l * D * D, D, 64 * (r / 16), 64 * (r % 16), (bf16*)(ws + WS_WOUT) + (size_t)l * D * D, D, 64 * (r % 16), nullptr, scr, lane); continue; }
            r -= 2 * T_L;
            if (r < 2 * T_F) { const int w3 = r / T_F; r -= w3 * T_F; const int n0 = 64 * (r % 44);
                transpose_tile(w3 ? args.ffn_w3 : args.ffn_w1, FF, 64 * (r / 44), n0, W13, D, (n0 >> 7) * 256 + (n0 & 127) + 128 * w3, args.g_ffn, scr, lane); continue; }
            r -= 2 * T_F;
            if (r < T_G) { transpose_tile(args.ffn_w2, D, 64 * (r / 16), 64 * (r % 16), W2, FF, 64 * (r % 16), nullptr, scr, lane); continue; }
            r -= T_G;
            { const int ew = r / T_E; r -= ew * T_E; const int e = ew >> 1, w3 = ew & 1; const int n0 = 64 * (r % 56);
              transpose_tile((w3 ? args.moe_w3 : args.moe_w1) + (size_t)e * D * FE, FE, 64 * (r / 56), n0, WE13 + (size_t)e * 2 * FE * D, D, (n0 >> 7) * 256 + (n0 & 127) + 128 * w3, args.g_ffn + D, scr, lane); }
        }
        for (int m = gw; m < M; m += NGW) {
            const f32x4* xr = (const f32x4*)(args.x + (size_t)m * D) + lane; float s = 0.f;
            unsigned long long* o8 = (unsigned long long*)(XB + (size_t)m * D) + lane;
#pragma unroll
            for (int j = 0; j < 4; ++j) { const f32x4 v = xr[64 * j]; s += (v[0] * v[0] + v[1] * v[1]) + (v[2] * v[2] + v[3] * v[3]);
                o8[64 * j] = (unsigned long long)pk2(v[0], v[1]) | ((unsigned long long)pk2(v[2], v[3]) << 32); }
            s = wave_sum(s);
            if (lane < 16) SS[(size_t)m * 16 + lane] = (lane == 0) ? s : 0.f;
        }
        for (int i = bx * NTHR + tid; i < 2049 * 4; i += G * NTHR) { const int d = i >> 2, h = i & 3; BL[i] = args.rel_bias[rel_bucket(d) * 4 + h] * LOG2E; }
    }
    SEAM(0);

    Ctx c; c.args = args; c.tid = tid; c.lane = lane; c.wave = wave; c.G = G; c.bx = bx; c.gw = gw; c.NGW = NGW; c.lo = lo; c.hi = hi; c.bar = bar;
    layer_phases<0>(c, lds);
    layer_phases<1>(c, lds);
}
#undef IN
#undef SEAM
#undef GRID_BAR


extern "C" void kernel_launch(void* const* d_in, const int* in_sizes, int n_in, void* d_out, int out_size, void* d_ws, size_t ws_size, hipStream_t stream) {
    static int grid = 0;
    if (grid == 0) {
        if (n_in != 18 || in_sizes[0] != M * D || out_size != M * D || ws_size < WS_END) { fprintf(stderr, "kernel_launch: unexpected shapes / workspace (%zu < %zu)\n", ws_size, (size_t)WS_END); grid = -1; return; }
        int dev = 0, cus = 0, per_cu = 0;
        if (hipGetDevice(&dev) != hipSuccess || hipDeviceGetAttribute(&cus, hipDeviceAttributeMultiprocessorCount, dev) != hipSuccess) { grid = -1; return; }
        if (hipFuncSetAttribute((const void*)hybrid_fwd, hipFuncAttributeMaxDynamicSharedMemorySize, LDS_BYTES) != hipSuccess) { fprintf(stderr, "kernel_launch: hipFuncSetAttribute failed\n"); grid = -1; return; }
        if (hipOccupancyMaxActiveBlocksPerMultiprocessor(&per_cu, (const void*)hybrid_fwd, NTHR, LDS_BYTES) != hipSuccess || per_cu < 1) { fprintf(stderr, "kernel_launch: occupancy query says %d\n", per_cu); }
        (void)hipGetLastError();
        grid = cus;
    }
    if (grid < 0) return;
    if (hipMemsetAsync((char*)d_ws + WS_CTL, 0, CTL_ZERO_BYTES, stream) != hipSuccess) return;
    Args a{};
    const float** f = (const float**)&a;
    for (int i = 0; i < 18; ++i) f[i] = (const float*)d_in[i];
    a.out = (float*)d_out; a.ws = (unsigned char*)d_ws;
    if (MK_N_LAUNCHES == 1) { a.ph_lo = 0; a.ph_hi = 64; hipLaunchKernelGGL(hybrid_fwd, dim3(grid), dim3(NTHR), LDS_BYTES, stream, a); }
    else {
        static const int phases[] = {0, 1, 2, 3, 4, 5, 6, 7, 17, 18, 19, 20, 21, 22, 23, 24, 25, 26, 27};
        for (int p : phases) { a.ph_lo = p; a.ph_hi = p + 1; hipLaunchKernelGGL(hybrid_fwd, dim3(grid), dim3(NTHR), LDS_BYTES, stream, a); }
    }
}
```

```cpp
#include <hip/hip_runtime.h>
#include <cstdio>
#include <cstdint>

#ifndef MK_N_LAUNCHES
#define MK_N_LAUNCHES 1
#endif

namespace pg8 {
#define PG8_LAS __attribute__((address_space(3)))
typedef unsigned short bf16_t;
typedef short bf16x8 __attribute__((ext_vector_type(8)));
typedef float f32x4 __attribute__((ext_vector_type(4)));
typedef unsigned u32x4 __attribute__((ext_vector_type(4)));
typedef unsigned u32x2 __attribute__((ext_vector_type(2)));
constexpr int BM = 256, BK = 64, HALF = 128, HTB = HALF * BK * 2, STAGE_BYTES = 8 * HTB, NXCD = 8, WGM = 8;

__host__ __device__ __forceinline__ int lds_byte(int r, int c) { const int st = (r >> 4) * 2 + (c >> 5), rr = r & 15, cc = c & 31, ob = rr * 64 + cc * 2; return st * 1024 + (ob ^ (((ob >> 9) & 1) << 5)); }
__host__ __device__ __forceinline__ void stage_rc(int b, int& R, int& C) { const int st = b / 1024, sb = b % 1024, swz = sb ^ (((sb >> 9) & 1) << 5); R = (st >> 1) * 16 + swz / 64; C = (st & 1) * 32 + (swz % 64) / 2; }
__host__ __device__ __forceinline__ int perm32(int rho) { const int n = rho >> 4, i = rho & 15; return 8 * (i >> 2) + 4 * n + (i & 3); }

struct Unit { int pm, pn; };
struct Gemm { const bf16_t* A; const bf16_t* Bt; int M, N, K; };

struct StaticOrder {
    int nM, nN, nwg, G, c;
    __host__ __device__ void init(int M, int N, int G_, int c_) { nM = M / BM; nN = N / BM; nwg = nM * nN; G = G_; c = c_; }
    __host__ __device__ bool next(int i, Unit& u) const {
        const long L = (long)i * G + c; if (L >= nwg) return false;
        int wgid = (int)L; { const int q = nwg / NXCD, r = nwg % NXCD, xcd = wgid % NXCD, off = wgid / NXCD; wgid = (xcd < r ? xcd * (q + 1) : r * (q + 1) + (xcd - r) * q) + off; }
        const int nig = WGM * nN, gid = wgid / nig, fm = gid * WGM, gsz = (nM - fm) < WGM ? (nM - fm) : WGM;
        u.pm = fm + ((wgid % nig) % gsz); u.pn = (wgid % nig) / gsz; return true;
    }
    __device__ __forceinline__ void a_ready(const Unit&) const {}
    __device__ __forceinline__ void done(const Unit&) const {}
};
struct MoeOrder {
    const int* panel_e; int npan, NT, G, c;
    __device__ bool next(int i, Unit& u) const {
        const long L = (long)i * G + c; if (L >= (long)npan * NT) return false;
        const int p = (int)(L / NT); u.pm = p; u.pn = panel_e[p] * NT + (int)(L % NT); return true;
    }
    __device__ __forceinline__ void a_ready(const Unit&) const {}
    __device__ __forceinline__ void done(const Unit&) const {}
};

__device__ __forceinline__ unsigned cvt_pk_bf16(float lo, float hi) { unsigned r; asm volatile("v_cvt_pk_bf16_f32 %0, %1, %2" : "=v"(r) : "v"(lo), "v"(hi)); return r; }

constexpr float RMS_EPS = 1e-6f;
__device__ __forceinline__ float rstd_of(const float* ss16) {
    const f32x4 a = *(const f32x4*)ss16, b = *(const f32x4*)(ss16 + 4), c = *(const f32x4*)(ss16 + 8), d = *(const f32x4*)(ss16 + 12);
    const float s = ((a[0] + a[1]) + (a[2] + a[3])) + ((b[0] + b[1]) + (b[2] + b[3])) + ((c[0] + c[1]) + (c[2] + c[3])) + ((d[0] + d[1]) + (d[2] + d[3]));
    return 1.0f / sqrtf(s * (1.0f / 1024.0f) + RMS_EPS);
}
__device__ __forceinline__ float logsig16(float x) { return ((x < 0.f ? x : 0.f) - log1pf(__expf(-fabsf(x)))) * (1.0f / 16.0f); }
__device__ __forceinline__ float silu_f(float a) { return a / (1.0f + __expf(-a)); }

struct EpiU {
    static constexpr bool PERM = true, AFTER_DRAIN = false;
    bf16_t* U; int ldu; const float* SS; const float* bgate; float qs;
    __device__ __forceinline__ void operator()(const f32x4 (&acc)[2][2][4][2], const Unit& u, int wr, int wc, int fr, int fq) const {
        const int row0 = u.pm * BM + wr * 64 + fr, cl = wc * 32 + 8 * fq, col0 = u.pn * BM + cl;
        const float sc = (u.pn == 0) ? qs : ((u.pn == 3) ? 0.125f : 1.0f);
        const bool la = (u.pn == 12);
        f32x4 bv[2][2];
#pragma unroll
        for (int bj = 0; bj < 2; ++bj)
#pragma unroll
            for (int n = 0; n < 2; ++n) bv[bj][n] = la ? *(const f32x4*)(bgate + cl + bj * HALF + 4 * n) : (f32x4){0.f, 0.f, 0.f, 0.f};
#pragma unroll
        for (int ai = 0; ai < 2; ++ai)
#pragma unroll
            for (int m = 0; m < 4; ++m) { const int row = row0 + ai * HALF + m * 16; const float rs = rstd_of(SS + (size_t)row * 16) * sc;
                bf16_t* rowp = U + (size_t)row * ldu + col0;
#pragma unroll
                for (int bj = 0; bj < 2; ++bj) { f32x4 v0 = acc[ai][bj][m][0] * rs, v1 = acc[ai][bj][m][1] * rs;
                    if (la) {
#pragma unroll
                        for (int j = 0; j < 4; ++j) { v0[j] = logsig16(v0[j] + bv[bj][0][j]); v1[j] = logsig16(v1[j] + bv[bj][1][j]); } }
                    u32x4 w; w.x = cvt_pk_bf16(v0[0], v0[1]); w.y = cvt_pk_bf16(v0[2], v0[3]); w.z = cvt_pk_bf16(v1[0], v1[1]); w.w = cvt_pk_bf16(v1[2], v1[3]);
                    *(u32x4*)(rowp + bj * HALF) = w; } }
    }
};
struct EpiRes {
    static constexpr bool PERM = false, AFTER_DRAIN = false;
    const float* Xin; float* Xout; bf16_t* XB; float* SS;
    __device__ __forceinline__ void operator()(const f32x4 (&acc)[2][2][4][2], const Unit& u, int wr, int wc, int fr, int fq) const {
        const int row0 = u.pm * BM + wr * 64 + fr, col0 = u.pn * BM + wc * 32 + 4 * fq;
#pragma unroll
        for (int ai = 0; ai < 2; ++ai)
#pragma unroll
            for (int m = 0; m < 4; ++m) { const int row = row0 + ai * HALF + m * 16; const size_t off = (size_t)row * 1024 + col0; float ssum = 0.f;
#pragma unroll
                for (int bj = 0; bj < 2; ++bj)
#pragma unroll
                    for (int n = 0; n < 2; ++n) { const f32x4 xo = *(const f32x4*)(Xin + off + bj * HALF + n * 16); const f32x4 v = xo + acc[ai][bj][m][n];
                        *(f32x4*)(Xout + off + bj * HALF + n * 16) = v; u32x2 w; w.x = cvt_pk_bf16(v[0], v[1]); w.y = cvt_pk_bf16(v[2], v[3]);
                        *(u32x2*)(XB + off + bj * HALF + n * 16) = w; ssum += (v[0] * v[0] + v[1] * v[1]) + (v[2] * v[2] + v[3] * v[3]); }
                ssum += __shfl_xor(ssum, 16); ssum += __shfl_xor(ssum, 32);
                if (fq == 0) SS[(size_t)row * 16 + u.pn * 4 + wc] = ssum;
                asm volatile("" ::: "memory"); }
    }
};
template <bool MOE> struct EpiGlu {
    static constexpr bool PERM = true, AFTER_DRAIN = false;
    bf16_t* O; int ldo; const float* SS;
    __device__ __forceinline__ void operator()(const f32x4 (&acc)[2][2][4][2], const Unit& u, int wr, int wc, int fr, int fq) const {
        const int row0 = u.pm * BM + wr * 64 + fr; const int pnl = MOE ? (u.pn % 28) : u.pn; const int col0 = pnl * HALF + wc * 32 + 8 * fq;
#pragma unroll
        for (int ai = 0; ai < 2; ++ai)
#pragma unroll
            for (int m = 0; m < 4; ++m) { const int row = row0 + ai * HALF + m * 16; const float rs = MOE ? SS[row] : rstd_of(SS + (size_t)row * 16);
                const f32x4 a0 = acc[ai][0][m][0] * rs, a1 = acc[ai][0][m][1] * rs, b0 = acc[ai][1][m][0] * rs, b1 = acc[ai][1][m][1] * rs;
                f32x4 g0, g1;
#pragma unroll
                for (int j = 0; j < 4; ++j) { g0[j] = silu_f(a0[j]) * b0[j]; g1[j] = silu_f(a1[j]) * b1[j]; }
                u32x4 w; w.x = cvt_pk_bf16(g0[0], g0[1]); w.y = cvt_pk_bf16(g0[2], g0[3]); w.z = cvt_pk_bf16(g1[0], g1[1]); w.w = cvt_pk_bf16(g1[2], g1[3]);
                *(u32x4*)(O + (size_t)row * ldo + col0) = w; }
    }
};
struct EpiMoeDown {
    static constexpr bool PERM = true, AFTER_DRAIN = false;
    bf16_t* Y; const float* gate;
    __device__ __forceinline__ void operator()(const f32x4 (&acc)[2][2][4][2], const Unit& u, int wr, int wc, int fr, int fq) const {
        const int row0 = u.pm * BM + wr * 64 + fr, col0 = (u.pn & 3) * BM + wc * 32 + 8 * fq;
#pragma unroll
        for (int ai = 0; ai < 2; ++ai)
#pragma unroll
            for (int m = 0; m < 4; ++m) { const int row = row0 + ai * HALF + m * 16; const float g = gate[row]; bf16_t* rowp = Y + (size_t)row * 1024 + col0;
#pragma unroll
                for (int bj = 0; bj < 2; ++bj) { const f32x4 v0 = acc[ai][bj][m][0] * g, v1 = acc[ai][bj][m][1] * g;
                    u32x4 w; w.x = cvt_pk_bf16(v0[0], v0[1]); w.y = cvt_pk_bf16(v0[2], v0[3]); w.z = cvt_pk_bf16(v1[0], v1[1]); w.w = cvt_pk_bf16(v1[2], v1[3]);
                    *(u32x4*)(rowp + bj * HALF) = w; } }
    }
};

template <class Epi, class Sched, bool ALIGN_EPI = false, bool SP2 = false>
__device__ __forceinline__ void gemm_phase(PG8_LAS unsigned char* lds, const Gemm g, const Sched& S, const Epi& E) {
    const int tid = threadIdx.x, wid = __builtin_amdgcn_readfirstlane(tid >> 6), lane = tid & 63, wr = wid >> 2, wc = wid & 3, fr = lane & 15, fq = lane >> 4;
    const int K = g.K, nt = K / BK;
    unsigned voffA[2], voffB[2];
#pragma unroll
    for (int i = 0; i < 2; ++i) { int R, C; stage_rc(tid * 16 + i * 8192, R, C); const int Rb = Epi::PERM ? ((R & ~31) + perm32(R & 31)) : R;
        voffA[i] = (unsigned)(R * K + C) * 2u; voffB[i] = (unsigned)(Rb * K + C) * 2u; }
    const size_t kstep = (size_t)(BK * 2);
    const size_t hstep = (size_t)HALF * K * 2;
    const size_t tstep = 2 * hstep;
    const unsigned ldsw = (unsigned)wid * 1024u;
    const int aoff = lds_byte(wr * 64 + fr, fq * 8), boff = lds_byte(wc * 32 + fr, fq * 8);
#define PG8_SA(b, h) (((b) * 2 + (h)) * HTB)
#define PG8_SB(b, h) ((4 + (b) * 2 + (h)) * HTB)
#define PG8_STAGE(bufoff, gbase, voff) do { _Pragma("unroll") for (int _i = 0; _i < 2; ++_i) \
        __builtin_amdgcn_global_load_lds((const unsigned*)((const char*)(gbase) + (voff)[_i]), (PG8_LAS unsigned*)(lds + (bufoff) + ldsw + _i * 8192), 16, 0, 0); } while (0)
#define PG8_LDA(dst, b, h) do { _Pragma("unroll") for (int m = 0; m < 4; ++m) _Pragma("unroll") for (int k = 0; k < 2; ++k) dst[m][k] = *(const PG8_LAS bf16x8*)(lds + PG8_SA(b, h) + aoff + m * 2048 + k * 1024); } while (0)
#define PG8_LDB(dst, b, h) do { _Pragma("unroll") for (int n = 0; n < 2; ++n) _Pragma("unroll") for (int k = 0; k < 2; ++k) dst[n][k] = *(const PG8_LAS bf16x8*)(lds + PG8_SB(b, h) + boff + n * 2048 + k * 1024); } while (0)
#define PG8_MMA(ai, bj, At, Bt) do { __builtin_amdgcn_s_setprio(1); _Pragma("unroll") for (int m = 0; m < 4; ++m) _Pragma("unroll") for (int n = 0; n < 2; ++n) _Pragma("unroll") for (int k = 0; k < 2; ++k) \
        acc[ai][bj][m][n] = __builtin_amdgcn_mfma_f32_16x16x32_bf16(Bt[n][k], At[m][k], acc[ai][bj][m][n], 0, 0, 0); __builtin_amdgcn_s_setprio(0); } while (0)
#define PG8_WAIT_V(n) asm volatile("s_waitcnt vmcnt(" #n ")" ::: "memory")
#define PG8_WAIT_L(n) asm volatile("s_waitcnt lgkmcnt(" #n ")" ::: "memory")
#define PG8_BAR __builtin_amdgcn_s_barrier()
#define PG8_SCHED __builtin_amdgcn_sched_barrier(0)
    Unit cur, nxt; int ui = 0;
    if (!S.next(0, cur)) return;
    f32x4 acc[2][2][4][2];
#pragma unroll
    for (int a = 0; a < 2; ++a)
#pragma unroll
        for (int b = 0; b < 2; ++b)
#pragma unroll
            for (int m = 0; m < 4; ++m)
#pragma unroll
                for (int n = 0; n < 2; ++n) acc[a][b][m][n] = (f32x4){0.f, 0.f, 0.f, 0.f};
    bf16x8 At[4][2], B0[2][2], B1[2][2];
    const char* cA = (const char*)g.A + (size_t)cur.pm * tstep; const char* cB = (const char*)g.Bt + (size_t)cur.pn * tstep;
    S.a_ready(cur);
    if constexpr (SP2) {
        PG8_STAGE(PG8_SB(0, 0), cB, voffB); PG8_STAGE(PG8_SB(0, 1), cB + hstep, voffB); PG8_STAGE(PG8_SA(0, 0), cA, voffA); PG8_STAGE(PG8_SA(0, 1), cA + hstep, voffA);
        if (wr == 1) PG8_BAR;
        PG8_WAIT_V(2); PG8_BAR;
        PG8_STAGE(PG8_SB(1, 0), cB + kstep, voffB); PG8_STAGE(PG8_SA(1, 0), cA + kstep, voffA); PG8_STAGE(PG8_SB(1, 1), cB + hstep + kstep, voffB);
        PG8_WAIT_V(6); PG8_BAR;
    } else {
        PG8_STAGE(PG8_SB(0, 0), cB, voffB); PG8_STAGE(PG8_SA(0, 0), cA, voffA); PG8_STAGE(PG8_SB(0, 1), cB + hstep, voffB); PG8_STAGE(PG8_SA(0, 1), cA + hstep, voffA);
        if (wr == 1) PG8_BAR;
        PG8_WAIT_V(4); PG8_BAR;
        PG8_STAGE(PG8_SB(1, 0), cB + kstep, voffB); PG8_STAGE(PG8_SA(1, 0), cA + kstep, voffA); PG8_STAGE(PG8_SB(1, 1), cB + hstep + kstep, voffB);
        PG8_WAIT_V(6); PG8_BAR;
    }
    for (;;) {
        const bool has_next = S.next(ui + 1, nxt);
        const char* nA = has_next ? (const char*)g.A + (size_t)nxt.pm * tstep : cA; const char* nB = has_next ? (const char*)g.Bt + (size_t)nxt.pn * tstep : cB;
        for (int t = 0; t < nt; t += 2) {
            const bool last = (t == nt - 2);
            const char* a1 = cA + (size_t)(t + 1) * kstep;
            const char* a2 = last ? nA : cA + (size_t)(t + 2) * kstep; const char* b2 = last ? nB : cB + (size_t)(t + 2) * kstep;
            const char* a3 = a2 + kstep; const char* b3 = b2 + kstep;
            if (last && has_next) S.a_ready(nxt);
            if constexpr (SP2) {
            PG8_LDB(B0, 0, 0); PG8_LDB(B1, 0, 1); PG8_SCHED; PG8_LDA(At, 0, 0); PG8_STAGE(PG8_SA(1, 1), a1 + hstep, voffA);
            PG8_WAIT_V(8); PG8_WAIT_L(0); PG8_BAR; PG8_MMA(0, 0, At, B0); PG8_MMA(0, 1, At, B1); PG8_BAR; PG8_SCHED;
            PG8_LDA(At, 0, 1); PG8_STAGE(PG8_SB(0, 0), b2, voffB); PG8_STAGE(PG8_SB(0, 1), b2 + hstep, voffB); PG8_STAGE(PG8_SA(0, 0), a2, voffA);
            PG8_WAIT_V(8); PG8_WAIT_L(0); PG8_BAR; PG8_MMA(1, 0, At, B0); PG8_MMA(1, 1, At, B1); PG8_BAR; PG8_SCHED;
            PG8_LDB(B0, 1, 0); PG8_LDB(B1, 1, 1); PG8_SCHED; PG8_LDA(At, 1, 0); PG8_STAGE(PG8_SA(0, 1), a2 + hstep, voffA);
            PG8_WAIT_V(8); PG8_WAIT_L(0); PG8_BAR; PG8_MMA(0, 0, At, B0); PG8_MMA(0, 1, At, B1); PG8_BAR; PG8_SCHED;
            PG8_LDA(At, 1, 1); PG8_STAGE(PG8_SB(1, 0), b3, voffB); PG8_STAGE(PG8_SB(1, 1), b3 + hstep, voffB); PG8_STAGE(PG8_SA(1, 0), a3, voffA);
            PG8_WAIT_V(8); PG8_WAIT_L(0); PG8_BAR; PG8_MMA(1, 0, At, B0); PG8_MMA(1, 1, At, B1); PG8_BAR; PG8_SCHED;
            } else {
            PG8_LDB(B0, 0, 0); PG8_SCHED; PG8_LDA(At, 0, 0); PG8_STAGE(PG8_SA(1, 1), a1 + hstep, voffA);
            PG8_WAIT_L(8); PG8_BAR; PG8_WAIT_L(0); PG8_MMA(0, 0, At, B0); PG8_BAR; PG8_SCHED;
            PG8_LDB(B1, 0, 1); PG8_STAGE(PG8_SB(0, 0), b2, voffB);
            PG8_BAR; PG8_WAIT_L(0); PG8_MMA(0, 1, At, B1); PG8_BAR;
            PG8_LDA(At, 0, 1); PG8_STAGE(PG8_SA(0, 0), a2, voffA);
            PG8_BAR; PG8_WAIT_L(0); PG8_MMA(1, 0, At, B0); PG8_BAR; PG8_SCHED;
            PG8_STAGE(PG8_SB(0, 1), b2 + hstep, voffB);
            PG8_WAIT_V(6); PG8_BAR; PG8_MMA(1, 1, At, B1); PG8_BAR;
            PG8_LDB(B0, 1, 0); PG8_SCHED; PG8_LDA(At, 1, 0); PG8_STAGE(PG8_SA(0, 1), a2 + hstep, voffA);
            PG8_WAIT_L(8); PG8_BAR; PG8_WAIT_L(0); PG8_MMA(0, 0, At, B0); PG8_BAR; PG8_SCHED;
            PG8_LDB(B1, 1, 1); PG8_STAGE(PG8_SB(1, 0), b3, voffB);
            PG8_BAR; PG8_WAIT_L(0); PG8_MMA(0, 1, At, B1); PG8_BAR;
            PG8_LDA(At, 1, 1); PG8_STAGE(PG8_SA(1, 0), a3, voffA);
            PG8_BAR; PG8_WAIT_L(0); PG8_MMA(1, 0, At, B0); PG8_BAR; PG8_SCHED;
            PG8_STAGE(PG8_SB(1, 1), b3 + hstep, voffB);
            PG8_WAIT_V(6); PG8_BAR; PG8_MMA(1, 1, At, B1); PG8_BAR;
            }
        }
        if constexpr (ALIGN_EPI) { if (wr == 0) PG8_BAR; }
        if constexpr (!Epi::AFTER_DRAIN) { E(acc, cur, wr, wc, fr, fq); S.done(cur); }
        if (!has_next) break;
#pragma unroll
        for (int a = 0; a < 2; ++a)
#pragma unroll
            for (int b = 0; b < 2; ++b)
#pragma unroll
                for (int m = 0; m < 4; ++m)
#pragma unroll
                    for (int n = 0; n < 2; ++n) acc[a][b][m][n] = (f32x4){0.f, 0.f, 0.f, 0.f};
        cur = nxt; cA = nA; cB = nB; ++ui;
        if constexpr (ALIGN_EPI) { if (wr == 1) PG8_BAR; }
    }
    PG8_WAIT_V(0);
    if constexpr (!ALIGN_EPI) { if (wr == 0) PG8_BAR; }
    PG8_BAR;
#undef PG8_SA
#undef PG8_SB
#undef PG8_STAGE
#undef PG8_LDA
#undef PG8_LDB
#undef PG8_MMA
#undef PG8_WAIT_V
#undef PG8_WAIT_L
#undef PG8_BAR
#undef PG8_SCHED
}
}

constexpr int NWAVES = 8, NTHR = NWAVES * 64;
constexpr int NB = 8, SEQ = 2048, D = 1024, M = NB * SEQ;
constexpr int INC = 3088;
constexpr int NU = 3328;
constexpr int UQ = 0, UK = 256, UV = 512, UGQ = 768, UGK = 1024, UGV = 1280, UGR = 1792, UCI = 2304, UCB = 2560, UCC = 2816, ULA = 3072;
constexpr int FF = 2816, FE = 3584, NE = 8;
constexpr int MAXPAN = 136, MAXROWS = MAXPAN * 256;
constexpr float LOG2E = 1.4426950408889634f;
constexpr float QS_ATT = 0.125f * LOG2E;

constexpr size_t MiB = 1u << 20;
constexpr size_t WS_CTL = 0, CTL_ZERO_BYTES = 1 * MiB;
constexpr size_t WS_SS = 1 * MiB;
constexpr size_t WS_BL = 2 * MiB;
constexpr size_t WS_DEC = 2 * MiB + 64 * 1024;
constexpr size_t WS_TOPI = 3 * MiB;
constexpr size_t WS_TOPW = 3 * MiB + 128 * 1024;
constexpr size_t WS_POS = 3 * MiB + 256 * 1024;
constexpr size_t WS_RS3 = 3 * MiB + 384 * 1024;
constexpr size_t WS_CNT = 3 * MiB + 448 * 1024;
constexpr size_t WS_PANE = 3 * MiB + 456 * 1024;
constexpr size_t WS_ROWGATE = 4 * MiB;
constexpr size_t WS_ROWRS = 4 * MiB + 256 * 1024;
constexpr size_t WS_WE13 = 8 * MiB;
constexpr size_t WS_Y = WS_WE13;
constexpr size_t WS_XS = 120 * MiB;
constexpr size_t WS_WE2 = WS_XS;
constexpr size_t WS_HE = 188 * MiB;
constexpr size_t WS_WIN = WS_HE;
constexpr size_t WS_WOUT = WS_HE + 13 * MiB;
constexpr size_t WS_W13 = WS_HE + 17 * MiB;
constexpr size_t WS_W2 = WS_HE + 28 * MiB;
constexpr size_t WS_XB = WS_HE + 34 * MiB;
constexpr size_t WS_U = WS_HE + 66 * MiB;
constexpr size_t WS_H = WS_U;
constexpr size_t WS_MIX = WS_HE + 170 * MiB;
constexpr size_t WS_CST = WS_HE + 202 * MiB;
constexpr size_t WS_END = WS_HE + 238 * MiB;
static_assert(WS_CST + 32 * MiB <= WS_END, "ws map");
constexpr int CW_BAR = 4096;

constexpr int LDS_BYTES = 147456;
constexpr int LDSCTL_OFF = 131072 + 14 * 1024, MISC_OFF = LDSCTL_OFF + 320;

#define GAS __attribute__((address_space(1)))
#define LAS __attribute__((address_space(3)))
typedef unsigned short bf16;
typedef float f32x4 __attribute__((ext_vector_type(4)));
typedef unsigned v4u __attribute__((ext_vector_type(4)));
__device__ __forceinline__ unsigned f2bf(float f) { unsigned u = __builtin_bit_cast(unsigned, f); return (u + 0x7fffu + ((u >> 16) & 1u)) >> 16; }
__device__ __forceinline__ unsigned pk2(float lo, float hi) { return f2bf(lo) | (f2bf(hi) << 16); }
__device__ __forceinline__ float bf2f(unsigned short b) { return __builtin_bit_cast(float, (unsigned)b << 16); }
__device__ __forceinline__ float bflo(unsigned w) { return __builtin_bit_cast(float, w << 16); }
__device__ __forceinline__ float bfhi(unsigned w) { return __builtin_bit_cast(float, w & 0xffff0000u); }
__device__ __forceinline__ float wave_sum(float v) {
#pragma unroll
    for (int o = 1; o < 64; o <<= 1) v += __shfl_xor(v, o);
    return v;
}
__device__ __forceinline__ float wave_max(float v) {
#pragma unroll
    for (int o = 1; o < 64; o <<= 1) v = fmaxf(v, __shfl_xor(v, o));
    return v;
}

#define XB_TMO      128
#define XB_XCNT(j)  (256  + 64 * (j))
#define XB_XSUB(j)  (1280 + 64 * (j))
#define XB_XGEN(j)  (2304 + 64 * (j))
#define XB_TOP      3328
#define XB_TOPGEN   3392
#define XCD_BAR_WORDS 3456
#define XB_SPIN_CAP (1u << 18)
__device__ __forceinline__ unsigned xb_ld(unsigned* p)              { return __hip_atomic_load(p, __ATOMIC_RELAXED, __HIP_MEMORY_SCOPE_AGENT); }
__device__ __forceinline__ unsigned xb_add(unsigned* p, unsigned v) { return __hip_atomic_fetch_add(p, v, __ATOMIC_RELAXED, __HIP_MEMORY_SCOPE_AGENT); }
__device__ __forceinline__ unsigned xb_xcc_id() { return (unsigned)__builtin_amdgcn_s_getreg((3 << 11) | 20) & 0xFu; }
#define XB_SPIN(cond, bar) do { unsigned _sp = 0; while (cond) { __builtin_amdgcn_s_sleep(1); \
    if ((++_sp & 255u) == 0u) { if (xb_ld(&(bar)[XB_TMO])) break; if (_sp > XB_SPIN_CAP) { atomicAdd(&(bar)[XB_TMO], 1u); break; } } } } while (0)
struct XcdBarrier { unsigned* bar; unsigned x; volatile LAS unsigned* st; };
__device__ __forceinline__ XcdBarrier xcd_barrier_post(unsigned* bar, volatile LAS unsigned* st) {
    XcdBarrier b; b.bar = bar; b.x = xb_xcc_id(); b.st = st;
    if (threadIdx.x == 0) (void)xb_add(&bar[XB_XCNT(b.x)], 1u);
    return b;
}
__device__ __forceinline__ void xcd_barrier_complete(unsigned* bar, unsigned x, unsigned& nloc, unsigned& nx) {
    const unsigned G = gridDim.x * gridDim.y * gridDim.z;
    unsigned sum, cnt, mine, sp = 0u;
    for (;;) {
        sum = 0u; cnt = 0u; mine = 0u;
#pragma unroll
        for (unsigned j = 0; j < 16; ++j) { const unsigned c = xb_ld(&bar[XB_XCNT(j)]); sum += c; cnt += (c > 0u) ? 1u : 0u; mine = (j == x) ? c : mine; }
        if (sum == G) break;
        __builtin_amdgcn_s_sleep(1);
        if ((++sp & 255u) == 0u) { if (xb_ld(&bar[XB_TMO])) break; if (sp > XB_SPIN_CAP) { atomicAdd(&bar[XB_TMO], 1u); break; } }
    }
    nloc = mine > 0u ? mine : 1u; nx = cnt > 0u ? cnt : 1u;
}
__device__ __forceinline__ void xcd_barrier(const XcdBarrier& b) {
    asm volatile("s_waitcnt vmcnt(0)" ::: "memory");
    __syncthreads();
    if (threadIdx.x == 0) {
        unsigned* bar = b.bar;
        __builtin_amdgcn_s_waitcnt(0);
        unsigned nloc = b.st[0], nx = b.st[1];
        if (nloc == 0u) { xcd_barrier_complete(bar, b.x, nloc, nx); b.st[0] = nloc; b.st[1] = nx; }
        const unsigned old = xb_add(&bar[XB_XSUB(b.x)], 1u);
        const unsigned gen = old / nloc;
        if (old + 1u == (gen + 1u) * nloc) {
            __builtin_amdgcn_fence(__ATOMIC_RELEASE, "agent");
            asm volatile("s_waitcnt vmcnt(0)" ::: "memory");
            const unsigned og = xb_add(&bar[XB_TOP], 1u);
            const unsigned tg = og / nx;
            if (og + 1u == (tg + 1u) * nx) xb_add(&bar[XB_TOPGEN], 1u);
            else XB_SPIN(xb_ld(&bar[XB_TOPGEN]) == tg, bar);
            __builtin_amdgcn_fence(__ATOMIC_ACQUIRE, "agent");
            xb_add(&bar[XB_XGEN(b.x)], 1u);
            asm volatile("s_waitcnt vmcnt(0)" ::: "memory");
        } else {
            XB_SPIN(xb_ld(&bar[XB_XGEN(b.x)]) == gen, bar);
            __builtin_amdgcn_fence(__ATOMIC_ACQUIRE, "agent");
            asm volatile("s_waitcnt vmcnt(0)" ::: "memory");
        }
    }
    __syncthreads();
}

struct Args {
    const float* x; const float* w_mix_in; const float* w_mix_out; const float* g_mix; const float* rel_bias; const float* gla_w_gate; const float* gla_b_gate;
    const float* gla_g_norm; const float* conv_w; const float* g_ffn; const float* ffn_w1; const float* ffn_w3; const float* ffn_w2; const float* moe_router;
    const float* moe_w1; const float* moe_w3; const float* moe_w2; const float* g_final;
    float* out; unsigned char* ws; int ph_lo, ph_hi;
};

__device__ __forceinline__ void transpose_tile(const float* src, int ldsrc, int k0, int n0, bf16* dst, int ldd, int drow0, const float* ksc, unsigned* scr, int lane) {
    const int nq = lane & 15, kk = lane >> 4;
#pragma unroll
    for (int i = 0; i < 8; ++i) { const int k = 8 * i + 2 * kk; const float* p = src + (size_t)(k0 + k) * ldsrc + n0 + 4 * nq;
        const f32x4 r0 = *(const f32x4*)p, r1 = *(const f32x4*)(p + ldsrc);
        const float s0 = ksc ? ksc[k0 + k] : 1.f, s1 = ksc ? ksc[k0 + k + 1] : 1.f;
#pragma unroll
        for (int j = 0; j < 4; ++j) scr[(4 * nq + j) * 33 + 4 * i + kk] = pk2(r0[j] * s0, r1[j] * s1); }
    asm volatile("s_waitcnt lgkmcnt(0)" ::: "memory");
#pragma unroll 8
    for (int i2 = 0; i2 < 32; ++i2) { const int n = 2 * i2 + (lane >> 5), d = lane & 31;
        ((unsigned*)(dst + (size_t)(drow0 + n) * ldd + k0))[d] = scr[n * 33 + d]; }
    asm volatile("s_waitcnt lgkmcnt(0)" ::: "memory");
}
__device__ __forceinline__ void glr_tile(const float* win, const float* wg, const float* g, int k0, int n0, bf16* dst, int drow0, int lane) {
    float w[16];
#pragma unroll
    for (int r = 0; r < 16; ++r) w[r] = wg[r * 256 + n0 + lane];
    unsigned* drow = (unsigned*)(dst + (size_t)(drow0 + n0 + lane) * 1024 + k0);
    for (int kp = 0; kp < 32; ++kp) { float v[2];
#pragma unroll
        for (int q = 0; q < 2; ++q) { const int k = k0 + 2 * kp + q; const float* s = win + (size_t)k * INC + 2304; float a = 0.f;
#pragma unroll
            for (int r = 0; r < 16; ++r) a += s[r] * w[r];
            v[q] = a * g[k]; }
        drow[kp] = pk2(v[0], v[1]); }
}
__device__ __forceinline__ int rel_bucket(int d) {
    if (d < 16) return d;
    const float lr = logf((float)d / 16.0f) / logf(128.0f);
    int b = 16 + (int)(lr * 16.0f); return b < 31 ? b : 31;
}


typedef short bf16x8 __attribute__((ext_vector_type(8)));
typedef short v4i16_t __attribute__((ext_vector_type(4)));
#define MFMA16(a, b, c) __builtin_amdgcn_mfma_f32_16x16x32_bf16((a), (b), (c), 0, 0, 0)
__device__ __forceinline__ v4i16_t tr16(LAS unsigned char* p) { return __builtin_amdgcn_ds_read_tr16_b64_v4i16((LAS v4i16_t*)p); }
__device__ __forceinline__ bf16x8 cat8(v4i16_t lo, v4i16_t hi) { return __builtin_shufflevector(lo, hi, 0, 1, 2, 3, 4, 5, 6, 7); }
__device__ __forceinline__ bf16x8 frag_rm(LAS unsigned char* base, int pitch, int c0, int k0, int lane) { return *(LAS bf16x8*)(base + (c0 + (lane & 15)) * pitch + (k0 + 8 * (lane >> 4)) * 2); }
__device__ __forceinline__ bf16x8 frag_tr(LAS unsigned char* base, int pitch, int c0, int k0, int lane) {
    const int i = lane & 15, g = lane >> 4; LAS unsigned char* p = base + (k0 + 8 * g + (i >> 2)) * pitch + (c0 + 4 * (i & 3)) * 2;
    return cat8(tr16(p), tr16(p + 4 * pitch)); }
__device__ __forceinline__ bf16x8 frag_trp(LAS unsigned char* base, int pitch, int c0, int k0, int lane) {
    const int i = lane & 15, g = lane >> 4; LAS unsigned char* p = base + (k0 + 4 * g + (i >> 2)) * pitch + (c0 + 4 * (i & 3)) * 2;
    return cat8(tr16(p), tr16(p + 16 * pitch)); }
__device__ __forceinline__ bf16x8 pack8(const f32x4& a, const f32x4& b) {
    v4u w; w.x = pg8::cvt_pk_bf16(a[0], a[1]); w.y = pg8::cvt_pk_bf16(a[2], a[3]); w.z = pg8::cvt_pk_bf16(b[0], b[1]); w.w = pg8::cvt_pk_bf16(b[2], b[3]); return __builtin_bit_cast(bf16x8, w); }

struct Ctx { Args args; int tid, lane, wave, G, bx, gw, NGW, lo, hi; XcdBarrier bar; };
#define GRID_BAR() do { if (MK_N_LAUNCHES == 1) xcd_barrier(bar); } while (0)
#define IN(k) (lo <= (k) && (k) < hi)
#define SEAM(k) do { if (IN(k) && IN((k) + 1)) GRID_BAR(); } while (0)
#define WS_PTRS \
    float* SS = (float*)(ws + WS_SS); float* BL = (float*)(ws + WS_BL); float* DEC = (float*)(ws + WS_DEC); \
    bf16* XB = (bf16*)(ws + WS_XB); bf16* U = (bf16*)(ws + WS_U); bf16* MIX = (bf16*)(ws + WS_MIX); float* CST = (float*)(ws + WS_CST); \
    bf16* H = (bf16*)(ws + WS_H); bf16* W13 = (bf16*)(ws + WS_W13); bf16* W2 = (bf16*)(ws + WS_W2); \
    bf16* WE13 = (bf16*)(ws + WS_WE13); bf16* WE2 = (bf16*)(ws + WS_WE2); bf16* XS = (bf16*)(ws + WS_XS); bf16* HE = (bf16*)(ws + WS_HE); bf16* Y = (bf16*)(ws + WS_Y); \
    int* TOPI = (int*)(ws + WS_TOPI); float* TOPW = (float*)(ws + WS_TOPW); int* POS = (int*)(ws + WS_POS); float* RS3 = (float*)(ws + WS_RS3); \
    int* CNT = (int*)(ws + WS_CNT); int* PANE = (int*)(ws + WS_PANE); float* ROWGATE = (float*)(ws + WS_ROWGATE); float* ROWRS = (float*)(ws + WS_ROWRS); \
    float* X = args.out; \
    (void)SS; (void)BL; (void)DEC; (void)XB; (void)U; (void)MIX; (void)CST; (void)H; (void)W13; (void)W2; (void)WE13; (void)WE2; (void)XS; (void)HE; (void)Y; \
    (void)TOPI; (void)TOPW; (void)POS; (void)RS3; (void)CNT; (void)PANE; (void)ROWGATE; (void)ROWRS; (void)X;

template <int layer> __device__ __forceinline__ void layer_phases(const Ctx& c, unsigned char* lds) {
    const Args& args = c.args; LAS unsigned char* ldsl = (LAS unsigned char*)lds;
    const int tid = c.tid, lane = c.lane, wave = c.wave, G = c.G, bx = c.bx, gw = c.gw, NGW = c.NGW, lo = c.lo, hi = c.hi; const XcdBarrier bar = c.bar;
    unsigned char* ws = args.ws; asm volatile("" : "+s"(ws));
    WS_PTRS
    (void)tid; (void)lane; (void)wave; (void)gw; (void)NGW;
        const int pb = 1 + 16 * layer;
        if (IN(pb + 0)) {
            pg8::Gemm g{XB, (const bf16*)(ws + WS_WIN) + (size_t)layer * NU * D, M, NU, D}; pg8::StaticOrder S; S.init(M, NU, G, bx);
            pg8::EpiU E{U, NU, SS, args.gla_b_gate + layer * 256, QS_ATT};
            pg8::gemm_phase<pg8::EpiU, pg8::StaticOrder, true, true>(ldsl, g, S, E);
        }
        SEAM(pb + 0);
        if (IN(pb + 1)) {
            float* cum = (float*)lds; float* kd = cum + 4096; float* vv = kd + 4096; float* seg = vv + 8192;
            for (int u = bx; u < 1024; u += G) {
                const int h = u & 3, n = (u >> 2) & 31, b = u >> 7; const size_t row0 = (size_t)b * SEQ + n * 64;
                { float c = 0.f;
#pragma unroll
                  for (int i = 0; i < 8; ++i) { const int t = 8 * wave + i; c += bf2f(U[(row0 + t) * NU + ULA + h * 64 + lane]); cum[t * 64 + lane] = c; }
                  seg[wave * 64 + lane] = c; }
                __syncthreads();
                { float off = 0.f, last = 0.f;
#pragma unroll
                  for (int w = 0; w < 8; ++w) { const float s = seg[w * 64 + lane]; last += s; if (w < wave) off += s; }
#pragma unroll
                  for (int i = 0; i < 8; ++i) { const int t = 8 * wave + i; const float cm = cum[t * 64 + lane] + off;
                      kd[t * 64 + lane] = bf2f(U[(row0 + t) * NU + UGK + h * 64 + lane]) * __expf(last - cm); }
                  if (wave == 0) DEC[u * 64 + lane] = __expf(last);
                  const int v = tid & 127, sg = tid >> 7;
#pragma unroll
                  for (int i = 0; i < 16; ++i) { const int s = sg + 4 * i; vv[s * 128 + v] = bf2f(U[(row0 + s) * NU + UGV + h * 128 + v]); } }
                __syncthreads();
                { float acc[16];
#pragma unroll
                  for (int i = 0; i < 16; ++i) acc[i] = 0.f;
                  for (int s = 0; s < 64; ++s) { const float kdv = kd[s * 64 + lane];
#pragma unroll
                      for (int i = 0; i < 16; ++i) acc[i] += vv[s * 128 + 16 * wave + i] * kdv; }
#pragma unroll
                  for (int i = 0; i < 16; ++i) CST[((size_t)u * 128 + 16 * wave + i) * 64 + lane] = acc[i]; }
                __syncthreads();
            }
            const float* cw = args.conv_w + layer * 3 * 256;
            for (int it = bx * NTHR + tid; it < M * 32; it += G * NTHR) {
                const int row = it >> 5, c0 = (it & 31) * 8, t = row & (SEQ - 1);
                const bf16* ur = U + (size_t)row * NU;
                const v4u cb = *(const v4u*)(ur + UCB + c0);
                v4u ci[3], cc[3];
#pragma unroll
                for (int d = 0; d < 3; ++d) { if (t >= d) { ci[d] = *(const v4u*)(ur - (size_t)d * NU + UCI + c0); cc[d] = *(const v4u*)(ur - (size_t)d * NU + UCC + c0); } else { ci[d] = (v4u){0u, 0u, 0u, 0u}; cc[d] = ci[d]; } }
                float o[8];
#pragma unroll
                for (int j = 0; j < 4; ++j) {
                    float a0 = 0.f, a1 = 0.f;
#pragma unroll
                    for (int d = 0; d < 3; ++d) { const float w0 = cw[(2 - d) * 256 + c0 + 2 * j], w1 = cw[(2 - d) * 256 + c0 + 2 * j + 1];
                        a0 += w0 * (bflo(cc[d][j]) * bflo(ci[d][j])); a1 += w1 * (bfhi(cc[d][j]) * bfhi(ci[d][j])); }
                    o[2 * j] = bflo(cb[j]) * a0; o[2 * j + 1] = bfhi(cb[j]) * a1; }
                v4u w; w.x = pk2(o[0], o[1]); w.y = pk2(o[2], o[3]); w.z = pk2(o[4], o[5]); w.w = pk2(o[6], o[7]);
                *(v4u*)(MIX + (size_t)row * D + 768 + c0) = w;
            }
        }
        SEAM(pb + 1);
        if (IN(pb + 2)) {
            for (int e = bx * NTHR + tid; e < NB * 4 * 8192; e += G * NTHR) {
                const int k = e & 63, v = (e >> 6) & 127, h = (e >> 13) & 3, b = e >> 15; float S = 0.f;
                for (int n = 0; n < 32; ++n) { const int u = (b * 32 + n) * 4 + h; const size_t idx = ((size_t)u * 128 + v) * 64 + k;
                    const float c = CST[idx]; CST[idx] = S; S = DEC[u * 64 + k] * S + c; }
            }
            {
                float* BLl = (float*)lds;
                for (int i = tid; i < 4 * 2049; i += NTHR) BLl[(i & 3) * 2049 + (i >> 2)] = BL[i];
                __syncthreads();
                LAS unsigned char* vst = ldsl + 33280 + wave * 5120;
                const int ql = lane & 15, g4 = lane >> 4;
                for (int u = bx; u < 512; u += G) {
                    const int c = u & 15, h = (u >> 4) & 3, b = u >> 6; const int i0 = 16 * wave; const size_t rowb = (size_t)b * SEQ;
                    const int tq = c + 16 * (i0 + ql);
                    const bf16* qp = U + (rowb + tq) * NU + UQ + h * 64 + 8 * g4;
                    const bf16x8 qf0 = *(const bf16x8*)qp, qf1 = *(const bf16x8*)(qp + 32);
                    float m_run = -INFINITY, l_run = 0.f; f32x4 o[4];
#pragma unroll
                    for (int d = 0; d < 4; ++d) o[d] = (f32x4){0.f, 0.f, 0.f, 0.f};
                    const float* blh = BLl + h * 2049;
#pragma unroll
                    for (int pi = 0; pi < 3; ++pi) {
                        const int lr = (pi == 0) ? 4 : ((pi == 1) ? 2 : 0); const int r = 1 << lr; const int rho = c & (r - 1);
                        const int mq = tq >> lr; const int mlo = ((c + 16 * i0) >> lr) - 128; const int base = mlo & ~31; const int mhi = (c + 16 * (i0 + 15)) >> lr;
                        const int np = ((mhi - base) >> 5) + 1; const int pr0 = base < 0 ? ((-base) >> 5) : 0;
                        for (int pr = pr0; pr < np; ++pr) {
                            const int mb = base + 32 * pr;
                            bf16x8 kf[2][2];
#pragma unroll
                            for (int tau = 0; tau < 2; ++tau) { int mk = mb + 16 * tau + ql; mk = mk < 0 ? 0 : (mk > mhi ? mhi : mk);
                                const bf16* kp = U + (rowb + (size_t)(mk * r + rho)) * NU + UK + h * 64 + 8 * g4; kf[tau][0] = *(const bf16x8*)kp; kf[tau][1] = *(const bf16x8*)(kp + 32); }
                            { const int vr = lane >> 1, vh = lane & 1; int mv = mb + vr; mv = mv < 0 ? 0 : (mv > mhi ? mhi : mv);
                              const v4u* vp = (const v4u*)(U + (rowb + (size_t)(mv * r + rho)) * NU + UV + h * 64 + 32 * vh);
                              const v4u v0 = vp[0], v1 = vp[1], v2 = vp[2], v3 = vp[3];
                              asm volatile("" ::: "memory");
                              LAS v4u* vd = (LAS v4u*)(vst + vr * 160 + vh * 64); vd[0] = v0; vd[1] = v1; vd[2] = v2; vd[3] = v3; }
                            f32x4 s[2];
#pragma unroll
                            for (int tau = 0; tau < 2; ++tau) { s[tau] = MFMA16(kf[tau][0], qf0, ((f32x4){0.f, 0.f, 0.f, 0.f})); s[tau] = MFMA16(kf[tau][1], qf1, s[tau]); }
                            float tmax = -INFINITY;
#pragma unroll
                            for (int tau = 0; tau < 2; ++tau)
#pragma unroll
                                for (int rg = 0; rg < 4; ++rg) { const int mkv = mb + 16 * tau + 4 * g4 + rg; const int dist = mq - mkv; const bool ok = ((unsigned)dist <= 128u) && (mkv >= 0);
                                    const float bias = blh[ok ? (dist << lr) : 0]; const float v = ok ? s[tau][rg] + bias : -INFINITY; s[tau][rg] = v; tmax = fmaxf(tmax, v); }
                            tmax = fmaxf(tmax, __shfl_xor(tmax, 16)); tmax = fmaxf(tmax, __shfl_xor(tmax, 32));
                            const float mn = fmaxf(m_run, tmax); const float ms = (mn == -INFINITY) ? 0.f : mn; const float alpha = exp2f(m_run - ms); m_run = mn;
                            float ps = 0.f;
#pragma unroll
                            for (int tau = 0; tau < 2; ++tau)
#pragma unroll
                                for (int rg = 0; rg < 4; ++rg) { const float p = exp2f(s[tau][rg] - ms); s[tau][rg] = p; ps += p; }
                            l_run = l_run * alpha + ps;
#pragma unroll
                            for (int d = 0; d < 4; ++d) o[d] = o[d] * alpha;
                            const bf16x8 pb = pack8(s[0], s[1]);
                            asm volatile("" ::: "memory");
#pragma unroll
                            for (int d = 0; d < 4; ++d) { const bf16x8 va = frag_trp(vst, 160, 16 * d, 0, lane); o[d] = MFMA16(va, pb, o[d]); }
                            asm volatile("" ::: "memory");
                        }
                    }
                    l_run += __shfl_xor(l_run, 16); l_run += __shfl_xor(l_run, 32); const float inv = 1.0f / l_run;
                    bf16* op = MIX + (rowb + tq) * D + h * 64 + 4 * g4;
#pragma unroll
                    for (int d = 0; d < 4; ++d) { pg8::u32x2 w; w.x = pg8::cvt_pk_bf16(o[d][0] * inv, o[d][1] * inv); w.y = pg8::cvt_pk_bf16(o[d][2] * inv, o[d][3] * inv); *(pg8::u32x2*)(op + 16 * d) = w; }
                }
            }
        }
        SEAM(pb + 2);
        if (IN(pb + 3)) {
            float* cum = (float*)lds; float* qe = cum + 4096; float* ke = qe + 4096;   float* vv = ke + 4224; float* st = vv + 8192;   float* seg = st + 8320; float* rsq = seg + 512;
            const float* gn = args.gla_g_norm + layer * 128;
            for (int u = bx; u < 1024; u += G) {
                const int h = u & 3, n = (u >> 2) & 31, b = u >> 7; const size_t row0 = (size_t)b * SEQ + n * 64;
                { float c = 0.f;
#pragma unroll
                  for (int i = 0; i < 8; ++i) { const int t = 8 * wave + i; c += bf2f(U[(row0 + t) * NU + ULA + h * 64 + lane]); cum[t * 64 + lane] = c; }
                  seg[wave * 64 + lane] = c; }
                __syncthreads();
                { float off = 0.f;
#pragma unroll
                  for (int w = 0; w < 8; ++w) { const float s = seg[w * 64 + lane]; if (w < wave) off += s; }
#pragma unroll
                  for (int i = 0; i < 8; ++i) { const int t = 8 * wave + i; const float cm = cum[t * 64 + lane] + off;
                      qe[t * 64 + lane] = bf2f(U[(row0 + t) * NU + UGQ + h * 64 + lane]) * __expf(cm);
                      ke[t * 65 + lane] = bf2f(U[(row0 + t) * NU + UGK + h * 64 + lane]) * __expf(-cm); }
                  const int v = tid & 127, sg = tid >> 7;
#pragma unroll
                  for (int i = 0; i < 16; ++i) { const int s = sg + 4 * i; vv[s * 128 + v] = bf2f(U[(row0 + s) * NU + UGV + h * 128 + v]); }
#pragma unroll
                  for (int i = 0; i < 16; ++i) { const int vr = 16 * wave + i; st[vr * 65 + lane] = CST[((size_t)u * 128 + vr) * 64 + lane]; } }
                __syncthreads();
                { float acc[8];
#pragma unroll
                  for (int i = 0; i < 8; ++i) acc[i] = 0.f;
                  for (int k = 0; k < 64; ++k) { const float kv = ke[lane * 65 + k];
#pragma unroll
                      for (int i = 0; i < 8; ++i) acc[i] += qe[(8 * wave + i) * 64 + k] * kv; }
#pragma unroll
                  for (int i = 0; i < 8; ++i) { const int t = 8 * wave + i; cum[t * 64 + lane] = (lane <= t) ? acc[i] : 0.f; } }
                __syncthreads();
                { const int v = tid & 127, tg = tid >> 7; float acc[16];
#pragma unroll
                  for (int i = 0; i < 16; ++i) acc[i] = 0.f;
                  for (int s = 0; s < 64; ++s) { const float x = vv[s * 128 + v];
#pragma unroll
                      for (int i = 0; i < 16; ++i) acc[i] += cum[(16 * tg + i) * 64 + s] * x; }
                  for (int k = 0; k < 64; ++k) { const float x = st[v * 65 + k];
#pragma unroll
                      for (int i = 0; i < 16; ++i) acc[i] += qe[(16 * tg + i) * 64 + k] * x; }
#pragma unroll
                  for (int i = 0; i < 16; ++i) { const float s2 = wave_sum(acc[i] * acc[i]); if (lane == 0) rsq[(16 * tg + i) * 2 + (wave & 1)] = s2; }
                  __syncthreads();
                  const float g = gn[v];
#pragma unroll
                  for (int i = 0; i < 16; ++i) { const int t = 16 * tg + i; const float rs = 1.0f / sqrtf((rsq[t * 2] + rsq[t * 2 + 1]) * (1.0f / 128.0f) + pg8::RMS_EPS);
                      const float gr = bf2f(U[(row0 + t) * NU + UGR + h * 128 + v]);
                      MIX[(row0 + t) * D + 256 + h * 128 + v] = (bf16)f2bf(acc[i] * rs * g * pg8::silu_f(gr)); } }
                __syncthreads();
            }
        }
        SEAM(pb + 3);
        if (IN(pb + 4)) {
            pg8::Gemm g{MIX, (const bf16*)(ws + WS_WOUT) + (size_t)layer * D * D, M, D, D}; pg8::StaticOrder S; S.init(M, D, G, bx);
            pg8::EpiRes E{layer == 0 ? args.x : (const float*)X, X, XB, SS};
            pg8::gemm_phase<pg8::EpiRes, pg8::StaticOrder, true, true>(ldsl, g, S, E);
        }
        SEAM(pb + 4);
        if (layer == 0) {
            if (IN(pb + 5)) {
                pg8::Gemm g{XB, W13, M, 2 * FF, D}; pg8::StaticOrder S; S.init(M, 2 * FF, G, bx);
                pg8::EpiGlu<false> E{H, FF, SS};
                pg8::gemm_phase<pg8::EpiGlu<false>, pg8::StaticOrder, true, true>(ldsl, g, S, E);
            }
            SEAM(pb + 5);
            if (IN(pb + 6)) {
                pg8::Gemm g{H, W2, M, D, FF}; pg8::StaticOrder S; S.init(M, D, G, bx);
                pg8::EpiRes E{X, X, XB, SS};
                pg8::gemm_phase<pg8::EpiRes, pg8::StaticOrder, true, true>(ldsl, g, S, E);
            }
            SEAM(pb + 6);
        } else {
            if (IN(pb + 5)) {
                float* wr_l = (float*)lds;
                int* cnt_l = (int*)(lds + 32768);
                const float* gf = args.g_ffn + D;
                for (int i = tid; i < D * 8; i += NTHR) wr_l[i] = args.moe_router[i] * gf[i >> 3];
                if (tid < 8) cnt_l[tid] = 0;
                __syncthreads();
                for (int blk = bx; blk < 256; blk += G) {
                    if (blk != bx) { __syncthreads(); if (tid < 8) cnt_l[tid] = 0; __syncthreads(); }
                    for (int i = 0; i < 8; ++i) { const int m = blk * 64 + wave * 8 + i;
                        const f32x4* xr = (const f32x4*)(X + (size_t)m * D) + lane; float lg[8];
#pragma unroll
                        for (int e = 0; e < 8; ++e) lg[e] = 0.f;
#pragma unroll
                        for (int j = 0; j < 4; ++j) { const f32x4 v = xr[64 * j]; const int k0 = 4 * (lane + 64 * j);
#pragma unroll
                            for (int q = 0; q < 4; ++q) { const f32x4 w0 = *(const f32x4*)(wr_l + (k0 + q) * 8), w1 = *(const f32x4*)(wr_l + (k0 + q) * 8 + 4);
#pragma unroll
                                for (int e = 0; e < 4; ++e) { lg[e] += v[q] * w0[e]; lg[4 + e] += v[q] * w1[e]; } } }
                        const float rs = pg8::rstd_of(SS + (size_t)m * 16);
#pragma unroll
                        for (int e = 0; e < 8; ++e) lg[e] = wave_sum(lg[e]) * rs;
                        int i0 = 0; float v0 = lg[0];
#pragma unroll
                        for (int e = 1; e < 8; ++e) if (lg[e] > v0) { v0 = lg[e]; i0 = e; }
                        int i1 = -1; float v1 = -INFINITY;
#pragma unroll
                        for (int e = 0; e < 8; ++e) if (e != i0 && lg[e] > v1) { v1 = lg[e]; i1 = e; }
                        const float w1 = 1.0f / (1.0f + __expf(v0 - v1)), w0 = 1.0f - w1;
                        if (lane == 0) { TOPI[m * 2] = i0; TOPI[m * 2 + 1] = i1; TOPW[m * 2] = w0; TOPW[m * 2 + 1] = w1; RS3[m] = rs; atomicAdd(&cnt_l[i0], 1); atomicAdd(&cnt_l[i1], 1); } }
                    __syncthreads();
                    if (tid < 8) CNT[blk * 8 + tid] = cnt_l[tid];
                }
            }
            SEAM(pb + 5);
            if (IN(pb + 6)) {
                int* base_l = (int*)lds;
                int* pre_l = base_l + 8;
                int* tot_l = pre_l + 8;
                int* pos_l = tot_l + 8;
                int* ent_l = pos_l + 128;
                for (int blk = bx; blk < 256; blk += G) {
                    __syncthreads();
                    if (tid < 8) { tot_l[tid] = 0; pre_l[tid] = 0; }
                    if (tid < 128) ent_l[tid] = TOPI[blk * 128 + tid];
                    __syncthreads();
                    { const int g2 = tid >> 1, e0 = (tid & 1) * 4; const int4 c = *(const int4*)(CNT + g2 * 8 + e0);
                      atomicAdd(&tot_l[e0], c.x); atomicAdd(&tot_l[e0 + 1], c.y); atomicAdd(&tot_l[e0 + 2], c.z); atomicAdd(&tot_l[e0 + 3], c.w);
                      if (g2 < blk) { atomicAdd(&pre_l[e0], c.x); atomicAdd(&pre_l[e0 + 1], c.y); atomicAdd(&pre_l[e0 + 2], c.z); atomicAdd(&pre_l[e0 + 3], c.w); } }
                    __syncthreads();
                    if (tid == 0) { int bs = 0; for (int e = 0; e < 8; ++e) { base_l[e] = bs; bs += (tot_l[e] + 255) & ~255; } }
                    __syncthreads();
                    if (tid < 128) { const int e = ent_l[tid]; int rank = 0; for (int j = 0; j < tid; ++j) rank += (ent_l[j] == e) ? 1 : 0;
                        const int p = base_l[e] + pre_l[e] + rank; pos_l[tid] = p; POS[blk * 128 + tid] = p; ROWGATE[p] = TOPW[blk * 128 + tid]; ROWRS[p] = RS3[blk * 64 + (tid >> 1)]; }
                    if (blk == 0) {
                        for (int e = 0; e < 8; ++e) { const int npe = (tot_l[e] + 255) >> 8; for (int p = base_l[e] + tot_l[e] + tid; p < base_l[e] + npe * 256; p += NTHR) { ROWGATE[p] = 0.f; ROWRS[p] = 0.f; } }
                        if (tid == 0) { int np = 0; for (int e = 0; e < 8; ++e) { const int npe = (tot_l[e] + 255) >> 8; for (int j = 0; j < npe; ++j) PANE[np++] = e; } PANE[MAXPAN] = np; } }
                    __syncthreads();
                    for (int i = 0; i < 16; ++i) { const int sl = wave * 16 + i; const int m = blk * 64 + (sl >> 1); const int p = pos_l[sl];
                        const v4u* s = (const v4u*)(XB + (size_t)m * D) + lane; v4u* d = (v4u*)(XS + (size_t)p * D) + lane; d[0] = s[0]; d[64] = s[64]; }
                }
            }
            SEAM(pb + 6);
            if (IN(pb + 7)) {
                pg8::Gemm g{XS, WE13, MAXROWS, 2 * FE, D}; pg8::MoeOrder S{PANE, PANE[MAXPAN], 28, G, bx};
                pg8::EpiGlu<true> E{HE, FE, ROWRS};
                pg8::gemm_phase<pg8::EpiGlu<true>, pg8::MoeOrder, true, true>(ldsl, g, S, E);
            }
            SEAM(pb + 7);
            if (IN(pb + 8)) {
                unsigned* scr = (unsigned*)(lds + wave * 8704);
                constexpr int T_J = 56 * 16;
                for (int it = gw; it < 8 * T_J; it += NGW) { const int e = it / T_J, r = it % T_J;
                    transpose_tile(args.moe_w2 + (size_t)e * FE * D, D, 64 * (r / 16), 64 * (r % 16), WE2 + (size_t)e * D * FE, FE, 64 * (r % 16), nullptr, scr, lane); }
            }
            SEAM(pb + 8);
            if (IN(pb + 9)) {
                pg8::Gemm g{HE, WE2, MAXROWS, D, FE}; pg8::MoeOrder S{PANE, PANE[MAXPAN], 4, G, bx};
                pg8::EpiMoeDown E{Y, ROWGATE};
                pg8::gemm_phase<pg8::EpiMoeDown, pg8::MoeOrder, true, true>(ldsl, g, S, E);
            }
            SEAM(pb + 9);
            if (IN(pb + 10)) {
                for (int m = gw; m < M; m += NGW) {
                    f32x4* xr = (f32x4*)(X + (size_t)m * D) + lane; const int p0 = POS[m * 2], p1 = POS[m * 2 + 1];
                    const unsigned long long* y0 = (const unsigned long long*)(Y + (size_t)p0 * D) + lane; const unsigned long long* y1 = (const unsigned long long*)(Y + (size_t)p1 * D) + lane;
                    f32x4 v[4]; float s = 0.f;
#pragma unroll
                    for (int j = 0; j < 4; ++j) { v[j] = xr[64 * j]; const unsigned long long a = y0[64 * j], c = y1[64 * j];
                        v[j][0] += bflo((unsigned)a) + bflo((unsigned)c); v[j][1] += bfhi((unsigned)a) + bfhi((unsigned)c);
                        v[j][2] += bflo((unsigned)(a >> 32)) + bflo((unsigned)(c >> 32)); v[j][3] += bfhi((unsigned)(a >> 32)) + bfhi((unsigned)(c >> 32));
                        s += (v[j][0] * v[j][0] + v[j][1] * v[j][1]) + (v[j][2] * v[j][2] + v[j][3] * v[j][3]); }
                    const float rs = 1.0f / sqrtf(wave_sum(s) * (1.0f / D) + pg8::RMS_EPS);
                    const f32x4* gf = (const f32x4*)args.g_final + lane;
#pragma unroll
                    for (int j = 0; j < 4; ++j) xr[64 * j] = v[j] * rs * gf[64 * j];
                }
            }
        }
}

__global__ void __launch_bounds__(NTHR, 2) hybrid_fwd(Args args) {
    extern __shared__ __attribute__((aligned(16))) unsigned char lds[];
    LAS unsigned char* ldsl = (LAS unsigned char*)lds;
    volatile LAS unsigned* MISC = (volatile LAS unsigned*)(ldsl + MISC_OFF);
    const int tid = threadIdx.x, lane = tid & 63, wave = __builtin_amdgcn_readfirstlane(tid >> 6);
    const int G = gridDim.x; const int bx = blockIdx.x;
    const int gw = bx * NWAVES + wave, NGW = G * NWAVES;
    unsigned char* ws = args.ws;
    for (int u = tid; u < (LDS_BYTES - LDSCTL_OFF) / 4; u += NTHR) ((LAS unsigned*)(ldsl + LDSCTL_OFF))[u] = 0u;
    __syncthreads();
    XcdBarrier bar; bar.bar = (unsigned*)(ws + WS_CTL) + CW_BAR; bar.x = 0; bar.st = nullptr;
    if (MK_N_LAUNCHES == 1) bar = xcd_barrier_post((unsigned*)(ws + WS_CTL) + CW_BAR, MISC + 8);
    const int lo = args.ph_lo, hi = args.ph_hi;

    WS_PTRS

    if (IN(0)) {
        unsigned* scr = (unsigned*)(lds + wave * 8704);
        constexpr int T_A = 16 * 36, T_B = 16 * 12, T_C = 16 * 4, T_D = 16 * 16, T_L = T_A + T_B + T_C + T_D;
        constexpr int T_F = 16 * 44, T_G = 44 * 16, T_E = 16 * 56;
        constexpr int NT0 = 2 * T_L + 2 * T_F + T_G + 16 * T_E;
        for (int it = gw; it < NT0; it += NGW) {
            int r = it;
            if (r < 2 * T_L) { const int l = r / T_L; r -= l * T_L; const float* win = args.w_mix_in + (size_t)l * D * INC; const float* gm = args.g_mix + l * D;
                bf16* WIN = (bf16*)(ws + WS_WIN) + (size_t)l * NU * D;
                if (r < T_A) { transpose_tile(win, INC, 64 * (r / 36), 64 * (r % 36), WIN, D, 64 * (r % 36), gm, scr, lane); continue; } r -= T_A;
                if (r < T_B) { transpose_tile(win, INC, 64 * (r / 12), 2320 + 64 * (r % 12), WIN, D, 2304 + 64 * (r % 12), gm, scr, lane); continue; } r -= T_B;
                if (r < T_C) { glr_tile(win, args.gla_w_gate + l * 16 * 256, gm, 64 * (r / 4), 64 * (r % 4), WIN, 3072, lane); continue; } r -= T_C;
                transpose_tile(args.w_mix_out + (size_t)l * D * D, D, 64 * (r / 16), 64 * (r % 16), (bf16*)(ws + WS_WOUT) + (size_t)l * D * D, D, 64 * (r % 16), nullptr, scr, lane); continue; }
            r -= 2 * T_L;
            if (r < 2 * T_F) { const int w3 = r / T_F; r -= w3 * T_F; const int n0 = 64 * (r % 44);
                transpose_tile(w3 ? args.ffn_w3 : args.ffn_w1, FF, 64 * (r / 44), n0, W13, D, (n0 >> 7) * 256 + (n0 & 127) + 128 * w3, args.g_ffn, scr, lane); continue; }
            r -= 2 * T_F;
            if (r < T_G) { transpose_tile(args.ffn_w2, D, 64 * (r / 16), 64 * (r % 16), W2, FF, 64 * (r % 16), nullptr, scr, lane); continue; }
            r -= T_G;
            { const int ew = r / T_E; r -= ew * T_E; const int e = ew >> 1, w3 = ew & 1; const int n0 = 64 * (r % 56);
              transpose_tile((w3 ? args.moe_w3 : args.moe_w1) + (size_t)e * D * FE, FE, 64 * (r / 56), n0, WE13 + (size_t)e * 2 * FE * D, D, (n0 >> 7) * 256 + (n0 & 127) + 128 * w3, args.g_ffn + D, scr, lane); }
        }
        for (int m = gw; m < M; m += NGW) {
            const f32x4* xr = (const f32x4*)(args.x + (size_t)m * D) + lane; float s = 0.f;
            unsigned long long* o8 = (unsigned long long*)(XB + (size_t)m * D) + lane;
#pragma unroll
            for (int j = 0; j < 4; ++j) { const f32x4 v = xr[64 * j]; s += (v[0] * v[0] + v[1] * v[1]) + (v[2] * v[2] + v[3] * v[3]);
                o8[64 * j] = (unsigned long long)pk2(v[0], v[1]) | ((unsigned long long)pk2(v[2], v[3]) << 32); }
            s = wave_sum(s);
            if (lane < 16) SS[(size_t)m * 16 + lane] = (lane == 0) ? s : 0.f;
        }
        for (int i = bx * NTHR + tid; i < 2049 * 4; i += G * NTHR) { const int d = i >> 2, h = i & 3; BL[i] = args.rel_bias[rel_bucket(d) * 4 + h] * LOG2E; }
    }
    SEAM(0);

    Ctx c; c.args = args; c.tid = tid; c.lane = lane; c.wave = wave; c.G = G; c.bx = bx; c.gw = gw; c.NGW = NGW; c.lo = lo; c.hi = hi; c.bar = bar;
    layer_phases<0>(c, lds);
    layer_phases<1>(c, lds);
}
#undef IN
#undef SEAM
#undef GRID_BAR


extern "C" void kernel_launch(void* const* d_in, const int* in_sizes, int n_in, void* d_out, int out_size, void* d_ws, size_t ws_size, hipStream_t stream) {
    static int grid = 0;
    if (grid == 0) {
        if (n_in != 18 || in_sizes[0] != M * D || out_size != M * D || ws_size < WS_END) { fprintf(stderr, "kernel_launch: unexpected shapes / workspace (%zu < %zu)\n", ws_size, (size_t)WS_END); grid = -1; return; }
        int dev = 0, cus = 0, per_cu = 0;
        if (hipGetDevice(&dev) != hipSuccess || hipDeviceGetAttribute(&cus, hipDeviceAttributeMultiprocessorCount, dev) != hipSuccess) { grid = -1; return; }
        if (hipFuncSetAttribute((const void*)hybrid_fwd, hipFuncAttributeMaxDynamicSharedMemorySize, LDS_BYTES) != hipSuccess) { fprintf(stderr, "kernel_launch: hipFuncSetAttribute failed\n"); grid = -1; return; }
        if (hipOccupancyMaxActiveBlocksPerMultiprocessor(&per_cu, (const void*)hybrid_fwd, NTHR, LDS_BYTES) != hipSuccess || per_cu < 1) { fprintf(stderr, "kernel_launch: occupancy query says %d\n", per_cu); }
        (void)hipGetLastError();
        grid = cus;
    }
    if (grid < 0) return;
    if (hipMemsetAsync((char*)d_ws + WS_CTL, 0, CTL_ZERO_BYTES, stream) != hipSuccess) return;
    Args a{};
    const float** f = (const float**)&a;
    for (int i = 0; i < 18; ++i) f[i] = (const float*)d_in[i];
    a.out = (float*)d_out; a.ws = (unsigned char*)d_ws;
    if (MK_N_LAUNCHES == 1) { a.ph_lo = 0; a.ph_hi = 64; hipLaunchKernelGGL(hybrid_fwd, dim3(grid), dim3(NTHR), LDS_BYTES, stream, a); }
    else {
        static const int phases[] = {0, 1, 2, 3, 4, 5, 6, 7, 17, 18, 19, 20, 21, 22, 23, 24, 25, 26, 27};
        for (int p : phases) { a.ph_lo = p; a.ph_hi = p + 1; hipLaunchKernelGGL(hybrid_fwd, dim3(grid), dim3(NTHR), LDS_BYTES, stream, a); }
    }
}
```

```cpp
#include <hip/hip_runtime.h>
#include <cstdio>
#include <cstdint>

#ifndef MK_N_LAUNCHES
#define MK_N_LAUNCHES 1
#endif

namespace pg8 {
#define PG8_LAS __attribute__((address_space(3)))
typedef unsigned short bf16_t;
typedef short bf16x8 __attribute__((ext_vector_type(8)));
typedef float f32x4 __attribute__((ext_vector_type(4)));
typedef unsigned u32x4 __attribute__((ext_vector_type(4)));
typedef unsigned u32x2 __attribute__((ext_vector_type(2)));
constexpr int BM = 256, BK = 64, HALF = 128, HTB = HALF * BK * 2, STAGE_BYTES = 8 * HTB, NXCD = 8, WGM = 8;

__host__ __device__ __forceinline__ int lds_byte(int r, int c) { const int st = (r >> 4) * 2 + (c >> 5), rr = r & 15, cc = c & 31, ob = rr * 64 + cc * 2; return st * 1024 + (ob ^ (((ob >> 9) & 1) << 5)); }
__host__ __device__ __forceinline__ void stage_rc(int b, int& R, int& C) { const int st = b / 1024, sb = b % 1024, swz = sb ^ (((sb >> 9) & 1) << 5); R = (st >> 1) * 16 + swz / 64; C = (st & 1) * 32 + (swz % 64) / 2; }
__host__ __device__ __forceinline__ int perm32(int rho) { const int n = rho >> 4, i = rho & 15; return 8 * (i >> 2) + 4 * n + (i & 3); }

struct Unit { int pm, pn; };
struct Gemm { const bf16_t* A; const bf16_t* Bt; int M, N, K; };

struct StaticOrder {
    int nM, nN, nwg, G, c;
    __host__ __device__ void init(int M, int N, int G_, int c_) { nM = M / BM; nN = N / BM; nwg = nM * nN; G = G_; c = c_; }
    __host__ __device__ bool next(int i, Unit& u) const {
        const long L = (long)i * G + c; if (L >= nwg) return false;
        int wgid = (int)L; { const int q = nwg / NXCD, r = nwg % NXCD, xcd = wgid % NXCD, off = wgid / NXCD; wgid = (xcd < r ? xcd * (q + 1) : r * (q + 1) + (xcd - r) * q) + off; }
        const int nig = WGM * nN, gid = wgid / nig, fm = gid * WGM, gsz = (nM - fm) < WGM ? (nM - fm) : WGM;
        u.pm = fm + ((wgid % nig) % gsz); u.pn = (wgid % nig) / gsz; return true;
    }
    __device__ __forceinline__ void a_ready(const Unit&) const {}
    __device__ __forceinline__ void done(const Unit&) const {}
};
struct MoeOrder {
    const int* panel_e; int npan, NT, G, c;
    __device__ bool next(int i, Unit& u) const {
        const long L = (long)i * G + c; if (L >= (long)npan * NT) return false;
        const int p = (int)(L / NT); u.pm = p; u.pn = panel_e[p] * NT + (int)(L % NT); return true;
    }
    __device__ __forceinline__ void a_ready(const Unit&) const {}
    __device__ __forceinline__ void done(const Unit&) const {}
};

__device__ __forceinline__ unsigned cvt_pk_bf16(float lo, float hi) { unsigned r; asm volatile("v_cvt_pk_bf16_f32 %0, %1, %2" : "=v"(r) : "v"(lo), "v"(hi)); return r; }

constexpr float RMS_EPS = 1e-6f;
__device__ __forceinline__ float rstd_of(const float* ss16) {
    const f32x4 a = *(const f32x4*)ss16, b = *(const f32x4*)(ss16 + 4), c = *(const f32x4*)(ss16 + 8), d = *(const f32x4*)(ss16 + 12);
    const float s = ((a[0] + a[1]) + (a[2] + a[3])) + ((b[0] + b[1]) + (b[2] + b[3])) + ((c[0] + c[1]) + (c[2] + c[3])) + ((d[0] + d[1]) + (d[2] + d[3]));
    return 1.0f / sqrtf(s * (1.0f / 1024.0f) + RMS_EPS);
}
__device__ __forceinline__ float logsig16(float x) { return ((x < 0.f ? x : 0.f) - log1pf(__expf(-fabsf(x)))) * (1.0f / 16.0f); }
__device__ __forceinline__ float silu_f(float a) { return a / (1.0f + __expf(-a)); }

struct EpiU {
    static constexpr bool PERM = true, AFTER_DRAIN = false;
    bf16_t* U; int ldu; const float* SS; const float* bgate; float qs;
    __device__ __forceinline__ void operator()(const f32x4 (&acc)[2][2][4][2], const Unit& u, int wr, int wc, int fr, int fq) const {
        const int row0 = u.pm * BM + wr * 64 + fr, cl = wc * 32 + 8 * fq, col0 = u.pn * BM + cl;
        const float sc = (u.pn == 0) ? qs : ((u.pn == 3) ? 0.125f : 1.0f);
        const bool la = (u.pn == 12);
        f32x4 bv[2][2];
#pragma unroll
        for (int bj = 0; bj < 2; ++bj)
#pragma unroll
            for (int n = 0; n < 2; ++n) bv[bj][n] = la ? *(const f32x4*)(bgate + cl + bj * HALF + 4 * n) : (f32x4){0.f, 0.f, 0.f, 0.f};
#pragma unroll
        for (int ai = 0; ai < 2; ++ai)
#pragma unroll
            for (int m = 0; m < 4; ++m) { const int row = row0 + ai * HALF + m * 16; const float rs = rstd_of(SS + (size_t)row * 16) * sc;
                bf16_t* rowp = U + (size_t)row * ldu + col0;
#pragma unroll
                for (int bj = 0; bj < 2; ++bj) { f32x4 v0 = acc[ai][bj][m][0] * rs, v1 = acc[ai][bj][m][1] * rs;
                    if (la) {
#pragma unroll
                        for (int j = 0; j < 4; ++j) { v0[j] = logsig16(v0[j] + bv[bj][0][j]); v1[j] = logsig16(v1[j] + bv[bj][1][j]); } }
                    u32x4 w; w.x = cvt_pk_bf16(v0[0], v0[1]); w.y = cvt_pk_bf16(v0[2], v0[3]); w.z = cvt_pk_bf16(v1[0], v1[1]); w.w = cvt_pk_bf16(v1[2], v1[3]);
                    *(u32x4*)(rowp + bj * HALF) = w; } }
    }
};
struct EpiRes {
    static constexpr bool PERM = false, AFTER_DRAIN = false;
    const float* Xin; float* Xout; bf16_t* XB; float* SS;
    __device__ __forceinline__ void operator()(const f32x4 (&acc)[2][2][4][2], const Unit& u, int wr, int wc, int fr, int fq) const {
        const int row0 = u.pm * BM + wr * 64 + fr, col0 = u.pn * BM + wc * 32 + 4 * fq;
#pragma unroll
        for (int ai = 0; ai < 2; ++ai)
#pragma unroll
            for (int m = 0; m < 4; ++m) { const int row = row0 + ai * HALF + m * 16; const size_t off = (size_t)row * 1024 + col0; float ssum = 0.f;
#pragma unroll
                for (int bj = 0; bj < 2; ++bj)
#pragma unroll
                    for (int n = 0; n < 2; ++n) { const f32x4 xo = *(const f32x4*)(Xin + off + bj * HALF + n * 16); const f32x4 v = xo + acc[ai][bj][m][n];
                        *(f32x4*)(Xout + off + bj * HALF + n * 16) = v; u32x2 w; w.x = cvt_pk_bf16(v[0], v[1]); w.y = cvt_pk_bf16(v[2], v[3]);
                        *(u32x2*)(XB + off + bj * HALF + n * 16) = w; ssum += (v[0] * v[0] + v[1] * v[1]) + (v[2] * v[2] + v[3] * v[3]); }
                ssum += __shfl_xor(ssum, 16); ssum += __shfl_xor(ssum, 32);
                if (fq == 0) SS[(size_t)row * 16 + u.pn * 4 + wc] = ssum;
                asm volatile("" ::: "memory"); }
    }
};
template <bool MOE> struct EpiGlu {
    static constexpr bool PERM = true, AFTER_DRAIN = false;
    bf16_t* O; int ldo; const float* SS;
    __device__ __forceinline__ void operator()(const f32x4 (&acc)[2][2][4][2], const Unit& u, int wr, int wc, int fr, int fq) const {
        const int row0 = u.pm * BM + wr * 64 + fr; const int pnl = MOE ? (u.pn % 28) : u.pn; const int col0 = pnl * HALF + wc * 32 + 8 * fq;
#pragma unroll
        for (int ai = 0; ai < 2; ++ai)
#pragma unroll
            for (int m = 0; m < 4; ++m) { const int row = row0 + ai * HALF + m * 16; const float rs = MOE ? SS[row] : rstd_of(SS + (size_t)row * 16);
                const f32x4 a0 = acc[ai][0][m][0] * rs, a1 = acc[ai][0][m][1] * rs, b0 = acc[ai][1][m][0] * rs, b1 = acc[ai][1][m][1] * rs;
                f32x4 g0, g1;
#pragma unroll
                for (int j = 0; j < 4; ++j) { g0[j] = silu_f(a0[j]) * b0[j]; g1[j] = silu_f(a1[j]) * b1[j]; }
                u32x4 w; w.x = cvt_pk_bf16(g0[0], g0[1]); w.y = cvt_pk_bf16(g0[2], g0[3]); w.z = cvt_pk_bf16(g1[0], g1[1]); w.w = cvt_pk_bf16(g1[2], g1[3]);
                *(u32x4*)(O + (size_t)row * ldo + col0) = w; }
    }
};
struct EpiMoeDown {
    static constexpr bool PERM = true, AFTER_DRAIN = false;
    bf16_t* Y; const float* gate;
    __device__ __forceinline__ void operator()(const f32x4 (&acc)[2][2][4][2], const Unit& u, int wr, int wc, int fr, int fq) const {
        const int row0 = u.pm * BM + wr * 64 + fr, col0 = (u.pn & 3) * BM + wc * 32 + 8 * fq;
#pragma unroll
        for (int ai = 0; ai < 2; ++ai)
#pragma unroll
            for (int m = 0; m < 4; ++m) { const int row = row0 + ai * HALF + m * 16; const float g = gate[row]; bf16_t* rowp = Y + (size_t)row * 1024 + col0;
#pragma unroll
                for (int bj = 0; bj < 2; ++bj) { const f32x4 v0 = acc[ai][bj][m][0] * g, v1 = acc[ai][bj][m][1] * g;
                    u32x4 w; w.x = cvt_pk_bf16(v0[0], v0[1]); w.y = cvt_pk_bf16(v0[2], v0[3]); w.z = cvt_pk_bf16(v1[0], v1[1]); w.w = cvt_pk_bf16(v1[2], v1[3]);
                    *(u32x4*)(rowp + bj * HALF) = w; } }
    }
};

template <class Epi, class Sched, bool ALIGN_EPI = false, bool SP2 = false>
__device__ __forceinline__ void gemm_phase(PG8_LAS unsigned char* lds, const Gemm g, const Sched& S, const Epi& E) {
    const int tid = threadIdx.x, wid = __builtin_amdgcn_readfirstlane(tid >> 6), lane = tid & 63, wr = wid >> 2, wc = wid & 3, fr = lane & 15, fq = lane >> 4;
    const int K = g.K, nt = K / BK;
    unsigned voffA[2], voffB[2];
#pragma unroll
    for (int i = 0; i < 2; ++i) { int R, C; stage_rc(tid * 16 + i * 8192, R, C); const int Rb = Epi::PERM ? ((R & ~31) + perm32(R & 31)) : R;
        voffA[i] = (unsigned)(R * K + C) * 2u; voffB[i] = (unsigned)(Rb * K + C) * 2u; }
    const size_t kstep = (size_t)(BK * 2);
    const size_t hstep = (size_t)HALF * K * 2;
    const size_t tstep = 2 * hstep;
    const unsigned ldsw = (unsigned)wid * 1024u;
    const int aoff = lds_byte(wr * 64 + fr, fq * 8), boff = lds_byte(wc * 32 + fr, fq * 8);
#define PG8_SA(b, h) (((b) * 2 + (h)) * HTB)
#define PG8_SB(b, h) ((4 + (b) * 2 + (h)) * HTB)
#define PG8_STAGE(bufoff, gbase, voff) do { _Pragma("unroll") for (int _i = 0; _i < 2; ++_i) \
        __builtin_amdgcn_global_load_lds((const unsigned*)((const char*)(gbase) + (voff)[_i]), (PG8_LAS unsigned*)(lds + (bufoff) + ldsw + _i * 8192), 16, 0, 0); } while (0)
#define PG8_LDA(dst, b, h) do { _Pragma("unroll") for (int m = 0; m < 4; ++m) _Pragma("unroll") for (int k = 0; k < 2; ++k) dst[m][k] = *(const PG8_LAS bf16x8*)(lds + PG8_SA(b, h) + aoff + m * 2048 + k * 1024); } while (0)
#define PG8_LDB(dst, b, h) do { _Pragma("unroll") for (int n = 0; n < 2; ++n) _Pragma("unroll") for (int k = 0; k < 2; ++k) dst[n][k] = *(const PG8_LAS bf16x8*)(lds + PG8_SB(b, h) + boff + n * 2048 + k * 1024); } while (0)
#define PG8_MMA(ai, bj, At, Bt) do { __builtin_amdgcn_s_setprio(1); _Pragma("unroll") for (int m = 0; m < 4; ++m) _Pragma("unroll") for (int n = 0; n < 2; ++n) _Pragma("unroll") for (int k = 0; k < 2; ++k) \
        acc[ai][bj][m][n] = __builtin_amdgcn_mfma_f32_16x16x32_bf16(Bt[n][k], At[m][k], acc[ai][bj][m][n], 0, 0, 0); __builtin_amdgcn_s_setprio(0); } while (0)
#define PG8_WAIT_V(n) asm volatile("s_waitcnt vmcnt(" #n ")" ::: "memory")
#define PG8_WAIT_L(n) asm volatile("s_waitcnt lgkmcnt(" #n ")" ::: "memory")
#define PG8_BAR __builtin_amdgcn_s_barrier()
#define PG8_SCHED __builtin_amdgcn_sched_barrier(0)
    Unit cur, nxt; int ui = 0;
    if (!S.next(0, cur)) return;
    f32x4 acc[2][2][4][2];
#pragma unroll
    for (int a = 0; a < 2; ++a)
#pragma unroll
        for (int b = 0; b < 2; ++b)
#pragma unroll
            for (int m = 0; m < 4; ++m)
#pragma unroll
                for (int n = 0; n < 2; ++n) acc[a][b][m][n] = (f32x4){0.f, 0.f, 0.f, 0.f};
    bf16x8 At[4][2], B0[2][2], B1[2][2];
    const char* cA = (const char*)g.A + (size_t)cur.pm * tstep; const char* cB = (const char*)g.Bt + (size_t)cur.pn * tstep;
    S.a_ready(cur);
    if constexpr (SP2) {
        PG8_STAGE(PG8_SB(0, 0), cB, voffB); PG8_STAGE(PG8_SB(0, 1), cB + hstep, voffB); PG8_STAGE(PG8_SA(0, 0), cA, voffA); PG8_STAGE(PG8_SA(0, 1), cA + hstep, voffA);
        if (wr == 1) PG8_BAR;
        PG8_WAIT_V(2); PG8_BAR;
        PG8_STAGE(PG8_SB(1, 0), cB + kstep, voffB); PG8_STAGE(PG8_SA(1, 0), cA + kstep, voffA); PG8_STAGE(PG8_SB(1, 1), cB + hstep + kstep, voffB);
        PG8_WAIT_V(6); PG8_BAR;
    } else {
        PG8_STAGE(PG8_SB(0, 0), cB, voffB); PG8_STAGE(PG8_SA(0, 0), cA, voffA); PG8_STAGE(PG8_SB(0, 1), cB + hstep, voffB); PG8_STAGE(PG8_SA(0, 1), cA + hstep, voffA);
        if (wr == 1) PG8_BAR;
        PG8_WAIT_V(4); PG8_BAR;
        PG8_STAGE(PG8_SB(1, 0), cB + kstep, voffB); PG8_STAGE(PG8_SA(1, 0), cA + kstep, voffA); PG8_STAGE(PG8_SB(1, 1), cB + hstep + kstep, voffB);
        PG8_WAIT_V(6); PG8_BAR;
    }
    for (;;) {
        const bool has_next = S.next(ui + 1, nxt);
        const char* nA = has_next ? (const char*)g.A + (size_t)nxt.pm * tstep : cA; const char* nB = has_next ? (const char*)g.Bt + (size_t)nxt.pn * tstep : cB;
        for (int t = 0; t < nt; t += 2) {
            const bool last = (t == nt - 2);
            const char* a1 = cA + (size_t)(t + 1) * kstep;
            const char* a2 = last ? nA : cA + (size_t)(t + 2) * kstep; const char* b2 = last ? nB : cB + (size_t)(t + 2) * kstep;
            const char* a3 = a2 + kstep; const char* b3 = b2 + kstep;
            if (last && has_next) S.a_ready(nxt);
            if constexpr (SP2) {
            PG8_LDB(B0, 0, 0); PG8_LDB(B1, 0, 1); PG8_SCHED; PG8_LDA(At, 0, 0); PG8_STAGE(PG8_SA(1, 1), a1 + hstep, voffA);
            PG8_WAIT_V(8); PG8_WAIT_L(0); PG8_BAR; PG8_MMA(0, 0, At, B0); PG8_MMA(0, 1, At, B1); PG8_BAR; PG8_SCHED;
            PG8_LDA(At, 0, 1); PG8_STAGE(PG8_SB(0, 0), b2, voffB); PG8_STAGE(PG8_SB(0, 1), b2 + hstep, voffB); PG8_STAGE(PG8_SA(0, 0), a2, voffA);
            PG8_WAIT_V(8); PG8_WAIT_L(0); PG8_BAR; PG8_MMA(1, 0, At, B0); PG8_MMA(1, 1, At, B1); PG8_BAR; PG8_SCHED;
            PG8_LDB(B0, 1, 0); PG8_LDB(B1, 1, 1); PG8_SCHED; PG8_LDA(At, 1, 0); PG8_STAGE(PG8_SA(0, 1), a2 + hstep, voffA);
            PG8_WAIT_V(8); PG8_WAIT_L(0); PG8_BAR; PG8_MMA(0, 0, At, B0); PG8_MMA(0, 1, At, B1); PG8_BAR; PG8_SCHED;
            PG8_LDA(At, 1, 1); PG8_STAGE(PG8_SB(1, 0), b3, voffB); PG8_STAGE(PG8_SB(1, 1), b3 + hstep, voffB); PG8_STAGE(PG8_SA(1, 0), a3, voffA);
            PG8_WAIT_V(8); PG8_WAIT_L(0); PG8_BAR; PG8_MMA(1, 0, At, B0); PG8_MMA(1, 1, At, B1); PG8_BAR; PG8_SCHED;
            } else {
            PG8_LDB(B0, 0, 0); PG8_SCHED; PG8_LDA(At, 0, 0); PG8_STAGE(PG8_SA(1, 1), a1 + hstep, voffA);
            PG8_WAIT_L(8); PG8_BAR; PG8_WAIT_L(0); PG8_MMA(0, 0, At, B0); PG8_BAR; PG8_SCHED;
            PG8_LDB(B1, 0, 1); PG8_STAGE(PG8_SB(0, 0), b2, voffB);
            PG8_BAR; PG8_WAIT_L(0); PG8_MMA(0, 1, At, B1); PG8_BAR;
            PG8_LDA(At, 0, 1); PG8_STAGE(PG8_SA(0, 0), a2, voffA);
            PG8_BAR; PG8_WAIT_L(0); PG8_MMA(1, 0, At, B0); PG8_BAR; PG8_SCHED;
            PG8_STAGE(PG8_SB(0, 1), b2 + hstep, voffB);
            PG8_WAIT_V(6); PG8_BAR; PG8_MMA(1, 1, At, B1); PG8_BAR;
            PG8_LDB(B0, 1, 0); PG8_SCHED; PG8_LDA(At, 1, 0); PG8_STAGE(PG8_SA(0, 1), a2 + hstep, voffA);
            PG8_WAIT_L(8); PG8_BAR; PG8_WAIT_L(0); PG8_MMA(0, 0, At, B0); PG8_BAR; PG8_SCHED;
            PG8_LDB(B1, 1, 1); PG8_STAGE(PG8_SB(1, 0), b3, voffB);
            PG8_BAR; PG8_WAIT_L(0); PG8_MMA(0, 1, At, B1); PG8_BAR;
            PG8_LDA(At, 1, 1); PG8_STAGE(PG8_SA(1, 0), a3, voffA);
            PG8_BAR; PG8_WAIT_L(0); PG8_MMA(1, 0, At, B0); PG8_BAR; PG8_SCHED;
            PG8_STAGE(PG8_SB(1, 1), b3 + hstep, voffB);
            PG8_WAIT_V(6); PG8_BAR; PG8_MMA(1, 1, At, B1); PG8_BAR;
            }
        }
        if constexpr (ALIGN_EPI) { if (wr == 0) PG8_BAR; }
        if constexpr (!Epi::AFTER_DRAIN) { E(acc, cur, wr, wc, fr, fq); S.done(cur); }
        if (!has_next) break;
#pragma unroll
        for (int a = 0; a < 2; ++a)
#pragma unroll
            for (int b = 0; b < 2; ++b)
#pragma unroll
                for (int m = 0; m < 4; ++m)
#pragma unroll
                    for (int n = 0; n < 2; ++n) acc[a][b][m][n] = (f32x4){0.f, 0.f, 0.f, 0.f};
        cur = nxt; cA = nA; cB = nB; ++ui;
        if constexpr (ALIGN_EPI) { if (wr == 1) PG8_BAR; }
    }
    PG8_WAIT_V(0);
    if constexpr (!ALIGN_EPI) { if (wr == 0) PG8_BAR; }
    PG8_BAR;
#undef PG8_SA
#undef PG8_SB
#undef PG8_STAGE
#undef PG8_LDA
#undef PG8_LDB
#undef PG8_MMA
#undef PG8_WAIT_V
#undef PG8_WAIT_L
#undef PG8_BAR
#undef PG8_SCHED
}
}

constexpr int NWAVES = 8, NTHR = NWAVES * 64;
constexpr int NB = 8, SEQ = 2048, D = 1024, M = NB * SEQ;
constexpr int INC = 3088;
constexpr int NU = 3328;
constexpr int UQ = 0, UK = 256, UV = 512, UGQ = 768, UGK = 1024, UGV = 1280, UGR = 1792, UCI = 2304, UCB = 2560, UCC = 2816, ULA = 3072;
constexpr int FF = 2816, FE = 3584, NE = 8;
constexpr int MAXPAN = 136, MAXROWS = MAXPAN * 256;
constexpr float LOG2E = 1.4426950408889634f;
constexpr float QS_ATT = 0.125f * LOG2E;

constexpr size_t MiB = 1u << 20;
constexpr size_t WS_CTL = 0, CTL_ZERO_BYTES = 1 * MiB;
constexpr size_t WS_SS = 1 * MiB;
constexpr size_t WS_BL = 2 * MiB;
constexpr size_t WS_DEC = 2 * MiB + 64 * 1024;
constexpr size_t WS_TOPI = 3 * MiB;
constexpr size_t WS_TOPW = 3 * MiB + 128 * 1024;
constexpr size_t WS_POS = 3 * MiB + 256 * 1024;
constexpr size_t WS_RS3 = 3 * MiB + 384 * 1024;
constexpr size_t WS_CNT = 3 * MiB + 448 * 1024;
constexpr size_t WS_PANE = 3 * MiB + 456 * 1024;
constexpr size_t WS_ROWGATE = 4 * MiB;
constexpr size_t WS_ROWRS = 4 * MiB + 256 * 1024;
constexpr size_t WS_WE13 = 8 * MiB;
constexpr size_t WS_Y = WS_WE13;
constexpr size_t WS_XS = 120 * MiB;
constexpr size_t WS_WE2 = WS_XS;
constexpr size_t WS_HE = 188 * MiB;
constexpr size_t WS_WIN = WS_HE;
constexpr size_t WS_WOUT = WS_HE + 13 * MiB;
constexpr size_t WS_W13 = WS_HE + 17 * MiB;
constexpr size_t WS_W2 = WS_HE + 28 * MiB;
constexpr size_t WS_XB = WS_HE + 34 * MiB;
constexpr size_t WS_U = WS_HE + 66 * MiB;
constexpr size_t WS_H = WS_U;
constexpr size_t WS_MIX = WS_HE + 170 * MiB;
constexpr size_t WS_CST = WS_HE + 202 * MiB;
constexpr size_t WS_END = WS_HE + 238 * MiB;
static_assert(WS_CST + 32 * MiB <= WS_END, "ws map");
constexpr int CW_BAR = 4096;

constexpr int LDS_BYTES = 147456;
constexpr int LDSCTL_OFF = 131072 + 14 * 1024, MISC_OFF = LDSCTL_OFF + 320;

#define GAS __attribute__((address_space(1)))
#define LAS __attribute__((address_space(3)))
typedef unsigned short bf16;
typedef float f32x4 __attribute__((ext_vector_type(4)));
typedef unsigned v4u __attribute__((ext_vector_type(4)));
__device__ __forceinline__ unsigned f2bf(float f) { unsigned u = __builtin_bit_cast(unsigned, f); return (u + 0x7fffu + ((u >> 16) & 1u)) >> 16; }
__device__ __forceinline__ unsigned pk2(float lo, float hi) { return f2bf(lo) | (f2bf(hi) << 16); }
__device__ __forceinline__ float bf2f(unsigned short b) { return __builtin_bit_cast(float, (unsigned)b << 16); }
__device__ __forceinline__ float bflo(unsigned w) { return __builtin_bit_cast(float, w << 16); }
__device__ __forceinline__ float bfhi(unsigned w) { return __builtin_bit_cast(float, w & 0xffff0000u); }
__device__ __forceinline__ float wave_sum(float v) {
#pragma unroll
    for (int o = 1; o < 64; o <<= 1) v += __shfl_xor(v, o);
    return v;
}
__device__ __forceinline__ float wave_max(float v) {
#pragma unroll
    for (int o = 1; o < 64; o <<= 1) v = fmaxf(v, __shfl_xor(v, o));
    return v;
}

#define XB_TMO      128
#define XB_XCNT(j)  (256  + 64 * (j))
#define XB_XSUB(j)  (1280 + 64 * (j))
#define XB_XGEN(j)  (2304 + 64 * (j))
#define XB_TOP      3328
#define XB_TOPGEN   3392
#define XCD_BAR_WORDS 3456
#define XB_SPIN_CAP (1u << 18)
__device__ __forceinline__ unsigned xb_ld(unsigned* p)              { return __hip_atomic_load(p, __ATOMIC_RELAXED, __HIP_MEMORY_SCOPE_AGENT); }
__device__ __forceinline__ unsigned xb_add(unsigned* p, unsigned v) { return __hip_atomic_fetch_add(p, v, __ATOMIC_RELAXED, __HIP_MEMORY_SCOPE_AGENT); }
__device__ __forceinline__ unsigned xb_xcc_id() { return (unsigned)__builtin_amdgcn_s_getreg((3 << 11) | 20) & 0xFu; }
#define XB_SPIN(cond, bar) do { unsigned _sp = 0; while (cond) { __builtin_amdgcn_s_sleep(1); \
    if ((++_sp & 255u) == 0u) { if (xb_ld(&(bar)[XB_TMO])) break; if (_sp > XB_SPIN_CAP) { atomicAdd(&(bar)[XB_TMO], 1u); break; } } } } while (0)
struct XcdBarrier { unsigned* bar; unsigned x; volatile LAS unsigned* st; };
__device__ __forceinline__ XcdBarrier xcd_barrier_post(unsigned* bar, volatile LAS unsigned* st) {
    XcdBarrier b; b.bar = bar; b.x = xb_xcc_id(); b.st = st;
    if (threadIdx.x == 0) (void)xb_add(&bar[XB_XCNT(b.x)], 1u);
    return b;
}
__device__ __forceinline__ void xcd_barrier_complete(unsigned* bar, unsigned x, unsigned& nloc, unsigned& nx) {
    const unsigned G = gridDim.x * gridDim.y * gridDim.z;
    unsigned sum, cnt, mine, sp = 0u;
    for (;;) {
        sum = 0u; cnt = 0u; mine = 0u;
#pragma unroll
        for (unsigned j = 0; j < 16; ++j) { const unsigned c = xb_ld(&bar[XB_XCNT(j)]); sum += c; cnt += (c > 0u) ? 1u : 0u; mine = (j == x) ? c : mine; }
        if (sum == G) break;
        __builtin_amdgcn_s_sleep(1);
        if ((++sp & 255u) == 0u) { if (xb_ld(&bar[XB_TMO])) break; if (sp > XB_SPIN_CAP) { atomicAdd(&bar[XB_TMO], 1u); break; } }
    }
    nloc = mine > 0u ? mine : 1u; nx = cnt > 0u ? cnt : 1u;
}
__device__ __forceinline__ void xcd_barrier(const XcdBarrier& b) {
    asm volatile("s_waitcnt vmcnt(0)" ::: "memory");
    __syncthreads();
    if (threadIdx.x == 0) {
        unsigned* bar = b.bar;
        __builtin_amdgcn_s_waitcnt(0);
        unsigned nloc = b.st[0], nx = b.st[1];
        if (nloc == 0u) { xcd_barrier_complete(bar, b.x, nloc, nx); b.st[0] = nloc; b.st[1] = nx; }
        const unsigned old = xb_add(&bar[XB_XSUB(b.x)], 1u);
        const unsigned gen = old / nloc;
        if (old + 1u == (gen + 1u) * nloc) {
            __builtin_amdgcn_fence(__ATOMIC_RELEASE, "agent");
            asm volatile("s_waitcnt vmcnt(0)" ::: "memory");
            const unsigned og = xb_add(&bar[XB_TOP], 1u);
            const unsigned tg = og / nx;
            if (og + 1u == (tg + 1u) * nx) xb_add(&bar[XB_TOPGEN], 1u);
            else XB_SPIN(xb_ld(&bar[XB_TOPGEN]) == tg, bar);
            __builtin_amdgcn_fence(__ATOMIC_ACQUIRE, "agent");
            xb_add(&bar[XB_XGEN(b.x)], 1u);
            asm volatile("s_waitcnt vmcnt(0)" ::: "memory");
        } else {
            XB_SPIN(xb_ld(&bar[XB_XGEN(b.x)]) == gen, bar);
            __builtin_amdgcn_fence(__ATOMIC_ACQUIRE, "agent");
            asm volatile("s_waitcnt vmcnt(0)" ::: "memory");
        }
    }
    __syncthreads();
}

struct Args {
    const float* x; const float* w_mix_in; const float* w_mix_out; const float* g_mix; const float* rel_bias; const float* gla_w_gate; const float* gla_b_gate;
    const float* gla_g_norm; const float* conv_w; const float* g_ffn; const float* ffn_w1; const float* ffn_w3; const float* ffn_w2; const float* moe_router;
    const float* moe_w1; const float* moe_w3; const float* moe_w2; const float* g_final;
    float* out; unsigned char* ws; int ph_lo, ph_hi;
};

__device__ __forceinline__ void transpose_tile(const float* src, int ldsrc, int k0, int n0, bf16* dst, int ldd, int drow0, const float* ksc, unsigned* scr, int lane) {
    const int nq = lane & 15, kk = lane >> 4;
#pragma unroll
    for (int i = 0; i < 8; ++i) { const int k = 8 * i + 2 * kk; const float* p = src + (size_t)(k0 + k) * ldsrc + n0 + 4 * nq;
        const f32x4 r0 = *(const f32x4*)p, r1 = *(const f32x4*)(p + ldsrc);
        const float s0 = ksc ? ksc[k0 + k] : 1.f, s1 = ksc ? ksc[k0 + k + 1] : 1.f;
#pragma unroll
        for (int j = 0; j < 4; ++j) scr[(4 * nq + j) * 33 + 4 * i + kk] = pk2(r0[j] * s0, r1[j] * s1); }
    asm volatile("s_waitcnt lgkmcnt(0)" ::: "memory");
#pragma unroll 8
    for (int i2 = 0; i2 < 32; ++i2) { const int n = 2 * i2 + (lane >> 5), d = lane & 31;
        ((unsigned*)(dst + (size_t)(drow0 + n) * ldd + k0))[d] = scr[n * 33 + d]; }
    asm volatile("s_waitcnt lgkmcnt(0)" ::: "memory");
}
__device__ __forceinline__ void glr_tile(const float* win, const float* wg, const float* g, int k0, int n0, bf16* dst, int drow0, int lane) {
    float w[16];
#pragma unroll
    for (int r = 0; r < 16; ++r) w[r] = wg[r * 256 + n0 + lane];
    unsigned* drow = (unsigned*)(dst + (size_t)(drow0 + n0 + lane) * 1024 + k0);
    for (int kp = 0; kp < 32; ++kp) { float v[2];
#pragma unroll
        for (int q = 0; q < 2; ++q) { const int k = k0 + 2 * kp + q; const float* s = win + (size_t)k * INC + 2304; float a = 0.f;
#pragma unroll
            for (int r = 0; r < 16; ++r) a += s[r] * w[r];
            v[q] = a * g[k]; }
        drow[kp] = pk2(v[0], v[1]); }
}
__device__ __forceinline__ int rel_bucket(int d) {
    if (d < 16) return d;
    const float lr = logf((float)d / 16.0f) / logf(128.0f);
    int b = 16 + (int)(lr * 16.0f); return b < 31 ? b : 31;
}


typedef short bf16x8 __attribute__((ext_vector_type(8)));
typedef short v4i16_t __attribute__((ext_vector_type(4)));
#define MFMA16(a, b, c) __builtin_amdgcn_mfma_f32_16x16x32_bf16((a), (b), (c), 0, 0, 0)
__device__ __forceinline__ v4i16_t tr16(LAS unsigned char* p) { return __builtin_amdgcn_ds_read_tr16_b64_v4i16((LAS v4i16_t*)p); }
__device__ __forceinline__ bf16x8 cat8(v4i16_t lo, v4i16_t hi) { return __builtin_shufflevector(lo, hi, 0, 1, 2, 3, 4, 5, 6, 7); }
__device__ __forceinline__ bf16x8 frag_rm(LAS unsigned char* base, int pitch, int c0, int k0, int lane) { return *(LAS bf16x8*)(base + (c0 + (lane & 15)) * pitch + (k0 + 8 * (lane >> 4)) * 2); }
__device__ __forceinline__ bf16x8 frag_tr(LAS unsigned char* base, int pitch, int c0, int k0, int lane) {
    const int i = lane & 15, g = lane >> 4; LAS unsigned char* p = base + (k0 + 8 * g + (i >> 2)) * pitch + (c0 + 4 * (i & 3)) * 2;
    return cat8(tr16(p), tr16(p + 4 * pitch)); }
__device__ __forceinline__ bf16x8 frag_trp(LAS unsigned char* base, int pitch, int c0, int k0, int lane) {
    const int i = lane & 15, g = lane >> 4; LAS unsigned char* p = base + (k0 + 4 * g + (i >> 2)) * pitch + (c0 + 4 * (i & 3)) * 2;
    return cat8(tr16(p), tr16(p + 16 * pitch)); }
__device__ __forceinline__ bf16x8 pack8(const f32x4& a, const f32x4& b) {
    v4u w; w.x = pg8::cvt_pk_bf16(a[0], a[1]); w.y = pg8::cvt_pk_bf16(a[2], a[3]); w.z = pg8::cvt_pk_bf16(b[0], b[1]); w.w = pg8::cvt_pk_bf16(b[2], b[3]); return __builtin_bit_cast(bf16x8, w); }

struct Ctx { Args args; int tid, lane, wave, G, bx, gw, NGW, lo, hi; XcdBarrier bar; };
#define GRID_BAR() do { if (MK_N_LAUNCHES == 1) xcd_barrier(bar); } while (0)
#define IN(k) (lo <= (k) && (k) < hi)
#define SEAM(k) do { if (IN(k) && IN((k) + 1)) GRID_BAR(); } while (0)
#define WS_PTRS \
    float* SS = (float*)(ws + WS_SS); float* BL = (float*)(ws + WS_BL); float* DEC = (float*)(ws + WS_DEC); \
    bf16* XB = (bf16*)(ws + WS_XB); bf16* U = (bf16*)(ws + WS_U); bf16* MIX = (bf16*)(ws + WS_MIX); float* CST = (float*)(ws + WS_CST); \
    bf16* H = (bf16*)(ws + WS_H); bf16* W13 = (bf16*)(ws + WS_W13); bf16* W2 = (bf16*)(ws + WS_W2); \
    bf16* WE13 = (bf16*)(ws + WS_WE13); bf16* WE2 = (bf16*)(ws + WS_WE2); bf16* XS = (bf16*)(ws + WS_XS); bf16* HE = (bf16*)(ws + WS_HE); bf16* Y = (bf16*)(ws + WS_Y); \
    int* TOPI = (int*)(ws + WS_TOPI); float* TOPW = (float*)(ws + WS_TOPW); int* POS = (int*)(ws + WS_POS); float* RS3 = (float*)(ws + WS_RS3); \
    int* CNT = (int*)(ws + WS_CNT); int* PANE = (int*)(ws + WS_PANE); float* ROWGATE = (float*)(ws + WS_ROWGATE); float* ROWRS = (float*)(ws + WS_ROWRS); \
    float* X = args.out; \
    (void)SS; (void)BL; (void)DEC; (void)XB; (void)U; (void)MIX; (void)CST; (void)H; (void)W13; (void)W2; (void)WE13; (void)WE2; (void)XS; (void)HE; (void)Y; \
    (void)TOPI; (void)TOPW; (void)POS; (void)RS3; (void)CNT; (void)PANE; (void)ROWGATE; (void)ROWRS; (void)X;

template <int layer> __device__ __forceinline__ void layer_phases(const Ctx& c, unsigned char* lds) {
    const Args& args = c.args; LAS unsigned char* ldsl = (LAS unsigned char*)lds;
    const int tid = c.tid, lane = c.lane, wave = c.wave, G = c.G, bx = c.bx, gw = c.gw, NGW = c.NGW, lo = c.lo, hi = c.hi; const XcdBarrier bar = c.bar;
    unsigned char* ws = args.ws; asm volatile("" : "+s"(ws));
    WS_PTRS
    (void)tid; (void)lane; (void)wave; (void)gw; (void)NGW;
        const int pb = 1 + 16 * layer;
        if (IN(pb + 0)) {
            pg8::Gemm g{XB, (const bf16*)(ws + WS_WIN) + (size_t)layer * NU * D, M, NU, D}; pg8::StaticOrder S; S.init(M, NU, G, bx);
            pg8::EpiU E{U, NU, SS, args.gla_b_gate + layer * 256, QS_ATT};
            pg8::gemm_phase<pg8::EpiU, pg8::StaticOrder, true, true>(ldsl, g, S, E);
        }
        SEAM(pb + 0);
        if (IN(pb + 1)) {
            float* cum = (float*)lds; float* seg = cum + 4096;
            LAS unsigned char* kdl = ldsl + 18432;
            LAS unsigned char* vvl = ldsl + 27648;
            for (int u = bx; u < 1024; u += G) {
                const int h = u & 3, n = (u >> 2) & 31, b = u >> 7; const size_t row0 = (size_t)b * SEQ + n * 64;
                { float c = 0.f;
#pragma unroll
                  for (int i = 0; i < 8; ++i) { const int t = 8 * wave + i; c += bf2f(U[(row0 + t) * NU + ULA + h * 64 + lane]); cum[t * 64 + lane] = c; }
                  seg[wave * 64 + lane] = c; }
                __syncthreads();
                { float off = 0.f, last = 0.f;
#pragma unroll
                  for (int w = 0; w < 8; ++w) { const float s = seg[w * 64 + lane]; last += s; if (w < wave) off += s; }
#pragma unroll
                  for (int i = 0; i < 8; ++i) { const int t = 8 * wave + i; const float cm = cum[t * 64 + lane] + off;
                      *(LAS unsigned short*)(kdl + t * 144 + lane * 2) = (unsigned short)f2bf(bf2f(U[(row0 + t) * NU + UGK + h * 64 + lane]) * __expf(last - cm)); }
                  if (wave == 0) DEC[u * 64 + lane] = __expf(last);
                  const int vr = tid >> 3, ch = tid & 7; const v4u* vp = (const v4u*)(U + (row0 + vr) * NU + UGV + h * 128 + ch * 16);
                  const v4u x0 = vp[0], x1 = vp[1]; LAS v4u* vd = (LAS v4u*)(vvl + vr * 272 + ch * 32); vd[0] = x0; vd[1] = x1; }
                __syncthreads();
                { f32x4 acc[4];
#pragma unroll
                  for (int kt = 0; kt < 4; ++kt) acc[kt] = (f32x4){0.f, 0.f, 0.f, 0.f};
#pragma unroll
                  for (int ks = 0; ks < 2; ++ks) { const bf16x8 a = frag_tr(vvl, 272, 16 * wave, 32 * ks, lane);
#pragma unroll
                      for (int kt = 0; kt < 4; ++kt) { const bf16x8 bq = frag_tr(kdl, 144, 16 * kt, 32 * ks, lane); acc[kt] = MFMA16(a, bq, acc[kt]); } }
                  const int g4 = lane >> 4, ql = lane & 15;
#pragma unroll
                  for (int kt = 0; kt < 4; ++kt)
#pragma unroll
                      for (int rg = 0; rg < 4; ++rg) CST[((size_t)u * 128 + 16 * wave + 4 * g4 + rg) * 64 + 16 * kt + ql] = acc[kt][rg]; }
                __syncthreads();
            }
            const float* cw = args.conv_w + layer * 3 * 256;
            for (int it = bx * NTHR + tid; it < M * 32; it += G * NTHR) {
                const int row = it >> 5, c0 = (it & 31) * 8, t = row & (SEQ - 1);
                const bf16* ur = U + (size_t)row * NU;
                const v4u cb = *(const v4u*)(ur + UCB + c0);
                v4u ci[3], cc[3];
#pragma unroll
                for (int d = 0; d < 3; ++d) { if (t >= d) { ci[d] = *(const v4u*)(ur - (size_t)d * NU + UCI + c0); cc[d] = *(const v4u*)(ur - (size_t)d * NU + UCC + c0); } else { ci[d] = (v4u){0u, 0u, 0u, 0u}; cc[d] = ci[d]; } }
                float o[8];
#pragma unroll
                for (int j = 0; j < 4; ++j) {
                    float a0 = 0.f, a1 = 0.f;
#pragma unroll
                    for (int d = 0; d < 3; ++d) { const float w0 = cw[(2 - d) * 256 + c0 + 2 * j], w1 = cw[(2 - d) * 256 + c0 + 2 * j + 1];
                        a0 += w0 * (bflo(cc[d][j]) * bflo(ci[d][j])); a1 += w1 * (bfhi(cc[d][j]) * bfhi(ci[d][j])); }
                    o[2 * j] = bflo(cb[j]) * a0; o[2 * j + 1] = bfhi(cb[j]) * a1; }
                v4u w; w.x = pk2(o[0], o[1]); w.y = pk2(o[2], o[3]); w.z = pk2(o[4], o[5]); w.w = pk2(o[6], o[7]);
                *(v4u*)(MIX + (size_t)row * D + 768 + c0) = w;
            }
        }
        SEAM(pb + 1);
        if (IN(pb + 2)) {
            for (int e = bx * NTHR + tid; e < NB * 4 * 8192; e += G * NTHR) {
                const int k = e & 63, v = (e >> 6) & 127, h = (e >> 13) & 3, b = e >> 15; float S = 0.f;
                for (int n = 0; n < 32; ++n) { const int u = (b * 32 + n) * 4 + h; const size_t idx = ((size_t)u * 128 + v) * 64 + k;
                    const float c = CST[idx]; CST[idx] = S; S = DEC[u * 64 + k] * S + c; }
            }
            {
                float* BLl = (float*)lds;
                for (int i = tid; i < 4 * 2049; i += NTHR) BLl[(i & 3) * 2049 + (i >> 2)] = BL[i];
                __syncthreads();
                LAS unsigned char* vst = ldsl + 33280 + wave * 5120;
                const int ql = lane & 15, g4 = lane >> 4;
                for (int u = bx; u < 512; u += G) {
                    const int c = u & 15, h = (u >> 4) & 3, b = u >> 6; const int i0 = 16 * wave; const size_t rowb = (size_t)b * SEQ;
                    const int tq = c + 16 * (i0 + ql);
                    const bf16* qp = U + (rowb + tq) * NU + UQ + h * 64 + 8 * g4;
                    const bf16x8 qf0 = *(const bf16x8*)qp, qf1 = *(const bf16x8*)(qp + 32);
                    float m_run = -INFINITY, l_run = 0.f; f32x4 o[4];
#pragma unroll
                    for (int d = 0; d < 4; ++d) o[d] = (f32x4){0.f, 0.f, 0.f, 0.f};
                    const float* blh = BLl + h * 2049;
#pragma unroll
                    for (int pi = 0; pi < 3; ++pi) {
                        const int lr = (pi == 0) ? 4 : ((pi == 1) ? 2 : 0); const int r = 1 << lr; const int rho = c & (r - 1);
                        const int mq = tq >> lr; const int mlo = ((c + 16 * i0) >> lr) - 128; const int base = mlo & ~31; const int mhi = (c + 16 * (i0 + 15)) >> lr;
                        const int np = ((mhi - base) >> 5) + 1; const int pr0 = base < 0 ? ((-base) >> 5) : 0;
                        for (int pr = pr0; pr < np; ++pr) {
                            const int mb = base + 32 * pr;
                            bf16x8 kf[2][2];
#pragma unroll
                            for (int tau = 0; tau < 2; ++tau) { int mk = mb + 16 * tau + ql; mk = mk < 0 ? 0 : (mk > mhi ? mhi : mk);
                                const bf16* kp = U + (rowb + (size_t)(mk * r + rho)) * NU + UK + h * 64 + 8 * g4; kf[tau][0] = *(const bf16x8*)kp; kf[tau][1] = *(const bf16x8*)(kp + 32); }
                            { const int vr = lane >> 1, vh = lane & 1; int mv = mb + vr; mv = mv < 0 ? 0 : (mv > mhi ? mhi : mv);
                              const v4u* vp = (const v4u*)(U + (rowb + (size_t)(mv * r + rho)) * NU + UV + h * 64 + 32 * vh);
                              const v4u v0 = vp[0], v1 = vp[1], v2 = vp[2], v3 = vp[3];
                              asm volatile("" ::: "memory");
                              LAS v4u* vd = (LAS v4u*)(vst + vr * 160 + vh * 64); vd[0] = v0; vd[1] = v1; vd[2] = v2; vd[3] = v3; }
                            f32x4 s[2];
#pragma unroll
                            for (int tau = 0; tau < 2; ++tau) { s[tau] = MFMA16(kf[tau][0], qf0, ((f32x4){0.f, 0.f, 0.f, 0.f})); s[tau] = MFMA16(kf[tau][1], qf1, s[tau]); }
                            float tmax = -INFINITY;
#pragma unroll
                            for (int tau = 0; tau < 2; ++tau)
#pragma unroll
                                for (int rg = 0; rg < 4; ++rg) { const int mkv = mb + 16 * tau + 4 * g4 + rg; const int dist = mq - mkv; const bool ok = ((unsigned)dist <= 128u) && (mkv >= 0);
                                    const float bias = blh[ok ? (dist << lr) : 0]; const float v = ok ? s[tau][rg] + bias : -INFINITY; s[tau][rg] = v; tmax = fmaxf(tmax, v); }
                            tmax = fmaxf(tmax, __shfl_xor(tmax, 16)); tmax = fmaxf(tmax, __shfl_xor(tmax, 32));
                            const float mn = fmaxf(m_run, tmax); const float ms = (mn == -INFINITY) ? 0.f : mn; const float alpha = exp2f(m_run - ms); m_run = mn;
                            float ps = 0.f;
#pragma unroll
                            for (int tau = 0; tau < 2; ++tau)
#pragma unroll
                                for (int rg = 0; rg < 4; ++rg) { const float p = exp2f(s[tau][rg] - ms); s[tau][rg] = p; ps += p; }
                            l_run = l_run * alpha + ps;
#pragma unroll
                            for (int d = 0; d < 4; ++d) o[d] = o[d] * alpha;
                            const bf16x8 pb = pack8(s[0], s[1]);
                            asm volatile("" ::: "memory");
#pragma unroll
                            for (int d = 0; d < 4; ++d) { const bf16x8 va = frag_trp(vst, 160, 16 * d, 0, lane); o[d] = MFMA16(va, pb, o[d]); }
                            asm volatile("" ::: "memory");
                        }
                    }
                    l_run += __shfl_xor(l_run, 16); l_run += __shfl_xor(l_run, 32); const float inv = 1.0f / l_run;
                    bf16* op = MIX + (rowb + tq) * D + h * 64 + 4 * g4;
#pragma unroll
                    for (int d = 0; d < 4; ++d) { pg8::u32x2 w; w.x = pg8::cvt_pk_bf16(o[d][0] * inv, o[d][1] * inv); w.y = pg8::cvt_pk_bf16(o[d][2] * inv, o[d][3] * inv); *(pg8::u32x2*)(op + 16 * d) = w; }
                }
            }
        }
        SEAM(pb + 2);
        if (IN(pb + 3)) {
            float* cum = (float*)lds; float* seg = cum + 4096;
            LAS unsigned char* qel = ldsl + 18432;
            LAS unsigned char* kel = ldsl + 27648;
            LAS unsigned char* vvl = ldsl + 36864;
            LAS unsigned char* stl = ldsl + 54272;
            float* rsq = (float*)(lds + 72704);
            const float* gn = args.gla_g_norm + layer * 128;
            for (int u = bx; u < 1024; u += G) {
                const int h = u & 3, n = (u >> 2) & 31, b = u >> 7; const size_t row0 = (size_t)b * SEQ + n * 64;
                { float c = 0.f;
#pragma unroll
                  for (int i = 0; i < 8; ++i) { const int t = 8 * wave + i; c += bf2f(U[(row0 + t) * NU + ULA + h * 64 + lane]); cum[t * 64 + lane] = c; }
                  seg[wave * 64 + lane] = c; }
                __syncthreads();
                { float off = 0.f;
#pragma unroll
                  for (int w = 0; w < 8; ++w) { const float s = seg[w * 64 + lane]; if (w < wave) off += s; }
#pragma unroll
                  for (int i = 0; i < 8; ++i) { const int t = 8 * wave + i; const float cm = cum[t * 64 + lane] + off;
                      *(LAS unsigned short*)(qel + t * 144 + lane * 2) = (unsigned short)f2bf(bf2f(U[(row0 + t) * NU + UGQ + h * 64 + lane]) * __expf(cm));
                      *(LAS unsigned short*)(kel + t * 144 + lane * 2) = (unsigned short)f2bf(bf2f(U[(row0 + t) * NU + UGK + h * 64 + lane]) * __expf(-cm)); }
                  { const int vr = tid >> 3, ch = tid & 7; const v4u* vp = (const v4u*)(U + (row0 + vr) * NU + UGV + h * 128 + ch * 16);
                    const v4u x0 = vp[0], x1 = vp[1]; LAS v4u* vd = (LAS v4u*)(vvl + vr * 272 + ch * 32); vd[0] = x0; vd[1] = x1; }
                  { const int v = tid >> 2, kq = (tid & 3) * 16; const f32x4* sp = (const f32x4*)(CST + ((size_t)u * 128 + v) * 64 + kq);
                    const f32x4 a0 = sp[0], a1 = sp[1], a2 = sp[2], a3 = sp[3];
                    v4u w0, w1; w0.x = pk2(a0[0], a0[1]); w0.y = pk2(a0[2], a0[3]); w0.z = pk2(a1[0], a1[1]); w0.w = pk2(a1[2], a1[3]);
                    w1.x = pk2(a2[0], a2[1]); w1.y = pk2(a2[2], a2[3]); w1.z = pk2(a3[0], a3[1]); w1.w = pk2(a3[2], a3[3]);
                    LAS v4u* sd = (LAS v4u*)(stl + v * 144 + kq * 2); sd[0] = w0; sd[1] = w1; } }
                __syncthreads();
                { const int tt = wave & 3, vh = wave >> 2, ql = lane & 15, g4 = lane >> 4; const int t = 16 * tt + ql;
                  const bf16x8 qb0 = frag_rm(qel, 144, 16 * tt, 0, lane), qb1 = frag_rm(qel, 144, 16 * tt, 32, lane);
                  f32x4 sT[4];
#pragma unroll
                  for (int st = 0; st < 4; ++st) { sT[st] = (f32x4){0.f, 0.f, 0.f, 0.f};
                      if (st <= tt) { sT[st] = MFMA16(frag_rm(kel, 144, 16 * st, 0, lane), qb0, sT[st]); sT[st] = MFMA16(frag_rm(kel, 144, 16 * st, 32, lane), qb1, sT[st]);
#pragma unroll
                          for (int rg = 0; rg < 4; ++rg) if (16 * st + 4 * g4 + rg > t) sT[st][rg] = 0.f; } }
                  const bf16x8 pb0 = pack8(sT[0], sT[1]), pb1 = pack8(sT[2], sT[3]);
                  f32x4 acc[4]; float ss = 0.f;
#pragma unroll
                  for (int vt = 0; vt < 4; ++vt) { const int V0 = 16 * (4 * vh + vt); f32x4 a = (f32x4){0.f, 0.f, 0.f, 0.f};
                      a = MFMA16(frag_trp(vvl, 272, V0, 0, lane), pb0, a); a = MFMA16(frag_trp(vvl, 272, V0, 32, lane), pb1, a);
                      a = MFMA16(frag_rm(stl, 144, V0, 0, lane), qb0, a); a = MFMA16(frag_rm(stl, 144, V0, 32, lane), qb1, a);
                      acc[vt] = a; ss += (a[0] * a[0] + a[1] * a[1]) + (a[2] * a[2] + a[3] * a[3]); }
                  ss += __shfl_xor(ss, 16); ss += __shfl_xor(ss, 32);
                  if (g4 == 0) rsq[(tt * 2 + vh) * 16 + ql] = ss;
                  __syncthreads();
                  const float rs = 1.0f / sqrtf((rsq[(tt * 2) * 16 + ql] + rsq[(tt * 2 + 1) * 16 + ql]) * (1.0f / 128.0f) + pg8::RMS_EPS);
#pragma unroll
                  for (int vt = 0; vt < 4; ++vt) { const int v0 = 16 * (4 * vh + vt) + 4 * g4;
                      const pg8::u32x2 gr = *(const pg8::u32x2*)(U + (row0 + t) * NU + UGR + h * 128 + v0); const f32x4 gv = *(const f32x4*)(gn + v0);
                      const float o0 = acc[vt][0] * rs * gv[0] * pg8::silu_f(bflo(gr.x)), o1 = acc[vt][1] * rs * gv[1] * pg8::silu_f(bfhi(gr.x));
                      const float o2 = acc[vt][2] * rs * gv[2] * pg8::silu_f(bflo(gr.y)), o3 = acc[vt][3] * rs * gv[3] * pg8::silu_f(bfhi(gr.y));
                      pg8::u32x2 w; w.x = pg8::cvt_pk_bf16(o0, o1); w.y = pg8::cvt_pk_bf16(o2, o3);
                      *(pg8::u32x2*)(MIX + (row0 + t) * D + 256 + h * 128 + v0) = w; } }
                __syncthreads();
            }
        }
        SEAM(pb + 3);
        if (IN(pb + 4)) {
            pg8::Gemm g{MIX, (const bf16*)(ws + WS_WOUT) + (size_t)layer * D * D, M, D, D}; pg8::StaticOrder S; S.init(M, D, G, bx);
            pg8::EpiRes E{layer == 0 ? args.x : (const float*)X, X, XB, SS};
            pg8::gemm_phase<pg8::EpiRes, pg8::StaticOrder, true, true>(ldsl, g, S, E);
        }
        SEAM(pb + 4);
        if (layer == 0) {
            if (IN(pb + 5)) {
                pg8::Gemm g{XB, W13, M, 2 * FF, D}; pg8::StaticOrder S; S.init(M, 2 * FF, G, bx);
                pg8::EpiGlu<false> E{H, FF, SS};
                pg8::gemm_phase<pg8::EpiGlu<false>, pg8::StaticOrder, true, true>(ldsl, g, S, E);
            }
            SEAM(pb + 5);
            if (IN(pb + 6)) {
                pg8::Gemm g{H, W2, M, D, FF}; pg8::StaticOrder S; S.init(M, D, G, bx);
                pg8::EpiRes E{X, X, XB, SS};
                pg8::gemm_phase<pg8::EpiRes, pg8::StaticOrder, true, true>(ldsl, g, S, E);
            }
            SEAM(pb + 6);
        } else {
            if (IN(pb + 5)) {
                float* wr_l = (float*)lds;
                int* cnt_l = (int*)(lds + 32768);
                const float* gf = args.g_ffn + D;
                for (int i = tid; i < D * 8; i += NTHR) wr_l[i] = args.moe_router[i] * gf[i >> 3];
                if (tid < 8) cnt_l[tid] = 0;
                __syncthreads();
                for (int blk = bx; blk < 256; blk += G) {
                    if (blk != bx) { __syncthreads(); if (tid < 8) cnt_l[tid] = 0; __syncthreads(); }
                    for (int i = 0; i < 8; ++i) { const int m = blk * 64 + wave * 8 + i;
                        const f32x4* xr = (const f32x4*)(X + (size_t)m * D) + lane; float lg[8];
#pragma unroll
                        for (int e = 0; e < 8; ++e) lg[e] = 0.f;
#pragma unroll
                        for (int j = 0; j < 4; ++j) { const f32x4 v = xr[64 * j]; const int k0 = 4 * (lane + 64 * j);
#pragma unroll
                            for (int q = 0; q < 4; ++q) { const f32x4 w0 = *(const f32x4*)(wr_l + (k0 + q) * 8), w1 = *(const f32x4*)(wr_l + (k0 + q) * 8 + 4);
#pragma unroll
                                for (int e = 0; e < 4; ++e) { lg[e] += v[q] * w0[e]; lg[4 + e] += v[q] * w1[e]; } } }
                        const float rs = pg8::rstd_of(SS + (size_t)m * 16);
#pragma unroll
                        for (int e = 0; e < 8; ++e) lg[e] = wave_sum(lg[e]) * rs;
                        int i0 = 0; float v0 = lg[0];
#pragma unroll
                        for (int e = 1; e < 8; ++e) if (lg[e] > v0) { v0 = lg[e]; i0 = e; }
                        int i1 = -1; float v1 = -INFINITY;
#pragma unroll
                        for (int e = 0; e < 8; ++e) if (e != i0 && lg[e] > v1) { v1 = lg[e]; i1 = e; }
                        const float w1 = 1.0f / (1.0f + __expf(v0 - v1)), w0 = 1.0f - w1;
                        if (lane == 0) { TOPI[m * 2] = i0; TOPI[m * 2 + 1] = i1; TOPW[m * 2] = w0; TOPW[m * 2 + 1] = w1; RS3[m] = rs; atomicAdd(&cnt_l[i0], 1); atomicAdd(&cnt_l[i1], 1); } }
                    __syncthreads();
                    if (tid < 8) CNT[blk * 8 + tid] = cnt_l[tid];
                }
            }
            SEAM(pb + 5);
            if (IN(pb + 6)) {
                int* base_l = (int*)lds;
                int* pre_l = base_l + 8;
                int* tot_l = pre_l + 8;
                int* pos_l = tot_l + 8;
                int* ent_l = pos_l + 128;
                for (int blk = bx; blk < 256; blk += G) {
                    __syncthreads();
                    if (tid < 8) { tot_l[tid] = 0; pre_l[tid] = 0; }
                    if (tid < 128) ent_l[tid] = TOPI[blk * 128 + tid];
                    __syncthreads();
                    { const int g2 = tid >> 1, e0 = (tid & 1) * 4; const int4 c = *(const int4*)(CNT + g2 * 8 + e0);
                      atomicAdd(&tot_l[e0], c.x); atomicAdd(&tot_l[e0 + 1], c.y); atomicAdd(&tot_l[e0 + 2], c.z); atomicAdd(&tot_l[e0 + 3], c.w);
                      if (g2 < blk) { atomicAdd(&pre_l[e0], c.x); atomicAdd(&pre_l[e0 + 1], c.y); atomicAdd(&pre_l[e0 + 2], c.z); atomicAdd(&pre_l[e0 + 3], c.w); } }
                    __syncthreads();
                    if (tid == 0) { int bs = 0; for (int e = 0; e < 8; ++e) { base_l[e] = bs; bs += (tot_l[e] + 255) & ~255; } }
                    __syncthreads();
                    if (tid < 128) { const int e = ent_l[tid]; int rank = 0; for (int j = 0; j < tid; ++j) rank += (ent_l[j] == e) ? 1 : 0;
                        const int p = base_l[e] + pre_l[e] + rank; pos_l[tid] = p; POS[blk * 128 + tid] = p; ROWGATE[p] = TOPW[blk * 128 + tid]; ROWRS[p] = RS3[blk * 64 + (tid >> 1)]; }
                    if (blk == 0) {
                        for (int e = 0; e < 8; ++e) { const int npe = (tot_l[e] + 255) >> 8; for (int p = base_l[e] + tot_l[e] + tid; p < base_l[e] + npe * 256; p += NTHR) { ROWGATE[p] = 0.f; ROWRS[p] = 0.f; } }
                        if (tid == 0) { int np = 0; for (int e = 0; e < 8; ++e) { const int npe = (tot_l[e] + 255) >> 8; for (int j = 0; j < npe; ++j) PANE[np++] = e; } PANE[MAXPAN] = np; } }
                    __syncthreads();
                    for (int i = 0; i < 16; ++i) { const int sl = wave * 16 + i; const int m = blk * 64 + (sl >> 1); const int p = pos_l[sl];
                        const v4u* s = (const v4u*)(XB + (size_t)m * D) + lane; v4u* d = (v4u*)(XS + (size_t)p * D) + lane; d[0] = s[0]; d[64] = s[64]; }
                }
            }
            SEAM(pb + 6);
            if (IN(pb + 7)) {
                pg8::Gemm g{XS, WE13, MAXROWS, 2 * FE, D}; pg8::MoeOrder S{PANE, PANE[MAXPAN], 28, G, bx};
                pg8::EpiGlu<true> E{HE, FE, ROWRS};
                pg8::gemm_phase<pg8::EpiGlu<true>, pg8::MoeOrder, true, true>(ldsl, g, S, E);
            }
            SEAM(pb + 7);
            if (IN(pb + 8)) {
                unsigned* scr = (unsigned*)(lds + wave * 8704);
                constexpr int T_J = 56 * 16;
                for (int it = gw; it < 8 * T_J; it += NGW) { const int e = it / T_J, r = it % T_J;
                    transpose_tile(args.moe_w2 + (size_t)e * FE * D, D, 64 * (r / 16), 64 * (r % 16), WE2 + (size_t)e * D * FE, FE, 64 * (r % 16), nullptr, scr, lane); }
            }
            SEAM(pb + 8);
            if (IN(pb + 9)) {
                pg8::Gemm g{HE, WE2, MAXROWS, D, FE}; pg8::MoeOrder S{PANE, PANE[MAXPAN], 4, G, bx};
                pg8::EpiMoeDown E{Y, ROWGATE};
                pg8::gemm_phase<pg8::EpiMoeDown, pg8::MoeOrder, true, true>(ldsl, g, S, E);
            }
            SEAM(pb + 9);
            if (IN(pb + 10)) {
                for (int m = gw; m < M; m += NGW) {
                    f32x4* xr = (f32x4*)(X + (size_t)m * D) + lane; const int p0 = POS[m * 2], p1 = POS[m * 2 + 1];
                    const unsigned long long* y0 = (const unsigned long long*)(Y + (size_t)p0 * D) + lane; const unsigned long long* y1 = (const unsigned long long*)(Y + (size_t)p1 * D) + lane;
                    f32x4 v[4]; float s = 0.f;
#pragma unroll
                    for (int j = 0; j < 4; ++j) { v[j] = xr[64 * j]; const unsigned long long a = y0[64 * j], c = y1[64 * j];
                        v[j][0] += bflo((unsigned)a) + bflo((unsigned)c); v[j][1] += bfhi((unsigned)a) + bfhi((unsigned)c);
                        v[j][2] += bflo((unsigned)(a >> 32)) + bflo((unsigned)(c >> 32)); v[j][3] += bfhi((unsigned)(a >> 32)) + bfhi((unsigned)(c >> 32));
                        s += (v[j][0] * v[j][0] + v[j][1] * v[j][1]) + (v[j][2] * v[j][2] + v[j][3] * v[j][3]); }
                    const float rs = 1.0f / sqrtf(wave_sum(s) * (1.0f / D) + pg8::RMS_EPS);
                    const f32x4* gf = (const f32x4*)args.g_final + lane;
#pragma unroll
                    for (int j = 0; j < 4; ++j) xr[64 * j] = v[j] * rs * gf[64 * j];
                }
            }
        }
}

__global__ void __launch_bounds__(NTHR, 2) hybrid_fwd(Args args) {
    extern __shared__ __attribute__((aligned(16))) unsigned char lds[];
    LAS unsigned char* ldsl = (LAS unsigned char*)lds;
    volatile LAS unsigned* MISC = (volatile LAS unsigned*)(ldsl + MISC_OFF);
    const int tid = threadIdx.x, lane = tid & 63, wave = __builtin_amdgcn_readfirstlane(tid >> 6);
    const int G = gridDim.x; const int bx = blockIdx.x;
    const int gw = bx * NWAVES + wave, NGW = G * NWAVES;
    unsigned char* ws = args.ws;
    for (int u = tid; u < (LDS_BYTES - LDSCTL_OFF) / 4; u += NTHR) ((LAS unsigned*)(ldsl + LDSCTL_OFF))[u] = 0u;
    __syncthreads();
    XcdBarrier bar; bar.bar = (unsigned*)(ws + WS_CTL) + CW_BAR; bar.x = 0; bar.st = nullptr;
    if (MK_N_LAUNCHES == 1) bar = xcd_barrier_post((unsigned*)(ws + WS_CTL) + CW_BAR, MISC + 8);
    const int lo = args.ph_lo, hi = args.ph_hi;

    WS_PTRS

    if (IN(0)) {
        unsigned* scr = (unsigned*)(lds + wave * 8704);
        constexpr int T_A = 16 * 36, T_B = 16 * 12, T_C = 16 * 4, T_D = 16 * 16, T_L = T_A + T_B + T_C + T_D;
        constexpr int T_F = 16 * 44, T_G = 44 * 16, T_E = 16 * 56;
        constexpr int NT0 = 2 * T_L + 2 * T_F + T_G + 16 * T_E;
        for (int it = gw; it < NT0; it += NGW) {
            int r = it;
            if (r < 2 * T_L) { const int l = r / T_L; r -= l * T_L; const float* win = args.w_mix_in + (size_t)l * D * INC; const float* gm = args.g_mix + l * D;
                bf16* WIN = (bf16*)(ws + WS_WIN) + (size_t)l * NU * D;
                if (r < T_A) { transpose_tile(win, INC, 64 * (r / 36), 64 * (r % 36), WIN, D, 64 * (r % 36), gm, scr, lane); continue; } r -= T_A;
                if (r < T_B) { transpose_tile(win, INC, 64 * (r / 12), 2320 + 64 * (r % 12), WIN, D, 2304 + 64 * (r % 12), gm, scr, lane); continue; } r -= T_B;
                if (r < T_C) { glr_tile(win, args.gla_w_gate + l * 16 * 256, gm, 64 * (r / 4), 64 * (r % 4), WIN, 3072, lane); continue; } r -= T_C;
                transpose_tile(args.w_mix_out + (size_t)l * D * D, D, 64 * (r / 16), 64 * (r % 16), (bf16*)(ws + WS_WOUT) + (size_t)l * D * D, D, 64 * (r % 16), nullptr, scr, lane); continue; }
            r -= 2 * T_L;
            if (r < 2 * T_F) { const int w3 = r / T_F; r -= w3 * T_F; const int n0 = 64 * (r % 44);
                transpose_tile(w3 ? args.ffn_w3 : args.ffn_w1, FF, 64 * (r / 44), n0, W13, D, (n0 >> 7) * 256 + (n0 & 127) + 128 * w3, args.g_ffn, scr, lane); continue; }
            r -= 2 * T_F;
            if (r < T_G) { transpose_tile(args.ffn_w2, D, 64 * (r / 16), 64 * (r % 16), W2, FF, 64 * (r % 16), nullptr, scr, lane); continue; }
            r -= T_G;
            { const int ew = r / T_E; r -= ew * T_E; const int e = ew >> 1, w3 = ew & 1; const int n0 = 64 * (r % 56);
              transpose_tile((w3 ? args.moe_w3 : args.moe_w1) + (size_t)e * D * FE, FE, 64 * (r / 56), n0, WE13 + (size_t)e * 2 * FE * D, D, (n0 >> 7) * 256 + (n0 & 127) + 128 * w3, args.g_ffn + D, scr, lane); }
        }
        for (int m = gw; m < M; m += NGW) {
            const f32x4* xr = (const f32x4*)(args.x + (size_t)m * D) + lane; float s = 0.f;
            unsigned long long* o8 = (unsigned long long*)(XB + (size_t)m * D) + lane;
#pragma unroll
            for (int j = 0; j < 4; ++j) { const f32x4 v = xr[64 * j]; s += (v[0] * v[0] + v[1] * v[1]) + (v[2] * v[2] + v[3] * v[3]);
                o8[64 * j] = (unsigned long long)pk2(v[0], v[1]) | ((unsigned long long)pk2(v[2], v[3]) << 32); }
            s = wave_sum(s);
            if (lane < 16) SS[(size_t)m * 16 + lane] = (lane == 0) ? s : 0.f;
        }
        for (int i = bx * NTHR + tid; i < 2049 * 4; i += G * NTHR) { const int d = i >> 2, h = i & 3; BL[i] = args.rel_bias[rel_bucket(d) * 4 + h] * LOG2E; }
    }
    SEAM(0);

    Ctx c; c.args = args; c.tid = tid; c.lane = lane; c.wave = wave; c.G = G; c.bx = bx; c.gw = gw; c.NGW = NGW; c.lo = lo; c.hi = hi; c.bar = bar;
    layer_phases<0>(c, lds);
    layer_phases<1>(c, lds);
}
#undef IN
#undef SEAM
#undef GRID_BAR


extern "C" void kernel_launch(void* const* d_in, const int* in_sizes, int n_in, void* d_out, int out_size, void* d_ws, size_t ws_size, hipStream_t stream) {
    static int grid = 0;
    if (grid == 0) {
        if (n_in != 18 || in_sizes[0] != M * D || out_size != M * D || ws_size < WS_END) { fprintf(stderr, "kernel_launch: unexpected shapes / workspace (%zu < %zu)\n", ws_size, (size_t)WS_END); grid = -1; return; }
        int dev = 0, cus = 0, per_cu = 0;
        if (hipGetDevice(&dev) != hipSuccess || hipDeviceGetAttribute(&cus, hipDeviceAttributeMultiprocessorCount, dev) != hipSuccess) { grid = -1; return; }
        if (hipFuncSetAttribute((const void*)hybrid_fwd, hipFuncAttributeMaxDynamicSharedMemorySize, LDS_BYTES) != hipSuccess) { fprintf(stderr, "kernel_launch: hipFuncSetAttribute failed\n"); grid = -1; return; }
        if (hipOccupancyMaxActiveBlocksPerMultiprocessor(&per_cu, (const void*)hybrid_fwd, NTHR, LDS_BYTES) != hipSuccess || per_cu < 1) { fprintf(stderr, "kernel_launch: occupancy query says %d\n", per_cu); }
        (void)hipGetLastError();
        grid = cus;
    }
    if (grid < 0) return;
    if (hipMemsetAsync((char*)d_ws + WS_CTL, 0, CTL_ZERO_BYTES, stream) != hipSuccess) return;
    Args a{};
    const float** f = (const float**)&a;
    for (int i = 0; i < 18; ++i) f[i] = (const float*)d_in[i];
    a.out = (float*)d_out; a.ws = (unsigned char*)d_ws;
    if (MK_N_LAUNCHES == 1) { a.ph_lo = 0; a.ph_hi = 64; hipLaunchKernelGGL(hybrid_fwd, dim3(grid), dim3(NTHR), LDS_BYTES, stream, a); }
    else {
        static const int phases[] = {0, 1, 2, 3, 4, 5, 6, 7, 17, 18, 19, 20, 21, 22, 23, 24, 25, 26, 27};
        for (int p : phases) { a.ph_lo = p; a.ph_hi = p + 1; hipLaunchKernelGGL(hybrid_fwd, dim3(grid), dim3(NTHR), LDS_BYTES, stream, a); }
    }
}
```

```cpp
#include <hip/hip_runtime.h>
#include <cstdio>
#include <cstdint>

#ifndef MK_N_LAUNCHES
#define MK_N_LAUNCHES 1
#endif

namespace pg8 {
#define PG8_LAS __attribute__((address_space(3)))
typedef unsigned short bf16_t;
typedef short bf16x8 __attribute__((ext_vector_type(8)));
typedef float f32x4 __attribute__((ext_vector_type(4)));
typedef unsigned u32x4 __attribute__((ext_vector_type(4)));
typedef unsigned u32x2 __attribute__((ext_vector_type(2)));
constexpr int BM = 256, BK = 64, HALF = 128, HTB = HALF * BK * 2, STAGE_BYTES = 8 * HTB, NXCD = 8, WGM = 8;

__host__ __device__ __forceinline__ int lds_byte(int r, int c) { const int st = (r >> 4) * 2 + (c >> 5), rr = r & 15, cc = c & 31, ob = rr * 64 + cc * 2; return st * 1024 + (ob ^ (((ob >> 9) & 1) << 5)); }
__host__ __device__ __forceinline__ void stage_rc(int b, int& R, int& C) { const int st = b / 1024, sb = b % 1024, swz = sb ^ (((sb >> 9) & 1) << 5); R = (st >> 1) * 16 + swz / 64; C = (st & 1) * 32 + (swz % 64) / 2; }
__host__ __device__ __forceinline__ int perm32(int rho) { const int n = rho >> 4, i = rho & 15; return 8 * (i >> 2) + 4 * n + (i & 3); }

struct Unit { int pm, pn; };
struct Gemm { const bf16_t* A; const bf16_t* Bt; int M, N, K; };

struct StaticOrder {
    int nM, nN, nwg, G, c;
    __host__ __device__ void init(int M, int N, int G_, int c_) { nM = M / BM; nN = N / BM; nwg = nM * nN; G = G_; c = c_; }
    __host__ __device__ bool next(int i, Unit& u) const {
        const long L = (long)i * G + c; if (L >= nwg) return false;
        int wgid = (int)L; { const int q = nwg / NXCD, r = nwg % NXCD, xcd = wgid % NXCD, off = wgid / NXCD; wgid = (xcd < r ? xcd * (q + 1) : r * (q + 1) + (xcd - r) * q) + off; }
        const int nig = WGM * nN, gid = wgid / nig, fm = gid * WGM, gsz = (nM - fm) < WGM ? (nM - fm) : WGM;
        u.pm = fm + ((wgid % nig) % gsz); u.pn = (wgid % nig) / gsz; return true;
    }
    __device__ __forceinline__ void a_ready(const Unit&) const {}
    __device__ __forceinline__ void done(const Unit&) const {}
};
struct MoeOrder {
    const int* panel_e; int npan, NT, G, c;
    __device__ bool next(int i, Unit& u) const {
        const long L = (long)i * G + c; if (L >= (long)npan * NT) return false;
        const int p = (int)(L / NT); u.pm = p; u.pn = panel_e[p] * NT + (int)(L % NT); return true;
    }
    __device__ __forceinline__ void a_ready(const Unit&) const {}
    __device__ __forceinline__ void done(const Unit&) const {}
};

__device__ __forceinline__ unsigned cvt_pk_bf16(float lo, float hi) { unsigned r; asm volatile("v_cvt_pk_bf16_f32 %0, %1, %2" : "=v"(r) : "v"(lo), "v"(hi)); return r; }

constexpr float RMS_EPS = 1e-6f;
__device__ __forceinline__ float rstd_of(const float* ss16) {
    const f32x4 a = *(const f32x4*)ss16, b = *(const f32x4*)(ss16 + 4), c = *(const f32x4*)(ss16 + 8), d = *(const f32x4*)(ss16 + 12);
    const float s = ((a[0] + a[1]) + (a[2] + a[3])) + ((b[0] + b[1]) + (b[2] + b[3])) + ((c[0] + c[1]) + (c[2] + c[3])) + ((d[0] + d[1]) + (d[2] + d[3]));
    return 1.0f / sqrtf(s * (1.0f / 1024.0f) + RMS_EPS);
}
__device__ __forceinline__ float logsig16(float x) { return ((x < 0.f ? x : 0.f) - log1pf(__expf(-fabsf(x)))) * (1.0f / 16.0f); }
__device__ __forceinline__ float silu_f(float a) { return a / (1.0f + __expf(-a)); }

struct EpiU {
    static constexpr bool PERM = true, AFTER_DRAIN = false;
    bf16_t* U; int ldu; const float* SS; const float* bgate; float qs;
    __device__ __forceinline__ void operator()(const f32x4 (&acc)[2][2][4][2], const Unit& u, int wr, int wc, int fr, int fq) const {
        const int row0 = u.pm * BM + wr * 64 + fr, cl = wc * 32 + 8 * fq, col0 = u.pn * BM + cl;
        const float sc = (u.pn == 0) ? qs : ((u.pn == 3) ? 0.125f : 1.0f);
        const bool la = (u.pn == 12);
        f32x4 bv[2][2];
#pragma unroll
        for (int bj = 0; bj < 2; ++bj)
#pragma unroll
            for (int n = 0; n < 2; ++n) bv[bj][n] = la ? *(const f32x4*)(bgate + cl + bj * HALF + 4 * n) : (f32x4){0.f, 0.f, 0.f, 0.f};
#pragma unroll
        for (int ai = 0; ai < 2; ++ai)
#pragma unroll
            for (int m = 0; m < 4; ++m) { const int row = row0 + ai * HALF + m * 16; const float rs = rstd_of(SS + (size_t)row * 16) * sc;
                bf16_t* rowp = U + (size_t)row * ldu + col0;
#pragma unroll
                for (int bj = 0; bj < 2; ++bj) { f32x4 v0 = acc[ai][bj][m][0] * rs, v1 = acc[ai][bj][m][1] * rs;
                    if (la) {
#pragma unroll
                        for (int j = 0; j < 4; ++j) { v0[j] = logsig16(v0[j] + bv[bj][0][j]); v1[j] = logsig16(v1[j] + bv[bj][1][j]); } }
                    u32x4 w; w.x = cvt_pk_bf16(v0[0], v0[1]); w.y = cvt_pk_bf16(v0[2], v0[3]); w.z = cvt_pk_bf16(v1[0], v1[1]); w.w = cvt_pk_bf16(v1[2], v1[3]);
                    *(u32x4*)(rowp + bj * HALF) = w; } }
    }
};
struct EpiRes {
    static constexpr bool PERM = false, AFTER_DRAIN = false;
    const float* Xin; float* Xout; bf16_t* XB; float* SS;
    __device__ __forceinline__ void operator()(const f32x4 (&acc)[2][2][4][2], const Unit& u, int wr, int wc, int fr, int fq) const {
        const int row0 = u.pm * BM + wr * 64 + fr, col0 = u.pn * BM + wc * 32 + 4 * fq;
#pragma unroll
        for (int ai = 0; ai < 2; ++ai)
#pragma unroll
            for (int m = 0; m < 4; ++m) { const int row = row0 + ai * HALF + m * 16; const size_t off = (size_t)row * 1024 + col0; float ssum = 0.f;
#pragma unroll
                for (int bj = 0; bj < 2; ++bj)
#pragma unroll
                    for (int n = 0; n < 2; ++n) { const f32x4 xo = *(const f32x4*)(Xin + off + bj * HALF + n * 16); const f32x4 v = xo + acc[ai][bj][m][n];
                        *(f32x4*)(Xout + off + bj * HALF + n * 16) = v; u32x2 w; w.x = cvt_pk_bf16(v[0], v[1]); w.y = cvt_pk_bf16(v[2], v[3]);
                        *(u32x2*)(XB + off + bj * HALF + n * 16) = w; ssum += (v[0] * v[0] + v[1] * v[1]) + (v[2] * v[2] + v[3] * v[3]); }
                ssum += __shfl_xor(ssum, 16); ssum += __shfl_xor(ssum, 32);
                if (fq == 0) SS[(size_t)row * 16 + u.pn * 4 + wc] = ssum;
                asm volatile("" ::: "memory"); }
    }
};
template <bool MOE> struct EpiGlu {
    static constexpr bool PERM = true, AFTER_DRAIN = false;
    bf16_t* O; int ldo; const float* SS;
    __device__ __forceinline__ void operator()(const f32x4 (&acc)[2][2][4][2], const Unit& u, int wr, int wc, int fr, int fq) const {
        const int row0 = u.pm * BM + wr * 64 + fr; const int pnl = MOE ? (u.pn % 28) : u.pn; const int col0 = pnl * HALF + wc * 32 + 8 * fq;
#pragma unroll
        for (int ai = 0; ai < 2; ++ai)
#pragma unroll
            for (int m = 0; m < 4; ++m) { const int row = row0 + ai * HALF + m * 16; const float rs = MOE ? SS[row] : rstd_of(SS + (size_t)row * 16);
                const f32x4 a0 = acc[ai][0][m][0] * rs, a1 = acc[ai][0][m][1] * rs, b0 = acc[ai][1][m][0] * rs, b1 = acc[ai][1][m][1] * rs;
                f32x4 g0, g1;
#pragma unroll
                for (int j = 0; j < 4; ++j) { g0[j] = silu_f(a0[j]) * b0[j]; g1[j] = silu_f(a1[j]) * b1[j]; }
                u32x4 w; w.x = cvt_pk_bf16(g0[0], g0[1]); w.y = cvt_pk_bf16(g0[2], g0[3]); w.z = cvt_pk_bf16(g1[0], g1[1]); w.w = cvt_pk_bf16(g1[2], g1[3]);
                *(u32x4*)(O + (size_t)row * ldo + col0) = w; }
    }
};
struct EpiMoeDown {
    static constexpr bool PERM = true, AFTER_DRAIN = false;
    bf16_t* Y; const float* gate;
    __device__ __forceinline__ void operator()(const f32x4 (&acc)[2][2][4][2], const Unit& u, int wr, int wc, int fr, int fq) const {
        const int row0 = u.pm * BM + wr * 64 + fr, col0 = (u.pn & 3) * BM + wc * 32 + 8 * fq;
#pragma unroll
        for (int ai = 0; ai < 2; ++ai)
#pragma unroll
            for (int m = 0; m < 4; ++m) { const int row = row0 + ai * HALF + m * 16; const float g = gate[row]; bf16_t* rowp = Y + (size_t)row * 1024 + col0;
#pragma unroll
                for (int bj = 0; bj < 2; ++bj) { const f32x4 v0 = acc[ai][bj][m][0] * g, v1 = acc[ai][bj][m][1] * g;
                    u32x4 w; w.x = cvt_pk_bf16(v0[0], v0[1]); w.y = cvt_pk_bf16(v0[2], v0[3]); w.z = cvt_pk_bf16(v1[0], v1[1]); w.w = cvt_pk_bf16(v1[2], v1[3]);
                    *(u32x4*)(rowp + bj * HALF) = w; } }
    }
};

template <class Epi, class Sched, bool ALIGN_EPI = false, bool SP2 = false>
__device__ __forceinline__ void gemm_phase(PG8_LAS unsigned char* lds, const Gemm g, const Sched& S, const Epi& E) {
    const int tid = threadIdx.x, wid = __builtin_amdgcn_readfirstlane(tid >> 6), lane = tid & 63, wr = wid >> 2, wc = wid & 3, fr = lane & 15, fq = lane >> 4;
    const int K = g.K, nt = K / BK;
    unsigned voffA[2], voffB[2];
#pragma unroll
    for (int i = 0; i < 2; ++i) { int R, C; stage_rc(tid * 16 + i * 8192, R, C); const int Rb = Epi::PERM ? ((R & ~31) + perm32(R & 31)) : R;
        voffA[i] = (unsigned)(R * K + C) * 2u; voffB[i] = (unsigned)(Rb * K + C) * 2u; }
    const size_t kstep = (size_t)(BK * 2);
    const size_t hstep = (size_t)HALF * K * 2;
    const size_t tstep = 2 * hstep;
    const unsigned ldsw = (unsigned)wid * 1024u;
    const int aoff = lds_byte(wr * 64 + fr, fq * 8), boff = lds_byte(wc * 32 + fr, fq * 8);
#define PG8_SA(b, h) (((b) * 2 + (h)) * HTB)
#define PG8_SB(b, h) ((4 + (b) * 2 + (h)) * HTB)
#define PG8_STAGE(bufoff, gbase, voff) do { _Pragma("unroll") for (int _i = 0; _i < 2; ++_i) \
        __builtin_amdgcn_global_load_lds((const unsigned*)((const char*)(gbase) + (voff)[_i]), (PG8_LAS unsigned*)(lds + (bufoff) + ldsw + _i * 8192), 16, 0, 0); } while (0)
#define PG8_LDA(dst, b, h) do { _Pragma("unroll") for (int m = 0; m < 4; ++m) _Pragma("unroll") for (int k = 0; k < 2; ++k) dst[m][k] = *(const PG8_LAS bf16x8*)(lds + PG8_SA(b, h) + aoff + m * 2048 + k * 1024); } while (0)
#define PG8_LDB(dst, b, h) do { _Pragma("unroll") for (int n = 0; n < 2; ++n) _Pragma("unroll") for (int k = 0; k < 2; ++k) dst[n][k] = *(const PG8_LAS bf16x8*)(lds + PG8_SB(b, h) + boff + n * 2048 + k * 1024); } while (0)
#define PG8_MMA(ai, bj, At, Bt) do { __builtin_amdgcn_s_setprio(1); _Pragma("unroll") for (int m = 0; m < 4; ++m) _Pragma("unroll") for (int n = 0; n < 2; ++n) _Pragma("unroll") for (int k = 0; k < 2; ++k) \
        acc[ai][bj][m][n] = __builtin_amdgcn_mfma_f32_16x16x32_bf16(Bt[n][k], At[m][k], acc[ai][bj][m][n], 0, 0, 0); __builtin_amdgcn_s_setprio(0); } while (0)
#define PG8_WAIT_V(n) asm volatile("s_waitcnt vmcnt(" #n ")" ::: "memory")
#define PG8_WAIT_L(n) asm volatile("s_waitcnt lgkmcnt(" #n ")" ::: "memory")
#define PG8_BAR __builtin_amdgcn_s_barrier()
#define PG8_SCHED __builtin_amdgcn_sched_barrier(0)
    Unit cur, nxt; int ui = 0;
    if (!S.next(0, cur)) return;
    f32x4 acc[2][2][4][2];
#pragma unroll
    for (int a = 0; a < 2; ++a)
#pragma unroll
        for (int b = 0; b < 2; ++b)
#pragma unroll
            for (int m = 0; m < 4; ++m)
#pragma unroll
                for (int n = 0; n < 2; ++n) acc[a][b][m][n] = (f32x4){0.f, 0.f, 0.f, 0.f};
    bf16x8 At[4][2], B0[2][2], B1[2][2];
    const char* cA = (const char*)g.A + (size_t)cur.pm * tstep; const char* cB = (const char*)g.Bt + (size_t)cur.pn * tstep;
    S.a_ready(cur);
    if constexpr (SP2) {
        PG8_STAGE(PG8_SB(0, 0), cB, voffB); PG8_STAGE(PG8_SB(0, 1), cB + hstep, voffB); PG8_STAGE(PG8_SA(0, 0), cA, voffA); PG8_STAGE(PG8_SA(0, 1), cA + hstep, voffA);
        if (wr == 1) PG8_BAR;
        PG8_WAIT_V(2); PG8_BAR;
        PG8_STAGE(PG8_SB(1, 0), cB + kstep, voffB); PG8_STAGE(PG8_SA(1, 0), cA + kstep, voffA); PG8_STAGE(PG8_SB(1, 1), cB + hstep + kstep, voffB);
        PG8_WAIT_V(6); PG8_BAR;
    } else {
        PG8_STAGE(PG8_SB(0, 0), cB, voffB); PG8_STAGE(PG8_SA(0, 0), cA, voffA); PG8_STAGE(PG8_SB(0, 1), cB + hstep, voffB); PG8_STAGE(PG8_SA(0, 1), cA + hstep, voffA);
        if (wr == 1) PG8_BAR;
        PG8_WAIT_V(4); PG8_BAR;
        PG8_STAGE(PG8_SB(1, 0), cB + kstep, voffB); PG8_STAGE(PG8_SA(1, 0), cA + kstep, voffA); PG8_STAGE(PG8_SB(1, 1), cB + hstep + kstep, voffB);
        PG8_WAIT_V(6); PG8_BAR;
    }
    for (;;) {
        const bool has_next = S.next(ui + 1, nxt);
        const char* nA = has_next ? (const char*)g.A + (size_t)nxt.pm * tstep : cA; const char* nB = has_next ? (const char*)g.Bt + (size_t)nxt.pn * tstep : cB;
        for (int t = 0; t < nt; t += 2) {
            const bool last = (t == nt - 2);
            const char* a1 = cA + (size_t)(t + 1) * kstep;
            const char* a2 = last ? nA : cA + (size_t)(t + 2) * kstep; const char* b2 = last ? nB : cB + (size_t)(t + 2) * kstep;
            const char* a3 = a2 + kstep; const char* b3 = b2 + kstep;
            if (last && has_next) S.a_ready(nxt);
            if constexpr (SP2) {
            PG8_LDB(B0, 0, 0); PG8_LDB(B1, 0, 1); PG8_SCHED; PG8_LDA(At, 0, 0); PG8_STAGE(PG8_SA(1, 1), a1 + hstep, voffA);
            PG8_WAIT_V(8); PG8_WAIT_L(0); PG8_BAR; PG8_MMA(0, 0, At, B0); PG8_MMA(0, 1, At, B1); PG8_BAR; PG8_SCHED;
            PG8_LDA(At, 0, 1); PG8_STAGE(PG8_SB(0, 0), b2, voffB); PG8_STAGE(PG8_SB(0, 1), b2 + hstep, voffB); PG8_STAGE(PG8_SA(0, 0), a2, voffA);
            PG8_WAIT_V(8); PG8_WAIT_L(0); PG8_BAR; PG8_MMA(1, 0, At, B0); PG8_MMA(1, 1, At, B1); PG8_BAR; PG8_SCHED;
            PG8_LDB(B0, 1, 0); PG8_LDB(B1, 1, 1); PG8_SCHED; PG8_LDA(At, 1, 0); PG8_STAGE(PG8_SA(0, 1), a2 + hstep, voffA);
            PG8_WAIT_V(8); PG8_WAIT_L(0); PG8_BAR; PG8_MMA(0, 0, At, B0); PG8_MMA(0, 1, At, B1); PG8_BAR; PG8_SCHED;
            PG8_LDA(At, 1, 1); PG8_STAGE(PG8_SB(1, 0), b3, voffB); PG8_STAGE(PG8_SB(1, 1), b3 + hstep, voffB); PG8_STAGE(PG8_SA(1, 0), a3, voffA);
            PG8_WAIT_V(8); PG8_WAIT_L(0); PG8_BAR; PG8_MMA(1, 0, At, B0); PG8_MMA(1, 1, At, B1); PG8_BAR; PG8_SCHED;
            } else {
            PG8_LDB(B0, 0, 0); PG8_SCHED; PG8_LDA(At, 0, 0); PG8_STAGE(PG8_SA(1, 1), a1 + hstep, voffA);
            PG8_WAIT_L(8); PG8_BAR; PG8_WAIT_L(0); PG8_MMA(0, 0, At, B0); PG8_BAR; PG8_SCHED;
            PG8_LDB(B1, 0, 1); PG8_STAGE(PG8_SB(0, 0), b2, voffB);
            PG8_BAR; PG8_WAIT_L(0); PG8_MMA(0, 1, At, B1); PG8_BAR;
            PG8_LDA(At, 0, 1); PG8_STAGE(PG8_SA(0, 0), a2, voffA);
            PG8_BAR; PG8_WAIT_L(0); PG8_MMA(1, 0, At, B0); PG8_BAR; PG8_SCHED;
            PG8_STAGE(PG8_SB(0, 1), b2 + hstep, voffB);
            PG8_WAIT_V(6); PG8_BAR; PG8_MMA(1, 1, At, B1); PG8_BAR;
            PG8_LDB(B0, 1, 0); PG8_SCHED; PG8_LDA(At, 1, 0); PG8_STAGE(PG8_SA(0, 1), a2 + hstep, voffA);
            PG8_WAIT_L(8); PG8_BAR; PG8_WAIT_L(0); PG8_MMA(0, 0, At, B0); PG8_BAR; PG8_SCHED;
            PG8_LDB(B1, 1, 1); PG8_STAGE(PG8_SB(1, 0), b3, voffB);
            PG8_BAR; PG8_WAIT_L(0); PG8_MMA(0, 1, At, B1); PG8_BAR;
            PG8_LDA(At, 1, 1); PG8_STAGE(PG8_SA(1, 0), a3, voffA);
            PG8_BAR; PG8_WAIT_L(0); PG8_MMA(1, 0, At, B0); PG8_BAR; PG8_SCHED;
            PG8_STAGE(PG8_SB(1, 1), b3 + hstep, voffB);
            PG8_WAIT_V(6); PG8_BAR; PG8_MMA(1, 1, At, B1); PG8_BAR;
            }
        }
        if constexpr (ALIGN_EPI) { if (wr == 0) PG8_BAR; }
        if constexpr (!Epi::AFTER_DRAIN) { E(acc, cur, wr, wc, fr, fq); S.done(cur); }
        if (!has_next) break;
#pragma unroll
        for (int a = 0; a < 2; ++a)
#pragma unroll
            for (int b = 0; b < 2; ++b)
#pragma unroll
                for (int m = 0; m < 4; ++m)
#pragma unroll
                    for (int n = 0; n < 2; ++n) acc[a][b][m][n] = (f32x4){0.f, 0.f, 0.f, 0.f};
        cur = nxt; cA = nA; cB = nB; ++ui;
        if constexpr (ALIGN_EPI) { if (wr == 1) PG8_BAR; }
    }
    PG8_WAIT_V(0);
    if constexpr (!ALIGN_EPI) { if (wr == 0) PG8_BAR; }
    PG8_BAR;
#undef PG8_SA
#undef PG8_SB
#undef PG8_STAGE
#undef PG8_LDA
#undef PG8_LDB
#undef PG8_MMA
#undef PG8_WAIT_V
#undef PG8_WAIT_L
#undef PG8_BAR
#undef PG8_SCHED
}
}

constexpr int NWAVES = 8, NTHR = NWAVES * 64;
constexpr int NB = 8, SEQ = 2048, D = 1024, M = NB * SEQ;
constexpr int INC = 3088;
constexpr int NU = 3328;
constexpr int UQ = 0, UK = 256, UV = 512, UGQ = 768, UGK = 1024, UGV = 1280, UGR = 1792, UCI = 2304, UCB = 2560, UCC = 2816, ULA = 3072;
constexpr int FF = 2816, FE = 3584, NE = 8;
constexpr int MAXPAN = 136, MAXROWS = MAXPAN * 256;
constexpr float LOG2E = 1.4426950408889634f;
constexpr float QS_ATT = 0.125f * LOG2E;

constexpr size_t MiB = 1u << 20;
constexpr size_t WS_CTL = 0, CTL_ZERO_BYTES = 1 * MiB;
constexpr size_t WS_SS = 1 * MiB;
constexpr size_t WS_BL = 2 * MiB;
constexpr size_t WS_DEC = 2 * MiB + 64 * 1024;
constexpr size_t WS_TOPI = 3 * MiB;
constexpr size_t WS_TOPW = 3 * MiB + 128 * 1024;
constexpr size_t WS_POS = 3 * MiB + 256 * 1024;
constexpr size_t WS_RS3 = 3 * MiB + 384 * 1024;
constexpr size_t WS_CNT = 3 * MiB + 448 * 1024;
constexpr size_t WS_PANE = 3 * MiB + 456 * 1024;
constexpr size_t WS_ROWGATE = 4 * MiB;
constexpr size_t WS_ROWRS = 4 * MiB + 256 * 1024;
constexpr size_t WS_WE13 = 8 * MiB;
constexpr size_t WS_Y = WS_WE13;
constexpr size_t WS_XS = 120 * MiB;
constexpr size_t WS_WE2 = WS_XS;
constexpr size_t WS_HE = 188 * MiB;
constexpr size_t WS_WIN = WS_HE;
constexpr size_t WS_WOUT = WS_HE + 13 * MiB;
constexpr size_t WS_W13 = WS_HE + 17 * MiB;
constexpr size_t WS_W2 = WS_HE + 28 * MiB;
constexpr size_t WS_XB = WS_HE + 34 * MiB;
constexpr size_t WS_U = WS_HE + 66 * MiB;
constexpr size_t WS_H = WS_U;
constexpr size_t WS_MIX = WS_HE + 170 * MiB;
constexpr size_t WS_CST = WS_HE + 202 * MiB;
constexpr size_t WS_END = WS_HE + 238 * MiB;
static_assert(WS_CST + 32 * MiB <= WS_END, "ws map");
constexpr int CW_BAR = 4096;

constexpr int LDS_BYTES = 147456;
constexpr int LDSCTL_OFF = 131072 + 14 * 1024, MISC_OFF = LDSCTL_OFF + 320;

#define GAS __attribute__((address_space(1)))
#define LAS __attribute__((address_space(3)))
typedef unsigned short bf16;
typedef float f32x4 __attribute__((ext_vector_type(4)));
typedef unsigned v4u __attribute__((ext_vector_type(4)));
__device__ __forceinline__ unsigned f2bf(float f) { unsigned u = __builtin_bit_cast(unsigned, f); return (u + 0x7fffu + ((u >> 16) & 1u)) >> 16; }
__device__ __forceinline__ unsigned pk2(float lo, float hi) { return f2bf(lo) | (f2bf(hi) << 16); }
__device__ __forceinline__ float bf2f(unsigned short b) { return __builtin_bit_cast(float, (unsigned)b << 16); }
__device__ __forceinline__ float bflo(unsigned w) { return __builtin_bit_cast(float, w << 16); }
__device__ __forceinline__ float bfhi(unsigned w) { return __builtin_bit_cast(float, w & 0xffff0000u); }
__device__ __forceinline__ float wave_sum(float v) {
#pragma unroll
    for (int o = 1; o < 64; o <<= 1) v += __shfl_xor(v, o);
    return v;
}
__device__ __forceinline__ float wave_max(float v) {
#pragma unroll
    for (int o = 1; o < 64; o <<= 1) v = fmaxf(v, __shfl_xor(v, o));
    return v;
}

#define XB_TMO      128
#define XB_XCNT(j)  (256  + 64 * (j))
#define XB_XSUB(j)  (1280 + 64 * (j))
#define XB_XGEN(j)  (2304 + 64 * (j))
#define XB_TOP      3328
#define XB_TOPGEN   3392
#define XCD_BAR_WORDS 3456
#define XB_SPIN_CAP (1u << 18)
__device__ __forceinline__ unsigned xb_ld(unsigned* p)              { return __hip_atomic_load(p, __ATOMIC_RELAXED, __HIP_MEMORY_SCOPE_AGENT); }
__device__ __forceinline__ unsigned xb_add(unsigned* p, unsigned v) { return __hip_atomic_fetch_add(p, v, __ATOMIC_RELAXED, __HIP_MEMORY_SCOPE_AGENT); }
__device__ __forceinline__ unsigned xb_xcc_id() { return (unsigned)__builtin_amdgcn_s_getreg((3 << 11) | 20) & 0xFu; }
#define XB_SPIN(cond, bar) do { unsigned _sp = 0; while (cond) { __builtin_amdgcn_s_sleep(1); \
    if ((++_sp & 255u) == 0u) { if (xb_ld(&(bar)[XB_TMO])) break; if (_sp > XB_SPIN_CAP) { atomicAdd(&(bar)[XB_TMO], 1u); break; } } } } while (0)
struct XcdBarrier { unsigned* bar; unsigned x; volatile LAS unsigned* st; };
__device__ __forceinline__ XcdBarrier xcd_barrier_post(unsigned* bar, volatile LAS unsigned* st) {
    XcdBarrier b; b.bar = bar; b.x = xb_xcc_id(); b.st = st;
    if (threadIdx.x == 0) (void)xb_add(&bar[XB_XCNT(b.x)], 1u);
    return b;
}
__device__ __forceinline__ void xcd_barrier_complete(unsigned* bar, unsigned x, unsigned& nloc, unsigned& nx) {
    const unsigned G = gridDim.x * gridDim.y * gridDim.z;
    unsigned sum, cnt, mine, sp = 0u;
    for (;;) {
        sum = 0u; cnt = 0u; mine = 0u;
#pragma unroll
        for (unsigned j = 0; j < 16; ++j) { const unsigned c = xb_ld(&bar[XB_XCNT(j)]); sum += c; cnt += (c > 0u) ? 1u : 0u; mine = (j == x) ? c : mine; }
        if (sum == G) break;
        __builtin_amdgcn_s_sleep(1);
        if ((++sp & 255u) == 0u) { if (xb_ld(&bar[XB_TMO])) break; if (sp > XB_SPIN_CAP) { atomicAdd(&bar[XB_TMO], 1u); break; } }
    }
    nloc = mine > 0u ? mine : 1u; nx = cnt > 0u ? cnt : 1u;
}
__device__ __forceinline__ void xcd_barrier(const XcdBarrier& b) {
    asm volatile("s_waitcnt vmcnt(0)" ::: "memory");
    __syncthreads();
    if (threadIdx.x == 0) {
        unsigned* bar = b.bar;
        __builtin_amdgcn_s_waitcnt(0);
        unsigned nloc = b.st[0], nx = b.st[1];
        if (nloc == 0u) { xcd_barrier_complete(bar, b.x, nloc, nx); b.st[0] = nloc; b.st[1] = nx; }
        const unsigned old = xb_add(&bar[XB_XSUB(b.x)], 1u);
        const unsigned gen = old / nloc;
        if (old + 1u == (gen + 1u) * nloc) {
            __builtin_amdgcn_fence(__ATOMIC_RELEASE, "agent");
            asm volatile("s_waitcnt vmcnt(0)" ::: "memory");
            const unsigned og = xb_add(&bar[XB_TOP], 1u);
            const unsigned tg = og / nx;
            if (og + 1u == (tg + 1u) * nx) xb_add(&bar[XB_TOPGEN], 1u);
            else XB_SPIN(xb_ld(&bar[XB_TOPGEN]) == tg, bar);
            __builtin_amdgcn_fence(__ATOMIC_ACQUIRE, "agent");
            xb_add(&bar[XB_XGEN(b.x)], 1u);
            asm volatile("s_waitcnt vmcnt(0)" ::: "memory");
        } else {
            XB_SPIN(xb_ld(&bar[XB_XGEN(b.x)]) == gen, bar);
            __builtin_amdgcn_fence(__ATOMIC_ACQUIRE, "agent");
            asm volatile("s_waitcnt vmcnt(0)" ::: "memory");
        }
    }
    __syncthreads();
}

struct Args {
    const float* x; const float* w_mix_in; const float* w_mix_out; const float* g_mix; const float* rel_bias; const float* gla_w_gate; const float* gla_b_gate;
    const float* gla_g_norm; const float* conv_w; const float* g_ffn; const float* ffn_w1; const float* ffn_w3; const float* ffn_w2; const float* moe_router;
    const float* moe_w1; const float* moe_w3; const float* moe_w2; const float* g_final;
    float* out; unsigned char* ws; int ph_lo, ph_hi, li, pad;
};

__device__ __forceinline__ void transpose_tile(const float* src, int ldsrc, int k0, int n0, bf16* dst, int ldd, int drow0, const float* ksc, unsigned* scr, int lane) {
    const int nq = lane & 15, kk = lane >> 4;
#pragma unroll
    for (int i = 0; i < 8; ++i) { const int k = 8 * i + 2 * kk; const float* p = src + (size_t)(k0 + k) * ldsrc + n0 + 4 * nq;
        const f32x4 r0 = *(const f32x4*)p, r1 = *(const f32x4*)(p + ldsrc);
        const float s0 = ksc ? ksc[k0 + k] : 1.f, s1 = ksc ? ksc[k0 + k + 1] : 1.f;
#pragma unroll
        for (int j = 0; j < 4; ++j) scr[(4 * nq + j) * 33 + 4 * i + kk] = pk2(r0[j] * s0, r1[j] * s1); }
    asm volatile("s_waitcnt lgkmcnt(0)" ::: "memory");
#pragma unroll 8
    for (int i2 = 0; i2 < 32; ++i2) { const int n = 2 * i2 + (lane >> 5), d = lane & 31;
        ((unsigned*)(dst + (size_t)(drow0 + n) * ldd + k0))[d] = scr[n * 33 + d]; }
    asm volatile("s_waitcnt lgkmcnt(0)" ::: "memory");
}
__device__ __forceinline__ void glr_tile(const float* win, const float* wg, const float* g, int k0, int n0, bf16* dst, int drow0, int lane) {
    float w[16];
#pragma unroll
    for (int r = 0; r < 16; ++r) w[r] = wg[r * 256 + n0 + lane];
    unsigned* drow = (unsigned*)(dst + (size_t)(drow0 + n0 + lane) * 1024 + k0);
    for (int kp = 0; kp < 32; ++kp) { float v[2];
#pragma unroll
        for (int q = 0; q < 2; ++q) { const int k = k0 + 2 * kp + q; const float* s = win + (size_t)k * INC + 2304; float a = 0.f;
#pragma unroll
            for (int r = 0; r < 16; ++r) a += s[r] * w[r];
            v[q] = a * g[k]; }
        drow[kp] = pk2(v[0], v[1]); }
}
__device__ __forceinline__ int rel_bucket(int d) {
    if (d < 16) return d;
    const float lr = logf((float)d / 16.0f) / logf(128.0f);
    int b = 16 + (int)(lr * 16.0f); return b < 31 ? b : 31;
}


typedef short bf16x8 __attribute__((ext_vector_type(8)));
typedef short v4i16_t __attribute__((ext_vector_type(4)));
#define MFMA16(a, b, c) __builtin_amdgcn_mfma_f32_16x16x32_bf16((a), (b), (c), 0, 0, 0)
__device__ __forceinline__ v4i16_t tr16(LAS unsigned char* p) { return __builtin_amdgcn_ds_read_tr16_b64_v4i16((LAS v4i16_t*)p); }
__device__ __forceinline__ bf16x8 cat8(v4i16_t lo, v4i16_t hi) { return __builtin_shufflevector(lo, hi, 0, 1, 2, 3, 4, 5, 6, 7); }
__device__ __forceinline__ bf16x8 frag_rm(LAS unsigned char* base, int pitch, int c0, int k0, int lane) { return *(LAS bf16x8*)(base + (c0 + (lane & 15)) * pitch + (k0 + 8 * (lane >> 4)) * 2); }
__device__ __forceinline__ bf16x8 frag_tr(LAS unsigned char* base, int pitch, int c0, int k0, int lane) {
    const int i = lane & 15, g = lane >> 4; LAS unsigned char* p = base + (k0 + 8 * g + (i >> 2)) * pitch + (c0 + 4 * (i & 3)) * 2;
    return cat8(tr16(p), tr16(p + 4 * pitch)); }
__device__ __forceinline__ bf16x8 frag_trp(LAS unsigned char* base, int pitch, int c0, int k0, int lane) {
    const int i = lane & 15, g = lane >> 4; LAS unsigned char* p = base + (k0 + 4 * g + (i >> 2)) * pitch + (c0 + 4 * (i & 3)) * 2;
    return cat8(tr16(p), tr16(p + 16 * pitch)); }
__device__ __forceinline__ bf16x8 pack8(const f32x4& a, const f32x4& b) {
    v4u w; w.x = pg8::cvt_pk_bf16(a[0], a[1]); w.y = pg8::cvt_pk_bf16(a[2], a[3]); w.z = pg8::cvt_pk_bf16(b[0], b[1]); w.w = pg8::cvt_pk_bf16(b[2], b[3]); return __builtin_bit_cast(bf16x8, w); }

struct Ctx { Args args; int tid, lane, wave, G, bx, gw, NGW, lo, hi; XcdBarrier bar; };
#define GRID_BAR() do { if (MK_N_LAUNCHES == 1) xcd_barrier(bar); } while (0)
#define IN(k) (lo <= (k) && (k) < hi)
#define SEAM(k) do { if (IN(k) && IN((k) + 1)) GRID_BAR(); } while (0)
#define WS_PTRS \
    float* SS = (float*)(ws + WS_SS); float* BL = (float*)(ws + WS_BL); float* DEC = (float*)(ws + WS_DEC); \
    bf16* XB = (bf16*)(ws + WS_XB); bf16* U = (bf16*)(ws + WS_U); bf16* MIX = (bf16*)(ws + WS_MIX); float* CST = (float*)(ws + WS_CST); \
    bf16* H = (bf16*)(ws + WS_H); bf16* W13 = (bf16*)(ws + WS_W13); bf16* W2 = (bf16*)(ws + WS_W2); \
    bf16* WE13 = (bf16*)(ws + WS_WE13); bf16* WE2 = (bf16*)(ws + WS_WE2); bf16* XS = (bf16*)(ws + WS_XS); bf16* HE = (bf16*)(ws + WS_HE); bf16* Y = (bf16*)(ws + WS_Y); \
    int* TOPI = (int*)(ws + WS_TOPI); float* TOPW = (float*)(ws + WS_TOPW); int* POS = (int*)(ws + WS_POS); float* RS3 = (float*)(ws + WS_RS3); \
    int* CNT = (int*)(ws + WS_CNT); int* PANE = (int*)(ws + WS_PANE); float* ROWGATE = (float*)(ws + WS_ROWGATE); float* ROWRS = (float*)(ws + WS_ROWRS); \
    float* X = args.out; \
    (void)SS; (void)BL; (void)DEC; (void)XB; (void)U; (void)MIX; (void)CST; (void)H; (void)W13; (void)W2; (void)WE13; (void)WE2; (void)XS; (void)HE; (void)Y; \
    (void)TOPI; (void)TOPW; (void)POS; (void)RS3; (void)CNT; (void)PANE; (void)ROWGATE; (void)ROWRS; (void)X;

template <int layer> __device__ __forceinline__ void layer_phases(const Ctx& c, unsigned char* lds) {
    const Args& args = c.args; LAS unsigned char* ldsl = (LAS unsigned char*)lds;
    const int tid = c.tid, lane = c.lane, wave = c.wave, G = c.G, bx = c.bx, gw = c.gw, NGW = c.NGW, lo = c.lo, hi = c.hi; const XcdBarrier bar = c.bar;
    unsigned char* ws = args.ws;
    WS_PTRS
    (void)tid; (void)lane; (void)wave; (void)gw; (void)NGW;
        const int pb = 1 + 16 * layer;
        if (IN(pb + 0)) {
            pg8::Gemm g{XB, (const bf16*)(ws + WS_WIN) + (size_t)layer * NU * D, M, NU, D}; pg8::StaticOrder S; S.init(M, NU, G, bx);
            pg8::EpiU E{U, NU, SS, args.gla_b_gate + layer * 256, QS_ATT};
            pg8::gemm_phase<pg8::EpiU, pg8::StaticOrder, true, true>(ldsl, g, S, E);
        }
        SEAM(pb + 0);
        if (IN(pb + 1)) {
            float* cum = (float*)lds; float* seg = cum + 4096;
            LAS unsigned char* kdl = ldsl + 18432;
            LAS unsigned char* vvl = ldsl + 27648;
            for (int u = bx; u < 1024; u += G) {
                const int h = u & 3, n = (u >> 2) & 31, b = u >> 7; const size_t row0 = (size_t)b * SEQ + n * 64;
                { float c = 0.f;
#pragma unroll
                  for (int i = 0; i < 8; ++i) { const int t = 8 * wave + i; c += bf2f(U[(row0 + t) * NU + ULA + h * 64 + lane]); cum[t * 64 + lane] = c; }
                  seg[wave * 64 + lane] = c; }
                __syncthreads();
                { float off = 0.f, last = 0.f;
#pragma unroll
                  for (int w = 0; w < 8; ++w) { const float s = seg[w * 64 + lane]; last += s; if (w < wave) off += s; }
#pragma unroll
                  for (int i = 0; i < 8; ++i) { const int t = 8 * wave + i; const float cm = cum[t * 64 + lane] + off;
                      *(LAS unsigned short*)(kdl + t * 144 + lane * 2) = (unsigned short)f2bf(bf2f(U[(row0 + t) * NU + UGK + h * 64 + lane]) * __expf(last - cm)); }
                  if (wave == 0) DEC[u * 64 + lane] = __expf(last);
                  const int vr = tid >> 3, ch = tid & 7; const v4u* vp = (const v4u*)(U + (row0 + vr) * NU + UGV + h * 128 + ch * 16);
                  const v4u x0 = vp[0], x1 = vp[1]; LAS v4u* vd = (LAS v4u*)(vvl + vr * 272 + ch * 32); vd[0] = x0; vd[1] = x1; }
                __syncthreads();
                { f32x4 acc[4];
#pragma unroll
                  for (int kt = 0; kt < 4; ++kt) acc[kt] = (f32x4){0.f, 0.f, 0.f, 0.f};
#pragma unroll
                  for (int ks = 0; ks < 2; ++ks) { const bf16x8 a = frag_tr(vvl, 272, 16 * wave, 32 * ks, lane);
#pragma unroll
                      for (int kt = 0; kt < 4; ++kt) { const bf16x8 bq = frag_tr(kdl, 144, 16 * kt, 32 * ks, lane); acc[kt] = MFMA16(a, bq, acc[kt]); } }
                  const int g4 = lane >> 4, ql = lane & 15;
#pragma unroll
                  for (int kt = 0; kt < 4; ++kt)
#pragma unroll
                      for (int rg = 0; rg < 4; ++rg) CST[((size_t)u * 128 + 16 * wave + 4 * g4 + rg) * 64 + 16 * kt + ql] = acc[kt][rg]; }
                __syncthreads();
            }
            const float* cw = args.conv_w + layer * 3 * 256;
            for (int it = bx * NTHR + tid; it < M * 32; it += G * NTHR) {
                const int row = it >> 5, c0 = (it & 31) * 8, t = row & (SEQ - 1);
                const bf16* ur = U + (size_t)row * NU;
                const v4u cb = *(const v4u*)(ur + UCB + c0);
                v4u ci[3], cc[3];
#pragma unroll
                for (int d = 0; d < 3; ++d) { if (t >= d) { ci[d] = *(const v4u*)(ur - (size_t)d * NU + UCI + c0); cc[d] = *(const v4u*)(ur - (size_t)d * NU + UCC + c0); } else { ci[d] = (v4u){0u, 0u, 0u, 0u}; cc[d] = ci[d]; } }
                float o[8];
#pragma unroll
                for (int j = 0; j < 4; ++j) {
                    float a0 = 0.f, a1 = 0.f;
#pragma unroll
                    for (int d = 0; d < 3; ++d) { const float w0 = cw[(2 - d) * 256 + c0 + 2 * j], w1 = cw[(2 - d) * 256 + c0 + 2 * j + 1];
                        a0 += w0 * (bflo(cc[d][j]) * bflo(ci[d][j])); a1 += w1 * (bfhi(cc[d][j]) * bfhi(ci[d][j])); }
                    o[2 * j] = bflo(cb[j]) * a0; o[2 * j + 1] = bfhi(cb[j]) * a1; }
                v4u w; w.x = pk2(o[0], o[1]); w.y = pk2(o[2], o[3]); w.z = pk2(o[4], o[5]); w.w = pk2(o[6], o[7]);
                *(v4u*)(MIX + (size_t)row * D + 768 + c0) = w;
            }
            __syncthreads();
            {
                float* BLl = (float*)lds;
                for (int i = tid; i < 4 * 2049; i += NTHR) BLl[(i & 3) * 2049 + (i >> 2)] = BL[i];
                __syncthreads();
                LAS unsigned char* vst = ldsl + 33280 + wave * 5120;
                const int ql = lane & 15, g4 = lane >> 4;
                for (int uu = bx; uu < 512; uu += G) {
                    int u = uu; if (G == 256) { const int j = (uu & 255) >> 3; u = ((((uu >> 8) * 16 + (uu & 7) * 2 + (j >> 4)) << 4) | (j & 15)); }
                    const int c = u & 15, h = (u >> 4) & 3, b = u >> 6; const int i0 = 16 * wave; const size_t rowb = (size_t)b * SEQ;
                    const int tq = c + 16 * (i0 + ql);
                    const bf16* ub = U + rowb * NU + h * 64;
                    const bf16x8 qf0 = *(const bf16x8*)(ub + (size_t)tq * NU + UQ + 8 * g4), qf1 = *(const bf16x8*)(ub + (size_t)tq * NU + UQ + 8 * g4 + 32);
                    const float* blh = BLl + h * 2049;
                    const int t0 = c + 16 * i0, t1 = t0 + 240;
                    const int base0 = ((t0 >> 4) - 128) & ~31, mhi0 = t1 >> 4, np0 = ((mhi0 - base0) >> 5) + 1, pz0 = base0 < 0 ? ((-base0) >> 5) : 0;
                    const int base1 = ((t0 >> 2) - 128) & ~31, mhi1 = t1 >> 2, np1 = ((mhi1 - base1) >> 5) + 1, pz1 = base1 < 0 ? ((-base1) >> 5) : 0;
                    const int base2 = (t0 - 128) & ~31, mhi2 = t1, np2 = ((mhi2 - base2) >> 5) + 1, pz2 = base2 < 0 ? ((-base2) >> 5) : 0;
                    const int n0 = np0 - pz0, n1 = np1 - pz1, n2 = np2 - pz2, NT = n0 + n1 + n2;
                    bf16x8 kc[2][2], kn[2][2]; v4u vc[4], vn[4];
#define ATT_ITEM(it, LR, MB, MHI, RHO) do { if ((it) < n0) { LR = 4; MB = base0 + 32 * (np0 - 1 - (it)); MHI = mhi0; RHO = c; } \
                        else if ((it) < n0 + n1) { LR = 2; MB = base1 + 32 * (pz1 + (it) - n0); MHI = mhi1; RHO = c & 3; } \
                        else { LR = 0; MB = base2 + 32 * (pz2 + (it) - n0 - n1); MHI = mhi2; RHO = 0; } } while (0)
#define ATT_LOAD(K_, V_, LR, MB, MHI, RHO) do { _Pragma("unroll") for (int tau = 0; tau < 2; ++tau) { int mk = (MB) + 16 * tau + ql; mk = mk < 0 ? 0 : (mk > (MHI) ? (MHI) : mk); \
                            const bf16* kp = ub + (size_t)((mk << (LR)) + (RHO)) * NU + UK + 8 * g4; K_[tau][0] = *(const bf16x8*)kp; K_[tau][1] = *(const bf16x8*)(kp + 32); } \
                        { int mv = (MB) + (lane >> 1); mv = mv < 0 ? 0 : (mv > (MHI) ? (MHI) : mv); const v4u* vp = (const v4u*)(ub + (size_t)((mv << (LR)) + (RHO)) * NU + UV + 32 * (lane & 1)); \
                          V_[0] = vp[0]; V_[1] = vp[1]; V_[2] = vp[2]; V_[3] = vp[3]; } } while (0)
                    int lr, mb, mhi, rho; ATT_ITEM(0, lr, mb, mhi, rho); ATT_LOAD(kc, vc, lr, mb, mhi, rho);
                    float m_ref = -INFINITY, l_run = 0.f; f32x4 o[4];
#pragma unroll
                    for (int d = 0; d < 4; ++d) o[d] = (f32x4){0.f, 0.f, 0.f, 0.f};
                    for (int it = 0; it < NT; ++it) {
                        int lrn = lr, mbn = mb, mhin = mhi, rhon = rho;
                        if (it + 1 < NT) { ATT_ITEM(it + 1, lrn, mbn, mhin, rhon); ATT_LOAD(kn, vn, lrn, mbn, mhin, rhon); }
                        { LAS v4u* vd = (LAS v4u*)(vst + (lane >> 1) * 160 + (lane & 1) * 64); vd[0] = vc[0]; vd[1] = vc[1]; vd[2] = vc[2]; vd[3] = vc[3]; }
                        f32x4 s[2];
#pragma unroll
                        for (int tau = 0; tau < 2; ++tau) { s[tau] = MFMA16(kc[tau][0], qf0, ((f32x4){0.f, 0.f, 0.f, 0.f})); s[tau] = MFMA16(kc[tau][1], qf1, s[tau]); }
                        const int d0 = (tq >> lr) - mb - 4 * g4, k0 = mb + 4 * g4; float tmax = -INFINITY;
#pragma unroll
                        for (int tau = 0; tau < 2; ++tau)
#pragma unroll
                            for (int rg = 0; rg < 4; ++rg) { const int dist = d0 - (16 * tau + rg); const bool ok = ((unsigned)dist <= 128u) && (k0 + 16 * tau + rg >= 0);
                                const float bias = blh[ok ? (dist << lr) : 0]; const float v = ok ? s[tau][rg] + bias : -INFINITY; s[tau][rg] = v; tmax = fmaxf(tmax, v); }
                        if (__any(tmax > m_ref + 16.0f)) {
                            float tm = fmaxf(tmax, __shfl_xor(tmax, 16)); tm = fmaxf(tm, __shfl_xor(tm, 32));
                            const float mn = fmaxf(m_ref, tm); const float ms = (mn == -INFINITY) ? 0.f : mn; const float alpha = __builtin_amdgcn_exp2f(m_ref - ms); m_ref = ms;
                            l_run *= alpha;
#pragma unroll
                            for (int d = 0; d < 4; ++d) o[d] = o[d] * alpha;
                        }
                        float ps = 0.f;
#pragma unroll
                        for (int tau = 0; tau < 2; ++tau)
#pragma unroll
                            for (int rg = 0; rg < 4; ++rg) { const float p = __builtin_amdgcn_exp2f(s[tau][rg] - m_ref); s[tau][rg] = p; ps += p; }
                        l_run += ps;
                        const bf16x8 pb = pack8(s[0], s[1]);
                        asm volatile("" ::: "memory");
#pragma unroll
                        for (int d = 0; d < 4; ++d) { const bf16x8 va = frag_trp(vst, 160, 16 * d, 0, lane); o[d] = MFMA16(va, pb, o[d]); }
                        asm volatile("" ::: "memory");
#pragma unroll
                        for (int tau = 0; tau < 2; ++tau) { kc[tau][0] = kn[tau][0]; kc[tau][1] = kn[tau][1]; }
#pragma unroll
                        for (int j = 0; j < 4; ++j) vc[j] = vn[j];
                        lr = lrn; mb = mbn; mhi = mhin; rho = rhon;
                    }
#undef ATT_ITEM
#undef ATT_LOAD
                    l_run += __shfl_xor(l_run, 16); l_run += __shfl_xor(l_run, 32); const float inv = 1.0f / l_run;
                    bf16* op = MIX + (rowb + tq) * D + h * 64 + 4 * g4;
#pragma unroll
                    for (int d = 0; d < 4; ++d) { pg8::u32x2 w; w.x = pg8::cvt_pk_bf16(o[d][0] * inv, o[d][1] * inv); w.y = pg8::cvt_pk_bf16(o[d][2] * inv, o[d][3] * inv); *(pg8::u32x2*)(op + 16 * d) = w; }
                }
            }
        }
        SEAM(pb + 1);
        if (IN(pb + 2)) {
            for (int e = bx * NTHR + tid; e < NB * 4 * 8192; e += G * NTHR) {
                const int k = e & 63, v = (e >> 6) & 127, h = (e >> 13) & 3, b = e >> 15; float cc[32], dd[32];
                float* cp = CST + ((size_t)(b * 128 + h) * 128 + v) * 64 + k; const float* dp = DEC + (b * 128 + h) * 64 + k;
#pragma unroll
                for (int n = 0; n < 32; ++n) { cc[n] = cp[(size_t)n * 4 * 8192]; dd[n] = dp[n * 4 * 64]; }
                float S = 0.f;
#pragma unroll
                for (int n = 0; n < 32; ++n) { cp[(size_t)n * 4 * 8192] = S; S = dd[n] * S + cc[n]; }
            }
        }
        SEAM(pb + 2);
        if (IN(pb + 3)) {
            float* cum = (float*)lds; float* seg = cum + 4096;
            LAS unsigned char* qel = ldsl + 18432;
            LAS unsigned char* kel = ldsl + 27648;
            LAS unsigned char* vvl = ldsl + 36864;
            LAS unsigned char* stl = ldsl + 54272;
            float* rsq = (float*)(lds + 72704);
            const float* gn = args.gla_g_norm + layer * 128;
            for (int u = bx; u < 1024; u += G) {
                const int h = u & 3, n = (u >> 2) & 31, b = u >> 7; const size_t row0 = (size_t)b * SEQ + n * 64;
                { float c = 0.f;
#pragma unroll
                  for (int i = 0; i < 8; ++i) { const int t = 8 * wave + i; c += bf2f(U[(row0 + t) * NU + ULA + h * 64 + lane]); cum[t * 64 + lane] = c; }
                  seg[wave * 64 + lane] = c; }
                __syncthreads();
                { float off = 0.f;
#pragma unroll
                  for (int w = 0; w < 8; ++w) { const float s = seg[w * 64 + lane]; if (w < wave) off += s; }
#pragma unroll
                  for (int i = 0; i < 8; ++i) { const int t = 8 * wave + i; const float cm = cum[t * 64 + lane] + off;
                      *(LAS unsigned short*)(qel + t * 144 + lane * 2) = (unsigned short)f2bf(bf2f(U[(row0 + t) * NU + UGQ + h * 64 + lane]) * __expf(cm));
                      *(LAS unsigned short*)(kel + t * 144 + lane * 2) = (unsigned short)f2bf(bf2f(U[(row0 + t) * NU + UGK + h * 64 + lane]) * __expf(-cm)); }
                  { const int vr = tid >> 3, ch = tid & 7; const v4u* vp = (const v4u*)(U + (row0 + vr) * NU + UGV + h * 128 + ch * 16);
                    const v4u x0 = vp[0], x1 = vp[1]; LAS v4u* vd = (LAS v4u*)(vvl + vr * 272 + ch * 32); vd[0] = x0; vd[1] = x1; }
                  { const int v = tid >> 2, kq = (tid & 3) * 16; const f32x4* sp = (const f32x4*)(CST + ((size_t)u * 128 + v) * 64 + kq);
                    const f32x4 a0 = sp[0], a1 = sp[1], a2 = sp[2], a3 = sp[3];
                    v4u w0, w1; w0.x = pk2(a0[0], a0[1]); w0.y = pk2(a0[2], a0[3]); w0.z = pk2(a1[0], a1[1]); w0.w = pk2(a1[2], a1[3]);
                    w1.x = pk2(a2[0], a2[1]); w1.y = pk2(a2[2], a2[3]); w1.z = pk2(a3[0], a3[1]); w1.w = pk2(a3[2], a3[3]);
                    LAS v4u* sd = (LAS v4u*)(stl + v * 144 + kq * 2); sd[0] = w0; sd[1] = w1; } }
                __syncthreads();
                { const int tt = wave & 3, vh = wave >> 2, ql = lane & 15, g4 = lane >> 4; const int t = 16 * tt + ql;
                  const bf16x8 qb0 = frag_rm(qel, 144, 16 * tt, 0, lane), qb1 = frag_rm(qel, 144, 16 * tt, 32, lane);
                  f32x4 sT[4];
#pragma unroll
                  for (int st = 0; st < 4; ++st) { sT[st] = (f32x4){0.f, 0.f, 0.f, 0.f};
                      if (st <= tt) { sT[st] = MFMA16(frag_rm(kel, 144, 16 * st, 0, lane), qb0, sT[st]); sT[st] = MFMA16(frag_rm(kel, 144, 16 * st, 32, lane), qb1, sT[st]);
#pragma unroll
                          for (int rg = 0; rg < 4; ++rg) if (16 * st + 4 * g4 + rg > t) sT[st][rg] = 0.f; } }
                  const bf16x8 pb0 = pack8(sT[0], sT[1]), pb1 = pack8(sT[2], sT[3]);
                  f32x4 acc[4]; float ss = 0.f;
#pragma unroll
                  for (int vt = 0; vt < 4; ++vt) { const int V0 = 16 * (4 * vh + vt); f32x4 a = (f32x4){0.f, 0.f, 0.f, 0.f};
                      a = MFMA16(frag_trp(vvl, 272, V0, 0, lane), pb0, a); a = MFMA16(frag_trp(vvl, 272, V0, 32, lane), pb1, a);
                      a = MFMA16(frag_rm(stl, 144, V0, 0, lane), qb0, a); a = MFMA16(frag_rm(stl, 144, V0, 32, lane), qb1, a);
                      acc[vt] = a; ss += (a[0] * a[0] + a[1] * a[1]) + (a[2] * a[2] + a[3] * a[3]); }
                  ss += __shfl_xor(ss, 16); ss += __shfl_xor(ss, 32);
                  if (g4 == 0) rsq[(tt * 2 + vh) * 16 + ql] = ss;
                  __syncthreads();
                  const float rs = 1.0f / sqrtf((rsq[(tt * 2) * 16 + ql] + rsq[(tt * 2 + 1) * 16 + ql]) * (1.0f / 128.0f) + pg8::RMS_EPS);
#pragma unroll
                  for (int vt = 0; vt < 4; ++vt) { const int v0 = 16 * (4 * vh + vt) + 4 * g4;
                      const pg8::u32x2 gr = *(const pg8::u32x2*)(U + (row0 + t) * NU + UGR + h * 128 + v0); const f32x4 gv = *(const f32x4*)(gn + v0);
                      const float o0 = acc[vt][0] * rs * gv[0] * pg8::silu_f(bflo(gr.x)), o1 = acc[vt][1] * rs * gv[1] * pg8::silu_f(bfhi(gr.x));
                      const float o2 = acc[vt][2] * rs * gv[2] * pg8::silu_f(bflo(gr.y)), o3 = acc[vt][3] * rs * gv[3] * pg8::silu_f(bfhi(gr.y));
                      pg8::u32x2 w; w.x = pg8::cvt_pk_bf16(o0, o1); w.y = pg8::cvt_pk_bf16(o2, o3);
                      *(pg8::u32x2*)(MIX + (row0 + t) * D + 256 + h * 128 + v0) = w; } }
                __syncthreads();
            }
        }
        SEAM(pb + 3);
        if (IN(pb + 4)) {
            pg8::Gemm g{MIX, (const bf16*)(ws + WS_WOUT) + (size_t)layer * D * D, M, D, D}; pg8::StaticOrder S; S.init(M, D, G, bx);
            pg8::EpiRes E{layer == 0 ? args.x : (const float*)X, X, XB, SS};
            pg8::gemm_phase<pg8::EpiRes, pg8::StaticOrder, true, true>(ldsl, g, S, E);
        }
        SEAM(pb + 4);
        if (layer == 0) {
            if (IN(pb + 5)) {
                pg8::Gemm g{XB, W13, M, 2 * FF, D}; pg8::StaticOrder S; S.init(M, 2 * FF, G, bx);
                pg8::EpiGlu<false> E{H, FF, SS};
                pg8::gemm_phase<pg8::EpiGlu<false>, pg8::StaticOrder, true, true>(ldsl, g, S, E);
            }
            SEAM(pb + 5);
            if (IN(pb + 6)) {
                pg8::Gemm g{H, W2, M, D, FF}; pg8::StaticOrder S; S.init(M, D, G, bx);
                pg8::EpiRes E{X, X, XB, SS};
                pg8::gemm_phase<pg8::EpiRes, pg8::StaticOrder, true, true>(ldsl, g, S, E);
            }
            SEAM(pb + 6);
        } else {
            if (IN(pb + 5)) {
                float* wr_l = (float*)lds;
                int* cnt_l = (int*)(lds + 32768);
                const float* gf = args.g_ffn + D;
                for (int i = tid; i < D * 8; i += NTHR) wr_l[i] = args.moe_router[i] * gf[i >> 3];
                if (tid < 8) cnt_l[tid] = 0;
                __syncthreads();
                for (int blk = bx; blk < 256; blk += G) {
                    if (blk != bx) { __syncthreads(); if (tid < 8) cnt_l[tid] = 0; __syncthreads(); }
                    for (int i = 0; i < 8; ++i) { const int m = blk * 64 + wave * 8 + i;
                        const f32x4* xr = (const f32x4*)(X + (size_t)m * D) + lane; float lg[8];
#pragma unroll
                        for (int e = 0; e < 8; ++e) lg[e] = 0.f;
#pragma unroll
                        for (int j = 0; j < 4; ++j) { const f32x4 v = xr[64 * j]; const int k0 = 4 * (lane + 64 * j);
#pragma unroll
                            for (int q = 0; q < 4; ++q) { const f32x4 w0 = *(const f32x4*)(wr_l + (k0 + q) * 8), w1 = *(const f32x4*)(wr_l + (k0 + q) * 8 + 4);
#pragma unroll
                                for (int e = 0; e < 4; ++e) { lg[e] += v[q] * w0[e]; lg[4 + e] += v[q] * w1[e]; } } }
                        const float rs = pg8::rstd_of(SS + (size_t)m * 16);
#pragma unroll
                        for (int e = 0; e < 8; ++e) lg[e] = wave_sum(lg[e]) * rs;
                        int i0 = 0; float v0 = lg[0];
#pragma unroll
                        for (int e = 1; e < 8; ++e) if (lg[e] > v0) { v0 = lg[e]; i0 = e; }
                        int i1 = -1; float v1 = -INFINITY;
#pragma unroll
                        for (int e = 0; e < 8; ++e) if (e != i0 && lg[e] > v1) { v1 = lg[e]; i1 = e; }
                        const float w1 = 1.0f / (1.0f + __expf(v0 - v1)), w0 = 1.0f - w1;
                        if (lane == 0) { TOPI[m * 2] = i0; TOPI[m * 2 + 1] = i1; TOPW[m * 2] = w0; TOPW[m * 2 + 1] = w1; RS3[m] = rs; atomicAdd(&cnt_l[i0], 1); atomicAdd(&cnt_l[i1], 1); } }
                    __syncthreads();
                    if (tid < 8) CNT[blk * 8 + tid] = cnt_l[tid];
                }
            }
            SEAM(pb + 5);
            if (IN(pb + 6)) {
                int* base_l = (int*)lds;
                int* pre_l = base_l + 8;
                int* tot_l = pre_l + 8;
                int* pos_l = tot_l + 8;
                int* ent_l = pos_l + 128;
                for (int blk = bx; blk < 256; blk += G) {
                    __syncthreads();
                    if (tid < 8) { tot_l[tid] = 0; pre_l[tid] = 0; }
                    if (tid < 128) ent_l[tid] = TOPI[blk * 128 + tid];
                    __syncthreads();
                    { const int g2 = tid >> 1, e0 = (tid & 1) * 4; const int4 c = *(const int4*)(CNT + g2 * 8 + e0);
                      atomicAdd(&tot_l[e0], c.x); atomicAdd(&tot_l[e0 + 1], c.y); atomicAdd(&tot_l[e0 + 2], c.z); atomicAdd(&tot_l[e0 + 3], c.w);
                      if (g2 < blk) { atomicAdd(&pre_l[e0], c.x); atomicAdd(&pre_l[e0 + 1], c.y); atomicAdd(&pre_l[e0 + 2], c.z); atomicAdd(&pre_l[e0 + 3], c.w); } }
                    __syncthreads();
                    if (tid == 0) { int bs = 0; for (int e = 0; e < 8; ++e) { base_l[e] = bs; bs += (tot_l[e] + 255) & ~255; } }
                    __syncthreads();
                    if (tid < 128) { const int e = ent_l[tid]; int rank = 0; for (int j = 0; j < tid; ++j) rank += (ent_l[j] == e) ? 1 : 0;
                        const int p = base_l[e] + pre_l[e] + rank; pos_l[tid] = p; POS[blk * 128 + tid] = p; ROWGATE[p] = TOPW[blk * 128 + tid]; ROWRS[p] = RS3[blk * 64 + (tid >> 1)]; }
                    if (blk == 0) {
                        for (int e = 0; e < 8; ++e) { const int npe = (tot_l[e] + 255) >> 8; for (int p = base_l[e] + tot_l[e] + tid; p < base_l[e] + npe * 256; p += NTHR) { ROWGATE[p] = 0.f; ROWRS[p] = 0.f; } }
                        if (tid == 0) { int np = 0; for (int e = 0; e < 8; ++e) { const int npe = (tot_l[e] + 255) >> 8; for (int j = 0; j < npe; ++j) PANE[np++] = e; } PANE[MAXPAN] = np; } }
                    __syncthreads();
                    for (int i = 0; i < 16; ++i) { const int sl = wave * 16 + i; const int m = blk * 64 + (sl >> 1); const int p = pos_l[sl];
                        const v4u* s = (const v4u*)(XB + (size_t)m * D) + lane; v4u* d = (v4u*)(XS + (size_t)p * D) + lane; d[0] = s[0]; d[64] = s[64]; }
                }
            }
            SEAM(pb + 6);
            if (IN(pb + 7)) {
                pg8::Gemm g{XS, WE13, MAXROWS, 2 * FE, D}; pg8::MoeOrder S{PANE, PANE[MAXPAN], 28, G, bx};
                pg8::EpiGlu<true> E{HE, FE, ROWRS};
                pg8::gemm_phase<pg8::EpiGlu<true>, pg8::MoeOrder, true, true>(ldsl, g, S, E);
            }
            SEAM(pb + 7);
            if (IN(pb + 8)) {
                unsigned* scr = (unsigned*)(lds + wave * 8704);
                constexpr int T_J = 56 * 16;
                for (int it = gw; it < 8 * T_J; it += NGW) { const int e = it / T_J, r = it % T_J;
                    transpose_tile(args.moe_w2 + (size_t)e * FE * D, D, 64 * (r / 16), 64 * (r % 16), WE2 + (size_t)e * D * FE, FE, 64 * (r % 16), nullptr, scr, lane); }
            }
            SEAM(pb + 8);
            if (IN(pb + 9)) {
                pg8::Gemm g{HE, WE2, MAXROWS, D, FE}; pg8::MoeOrder S{PANE, PANE[MAXPAN], 4, G, bx};
                pg8::EpiMoeDown E{Y, ROWGATE};
                pg8::gemm_phase<pg8::EpiMoeDown, pg8::MoeOrder, true, true>(ldsl, g, S, E);
            }
            SEAM(pb + 9);
            if (IN(pb + 10)) {
                for (int m = gw; m < M; m += NGW) {
                    f32x4* xr = (f32x4*)(X + (size_t)m * D) + lane; const int p0 = POS[m * 2], p1 = POS[m * 2 + 1];
                    const unsigned long long* y0 = (const unsigned long long*)(Y + (size_t)p0 * D) + lane; const unsigned long long* y1 = (const unsigned long long*)(Y + (size_t)p1 * D) + lane;
                    f32x4 v[4]; float s = 0.f;
#pragma unroll
                    for (int j = 0; j < 4; ++j) { v[j] = xr[64 * j]; const unsigned long long a = y0[64 * j], c = y1[64 * j];
                        v[j][0] += bflo((unsigned)a) + bflo((unsigned)c); v[j][1] += bfhi((unsigned)a) + bfhi((unsigned)c);
                        v[j][2] += bflo((unsigned)(a >> 32)) + bflo((unsigned)(c >> 32)); v[j][3] += bfhi((unsigned)(a >> 32)) + bfhi((unsigned)(c >> 32));
                        s += (v[j][0] * v[j][0] + v[j][1] * v[j][1]) + (v[j][2] * v[j][2] + v[j][3] * v[j][3]); }
                    const float rs = 1.0f / sqrtf(wave_sum(s) * (1.0f / D) + pg8::RMS_EPS);
                    const f32x4* gf = (const f32x4*)args.g_final + lane;
#pragma unroll
                    for (int j = 0; j < 4; ++j) xr[64 * j] = v[j] * rs * gf[64 * j];
                }
            }
        }
}

__global__ void __launch_bounds__(NTHR, 2) hybrid_fwd(Args args) {
    extern __shared__ __attribute__((aligned(16))) unsigned char lds[];
    LAS unsigned char* ldsl = (LAS unsigned char*)lds;
    volatile LAS unsigned* MISC = (volatile LAS unsigned*)(ldsl + MISC_OFF);
    const int tid = threadIdx.x, lane = tid & 63, wave = __builtin_amdgcn_readfirstlane(tid >> 6);
    const int G = gridDim.x; const int bx = blockIdx.x;
    const int gw = bx * NWAVES + wave, NGW = G * NWAVES;
    unsigned char* ws = args.ws;
    for (int u = tid; u < (LDS_BYTES - LDSCTL_OFF) / 4; u += NTHR) ((LAS unsigned*)(ldsl + LDSCTL_OFF))[u] = 0u;
    __syncthreads();
    XcdBarrier bar; bar.bar = (unsigned*)(ws + WS_CTL) + CW_BAR + args.li * XCD_BAR_WORDS; bar.x = 0; bar.st = nullptr;
    if (MK_N_LAUNCHES == 1) bar = xcd_barrier_post((unsigned*)(ws + WS_CTL) + CW_BAR + args.li * XCD_BAR_WORDS, MISC + 8);
    const int lo = args.ph_lo, hi = args.ph_hi;

    WS_PTRS

    if (IN(0)) {
        unsigned* scr = (unsigned*)(lds + wave * 8704);
        constexpr int T_A = 16 * 36, T_B = 16 * 12, T_C = 16 * 4, T_D = 16 * 16, T_L = T_A + T_B + T_C + T_D;
        constexpr int T_F = 16 * 44, T_G = 44 * 16, T_E = 16 * 56;
        constexpr int NT0 = 2 * T_L + 2 * T_F + T_G + 16 * T_E;
        for (int it = gw; it < NT0; it += NGW) {
            int r = it;
            if (r < 2 * T_L) { const int l = r / T_L; r -= l * T_L; const float* win = args.w_mix_in + (size_t)l * D * INC; const float* gm = args.g_mix + l * D;
                bf16* WIN = (bf16*)(ws + WS_WIN) + (size_t)l * NU * D;
                if (r < T_A) { transpose_tile(win, INC, 64 * (r / 36), 64 * (r % 36), WIN, D, 64 * (r % 36), gm, scr, lane); continue; } r -= T_A;
                if (r < T_B) { transpose_tile(win, INC, 64 * (r / 12), 2320 + 64 * (r % 12), WIN, D, 2304 + 64 * (r % 12), gm, scr, lane); continue; } r -= T_B;
                if (r < T_C) { glr_tile(win, args.gla_w_gate + l * 16 * 256, gm, 64 * (r / 4), 64 * (r % 4), WIN, 3072, lane); continue; } r -= T_C;
                transpose_tile(args.w_mix_out + (size_t)l * D * D, D, 64 * (r / 16), 64 * (r % 16), (bf16*)(ws + WS_WOUT) + (size_t)l * D * D, D, 64 * (r % 16), nullptr, scr, lane); continue; }
            r -= 2 * T_L;
            if (r < 2 * T_F) { const int w3 = r / T_F; r -= w3 * T_F; const int n0 = 64 * (r % 44);
                transpose_tile(w3 ? args.ffn_w3 : args.ffn_w1, FF, 64 * (r / 44), n0, W13, D, (n0 >> 7) * 256 + (n0 & 127) + 128 * w3, args.g_ffn, scr, lane); continue; }
            r -= 2 * T_F;
            if (r < T_G) { transpose_tile(args.ffn_w2, D, 64 * (r / 16), 64 * (r % 16), W2, FF, 64 * (r % 16), nullptr, scr, lane); continue; }
            r -= T_G;
            { const int ew = r / T_E; r -= ew * T_E; const int e = ew >> 1, w3 = ew & 1; const int n0 = 64 * (r % 56);
              transpose_tile((w3 ? args.moe_w3 : args.moe_w1) + (size_t)e * D * FE, FE, 64 * (r / 56), n0, WE13 + (size_t)e * 2 * FE * D, D, (n0 >> 7) * 256 + (n0 & 127) + 128 * w3, args.g_ffn + D, scr, lane); }
        }
        for (int m = gw; m < M; m += NGW) {
            const f32x4* xr = (const f32x4*)(args.x + (size_t)m * D) + lane; float s = 0.f;
            unsigned long long* o8 = (unsigned long long*)(XB + (size_t)m * D) + lane;
#pragma unroll
            for (int j = 0; j < 4; ++j) { const f32x4 v = xr[64 * j]; s += (v[0] * v[0] + v[1] * v[1]) + (v[2] * v[2] + v[3] * v[3]);
                o8[64 * j] = (unsigned long long)pk2(v[0], v[1]) | ((unsigned long long)pk2(v[2], v[3]) << 32); }
            s = wave_sum(s);
            if (lane < 16) SS[(size_t)m * 16 + lane] = (lane == 0) ? s : 0.f;
        }
        for (int i = bx * NTHR + tid; i < 2049 * 4; i += G * NTHR) { const int d = i >> 2, h = i & 3; BL[i] = args.rel_bias[rel_bucket(d) * 4 + h] * LOG2E; }
    }
    SEAM(0);

    Ctx c; c.args = args; c.tid = tid; c.lane = lane; c.wave = wave; c.G = G; c.bx = bx; c.gw = gw; c.NGW = NGW; c.lo = lo; c.hi = hi; c.bar = bar;
    layer_phases<0>(c, lds);
    layer_phases<1>(c, lds);
}
#undef IN
#undef SEAM
#undef GRID_BAR


extern "C" void kernel_launch(void* const* d_in, const int* in_sizes, int n_in, void* d_out, int out_size, void* d_ws, size_t ws_size, hipStream_t stream) {
    static int grid = 0;
    if (grid == 0) {
        if (n_in != 18 || in_sizes[0] != M * D || out_size != M * D || ws_size < WS_END) { fprintf(stderr, "kernel_launch: unexpected shapes / workspace (%zu < %zu)\n", ws_size, (size_t)WS_END); grid = -1; return; }
        int dev = 0, cus = 0, per_cu = 0;
        if (hipGetDevice(&dev) != hipSuccess || hipDeviceGetAttribute(&cus, hipDeviceAttributeMultiprocessorCount, dev) != hipSuccess) { grid = -1; return; }
        if (hipFuncSetAttribute((const void*)hybrid_fwd, hipFuncAttributeMaxDynamicSharedMemorySize, LDS_BYTES) != hipSuccess) { fprintf(stderr, "kernel_launch: hipFuncSetAttribute failed\n"); grid = -1; return; }
        if (hipOccupancyMaxActiveBlocksPerMultiprocessor(&per_cu, (const void*)hybrid_fwd, NTHR, LDS_BYTES) != hipSuccess || per_cu < 1) { fprintf(stderr, "kernel_launch: occupancy query says %d\n", per_cu); }
        (void)hipGetLastError();
        grid = cus;
    }
    if (grid < 0) return;
    if (hipMemsetAsync((char*)d_ws + WS_CTL, 0, CTL_ZERO_BYTES, stream) != hipSuccess) return;
    Args a{};
    const float** f = (const float**)&a;
    for (int i = 0; i < 18; ++i) f[i] = (const float*)d_in[i];
    a.out = (float*)d_out; a.ws = (unsigned char*)d_ws;
    if (MK_N_LAUNCHES == 1) {
#ifdef PROBE_PHASE
        const int cuts[4][2] = {{0, PROBE_PHASE + 1}, {PROBE_PHASE, PROBE_PHASE + 1}, {PROBE_PHASE + 1, 64}, {0, 0}};
        for (int li = 0; li < 3; ++li) { a.ph_lo = cuts[li][0]; a.ph_hi = cuts[li][1]; a.li = li; hipLaunchKernelGGL(hybrid_fwd, dim3(grid), dim3(NTHR), LDS_BYTES, stream, a); }
#else
        a.ph_lo = 0; a.ph_hi = 64; a.li = 0; hipLaunchKernelGGL(hybrid_fwd, dim3(grid), dim3(NTHR), LDS_BYTES, stream, a);
#endif
    }
    else {
        static const int phases[] = {0, 1, 2, 3, 4, 5, 6, 7, 17, 18, 19, 20, 21, 22, 23, 24, 25, 26, 27};
        for (int p : phases) { a.ph_lo = p; a.ph_hi = p + 1; hipLaunchKernelGGL(hybrid_fwd, dim3(grid), dim3(NTHR), LDS_BYTES, stream, a); }
    }
}
```

```cpp
#include <hip/hip_runtime.h>
#include <cstdio>
#include <cstdint>

#ifndef MK_N_LAUNCHES
#define MK_N_LAUNCHES 1
#endif

namespace pg8 {
#define PG8_LAS __attribute__((address_space(3)))
typedef unsigned short bf16_t;
typedef short bf16x8 __attribute__((ext_vector_type(8)));
typedef float f32x4 __attribute__((ext_vector_type(4)));
typedef unsigned u32x4 __attribute__((ext_vector_type(4)));
typedef unsigned u32x2 __attribute__((ext_vector_type(2)));
constexpr int BM = 256, BK = 64, HALF = 128, HTB = HALF * BK * 2, STAGE_BYTES = 8 * HTB, NXCD = 8, WGM = 8;

__host__ __device__ __forceinline__ int lds_byte(int r, int c) { const int st = (r >> 4) * 2 + (c >> 5), rr = r & 15, cc = c & 31, ob = rr * 64 + cc * 2; return st * 1024 + (ob ^ (((ob >> 9) & 1) << 5)); }
__host__ __device__ __forceinline__ void stage_rc(int b, int& R, int& C) { const int st = b / 1024, sb = b % 1024, swz = sb ^ (((sb >> 9) & 1) << 5); R = (st >> 1) * 16 + swz / 64; C = (st & 1) * 32 + (swz % 64) / 2; }
__host__ __device__ __forceinline__ int perm32(int rho) { const int n = rho >> 4, i = rho & 15; return 8 * (i >> 2) + 4 * n + (i & 3); }

struct Unit { int pm, pn; };
struct Gemm { const bf16_t* A; const bf16_t* Bt; int M, N, K; };

struct StaticOrder {
    int nM, nN, nwg, G, c;
    __host__ __device__ void init(int M, int N, int G_, int c_) { nM = M / BM; nN = N / BM; nwg = nM * nN; G = G_; c = c_; }
    __host__ __device__ bool next(int i, Unit& u) const {
        const long L = (long)i * G + c; if (L >= nwg) return false;
        int wgid = (int)L; { const int q = nwg / NXCD, r = nwg % NXCD, xcd = wgid % NXCD, off = wgid / NXCD; wgid = (xcd < r ? xcd * (q + 1) : r * (q + 1) + (xcd - r) * q) + off; }
        const int nig = WGM * nN, gid = wgid / nig, fm = gid * WGM, gsz = (nM - fm) < WGM ? (nM - fm) : WGM;
        u.pm = fm + ((wgid % nig) % gsz); u.pn = (wgid % nig) / gsz; return true;
    }
    __device__ __forceinline__ void a_ready(const Unit&) const {}
    __device__ __forceinline__ void done(const Unit&) const {}
};
struct MoeOrder {
    const int* panel_e; int npan, NT, G, c;
    __device__ bool next(int i, Unit& u) const {
        const long L = (long)i * G + c; if (L >= (long)npan * NT) return false;
        const int p = (int)(L / NT); u.pm = p; u.pn = panel_e[p] * NT + (int)(L % NT); return true;
    }
    __device__ __forceinline__ void a_ready(const Unit&) const {}
    __device__ __forceinline__ void done(const Unit&) const {}
};

__device__ __forceinline__ unsigned cvt_pk_bf16(float lo, float hi) { unsigned r; asm volatile("v_cvt_pk_bf16_f32 %0, %1, %2" : "=v"(r) : "v"(lo), "v"(hi)); return r; }

constexpr float RMS_EPS = 1e-6f;
__device__ __forceinline__ float rstd_of(const float* ss16) {
    const f32x4 a = *(const f32x4*)ss16, b = *(const f32x4*)(ss16 + 4), c = *(const f32x4*)(ss16 + 8), d = *(const f32x4*)(ss16 + 12);
    const float s = ((a[0] + a[1]) + (a[2] + a[3])) + ((b[0] + b[1]) + (b[2] + b[3])) + ((c[0] + c[1]) + (c[2] + c[3])) + ((d[0] + d[1]) + (d[2] + d[3]));
    return 1.0f / sqrtf(s * (1.0f / 1024.0f) + RMS_EPS);
}
__device__ __forceinline__ float logsig16(float x) { return ((x < 0.f ? x : 0.f) - log1pf(__expf(-fabsf(x)))) * (1.0f / 16.0f); }
__device__ __forceinline__ float silu_f(float a) { return a / (1.0f + __expf(-a)); }

struct EpiU {
    static constexpr bool PERM = true, AFTER_DRAIN = false;
    bf16_t* U; int ldu; const float* SS; float qs;
    __device__ __forceinline__ void operator()(const f32x4 (&acc)[2][2][4][2], const Unit& u, int wr, int wc, int fr, int fq) const {
        const int row0 = u.pm * BM + wr * 64 + fr, col0 = u.pn * BM + wc * 32 + 8 * fq;
        const float sc = (u.pn == 0) ? qs : ((u.pn == 3) ? 0.125f : 1.0f);
#pragma unroll
        for (int ai = 0; ai < 2; ++ai)
#pragma unroll
            for (int m = 0; m < 4; ++m) { const int row = row0 + ai * HALF + m * 16; const float rs = rstd_of(SS + (size_t)row * 16) * sc;
                bf16_t* rowp = U + (size_t)row * ldu + col0;
#pragma unroll
                for (int bj = 0; bj < 2; ++bj) { const f32x4 v0 = acc[ai][bj][m][0] * rs, v1 = acc[ai][bj][m][1] * rs;
                    u32x4 w; w.x = cvt_pk_bf16(v0[0], v0[1]); w.y = cvt_pk_bf16(v0[2], v0[3]); w.z = cvt_pk_bf16(v1[0], v1[1]); w.w = cvt_pk_bf16(v1[2], v1[3]);
                    *(u32x4*)(rowp + bj * HALF) = w; } }
    }
};
struct EpiRes {
    static constexpr bool PERM = false, AFTER_DRAIN = false;
    const float* Xin; float* Xout; bf16_t* XB; float* SS;
    __device__ __forceinline__ void operator()(const f32x4 (&acc)[2][2][4][2], const Unit& u, int wr, int wc, int fr, int fq) const {
        const int row0 = u.pm * BM + wr * 64 + fr, col0 = u.pn * BM + wc * 32 + 4 * fq;
#pragma unroll
        for (int ai = 0; ai < 2; ++ai)
#pragma unroll
            for (int m = 0; m < 4; ++m) { const int row = row0 + ai * HALF + m * 16; const size_t off = (size_t)row * 1024 + col0; float ssum = 0.f;
#pragma unroll
                for (int bj = 0; bj < 2; ++bj)
#pragma unroll
                    for (int n = 0; n < 2; ++n) { const f32x4 xo = *(const f32x4*)(Xin + off + bj * HALF + n * 16); const f32x4 v = xo + acc[ai][bj][m][n];
                        *(f32x4*)(Xout + off + bj * HALF + n * 16) = v; u32x2 w; w.x = cvt_pk_bf16(v[0], v[1]); w.y = cvt_pk_bf16(v[2], v[3]);
                        *(u32x2*)(XB + off + bj * HALF + n * 16) = w; ssum += (v[0] * v[0] + v[1] * v[1]) + (v[2] * v[2] + v[3] * v[3]); }
                ssum += __shfl_xor(ssum, 16); ssum += __shfl_xor(ssum, 32);
                if (fq == 0) SS[(size_t)row * 16 + u.pn * 4 + wc] = ssum;
                asm volatile("" ::: "memory"); }
    }
};
template <bool MOE> struct EpiGlu {
    static constexpr bool PERM = true, AFTER_DRAIN = false;
    bf16_t* O; int ldo; const float* SS;
    __device__ __forceinline__ void operator()(const f32x4 (&acc)[2][2][4][2], const Unit& u, int wr, int wc, int fr, int fq) const {
        const int row0 = u.pm * BM + wr * 64 + fr; const int pnl = MOE ? (u.pn % 28) : u.pn; const int col0 = pnl * HALF + wc * 32 + 8 * fq;
#pragma unroll
        for (int ai = 0; ai < 2; ++ai)
#pragma unroll
            for (int m = 0; m < 4; ++m) { const int row = row0 + ai * HALF + m * 16; const float rs = MOE ? SS[row] : rstd_of(SS + (size_t)row * 16);
                const f32x4 a0 = acc[ai][0][m][0] * rs, a1 = acc[ai][0][m][1] * rs, b0 = acc[ai][1][m][0] * rs, b1 = acc[ai][1][m][1] * rs;
                f32x4 g0, g1;
#pragma unroll
                for (int j = 0; j < 4; ++j) { g0[j] = silu_f(a0[j]) * b0[j]; g1[j] = silu_f(a1[j]) * b1[j]; }
                u32x4 w; w.x = cvt_pk_bf16(g0[0], g0[1]); w.y = cvt_pk_bf16(g0[2], g0[3]); w.z = cvt_pk_bf16(g1[0], g1[1]); w.w = cvt_pk_bf16(g1[2], g1[3]);
                *(u32x4*)(O + (size_t)row * ldo + col0) = w; }
    }
};
struct EpiMoeDown {
    static constexpr bool PERM = true, AFTER_DRAIN = false;
    bf16_t* Y; const float* gate;
    __device__ __forceinline__ void operator()(const f32x4 (&acc)[2][2][4][2], const Unit& u, int wr, int wc, int fr, int fq) const {
        const int row0 = u.pm * BM + wr * 64 + fr, col0 = (u.pn & 3) * BM + wc * 32 + 8 * fq;
#pragma unroll
        for (int ai = 0; ai < 2; ++ai)
#pragma unroll
            for (int m = 0; m < 4; ++m) { const int row = row0 + ai * HALF + m * 16; const float g = gate[row]; bf16_t* rowp = Y + (size_t)row * 1024 + col0;
#pragma unroll
                for (int bj = 0; bj < 2; ++bj) { const f32x4 v0 = acc[ai][bj][m][0] * g, v1 = acc[ai][bj][m][1] * g;
                    u32x4 w; w.x = cvt_pk_bf16(v0[0], v0[1]); w.y = cvt_pk_bf16(v0[2], v0[3]); w.z = cvt_pk_bf16(v1[0], v1[1]); w.w = cvt_pk_bf16(v1[2], v1[3]);
                    *(u32x4*)(rowp + bj * HALF) = w; } }
    }
};

template <class Epi, class Sched, bool ALIGN_EPI = false, bool SP2 = false>
__device__ __forceinline__ void gemm_phase(PG8_LAS unsigned char* lds, const Gemm g, const Sched& S, const Epi& E) {
    const int tid = threadIdx.x, wid = __builtin_amdgcn_readfirstlane(tid >> 6), lane = tid & 63, wr = wid >> 2, wc = wid & 3, fr = lane & 15, fq = lane >> 4;
    const int K = g.K, nt = K / BK;
    unsigned voffA[2], voffB[2];
#pragma unroll
    for (int i = 0; i < 2; ++i) { int R, C; stage_rc(tid * 16 + i * 8192, R, C); const int Rb = Epi::PERM ? ((R & ~31) + perm32(R & 31)) : R;
        voffA[i] = (unsigned)(R * K + C) * 2u; voffB[i] = (unsigned)(Rb * K + C) * 2u; }
    const size_t kstep = (size_t)(BK * 2);
    const size_t hstep = (size_t)HALF * K * 2;
    const size_t tstep = 2 * hstep;
    const unsigned ldsw = (unsigned)wid * 1024u;
    const int aoff = lds_byte(wr * 64 + fr, fq * 8), boff = lds_byte(wc * 32 + fr, fq * 8);
#define PG8_SA(b, h) (((b) * 2 + (h)) * HTB)
#define PG8_SB(b, h) ((4 + (b) * 2 + (h)) * HTB)
#define PG8_STAGE(bufoff, gbase, voff) do { _Pragma("unroll") for (int _i = 0; _i < 2; ++_i) \
        __builtin_amdgcn_global_load_lds((const unsigned*)((const char*)(gbase) + (voff)[_i]), (PG8_LAS unsigned*)(lds + (bufoff) + ldsw + _i * 8192), 16, 0, 0); } while (0)
#define PG8_LDA(dst, b, h) do { _Pragma("unroll") for (int m = 0; m < 4; ++m) _Pragma("unroll") for (int k = 0; k < 2; ++k) dst[m][k] = *(const PG8_LAS bf16x8*)(lds + PG8_SA(b, h) + aoff + m * 2048 + k * 1024); } while (0)
#define PG8_LDB(dst, b, h) do { _Pragma("unroll") for (int n = 0; n < 2; ++n) _Pragma("unroll") for (int k = 0; k < 2; ++k) dst[n][k] = *(const PG8_LAS bf16x8*)(lds + PG8_SB(b, h) + boff + n * 2048 + k * 1024); } while (0)
#define PG8_MMA(ai, bj, At, Bt) do { __builtin_amdgcn_s_setprio(1); _Pragma("unroll") for (int m = 0; m < 4; ++m) _Pragma("unroll") for (int n = 0; n < 2; ++n) _Pragma("unroll") for (int k = 0; k < 2; ++k) \
        acc[ai][bj][m][n] = __builtin_amdgcn_mfma_f32_16x16x32_bf16(Bt[n][k], At[m][k], acc[ai][bj][m][n], 0, 0, 0); __builtin_amdgcn_s_setprio(0); } while (0)
#define PG8_WAIT_V(n) asm volatile("s_waitcnt vmcnt(" #n ")" ::: "memory")
#define PG8_WAIT_L(n) asm volatile("s_waitcnt lgkmcnt(" #n ")" ::: "memory")
#define PG8_BAR __builtin_amdgcn_s_barrier()
#define PG8_SCHED __builtin_amdgcn_sched_barrier(0)
    Unit cur, nxt; int ui = 0;
    if (!S.next(0, cur)) return;
    f32x4 acc[2][2][4][2];
#pragma unroll
    for (int a = 0; a < 2; ++a)
#pragma unroll
        for (int b = 0; b < 2; ++b)
#pragma unroll
            for (int m = 0; m < 4; ++m)
#pragma unroll
                for (int n = 0; n < 2; ++n) acc[a][b][m][n] = (f32x4){0.f, 0.f, 0.f, 0.f};
    bf16x8 At[4][2], B0[2][2], B1[2][2];
    const char* cA = (const char*)g.A + (size_t)cur.pm * tstep; const char* cB = (const char*)g.Bt + (size_t)cur.pn * tstep;
    S.a_ready(cur);
    if constexpr (SP2) {
        PG8_STAGE(PG8_SB(0, 0), cB, voffB); PG8_STAGE(PG8_SB(0, 1), cB + hstep, voffB); PG8_STAGE(PG8_SA(0, 0), cA, voffA); PG8_STAGE(PG8_SA(0, 1), cA + hstep, voffA);
        if (wr == 1) PG8_BAR;
        PG8_WAIT_V(2); PG8_BAR;
        PG8_STAGE(PG8_SB(1, 0), cB + kstep, voffB); PG8_STAGE(PG8_SA(1, 0), cA + kstep, voffA); PG8_STAGE(PG8_SB(1, 1), cB + hstep + kstep, voffB);
        PG8_WAIT_V(6); PG8_BAR;
    } else {
        PG8_STAGE(PG8_SB(0, 0), cB, voffB); PG8_STAGE(PG8_SA(0, 0), cA, voffA); PG8_STAGE(PG8_SB(0, 1), cB + hstep, voffB); PG8_STAGE(PG8_SA(0, 1), cA + hstep, voffA);
        if (wr == 1) PG8_BAR;
        PG8_WAIT_V(4); PG8_BAR;
        PG8_STAGE(PG8_SB(1, 0), cB + kstep, voffB); PG8_STAGE(PG8_SA(1, 0), cA + kstep, voffA); PG8_STAGE(PG8_SB(1, 1), cB + hstep + kstep, voffB);
        PG8_WAIT_V(6); PG8_BAR;
    }
    for (;;) {
        const bool has_next = S.next(ui + 1, nxt);
        const char* nA = has_next ? (const char*)g.A + (size_t)nxt.pm * tstep : cA; const char* nB = has_next ? (const char*)g.Bt + (size_t)nxt.pn * tstep : cB;
        for (int t = 0; t < nt; t += 2) {
            const bool last = (t == nt - 2);
            const char* a1 = cA + (size_t)(t + 1) * kstep;
            const char* a2 = last ? nA : cA + (size_t)(t + 2) * kstep; const char* b2 = last ? nB : cB + (size_t)(t + 2) * kstep;
            const char* a3 = a2 + kstep; const char* b3 = b2 + kstep;
            if (last && has_next) S.a_ready(nxt);
            if constexpr (SP2) {
            PG8_LDB(B0, 0, 0); PG8_LDB(B1, 0, 1); PG8_SCHED; PG8_LDA(At, 0, 0); PG8_STAGE(PG8_SA(1, 1), a1 + hstep, voffA);
            PG8_WAIT_V(8); PG8_WAIT_L(0); PG8_BAR; PG8_MMA(0, 0, At, B0); PG8_MMA(0, 1, At, B1); PG8_BAR; PG8_SCHED;
            PG8_LDA(At, 0, 1); PG8_STAGE(PG8_SB(0, 0), b2, voffB); PG8_STAGE(PG8_SB(0, 1), b2 + hstep, voffB); PG8_STAGE(PG8_SA(0, 0), a2, voffA);
            PG8_WAIT_V(8); PG8_WAIT_L(0); PG8_BAR; PG8_MMA(1, 0, At, B0); PG8_MMA(1, 1, At, B1); PG8_BAR; PG8_SCHED;
            PG8_LDB(B0, 1, 0); PG8_LDB(B1, 1, 1); PG8_SCHED; PG8_LDA(At, 1, 0); PG8_STAGE(PG8_SA(0, 1), a2 + hstep, voffA);
            PG8_WAIT_V(8); PG8_WAIT_L(0); PG8_BAR; PG8_MMA(0, 0, At, B0); PG8_MMA(0, 1, At, B1); PG8_BAR; PG8_SCHED;
            PG8_LDA(At, 1, 1); PG8_STAGE(PG8_SB(1, 0), b3, voffB); PG8_STAGE(PG8_SB(1, 1), b3 + hstep, voffB); PG8_STAGE(PG8_SA(1, 0), a3, voffA);
            PG8_WAIT_V(8); PG8_WAIT_L(0); PG8_BAR; PG8_MMA(1, 0, At, B0); PG8_MMA(1, 1, At, B1); PG8_BAR; PG8_SCHED;
            } else {
            PG8_LDB(B0, 0, 0); PG8_SCHED; PG8_LDA(At, 0, 0); PG8_STAGE(PG8_SA(1, 1), a1 + hstep, voffA);
            PG8_WAIT_L(8); PG8_BAR; PG8_WAIT_L(0); PG8_MMA(0, 0, At, B0); PG8_BAR; PG8_SCHED;
            PG8_LDB(B1, 0, 1); PG8_STAGE(PG8_SB(0, 0), b2, voffB);
            PG8_BAR; PG8_WAIT_L(0); PG8_MMA(0, 1, At, B1); PG8_BAR;
            PG8_LDA(At, 0, 1); PG8_STAGE(PG8_SA(0, 0), a2, voffA);
            PG8_BAR; PG8_WAIT_L(0); PG8_MMA(1, 0, At, B0); PG8_BAR; PG8_SCHED;
            PG8_STAGE(PG8_SB(0, 1), b2 + hstep, voffB);
            PG8_WAIT_V(6); PG8_BAR; PG8_MMA(1, 1, At, B1); PG8_BAR;
            PG8_LDB(B0, 1, 0); PG8_SCHED; PG8_LDA(At, 1, 0); PG8_STAGE(PG8_SA(0, 1), a2 + hstep, voffA);
            PG8_WAIT_L(8); PG8_BAR; PG8_WAIT_L(0); PG8_MMA(0, 0, At, B0); PG8_BAR; PG8_SCHED;
            PG8_LDB(B1, 1, 1); PG8_STAGE(PG8_SB(1, 0), b3, voffB);
            PG8_BAR; PG8_WAIT_L(0); PG8_MMA(0, 1, At, B1); PG8_BAR;
            PG8_LDA(At, 1, 1); PG8_STAGE(PG8_SA(1, 0), a3, voffA);
            PG8_BAR; PG8_WAIT_L(0); PG8_MMA(1, 0, At, B0); PG8_BAR; PG8_SCHED;
            PG8_STAGE(PG8_SB(1, 1), b3 + hstep, voffB);
            PG8_WAIT_V(6); PG8_BAR; PG8_MMA(1, 1, At, B1); PG8_BAR;
            }
        }
        if constexpr (ALIGN_EPI) { if (wr == 0) PG8_BAR; }
        if constexpr (!Epi::AFTER_DRAIN) { E(acc, cur, wr, wc, fr, fq); S.done(cur); }
        if (!has_next) break;
#pragma unroll
        for (int a = 0; a < 2; ++a)
#pragma unroll
            for (int b = 0; b < 2; ++b)
#pragma unroll
                for (int m = 0; m < 4; ++m)
#pragma unroll
                    for (int n = 0; n < 2; ++n) acc[a][b][m][n] = (f32x4){0.f, 0.f, 0.f, 0.f};
        cur = nxt; cA = nA; cB = nB; ++ui;
        if constexpr (ALIGN_EPI) { if (wr == 1) PG8_BAR; }
    }
    PG8_WAIT_V(0);
    if constexpr (!ALIGN_EPI) { if (wr == 0) PG8_BAR; }
    PG8_BAR;
#undef PG8_SA
#undef PG8_SB
#undef PG8_STAGE
#undef PG8_LDA
#undef PG8_LDB
#undef PG8_MMA
#undef PG8_WAIT_V
#undef PG8_WAIT_L
#undef PG8_BAR
#undef PG8_SCHED
}
}

constexpr int NWAVES = 8, NTHR = NWAVES * 64;
constexpr int NB = 8, SEQ = 2048, D = 1024, M = NB * SEQ;
constexpr int INC = 3088;
constexpr int NU = 3072;
constexpr int UQ = 0, UK = 256, UV = 512, UGQ = 768, UGK = 1024, UGV = 1280, UGR = 1792, UCI = 2304, UCB = 2560, UCC = 2816;
constexpr int FF = 2816, FE = 3584, NE = 8;
constexpr int MAXPAN = 136, MAXROWS = MAXPAN * 256;
constexpr float LOG2E = 1.4426950408889634f;
constexpr float QS_ATT = 0.125f * LOG2E;

constexpr size_t MiB = 1u << 20;
constexpr size_t WS_CTL = 0, CTL_ZERO_BYTES = 1 * MiB;
constexpr size_t WS_SS = 1 * MiB;
constexpr size_t WS_BL = 2 * MiB;
constexpr size_t WS_DEC = 2 * MiB + 64 * 1024;
constexpr size_t WS_TOPI = 3 * MiB;
constexpr size_t WS_TOPW = 3 * MiB + 128 * 1024;
constexpr size_t WS_POS = 3 * MiB + 256 * 1024;
constexpr size_t WS_RS3 = 3 * MiB + 384 * 1024;
constexpr size_t WS_CNT = 3 * MiB + 448 * 1024;
constexpr size_t WS_PANE = 3 * MiB + 456 * 1024;
constexpr size_t WS_ROWGATE = 4 * MiB;
constexpr size_t WS_ROWRS = 4 * MiB + 256 * 1024;
constexpr size_t WS_GLR = 5 * MiB;
constexpr size_t WS_WE13 = 8 * MiB;
constexpr size_t WS_Y = WS_WE13;
constexpr size_t WS_XS = 120 * MiB;
constexpr size_t WS_WE2 = WS_XS;
constexpr size_t WS_HE = 188 * MiB;
constexpr size_t WS_WIN = WS_HE;
constexpr size_t WS_WGLR = WS_HE + 12 * MiB;
constexpr size_t WS_WOUT = WS_HE + 13 * MiB;
constexpr size_t WS_W13 = WS_HE + 17 * MiB;
constexpr size_t WS_W2 = WS_HE + 28 * MiB;
constexpr size_t WS_XB = WS_HE + 34 * MiB;
constexpr size_t WS_U = WS_HE + 66 * MiB;
constexpr size_t WS_H = WS_U;
constexpr size_t WS_MIX = WS_HE + 170 * MiB;
constexpr size_t WS_CST = WS_HE + 202 * MiB;
constexpr size_t WS_END = WS_HE + 238 * MiB;
static_assert(WS_CST + 32 * MiB <= WS_END, "ws map");
constexpr int CW_BAR = 4096;

constexpr int LDS_BYTES = 147456;
constexpr int LDSCTL_OFF = 131072 + 14 * 1024, MISC_OFF = LDSCTL_OFF + 320;

#define GAS __attribute__((address_space(1)))
#define LAS __attribute__((address_space(3)))
typedef unsigned short bf16;
typedef float f32x4 __attribute__((ext_vector_type(4)));
typedef unsigned v4u __attribute__((ext_vector_type(4)));
__device__ __forceinline__ unsigned f2bf(float f) { unsigned u = __builtin_bit_cast(unsigned, f); return (u + 0x7fffu + ((u >> 16) & 1u)) >> 16; }
__device__ __forceinline__ unsigned pk2(float lo, float hi) { return f2bf(lo) | (f2bf(hi) << 16); }
__device__ __forceinline__ float bf2f(unsigned short b) { return __builtin_bit_cast(float, (unsigned)b << 16); }
__device__ __forceinline__ float bflo(unsigned w) { return __builtin_bit_cast(float, w << 16); }
__device__ __forceinline__ float bfhi(unsigned w) { return __builtin_bit_cast(float, w & 0xffff0000u); }
__device__ __forceinline__ float wave_sum(float v) {
#pragma unroll
    for (int o = 1; o < 64; o <<= 1) v += __shfl_xor(v, o);
    return v;
}
__device__ __forceinline__ float wave_max(float v) {
#pragma unroll
    for (int o = 1; o < 64; o <<= 1) v = fmaxf(v, __shfl_xor(v, o));
    return v;
}

#define XB_TMO      128
#define XB_XCNT(j)  (256  + 64 * (j))
#define XB_XSUB(j)  (1280 + 64 * (j))
#define XB_XGEN(j)  (2304 + 64 * (j))
#define XB_TOP      3328
#define XB_TOPGEN   3392
#define XCD_BAR_WORDS 3456
#define XB_SPIN_CAP (1u << 18)
__device__ __forceinline__ unsigned xb_ld(unsigned* p)              { return __hip_atomic_load(p, __ATOMIC_RELAXED, __HIP_MEMORY_SCOPE_AGENT); }
__device__ __forceinline__ unsigned xb_add(unsigned* p, unsigned v) { return __hip_atomic_fetch_add(p, v, __ATOMIC_RELAXED, __HIP_MEMORY_SCOPE_AGENT); }
__device__ __forceinline__ unsigned xb_xcc_id() { return (unsigned)__builtin_amdgcn_s_getreg((3 << 11) | 20) & 0xFu; }
#define XB_SPIN(cond, bar) do { unsigned _sp = 0; while (cond) { __builtin_amdgcn_s_sleep(1); \
    if ((++_sp & 255u) == 0u) { if (xb_ld(&(bar)[XB_TMO])) break; if (_sp > XB_SPIN_CAP) { atomicAdd(&(bar)[XB_TMO], 1u); break; } } } } while (0)
struct XcdBarrier { unsigned* bar; unsigned x; volatile LAS unsigned* st; };
__device__ __forceinline__ XcdBarrier xcd_barrier_post(unsigned* bar, volatile LAS unsigned* st) {
    XcdBarrier b; b.bar = bar; b.x = xb_xcc_id(); b.st = st;
    if (threadIdx.x == 0) (void)xb_add(&bar[XB_XCNT(b.x)], 1u);
    return b;
}
__device__ __forceinline__ void xcd_barrier_complete(unsigned* bar, unsigned x, unsigned& nloc, unsigned& nx) {
    const unsigned G = gridDim.x * gridDim.y * gridDim.z;
    unsigned sum, cnt, mine, sp = 0u;
    for (;;) {
        sum = 0u; cnt = 0u; mine = 0u;
#pragma unroll
        for (unsigned j = 0; j < 16; ++j) { const unsigned c = xb_ld(&bar[XB_XCNT(j)]); sum += c; cnt += (c > 0u) ? 1u : 0u; mine = (j == x) ? c : mine; }
        if (sum == G) break;
        __builtin_amdgcn_s_sleep(1);
        if ((++sp & 255u) == 0u) { if (xb_ld(&bar[XB_TMO])) break; if (sp > XB_SPIN_CAP) { atomicAdd(&bar[XB_TMO], 1u); break; } }
    }
    nloc = mine > 0u ? mine : 1u; nx = cnt > 0u ? cnt : 1u;
}
__device__ __forceinline__ void xcd_barrier(const XcdBarrier& b) {
    asm volatile("s_waitcnt vmcnt(0)" ::: "memory");
    __syncthreads();
    if (threadIdx.x == 0) {
        unsigned* bar = b.bar;
        __builtin_amdgcn_s_waitcnt(0);
        unsigned nloc = b.st[0], nx = b.st[1];
        if (nloc == 0u) { xcd_barrier_complete(bar, b.x, nloc, nx); b.st[0] = nloc; b.st[1] = nx; }
        const unsigned old = xb_add(&bar[XB_XSUB(b.x)], 1u);
        const unsigned gen = old / nloc;
        if (old + 1u == (gen + 1u) * nloc) {
            __builtin_amdgcn_fence(__ATOMIC_RELEASE, "agent");
            asm volatile("s_waitcnt vmcnt(0)" ::: "memory");
            const unsigned og = xb_add(&bar[XB_TOP], 1u);
            const unsigned tg = og / nx;
            if (og + 1u == (tg + 1u) * nx) xb_add(&bar[XB_TOPGEN], 1u);
            else XB_SPIN(xb_ld(&bar[XB_TOPGEN]) == tg, bar);
            __builtin_amdgcn_fence(__ATOMIC_ACQUIRE, "agent");
            xb_add(&bar[XB_XGEN(b.x)], 1u);
            asm volatile("s_waitcnt vmcnt(0)" ::: "memory");
        } else {
            XB_SPIN(xb_ld(&bar[XB_XGEN(b.x)]) == gen, bar);
            __builtin_amdgcn_fence(__ATOMIC_ACQUIRE, "agent");
            asm volatile("s_waitcnt vmcnt(0)" ::: "memory");
        }
    }
    __syncthreads();
}

struct Args {
    const float* x; const float* w_mix_in; const float* w_mix_out; const float* g_mix; const float* rel_bias; const float* gla_w_gate; const float* gla_b_gate;
    const float* gla_g_norm; const float* conv_w; const float* g_ffn; const float* ffn_w1; const float* ffn_w3; const float* ffn_w2; const float* moe_router;
    const float* moe_w1; const float* moe_w3; const float* moe_w2; const float* g_final;
    float* out; unsigned char* ws; int ph_lo, ph_hi, li, pad;
};

__device__ __forceinline__ void transpose_tile(const float* src, int ldsrc, int k0, int n0, bf16* dst, int ldd, int drow0, const float* ksc, unsigned* scr, int lane) {
    const int nq = lane & 15, kk = lane >> 4;
#pragma unroll
    for (int i = 0; i < 8; ++i) { const int k = 8 * i + 2 * kk; const float* p = src + (size_t)(k0 + k) * ldsrc + n0 + 4 * nq;
        const f32x4 r0 = *(const f32x4*)p, r1 = *(const f32x4*)(p + ldsrc);
        const float s0 = ksc ? ksc[k0 + k] : 1.f, s1 = ksc ? ksc[k0 + k + 1] : 1.f;
#pragma unroll
        for (int j = 0; j < 4; ++j) scr[(4 * nq + j) * 33 + 4 * i + kk] = pk2(r0[j] * s0, r1[j] * s1); }
    asm volatile("s_waitcnt lgkmcnt(0)" ::: "memory");
#pragma unroll 8
    for (int i2 = 0; i2 < 32; ++i2) { const int n = 2 * i2 + (lane >> 5), d = lane & 31;
        ((unsigned*)(dst + (size_t)(drow0 + n) * ldd + k0))[d] = scr[n * 33 + d]; }
    asm volatile("s_waitcnt lgkmcnt(0)" ::: "memory");
}
__device__ __forceinline__ void glr_tile(const float* win, const float* wg, const float* g, int k0, int n0, bf16* dst, int drow0, int lane) {
    float w[16];
#pragma unroll
    for (int r = 0; r < 16; ++r) w[r] = wg[r * 256 + n0 + lane];
    unsigned* drow = (unsigned*)(dst + (size_t)(drow0 + n0 + lane) * 1024 + k0);
    for (int kp = 0; kp < 32; ++kp) { float v[2];
#pragma unroll
        for (int q = 0; q < 2; ++q) { const int k = k0 + 2 * kp + q; const float* s = win + (size_t)k * INC + 2304; float a = 0.f;
#pragma unroll
            for (int r = 0; r < 16; ++r) a += s[r] * w[r];
            v[q] = a * g[k]; }
        drow[kp] = pk2(v[0], v[1]); }
}
__device__ __forceinline__ int rel_bucket(int d) {
    if (d < 16) return d;
    const float lr = logf((float)d / 16.0f) / logf(128.0f);
    int b = 16 + (int)(lr * 16.0f); return b < 31 ? b : 31;
}


typedef short bf16x8 __attribute__((ext_vector_type(8)));
typedef short v4i16_t __attribute__((ext_vector_type(4)));
#define MFMA16(a, b, c) __builtin_amdgcn_mfma_f32_16x16x32_bf16((a), (b), (c), 0, 0, 0)
__device__ __forceinline__ v4i16_t tr16(LAS unsigned char* p) { return __builtin_amdgcn_ds_read_tr16_b64_v4i16((LAS v4i16_t*)p); }
__device__ __forceinline__ bf16x8 cat8(v4i16_t lo, v4i16_t hi) { return __builtin_shufflevector(lo, hi, 0, 1, 2, 3, 4, 5, 6, 7); }
__device__ __forceinline__ bf16x8 frag_rm(LAS unsigned char* base, int pitch, int c0, int k0, int lane) { return *(LAS bf16x8*)(base + (c0 + (lane & 15)) * pitch + (k0 + 8 * (lane >> 4)) * 2); }
__device__ __forceinline__ bf16x8 frag_tr(LAS unsigned char* base, int pitch, int c0, int k0, int lane) {
    const int i = lane & 15, g = lane >> 4; LAS unsigned char* p = base + (k0 + 8 * g + (i >> 2)) * pitch + (c0 + 4 * (i & 3)) * 2;
    return cat8(tr16(p), tr16(p + 4 * pitch)); }
__device__ __forceinline__ bf16x8 frag_trp(LAS unsigned char* base, int pitch, int c0, int k0, int lane) {
    const int i = lane & 15, g = lane >> 4; LAS unsigned char* p = base + (k0 + 4 * g + (i >> 2)) * pitch + (c0 + 4 * (i & 3)) * 2;
    return cat8(tr16(p), tr16(p + 16 * pitch)); }
__device__ __forceinline__ bf16x8 pack8(const f32x4& a, const f32x4& b) {
    v4u w; w.x = pg8::cvt_pk_bf16(a[0], a[1]); w.y = pg8::cvt_pk_bf16(a[2], a[3]); w.z = pg8::cvt_pk_bf16(b[0], b[1]); w.w = pg8::cvt_pk_bf16(b[2], b[3]); return __builtin_bit_cast(bf16x8, w); }

struct Ctx { Args args; int tid, lane, wave, G, bx, gw, NGW, lo, hi; XcdBarrier bar; };
#define GRID_BAR() do { if (MK_N_LAUNCHES == 1) xcd_barrier(bar); } while (0)
#define IN(k) (lo <= (k) && (k) < hi)
#define SEAM(k) do { if (IN(k) && IN((k) + 1)) GRID_BAR(); } while (0)
#define WS_PTRS \
    float* SS = (float*)(ws + WS_SS); float* BL = (float*)(ws + WS_BL); float* DEC = (float*)(ws + WS_DEC); \
    bf16* XB = (bf16*)(ws + WS_XB); bf16* U = (bf16*)(ws + WS_U); bf16* MIX = (bf16*)(ws + WS_MIX); float* CST = (float*)(ws + WS_CST); \
    bf16* H = (bf16*)(ws + WS_H); bf16* W13 = (bf16*)(ws + WS_W13); bf16* W2 = (bf16*)(ws + WS_W2); \
    bf16* WE13 = (bf16*)(ws + WS_WE13); bf16* WE2 = (bf16*)(ws + WS_WE2); bf16* XS = (bf16*)(ws + WS_XS); bf16* HE = (bf16*)(ws + WS_HE); bf16* Y = (bf16*)(ws + WS_Y); \
    int* TOPI = (int*)(ws + WS_TOPI); float* TOPW = (float*)(ws + WS_TOPW); int* POS = (int*)(ws + WS_POS); float* RS3 = (float*)(ws + WS_RS3); \
    int* CNT = (int*)(ws + WS_CNT); int* PANE = (int*)(ws + WS_PANE); float* ROWGATE = (float*)(ws + WS_ROWGATE); float* ROWRS = (float*)(ws + WS_ROWRS); \
    float* X = args.out; \
    (void)SS; (void)BL; (void)DEC; (void)XB; (void)U; (void)MIX; (void)CST; (void)H; (void)W13; (void)W2; (void)WE13; (void)WE2; (void)XS; (void)HE; (void)Y; \
    (void)TOPI; (void)TOPW; (void)POS; (void)RS3; (void)CNT; (void)PANE; (void)ROWGATE; (void)ROWRS; (void)X;

template <int layer> __device__ __forceinline__ void layer_phases(const Ctx& c, unsigned char* lds) {
    const Args& args = c.args; LAS unsigned char* ldsl = (LAS unsigned char*)lds;
    const int tid = c.tid, lane = c.lane, wave = c.wave, G = c.G, bx = c.bx, gw = c.gw, NGW = c.NGW, lo = c.lo, hi = c.hi; const XcdBarrier bar = c.bar;
    unsigned char* ws = args.ws;
    WS_PTRS
    (void)tid; (void)lane; (void)wave; (void)gw; (void)NGW;
        const int pb = 1 + 16 * layer;
        if (IN(pb + 0)) {
            pg8::Gemm g{XB, (const bf16*)(ws + WS_WIN) + (size_t)layer * NU * D, M, NU, D}; pg8::StaticOrder S; S.init(M, NU, G, bx);
            pg8::EpiU E{U, NU, SS, QS_ATT};
            pg8::gemm_phase<pg8::EpiU, pg8::StaticOrder, true, true>(ldsl, g, S, E);
            { const bf16* wg = (const bf16*)(ws + WS_WGLR) + (size_t)layer * 16 * D; float* GLR = (float*)(ws + WS_GLR); f32x4* xch = (f32x4*)lds;
              for (int blk = bx; blk < 256; blk += G) {
                  const int rt = wave & 3, kh = wave >> 2, ql = lane & 15, g4 = lane >> 4;
                  const bf16* ap = XB + (size_t)(blk * 64 + rt * 16 + ql) * D + kh * 512 + 8 * g4; const bf16* bp = wg + (size_t)ql * D + kh * 512 + 8 * g4;
                  f32x4 acc = (f32x4){0.f, 0.f, 0.f, 0.f};
#pragma unroll
                  for (int ks = 0; ks < 16; ++ks) acc = MFMA16(*(const bf16x8*)(ap + 32 * ks), *(const bf16x8*)(bp + 32 * ks), acc);
                  if (kh == 1) xch[rt * 64 + lane] = acc;
                  __syncthreads();
                  if (kh == 0) { acc += xch[rt * 64 + lane];
#pragma unroll
                      for (int rg = 0; rg < 4; ++rg) { const int row = blk * 64 + rt * 16 + 4 * g4 + rg; GLR[(size_t)row * 16 + ql] = acc[rg] * pg8::rstd_of(SS + (size_t)row * 16); } }
                  __syncthreads();
              } }
        }
        SEAM(pb + 0);
        if (IN(pb + 1)) {
            float* cum = (float*)lds; float* seg = cum + 4096;
            LAS unsigned char* kdl = ldsl + 18432;
            LAS unsigned char* vvl = ldsl + 27648;
            for (int u = bx; u < 1024; u += G) {
                const int h = u & 3, n = (u >> 2) & 31, b = u >> 7; const size_t row0 = (size_t)b * SEQ + n * 64;
                { float c = 0.f; float wgc[16]; const float* wgp = args.gla_w_gate + layer * 16 * 256 + h * 64 + lane; const float bgv = args.gla_b_gate[layer * 256 + h * 64 + lane];
#pragma unroll
                  for (int r = 0; r < 16; ++r) wgc[r] = wgp[r * 256];
                  const float* GLR = (const float*)(ws + WS_GLR);
#pragma unroll
                  for (int i = 0; i < 8; ++i) { const int t = 8 * wave + i; const f32x4* gp = (const f32x4*)(GLR + (row0 + t) * 16); float z = bgv;
#pragma unroll
                      for (int q4 = 0; q4 < 4; ++q4) { const f32x4 gv = gp[q4]; z += gv[0] * wgc[4 * q4] + gv[1] * wgc[4 * q4 + 1] + gv[2] * wgc[4 * q4 + 2] + gv[3] * wgc[4 * q4 + 3]; }
                      c += pg8::logsig16(z); cum[t * 64 + lane] = c; }
                  seg[wave * 64 + lane] = c; }
                __syncthreads();
                { float off = 0.f, last = 0.f;
#pragma unroll
                  for (int w = 0; w < 8; ++w) { const float s = seg[w * 64 + lane]; last += s; if (w < wave) off += s; }
#pragma unroll
                  for (int i = 0; i < 8; ++i) { const int t = 8 * wave + i; const float cm = cum[t * 64 + lane] + off;
                      *(LAS unsigned short*)(kdl + t * 144 + lane * 2) = (unsigned short)f2bf(bf2f(U[(row0 + t) * NU + UGK + h * 64 + lane]) * __expf(last - cm)); }
                  if (wave == 0) DEC[u * 64 + lane] = __expf(last);
                  const int vr = tid >> 3, ch = tid & 7; const v4u* vp = (const v4u*)(U + (row0 + vr) * NU + UGV + h * 128 + ch * 16);
                  const v4u x0 = vp[0], x1 = vp[1]; LAS v4u* vd = (LAS v4u*)(vvl + vr * 272 + ch * 32); vd[0] = x0; vd[1] = x1; }
                __syncthreads();
                { f32x4 acc[4];
#pragma unroll
                  for (int kt = 0; kt < 4; ++kt) acc[kt] = (f32x4){0.f, 0.f, 0.f, 0.f};
#pragma unroll
                  for (int ks = 0; ks < 2; ++ks) { const bf16x8 a = frag_tr(vvl, 272, 16 * wave, 32 * ks, lane);
#pragma unroll
                      for (int kt = 0; kt < 4; ++kt) { const bf16x8 bq = frag_tr(kdl, 144, 16 * kt, 32 * ks, lane); acc[kt] = MFMA16(a, bq, acc[kt]); } }
                  const int g4 = lane >> 4, ql = lane & 15;
#pragma unroll
                  for (int kt = 0; kt < 4; ++kt)
#pragma unroll
                      for (int rg = 0; rg < 4; ++rg) CST[((size_t)u * 128 + 16 * wave + 4 * g4 + rg) * 64 + 16 * kt + ql] = acc[kt][rg]; }
                __syncthreads();
            }
            const float* cw = args.conv_w + layer * 3 * 256;
            for (int it = bx * NTHR + tid; it < M * 32; it += G * NTHR) {
                const int row = it >> 5, c0 = (it & 31) * 8, t = row & (SEQ - 1);
                const bf16* ur = U + (size_t)row * NU;
                const v4u cb = *(const v4u*)(ur + UCB + c0);
                v4u ci[3], cc[3];
#pragma unroll
                for (int d = 0; d < 3; ++d) { if (t >= d) { ci[d] = *(const v4u*)(ur - (size_t)d * NU + UCI + c0); cc[d] = *(const v4u*)(ur - (size_t)d * NU + UCC + c0); } else { ci[d] = (v4u){0u, 0u, 0u, 0u}; cc[d] = ci[d]; } }
                float o[8];
#pragma unroll
                for (int j = 0; j < 4; ++j) {
                    float a0 = 0.f, a1 = 0.f;
#pragma unroll
                    for (int d = 0; d < 3; ++d) { const float w0 = cw[(2 - d) * 256 + c0 + 2 * j], w1 = cw[(2 - d) * 256 + c0 + 2 * j + 1];
                        a0 += w0 * (bflo(cc[d][j]) * bflo(ci[d][j])); a1 += w1 * (bfhi(cc[d][j]) * bfhi(ci[d][j])); }
                    o[2 * j] = bflo(cb[j]) * a0; o[2 * j + 1] = bfhi(cb[j]) * a1; }
                v4u w; w.x = pk2(o[0], o[1]); w.y = pk2(o[2], o[3]); w.z = pk2(o[4], o[5]); w.w = pk2(o[6], o[7]);
                *(v4u*)(MIX + (size_t)row * D + 768 + c0) = w;
            }
            __syncthreads();
            {
                float* BLl = (float*)lds;
                for (int i = tid; i < 4 * 2049; i += NTHR) BLl[(i & 3) * 2049 + (i >> 2)] = BL[i];
                __syncthreads();
                LAS unsigned char* vst = ldsl + 33280 + wave * 5120;
                const int ql = lane & 15, g4 = lane >> 4;
                for (int uu = bx; uu < 512; uu += G) {
                    int u = uu; if (G == 256) { const int j = (uu & 255) >> 3; u = ((((uu >> 8) * 16 + (uu & 7) * 2 + (j >> 4)) << 4) | (j & 15)); }
                    const int c = u & 15, h = (u >> 4) & 3, b = u >> 6; const int i0 = 16 * wave; const size_t rowb = (size_t)b * SEQ;
                    const int tq = c + 16 * (i0 + ql);
                    const bf16* ub = U + rowb * NU + h * 64;
                    const bf16x8 qf0 = *(const bf16x8*)(ub + (size_t)tq * NU + UQ + 8 * g4), qf1 = *(const bf16x8*)(ub + (size_t)tq * NU + UQ + 8 * g4 + 32);
                    const float* blh = BLl + h * 2049;
                    const int t0 = c + 16 * i0, t1 = t0 + 240;
                    const int base0 = ((t0 >> 4) - 128) & ~31, mhi0 = t1 >> 4, np0 = ((mhi0 - base0) >> 5) + 1, pz0 = base0 < 0 ? ((-base0) >> 5) : 0;
                    const int base1 = ((t0 >> 2) - 128) & ~31, mhi1 = t1 >> 2, np1 = ((mhi1 - base1) >> 5) + 1, pz1 = base1 < 0 ? ((-base1) >> 5) : 0;
                    const int base2 = (t0 - 128) & ~31, mhi2 = t1, np2 = ((mhi2 - base2) >> 5) + 1, pz2 = base2 < 0 ? ((-base2) >> 5) : 0;
                    const int n0 = np0 - pz0, n1 = np1 - pz1, n2 = np2 - pz2, NT = n0 + n1 + n2;
                    bf16x8 kc[2][2], kn[2][2]; v4u vc[4], vn[4];
#define ATT_ITEM(it, LR, MB, MHI, RHO) do { if ((it) < n0) { LR = 4; MB = base0 + 32 * (np0 - 1 - (it)); MHI = mhi0; RHO = c; } \
                        else if ((it) < n0 + n1) { LR = 2; MB = base1 + 32 * (pz1 + (it) - n0); MHI = mhi1; RHO = c & 3; } \
                        else { LR = 0; MB = base2 + 32 * (pz2 + (it) - n0 - n1); MHI = mhi2; RHO = 0; } } while (0)
#define ATT_LOAD(K_, V_, LR, MB, MHI, RHO) do { _Pragma("unroll") for (int tau = 0; tau < 2; ++tau) { int mk = (MB) + 16 * tau + ql; mk = mk < 0 ? 0 : (mk > (MHI) ? (MHI) : mk); \
                            const bf16* kp = ub + (size_t)((mk << (LR)) + (RHO)) * NU + UK + 8 * g4; K_[tau][0] = *(const bf16x8*)kp; K_[tau][1] = *(const bf16x8*)(kp + 32); } \
                        _Pragma("unroll") for (int j = 0; j < 4; ++j) { int mv = (MB) + (lane >> 3) + 8 * j; mv = mv < 0 ? 0 : (mv > (MHI) ? (MHI) : mv); \
                            V_[j] = *(const v4u*)(ub + (size_t)((mv << (LR)) + (RHO)) * NU + UV + 8 * (lane & 7)); } } while (0)
                    int lr, mb, mhi, rho; ATT_ITEM(0, lr, mb, mhi, rho); ATT_LOAD(kc, vc, lr, mb, mhi, rho);
                    float m_ref = -INFINITY, l_run = 0.f; f32x4 o[4];
#pragma unroll
                    for (int d = 0; d < 4; ++d) o[d] = (f32x4){0.f, 0.f, 0.f, 0.f};
                    for (int it = 0; it < NT; ++it) {
                        int lrn = lr, mbn = mb, mhin = mhi, rhon = rho;
                        if (it + 1 < NT) { ATT_ITEM(it + 1, lrn, mbn, mhin, rhon); ATT_LOAD(kn, vn, lrn, mbn, mhin, rhon); }
                        { LAS unsigned char* vd = vst + (lane >> 3) * 160 + (lane & 7) * 16;
#pragma unroll
                          for (int j = 0; j < 4; ++j) *(LAS v4u*)(vd + j * 8 * 160) = vc[j]; }
                        f32x4 s[2];
#pragma unroll
                        for (int tau = 0; tau < 2; ++tau) { s[tau] = MFMA16(kc[tau][0], qf0, ((f32x4){0.f, 0.f, 0.f, 0.f})); s[tau] = MFMA16(kc[tau][1], qf1, s[tau]); }
                        const int d0 = (tq >> lr) - mb - 4 * g4, k0 = mb + 4 * g4; float tmax = -INFINITY;
#pragma unroll
                        for (int tau = 0; tau < 2; ++tau)
#pragma unroll
                            for (int rg = 0; rg < 4; ++rg) { const int dist = d0 - (16 * tau + rg); const bool ok = ((unsigned)dist <= 128u) && (k0 + 16 * tau + rg >= 0);
                                const float bias = blh[ok ? (dist << lr) : 0]; const float v = ok ? s[tau][rg] + bias : -INFINITY; s[tau][rg] = v; tmax = fmaxf(tmax, v); }
                        if (__any(tmax > m_ref + 16.0f)) {
                            float tm = fmaxf(tmax, __shfl_xor(tmax, 16)); tm = fmaxf(tm, __shfl_xor(tm, 32));
                            const float mn = fmaxf(m_ref, tm); const float ms = (mn == -INFINITY) ? 0.f : mn; const float alpha = __builtin_amdgcn_exp2f(m_ref - ms); m_ref = ms;
                            l_run *= alpha;
#pragma unroll
                            for (int d = 0; d < 4; ++d) o[d] = o[d] * alpha;
                        }
                        float ps = 0.f;
#pragma unroll
                        for (int tau = 0; tau < 2; ++tau)
#pragma unroll
                            for (int rg = 0; rg < 4; ++rg) { const float p = __builtin_amdgcn_exp2f(s[tau][rg] - m_ref); s[tau][rg] = p; ps += p; }
                        l_run += ps;
                        const bf16x8 pb = pack8(s[0], s[1]);
                        asm volatile("" ::: "memory");
#pragma unroll
                        for (int d = 0; d < 4; ++d) { const bf16x8 va = frag_trp(vst, 160, 16 * d, 0, lane); o[d] = MFMA16(va, pb, o[d]); }
                        asm volatile("" ::: "memory");
#pragma unroll
                        for (int tau = 0; tau < 2; ++tau) { kc[tau][0] = kn[tau][0]; kc[tau][1] = kn[tau][1]; }
#pragma unroll
                        for (int j = 0; j < 4; ++j) vc[j] = vn[j];
                        lr = lrn; mb = mbn; mhi = mhin; rho = rhon;
                    }
#undef ATT_ITEM
#undef ATT_LOAD
                    l_run += __shfl_xor(l_run, 16); l_run += __shfl_xor(l_run, 32); const float inv = 1.0f / l_run;
                    bf16* op = MIX + (rowb + tq) * D + h * 64 + 4 * g4;
#pragma unroll
                    for (int d = 0; d < 4; ++d) { pg8::u32x2 w; w.x = pg8::cvt_pk_bf16(o[d][0] * inv, o[d][1] * inv); w.y = pg8::cvt_pk_bf16(o[d][2] * inv, o[d][3] * inv); *(pg8::u32x2*)(op + 16 * d) = w; }
                }
            }
        }
        SEAM(pb + 1);
        if (IN(pb + 2)) {
            for (int e = bx * NTHR + tid; e < NB * 4 * 8192; e += G * NTHR) {
                const int k = e & 63, v = (e >> 6) & 127, h = (e >> 13) & 3, b = e >> 15; float cc[32], dd[32];
                float* cp = CST + ((size_t)(b * 128 + h) * 128 + v) * 64 + k; const float* dp = DEC + (b * 128 + h) * 64 + k;
#pragma unroll
                for (int n = 0; n < 32; ++n) { cc[n] = cp[(size_t)n * 4 * 8192]; dd[n] = dp[n * 4 * 64]; }
                float S = 0.f;
#pragma unroll
                for (int n = 0; n < 32; ++n) { cp[(size_t)n * 4 * 8192] = S; S = dd[n] * S + cc[n]; }
            }
        }
        SEAM(pb + 2);
        if (IN(pb + 3)) {
            float* cum = (float*)lds; float* seg = cum + 4096;
            LAS unsigned char* qel = ldsl + 18432;
            LAS unsigned char* kel = ldsl + 27648;
            LAS unsigned char* vvl = ldsl + 36864;
            LAS unsigned char* stl = ldsl + 54272;
            float* rsq = (float*)(lds + 72704);
            const float* gn = args.gla_g_norm + layer * 128;
            for (int u = bx; u < 1024; u += G) {
                const int h = u & 3, n = (u >> 2) & 31, b = u >> 7; const size_t row0 = (size_t)b * SEQ + n * 64;
                { float c = 0.f; float wgc[16]; const float* wgp = args.gla_w_gate + layer * 16 * 256 + h * 64 + lane; const float bgv = args.gla_b_gate[layer * 256 + h * 64 + lane];
#pragma unroll
                  for (int r = 0; r < 16; ++r) wgc[r] = wgp[r * 256];
                  const float* GLR = (const float*)(ws + WS_GLR);
#pragma unroll
                  for (int i = 0; i < 8; ++i) { const int t = 8 * wave + i; const f32x4* gp = (const f32x4*)(GLR + (row0 + t) * 16); float z = bgv;
#pragma unroll
                      for (int q4 = 0; q4 < 4; ++q4) { const f32x4 gv = gp[q4]; z += gv[0] * wgc[4 * q4] + gv[1] * wgc[4 * q4 + 1] + gv[2] * wgc[4 * q4 + 2] + gv[3] * wgc[4 * q4 + 3]; }
                      c += pg8::logsig16(z); cum[t * 64 + lane] = c; }
                  seg[wave * 64 + lane] = c; }
                __syncthreads();
                { float off = 0.f;
#pragma unroll
                  for (int w = 0; w < 8; ++w) { const float s = seg[w * 64 + lane]; if (w < wave) off += s; }
#pragma unroll
                  for (int i = 0; i < 8; ++i) { const int t = 8 * wave + i; const float cm = cum[t * 64 + lane] + off;
                      *(LAS unsigned short*)(qel + t * 144 + lane * 2) = (unsigned short)f2bf(bf2f(U[(row0 + t) * NU + UGQ + h * 64 + lane]) * __expf(cm));
                      *(LAS unsigned short*)(kel + t * 144 + lane * 2) = (unsigned short)f2bf(bf2f(U[(row0 + t) * NU + UGK + h * 64 + lane]) * __expf(-cm)); }
                  { const int vr = tid >> 3, ch = tid & 7; const v4u* vp = (const v4u*)(U + (row0 + vr) * NU + UGV + h * 128 + ch * 16);
                    const v4u x0 = vp[0], x1 = vp[1]; LAS v4u* vd = (LAS v4u*)(vvl + vr * 272 + ch * 32); vd[0] = x0; vd[1] = x1; }
                  { const int v = tid >> 2, kq = (tid & 3) * 16; const f32x4* sp = (const f32x4*)(CST + ((size_t)u * 128 + v) * 64 + kq);
                    const f32x4 a0 = sp[0], a1 = sp[1], a2 = sp[2], a3 = sp[3];
                    v4u w0, w1; w0.x = pk2(a0[0], a0[1]); w0.y = pk2(a0[2], a0[3]); w0.z = pk2(a1[0], a1[1]); w0.w = pk2(a1[2], a1[3]);
                    w1.x = pk2(a2[0], a2[1]); w1.y = pk2(a2[2], a2[3]); w1.z = pk2(a3[0], a3[1]); w1.w = pk2(a3[2], a3[3]);
                    LAS v4u* sd = (LAS v4u*)(stl + v * 144 + kq * 2); sd[0] = w0; sd[1] = w1; } }
                __syncthreads();
                { const int tt = wave & 3, vh = wave >> 2, ql = lane & 15, g4 = lane >> 4; const int t = 16 * tt + ql;
                  const bf16x8 qb0 = frag_rm(qel, 144, 16 * tt, 0, lane), qb1 = frag_rm(qel, 144, 16 * tt, 32, lane);
                  f32x4 sT[4];
#pragma unroll
                  for (int st = 0; st < 4; ++st) { sT[st] = (f32x4){0.f, 0.f, 0.f, 0.f};
                      if (st <= tt) { sT[st] = MFMA16(frag_rm(kel, 144, 16 * st, 0, lane), qb0, sT[st]); sT[st] = MFMA16(frag_rm(kel, 144, 16 * st, 32, lane), qb1, sT[st]);
#pragma unroll
                          for (int rg = 0; rg < 4; ++rg) if (16 * st + 4 * g4 + rg > t) sT[st][rg] = 0.f; } }
                  const bf16x8 pb0 = pack8(sT[0], sT[1]), pb1 = pack8(sT[2], sT[3]);
                  f32x4 acc[4]; float ss = 0.f;
#pragma unroll
                  for (int vt = 0; vt < 4; ++vt) { const int V0 = 16 * (4 * vh + vt); f32x4 a = (f32x4){0.f, 0.f, 0.f, 0.f};
                      a = MFMA16(frag_trp(vvl, 272, V0, 0, lane), pb0, a); a = MFMA16(frag_trp(vvl, 272, V0, 32, lane), pb1, a);
                      a = MFMA16(frag_rm(stl, 144, V0, 0, lane), qb0, a); a = MFMA16(frag_rm(stl, 144, V0, 32, lane), qb1, a);
                      acc[vt] = a; ss += (a[0] * a[0] + a[1] * a[1]) + (a[2] * a[2] + a[3] * a[3]); }
                  ss += __shfl_xor(ss, 16); ss += __shfl_xor(ss, 32);
                  if (g4 == 0) rsq[(tt * 2 + vh) * 16 + ql] = ss;
                  __syncthreads();
                  const float rs = 1.0f / sqrtf((rsq[(tt * 2) * 16 + ql] + rsq[(tt * 2 + 1) * 16 + ql]) * (1.0f / 128.0f) + pg8::RMS_EPS);
#pragma unroll
                  for (int vt = 0; vt < 4; ++vt) { const int v0 = 16 * (4 * vh + vt) + 4 * g4;
                      const pg8::u32x2 gr = *(const pg8::u32x2*)(U + (row0 + t) * NU + UGR + h * 128 + v0); const f32x4 gv = *(const f32x4*)(gn + v0);
                      const float o0 = acc[vt][0] * rs * gv[0] * pg8::silu_f(bflo(gr.x)), o1 = acc[vt][1] * rs * gv[1] * pg8::silu_f(bfhi(gr.x));
                      const float o2 = acc[vt][2] * rs * gv[2] * pg8::silu_f(bflo(gr.y)), o3 = acc[vt][3] * rs * gv[3] * pg8::silu_f(bfhi(gr.y));
                      pg8::u32x2 w; w.x = pg8::cvt_pk_bf16(o0, o1); w.y = pg8::cvt_pk_bf16(o2, o3);
                      *(pg8::u32x2*)(MIX + (row0 + t) * D + 256 + h * 128 + v0) = w; } }
                __syncthreads();
            }
        }
        SEAM(pb + 3);
        if (IN(pb + 4)) {
            pg8::Gemm g{MIX, (const bf16*)(ws + WS_WOUT) + (size_t)layer * D * D, M, D, D}; pg8::StaticOrder S; S.init(M, D, G, bx);
            pg8::EpiRes E{layer == 0 ? args.x : (const float*)X, X, XB, SS};
            pg8::gemm_phase<pg8::EpiRes, pg8::StaticOrder, true, true>(ldsl, g, S, E);
        }
        SEAM(pb + 4);
        if (layer == 0) {
            if (IN(pb + 5)) {
                pg8::Gemm g{XB, W13, M, 2 * FF, D}; pg8::StaticOrder S; S.init(M, 2 * FF, G, bx);
                pg8::EpiGlu<false> E{H, FF, SS};
                pg8::gemm_phase<pg8::EpiGlu<false>, pg8::StaticOrder, true, true>(ldsl, g, S, E);
            }
            SEAM(pb + 5);
            if (IN(pb + 6)) {
                pg8::Gemm g{H, W2, M, D, FF}; pg8::StaticOrder S; S.init(M, D, G, bx);
                pg8::EpiRes E{X, X, XB, SS};
                pg8::gemm_phase<pg8::EpiRes, pg8::StaticOrder, true, true>(ldsl, g, S, E);
            }
            SEAM(pb + 6);
        } else {
            if (IN(pb + 5)) {
                float* wr_l = (float*)lds;
                int* cnt_l = (int*)(lds + 32768);
                const float* gf = args.g_ffn + D;
                for (int i = tid; i < D * 8; i += NTHR) wr_l[(i & 7) * D + (i >> 3)] = args.moe_router[i] * gf[i >> 3];
                if (tid < 8) cnt_l[tid] = 0;
                __syncthreads();
                for (int blk = bx; blk < 256; blk += G) {
                    if (blk != bx) { __syncthreads(); if (tid < 8) cnt_l[tid] = 0; __syncthreads(); }
                    for (int i = 0; i < 8; ++i) { const int m = blk * 64 + wave * 8 + i;
                        const f32x4* xr = (const f32x4*)(X + (size_t)m * D) + lane; float lg[8];
#pragma unroll
                        for (int e = 0; e < 8; ++e) lg[e] = 0.f;
#pragma unroll
                        for (int j = 0; j < 4; ++j) { const f32x4 v = xr[64 * j]; const int k0 = 4 * (lane + 64 * j);
#pragma unroll
                            for (int e = 0; e < 8; ++e) { const f32x4 w = *(const f32x4*)(wr_l + e * D + k0); lg[e] += (v[0] * w[0] + v[1] * w[1]) + (v[2] * w[2] + v[3] * w[3]); } }
                        const float rs = pg8::rstd_of(SS + (size_t)m * 16);
#pragma unroll
                        for (int e = 0; e < 8; ++e) lg[e] = wave_sum(lg[e]) * rs;
                        int i0 = 0; float v0 = lg[0];
#pragma unroll
                        for (int e = 1; e < 8; ++e) if (lg[e] > v0) { v0 = lg[e]; i0 = e; }
                        int i1 = -1; float v1 = -INFINITY;
#pragma unroll
                        for (int e = 0; e < 8; ++e) if (e != i0 && lg[e] > v1) { v1 = lg[e]; i1 = e; }
                        const float w1 = 1.0f / (1.0f + __expf(v0 - v1)), w0 = 1.0f - w1;
                        if (lane == 0) { TOPI[m * 2] = i0; TOPI[m * 2 + 1] = i1; TOPW[m * 2] = w0; TOPW[m * 2 + 1] = w1; RS3[m] = rs; atomicAdd(&cnt_l[i0], 1); atomicAdd(&cnt_l[i1], 1); } }
                    __syncthreads();
                    if (tid < 8) CNT[blk * 8 + tid] = cnt_l[tid];
                }
            }
            SEAM(pb + 5);
            if (IN(pb + 6)) {
                int* base_l = (int*)lds;
                int* pre_l = base_l + 8;
                int* tot_l = pre_l + 8;
                int* pos_l = tot_l + 8;
                int* ent_l = pos_l + 128;
                for (int blk = bx; blk < 256; blk += G) {
                    __syncthreads();
                    if (tid < 8) { tot_l[tid] = 0; pre_l[tid] = 0; }
                    if (tid < 128) ent_l[tid] = TOPI[blk * 128 + tid];
                    __syncthreads();
                    { const int g2 = tid >> 1, e0 = (tid & 1) * 4; const int4 c = *(const int4*)(CNT + g2 * 8 + e0);
                      atomicAdd(&tot_l[e0], c.x); atomicAdd(&tot_l[e0 + 1], c.y); atomicAdd(&tot_l[e0 + 2], c.z); atomicAdd(&tot_l[e0 + 3], c.w);
                      if (g2 < blk) { atomicAdd(&pre_l[e0], c.x); atomicAdd(&pre_l[e0 + 1], c.y); atomicAdd(&pre_l[e0 + 2], c.z); atomicAdd(&pre_l[e0 + 3], c.w); } }
                    __syncthreads();
                    if (tid == 0) { int bs = 0; for (int e = 0; e < 8; ++e) { base_l[e] = bs; bs += (tot_l[e] + 255) & ~255; } }
                    __syncthreads();
                    if (tid < 128) { const int e = ent_l[tid]; int rank = 0; for (int j = 0; j < tid; ++j) rank += (ent_l[j] == e) ? 1 : 0;
                        const int p = base_l[e] + pre_l[e] + rank; pos_l[tid] = p; POS[blk * 128 + tid] = p; ROWGATE[p] = TOPW[blk * 128 + tid]; ROWRS[p] = RS3[blk * 64 + (tid >> 1)]; }
                    if (blk == 0) {
                        for (int e = 0; e < 8; ++e) { const int npe = (tot_l[e] + 255) >> 8; for (int p = base_l[e] + tot_l[e] + tid; p < base_l[e] + npe * 256; p += NTHR) { ROWGATE[p] = 0.f; ROWRS[p] = 0.f; } }
                        if (tid == 0) { int np = 0; for (int e = 0; e < 8; ++e) { const int npe = (tot_l[e] + 255) >> 8; for (int j = 0; j < npe; ++j) PANE[np++] = e; } PANE[MAXPAN] = np; } }
                    __syncthreads();
                    for (int i = 0; i < 16; ++i) { const int sl = wave * 16 + i; const int m = blk * 64 + (sl >> 1); const int p = pos_l[sl];
                        const v4u* s = (const v4u*)(XB + (size_t)m * D) + lane; v4u* d = (v4u*)(XS + (size_t)p * D) + lane; d[0] = s[0]; d[64] = s[64]; }
                }
            }
            SEAM(pb + 6);
            if (IN(pb + 7)) {
                pg8::Gemm g{XS, WE13, MAXROWS, 2 * FE, D}; pg8::MoeOrder S{PANE, PANE[MAXPAN], 28, G, bx};
                pg8::EpiGlu<true> E{HE, FE, ROWRS};
                pg8::gemm_phase<pg8::EpiGlu<true>, pg8::MoeOrder, true, true>(ldsl, g, S, E);
            }
            SEAM(pb + 7);
            if (IN(pb + 8)) {
                unsigned* scr = (unsigned*)(lds + wave * 8704);
                constexpr int T_J = 56 * 16;
                for (int it = gw; it < 8 * T_J; it += NGW) { const int e = it / T_J, r = it % T_J;
                    transpose_tile(args.moe_w2 + (size_t)e * FE * D, D, 64 * (r / 16), 64 * (r % 16), WE2 + (size_t)e * D * FE, FE, 64 * (r % 16), nullptr, scr, lane); }
            }
            SEAM(pb + 8);
            if (IN(pb + 9)) {
                pg8::Gemm g{HE, WE2, MAXROWS, D, FE}; pg8::MoeOrder S{PANE, PANE[MAXPAN], 4, G, bx};
                pg8::EpiMoeDown E{Y, ROWGATE};
                pg8::gemm_phase<pg8::EpiMoeDown, pg8::MoeOrder, true, true>(ldsl, g, S, E);
            }
            SEAM(pb + 9);
            if (IN(pb + 10)) {
                for (int m = gw; m < M; m += NGW) {
                    f32x4* xr = (f32x4*)(X + (size_t)m * D) + lane; const int p0 = POS[m * 2], p1 = POS[m * 2 + 1];
                    const unsigned long long* y0 = (const unsigned long long*)(Y + (size_t)p0 * D) + lane; const unsigned long long* y1 = (const unsigned long long*)(Y + (size_t)p1 * D) + lane;
                    f32x4 v[4]; float s = 0.f;
#pragma unroll
                    for (int j = 0; j < 4; ++j) { v[j] = xr[64 * j]; const unsigned long long a = y0[64 * j], c = y1[64 * j];
                        v[j][0] += bflo((unsigned)a) + bflo((unsigned)c); v[j][1] += bfhi((unsigned)a) + bfhi((unsigned)c);
                        v[j][2] += bflo((unsigned)(a >> 32)) + bflo((unsigned)(c >> 32)); v[j][3] += bfhi((unsigned)(a >> 32)) + bfhi((unsigned)(c >> 32));
                        s += (v[j][0] * v[j][0] + v[j][1] * v[j][1]) + (v[j][2] * v[j][2] + v[j][3] * v[j][3]); }
                    const float rs = 1.0f / sqrtf(wave_sum(s) * (1.0f / D) + pg8::RMS_EPS);
                    const f32x4* gf = (const f32x4*)args.g_final + lane;
#pragma unroll
                    for (int j = 0; j < 4; ++j) xr[64 * j] = v[j] * rs * gf[64 * j];
                }
            }
        }
}

__global__ void __launch_bounds__(NTHR, 2) hybrid_fwd(Args args) {
    extern __shared__ __attribute__((aligned(16))) unsigned char lds[];
    LAS unsigned char* ldsl = (LAS unsigned char*)lds;
    volatile LAS unsigned* MISC = (volatile LAS unsigned*)(ldsl + MISC_OFF);
    const int tid = threadIdx.x, lane = tid & 63, wave = __builtin_amdgcn_readfirstlane(tid >> 6);
    const int G = gridDim.x; const int bx = blockIdx.x;
    const int gw = bx * NWAVES + wave, NGW = G * NWAVES;
    unsigned char* ws = args.ws;
    for (int u = tid; u < (LDS_BYTES - LDSCTL_OFF) / 4; u += NTHR) ((LAS unsigned*)(ldsl + LDSCTL_OFF))[u] = 0u;
    __syncthreads();
    XcdBarrier bar; bar.bar = (unsigned*)(ws + WS_CTL) + CW_BAR + args.li * XCD_BAR_WORDS; bar.x = 0; bar.st = nullptr;
    if (MK_N_LAUNCHES == 1) bar = xcd_barrier_post((unsigned*)(ws + WS_CTL) + CW_BAR + args.li * XCD_BAR_WORDS, MISC + 8);
    const int lo = args.ph_lo, hi = args.ph_hi;

    WS_PTRS

    if (IN(0)) {
        unsigned* scr = (unsigned*)(lds + wave * 8704);
        constexpr int T_A = 16 * 36, T_B = 16 * 12, T_D = 16 * 16, T_L = T_A + T_B + T_D;
        constexpr int T_F = 16 * 44, T_G = 44 * 16, T_E = 16 * 56;
        constexpr int NT0 = 2 * T_L + 2 * T_F + T_G + 16 * T_E;
        for (int it = gw; it < NT0; it += NGW) {
            int r = it;
            if (r < 2 * T_L) { const int l = r / T_L; r -= l * T_L; const float* win = args.w_mix_in + (size_t)l * D * INC; const float* gm = args.g_mix + l * D;
                bf16* WIN = (bf16*)(ws + WS_WIN) + (size_t)l * NU * D;
                if (r < T_A) { transpose_tile(win, INC, 64 * (r / 36), 64 * (r % 36), WIN, D, 64 * (r % 36), gm, scr, lane); continue; } r -= T_A;
                if (r < T_B) { transpose_tile(win, INC, 64 * (r / 12), 2320 + 64 * (r % 12), WIN, D, 2304 + 64 * (r % 12), gm, scr, lane); continue; } r -= T_B;
                transpose_tile(args.w_mix_out + (size_t)l * D * D, D, 64 * (r / 16), 64 * (r % 16), (bf16*)(ws + WS_WOUT) + (size_t)l * D * D, D, 64 * (r % 16), nullptr, scr, lane); continue; }
            r -= 2 * T_L;
            if (r < 2 * T_F) { const int w3 = r / T_F; r -= w3 * T_F; const int n0 = 64 * (r % 44);
                transpose_tile(w3 ? args.ffn_w3 : args.ffn_w1, FF, 64 * (r / 44), n0, W13, D, (n0 >> 7) * 256 + (n0 & 127) + 128 * w3, args.g_ffn, scr, lane); continue; }
            r -= 2 * T_F;
            if (r < T_G) { transpose_tile(args.ffn_w2, D, 64 * (r / 16), 64 * (r % 16), W2, FF, 64 * (r % 16), nullptr, scr, lane); continue; }
            r -= T_G;
            { const int ew = r / T_E; r -= ew * T_E; const int e = ew >> 1, w3 = ew & 1; const int n0 = 64 * (r % 56);
              transpose_tile((w3 ? args.moe_w3 : args.moe_w1) + (size_t)e * D * FE, FE, 64 * (r / 56), n0, WE13 + (size_t)e * 2 * FE * D, D, (n0 >> 7) * 256 + (n0 & 127) + 128 * w3, args.g_ffn + D, scr, lane); }
        }
        for (int m = gw; m < M; m += NGW) {
            const f32x4* xr = (const f32x4*)(args.x + (size_t)m * D) + lane; float s = 0.f;
            unsigned long long* o8 = (unsigned long long*)(XB + (size_t)m * D) + lane;
#pragma unroll
            for (int j = 0; j < 4; ++j) { const f32x4 v = xr[64 * j]; s += (v[0] * v[0] + v[1] * v[1]) + (v[2] * v[2] + v[3] * v[3]);
                o8[64 * j] = (unsigned long long)pk2(v[0], v[1]) | ((unsigned long long)pk2(v[2], v[3]) << 32); }
            s = wave_sum(s);
            if (lane < 16) SS[(size_t)m * 16 + lane] = (lane == 0) ? s : 0.f;
        }
        for (int i = bx * NTHR + tid; i < 2049 * 4; i += G * NTHR) { const int d = i >> 2, h = i & 3; BL[i] = args.rel_bias[rel_bucket(d) * 4 + h] * LOG2E; }
        for (int i = bx * NTHR + tid; i < 2 * 16 * D; i += G * NTHR) { const int k = i & (D - 1), r = (i >> 10) & 15, l = i >> 14;
            ((bf16*)(ws + WS_WGLR))[i] = (bf16)f2bf(args.g_mix[l * D + k] * args.w_mix_in[((size_t)l * D + k) * INC + 2304 + r]); }
    }
    SEAM(0);

    Ctx c; c.args = args; c.tid = tid; c.lane = lane; c.wave = wave; c.G = G; c.bx = bx; c.gw = gw; c.NGW = NGW; c.lo = lo; c.hi = hi; c.bar = bar;
    layer_phases<0>(c, lds);
    layer_phases<1>(c, lds);
}
#undef IN
#undef SEAM
#undef GRID_BAR


extern "C" void kernel_launch(void* const* d_in, const int* in_sizes, int n_in, void* d_out, int out_size, void* d_ws, size_t ws_size, hipStream_t stream) {
    static int grid = 0;
    if (grid == 0) {
        if (n_in != 18 || in_sizes[0] != M * D || out_size != M * D || ws_size < WS_END) { fprintf(stderr, "kernel_launch: unexpected shapes / workspace (%zu < %zu)\n", ws_size, (size_t)WS_END); grid = -1; return; }
        int dev = 0, cus = 0, per_cu = 0;
        if (hipGetDevice(&dev) != hipSuccess || hipDeviceGetAttribute(&cus, hipDeviceAttributeMultiprocessorCount, dev) != hipSuccess) { grid = -1; return; }
        if (hipFuncSetAttribute((const void*)hybrid_fwd, hipFuncAttributeMaxDynamicSharedMemorySize, LDS_BYTES) != hipSuccess) { fprintf(stderr, "kernel_launch: hipFuncSetAttribute failed\n"); grid = -1; return; }
        if (hipOccupancyMaxActiveBlocksPerMultiprocessor(&per_cu, (const void*)hybrid_fwd, NTHR, LDS_BYTES) != hipSuccess || per_cu < 1) { fprintf(stderr, "kernel_launch: occupancy query says %d\n", per_cu); }
        (void)hipGetLastError();
        grid = cus;
    }
    if (grid < 0) return;
    if (hipMemsetAsync((char*)d_ws + WS_CTL, 0, CTL_ZERO_BYTES, stream) != hipSuccess) return;
    Args a{};
    const float** f = (const float**)&a;
    for (int i = 0; i < 18; ++i) f[i] = (const float*)d_in[i];
    a.out = (float*)d_out; a.ws = (unsigned char*)d_ws;
    if (MK_N_LAUNCHES == 1) {
#ifdef PROBE_PHASE
        const int cuts[4][2] = {{0, PROBE_PHASE + 1}, {PROBE_PHASE, PROBE_PHASE + 1}, {PROBE_PHASE + 1, 64}, {0, 0}};
        for (int li = 0; li < 3; ++li) { a.ph_lo = cuts[li][0]; a.ph_hi = cuts[li][1]; a.li = li; hipLaunchKernelGGL(hybrid_fwd, dim3(grid), dim3(NTHR), LDS_BYTES, stream, a); }
#else
        a.ph_lo = 0; a.ph_hi = 64; a.li = 0; hipLaunchKernelGGL(hybrid_fwd, dim3(grid), dim3(NTHR), LDS_BYTES, stream, a);
#endif
    }
    else {
        static const int phases[] = {0, 1, 2, 3, 4, 5, 6, 7, 17, 18, 19, 20, 21, 22, 23, 24, 25, 26, 27};
        for (int p : phases) { a.ph_lo = p; a.ph_hi = p + 1; hipLaunchKernelGGL(hybrid_fwd, dim3(grid), dim3(NTHR), LDS_BYTES, stream, a); }
    }
}
```

```cpp
#include <hip/hip_runtime.h>
#include <cstdio>
#include <cstdint>

#ifndef MK_N_LAUNCHES
#define MK_N_LAUNCHES 1
#endif

namespace pg8 {
#define PG8_LAS __attribute__((address_space(3)))
typedef unsigned short bf16_t;
typedef short bf16x8 __attribute__((ext_vector_type(8)));
typedef float f32x4 __attribute__((ext_vector_type(4)));
typedef unsigned u32x4 __attribute__((ext_vector_type(4)));
typedef unsigned u32x2 __attribute__((ext_vector_type(2)));
constexpr int BM = 256, BK = 64, HALF = 128, HTB = HALF * BK * 2, STAGE_BYTES = 8 * HTB, NXCD = 8, WGM = 8;

__host__ __device__ __forceinline__ int lds_byte(int r, int c) { const int st = (r >> 4) * 2 + (c >> 5), rr = r & 15, cc = c & 31, ob = rr * 64 + cc * 2; return st * 1024 + (ob ^ (((ob >> 9) & 1) << 5)); }
__host__ __device__ __forceinline__ void stage_rc(int b, int& R, int& C) { const int st = b / 1024, sb = b % 1024, swz = sb ^ (((sb >> 9) & 1) << 5); R = (st >> 1) * 16 + swz / 64; C = (st & 1) * 32 + (swz % 64) / 2; }
__host__ __device__ __forceinline__ int perm32(int rho) { const int n = rho >> 4, i = rho & 15; return 8 * (i >> 2) + 4 * n + (i & 3); }

struct Unit { int pm, pn; };
struct Gemm { const bf16_t* A; const bf16_t* Bt; int M, N, K; };

struct StaticOrder {
    int nM, nN, nwg, G, c;
    __host__ __device__ void init(int M, int N, int G_, int c_) { nM = M / BM; nN = N / BM; nwg = nM * nN; G = G_; c = c_; }
    __host__ __device__ bool next(int i, Unit& u) const {
        const long L = (long)i * G + c; if (L >= nwg) return false;
        int wgid = (int)L; { const int q = nwg / NXCD, r = nwg % NXCD, xcd = wgid % NXCD, off = wgid / NXCD; wgid = (xcd < r ? xcd * (q + 1) : r * (q + 1) + (xcd - r) * q) + off; }
        const int nig = WGM * nN, gid = wgid / nig, fm = gid * WGM, gsz = (nM - fm) < WGM ? (nM - fm) : WGM;
        u.pm = fm + ((wgid % nig) % gsz); u.pn = (wgid % nig) / gsz; return true;
    }
    __device__ __forceinline__ void a_ready(const Unit&) const {}
    __device__ __forceinline__ void done(const Unit&) const {}
};
struct MoeOrder {
    const int* panel_e; int npan, NT, GP, G, c;
    __device__ bool next(int i, Unit& u) const {
        const int nwg = npan * NT; const long L = (long)i * G + c; if (L >= nwg) return false;
        int wgid = (int)L; { const int q = nwg / NXCD, r = nwg % NXCD, xcd = wgid % NXCD, off = wgid / NXCD; wgid = (xcd < r ? xcd * (q + 1) : r * (q + 1) + (xcd - r) * q) + off; }
        const int nig = GP * NT, grp = wgid / nig, fm = grp * GP, gsz = (npan - fm) < GP ? (npan - fm) : GP; const int rr = wgid % nig;
        const int p = fm + rr % gsz; u.pm = p; u.pn = panel_e[p] * NT + rr / gsz; return true;
    }
    __device__ __forceinline__ void a_ready(const Unit&) const {}
    __device__ __forceinline__ void done(const Unit&) const {}
};

__device__ __forceinline__ unsigned cvt_pk_bf16(float lo, float hi) { unsigned r; asm volatile("v_cvt_pk_bf16_f32 %0, %1, %2" : "=v"(r) : "v"(lo), "v"(hi)); return r; }

constexpr float RMS_EPS = 1e-6f;
__device__ __forceinline__ float rstd_of(const float* ss16) {
    const f32x4 a = *(const f32x4*)ss16, b = *(const f32x4*)(ss16 + 4), c = *(const f32x4*)(ss16 + 8), d = *(const f32x4*)(ss16 + 12);
    const float s = ((a[0] + a[1]) + (a[2] + a[3])) + ((b[0] + b[1]) + (b[2] + b[3])) + ((c[0] + c[1]) + (c[2] + c[3])) + ((d[0] + d[1]) + (d[2] + d[3]));
    return 1.0f / sqrtf(s * (1.0f / 1024.0f) + RMS_EPS);
}
__device__ __forceinline__ void rstd4(const float* SS, int row0, float (&rs)[4]) {
    f32x4 p[4][4];
#pragma unroll
    for (int m = 0; m < 4; ++m)
#pragma unroll
        for (int q = 0; q < 4; ++q) p[m][q] = *(const f32x4*)(SS + (size_t)(row0 + 16 * m) * 16 + 4 * q);
    asm volatile("" : "+v"(p[0][0]), "+v"(p[0][1]), "+v"(p[0][2]), "+v"(p[0][3]), "+v"(p[1][0]), "+v"(p[1][1]), "+v"(p[1][2]), "+v"(p[1][3]),
                      "+v"(p[2][0]), "+v"(p[2][1]), "+v"(p[2][2]), "+v"(p[2][3]), "+v"(p[3][0]), "+v"(p[3][1]), "+v"(p[3][2]), "+v"(p[3][3]));
#pragma unroll
    for (int m = 0; m < 4; ++m) { const f32x4 a = p[m][0], b = p[m][1], c = p[m][2], d = p[m][3];
        const float s = ((a[0] + a[1]) + (a[2] + a[3])) + ((b[0] + b[1]) + (b[2] + b[3])) + ((c[0] + c[1]) + (c[2] + c[3])) + ((d[0] + d[1]) + (d[2] + d[3]));
        rs[m] = 1.0f / sqrtf(s * (1.0f / 1024.0f) + RMS_EPS); }
}
__device__ __forceinline__ float logsig16(float x) { return ((x < 0.f ? x : 0.f) - log1pf(__expf(-fabsf(x)))) * (1.0f / 16.0f); }
__device__ __forceinline__ float silu_f(float a) { return a / (1.0f + __expf(-a)); }

struct EpiU {
    static constexpr bool PERM = true, AFTER_DRAIN = false;
    bf16_t* U; int ldu; const float* SS; float qs;
    __device__ __forceinline__ void operator()(const f32x4 (&acc)[2][2][4][2], const Unit& u, int wr, int wc, int fr, int fq) const {
        const int row0 = u.pm * BM + wr * 64 + fr, col0 = u.pn * BM + wc * 32 + 8 * fq;
        const float sc = (u.pn == 0) ? qs : ((u.pn == 3) ? 0.125f : 1.0f);
#pragma unroll
        for (int ai = 0; ai < 2; ++ai) { float rs4[4]; rstd4(SS, row0 + ai * HALF, rs4);
#pragma unroll
            for (int m = 0; m < 4; ++m) { const int row = row0 + ai * HALF + m * 16; const float rs = rs4[m] * sc;
                bf16_t* rowp = U + (size_t)row * ldu + col0;
#pragma unroll
                for (int bj = 0; bj < 2; ++bj) { const f32x4 v0 = acc[ai][bj][m][0] * rs, v1 = acc[ai][bj][m][1] * rs;
                    u32x4 w; w.x = cvt_pk_bf16(v0[0], v0[1]); w.y = cvt_pk_bf16(v0[2], v0[3]); w.z = cvt_pk_bf16(v1[0], v1[1]); w.w = cvt_pk_bf16(v1[2], v1[3]);
                    *(u32x4*)(rowp + bj * HALF) = w; } } }
    }
};
template <bool IN_F32, int PM = 0> struct EpiRes {
    static constexpr bool PERM = true, AFTER_DRAIN = false;
    const void* Xin; bf16_t* XB; float* SS;
    __device__ __forceinline__ void operator()(const f32x4 (&acc)[2][2][4][2], const Unit& u, int wr, int wc, int fr, int fq) const {
        const int row0 = u.pm * BM + wr * 64 + fr, col0 = u.pn * BM + wc * 32 + 8 * fq;
        if constexpr (IN_F32) {
#pragma unroll
            for (int ai = 0; ai < 2; ++ai) { f32x4 xo[4][2][2];
#pragma unroll
                for (int m = 0; m < 4; ++m)
#pragma unroll
                    for (int bj = 0; bj < 2; ++bj) { const float* p = (const float*)Xin + (size_t)(row0 + ai * HALF + m * 16) * 1024 + col0 + bj * HALF; xo[m][bj][0] = *(const f32x4*)p; xo[m][bj][1] = *(const f32x4*)(p + 4); }
                asm volatile("" : "+v"(xo[0][0][0]), "+v"(xo[0][0][1]), "+v"(xo[0][1][0]), "+v"(xo[0][1][1]), "+v"(xo[1][0][0]), "+v"(xo[1][0][1]), "+v"(xo[1][1][0]), "+v"(xo[1][1][1]),
                                  "+v"(xo[2][0][0]), "+v"(xo[2][0][1]), "+v"(xo[2][1][0]), "+v"(xo[2][1][1]), "+v"(xo[3][0][0]), "+v"(xo[3][0][1]), "+v"(xo[3][1][0]), "+v"(xo[3][1][1]));
#pragma unroll
                for (int m = 0; m < 4; ++m) { const int row = row0 + ai * HALF + m * 16; float ssum = 0.f;
#pragma unroll
                    for (int bj = 0; bj < 2; ++bj) { const f32x4 v0 = xo[m][bj][0] + acc[ai][bj][m][0], v1 = xo[m][bj][1] + acc[ai][bj][m][1];
                        u32x4 w; w.x = cvt_pk_bf16(v0[0], v0[1]); w.y = cvt_pk_bf16(v0[2], v0[3]); w.z = cvt_pk_bf16(v1[0], v1[1]); w.w = cvt_pk_bf16(v1[2], v1[3]);
                        *(u32x4*)(XB + (size_t)row * 1024 + col0 + bj * HALF) = w;
                        ssum += ((v0[0] * v0[0] + v0[1] * v0[1]) + (v0[2] * v0[2] + v0[3] * v0[3])) + ((v1[0] * v1[0] + v1[1] * v1[1]) + (v1[2] * v1[2] + v1[3] * v1[3])); }
                    ssum += __shfl_xor(ssum, 16); ssum += __shfl_xor(ssum, 32);
                    if (fq == 0) SS[(size_t)row * 16 + u.pn * 4 + wc] = ssum; } }
        } else {
            u32x4 xo[2][4][2];
#pragma unroll
            for (int ai = 0; ai < 2; ++ai)
#pragma unroll
                for (int m = 0; m < 4; ++m)
#pragma unroll
                    for (int bj = 0; bj < 2; ++bj) xo[ai][m][bj] = *(const u32x4*)((const bf16_t*)Xin + (size_t)(row0 + ai * HALF + m * 16) * 1024 + col0 + bj * HALF);
            asm volatile("" : "+v"(xo[0][0][0]), "+v"(xo[0][0][1]), "+v"(xo[0][1][0]), "+v"(xo[0][1][1]), "+v"(xo[0][2][0]), "+v"(xo[0][2][1]), "+v"(xo[0][3][0]), "+v"(xo[0][3][1]),
                              "+v"(xo[1][0][0]), "+v"(xo[1][0][1]), "+v"(xo[1][1][0]), "+v"(xo[1][1][1]), "+v"(xo[1][2][0]), "+v"(xo[1][2][1]), "+v"(xo[1][3][0]), "+v"(xo[1][3][1]));
#pragma unroll
            for (int ai = 0; ai < 2; ++ai)
#pragma unroll
                for (int m = 0; m < 4; ++m) { const int row = row0 + ai * HALF + m * 16; float ssum = 0.f;
#pragma unroll
                    for (int bj = 0; bj < 2; ++bj) { const u32x4 x = xo[ai][m][bj]; f32x4 v0, v1;
                        v0[0] = __builtin_bit_cast(float, x.x << 16) + acc[ai][bj][m][0][0]; v0[1] = __builtin_bit_cast(float, x.x & 0xffff0000u) + acc[ai][bj][m][0][1];
                        v0[2] = __builtin_bit_cast(float, x.y << 16) + acc[ai][bj][m][0][2]; v0[3] = __builtin_bit_cast(float, x.y & 0xffff0000u) + acc[ai][bj][m][0][3];
                        v1[0] = __builtin_bit_cast(float, x.z << 16) + acc[ai][bj][m][1][0]; v1[1] = __builtin_bit_cast(float, x.z & 0xffff0000u) + acc[ai][bj][m][1][1];
                        v1[2] = __builtin_bit_cast(float, x.w << 16) + acc[ai][bj][m][1][2]; v1[3] = __builtin_bit_cast(float, x.w & 0xffff0000u) + acc[ai][bj][m][1][3];
                        u32x4 w; w.x = cvt_pk_bf16(v0[0], v0[1]); w.y = cvt_pk_bf16(v0[2], v0[3]); w.z = cvt_pk_bf16(v1[0], v1[1]); w.w = cvt_pk_bf16(v1[2], v1[3]);
                        if constexpr (!(PM & 8)) *(u32x4*)(XB + (size_t)row * 1024 + col0 + bj * HALF) = w;
                        ssum += ((v0[0] * v0[0] + v0[1] * v0[1]) + (v0[2] * v0[2] + v0[3] * v0[3])) + ((v1[0] * v1[0] + v1[1] * v1[1]) + (v1[2] * v1[2] + v1[3] * v1[3])); }
                    if constexpr (!(PM & 16)) { ssum += __shfl_xor(ssum, 16); ssum += __shfl_xor(ssum, 32); }
                    if constexpr (!(PM & 4)) { if (fq == 0) SS[(size_t)row * 16 + u.pn * 4 + wc] = ssum; }
                    if constexpr ((PM & 12) == 12) asm volatile("" :: "v"(ssum)); }
        }
    }
};
template <bool MOE> struct EpiGlu {
    static constexpr bool PERM = true, AFTER_DRAIN = false;
    bf16_t* O; int ldo; const float* SS;
    __device__ __forceinline__ void operator()(const f32x4 (&acc)[2][2][4][2], const Unit& u, int wr, int wc, int fr, int fq) const {
        const int row0 = u.pm * BM + wr * 64 + fr; const int pnl = MOE ? (u.pn % 28) : u.pn; const int col0 = pnl * HALF + wc * 32 + 8 * fq;
#pragma unroll
        for (int ai = 0; ai < 2; ++ai) { float rs4[4];
            if constexpr (MOE) {
#pragma unroll
                for (int m = 0; m < 4; ++m) rs4[m] = SS[row0 + ai * HALF + m * 16];
                asm volatile("" : "+v"(rs4[0]), "+v"(rs4[1]), "+v"(rs4[2]), "+v"(rs4[3]));
            } else rstd4(SS, row0 + ai * HALF, rs4);
#pragma unroll
            for (int m = 0; m < 4; ++m) { const int row = row0 + ai * HALF + m * 16; const float rs = rs4[m];
                const f32x4 a0 = acc[ai][0][m][0] * rs, a1 = acc[ai][0][m][1] * rs, b0 = acc[ai][1][m][0] * rs, b1 = acc[ai][1][m][1] * rs;
                f32x4 g0, g1;
#pragma unroll
                for (int j = 0; j < 4; ++j) { g0[j] = silu_f(a0[j]) * b0[j]; g1[j] = silu_f(a1[j]) * b1[j]; }
                u32x4 w; w.x = cvt_pk_bf16(g0[0], g0[1]); w.y = cvt_pk_bf16(g0[2], g0[3]); w.z = cvt_pk_bf16(g1[0], g1[1]); w.w = cvt_pk_bf16(g1[2], g1[3]);
                *(u32x4*)(O + (size_t)row * ldo + col0) = w; } }
    }
};
struct EpiMoeDown {
    static constexpr bool PERM = true, AFTER_DRAIN = false;
    bf16_t* Y; const float* gate;
    __device__ __forceinline__ void operator()(const f32x4 (&acc)[2][2][4][2], const Unit& u, int wr, int wc, int fr, int fq) const {
        const int row0 = u.pm * BM + wr * 64 + fr, col0 = (u.pn & 3) * BM + wc * 32 + 8 * fq;
        float gt[2][4];
#pragma unroll
        for (int ai = 0; ai < 2; ++ai)
#pragma unroll
            for (int m = 0; m < 4; ++m) gt[ai][m] = gate[row0 + ai * HALF + m * 16];
        asm volatile("" : "+v"(gt[0][0]), "+v"(gt[0][1]), "+v"(gt[0][2]), "+v"(gt[0][3]), "+v"(gt[1][0]), "+v"(gt[1][1]), "+v"(gt[1][2]), "+v"(gt[1][3]));
#pragma unroll
        for (int ai = 0; ai < 2; ++ai)
#pragma unroll
            for (int m = 0; m < 4; ++m) { const int row = row0 + ai * HALF + m * 16; const float g = gt[ai][m]; bf16_t* rowp = Y + (size_t)row * 1024 + col0;
#pragma unroll
                for (int bj = 0; bj < 2; ++bj) { const f32x4 v0 = acc[ai][bj][m][0] * g, v1 = acc[ai][bj][m][1] * g;
                    u32x4 w; w.x = cvt_pk_bf16(v0[0], v0[1]); w.y = cvt_pk_bf16(v0[2], v0[3]); w.z = cvt_pk_bf16(v1[0], v1[1]); w.w = cvt_pk_bf16(v1[2], v1[3]);
                    *(u32x4*)(rowp + bj * HALF) = w; } }
    }
};

template <class Epi, class Sched, bool ALIGN_EPI = false, bool SP2 = false>
__device__ __forceinline__ void gemm_phase(PG8_LAS unsigned char* lds, const Gemm g, const Sched& S, const Epi& E, const bool skip_epi = false) {
    const int tid = threadIdx.x, wid = __builtin_amdgcn_readfirstlane(tid >> 6), lane = tid & 63, wr = wid >> 2, wc = wid & 3, fr = lane & 15, fq = lane >> 4;
    const int K = g.K, nt = K / BK;
    unsigned voffA[2], voffB[2];
#pragma unroll
    for (int i = 0; i < 2; ++i) { int R, C; stage_rc(tid * 16 + i * 8192, R, C); const int Rb = Epi::PERM ? ((R & ~31) + perm32(R & 31)) : R;
        voffA[i] = (unsigned)(R * K + C) * 2u; voffB[i] = (unsigned)(Rb * K + C) * 2u; }
    const size_t kstep = (size_t)(BK * 2);
    const size_t hstep = (size_t)HALF * K * 2;
    const size_t tstep = 2 * hstep;
    const unsigned ldsw = (unsigned)wid * 1024u;
    const int aoff = lds_byte(wr * 64 + fr, fq * 8), boff = lds_byte(wc * 32 + fr, fq * 8);
#define PG8_SA(b, h) (((b) * 2 + (h)) * HTB)
#define PG8_SB(b, h) ((4 + (b) * 2 + (h)) * HTB)
#define PG8_STAGE(bufoff, gbase, voff) do { _Pragma("unroll") for (int _i = 0; _i < 2; ++_i) \
        __builtin_amdgcn_global_load_lds((const unsigned*)((const char*)(gbase) + (voff)[_i]), (PG8_LAS unsigned*)(lds + (bufoff) + ldsw + _i * 8192), 16, 0, 0); } while (0)
#define PG8_LDA(dst, b, h) do { _Pragma("unroll") for (int m = 0; m < 4; ++m) _Pragma("unroll") for (int k = 0; k < 2; ++k) dst[m][k] = *(const PG8_LAS bf16x8*)(lds + PG8_SA(b, h) + aoff + m * 2048 + k * 1024); } while (0)
#define PG8_LDB(dst, b, h) do { _Pragma("unroll") for (int n = 0; n < 2; ++n) _Pragma("unroll") for (int k = 0; k < 2; ++k) dst[n][k] = *(const PG8_LAS bf16x8*)(lds + PG8_SB(b, h) + boff + n * 2048 + k * 1024); } while (0)
#define PG8_MMA(ai, bj, At, Bt) do { __builtin_amdgcn_s_setprio(1); _Pragma("unroll") for (int m = 0; m < 4; ++m) _Pragma("unroll") for (int n = 0; n < 2; ++n) _Pragma("unroll") for (int k = 0; k < 2; ++k) \
        acc[ai][bj][m][n] = __builtin_amdgcn_mfma_f32_16x16x32_bf16(Bt[n][k], At[m][k], acc[ai][bj][m][n], 0, 0, 0); __builtin_amdgcn_s_setprio(0); } while (0)
#define PG8_WAIT_V(n) asm volatile("s_waitcnt vmcnt(" #n ")" ::: "memory")
#define PG8_WAIT_L(n) asm volatile("s_waitcnt lgkmcnt(" #n ")" ::: "memory")
#define PG8_BAR __builtin_amdgcn_s_barrier()
#define PG8_SCHED __builtin_amdgcn_sched_barrier(0)
    Unit cur, nxt; int ui = 0;
    if (!S.next(0, cur)) return;
    f32x4 acc[2][2][4][2];
#pragma unroll
    for (int a = 0; a < 2; ++a)
#pragma unroll
        for (int b = 0; b < 2; ++b)
#pragma unroll
            for (int m = 0; m < 4; ++m)
#pragma unroll
                for (int n = 0; n < 2; ++n) acc[a][b][m][n] = (f32x4){0.f, 0.f, 0.f, 0.f};
    bf16x8 At[4][2], B0[2][2], B1[2][2];
    const char* cA = (const char*)g.A + (size_t)cur.pm * tstep; const char* cB = (const char*)g.Bt + (size_t)cur.pn * tstep;
    S.a_ready(cur);
    if constexpr (SP2) {
        PG8_STAGE(PG8_SB(0, 0), cB, voffB); PG8_STAGE(PG8_SB(0, 1), cB + hstep, voffB); PG8_STAGE(PG8_SA(0, 0), cA, voffA); PG8_STAGE(PG8_SA(0, 1), cA + hstep, voffA);
        if (wr == 1) PG8_BAR;
        PG8_WAIT_V(2); PG8_BAR;
        PG8_STAGE(PG8_SB(1, 0), cB + kstep, voffB); PG8_STAGE(PG8_SA(1, 0), cA + kstep, voffA); PG8_STAGE(PG8_SB(1, 1), cB + hstep + kstep, voffB);
        PG8_WAIT_V(6); PG8_BAR;
    } else {
        PG8_STAGE(PG8_SB(0, 0), cB, voffB); PG8_STAGE(PG8_SA(0, 0), cA, voffA); PG8_STAGE(PG8_SB(0, 1), cB + hstep, voffB); PG8_STAGE(PG8_SA(0, 1), cA + hstep, voffA);
        if (wr == 1) PG8_BAR;
        PG8_WAIT_V(4); PG8_BAR;
        PG8_STAGE(PG8_SB(1, 0), cB + kstep, voffB); PG8_STAGE(PG8_SA(1, 0), cA + kstep, voffA); PG8_STAGE(PG8_SB(1, 1), cB + hstep + kstep, voffB);
        PG8_WAIT_V(6); PG8_BAR;
    }
    for (;;) {
        const bool has_next = S.next(ui + 1, nxt);
        const char* nA = has_next ? (const char*)g.A + (size_t)nxt.pm * tstep : cA; const char* nB = has_next ? (const char*)g.Bt + (size_t)nxt.pn * tstep : cB;
        for (int t = 0; t < nt; t += 2) {
            const bool last = (t == nt - 2);
            const char* a1 = cA + (size_t)(t + 1) * kstep;
            const char* a2 = last ? nA : cA + (size_t)(t + 2) * kstep; const char* b2 = last ? nB : cB + (size_t)(t + 2) * kstep;
            const char* a3 = a2 + kstep; const char* b3 = b2 + kstep;
            if (last && has_next) S.a_ready(nxt);
            if constexpr (SP2) {
            PG8_LDB(B0, 0, 0); PG8_LDB(B1, 0, 1); PG8_SCHED; PG8_LDA(At, 0, 0); PG8_STAGE(PG8_SA(1, 1), a1 + hstep, voffA);
            PG8_WAIT_V(8); PG8_WAIT_L(0); PG8_BAR; PG8_MMA(0, 0, At, B0); PG8_MMA(0, 1, At, B1); PG8_BAR; PG8_SCHED;
            PG8_LDA(At, 0, 1); PG8_STAGE(PG8_SB(0, 0), b2, voffB); PG8_STAGE(PG8_SB(0, 1), b2 + hstep, voffB); PG8_STAGE(PG8_SA(0, 0), a2, voffA);
            PG8_WAIT_V(8); PG8_WAIT_L(0); PG8_BAR; PG8_MMA(1, 0, At, B0); PG8_MMA(1, 1, At, B1); PG8_BAR; PG8_SCHED;
            PG8_LDB(B0, 1, 0); PG8_LDB(B1, 1, 1); PG8_SCHED; PG8_LDA(At, 1, 0); PG8_STAGE(PG8_SA(0, 1), a2 + hstep, voffA);
            PG8_WAIT_V(8); PG8_WAIT_L(0); PG8_BAR; PG8_MMA(0, 0, At, B0); PG8_MMA(0, 1, At, B1); PG8_BAR; PG8_SCHED;
            PG8_LDA(At, 1, 1); PG8_STAGE(PG8_SB(1, 0), b3, voffB); PG8_STAGE(PG8_SB(1, 1), b3 + hstep, voffB); PG8_STAGE(PG8_SA(1, 0), a3, voffA);
            PG8_WAIT_V(8); PG8_WAIT_L(0); PG8_BAR; PG8_MMA(1, 0, At, B0); PG8_MMA(1, 1, At, B1); PG8_BAR; PG8_SCHED;
            } else {
            PG8_LDB(B0, 0, 0); PG8_SCHED; PG8_LDA(At, 0, 0); PG8_STAGE(PG8_SA(1, 1), a1 + hstep, voffA);
            PG8_WAIT_L(8); PG8_BAR; PG8_WAIT_L(0); PG8_MMA(0, 0, At, B0); PG8_BAR; PG8_SCHED;
            PG8_LDB(B1, 0, 1); PG8_STAGE(PG8_SB(0, 0), b2, voffB);
            PG8_BAR; PG8_WAIT_L(0); PG8_MMA(0, 1, At, B1); PG8_BAR;
            PG8_LDA(At, 0, 1); PG8_STAGE(PG8_SA(0, 0), a2, voffA);
            PG8_BAR; PG8_WAIT_L(0); PG8_MMA(1, 0, At, B0); PG8_BAR; PG8_SCHED;
            PG8_STAGE(PG8_SB(0, 1), b2 + hstep, voffB);
            PG8_WAIT_V(6); PG8_BAR; PG8_MMA(1, 1, At, B1); PG8_BAR;
            PG8_LDB(B0, 1, 0); PG8_SCHED; PG8_LDA(At, 1, 0); PG8_STAGE(PG8_SA(0, 1), a2 + hstep, voffA);
            PG8_WAIT_L(8); PG8_BAR; PG8_WAIT_L(0); PG8_MMA(0, 0, At, B0); PG8_BAR; PG8_SCHED;
            PG8_LDB(B1, 1, 1); PG8_STAGE(PG8_SB(1, 0), b3, voffB);
            PG8_BAR; PG8_WAIT_L(0); PG8_MMA(0, 1, At, B1); PG8_BAR;
            PG8_LDA(At, 1, 1); PG8_STAGE(PG8_SA(1, 0), a3, voffA);
            PG8_BAR; PG8_WAIT_L(0); PG8_MMA(1, 0, At, B0); PG8_BAR; PG8_SCHED;
            PG8_STAGE(PG8_SB(1, 1), b3 + hstep, voffB);
            PG8_WAIT_V(6); PG8_BAR; PG8_MMA(1, 1, At, B1); PG8_BAR;
            }
        }
        if constexpr (ALIGN_EPI) { if (wr == 0) PG8_BAR; }
        if constexpr (!Epi::AFTER_DRAIN) { if (!skip_epi) E(acc, cur, wr, wc, fr, fq); S.done(cur); }
        if (!has_next) break;
#pragma unroll
        for (int a = 0; a < 2; ++a)
#pragma unroll
            for (int b = 0; b < 2; ++b)
#pragma unroll
                for (int m = 0; m < 4; ++m)
#pragma unroll
                    for (int n = 0; n < 2; ++n) acc[a][b][m][n] = (f32x4){0.f, 0.f, 0.f, 0.f};
        cur = nxt; cA = nA; cB = nB; ++ui;
        if constexpr (ALIGN_EPI) { if (wr == 1) PG8_BAR; }
    }
    PG8_WAIT_V(0);
    if constexpr (!ALIGN_EPI) { if (wr == 0) PG8_BAR; }
    PG8_BAR;
#undef PG8_SA
#undef PG8_SB
#undef PG8_STAGE
#undef PG8_LDA
#undef PG8_LDB
#undef PG8_MMA
#undef PG8_WAIT_V
#undef PG8_WAIT_L
#undef PG8_BAR
#undef PG8_SCHED
}
}

constexpr int NWAVES = 8, NTHR = NWAVES * 64;
constexpr int NB = 8, SEQ = 2048, D = 1024, M = NB * SEQ;
constexpr int INC = 3088;
constexpr int NU = 3072;
constexpr int UQ = 0, UK = 256, UV = 512, UGQ = 768, UGK = 1024, UGV = 1280, UGR = 1792, UCI = 2304, UCB = 2560, UCC = 2816;
constexpr int FF = 2816, FE = 3584, NE = 8;
constexpr int MAXPAN = 136, MAXROWS = MAXPAN * 256;
constexpr float LOG2E = 1.4426950408889634f;
constexpr float QS_ATT = 0.125f * LOG2E;

constexpr size_t MiB = 1u << 20;
constexpr size_t WS_CTL = 0, CTL_ZERO_BYTES = 1 * MiB;
constexpr size_t WS_SS = 1 * MiB;
constexpr size_t WS_BL = 2 * MiB;
constexpr size_t WS_DEC = 2 * MiB + 64 * 1024;
constexpr size_t WS_TOPI = 3 * MiB;
constexpr size_t WS_TOPW = 3 * MiB + 128 * 1024;
constexpr size_t WS_POS = 3 * MiB + 256 * 1024;
constexpr size_t WS_RS3 = 3 * MiB + 384 * 1024;
constexpr size_t WS_CNT = 3 * MiB + 448 * 1024;
constexpr size_t WS_PANE = 3 * MiB + 456 * 1024;
constexpr size_t WS_ROWGATE = 4 * MiB;
constexpr size_t WS_ROWRS = 4 * MiB + 256 * 1024;
constexpr size_t WS_GLR = 5 * MiB;
constexpr size_t WS_WE13 = 8 * MiB;
constexpr size_t WS_Y = WS_WE13;
constexpr size_t WS_XS = 120 * MiB;
constexpr size_t WS_WE2 = WS_XS;
constexpr size_t WS_HE = 188 * MiB;
constexpr size_t WS_WIN = WS_HE;
constexpr size_t WS_WGLR = WS_HE + 12 * MiB;
constexpr size_t WS_WOUT = WS_HE + 13 * MiB;
constexpr size_t WS_W13 = WS_HE + 17 * MiB;
constexpr size_t WS_W2 = WS_HE + 28 * MiB;
constexpr size_t WS_XB = WS_HE + 238 * MiB;
constexpr size_t WS_U = WS_HE + 66 * MiB;
constexpr size_t WS_H = WS_U;
constexpr size_t WS_MIX = WS_HE + 170 * MiB;
constexpr size_t WS_CST = WS_HE + 202 * MiB;
constexpr size_t WS_END = WS_HE + 270 * MiB;
static_assert(WS_CST + 32 * MiB <= WS_END, "ws map");
constexpr int CW_BAR = 4096;
constexpr int CW_SC = 32768;
constexpr int CW_TMO2 = 65536;

constexpr int LDS_BYTES = 147456;
constexpr int LDSCTL_OFF = 131072 + 14 * 1024, MISC_OFF = LDSCTL_OFF + 320;

#define GAS __attribute__((address_space(1)))
#define LAS __attribute__((address_space(3)))
typedef unsigned short bf16;
typedef float f32x4 __attribute__((ext_vector_type(4)));
typedef unsigned v4u __attribute__((ext_vector_type(4)));
__device__ __forceinline__ unsigned f2bf(float f) { unsigned u = __builtin_bit_cast(unsigned, f); return (u + 0x7fffu + ((u >> 16) & 1u)) >> 16; }
__device__ __forceinline__ unsigned pk2(float lo, float hi) { return f2bf(lo) | (f2bf(hi) << 16); }
__device__ __forceinline__ float bf2f(unsigned short b) { return __builtin_bit_cast(float, (unsigned)b << 16); }
__device__ __forceinline__ float bflo(unsigned w) { return __builtin_bit_cast(float, w << 16); }
__device__ __forceinline__ float bfhi(unsigned w) { return __builtin_bit_cast(float, w & 0xffff0000u); }
__device__ __forceinline__ float wave_sum(float v) {
#pragma unroll
    for (int o = 1; o < 64; o <<= 1) v += __shfl_xor(v, o);
    return v;
}
__device__ __forceinline__ float wave_max(float v) {
#pragma unroll
    for (int o = 1; o < 64; o <<= 1) v = fmaxf(v, __shfl_xor(v, o));
    return v;
}

#define XB_TMO      128
#define XB_XCNT(j)  (256  + 64 * (j))
#define XB_XSUB(j)  (1280 + 64 * (j))
#define XB_XGEN(j)  (2304 + 64 * (j))
#define XB_TOP      3328
#define XB_TOPGEN   3392
#define XCD_BAR_WORDS 3456
#define XB_SPIN_CAP (1u << 18)
__device__ __forceinline__ unsigned xb_ld(unsigned* p)              { return __hip_atomic_load(p, __ATOMIC_RELAXED, __HIP_MEMORY_SCOPE_AGENT); }
__device__ __forceinline__ unsigned xb_add(unsigned* p, unsigned v) { return __hip_atomic_fetch_add(p, v, __ATOMIC_RELAXED, __HIP_MEMORY_SCOPE_AGENT); }
__device__ __forceinline__ unsigned xb_xcc_id() { return (unsigned)__builtin_amdgcn_s_getreg((3 << 11) | 20) & 0xFu; }
#define XB_SPIN(cond, bar) do { unsigned _sp = 0; while (cond) { __builtin_amdgcn_s_sleep(1); \
    if ((++_sp & 255u) == 0u) { if (xb_ld(&(bar)[XB_TMO])) break; if (_sp > XB_SPIN_CAP) { atomicAdd(&(bar)[XB_TMO], 1u); break; } } } } while (0)
struct XcdBarrier { unsigned* bar; unsigned x; volatile LAS unsigned* st; };
__device__ __forceinline__ XcdBarrier xcd_barrier_post(unsigned* bar, volatile LAS unsigned* st) {
    XcdBarrier b; b.bar = bar; b.x = xb_xcc_id(); b.st = st;
    if (threadIdx.x == 0) (void)xb_add(&bar[XB_XCNT(b.x)], 1u);
    return b;
}
__device__ __forceinline__ void xcd_barrier_complete(unsigned* bar, unsigned x, unsigned& nloc, unsigned& nx) {
    const unsigned G = gridDim.x * gridDim.y * gridDim.z;
    unsigned sum, cnt, mine, sp = 0u;
    for (;;) {
        sum = 0u; cnt = 0u; mine = 0u;
#pragma unroll
        for (unsigned j = 0; j < 16; ++j) { const unsigned c = xb_ld(&bar[XB_XCNT(j)]); sum += c; cnt += (c > 0u) ? 1u : 0u; mine = (j == x) ? c : mine; }
        if (sum == G) break;
        __builtin_amdgcn_s_sleep(1);
        if ((++sp & 255u) == 0u) { if (xb_ld(&bar[XB_TMO])) break; if (sp > XB_SPIN_CAP) { atomicAdd(&bar[XB_TMO], 1u); break; } }
    }
    nloc = mine > 0u ? mine : 1u; nx = cnt > 0u ? cnt : 1u;
}
__device__ __forceinline__ void xcd_barrier(const XcdBarrier& b) {
    asm volatile("s_waitcnt vmcnt(0)" ::: "memory");
    __syncthreads();
    if (threadIdx.x == 0) {
        unsigned* bar = b.bar;
        __builtin_amdgcn_s_waitcnt(0);
        unsigned nloc = b.st[0], nx = b.st[1];
        if (nloc == 0u) { xcd_barrier_complete(bar, b.x, nloc, nx); b.st[0] = nloc; b.st[1] = nx; }
        const unsigned old = xb_add(&bar[XB_XSUB(b.x)], 1u);
        const unsigned gen = old / nloc;
        if (old + 1u == (gen + 1u) * nloc) {
            __builtin_amdgcn_fence(__ATOMIC_RELEASE, "agent");
            asm volatile("s_waitcnt vmcnt(0)" ::: "memory");
            const unsigned og = xb_add(&bar[XB_TOP], 1u);
            const unsigned tg = og / nx;
            if (og + 1u == (tg + 1u) * nx) xb_add(&bar[XB_TOPGEN], 1u);
            else XB_SPIN(xb_ld(&bar[XB_TOPGEN]) == tg, bar);
            __builtin_amdgcn_fence(__ATOMIC_ACQUIRE, "agent");
            xb_add(&bar[XB_XGEN(b.x)], 1u);
            asm volatile("s_waitcnt vmcnt(0)" ::: "memory");
        } else {
            XB_SPIN(xb_ld(&bar[XB_XGEN(b.x)]) == gen, bar);
            __builtin_amdgcn_fence(__ATOMIC_ACQUIRE, "agent");
            asm volatile("s_waitcnt vmcnt(0)" ::: "memory");
        }
    }
    __syncthreads();
}

struct Args {
    const float* x; const float* w_mix_in; const float* w_mix_out; const float* g_mix; const float* rel_bias; const float* gla_w_gate; const float* gla_b_gate;
    const float* gla_g_norm; const float* conv_w; const float* g_ffn; const float* ffn_w1; const float* ffn_w3; const float* ffn_w2; const float* moe_router;
    const float* moe_w1; const float* moe_w3; const float* moe_w2; const float* g_final;
    float* out; unsigned char* ws; int ph_lo, ph_hi, li, pad;
};

__device__ __forceinline__ void transpose_tile(const float* src, int ldsrc, int k0, int n0, bf16* dst, int ldd, int drow0, const float* ksc, unsigned* scr, int lane) {
    const int nq = lane & 15, kk = lane >> 4;
#pragma unroll
    for (int i = 0; i < 8; ++i) { const int k = 8 * i + 2 * kk; const float* p = src + (size_t)(k0 + k) * ldsrc + n0 + 4 * nq;
        const f32x4 r0 = *(const f32x4*)p, r1 = *(const f32x4*)(p + ldsrc);
        const float s0 = ksc ? ksc[k0 + k] : 1.f, s1 = ksc ? ksc[k0 + k + 1] : 1.f;
#pragma unroll
        for (int j = 0; j < 4; ++j) scr[(4 * nq + j) * 33 + 4 * i + kk] = pk2(r0[j] * s0, r1[j] * s1); }
    asm volatile("s_waitcnt lgkmcnt(0)" ::: "memory");
#pragma unroll 8
    for (int i2 = 0; i2 < 32; ++i2) { const int n = 2 * i2 + (lane >> 5), d = lane & 31;
        ((unsigned*)(dst + (size_t)(drow0 + n) * ldd + k0))[d] = scr[n * 33 + d]; }
    asm volatile("s_waitcnt lgkmcnt(0)" ::: "memory");
}
__device__ __forceinline__ void glr_tile(const float* win, const float* wg, const float* g, int k0, int n0, bf16* dst, int drow0, int lane) {
    float w[16];
#pragma unroll
    for (int r = 0; r < 16; ++r) w[r] = wg[r * 256 + n0 + lane];
    unsigned* drow = (unsigned*)(dst + (size_t)(drow0 + n0 + lane) * 1024 + k0);
    for (int kp = 0; kp < 32; ++kp) { float v[2];
#pragma unroll
        for (int q = 0; q < 2; ++q) { const int k = k0 + 2 * kp + q; const float* s = win + (size_t)k * INC + 2304; float a = 0.f;
#pragma unroll
            for (int r = 0; r < 16; ++r) a += s[r] * w[r];
            v[q] = a * g[k]; }
        drow[kp] = pk2(v[0], v[1]); }
}
__device__ __forceinline__ int rel_bucket(int d) {
    if (d < 16) return d;
    const float lr = logf((float)d / 16.0f) / logf(128.0f);
    int b = 16 + (int)(lr * 16.0f); return b < 31 ? b : 31;
}


typedef short bf16x8 __attribute__((ext_vector_type(8)));
typedef short v4i16_t __attribute__((ext_vector_type(4)));
#define MFMA16(a, b, c) __builtin_amdgcn_mfma_f32_16x16x32_bf16((a), (b), (c), 0, 0, 0)
__device__ __forceinline__ v4i16_t tr16(LAS unsigned char* p) { return __builtin_amdgcn_ds_read_tr16_b64_v4i16((LAS v4i16_t*)p); }
__device__ __forceinline__ bf16x8 cat8(v4i16_t lo, v4i16_t hi) { return __builtin_shufflevector(lo, hi, 0, 1, 2, 3, 4, 5, 6, 7); }
__device__ __forceinline__ bf16x8 frag_rm(LAS unsigned char* base, int pitch, int c0, int k0, int lane) { return *(LAS bf16x8*)(base + (c0 + (lane & 15)) * pitch + (k0 + 8 * (lane >> 4)) * 2); }
__device__ __forceinline__ bf16x8 frag_tr(LAS unsigned char* base, int pitch, int c0, int k0, int lane) {
    const int i = lane & 15, g = lane >> 4; LAS unsigned char* p = base + (k0 + 8 * g + (i >> 2)) * pitch + (c0 + 4 * (i & 3)) * 2;
    return cat8(tr16(p), tr16(p + 4 * pitch)); }
__device__ __forceinline__ bf16x8 frag_trp(LAS unsigned char* base, int pitch, int c0, int k0, int lane) {
    const int i = lane & 15, g = lane >> 4; LAS unsigned char* p = base + (k0 + 4 * g + (i >> 2)) * pitch + (c0 + 4 * (i & 3)) * 2;
    return cat8(tr16(p), tr16(p + 16 * pitch)); }
__device__ __forceinline__ bf16x8 pack8(const f32x4& a, const f32x4& b) {
    v4u w; w.x = pg8::cvt_pk_bf16(a[0], a[1]); w.y = pg8::cvt_pk_bf16(a[2], a[3]); w.z = pg8::cvt_pk_bf16(b[0], b[1]); w.w = pg8::cvt_pk_bf16(b[2], b[3]); return __builtin_bit_cast(bf16x8, w); }

struct Ctx { Args args; int tid, lane, wave, G, bx, gw, NGW, lo, hi; XcdBarrier bar; };
#define GRID_BAR() do { if (MK_N_LAUNCHES == 1) xcd_barrier(bar); } while (0)
#define IN(k) (lo <= (k) && (k) < hi)
#define SEAM(k) do { if (IN(k) && IN((k) + 1)) GRID_BAR(); } while (0)
#define WS_PTRS \
    float* SS = (float*)(ws + WS_SS); float* BL = (float*)(ws + WS_BL); float* DEC = (float*)(ws + WS_DEC); \
    bf16* XB = (bf16*)(ws + WS_XB); bf16* U = (bf16*)(ws + WS_U); bf16* MIX = (bf16*)(ws + WS_MIX); float* CST = (float*)(ws + WS_CST); \
    bf16* H = (bf16*)(ws + WS_H); bf16* W13 = (bf16*)(ws + WS_W13); bf16* W2 = (bf16*)(ws + WS_W2); \
    bf16* WE13 = (bf16*)(ws + WS_WE13); bf16* WE2 = (bf16*)(ws + WS_WE2); bf16* XS = (bf16*)(ws + WS_XS); bf16* HE = (bf16*)(ws + WS_HE); bf16* Y = (bf16*)(ws + WS_Y); \
    int* TOPI = (int*)(ws + WS_TOPI); float* TOPW = (float*)(ws + WS_TOPW); int* POS = (int*)(ws + WS_POS); float* RS3 = (float*)(ws + WS_RS3); \
    int* CNT = (int*)(ws + WS_CNT); int* PANE = (int*)(ws + WS_PANE); float* ROWGATE = (float*)(ws + WS_ROWGATE); float* ROWRS = (float*)(ws + WS_ROWRS); \
    float* X = args.out; \
    (void)SS; (void)BL; (void)DEC; (void)XB; (void)U; (void)MIX; (void)CST; (void)H; (void)W13; (void)W2; (void)WE13; (void)WE2; (void)XS; (void)HE; (void)Y; \
    (void)TOPI; (void)TOPW; (void)POS; (void)RS3; (void)CNT; (void)PANE; (void)ROWGATE; (void)ROWRS; (void)X;

template <int layer> __device__ __forceinline__ void layer_phases(const Ctx& c, unsigned char* lds) {
    const Args& args = c.args; LAS unsigned char* ldsl = (LAS unsigned char*)lds;
    const int tid = c.tid, lane = c.lane, wave = c.wave, G = c.G, bx = c.bx, gw = c.gw, NGW = c.NGW, lo = c.lo, hi = c.hi; const XcdBarrier bar = c.bar;
    unsigned char* ws = args.ws;
    WS_PTRS
    (void)tid; (void)lane; (void)wave; (void)gw; (void)NGW;
    const bool dry = (args.pad & 1) != 0, noepi = (args.pad & 2) != 0;
    bf16* XBD = dry ? (bf16*)(ws + WS_XS) : XB; float* SSD = dry ? (float*)(ws + WS_XS) : SS; (void)XBD; (void)SSD;
        const int pb = 1 + 16 * layer;
        if (IN(pb + 0)) {
            pg8::Gemm g{XB, (const bf16*)(ws + WS_WIN) + (size_t)layer * NU * D, M, NU, D}; pg8::StaticOrder S; S.init(M, NU, G, bx);
            pg8::EpiU E{U, NU, SS, QS_ATT};
            pg8::gemm_phase<pg8::EpiU, pg8::StaticOrder, true, true>(ldsl, g, S, E, noepi);
            { const bf16* wg = (const bf16*)(ws + WS_WGLR) + (size_t)layer * 16 * D; float* GLR = (float*)(ws + WS_GLR); f32x4* xch = (f32x4*)lds;
              for (int blk = bx; blk < 256; blk += G) {
                  const int rt = wave & 3, kh = wave >> 2, ql = lane & 15, g4 = lane >> 4;
                  const bf16* ap = XB + (size_t)(blk * 64 + rt * 16 + ql) * D + kh * 512 + 8 * g4; const bf16* bp = wg + (size_t)ql * D + kh * 512 + 8 * g4;
                  f32x4 acc = (f32x4){0.f, 0.f, 0.f, 0.f};
#pragma unroll
                  for (int ks = 0; ks < 16; ++ks) acc = MFMA16(*(const bf16x8*)(ap + 32 * ks), *(const bf16x8*)(bp + 32 * ks), acc);
                  if (kh == 1) xch[rt * 64 + lane] = acc;
                  __syncthreads();
                  if (kh == 0) { acc += xch[rt * 64 + lane];
#pragma unroll
                      for (int rg = 0; rg < 4; ++rg) { const int row = blk * 64 + rt * 16 + 4 * g4 + rg; GLR[(size_t)row * 16 + ql] = acc[rg] * pg8::rstd_of(SS + (size_t)row * 16); } }
                  __syncthreads();
              } }
        }
        SEAM(pb + 0);
        if (IN(pb + 1)) {
            float* cum = (float*)lds; float* seg = cum + 4096;
            LAS unsigned char* kdl = ldsl + 18432;
            LAS unsigned char* vvl = ldsl + 27648;
            for (int u = bx; u < 1024; u += G) {
                const int h = u & 3, n = (u >> 2) & 31, b = u >> 7; const size_t row0 = (size_t)b * SEQ + n * 64;
                const int tr = tid >> 3, c8 = tid & 7;
                const v4u kraw = *(const v4u*)(U + (row0 + tr) * NU + UGK + h * 64 + 8 * c8);
                const v4u* vp = (const v4u*)(U + (row0 + tr) * NU + UGV + h * 128 + c8 * 16); const v4u x0 = vp[0], x1 = vp[1];
                { float c = 0.f; float wgc[16]; const float* wgp = args.gla_w_gate + layer * 16 * 256 + h * 64 + lane; const float bgv = args.gla_b_gate[layer * 256 + h * 64 + lane];
#pragma unroll
                  for (int r = 0; r < 16; ++r) wgc[r] = wgp[r * 256];
                  const float* GLR = (const float*)(ws + WS_GLR);
#pragma unroll
                  for (int i = 0; i < 8; ++i) { const int t = 8 * wave + i; const f32x4* gp = (const f32x4*)(GLR + (row0 + t) * 16); float z = bgv;
#pragma unroll
                      for (int q4 = 0; q4 < 4; ++q4) { const f32x4 gv = gp[q4]; z += gv[0] * wgc[4 * q4] + gv[1] * wgc[4 * q4 + 1] + gv[2] * wgc[4 * q4 + 2] + gv[3] * wgc[4 * q4 + 3]; }
                      c += pg8::logsig16(z); cum[t * 64 + lane] = c; }
                  seg[wave * 64 + lane] = c; }
                __syncthreads();
                { f32x4 offa = (f32x4){0.f, 0.f, 0.f, 0.f}, offb = offa, lasta = offa, lastb = offa; const int wq = tr >> 3;
#pragma unroll
                  for (int w = 0; w < 8; ++w) { const f32x4 sa = *(const f32x4*)(seg + w * 64 + 8 * c8), sb = *(const f32x4*)(seg + w * 64 + 8 * c8 + 4); lasta += sa; lastb += sb; if (w < wq) { offa += sa; offb += sb; } }
                  const f32x4 ca = *(const f32x4*)(cum + tr * 64 + 8 * c8) + offa, cb = *(const f32x4*)(cum + tr * 64 + 8 * c8 + 4) + offb;
                  v4u w; w.x = pk2(bflo(kraw.x) * __expf(lasta[0] - ca[0]), bfhi(kraw.x) * __expf(lasta[1] - ca[1])); w.y = pk2(bflo(kraw.y) * __expf(lasta[2] - ca[2]), bfhi(kraw.y) * __expf(lasta[3] - ca[3]));
                  w.z = pk2(bflo(kraw.z) * __expf(lastb[0] - cb[0]), bfhi(kraw.z) * __expf(lastb[1] - cb[1])); w.w = pk2(bflo(kraw.w) * __expf(lastb[2] - cb[2]), bfhi(kraw.w) * __expf(lastb[3] - cb[3]));
                  *(LAS v4u*)(kdl + tr * 144 + c8 * 16) = w;
                  if (tr == 0) {
#pragma unroll
                      for (int j = 0; j < 4; ++j) { __hip_atomic_store(DEC + u * 64 + 8 * c8 + j, __expf(lasta[j]), __ATOMIC_RELAXED, __HIP_MEMORY_SCOPE_AGENT); __hip_atomic_store(DEC + u * 64 + 8 * c8 + 4 + j, __expf(lastb[j]), __ATOMIC_RELAXED, __HIP_MEMORY_SCOPE_AGENT); } }
                  LAS v4u* vd = (LAS v4u*)(vvl + tr * 272 + c8 * 32); vd[0] = x0; vd[1] = x1; }
                __syncthreads();
                { f32x4 acc[4];
#pragma unroll
                  for (int kt = 0; kt < 4; ++kt) acc[kt] = (f32x4){0.f, 0.f, 0.f, 0.f};
#pragma unroll
                  for (int ks = 0; ks < 2; ++ks) { const bf16x8 bv = frag_tr(vvl, 272, 16 * wave, 32 * ks, lane);
#pragma unroll
                      for (int kt = 0; kt < 4; ++kt) { const bf16x8 ak = frag_tr(kdl, 144, 16 * kt, 32 * ks, lane); acc[kt] = MFMA16(ak, bv, acc[kt]); } }
                  const int g4 = lane >> 4, ql = lane & 15;
                  const __amdgpu_buffer_rsrc_t rsrc = __builtin_amdgcn_make_buffer_rsrc((void*)CST, 0, 32 * 1024 * 1024, 0x00020000);
#pragma unroll
                  for (int kt = 0; kt < 4; ++kt)
                      __builtin_amdgcn_raw_buffer_store_b128(__builtin_bit_cast(v4u, acc[kt]), rsrc, (int)((((unsigned)u * 128u + 16u * wave + ql) * 64u + 16u * kt + 4u * g4) * 4u), 0, 16); }
                asm volatile("s_waitcnt vmcnt(0)" ::: "memory");
                __syncthreads();
                if (tid == 0) __hip_atomic_fetch_add((unsigned*)(ws + WS_CTL) + CW_SC + ((u >> 7) * 4 + (u & 3)) * 64, 1u, __ATOMIC_RELAXED, __HIP_MEMORY_SCOPE_AGENT);
            }
            const float* cw = args.conv_w + layer * 3 * 256;
            for (int it = bx * NTHR + tid; it < M * 32; it += G * NTHR) {
                const int row = it >> 5, c0 = (it & 31) * 8, t = row & (SEQ - 1);
                const bf16* ur = U + (size_t)row * NU;
                const v4u cb = *(const v4u*)(ur + UCB + c0);
                v4u ci[3], cc[3];
#pragma unroll
                for (int d = 0; d < 3; ++d) { if (t >= d) { ci[d] = *(const v4u*)(ur - (size_t)d * NU + UCI + c0); cc[d] = *(const v4u*)(ur - (size_t)d * NU + UCC + c0); } else { ci[d] = (v4u){0u, 0u, 0u, 0u}; cc[d] = ci[d]; } }
                float o[8];
#pragma unroll
                for (int j = 0; j < 4; ++j) {
                    float a0 = 0.f, a1 = 0.f;
#pragma unroll
                    for (int d = 0; d < 3; ++d) { const float w0 = cw[(2 - d) * 256 + c0 + 2 * j], w1 = cw[(2 - d) * 256 + c0 + 2 * j + 1];
                        a0 += w0 * (bflo(cc[d][j]) * bflo(ci[d][j])); a1 += w1 * (bfhi(cc[d][j]) * bfhi(ci[d][j])); }
                    o[2 * j] = bflo(cb[j]) * a0; o[2 * j + 1] = bfhi(cb[j]) * a1; }
                v4u w; w.x = pk2(o[0], o[1]); w.y = pk2(o[2], o[3]); w.z = pk2(o[4], o[5]); w.w = pk2(o[6], o[7]);
                *(v4u*)(MIX + (size_t)row * D + 768 + c0) = w;
            }
            __syncthreads();
            {
                float* BLl = (float*)lds;
                for (int i = tid; i < 4 * 2049; i += NTHR) BLl[(i & 3) * 2049 + (i >> 2)] = BL[i];
                __syncthreads();
                LAS unsigned char* vst = ldsl + 33280 + wave * 5120;
                const int ql = lane & 15, g4 = lane >> 4;
                for (int uu = bx; uu < 512; uu += G) {
                    int u = uu; if (G == 256) { const int j = (uu & 255) >> 3; u = ((((uu >> 8) * 16 + (uu & 7) * 2 + (j >> 4)) << 4) | (j & 15)); }
                    const int c = u & 15, h = (u >> 4) & 3, b = u >> 6; const int i0 = 16 * (((uu / G) & 1) ? 7 - wave : wave); const size_t rowb = (size_t)b * SEQ;
                    const int tq = c + 16 * (i0 + ql);
                    const bf16* ub = U + rowb * NU + h * 64;
                    const bf16x8 qf0 = *(const bf16x8*)(ub + (size_t)tq * NU + UQ + 8 * g4), qf1 = *(const bf16x8*)(ub + (size_t)tq * NU + UQ + 8 * g4 + 32);
                    const float* blh = BLl + h * 2049;
                    const int t0 = c + 16 * i0, t1 = t0 + 240;
                    const int base0 = ((t0 >> 4) - 128) & ~31, mhi0 = t1 >> 4, np0 = ((mhi0 - base0) >> 5) + 1, pz0 = base0 < 0 ? ((-base0) >> 5) : 0;
                    const int base1 = ((t0 >> 2) - 128) & ~31, mhi1 = t1 >> 2, np1 = ((mhi1 - base1) >> 5) + 1, pz1 = base1 < 0 ? ((-base1) >> 5) : 0;
                    const int base2 = (t0 - 128) & ~31, mhi2 = t1, np2 = ((mhi2 - base2) >> 5) + 1, pz2 = base2 < 0 ? ((-base2) >> 5) : 0;
                    const int n0 = np0 - pz0, n1 = np1 - pz1, n2 = np2 - pz2, NT = n0 + n1 + n2;
                    bf16x8 kc[2][2], kn[2][2]; v4u vc[4], vn[4];
#define ATT_ITEM(it, LR, MB, MHI, RHO) do { if ((it) < n0) { LR = 4; MB = base0 + 32 * (np0 - 1 - (it)); MHI = mhi0; RHO = c; } \
                        else if ((it) < n0 + n1) { LR = 2; MB = base1 + 32 * (pz1 + (it) - n0); MHI = mhi1; RHO = c & 3; } \
                        else { LR = 0; MB = base2 + 32 * (pz2 + (it) - n0 - n1); MHI = mhi2; RHO = 0; } } while (0)
#define ATT_LOAD(K_, V_, LR, MB, MHI, RHO) do { _Pragma("unroll") for (int tau = 0; tau < 2; ++tau) { int mk = (MB) + 16 * tau + ql; mk = mk < 0 ? 0 : (mk > (MHI) ? (MHI) : mk); \
                            const bf16* kp = ub + (size_t)((mk << (LR)) + (RHO)) * NU + UK + 8 * g4; K_[tau][0] = *(const bf16x8*)kp; K_[tau][1] = *(const bf16x8*)(kp + 32); } \
                        _Pragma("unroll") for (int j = 0; j < 4; ++j) { int mv = (MB) + (lane >> 3) + 8 * j; mv = mv < 0 ? 0 : (mv > (MHI) ? (MHI) : mv); \
                            V_[j] = *(const v4u*)(ub + (size_t)((mv << (LR)) + (RHO)) * NU + UV + 8 * (lane & 7)); } } while (0)
                    int lr, mb, mhi, rho; ATT_ITEM(0, lr, mb, mhi, rho); ATT_LOAD(kc, vc, lr, mb, mhi, rho);
                    float m_ref = -INFINITY, l_run = 0.f; f32x4 o[4];
#pragma unroll
                    for (int d = 0; d < 4; ++d) o[d] = (f32x4){0.f, 0.f, 0.f, 0.f};
                    for (int it = 0; it < NT; ++it) {
                        int lrn = lr, mbn = mb, mhin = mhi, rhon = rho;
                        if (it + 1 < NT) { ATT_ITEM(it + 1, lrn, mbn, mhin, rhon); ATT_LOAD(kn, vn, lrn, mbn, mhin, rhon); }
                        { LAS unsigned char* vd = vst + (lane >> 3) * 160 + (lane & 7) * 16;
#pragma unroll
                          for (int j = 0; j < 4; ++j) *(LAS v4u*)(vd + j * 8 * 160) = vc[j]; }
                        f32x4 s[2];
#pragma unroll
                        for (int tau = 0; tau < 2; ++tau) { s[tau] = MFMA16(kc[tau][0], qf0, ((f32x4){0.f, 0.f, 0.f, 0.f})); s[tau] = MFMA16(kc[tau][1], qf1, s[tau]); }
                        const int d0 = (tq >> lr) - mb - 4 * g4, k0 = mb + 4 * g4; float tmax = -INFINITY;
#pragma unroll
                        for (int tau = 0; tau < 2; ++tau)
#pragma unroll
                            for (int rg = 0; rg < 4; ++rg) { const int dist = d0 - (16 * tau + rg); const bool ok = ((unsigned)dist <= 128u) && (k0 + 16 * tau + rg >= 0);
                                const float bias = blh[ok ? (dist << lr) : 0]; const float v = ok ? s[tau][rg] + bias : -INFINITY; s[tau][rg] = v; tmax = fmaxf(tmax, v); }
                        if (__any(tmax > m_ref + 16.0f)) {
                            float tm = fmaxf(tmax, __shfl_xor(tmax, 16)); tm = fmaxf(tm, __shfl_xor(tm, 32));
                            const float mn = fmaxf(m_ref, tm); const float ms = (mn == -INFINITY) ? 0.f : mn; const float alpha = __builtin_amdgcn_exp2f(m_ref - ms); m_ref = ms;
                            l_run *= alpha;
#pragma unroll
                            for (int d = 0; d < 4; ++d) o[d] = o[d] * alpha;
                        }
                        float ps = 0.f;
#pragma unroll
                        for (int tau = 0; tau < 2; ++tau)
#pragma unroll
                            for (int rg = 0; rg < 4; ++rg) { const float p = __builtin_amdgcn_exp2f(s[tau][rg] - m_ref); s[tau][rg] = p; ps += p; }
                        l_run += ps;
                        const bf16x8 pb = pack8(s[0], s[1]);
                        asm volatile("" ::: "memory");
#pragma unroll
                        for (int d = 0; d < 4; ++d) { const bf16x8 va = frag_trp(vst, 160, 16 * d, 0, lane); o[d] = MFMA16(va, pb, o[d]); }
                        asm volatile("" ::: "memory");
#pragma unroll
                        for (int tau = 0; tau < 2; ++tau) { kc[tau][0] = kn[tau][0]; kc[tau][1] = kn[tau][1]; }
#pragma unroll
                        for (int j = 0; j < 4; ++j) vc[j] = vn[j];
                        lr = lrn; mb = mbn; mhi = mhin; rho = rhon;
                    }
#undef ATT_ITEM
#undef ATT_LOAD
                    l_run += __shfl_xor(l_run, 16); l_run += __shfl_xor(l_run, 32); const float inv = 1.0f / l_run;
                    bf16* op = MIX + (rowb + tq) * D + h * 64 + 4 * g4;
#pragma unroll
                    for (int d = 0; d < 4; ++d) { pg8::u32x2 w; w.x = pg8::cvt_pk_bf16(o[d][0] * inv, o[d][1] * inv); w.y = pg8::cvt_pk_bf16(o[d][2] * inv, o[d][3] * inv); *(pg8::u32x2*)(op + 16 * d) = w; }
                }
            }
            for (int u = bx; u < 1024; u += G) {
                const int h = u & 3, n = (u >> 2) & 31, b = u >> 7;
                unsigned* cw = (unsigned*)(ws + WS_CTL) + CW_SC + (b * 4 + h) * 64; unsigned* tmo = (unsigned*)(ws + WS_CTL) + CW_TMO2; const unsigned need = 32u * (unsigned)(layer + 1);
                if (wave == 0) { unsigned sp = 0; while (__hip_atomic_load(cw, __ATOMIC_RELAXED, __HIP_MEMORY_SCOPE_AGENT) < need) { __builtin_amdgcn_s_sleep(2);
                        if ((++sp & 255u) == 0u) { if (__hip_atomic_load(tmo, __ATOMIC_RELAXED, __HIP_MEMORY_SCOPE_AGENT) != 0u) break; if (sp > (1u << 20)) { __hip_atomic_store(tmo, 1u, __ATOMIC_RELAXED, __HIP_MEMORY_SCOPE_AGENT); break; } } } }
                __syncthreads();
                if (tid < 256) { const int idx = n * 256 + tid; float cc[32], dd[32];
                    float* cp = CST + (size_t)(b * 128 + h) * 8192 + idx; const float* dp = DEC + (b * 128 + h) * 64 + (idx & 63);
#pragma unroll
                    for (int m2 = 0; m2 < 32; ++m2) { cc[m2] = __hip_atomic_load(cp + (size_t)m2 * 4 * 8192, __ATOMIC_RELAXED, __HIP_MEMORY_SCOPE_AGENT); dd[m2] = __hip_atomic_load(dp + m2 * 4 * 64, __ATOMIC_RELAXED, __HIP_MEMORY_SCOPE_AGENT); }
                    float S = 0.f;
#pragma unroll
                    for (int m2 = 0; m2 < 32; ++m2) { cp[(size_t)m2 * 4 * 8192] = S; S = dd[m2] * S + cc[m2]; } }
            }
        }
        SEAM(pb + 1);
        if (IN(pb + 3)) {
            float* cum = (float*)lds; float* seg = cum + 4096;
            LAS unsigned char* qel = ldsl + 18432;
            LAS unsigned char* kel = ldsl + 27648;
            LAS unsigned char* vvl = ldsl + 36864;
            LAS unsigned char* stl = ldsl + 54272;
            float* rsq = (float*)(lds + 72704);
            const float* gn = args.gla_g_norm + layer * 128;
            for (int u = bx; u < 1024; u += G) {
                const int h = u & 3, n = (u >> 2) & 31, b = u >> 7; const size_t row0 = (size_t)b * SEQ + n * 64;
                const int tr = tid >> 3, c8 = tid & 7;
                const v4u qraw = *(const v4u*)(U + (row0 + tr) * NU + UGQ + h * 64 + 8 * c8), kraw = *(const v4u*)(U + (row0 + tr) * NU + UGK + h * 64 + 8 * c8);
                const v4u* vp = (const v4u*)(U + (row0 + tr) * NU + UGV + h * 128 + c8 * 16); const v4u x0 = vp[0], x1 = vp[1];
                const int sv = tid >> 2, skq = (tid & 3) * 16; const f32x4* sp = (const f32x4*)(CST + ((size_t)u * 128 + sv) * 64 + skq);
                const f32x4 a0 = sp[0], a1 = sp[1], a2 = sp[2], a3 = sp[3];
                { float c = 0.f; float wgc[16]; const float* wgp = args.gla_w_gate + layer * 16 * 256 + h * 64 + lane; const float bgv = args.gla_b_gate[layer * 256 + h * 64 + lane];
#pragma unroll
                  for (int r = 0; r < 16; ++r) wgc[r] = wgp[r * 256];
                  const float* GLR = (const float*)(ws + WS_GLR);
#pragma unroll
                  for (int i = 0; i < 8; ++i) { const int t = 8 * wave + i; const f32x4* gp = (const f32x4*)(GLR + (row0 + t) * 16); float z = bgv;
#pragma unroll
                      for (int q4 = 0; q4 < 4; ++q4) { const f32x4 gv = gp[q4]; z += gv[0] * wgc[4 * q4] + gv[1] * wgc[4 * q4 + 1] + gv[2] * wgc[4 * q4 + 2] + gv[3] * wgc[4 * q4 + 3]; }
                      c += pg8::logsig16(z); cum[t * 64 + lane] = c; }
                  seg[wave * 64 + lane] = c; }
                __syncthreads();
                { f32x4 offa = (f32x4){0.f, 0.f, 0.f, 0.f}, offb = offa; const int wq = tr >> 3;
#pragma unroll
                  for (int w = 0; w < 7; ++w) { if (w < wq) { offa += *(const f32x4*)(seg + w * 64 + 8 * c8); offb += *(const f32x4*)(seg + w * 64 + 8 * c8 + 4); } }
                  const f32x4 ca = *(const f32x4*)(cum + tr * 64 + 8 * c8) + offa, cb = *(const f32x4*)(cum + tr * 64 + 8 * c8 + 4) + offb;
                  float ea[8];
#pragma unroll
                  for (int j = 0; j < 4; ++j) { ea[j] = __expf(ca[j]); ea[4 + j] = __expf(cb[j]); }
                  v4u wq_, wk_;
                  wq_.x = pk2(bflo(qraw.x) * ea[0], bfhi(qraw.x) * ea[1]); wq_.y = pk2(bflo(qraw.y) * ea[2], bfhi(qraw.y) * ea[3]); wq_.z = pk2(bflo(qraw.z) * ea[4], bfhi(qraw.z) * ea[5]); wq_.w = pk2(bflo(qraw.w) * ea[6], bfhi(qraw.w) * ea[7]);
                  wk_.x = pk2(bflo(kraw.x) / ea[0], bfhi(kraw.x) / ea[1]); wk_.y = pk2(bflo(kraw.y) / ea[2], bfhi(kraw.y) / ea[3]); wk_.z = pk2(bflo(kraw.z) / ea[4], bfhi(kraw.z) / ea[5]); wk_.w = pk2(bflo(kraw.w) / ea[6], bfhi(kraw.w) / ea[7]);
                  *(LAS v4u*)(qel + tr * 144 + c8 * 16) = wq_; *(LAS v4u*)(kel + tr * 144 + c8 * 16) = wk_;
                  LAS v4u* vd = (LAS v4u*)(vvl + tr * 272 + c8 * 32); vd[0] = x0; vd[1] = x1;
                  v4u w0, w1; w0.x = pk2(a0[0], a0[1]); w0.y = pk2(a0[2], a0[3]); w0.z = pk2(a1[0], a1[1]); w0.w = pk2(a1[2], a1[3]);
                  w1.x = pk2(a2[0], a2[1]); w1.y = pk2(a2[2], a2[3]); w1.z = pk2(a3[0], a3[1]); w1.w = pk2(a3[2], a3[3]);
                  LAS v4u* sd = (LAS v4u*)(stl + sv * 144 + skq * 2); sd[0] = w0; sd[1] = w1; }
                __syncthreads();
                { const int tt = wave & 3, vh = wave >> 2, ql = lane & 15, g4 = lane >> 4; const int t = 16 * tt + ql;
                  const bf16x8 qb0 = frag_rm(qel, 144, 16 * tt, 0, lane), qb1 = frag_rm(qel, 144, 16 * tt, 32, lane);
                  f32x4 sT[4];
#pragma unroll
                  for (int st = 0; st < 4; ++st) { sT[st] = (f32x4){0.f, 0.f, 0.f, 0.f};
                      if (st <= tt) { sT[st] = MFMA16(frag_rm(kel, 144, 16 * st, 0, lane), qb0, sT[st]); sT[st] = MFMA16(frag_rm(kel, 144, 16 * st, 32, lane), qb1, sT[st]);
#pragma unroll
                          for (int rg = 0; rg < 4; ++rg) if (16 * st + 4 * g4 + rg > t) sT[st][rg] = 0.f; } }
                  const bf16x8 pb0 = pack8(sT[0], sT[1]), pb1 = pack8(sT[2], sT[3]);
                  f32x4 acc[4]; float ss = 0.f;
#pragma unroll
                  for (int vt = 0; vt < 4; ++vt) { const int V0 = 16 * (4 * vh + vt); f32x4 a = (f32x4){0.f, 0.f, 0.f, 0.f};
                      a = MFMA16(frag_trp(vvl, 272, V0, 0, lane), pb0, a); a = MFMA16(frag_trp(vvl, 272, V0, 32, lane), pb1, a);
                      a = MFMA16(frag_rm(stl, 144, V0, 0, lane), qb0, a); a = MFMA16(frag_rm(stl, 144, V0, 32, lane), qb1, a);
                      acc[vt] = a; ss += (a[0] * a[0] + a[1] * a[1]) + (a[2] * a[2] + a[3] * a[3]); }
                  ss += __shfl_xor(ss, 16); ss += __shfl_xor(ss, 32);
                  if (g4 == 0) rsq[(tt * 2 + vh) * 16 + ql] = ss;
                  __syncthreads();
                  const float rs = 1.0f / sqrtf((rsq[(tt * 2) * 16 + ql] + rsq[(tt * 2 + 1) * 16 + ql]) * (1.0f / 128.0f) + pg8::RMS_EPS);
#pragma unroll
                  for (int vt = 0; vt < 4; ++vt) { const int v0 = 16 * (4 * vh + vt) + 4 * g4;
                      const pg8::u32x2 gr = *(const pg8::u32x2*)(U + (row0 + t) * NU + UGR + h * 128 + v0); const f32x4 gv = *(const f32x4*)(gn + v0);
                      const float o0 = acc[vt][0] * rs * gv[0] * pg8::silu_f(bflo(gr.x)), o1 = acc[vt][1] * rs * gv[1] * pg8::silu_f(bfhi(gr.x));
                      const float o2 = acc[vt][2] * rs * gv[2] * pg8::silu_f(bflo(gr.y)), o3 = acc[vt][3] * rs * gv[3] * pg8::silu_f(bfhi(gr.y));
                      pg8::u32x2 w; w.x = pg8::cvt_pk_bf16(o0, o1); w.y = pg8::cvt_pk_bf16(o2, o3);
                      *(pg8::u32x2*)(MIX + (row0 + t) * D + 256 + h * 128 + v0) = w; } }
                __syncthreads();
            }
        }
        SEAM(pb + 3);
        if (IN(pb + 4)) {
            pg8::Gemm g{MIX, (const bf16*)(ws + WS_WOUT) + (size_t)layer * D * D, M, D, D}; pg8::StaticOrder S; S.init(M, D, G, bx);
            if constexpr (layer == 0) { pg8::EpiRes<true> E{args.x, XBD, SSD}; pg8::gemm_phase<pg8::EpiRes<true>, pg8::StaticOrder, true, true>(ldsl, g, S, E, noepi); }
            else { pg8::EpiRes<false> E{XB, XBD, SSD}; pg8::gemm_phase<pg8::EpiRes<false>, pg8::StaticOrder, true, true>(ldsl, g, S, E, noepi); }
        }
        SEAM(pb + 4);
        if (layer == 0) {
            if (IN(pb + 5)) {
                pg8::Gemm g{XB, W13, M, 2 * FF, D}; pg8::StaticOrder S; S.init(M, 2 * FF, G, bx);
                pg8::EpiGlu<false> E{H, FF, SS};
                pg8::gemm_phase<pg8::EpiGlu<false>, pg8::StaticOrder, true, true>(ldsl, g, S, E, noepi);
            }
            SEAM(pb + 5);
            if (IN(pb + 6)) {
                pg8::Gemm g{H, W2, M, D, FF}; pg8::StaticOrder S; S.init(M, D, G, bx);
#if defined(PROBE_EPI) && PROBE_EPI
                if (dry) { pg8::EpiRes<false, PROBE_EPI> E{XB, XBD, SSD}; pg8::gemm_phase<pg8::EpiRes<false, PROBE_EPI>, pg8::StaticOrder, true, true>(ldsl, g, S, E, noepi); } else
#endif
                { pg8::EpiRes<false> E{XB, XBD, SSD}; pg8::gemm_phase<pg8::EpiRes<false>, pg8::StaticOrder, true, true>(ldsl, g, S, E, noepi); }
            }
            SEAM(pb + 6);
        } else {
            if (IN(pb + 5)) {
                float* wr_l = (float*)lds;
                int* cnt_l = (int*)(lds + 32768);
                const float* gf = args.g_ffn + D;
                for (int i = tid; i < D * 8; i += NTHR) wr_l[(i & 7) * D + (i >> 3)] = args.moe_router[i] * gf[i >> 3];
                if (tid < 8) cnt_l[tid] = 0;
                __syncthreads();
                for (int blk = bx; blk < 256; blk += G) {
                    if (blk != bx) { __syncthreads(); if (tid < 8) cnt_l[tid] = 0; __syncthreads(); }
                    v4u xpre[8][2];
#pragma unroll
                    for (int i = 0; i < 8; ++i) { const v4u* xr = (const v4u*)(XB + (size_t)(blk * 64 + wave * 8 + i) * D) + lane; xpre[i][0] = xr[0]; xpre[i][1] = xr[64]; }
#pragma unroll
                    for (int i = 0; i < 8; ++i) { const int m = blk * 64 + wave * 8 + i; float lg[8];
#pragma unroll
                        for (int e = 0; e < 8; ++e) lg[e] = 0.f;
#pragma unroll
                        for (int j = 0; j < 2; ++j) { const v4u xw = xpre[i][j]; const int k0 = 8 * (lane + 64 * j);
                            const f32x4 va = (f32x4){bflo(xw.x), bfhi(xw.x), bflo(xw.y), bfhi(xw.y)}, vb = (f32x4){bflo(xw.z), bfhi(xw.z), bflo(xw.w), bfhi(xw.w)};
#pragma unroll
                            for (int e = 0; e < 8; ++e) { const f32x4 w0 = *(const f32x4*)(wr_l + e * D + k0), w1 = *(const f32x4*)(wr_l + e * D + k0 + 4);
                                lg[e] += ((va[0] * w0[0] + va[1] * w0[1]) + (va[2] * w0[2] + va[3] * w0[3])) + ((vb[0] * w1[0] + vb[1] * w1[1]) + (vb[2] * w1[2] + vb[3] * w1[3])); } }
                        const float rs = pg8::rstd_of(SS + (size_t)m * 16);
#pragma unroll
                        for (int e = 0; e < 8; ++e) lg[e] = wave_sum(lg[e]) * rs;
                        int i0 = 0; float v0 = lg[0];
#pragma unroll
                        for (int e = 1; e < 8; ++e) if (lg[e] > v0) { v0 = lg[e]; i0 = e; }
                        int i1 = -1; float v1 = -INFINITY;
#pragma unroll
                        for (int e = 0; e < 8; ++e) if (e != i0 && lg[e] > v1) { v1 = lg[e]; i1 = e; }
                        const float w1 = 1.0f / (1.0f + __expf(v0 - v1)), w0 = 1.0f - w1;
                        if (lane == 0) { TOPI[m * 2] = i0; TOPI[m * 2 + 1] = i1; TOPW[m * 2] = w0; TOPW[m * 2 + 1] = w1; RS3[m] = rs; atomicAdd(&cnt_l[i0], 1); atomicAdd(&cnt_l[i1], 1); } }
                    __syncthreads();
                    if (tid < 8) CNT[blk * 8 + tid] = cnt_l[tid];
                }
            }
            SEAM(pb + 5);
            if (IN(pb + 6)) {
                int* base_l = (int*)lds;
                int* pre_l = base_l + 8;
                int* tot_l = pre_l + 8;
                int* pos_l = tot_l + 8;
                int* ent_l = pos_l + 128;
                for (int blk = bx; blk < 256; blk += G) {
                    __syncthreads();
                    if (tid < 8) { tot_l[tid] = 0; pre_l[tid] = 0; }
                    if (tid < 128) ent_l[tid] = TOPI[blk * 128 + tid];
                    __syncthreads();
                    { const int g2 = tid >> 1, e0 = (tid & 1) * 4; const int4 c = *(const int4*)(CNT + g2 * 8 + e0);
                      atomicAdd(&tot_l[e0], c.x); atomicAdd(&tot_l[e0 + 1], c.y); atomicAdd(&tot_l[e0 + 2], c.z); atomicAdd(&tot_l[e0 + 3], c.w);
                      if (g2 < blk) { atomicAdd(&pre_l[e0], c.x); atomicAdd(&pre_l[e0 + 1], c.y); atomicAdd(&pre_l[e0 + 2], c.z); atomicAdd(&pre_l[e0 + 3], c.w); } }
                    __syncthreads();
                    if (tid == 0) { int bs = 0; for (int e = 0; e < 8; ++e) { base_l[e] = bs; bs += (tot_l[e] + 255) & ~255; } }
                    __syncthreads();
                    if (tid < 128) { const int e = ent_l[tid]; int rank = 0; for (int j = 0; j < tid; ++j) rank += (ent_l[j] == e) ? 1 : 0;
                        const int p = base_l[e] + pre_l[e] + rank; pos_l[tid] = p; POS[blk * 128 + tid] = p; ROWGATE[p] = TOPW[blk * 128 + tid]; ROWRS[p] = RS3[blk * 64 + (tid >> 1)]; }
                    if (blk == 0) {
                        for (int e = 0; e < 8; ++e) { const int npe = (tot_l[e] + 255) >> 8; for (int p = base_l[e] + tot_l[e] + tid; p < base_l[e] + npe * 256; p += NTHR) { ROWGATE[p] = 0.f; ROWRS[p] = 0.f; } }
                        if (tid == 0) { int np = 0; for (int e = 0; e < 8; ++e) { const int npe = (tot_l[e] + 255) >> 8; for (int j = 0; j < npe; ++j) PANE[np++] = e; } PANE[MAXPAN] = np; } }
                    __syncthreads();
                    for (int i = 0; i < 16; ++i) { const int sl = wave * 16 + i; const int m = blk * 64 + (sl >> 1); const int p = pos_l[sl];
                        const v4u* s = (const v4u*)(XB + (size_t)m * D) + lane; v4u* d = (v4u*)(XS + (size_t)p * D) + lane; d[0] = s[0]; d[64] = s[64]; }
                }
            }
            SEAM(pb + 6);
            if (IN(pb + 7)) {
                pg8::Gemm g{XS, WE13, MAXROWS, 2 * FE, D}; pg8::MoeOrder S{PANE, PANE[MAXPAN], 28, 4, G, bx};
                pg8::EpiGlu<true> E{HE, FE, ROWRS};
                pg8::gemm_phase<pg8::EpiGlu<true>, pg8::MoeOrder, true, true>(ldsl, g, S, E, noepi);
            }
            SEAM(pb + 7);
            if (IN(pb + 8)) {
                unsigned* scr = (unsigned*)(lds + wave * 8704);
                constexpr int T_J = 56 * 16;
                for (int it = gw; it < 8 * T_J; it += NGW) { const int e = it / T_J, r = it % T_J;
                    transpose_tile(args.moe_w2 + (size_t)e * FE * D, D, 64 * (r / 16), 64 * (r % 16), WE2 + (size_t)e * D * FE, FE, 64 * (r % 16), nullptr, scr, lane); }
            }
            SEAM(pb + 8);
            if (IN(pb + 9)) {
                pg8::Gemm g{HE, WE2, MAXROWS, D, FE}; pg8::MoeOrder S{PANE, PANE[MAXPAN], 4, 8, G, bx};
                pg8::EpiMoeDown E{Y, ROWGATE};
                pg8::gemm_phase<pg8::EpiMoeDown, pg8::MoeOrder, true, true>(ldsl, g, S, E, noepi);
            }
            SEAM(pb + 9);
            if (IN(pb + 10)) {
                for (int m = gw; m < M; m += NGW) {
                    f32x4* xr = (f32x4*)(X + (size_t)m * D) + lane; const int p0 = POS[m * 2], p1 = POS[m * 2 + 1];
                    const unsigned long long* xb = (const unsigned long long*)(XB + (size_t)m * D) + lane;
                    const unsigned long long* y0 = (const unsigned long long*)(Y + (size_t)p0 * D) + lane; const unsigned long long* y1 = (const unsigned long long*)(Y + (size_t)p1 * D) + lane;
                    f32x4 v[4]; float s = 0.f;
#pragma unroll
                    for (int j = 0; j < 4; ++j) { const unsigned long long xw = xb[64 * j], a = y0[64 * j], c = y1[64 * j];
                        v[j][0] = bflo((unsigned)xw) + bflo((unsigned)a) + bflo((unsigned)c); v[j][1] = bfhi((unsigned)xw) + bfhi((unsigned)a) + bfhi((unsigned)c);
                        v[j][2] = bflo((unsigned)(xw >> 32)) + bflo((unsigned)(a >> 32)) + bflo((unsigned)(c >> 32)); v[j][3] = bfhi((unsigned)(xw >> 32)) + bfhi((unsigned)(a >> 32)) + bfhi((unsigned)(c >> 32));
                        s += (v[j][0] * v[j][0] + v[j][1] * v[j][1]) + (v[j][2] * v[j][2] + v[j][3] * v[j][3]); }
                    const float rs = 1.0f / sqrtf(wave_sum(s) * (1.0f / D) + pg8::RMS_EPS);
                    const f32x4* gf = (const f32x4*)args.g_final + lane;
#pragma unroll
                    for (int j = 0; j < 4; ++j) (dry ? (f32x4*)((float*)(ws + WS_HE) + (size_t)m * D) + lane : xr)[64 * j] = v[j] * rs * gf[64 * j];
                }
            }
        }
}

__global__ void __launch_bounds__(NTHR, 2) hybrid_fwd(Args args) {
    extern __shared__ __attribute__((aligned(16))) unsigned char lds[];
    LAS unsigned char* ldsl = (LAS unsigned char*)lds;
    volatile LAS unsigned* MISC = (volatile LAS unsigned*)(ldsl + MISC_OFF);
    const int tid = threadIdx.x, lane = tid & 63, wave = __builtin_amdgcn_readfirstlane(tid >> 6);
    const int G = gridDim.x; const int bx = blockIdx.x;
    const int gw = bx * NWAVES + wave, NGW = G * NWAVES;
    unsigned char* ws = args.ws;
    for (int u = tid; u < (LDS_BYTES - LDSCTL_OFF) / 4; u += NTHR) ((LAS unsigned*)(ldsl + LDSCTL_OFF))[u] = 0u;
    __syncthreads();
    XcdBarrier bar; bar.bar = (unsigned*)(ws + WS_CTL) + CW_BAR + args.li * XCD_BAR_WORDS; bar.x = 0; bar.st = nullptr;
    if (MK_N_LAUNCHES == 1) bar = xcd_barrier_post((unsigned*)(ws + WS_CTL) + CW_BAR + args.li * XCD_BAR_WORDS, MISC + 8);
    const int lo = args.ph_lo, hi = args.ph_hi;

    WS_PTRS

    if (IN(0)) {
        unsigned* scr = (unsigned*)(lds + wave * 8704);
        constexpr int T_A = 16 * 36, T_B = 16 * 12, T_D = 16 * 16, T_L = T_A + T_B + T_D;
        constexpr int T_F = 16 * 44, T_G = 44 * 16, T_E = 16 * 56;
        constexpr int NT0 = 2 * T_L + 2 * T_F + T_G + 16 * T_E;
        for (int it = gw; it < NT0; it += NGW) {
            int r = it;
            if (r < 2 * T_L) { const int l = r / T_L; r -= l * T_L; const float* win = args.w_mix_in + (size_t)l * D * INC; const float* gm = args.g_mix + l * D;
                bf16* WIN = (bf16*)(ws + WS_WIN) + (size_t)l * NU * D;
                if (r < T_A) { transpose_tile(win, INC, 64 * (r / 36), 64 * (r % 36), WIN, D, 64 * (r % 36), gm, scr, lane); continue; } r -= T_A;
                if (r < T_B) { transpose_tile(win, INC, 64 * (r / 12), 2320 + 64 * (r % 12), WIN, D, 2304 + 64 * (r % 12), gm, scr, lane); continue; } r -= T_B;
                transpose_tile(args.w_mix_out + (size_t)l * D * D, D, 64 * (r / 16), 64 * (r % 16), (bf16*)(ws + WS_WOUT) + (size_t)l * D * D, D, 64 * (r % 16), nullptr, scr, lane); continue; }
            r -= 2 * T_L;
            if (r < 2 * T_F) { const int w3 = r / T_F; r -= w3 * T_F; const int n0 = 64 * (r % 44);
                transpose_tile(w3 ? args.ffn_w3 : args.ffn_w1, FF, 64 * (r / 44), n0, W13, D, (n0 >> 7) * 256 + (n0 & 127) + 128 * w3, args.g_ffn, scr, lane); continue; }
            r -= 2 * T_F;
            if (r < T_G) { transpose_tile(args.ffn_w2, D, 64 * (r / 16), 64 * (r % 16), W2, FF, 64 * (r % 16), nullptr, scr, lane); continue; }
            r -= T_G;
            { const int ew = r / T_E; r -= ew * T_E; const int e = ew >> 1, w3 = ew & 1; const int n0 = 64 * (r % 56);
              transpose_tile((w3 ? args.moe_w3 : args.moe_w1) + (size_t)e * D * FE, FE, 64 * (r / 56), n0, WE13 + (size_t)e * 2 * FE * D, D, (n0 >> 7) * 256 + (n0 & 127) + 128 * w3, args.g_ffn + D, scr, lane); }
        }
        for (int m = gw; m < M; m += NGW) {
            const f32x4* xr = (const f32x4*)(args.x + (size_t)m * D) + lane; float s = 0.f;
            unsigned long long* o8 = (unsigned long long*)(XB + (size_t)m * D) + lane;
#pragma unroll
            for (int j = 0; j < 4; ++j) { const f32x4 v = xr[64 * j]; s += (v[0] * v[0] + v[1] * v[1]) + (v[2] * v[2] + v[3] * v[3]);
                o8[64 * j] = (unsigned long long)pk2(v[0], v[1]) | ((unsigned long long)pk2(v[2], v[3]) << 32); }
            s = wave_sum(s);
            if (lane < 16) SS[(size_t)m * 16 + lane] = (lane == 0) ? s : 0.f;
        }
        for (int i = bx * NTHR + tid; i < 2049 * 4; i += G * NTHR) { const int d = i >> 2, h = i & 3; BL[i] = args.rel_bias[rel_bucket(d) * 4 + h] * LOG2E; }
        for (int i = bx * NTHR + tid; i < 2 * 16 * D; i += G * NTHR) { const int k = i & (D - 1), r = (i >> 10) & 15, l = i >> 14;
            ((bf16*)(ws + WS_WGLR))[i] = (bf16)f2bf(args.g_mix[l * D + k] * args.w_mix_in[((size_t)l * D + k) * INC + 2304 + r]); }
    }
    SEAM(0);

    Ctx c; c.args = args; c.tid = tid; c.lane = lane; c.wave = wave; c.G = G; c.bx = bx; c.gw = gw; c.NGW = NGW; c.lo = lo; c.hi = hi; c.bar = bar;
    layer_phases<0>(c, lds);
    layer_phases<1>(c, lds);
}
#undef IN
#undef SEAM
#undef GRID_BAR


extern "C" void kernel_launch(void* const* d_in, const int* in_sizes, int n_in, void* d_out, int out_size, void* d_ws, size_t ws_size, hipStream_t stream) {
    static int grid = 0;
    if (grid == 0) {
        if (n_in != 18 || in_sizes[0] != M * D || out_size != M * D || ws_size < WS_END) { fprintf(stderr, "kernel_launch: unexpected shapes / workspace (%zu < %zu)\n", ws_size, (size_t)WS_END); grid = -1; return; }
        int dev = 0, cus = 0, per_cu = 0;
        if (hipGetDevice(&dev) != hipSuccess || hipDeviceGetAttribute(&cus, hipDeviceAttributeMultiprocessorCount, dev) != hipSuccess) { grid = -1; return; }
        if (hipFuncSetAttribute((const void*)hybrid_fwd, hipFuncAttributeMaxDynamicSharedMemorySize, LDS_BYTES) != hipSuccess) { fprintf(stderr, "kernel_launch: hipFuncSetAttribute failed\n"); grid = -1; return; }
        if (hipOccupancyMaxActiveBlocksPerMultiprocessor(&per_cu, (const void*)hybrid_fwd, NTHR, LDS_BYTES) != hipSuccess || per_cu < 1) { fprintf(stderr, "kernel_launch: occupancy query says %d\n", per_cu); }
        (void)hipGetLastError();
        grid = cus;
    }
    if (grid < 0) return;
    if (hipMemsetAsync((char*)d_ws + WS_CTL, 0, CTL_ZERO_BYTES, stream) != hipSuccess) return;
    Args a{};
    const float** f = (const float**)&a;
    for (int i = 0; i < 18; ++i) f[i] = (const float*)d_in[i];
    a.out = (float*)d_out; a.ws = (unsigned char*)d_ws;
    if (MK_N_LAUNCHES == 1) {
#ifndef PROBE_MODE
#define PROBE_MODE 0
#endif
#ifdef PROBE_PHASE
        const int cuts[4][2] = {{0, PROBE_PHASE + 1}, {PROBE_PHASE, PROBE_PHASE + 1}, {PROBE_PHASE + 1, 64}, {0, 0}};
        for (int li = 0; li < 3; ++li) { a.ph_lo = cuts[li][0]; a.ph_hi = cuts[li][1]; a.li = li; a.pad = (li == 1) ? PROBE_MODE : 0; hipLaunchKernelGGL(hybrid_fwd, dim3(grid), dim3(NTHR), LDS_BYTES, stream, a); }
#else
        a.ph_lo = 0; a.ph_hi = 64; a.li = 0; hipLaunchKernelGGL(hybrid_fwd, dim3(grid), dim3(NTHR), LDS_BYTES, stream, a);
#endif
    }
    else {
        static const int phases[] = {0, 1, 2, 3, 4, 5, 6, 7, 17, 18, 19, 20, 21, 22, 23, 24, 25, 26, 27};
        for (int p : phases) { a.ph_lo = p; a.ph_hi = p + 1; hipLaunchKernelGGL(hybrid_fwd, dim3(grid), dim3(NTHR), LDS_BYTES, stream, a); }
    }
}
```

```cpp
#include <hip/hip_runtime.h>
#include <cstdio>
#include <cstdint>

#ifndef MK_N_LAUNCHES
#define MK_N_LAUNCHES 1
#endif

namespace pg8 {
#define PG8_LAS __attribute__((address_space(3)))
__device__ __forceinline__ int tid_here() { int t = threadIdx.x; asm volatile("" : "+v"(t)); return t; }
typedef unsigned short bf16_t;
typedef short bf16x8 __attribute__((ext_vector_type(8)));
typedef float f32x4 __attribute__((ext_vector_type(4)));
typedef unsigned u32x4 __attribute__((ext_vector_type(4)));
typedef unsigned u32x2 __attribute__((ext_vector_type(2)));
constexpr int BM = 256, BK = 64, HALF = 128, HTB = HALF * BK * 2, STAGE_BYTES = 8 * HTB, NXCD = 8, WGM = 8;

__host__ __device__ __forceinline__ int lds_byte(int r, int c) { const int st = (r >> 4) * 2 + (c >> 5), rr = r & 15, cc = c & 31, ob = rr * 64 + cc * 2; return st * 1024 + (ob ^ (((ob >> 9) & 1) << 5)); }
__host__ __device__ __forceinline__ void stage_rc(int b, int& R, int& C) { const int st = b / 1024, sb = b % 1024, swz = sb ^ (((sb >> 9) & 1) << 5); R = (st >> 1) * 16 + swz / 64; C = (st & 1) * 32 + (swz % 64) / 2; }
__host__ __device__ __forceinline__ int perm32(int rho) { const int n = rho >> 4, i = rho & 15; return 8 * (i >> 2) + 4 * n + (i & 3); }

struct Unit { int pm, pn, ko; };
struct Gemm { const bf16_t* A; const bf16_t* Bt; int M, N, K, ld; };

struct StaticOrder {
    int nM, nN, nwg, G, c;
    __host__ __device__ void init(int M, int N, int G_, int c_) { nM = M / BM; nN = N / BM; nwg = nM * nN; G = G_; c = c_; }
    __host__ __device__ bool next(int i, Unit& u) const {
        const long L = (long)i * G + c; if (L >= nwg) return false;
        int wgid = (int)L; { const int q = nwg / NXCD, r = nwg % NXCD, xcd = wgid % NXCD, off = wgid / NXCD; wgid = (xcd < r ? xcd * (q + 1) : r * (q + 1) + (xcd - r) * q) + off; }
        const int nig = WGM * nN, gid = wgid / nig, fm = gid * WGM, gsz = (nM - fm) < WGM ? (nM - fm) : WGM;
        u.pm = fm + ((wgid % nig) % gsz); u.pn = (wgid % nig) / gsz; u.ko = 0; return true;
    }
    __device__ __forceinline__ void a_ready(const Unit&) const {}
    __device__ __forceinline__ void done(const Unit&) const {}
};
struct MoeOrder {
    const int* panel_e; int npan, NT, GP, G, c;
    __device__ bool next(int i, Unit& u) const {
        const int nwg = npan * NT; const long L = (long)i * G + c; if (L >= nwg) return false;
        int wgid = (int)L; { const int q = nwg / NXCD, r = nwg % NXCD, xcd = wgid % NXCD, off = wgid / NXCD; wgid = (xcd < r ? xcd * (q + 1) : r * (q + 1) + (xcd - r) * q) + off; }
        const int nig = GP * NT, grp = wgid / nig, fm = grp * GP, gsz = (npan - fm) < GP ? (npan - fm) : GP; const int rr = wgid % nig;
        const int p = fm + rr % gsz; u.pm = p; u.pn = panel_e[p] * NT + rr / gsz; u.ko = 0; return true;
    }
    __device__ __forceinline__ void a_ready(const Unit&) const {}
    __device__ __forceinline__ void done(const Unit&) const {}
};

struct MoeTailOrder {
    const int* panel_e; int p0, ntp, G, c;
    __device__ bool next(int i, Unit& u) const {
        const long L = (long)i * G + c; if (L >= (long)ntp * 16) return false;
        const int kq = (int)L & 3, r = (int)L >> 2, p = p0 + (r >> 2); u.pm = p; u.pn = panel_e[p] * 4 + (r & 3); u.ko = kq * 896 * 2; return true;
    }
    __device__ __forceinline__ void a_ready(const Unit&) const {}
    __device__ __forceinline__ void done(const Unit&) const {}
};
__device__ __forceinline__ unsigned cvt_pk_bf16(float lo, float hi) { unsigned r; asm volatile("v_cvt_pk_bf16_f32 %0, %1, %2" : "=v"(r) : "v"(lo), "v"(hi)); return r; }

constexpr float RMS_EPS = 1e-6f;
__device__ __forceinline__ float rstd_of(const float* ss16) {
    const f32x4 a = *(const f32x4*)ss16, b = *(const f32x4*)(ss16 + 4), c = *(const f32x4*)(ss16 + 8), d = *(const f32x4*)(ss16 + 12);
    const float s = ((a[0] + a[1]) + (a[2] + a[3])) + ((b[0] + b[1]) + (b[2] + b[3])) + ((c[0] + c[1]) + (c[2] + c[3])) + ((d[0] + d[1]) + (d[2] + d[3]));
    return 1.0f / sqrtf(s * (1.0f / 1024.0f) + RMS_EPS);
}
__device__ __forceinline__ void rstd4(const float* SS, int row0, float (&rs)[4]) {
    f32x4 p[4][4];
#pragma unroll
    for (int m = 0; m < 4; ++m)
#pragma unroll
        for (int q = 0; q < 4; ++q) p[m][q] = *(const f32x4*)(SS + (size_t)(row0 + 16 * m) * 16 + 4 * q);
    asm volatile("" : "+v"(p[0][0]), "+v"(p[0][1]), "+v"(p[0][2]), "+v"(p[0][3]), "+v"(p[1][0]), "+v"(p[1][1]), "+v"(p[1][2]), "+v"(p[1][3]),
                      "+v"(p[2][0]), "+v"(p[2][1]), "+v"(p[2][2]), "+v"(p[2][3]), "+v"(p[3][0]), "+v"(p[3][1]), "+v"(p[3][2]), "+v"(p[3][3]));
#pragma unroll
    for (int m = 0; m < 4; ++m) { const f32x4 a = p[m][0], b = p[m][1], c = p[m][2], d = p[m][3];
        const float s = ((a[0] + a[1]) + (a[2] + a[3])) + ((b[0] + b[1]) + (b[2] + b[3])) + ((c[0] + c[1]) + (c[2] + c[3])) + ((d[0] + d[1]) + (d[2] + d[3]));
        rs[m] = 1.0f / sqrtf(s * (1.0f / 1024.0f) + RMS_EPS); }
}
__device__ __forceinline__ float logsig16(float x) { return ((x < 0.f ? x : 0.f) - log1pf(__expf(-fabsf(x)))) * (1.0f / 16.0f); }
__device__ __forceinline__ float silu_f(float a) { return a / (1.0f + __expf(-a)); }

struct EpiU {
    static constexpr bool PERM = true, AFTER_DRAIN = false;
    bf16_t* U; int ldu; const float* SS; float qs;
    __device__ __forceinline__ void operator()(const f32x4 (&acc)[2][2][4][2], const Unit& u, int wr, int wc, int fr, int fq) const {
        const int row0 = u.pm * BM + wr * 64 + fr, col0 = u.pn * BM + wc * 32 + 8 * fq;
        const float sc = (u.pn == 0) ? qs : ((u.pn == 3) ? 0.125f : 1.0f);
#pragma unroll
        for (int ai = 0; ai < 2; ++ai) { float rs4[4]; rstd4(SS, row0 + ai * HALF, rs4);
#pragma unroll
            for (int m = 0; m < 4; ++m) { const int row = row0 + ai * HALF + m * 16; const float rs = rs4[m] * sc;
                bf16_t* rowp = U + (size_t)row * ldu + col0;
#pragma unroll
                for (int bj = 0; bj < 2; ++bj) { const f32x4 v0 = acc[ai][bj][m][0] * rs, v1 = acc[ai][bj][m][1] * rs;
                    u32x4 w; w.x = cvt_pk_bf16(v0[0], v0[1]); w.y = cvt_pk_bf16(v0[2], v0[3]); w.z = cvt_pk_bf16(v1[0], v1[1]); w.w = cvt_pk_bf16(v1[2], v1[3]);
                    *(u32x4*)(rowp + bj * HALF) = w; } } }
    }
};
template <bool IN_F32, int PM = 0> struct EpiRes {
    static constexpr bool PERM = true, AFTER_DRAIN = false;
    const void* Xin; bf16_t* XB; float* SS;
    __device__ __forceinline__ void operator()(const f32x4 (&acc)[2][2][4][2], const Unit& u, int wr, int wc, int fr, int fq) const {
        const int row0 = u.pm * BM + wr * 64 + fr, col0 = u.pn * BM + wc * 32 + 8 * fq;
        if constexpr (IN_F32) {
#pragma unroll
            for (int ai = 0; ai < 2; ++ai) { f32x4 xo[4][2][2];
#pragma unroll
                for (int m = 0; m < 4; ++m)
#pragma unroll
                    for (int bj = 0; bj < 2; ++bj) { const float* p = (const float*)Xin + (size_t)(row0 + ai * HALF + m * 16) * 1024 + col0 + bj * HALF; xo[m][bj][0] = *(const f32x4*)p; xo[m][bj][1] = *(const f32x4*)(p + 4); }
                asm volatile("" : "+v"(xo[0][0][0]), "+v"(xo[0][0][1]), "+v"(xo[0][1][0]), "+v"(xo[0][1][1]), "+v"(xo[1][0][0]), "+v"(xo[1][0][1]), "+v"(xo[1][1][0]), "+v"(xo[1][1][1]),
                                  "+v"(xo[2][0][0]), "+v"(xo[2][0][1]), "+v"(xo[2][1][0]), "+v"(xo[2][1][1]), "+v"(xo[3][0][0]), "+v"(xo[3][0][1]), "+v"(xo[3][1][0]), "+v"(xo[3][1][1]));
#pragma unroll
                for (int m = 0; m < 4; ++m) { const int row = row0 + ai * HALF + m * 16; float ssum = 0.f;
#pragma unroll
                    for (int bj = 0; bj < 2; ++bj) { const f32x4 v0 = xo[m][bj][0] + acc[ai][bj][m][0], v1 = xo[m][bj][1] + acc[ai][bj][m][1];
                        u32x4 w; w.x = cvt_pk_bf16(v0[0], v0[1]); w.y = cvt_pk_bf16(v0[2], v0[3]); w.z = cvt_pk_bf16(v1[0], v1[1]); w.w = cvt_pk_bf16(v1[2], v1[3]);
                        *(u32x4*)(XB + (size_t)row * 1024 + col0 + bj * HALF) = w;
                        ssum += ((v0[0] * v0[0] + v0[1] * v0[1]) + (v0[2] * v0[2] + v0[3] * v0[3])) + ((v1[0] * v1[0] + v1[1] * v1[1]) + (v1[2] * v1[2] + v1[3] * v1[3])); }
                    ssum += __shfl_xor(ssum, 16); ssum += __shfl_xor(ssum, 32);
                    if (fq == 0) SS[(size_t)row * 16 + u.pn * 4 + wc] = ssum; } }
        } else {
            u32x4 xo[2][4][2];
#pragma unroll
            for (int ai = 0; ai < 2; ++ai)
#pragma unroll
                for (int m = 0; m < 4; ++m)
#pragma unroll
                    for (int bj = 0; bj < 2; ++bj) xo[ai][m][bj] = *(const u32x4*)((const bf16_t*)Xin + (size_t)(row0 + ai * HALF + m * 16) * 1024 + col0 + bj * HALF);
            asm volatile("" : "+v"(xo[0][0][0]), "+v"(xo[0][0][1]), "+v"(xo[0][1][0]), "+v"(xo[0][1][1]), "+v"(xo[0][2][0]), "+v"(xo[0][2][1]), "+v"(xo[0][3][0]), "+v"(xo[0][3][1]),
                              "+v"(xo[1][0][0]), "+v"(xo[1][0][1]), "+v"(xo[1][1][0]), "+v"(xo[1][1][1]), "+v"(xo[1][2][0]), "+v"(xo[1][2][1]), "+v"(xo[1][3][0]), "+v"(xo[1][3][1]));
#pragma unroll
            for (int ai = 0; ai < 2; ++ai)
#pragma unroll
                for (int m = 0; m < 4; ++m) { const int row = row0 + ai * HALF + m * 16; float ssum = 0.f;
#pragma unroll
                    for (int bj = 0; bj < 2; ++bj) { const u32x4 x = xo[ai][m][bj]; f32x4 v0, v1;
                        v0[0] = __builtin_bit_cast(float, x.x << 16) + acc[ai][bj][m][0][0]; v0[1] = __builtin_bit_cast(float, x.x & 0xffff0000u) + acc[ai][bj][m][0][1];
                        v0[2] = __builtin_bit_cast(float, x.y << 16) + acc[ai][bj][m][0][2]; v0[3] = __builtin_bit_cast(float, x.y & 0xffff0000u) + acc[ai][bj][m][0][3];
                        v1[0] = __builtin_bit_cast(float, x.z << 16) + acc[ai][bj][m][1][0]; v1[1] = __builtin_bit_cast(float, x.z & 0xffff0000u) + acc[ai][bj][m][1][1];
                        v1[2] = __builtin_bit_cast(float, x.w << 16) + acc[ai][bj][m][1][2]; v1[3] = __builtin_bit_cast(float, x.w & 0xffff0000u) + acc[ai][bj][m][1][3];
                        u32x4 w; w.x = cvt_pk_bf16(v0[0], v0[1]); w.y = cvt_pk_bf16(v0[2], v0[3]); w.z = cvt_pk_bf16(v1[0], v1[1]); w.w = cvt_pk_bf16(v1[2], v1[3]);
                        if constexpr (!(PM & 8)) *(u32x4*)(XB + (size_t)row * 1024 + col0 + bj * HALF) = w;
                        ssum += ((v0[0] * v0[0] + v0[1] * v0[1]) + (v0[2] * v0[2] + v0[3] * v0[3])) + ((v1[0] * v1[0] + v1[1] * v1[1]) + (v1[2] * v1[2] + v1[3] * v1[3])); }
                    if constexpr (!(PM & 16)) { ssum += __shfl_xor(ssum, 16); ssum += __shfl_xor(ssum, 32); }
                    if constexpr (!(PM & 4)) { if (fq == 0) SS[(size_t)row * 16 + u.pn * 4 + wc] = ssum; }
                    if constexpr ((PM & 12) == 12) asm volatile("" :: "v"(ssum)); }
        }
    }
};
template <bool MOE> struct EpiGlu {
    static constexpr bool PERM = true, AFTER_DRAIN = false;
    bf16_t* O; int ldo; const float* SS;
    __device__ __forceinline__ void operator()(const f32x4 (&acc)[2][2][4][2], const Unit& u, int wr, int wc, int fr, int fq) const {
        const int row0 = u.pm * BM + wr * 64 + fr; const int pnl = MOE ? (u.pn % 28) : u.pn; const int col0 = pnl * HALF + wc * 32 + 8 * fq;
#pragma unroll
        for (int ai = 0; ai < 2; ++ai) { float rs4[4];
            if constexpr (MOE) {
#pragma unroll
                for (int m = 0; m < 4; ++m) rs4[m] = SS[row0 + ai * HALF + m * 16];
                asm volatile("" : "+v"(rs4[0]), "+v"(rs4[1]), "+v"(rs4[2]), "+v"(rs4[3]));
            } else rstd4(SS, row0 + ai * HALF, rs4);
#pragma unroll
            for (int m = 0; m < 4; ++m) { const int row = row0 + ai * HALF + m * 16; const float rs = rs4[m];
                const f32x4 a0 = acc[ai][0][m][0] * rs, a1 = acc[ai][0][m][1] * rs, b0 = acc[ai][1][m][0] * rs, b1 = acc[ai][1][m][1] * rs;
                f32x4 g0, g1;
#pragma unroll
                for (int j = 0; j < 4; ++j) { g0[j] = silu_f(a0[j]) * b0[j]; g1[j] = silu_f(a1[j]) * b1[j]; }
                u32x4 w; w.x = cvt_pk_bf16(g0[0], g0[1]); w.y = cvt_pk_bf16(g0[2], g0[3]); w.z = cvt_pk_bf16(g1[0], g1[1]); w.w = cvt_pk_bf16(g1[2], g1[3]);
                *(u32x4*)(O + (size_t)row * ldo + col0) = w; } }
    }
};
struct EpiMoeDown {
    static constexpr bool PERM = true, AFTER_DRAIN = false;
    bf16_t* Y; const float* gate;
    __device__ __forceinline__ void operator()(const f32x4 (&acc)[2][2][4][2], const Unit& u, int wr, int wc, int fr, int fq) const {
        const int row0 = u.pm * BM + wr * 64 + fr, col0 = (u.pn & 3) * BM + wc * 32 + 8 * fq;
        float gt[2][4];
#pragma unroll
        for (int ai = 0; ai < 2; ++ai)
#pragma unroll
            for (int m = 0; m < 4; ++m) gt[ai][m] = gate[row0 + ai * HALF + m * 16];
        asm volatile("" : "+v"(gt[0][0]), "+v"(gt[0][1]), "+v"(gt[0][2]), "+v"(gt[0][3]), "+v"(gt[1][0]), "+v"(gt[1][1]), "+v"(gt[1][2]), "+v"(gt[1][3]));
#pragma unroll
        for (int ai = 0; ai < 2; ++ai)
#pragma unroll
            for (int m = 0; m < 4; ++m) { const int row = row0 + ai * HALF + m * 16; const float g = gt[ai][m]; bf16_t* rowp = Y + (size_t)row * 1024 + col0;
#pragma unroll
                for (int bj = 0; bj < 2; ++bj) { const f32x4 v0 = acc[ai][bj][m][0] * g, v1 = acc[ai][bj][m][1] * g;
                    u32x4 w; w.x = cvt_pk_bf16(v0[0], v0[1]); w.y = cvt_pk_bf16(v0[2], v0[3]); w.z = cvt_pk_bf16(v1[0], v1[1]); w.w = cvt_pk_bf16(v1[2], v1[3]);
                    *(u32x4*)(rowp + bj * HALF) = w; } }
    }
};

struct EpiMoeDownPart {
    static constexpr bool PERM = false, AFTER_DRAIN = false;
    float* YT; const float* gate; int row_base;
    __device__ __forceinline__ void operator()(const f32x4 (&acc)[2][2][4][2], const Unit& u, int wr, int wc, int fr, int fq) const {
        const int row0 = u.pm * BM + wr * 64 + fr, col0 = (u.pn & 3) * BM + wc * 32 + 4 * fq; const int kq = u.ko / 1792;
#pragma unroll
        for (int ai = 0; ai < 2; ++ai)
#pragma unroll
            for (int m = 0; m < 4; ++m) { const int row = row0 + ai * HALF + m * 16; const float gtv = gate[row]; float* rowp = YT + ((size_t)kq * 2048 + (row - row_base)) * 1024 + col0;
#pragma unroll
                for (int bj = 0; bj < 2; ++bj)
#pragma unroll
                    for (int n = 0; n < 2; ++n) *(f32x4*)(rowp + bj * HALF + n * 16) = acc[ai][bj][m][n] * gtv; }
    }
};
template <class Epi, class Sched, bool ALIGN_EPI = false, bool SP2 = false>
__device__ __forceinline__ void gemm_phase(PG8_LAS unsigned char* lds, const Gemm g, const Sched& S, const Epi& E, const bool skip_epi = false) {
    const int tid = tid_here(), wid = __builtin_amdgcn_readfirstlane(tid >> 6), lane = tid & 63, wr = wid >> 2, wc = wid & 3, fr = lane & 15, fq = lane >> 4;
    const int K = g.ld, nt = g.K / BK;
    unsigned voffA[2], voffB[2];
#pragma unroll
    for (int i = 0; i < 2; ++i) { int R, C; stage_rc(tid * 16 + i * 8192, R, C); const int Rb = Epi::PERM ? ((R & ~31) + perm32(R & 31)) : R;
        voffA[i] = (unsigned)(R * K + C) * 2u; voffB[i] = (unsigned)(Rb * K + C) * 2u; }
    const size_t kstep = (size_t)(BK * 2);
    const size_t hstep = (size_t)HALF * K * 2;
    const size_t tstep = 2 * hstep;
    const unsigned ldsw = (unsigned)wid * 1024u;
    const int aoff = lds_byte(wr * 64 + fr, fq * 8), boff = lds_byte(wc * 32 + fr, fq * 8);
#define PG8_SA(b, h) (((b) * 2 + (h)) * HTB)
#define PG8_SB(b, h) ((4 + (b) * 2 + (h)) * HTB)
#define PG8_STAGE(bufoff, gbase, voff) do { _Pragma("unroll") for (int _i = 0; _i < 2; ++_i) \
        __builtin_amdgcn_global_load_lds((const unsigned*)((const char*)(gbase) + (voff)[_i]), (PG8_LAS unsigned*)(lds + (bufoff) + ldsw + _i * 8192), 16, 0, 0); } while (0)
#define PG8_LDA(dst, b, h) do { _Pragma("unroll") for (int m = 0; m < 4; ++m) _Pragma("unroll") for (int k = 0; k < 2; ++k) dst[m][k] = *(const PG8_LAS bf16x8*)(lds + PG8_SA(b, h) + aoff + m * 2048 + k * 1024); } while (0)
#define PG8_LDB(dst, b, h) do { _Pragma("unroll") for (int n = 0; n < 2; ++n) _Pragma("unroll") for (int k = 0; k < 2; ++k) dst[n][k] = *(const PG8_LAS bf16x8*)(lds + PG8_SB(b, h) + boff + n * 2048 + k * 1024); } while (0)
#define PG8_MMA(ai, bj, At, Bt) do { __builtin_amdgcn_s_setprio(1); _Pragma("unroll") for (int m = 0; m < 4; ++m) _Pragma("unroll") for (int n = 0; n < 2; ++n) _Pragma("unroll") for (int k = 0; k < 2; ++k) \
        acc[ai][bj][m][n] = __builtin_amdgcn_mfma_f32_16x16x32_bf16(Bt[n][k], At[m][k], acc[ai][bj][m][n], 0, 0, 0); __builtin_amdgcn_s_setprio(0); } while (0)
#define PG8_WAIT_V(n) asm volatile("s_waitcnt vmcnt(" #n ")" ::: "memory")
#define PG8_WAIT_L(n) asm volatile("s_waitcnt lgkmcnt(" #n ")" ::: "memory")
#define PG8_BAR __builtin_amdgcn_s_barrier()
#define PG8_SCHED __builtin_amdgcn_sched_barrier(0)
    Unit cur, nxt; int ui = 0;
    if (!S.next(0, cur)) return;
    f32x4 acc[2][2][4][2];
#pragma unroll
    for (int a = 0; a < 2; ++a)
#pragma unroll
        for (int b = 0; b < 2; ++b)
#pragma unroll
            for (int m = 0; m < 4; ++m)
#pragma unroll
                for (int n = 0; n < 2; ++n) acc[a][b][m][n] = (f32x4){0.f, 0.f, 0.f, 0.f};
    bf16x8 At[4][2], B0[2][2], B1[2][2];
    const char* cA = (const char*)g.A + (size_t)cur.pm * tstep + cur.ko; const char* cB = (const char*)g.Bt + (size_t)cur.pn * tstep + cur.ko;
    S.a_ready(cur);
    if constexpr (SP2) {
        PG8_STAGE(PG8_SB(0, 0), cB, voffB); PG8_STAGE(PG8_SB(0, 1), cB + hstep, voffB); PG8_STAGE(PG8_SA(0, 0), cA, voffA); PG8_STAGE(PG8_SA(0, 1), cA + hstep, voffA);
        if (wr == 1) PG8_BAR;
        PG8_WAIT_V(2); PG8_BAR;
        PG8_STAGE(PG8_SB(1, 0), cB + kstep, voffB); PG8_STAGE(PG8_SA(1, 0), cA + kstep, voffA); PG8_STAGE(PG8_SB(1, 1), cB + hstep + kstep, voffB);
        PG8_WAIT_V(6); PG8_BAR;
    } else {
        PG8_STAGE(PG8_SB(0, 0), cB, voffB); PG8_STAGE(PG8_SA(0, 0), cA, voffA); PG8_STAGE(PG8_SB(0, 1), cB + hstep, voffB); PG8_STAGE(PG8_SA(0, 1), cA + hstep, voffA);
        if (wr == 1) PG8_BAR;
        PG8_WAIT_V(4); PG8_BAR;
        PG8_STAGE(PG8_SB(1, 0), cB + kstep, voffB); PG8_STAGE(PG8_SA(1, 0), cA + kstep, voffA); PG8_STAGE(PG8_SB(1, 1), cB + hstep + kstep, voffB);
        PG8_WAIT_V(6); PG8_BAR;
    }
    for (;;) {
        const bool has_next = S.next(ui + 1, nxt);
        const char* nA = has_next ? (const char*)g.A + (size_t)nxt.pm * tstep + nxt.ko : cA; const char* nB = has_next ? (const char*)g.Bt + (size_t)nxt.pn * tstep + nxt.ko : cB;
        for (int t = 0; t < nt; t += 2) {
            const bool last = (t == nt - 2);
            const char* a1 = cA + (size_t)(t + 1) * kstep;
            const char* a2 = last ? nA : cA + (size_t)(t + 2) * kstep; const char* b2 = last ? nB : cB + (size_t)(t + 2) * kstep;
            const char* a3 = a2 + kstep; const char* b3 = b2 + kstep;
            if (last && has_next) S.a_ready(nxt);
            if constexpr (SP2) {
            PG8_LDB(B0, 0, 0); PG8_LDB(B1, 0, 1); PG8_SCHED; PG8_LDA(At, 0, 0); PG8_STAGE(PG8_SA(1, 1), a1 + hstep, voffA);
            PG8_WAIT_V(8); PG8_WAIT_L(0); PG8_BAR; PG8_MMA(0, 0, At, B0); PG8_MMA(0, 1, At, B1); PG8_BAR; PG8_SCHED;
            PG8_LDA(At, 0, 1); PG8_STAGE(PG8_SB(0, 0), b2, voffB); PG8_STAGE(PG8_SB(0, 1), b2 + hstep, voffB); PG8_STAGE(PG8_SA(0, 0), a2, voffA);
            PG8_WAIT_V(8); PG8_WAIT_L(0); PG8_BAR; PG8_MMA(1, 0, At, B0); PG8_MMA(1, 1, At, B1); PG8_BAR; PG8_SCHED;
            PG8_LDB(B0, 1, 0); PG8_LDB(B1, 1, 1); PG8_SCHED; PG8_LDA(At, 1, 0); PG8_STAGE(PG8_SA(0, 1), a2 + hstep, voffA);
            PG8_WAIT_V(8); PG8_WAIT_L(0); PG8_BAR; PG8_MMA(0, 0, At, B0); PG8_MMA(0, 1, At, B1); PG8_BAR; PG8_SCHED;
            PG8_LDA(At, 1, 1); PG8_STAGE(PG8_SB(1, 0), b3, voffB); PG8_STAGE(PG8_SB(1, 1), b3 + hstep, voffB); PG8_STAGE(PG8_SA(1, 0), a3, voffA);
            PG8_WAIT_V(8); PG8_WAIT_L(0); PG8_BAR; PG8_MMA(1, 0, At, B0); PG8_MMA(1, 1, At, B1); PG8_BAR; PG8_SCHED;
            } else {
            PG8_LDB(B0, 0, 0); PG8_SCHED; PG8_LDA(At, 0, 0); PG8_STAGE(PG8_SA(1, 1), a1 + hstep, voffA);
            PG8_WAIT_L(8); PG8_BAR; PG8_WAIT_L(0); PG8_MMA(0, 0, At, B0); PG8_BAR; PG8_SCHED;
            PG8_LDB(B1, 0, 1); PG8_STAGE(PG8_SB(0, 0), b2, voffB);
            PG8_BAR; PG8_WAIT_L(0); PG8_MMA(0, 1, At, B1); PG8_BAR;
            PG8_LDA(At, 0, 1); PG8_STAGE(PG8_SA(0, 0), a2, voffA);
            PG8_BAR; PG8_WAIT_L(0); PG8_MMA(1, 0, At, B0); PG8_BAR; PG8_SCHED;
            PG8_STAGE(PG8_SB(0, 1), b2 + hstep, voffB);
            PG8_WAIT_V(6); PG8_BAR; PG8_MMA(1, 1, At, B1); PG8_BAR;
            PG8_LDB(B0, 1, 0); PG8_SCHED; PG8_LDA(At, 1, 0); PG8_STAGE(PG8_SA(0, 1), a2 + hstep, voffA);
            PG8_WAIT_L(8); PG8_BAR; PG8_WAIT_L(0); PG8_MMA(0, 0, At, B0); PG8_BAR; PG8_SCHED;
            PG8_LDB(B1, 1, 1); PG8_STAGE(PG8_SB(1, 0), b3, voffB);
            PG8_BAR; PG8_WAIT_L(0); PG8_MMA(0, 1, At, B1); PG8_BAR;
            PG8_LDA(At, 1, 1); PG8_STAGE(PG8_SA(1, 0), a3, voffA);
            PG8_BAR; PG8_WAIT_L(0); PG8_MMA(1, 0, At, B0); PG8_BAR; PG8_SCHED;
            PG8_STAGE(PG8_SB(1, 1), b3 + hstep, voffB);
            PG8_WAIT_V(6); PG8_BAR; PG8_MMA(1, 1, At, B1); PG8_BAR;
            }
        }
        if constexpr (ALIGN_EPI) { if (wr == 0) PG8_BAR; }
        if constexpr (!Epi::AFTER_DRAIN) { if (!skip_epi) E(acc, cur, wr, wc, fr, fq); S.done(cur); }
        if (!has_next) break;
#pragma unroll
        for (int a = 0; a < 2; ++a)
#pragma unroll
            for (int b = 0; b < 2; ++b)
#pragma unroll
                for (int m = 0; m < 4; ++m)
#pragma unroll
                    for (int n = 0; n < 2; ++n) acc[a][b][m][n] = (f32x4){0.f, 0.f, 0.f, 0.f};
        cur = nxt; cA = nA; cB = nB; ++ui;
        if constexpr (ALIGN_EPI) { if (wr == 1) PG8_BAR; }
    }
    PG8_WAIT_V(0);
    if constexpr (!ALIGN_EPI) { if (wr == 0) PG8_BAR; }
    PG8_BAR;
#undef PG8_SA
#undef PG8_SB
#undef PG8_STAGE
#undef PG8_LDA
#undef PG8_LDB
#undef PG8_MMA
#undef PG8_WAIT_V
#undef PG8_WAIT_L
#undef PG8_BAR
#undef PG8_SCHED
}
}

constexpr int NWAVES = 8, NTHR = NWAVES * 64;
constexpr int NB = 8, SEQ = 2048, D = 1024, M = NB * SEQ;
constexpr int INC = 3088;
constexpr int NU = 3072;
constexpr int UQ = 0, UK = 256, UV = 512, UGQ = 768, UGK = 1024, UGV = 1280, UGR = 1792, UCI = 2304, UCB = 2560, UCC = 2816;
constexpr int FF = 2816, FE = 3584, NE = 8;
constexpr int MAXPAN = 136, MAXROWS = MAXPAN * 256;
constexpr float LOG2E = 1.4426950408889634f;
constexpr float QS_ATT = 0.125f * LOG2E;

constexpr size_t MiB = 1u << 20;
constexpr size_t WS_CTL = 0, CTL_ZERO_BYTES = 1 * MiB;
constexpr size_t WS_SS = 1 * MiB;
constexpr size_t WS_BL = 2 * MiB;
constexpr size_t WS_DEC = 2 * MiB + 64 * 1024;
constexpr size_t WS_TOPI = 3 * MiB;
constexpr size_t WS_TOPW = 3 * MiB + 128 * 1024;
constexpr size_t WS_POS = 3 * MiB + 256 * 1024;
constexpr size_t WS_RS3 = 3 * MiB + 384 * 1024;
constexpr size_t WS_CNT = 3 * MiB + 448 * 1024;
constexpr size_t WS_PANE = 3 * MiB + 456 * 1024;
constexpr size_t WS_ROWGATE = 4 * MiB;
constexpr size_t WS_ROWRS = 4 * MiB + 256 * 1024;
constexpr size_t WS_GLR = 5 * MiB;
constexpr size_t WS_WE13 = 8 * MiB;
constexpr size_t WS_Y = WS_WE13;
constexpr size_t WS_YT = WS_WE13 + 68 * MiB;
constexpr size_t WS_XS = 120 * MiB;
constexpr size_t WS_WE2 = WS_XS;
constexpr size_t WS_HE = 188 * MiB;
constexpr size_t WS_WIN = WS_HE;
constexpr size_t WS_WGLR = WS_HE + 12 * MiB;
constexpr size_t WS_WOUT = WS_HE + 13 * MiB;
constexpr size_t WS_W13 = WS_HE + 17 * MiB;
constexpr size_t WS_W2 = WS_HE + 28 * MiB;
constexpr size_t WS_XB = WS_HE + 238 * MiB;
constexpr size_t WS_U = WS_HE + 66 * MiB;
constexpr size_t WS_H = WS_U;
constexpr size_t WS_MIX = WS_HE + 170 * MiB;
constexpr size_t WS_CST = WS_HE + 202 * MiB;
constexpr size_t WS_END = WS_HE + 270 * MiB;
static_assert(WS_CST + 32 * MiB <= WS_END, "ws map");
constexpr int CW_BAR = 4096;
constexpr int CW_SC = 32768;
constexpr int CW_TMO2 = 65536;

constexpr int LDS_BYTES = 147456;
constexpr int LDSCTL_OFF = 131072 + 14 * 1024, MISC_OFF = LDSCTL_OFF + 320;

#define GAS __attribute__((address_space(1)))
#define LAS __attribute__((address_space(3)))
typedef unsigned short bf16;
typedef float f32x4 __attribute__((ext_vector_type(4)));
typedef unsigned v4u __attribute__((ext_vector_type(4)));
__device__ __forceinline__ unsigned f2bf(float f) { unsigned u = __builtin_bit_cast(unsigned, f); return (u + 0x7fffu + ((u >> 16) & 1u)) >> 16; }
__device__ __forceinline__ unsigned pk2(float lo, float hi) { return f2bf(lo) | (f2bf(hi) << 16); }
__device__ __forceinline__ float bf2f(unsigned short b) { return __builtin_bit_cast(float, (unsigned)b << 16); }
__device__ __forceinline__ float bflo(unsigned w) { return __builtin_bit_cast(float, w << 16); }
__device__ __forceinline__ float bfhi(unsigned w) { return __builtin_bit_cast(float, w & 0xffff0000u); }
__device__ __forceinline__ float wave_sum(float v) {
#pragma unroll
    for (int o = 1; o < 64; o <<= 1) v += __shfl_xor(v, o);
    return v;
}
__device__ __forceinline__ float wave_max(float v) {
#pragma unroll
    for (int o = 1; o < 64; o <<= 1) v = fmaxf(v, __shfl_xor(v, o));
    return v;
}

#define XB_TMO      128
#define XB_XCNT(j)  (256  + 64 * (j))
#define XB_XSUB(j)  (1280 + 64 * (j))
#define XB_XGEN(j)  (2304 + 64 * (j))
#define XB_TOP      3328
#define XB_TOPGEN   3392
#define XCD_BAR_WORDS 3456
#define XB_SPIN_CAP (1u << 18)
__device__ __forceinline__ unsigned xb_ld(unsigned* p)              { return __hip_atomic_load(p, __ATOMIC_RELAXED, __HIP_MEMORY_SCOPE_AGENT); }
__device__ __forceinline__ unsigned xb_add(unsigned* p, unsigned v) { return __hip_atomic_fetch_add(p, v, __ATOMIC_RELAXED, __HIP_MEMORY_SCOPE_AGENT); }
__device__ __forceinline__ unsigned xb_xcc_id() { return (unsigned)__builtin_amdgcn_s_getreg((3 << 11) | 20) & 0xFu; }
#define XB_SPIN(cond, bar) do { unsigned _sp = 0; while (cond) { __builtin_amdgcn_s_sleep(1); \
    if ((++_sp & 255u) == 0u) { if (xb_ld(&(bar)[XB_TMO])) break; if (_sp > XB_SPIN_CAP) { atomicAdd(&(bar)[XB_TMO], 1u); break; } } } } while (0)
struct XcdBarrier { unsigned* bar; unsigned x; volatile LAS unsigned* st; };
__device__ __forceinline__ XcdBarrier xcd_barrier_post(unsigned* bar, volatile LAS unsigned* st) {
    XcdBarrier b; b.bar = bar; b.x = xb_xcc_id(); b.st = st;
    if (threadIdx.x == 0) (void)xb_add(&bar[XB_XCNT(b.x)], 1u);
    return b;
}
__device__ __forceinline__ void xcd_barrier_complete(unsigned* bar, unsigned x, unsigned& nloc, unsigned& nx) {
    const unsigned G = gridDim.x * gridDim.y * gridDim.z;
    unsigned sum, cnt, mine, sp = 0u;
    for (;;) {
        sum = 0u; cnt = 0u; mine = 0u;
#pragma unroll
        for (unsigned j = 0; j < 16; ++j) { const unsigned c = xb_ld(&bar[XB_XCNT(j)]); sum += c; cnt += (c > 0u) ? 1u : 0u; mine = (j == x) ? c : mine; }
        if (sum == G) break;
        __builtin_amdgcn_s_sleep(1);
        if ((++sp & 255u) == 0u) { if (xb_ld(&bar[XB_TMO])) break; if (sp > XB_SPIN_CAP) { atomicAdd(&bar[XB_TMO], 1u); break; } }
    }
    nloc = mine > 0u ? mine : 1u; nx = cnt > 0u ? cnt : 1u;
}
__device__ __forceinline__ void xcd_barrier(const XcdBarrier& b) {
    asm volatile("s_waitcnt vmcnt(0)" ::: "memory");
    __syncthreads();
    if (threadIdx.x == 0) {
        unsigned* bar = b.bar;
        __builtin_amdgcn_s_waitcnt(0);
        unsigned nloc = b.st[0], nx = b.st[1];
        if (nloc == 0u) { xcd_barrier_complete(bar, b.x, nloc, nx); b.st[0] = nloc; b.st[1] = nx; }
        const unsigned old = xb_add(&bar[XB_XSUB(b.x)], 1u);
        const unsigned gen = old / nloc;
        if (old + 1u == (gen + 1u) * nloc) {
            __builtin_amdgcn_fence(__ATOMIC_RELEASE, "agent");
            asm volatile("s_waitcnt vmcnt(0)" ::: "memory");
            const unsigned og = xb_add(&bar[XB_TOP], 1u);
            const unsigned tg = og / nx;
            if (og + 1u == (tg + 1u) * nx) xb_add(&bar[XB_TOPGEN], 1u);
            else XB_SPIN(xb_ld(&bar[XB_TOPGEN]) == tg, bar);
            __builtin_amdgcn_fence(__ATOMIC_ACQUIRE, "agent");
            xb_add(&bar[XB_XGEN(b.x)], 1u);
            asm volatile("s_waitcnt vmcnt(0)" ::: "memory");
        } else {
            XB_SPIN(xb_ld(&bar[XB_XGEN(b.x)]) == gen, bar);
            __builtin_amdgcn_fence(__ATOMIC_ACQUIRE, "agent");
            asm volatile("s_waitcnt vmcnt(0)" ::: "memory");
        }
    }
    __syncthreads();
}

struct Args {
    const float* x; const float* w_mix_in; const float* w_mix_out; const float* g_mix; const float* rel_bias; const float* gla_w_gate; const float* gla_b_gate;
    const float* gla_g_norm; const float* conv_w; const float* g_ffn; const float* ffn_w1; const float* ffn_w3; const float* ffn_w2; const float* moe_router;
    const float* moe_w1; const float* moe_w3; const float* moe_w2; const float* g_final;
    float* out; unsigned char* ws; int ph_lo, ph_hi, li, pad;
};

__device__ __forceinline__ void transpose_tile(const float* src, int ldsrc, int k0, int n0, bf16* dst, int ldd, int drow0, const float* ksc, unsigned* scr, int lane) {
    const int nq = lane & 15, kk = lane >> 4;
#pragma unroll
    for (int i = 0; i < 8; ++i) { const int k = 8 * i + 2 * kk; const float* p = src + (size_t)(k0 + k) * ldsrc + n0 + 4 * nq;
        const f32x4 r0 = *(const f32x4*)p, r1 = *(const f32x4*)(p + ldsrc);
        const float s0 = ksc ? ksc[k0 + k] : 1.f, s1 = ksc ? ksc[k0 + k + 1] : 1.f;
#pragma unroll
        for (int j = 0; j < 4; ++j) scr[(4 * nq + j) * 33 + 4 * i + kk] = pk2(r0[j] * s0, r1[j] * s1); }
    asm volatile("s_waitcnt lgkmcnt(0)" ::: "memory");
#pragma unroll 8
    for (int i2 = 0; i2 < 32; ++i2) { const int n = 2 * i2 + (lane >> 5), d = lane & 31;
        ((unsigned*)(dst + (size_t)(drow0 + n) * ldd + k0))[d] = scr[n * 33 + d]; }
    asm volatile("s_waitcnt lgkmcnt(0)" ::: "memory");
}
__device__ __forceinline__ void glr_tile(const float* win, const float* wg, const float* g, int k0, int n0, bf16* dst, int drow0, int lane) {
    float w[16];
#pragma unroll
    for (int r = 0; r < 16; ++r) w[r] = wg[r * 256 + n0 + lane];
    unsigned* drow = (unsigned*)(dst + (size_t)(drow0 + n0 + lane) * 1024 + k0);
    for (int kp = 0; kp < 32; ++kp) { float v[2];
#pragma unroll
        for (int q = 0; q < 2; ++q) { const int k = k0 + 2 * kp + q; const float* s = win + (size_t)k * INC + 2304; float a = 0.f;
#pragma unroll
            for (int r = 0; r < 16; ++r) a += s[r] * w[r];
            v[q] = a * g[k]; }
        drow[kp] = pk2(v[0], v[1]); }
}
__device__ __forceinline__ int rel_bucket(int d) {
    if (d < 16) return d;
    const float lr = logf((float)d / 16.0f) / logf(128.0f);
    int b = 16 + (int)(lr * 16.0f); return b < 31 ? b : 31;
}


typedef short bf16x8 __attribute__((ext_vector_type(8)));
typedef short v4i16_t __attribute__((ext_vector_type(4)));
#define MFMA16(a, b, c) __builtin_amdgcn_mfma_f32_16x16x32_bf16((a), (b), (c), 0, 0, 0)
__device__ __forceinline__ v4i16_t tr16(LAS unsigned char* p) { return __builtin_amdgcn_ds_read_tr16_b64_v4i16((LAS v4i16_t*)p); }
__device__ __forceinline__ bf16x8 cat8(v4i16_t lo, v4i16_t hi) { return __builtin_shufflevector(lo, hi, 0, 1, 2, 3, 4, 5, 6, 7); }
__device__ __forceinline__ bf16x8 frag_rm(LAS unsigned char* base, int pitch, int c0, int k0, int lane) { return *(LAS bf16x8*)(base + (c0 + (lane & 15)) * pitch + (k0 + 8 * (lane >> 4)) * 2); }
__device__ __forceinline__ bf16x8 frag_tr(LAS unsigned char* base, int pitch, int c0, int k0, int lane) {
    const int i = lane & 15, g = lane >> 4; LAS unsigned char* p = base + (k0 + 8 * g + (i >> 2)) * pitch + (c0 + 4 * (i & 3)) * 2;
    return cat8(tr16(p), tr16(p + 4 * pitch)); }
__device__ __forceinline__ bf16x8 frag_trp(LAS unsigned char* base, int pitch, int c0, int k0, int lane) {
    const int i = lane & 15, g = lane >> 4; LAS unsigned char* p = base + (k0 + 4 * g + (i >> 2)) * pitch + (c0 + 4 * (i & 3)) * 2;
    return cat8(tr16(p), tr16(p + 16 * pitch)); }
__device__ __forceinline__ bf16x8 pack8(const f32x4& a, const f32x4& b) {
    v4u w; w.x = pg8::cvt_pk_bf16(a[0], a[1]); w.y = pg8::cvt_pk_bf16(a[2], a[3]); w.z = pg8::cvt_pk_bf16(b[0], b[1]); w.w = pg8::cvt_pk_bf16(b[2], b[3]); return __builtin_bit_cast(bf16x8, w); }

struct Ctx { Args args; int tid, lane, wave, G, bx, gw, NGW, lo, hi; XcdBarrier bar; };
#define GRID_BAR() do { if (MK_N_LAUNCHES == 1) xcd_barrier(bar); } while (0)
#define IN(k) (lo <= (k) && (k) < hi)
#define SEAM(k) do { if (IN(k) && IN((k) + 1)) GRID_BAR(); } while (0)
#define WS_PTRS \
    float* SS = (float*)(ws + WS_SS); float* BL = (float*)(ws + WS_BL); float* DEC = (float*)(ws + WS_DEC); \
    bf16* XB = (bf16*)(ws + WS_XB); bf16* U = (bf16*)(ws + WS_U); bf16* MIX = (bf16*)(ws + WS_MIX); float* CST = (float*)(ws + WS_CST); \
    bf16* H = (bf16*)(ws + WS_H); bf16* W13 = (bf16*)(ws + WS_W13); bf16* W2 = (bf16*)(ws + WS_W2); \
    bf16* WE13 = (bf16*)(ws + WS_WE13); bf16* WE2 = (bf16*)(ws + WS_WE2); bf16* XS = (bf16*)(ws + WS_XS); bf16* HE = (bf16*)(ws + WS_HE); bf16* Y = (bf16*)(ws + WS_Y); \
    int* TOPI = (int*)(ws + WS_TOPI); float* TOPW = (float*)(ws + WS_TOPW); int* POS = (int*)(ws + WS_POS); float* RS3 = (float*)(ws + WS_RS3); \
    int* CNT = (int*)(ws + WS_CNT); int* PANE = (int*)(ws + WS_PANE); float* ROWGATE = (float*)(ws + WS_ROWGATE); float* ROWRS = (float*)(ws + WS_ROWRS); \
    float* X = args.out; \
    (void)SS; (void)BL; (void)DEC; (void)XB; (void)U; (void)MIX; (void)CST; (void)H; (void)W13; (void)W2; (void)WE13; (void)WE2; (void)XS; (void)HE; (void)Y; \
    (void)TOPI; (void)TOPW; (void)POS; (void)RS3; (void)CNT; (void)PANE; (void)ROWGATE; (void)ROWRS; (void)X;

template <int layer> __device__ __forceinline__ void layer_phases(const Ctx& c, unsigned char* lds) {
    const Args& args = c.args; LAS unsigned char* ldsl = (LAS unsigned char*)lds;
    const int tid = c.tid, lane = c.lane, wave = c.wave, G = c.G, bx = c.bx, gw = c.gw, NGW = c.NGW, lo = c.lo, hi = c.hi; const XcdBarrier bar = c.bar;
    unsigned char* ws = args.ws;
    WS_PTRS
    (void)tid; (void)lane; (void)wave; (void)gw; (void)NGW;
    const bool dry = (args.pad & 1) != 0, noepi = (args.pad & 2) != 0;
    bf16* XBD = dry ? (bf16*)(ws + WS_XS) : XB; float* SSD = dry ? (float*)(ws + WS_XS) : SS; (void)XBD; (void)SSD;
        const int pb = 1 + 16 * layer;
        if (IN(pb + 0)) {
            pg8::Gemm g{XB, (const bf16*)(ws + WS_WIN) + (size_t)layer * NU * D, M, NU, D, D}; pg8::StaticOrder S; S.init(M, NU, G, bx);
            pg8::EpiU E{U, NU, SS, QS_ATT};
            pg8::gemm_phase<pg8::EpiU, pg8::StaticOrder, true, true>(ldsl, g, S, E, noepi);
            { const bf16* wg = (const bf16*)(ws + WS_WGLR) + (size_t)layer * 16 * D; float* GLR = (float*)(ws + WS_GLR); f32x4* xch = (f32x4*)lds;
              for (int blk = bx; blk < 256; blk += G) {
                  const int rt = wave & 3, kh = wave >> 2, ql = lane & 15, g4 = lane >> 4;
                  const bf16* ap = XB + (size_t)(blk * 64 + rt * 16 + ql) * D + kh * 512 + 8 * g4; const bf16* bp = wg + (size_t)ql * D + kh * 512 + 8 * g4;
                  f32x4 acc = (f32x4){0.f, 0.f, 0.f, 0.f};
#pragma unroll
                  for (int ks = 0; ks < 16; ++ks) acc = MFMA16(*(const bf16x8*)(ap + 32 * ks), *(const bf16x8*)(bp + 32 * ks), acc);
                  if (kh == 1) xch[rt * 64 + lane] = acc;
                  __syncthreads();
                  if (kh == 0) { acc += xch[rt * 64 + lane];
#pragma unroll
                      for (int rg = 0; rg < 4; ++rg) { const int row = blk * 64 + rt * 16 + 4 * g4 + rg; GLR[(size_t)row * 16 + ql] = acc[rg] * pg8::rstd_of(SS + (size_t)row * 16); } }
                  __syncthreads();
              } }
        }
        SEAM(pb + 0);
        if (IN(pb + 1)) {
            const int tid = pg8::tid_here(), lane = tid & 63; (void)lane;
            float* cum = (float*)lds; float* seg = cum + 4096;
            LAS unsigned char* kdl = ldsl + 18432;
            LAS unsigned char* vvl = ldsl + 27648;
            for (int u = bx; u < 1024; u += G) {
                const int h = u & 3, n = (u >> 2) & 31, b = u >> 7; const size_t row0 = (size_t)b * SEQ + n * 64;
                const int tr = tid >> 3, c8 = tid & 7;
                const v4u kraw = *(const v4u*)(U + (row0 + tr) * NU + UGK + h * 64 + 8 * c8);
                const v4u* vp = (const v4u*)(U + (row0 + tr) * NU + UGV + h * 128 + c8 * 16); const v4u x0 = vp[0], x1 = vp[1];
                { float c = 0.f; float wgc[16]; const float* wgp = args.gla_w_gate + layer * 16 * 256 + h * 64 + lane; const float bgv = args.gla_b_gate[layer * 256 + h * 64 + lane];
#pragma unroll
                  for (int r = 0; r < 16; ++r) wgc[r] = wgp[r * 256];
                  const float* GLR = (const float*)(ws + WS_GLR);
#pragma unroll
                  for (int i = 0; i < 8; ++i) { const int t = 8 * wave + i; const f32x4* gp = (const f32x4*)(GLR + (row0 + t) * 16); float z = bgv;
#pragma unroll
                      for (int q4 = 0; q4 < 4; ++q4) { const f32x4 gv = gp[q4]; z += gv[0] * wgc[4 * q4] + gv[1] * wgc[4 * q4 + 1] + gv[2] * wgc[4 * q4 + 2] + gv[3] * wgc[4 * q4 + 3]; }
                      c += pg8::logsig16(z); cum[t * 64 + lane] = c; }
                  seg[wave * 64 + lane] = c; }
                __syncthreads();
                { f32x4 offa = (f32x4){0.f, 0.f, 0.f, 0.f}, offb = offa, lasta = offa, lastb = offa; const int wq = tr >> 3;
#pragma unroll
                  for (int w = 0; w < 8; ++w) { const f32x4 sa = *(const f32x4*)(seg + w * 64 + 8 * c8), sb = *(const f32x4*)(seg + w * 64 + 8 * c8 + 4); lasta += sa; lastb += sb; if (w < wq) { offa += sa; offb += sb; } }
                  const f32x4 ca = *(const f32x4*)(cum + tr * 64 + 8 * c8) + offa, cb = *(const f32x4*)(cum + tr * 64 + 8 * c8 + 4) + offb;
                  v4u w; w.x = pk2(bflo(kraw.x) * __expf(lasta[0] - ca[0]), bfhi(kraw.x) * __expf(lasta[1] - ca[1])); w.y = pk2(bflo(kraw.y) * __expf(lasta[2] - ca[2]), bfhi(kraw.y) * __expf(lasta[3] - ca[3]));
                  w.z = pk2(bflo(kraw.z) * __expf(lastb[0] - cb[0]), bfhi(kraw.z) * __expf(lastb[1] - cb[1])); w.w = pk2(bflo(kraw.w) * __expf(lastb[2] - cb[2]), bfhi(kraw.w) * __expf(lastb[3] - cb[3]));
                  *(LAS v4u*)(kdl + tr * 144 + c8 * 16) = w;
                  if (tr == 0) {
#pragma unroll
                      for (int j = 0; j < 4; ++j) { __hip_atomic_store(DEC + u * 64 + 8 * c8 + j, __expf(lasta[j]), __ATOMIC_RELAXED, __HIP_MEMORY_SCOPE_AGENT); __hip_atomic_store(DEC + u * 64 + 8 * c8 + 4 + j, __expf(lastb[j]), __ATOMIC_RELAXED, __HIP_MEMORY_SCOPE_AGENT); } }
                  LAS v4u* vd = (LAS v4u*)(vvl + tr * 272 + c8 * 32); vd[0] = x0; vd[1] = x1; }
                __syncthreads();
                { f32x4 acc[4];
#pragma unroll
                  for (int kt = 0; kt < 4; ++kt) acc[kt] = (f32x4){0.f, 0.f, 0.f, 0.f};
#pragma unroll
                  for (int ks = 0; ks < 2; ++ks) { const bf16x8 bv = frag_tr(vvl, 272, 16 * wave, 32 * ks, lane);
#pragma unroll
                      for (int kt = 0; kt < 4; ++kt) { const bf16x8 ak = frag_tr(kdl, 144, 16 * kt, 32 * ks, lane); acc[kt] = MFMA16(ak, bv, acc[kt]); } }
                  const int g4 = lane >> 4, ql = lane & 15;
                  const __amdgpu_buffer_rsrc_t rsrc = __builtin_amdgcn_make_buffer_rsrc((void*)CST, 0, 32 * 1024 * 1024, 0x00020000);
#pragma unroll
                  for (int kt = 0; kt < 4; ++kt)
                      __builtin_amdgcn_raw_buffer_store_b128(__builtin_bit_cast(v4u, acc[kt]), rsrc, (int)((((unsigned)u * 128u + 16u * wave + ql) * 64u + 16u * kt + 4u * g4) * 4u), 0, 16); }
                asm volatile("s_waitcnt vmcnt(0)" ::: "memory");
                __syncthreads();
                if (tid == 0) __hip_atomic_fetch_add((unsigned*)(ws + WS_CTL) + CW_SC + ((u >> 7) * 4 + (u & 3)) * 64, 1u, __ATOMIC_RELAXED, __HIP_MEMORY_SCOPE_AGENT);
            }
            const float* cw = args.conv_w + layer * 3 * 256;
            for (int it = bx * NTHR + tid; it < M * 32; it += G * NTHR) {
                const int row = it >> 5, c0 = (it & 31) * 8, t = row & (SEQ - 1);
                const bf16* ur = U + (size_t)row * NU;
                const v4u cb = *(const v4u*)(ur + UCB + c0);
                v4u ci[3], cc[3];
#pragma unroll
                for (int d = 0; d < 3; ++d) { if (t >= d) { ci[d] = *(const v4u*)(ur - (size_t)d * NU + UCI + c0); cc[d] = *(const v4u*)(ur - (size_t)d * NU + UCC + c0); } else { ci[d] = (v4u){0u, 0u, 0u, 0u}; cc[d] = ci[d]; } }
                float o[8];
#pragma unroll
                for (int j = 0; j < 4; ++j) {
                    float a0 = 0.f, a1 = 0.f;
#pragma unroll
                    for (int d = 0; d < 3; ++d) { const float w0 = cw[(2 - d) * 256 + c0 + 2 * j], w1 = cw[(2 - d) * 256 + c0 + 2 * j + 1];
                        a0 += w0 * (bflo(cc[d][j]) * bflo(ci[d][j])); a1 += w1 * (bfhi(cc[d][j]) * bfhi(ci[d][j])); }
                    o[2 * j] = bflo(cb[j]) * a0; o[2 * j + 1] = bfhi(cb[j]) * a1; }
                v4u w; w.x = pk2(o[0], o[1]); w.y = pk2(o[2], o[3]); w.z = pk2(o[4], o[5]); w.w = pk2(o[6], o[7]);
                *(v4u*)(MIX + (size_t)row * D + 768 + c0) = w;
            }
            __syncthreads();
            {
                float* BLl = (float*)lds;
                for (int i = tid; i < 4 * 2049; i += NTHR) BLl[(i & 3) * 2049 + (i >> 2)] = BL[i];
                __syncthreads();
                LAS unsigned char* vst = ldsl + 33280 + wave * 5120;
                const int ql = lane & 15, g4 = lane >> 4;
                for (int uu = bx; uu < 512; uu += G) {
                    int u = uu; if (G == 256) { const int j = (uu & 255) >> 3; u = ((((uu >> 8) * 16 + (uu & 7) * 2 + (j >> 4)) << 4) | (j & 15)); }
                    const int c = u & 15, h = (u >> 4) & 3, b = u >> 6; const int i0 = 16 * (((uu / G) & 1) ? 7 - wave : wave); const size_t rowb = (size_t)b * SEQ;
                    const int tq = c + 16 * (i0 + ql);
                    const bf16* ub = U + rowb * NU + h * 64;
                    const bf16x8 qf0 = *(const bf16x8*)(ub + (size_t)tq * NU + UQ + 8 * g4), qf1 = *(const bf16x8*)(ub + (size_t)tq * NU + UQ + 8 * g4 + 32);
                    const float* blh = BLl + h * 2049;
                    const int t0 = c + 16 * i0, t1 = t0 + 240;
                    const int base0 = ((t0 >> 4) - 128) & ~31, mhi0 = t1 >> 4, np0 = ((mhi0 - base0) >> 5) + 1, pz0 = base0 < 0 ? ((-base0) >> 5) : 0;
                    const int base1 = ((t0 >> 2) - 128) & ~31, mhi1 = t1 >> 2, np1 = ((mhi1 - base1) >> 5) + 1, pz1 = base1 < 0 ? ((-base1) >> 5) : 0;
                    const int base2 = (t0 - 128) & ~31, mhi2 = t1, np2 = ((mhi2 - base2) >> 5) + 1, pz2 = base2 < 0 ? ((-base2) >> 5) : 0;
                    const int n0 = np0 - pz0, n1 = np1 - pz1, n2 = np2 - pz2, NT = n0 + n1 + n2;
                    bf16x8 kc[2][2], kn[2][2]; v4u vc[4], vn[4];
#define ATT_ITEM(it, LR, MB, MHI, RHO) do { if ((it) < n0) { LR = 4; MB = base0 + 32 * (np0 - 1 - (it)); MHI = mhi0; RHO = c; } \
                        else if ((it) < n0 + n1) { LR = 2; MB = base1 + 32 * (pz1 + (it) - n0); MHI = mhi1; RHO = c & 3; } \
                        else { LR = 0; MB = base2 + 32 * (pz2 + (it) - n0 - n1); MHI = mhi2; RHO = 0; } } while (0)
#define ATT_LOAD(K_, V_, LR, MB, MHI, RHO) do { _Pragma("unroll") for (int tau = 0; tau < 2; ++tau) { int mk = (MB) + 16 * tau + ql; mk = mk < 0 ? 0 : (mk > (MHI) ? (MHI) : mk); \
                            const bf16* kp = ub + (size_t)((mk << (LR)) + (RHO)) * NU + UK + 8 * g4; K_[tau][0] = *(const bf16x8*)kp; K_[tau][1] = *(const bf16x8*)(kp + 32); } \
                        _Pragma("unroll") for (int j = 0; j < 4; ++j) { int mv = (MB) + (lane >> 3) + 8 * j; mv = mv < 0 ? 0 : (mv > (MHI) ? (MHI) : mv); \
                            V_[j] = *(const v4u*)(ub + (size_t)((mv << (LR)) + (RHO)) * NU + UV + 8 * (lane & 7)); } } while (0)
                    int lr, mb, mhi, rho; ATT_ITEM(0, lr, mb, mhi, rho); ATT_LOAD(kc, vc, lr, mb, mhi, rho);
                    float m_ref = -INFINITY, l_run = 0.f; f32x4 o[4];
#pragma unroll
                    for (int d = 0; d < 4; ++d) o[d] = (f32x4){0.f, 0.f, 0.f, 0.f};
                    for (int it = 0; it < NT; ++it) {
                        int lrn = lr, mbn = mb, mhin = mhi, rhon = rho;
                        if (it + 1 < NT) { ATT_ITEM(it + 1, lrn, mbn, mhin, rhon); ATT_LOAD(kn, vn, lrn, mbn, mhin, rhon); }
                        { LAS unsigned char* vd = vst + (lane >> 3) * 160 + (lane & 7) * 16;
#pragma unroll
                          for (int j = 0; j < 4; ++j) *(LAS v4u*)(vd + j * 8 * 160) = vc[j]; }
                        f32x4 s[2];
#pragma unroll
                        for (int tau = 0; tau < 2; ++tau) { s[tau] = MFMA16(kc[tau][0], qf0, ((f32x4){0.f, 0.f, 0.f, 0.f})); s[tau] = MFMA16(kc[tau][1], qf1, s[tau]); }
                        const int d0 = (tq >> lr) - mb - 4 * g4, k0 = mb + 4 * g4; float tmax = -INFINITY;
#pragma unroll
                        for (int tau = 0; tau < 2; ++tau)
#pragma unroll
                            for (int rg = 0; rg < 4; ++rg) { const int dist = d0 - (16 * tau + rg); const bool ok = ((unsigned)dist <= 128u) && (k0 + 16 * tau + rg >= 0);
                                const float bias = blh[ok ? (dist << lr) : 0]; const float v = ok ? s[tau][rg] + bias : -INFINITY; s[tau][rg] = v; tmax = fmaxf(tmax, v); }
                        if (__any(tmax > m_ref + 16.0f)) {
                            float tm = fmaxf(tmax, __shfl_xor(tmax, 16)); tm = fmaxf(tm, __shfl_xor(tm, 32));
                            const float mn = fmaxf(m_ref, tm); const float ms = (mn == -INFINITY) ? 0.f : mn; const float alpha = __builtin_amdgcn_exp2f(m_ref - ms); m_ref = ms;
                            l_run *= alpha;
#pragma unroll
                            for (int d = 0; d < 4; ++d) o[d] = o[d] * alpha;
                        }
                        float ps = 0.f;
#pragma unroll
                        for (int tau = 0; tau < 2; ++tau)
#pragma unroll
                            for (int rg = 0; rg < 4; ++rg) { const float p = __builtin_amdgcn_exp2f(s[tau][rg] - m_ref); s[tau][rg] = p; ps += p; }
                        l_run += ps;
                        const bf16x8 pb = pack8(s[0], s[1]);
                        asm volatile("" ::: "memory");
#pragma unroll
                        for (int d = 0; d < 4; ++d) { const bf16x8 va = frag_trp(vst, 160, 16 * d, 0, lane); o[d] = MFMA16(va, pb, o[d]); }
                        asm volatile("" ::: "memory");
#pragma unroll
                        for (int tau = 0; tau < 2; ++tau) { kc[tau][0] = kn[tau][0]; kc[tau][1] = kn[tau][1]; }
#pragma unroll
                        for (int j = 0; j < 4; ++j) vc[j] = vn[j];
                        lr = lrn; mb = mbn; mhi = mhin; rho = rhon;
                    }
#undef ATT_ITEM
#undef ATT_LOAD
                    l_run += __shfl_xor(l_run, 16); l_run += __shfl_xor(l_run, 32); const float inv = 1.0f / l_run;
                    bf16* op = MIX + (rowb + tq) * D + h * 64 + 4 * g4;
#pragma unroll
                    for (int d = 0; d < 4; ++d) { pg8::u32x2 w; w.x = pg8::cvt_pk_bf16(o[d][0] * inv, o[d][1] * inv); w.y = pg8::cvt_pk_bf16(o[d][2] * inv, o[d][3] * inv); *(pg8::u32x2*)(op + 16 * d) = w; }
                }
            }
            for (int u = bx; u < 1024; u += G) {
                const int h = u & 3, n = (u >> 2) & 31, b = u >> 7;
                unsigned* cw = (unsigned*)(ws + WS_CTL) + CW_SC + (b * 4 + h) * 64; unsigned* tmo = (unsigned*)(ws + WS_CTL) + CW_TMO2; const unsigned need = 32u * (unsigned)(layer + 1);
                if (wave == 0) { unsigned sp = 0; while (__hip_atomic_load(cw, __ATOMIC_RELAXED, __HIP_MEMORY_SCOPE_AGENT) < need) { __builtin_amdgcn_s_sleep(2);
                        if ((++sp & 255u) == 0u) { if (__hip_atomic_load(tmo, __ATOMIC_RELAXED, __HIP_MEMORY_SCOPE_AGENT) != 0u) break; if (sp > (1u << 20)) { __hip_atomic_store(tmo, 1u, __ATOMIC_RELAXED, __HIP_MEMORY_SCOPE_AGENT); break; } } } }
                __syncthreads();
                if (tid < 256) { const int idx = n * 256 + tid; float cc[32], dd[32];
                    float* cp = CST + (size_t)(b * 128 + h) * 8192 + idx; const float* dp = DEC + (b * 128 + h) * 64 + (idx & 63);
#pragma unroll
                    for (int m2 = 0; m2 < 32; ++m2) { cc[m2] = __hip_atomic_load(cp + (size_t)m2 * 4 * 8192, __ATOMIC_RELAXED, __HIP_MEMORY_SCOPE_AGENT); dd[m2] = __hip_atomic_load(dp + m2 * 4 * 64, __ATOMIC_RELAXED, __HIP_MEMORY_SCOPE_AGENT); }
                    float S = 0.f;
#pragma unroll
                    for (int m2 = 0; m2 < 32; ++m2) { cp[(size_t)m2 * 4 * 8192] = S; S = dd[m2] * S + cc[m2]; } }
            }
        }
        SEAM(pb + 1);
        if (IN(pb + 3)) {
            const int tid = pg8::tid_here(), lane = tid & 63; (void)lane;
            float* cum = (float*)lds; float* seg = cum + 4096;
            LAS unsigned char* qel = ldsl + 18432;
            LAS unsigned char* kel = ldsl + 27648;
            LAS unsigned char* vvl = ldsl + 36864;
            LAS unsigned char* stl = ldsl + 54272;
            float* rsq = (float*)(lds + 72704);
            const float* gn = args.gla_g_norm + layer * 128;
            for (int u = bx; u < 1024; u += G) {
                const int h = u & 3, n = (u >> 2) & 31, b = u >> 7; const size_t row0 = (size_t)b * SEQ + n * 64;
                const int tr = tid >> 3, c8 = tid & 7;
                const v4u qraw = *(const v4u*)(U + (row0 + tr) * NU + UGQ + h * 64 + 8 * c8), kraw = *(const v4u*)(U + (row0 + tr) * NU + UGK + h * 64 + 8 * c8);
                const v4u* vp = (const v4u*)(U + (row0 + tr) * NU + UGV + h * 128 + c8 * 16); const v4u x0 = vp[0], x1 = vp[1];
                const int sv = tid >> 2, skq = (tid & 3) * 16; const f32x4* sp = (const f32x4*)(CST + ((size_t)u * 128 + sv) * 64 + skq);
                const f32x4 a0 = sp[0], a1 = sp[1], a2 = sp[2], a3 = sp[3];
                { float c = 0.f; float wgc[16]; const float* wgp = args.gla_w_gate + layer * 16 * 256 + h * 64 + lane; const float bgv = args.gla_b_gate[layer * 256 + h * 64 + lane];
#pragma unroll
                  for (int r = 0; r < 16; ++r) wgc[r] = wgp[r * 256];
                  const float* GLR = (const float*)(ws + WS_GLR);
#pragma unroll
                  for (int i = 0; i < 8; ++i) { const int t = 8 * wave + i; const f32x4* gp = (const f32x4*)(GLR + (row0 + t) * 16); float z = bgv;
#pragma unroll
                      for (int q4 = 0; q4 < 4; ++q4) { const f32x4 gv = gp[q4]; z += gv[0] * wgc[4 * q4] + gv[1] * wgc[4 * q4 + 1] + gv[2] * wgc[4 * q4 + 2] + gv[3] * wgc[4 * q4 + 3]; }
                      c += pg8::logsig16(z); cum[t * 64 + lane] = c; }
                  seg[wave * 64 + lane] = c; }
                __syncthreads();
                { f32x4 offa = (f32x4){0.f, 0.f, 0.f, 0.f}, offb = offa; const int wq = tr >> 3;
#pragma unroll
                  for (int w = 0; w < 7; ++w) { if (w < wq) { offa += *(const f32x4*)(seg + w * 64 + 8 * c8); offb += *(const f32x4*)(seg + w * 64 + 8 * c8 + 4); } }
                  const f32x4 ca = *(const f32x4*)(cum + tr * 64 + 8 * c8) + offa, cb = *(const f32x4*)(cum + tr * 64 + 8 * c8 + 4) + offb;
                  float ea[8];
#pragma unroll
                  for (int j = 0; j < 4; ++j) { ea[j] = __expf(ca[j]); ea[4 + j] = __expf(cb[j]); }
                  v4u wq_, wk_;
                  wq_.x = pk2(bflo(qraw.x) * ea[0], bfhi(qraw.x) * ea[1]); wq_.y = pk2(bflo(qraw.y) * ea[2], bfhi(qraw.y) * ea[3]); wq_.z = pk2(bflo(qraw.z) * ea[4], bfhi(qraw.z) * ea[5]); wq_.w = pk2(bflo(qraw.w) * ea[6], bfhi(qraw.w) * ea[7]);
                  wk_.x = pk2(bflo(kraw.x) / ea[0], bfhi(kraw.x) / ea[1]); wk_.y = pk2(bflo(kraw.y) / ea[2], bfhi(kraw.y) / ea[3]); wk_.z = pk2(bflo(kraw.z) / ea[4], bfhi(kraw.z) / ea[5]); wk_.w = pk2(bflo(kraw.w) / ea[6], bfhi(kraw.w) / ea[7]);
                  *(LAS v4u*)(qel + tr * 144 + c8 * 16) = wq_; *(LAS v4u*)(kel + tr * 144 + c8 * 16) = wk_;
                  LAS v4u* vd = (LAS v4u*)(vvl + tr * 272 + c8 * 32); vd[0] = x0; vd[1] = x1;
                  v4u w0, w1; w0.x = pk2(a0[0], a0[1]); w0.y = pk2(a0[2], a0[3]); w0.z = pk2(a1[0], a1[1]); w0.w = pk2(a1[2], a1[3]);
                  w1.x = pk2(a2[0], a2[1]); w1.y = pk2(a2[2], a2[3]); w1.z = pk2(a3[0], a3[1]); w1.w = pk2(a3[2], a3[3]);
                  LAS v4u* sd = (LAS v4u*)(stl + sv * 144 + skq * 2); sd[0] = w0; sd[1] = w1; }
                __syncthreads();
                { const int tt = wave & 3, vh = wave >> 2, ql = lane & 15, g4 = lane >> 4; const int t = 16 * tt + ql;
                  const bf16x8 qb0 = frag_rm(qel, 144, 16 * tt, 0, lane), qb1 = frag_rm(qel, 144, 16 * tt, 32, lane);
                  f32x4 sT[4];
#pragma unroll
                  for (int st = 0; st < 4; ++st) { sT[st] = (f32x4){0.f, 0.f, 0.f, 0.f};
                      if (st <= tt) { sT[st] = MFMA16(frag_rm(kel, 144, 16 * st, 0, lane), qb0, sT[st]); sT[st] = MFMA16(frag_rm(kel, 144, 16 * st, 32, lane), qb1, sT[st]);
#pragma unroll
                          for (int rg = 0; rg < 4; ++rg) if (16 * st + 4 * g4 + rg > t) sT[st][rg] = 0.f; } }
                  const bf16x8 pb0 = pack8(sT[0], sT[1]), pb1 = pack8(sT[2], sT[3]);
                  f32x4 acc[4]; float ss = 0.f;
#pragma unroll
                  for (int vt = 0; vt < 4; ++vt) { const int V0 = 16 * (4 * vh + vt); f32x4 a = (f32x4){0.f, 0.f, 0.f, 0.f};
                      a = MFMA16(frag_trp(vvl, 272, V0, 0, lane), pb0, a); a = MFMA16(frag_trp(vvl, 272, V0, 32, lane), pb1, a);
                      a = MFMA16(frag_rm(stl, 144, V0, 0, lane), qb0, a); a = MFMA16(frag_rm(stl, 144, V0, 32, lane), qb1, a);
                      acc[vt] = a; ss += (a[0] * a[0] + a[1] * a[1]) + (a[2] * a[2] + a[3] * a[3]); }
                  ss += __shfl_xor(ss, 16); ss += __shfl_xor(ss, 32);
                  if (g4 == 0) rsq[(tt * 2 + vh) * 16 + ql] = ss;
                  __syncthreads();
                  const float rs = 1.0f / sqrtf((rsq[(tt * 2) * 16 + ql] + rsq[(tt * 2 + 1) * 16 + ql]) * (1.0f / 128.0f) + pg8::RMS_EPS);
#pragma unroll
                  for (int vt = 0; vt < 4; ++vt) { const int v0 = 16 * (4 * vh + vt) + 4 * g4;
                      const pg8::u32x2 gr = *(const pg8::u32x2*)(U + (row0 + t) * NU + UGR + h * 128 + v0); const f32x4 gv = *(const f32x4*)(gn + v0);
                      const float o0 = acc[vt][0] * rs * gv[0] * pg8::silu_f(bflo(gr.x)), o1 = acc[vt][1] * rs * gv[1] * pg8::silu_f(bfhi(gr.x));
                      const float o2 = acc[vt][2] * rs * gv[2] * pg8::silu_f(bflo(gr.y)), o3 = acc[vt][3] * rs * gv[3] * pg8::silu_f(bfhi(gr.y));
                      pg8::u32x2 w; w.x = pg8::cvt_pk_bf16(o0, o1); w.y = pg8::cvt_pk_bf16(o2, o3);
                      *(pg8::u32x2*)(MIX + (row0 + t) * D + 256 + h * 128 + v0) = w; } }
                __syncthreads();
            }
        }
        SEAM(pb + 3);
        if (IN(pb + 4)) {
            pg8::Gemm g{MIX, (const bf16*)(ws + WS_WOUT) + (size_t)layer * D * D, M, D, D, D}; pg8::StaticOrder S; S.init(M, D, G, bx);
            if constexpr (layer == 0) { pg8::EpiRes<true> E{args.x, XBD, SSD}; pg8::gemm_phase<pg8::EpiRes<true>, pg8::StaticOrder, true, true>(ldsl, g, S, E, noepi); }
            else { pg8::EpiRes<false> E{XB, XBD, SSD}; pg8::gemm_phase<pg8::EpiRes<false>, pg8::StaticOrder, true, true>(ldsl, g, S, E, noepi); }
        }
        SEAM(pb + 4);
        if (layer == 0) {
            if (IN(pb + 5)) {
                pg8::Gemm g{XB, W13, M, 2 * FF, D, D}; pg8::StaticOrder S; S.init(M, 2 * FF, G, bx);
                pg8::EpiGlu<false> E{H, FF, SS};
                pg8::gemm_phase<pg8::EpiGlu<false>, pg8::StaticOrder, true, true>(ldsl, g, S, E, noepi);
            }
            SEAM(pb + 5);
            if (IN(pb + 6)) {
                pg8::Gemm g{H, W2, M, D, FF, FF}; pg8::StaticOrder S; S.init(M, D, G, bx);
#if defined(PROBE_EPI) && PROBE_EPI
                if (dry) { pg8::EpiRes<false, PROBE_EPI> E{XB, XBD, SSD}; pg8::gemm_phase<pg8::EpiRes<false, PROBE_EPI>, pg8::StaticOrder, true, true>(ldsl, g, S, E, noepi); } else
#endif
                { pg8::EpiRes<false> E{XB, XBD, SSD}; pg8::gemm_phase<pg8::EpiRes<false>, pg8::StaticOrder, true, true>(ldsl, g, S, E, noepi); }
            }
            SEAM(pb + 6);
        } else {
            if (IN(pb + 5)) {
                const int tid = pg8::tid_here(), lane = tid & 63; (void)lane;
                float* wr_l = (float*)lds;
                int* cnt_l = (int*)(lds + 32768);
                const float* gf = args.g_ffn + D;
                for (int i = tid; i < D * 8; i += NTHR) wr_l[(i & 7) * D + (i >> 3)] = args.moe_router[i] * gf[i >> 3];
                if (tid < 8) cnt_l[tid] = 0;
                __syncthreads();
                for (int blk = bx; blk < 256; blk += G) {
                    if (blk != bx) { __syncthreads(); if (tid < 8) cnt_l[tid] = 0; __syncthreads(); }
                    v4u xpre[8][2];
#pragma unroll
                    for (int i = 0; i < 8; ++i) { const v4u* xr = (const v4u*)(XB + (size_t)(blk * 64 + wave * 8 + i) * D) + lane; xpre[i][0] = xr[0]; xpre[i][1] = xr[64]; }
#pragma unroll
                    for (int i = 0; i < 8; ++i) { const int m = blk * 64 + wave * 8 + i; float lg[8];
#pragma unroll
                        for (int e = 0; e < 8; ++e) lg[e] = 0.f;
#pragma unroll
                        for (int j = 0; j < 2; ++j) { const v4u xw = xpre[i][j]; const int k0 = 8 * (lane + 64 * j);
                            const f32x4 va = (f32x4){bflo(xw.x), bfhi(xw.x), bflo(xw.y), bfhi(xw.y)}, vb = (f32x4){bflo(xw.z), bfhi(xw.z), bflo(xw.w), bfhi(xw.w)};
#pragma unroll
                            for (int e = 0; e < 8; ++e) { const f32x4 w0 = *(const f32x4*)(wr_l + e * D + k0), w1 = *(const f32x4*)(wr_l + e * D + k0 + 4);
                                lg[e] += ((va[0] * w0[0] + va[1] * w0[1]) + (va[2] * w0[2] + va[3] * w0[3])) + ((vb[0] * w1[0] + vb[1] * w1[1]) + (vb[2] * w1[2] + vb[3] * w1[3])); } }
                        const float rs = pg8::rstd_of(SS + (size_t)m * 16);
#pragma unroll
                        for (int e = 0; e < 8; ++e) lg[e] = wave_sum(lg[e]) * rs;
                        int i0 = 0; float v0 = lg[0];
#pragma unroll
                        for (int e = 1; e < 8; ++e) if (lg[e] > v0) { v0 = lg[e]; i0 = e; }
                        int i1 = -1; float v1 = -INFINITY;
#pragma unroll
                        for (int e = 0; e < 8; ++e) if (e != i0 && lg[e] > v1) { v1 = lg[e]; i1 = e; }
                        const float w1 = 1.0f / (1.0f + __expf(v0 - v1)), w0 = 1.0f - w1;
                        if (lane == 0) { TOPI[m * 2] = i0; TOPI[m * 2 + 1] = i1; TOPW[m * 2] = w0; TOPW[m * 2 + 1] = w1; RS3[m] = rs; atomicAdd(&cnt_l[i0], 1); atomicAdd(&cnt_l[i1], 1); } }
                    __syncthreads();
                    if (tid < 8) CNT[blk * 8 + tid] = cnt_l[tid];
                }
            }
            SEAM(pb + 5);
            if (IN(pb + 6)) {
                const int tid = pg8::tid_here(), lane = tid & 63; (void)lane;
                int* base_l = (int*)lds;
                int* pre_l = base_l + 8;
                int* tot_l = pre_l + 8;
                int* pos_l = tot_l + 8;
                int* ent_l = pos_l + 128;
                for (int blk = bx; blk < 256; blk += G) {
                    __syncthreads();
                    if (tid < 8) { tot_l[tid] = 0; pre_l[tid] = 0; }
                    if (tid < 128) ent_l[tid] = TOPI[blk * 128 + tid];
                    __syncthreads();
                    { const int g2 = tid >> 1, e0 = (tid & 1) * 4; const int4 c = *(const int4*)(CNT + g2 * 8 + e0);
                      atomicAdd(&tot_l[e0], c.x); atomicAdd(&tot_l[e0 + 1], c.y); atomicAdd(&tot_l[e0 + 2], c.z); atomicAdd(&tot_l[e0 + 3], c.w);
                      if (g2 < blk) { atomicAdd(&pre_l[e0], c.x); atomicAdd(&pre_l[e0 + 1], c.y); atomicAdd(&pre_l[e0 + 2], c.z); atomicAdd(&pre_l[e0 + 3], c.w); } }
                    __syncthreads();
                    if (tid == 0) { int bs = 0; for (int e = 0; e < 8; ++e) { base_l[e] = bs; bs += (tot_l[e] + 255) & ~255; } }
                    __syncthreads();
                    if (tid < 128) { const int e = ent_l[tid]; int rank = 0; for (int j = 0; j < tid; ++j) rank += (ent_l[j] == e) ? 1 : 0;
                        const int p = base_l[e] + pre_l[e] + rank; pos_l[tid] = p; POS[blk * 128 + tid] = p; ROWGATE[p] = TOPW[blk * 128 + tid]; ROWRS[p] = RS3[blk * 64 + (tid >> 1)]; }
                    if (blk == 0) {
                        for (int e = 0; e < 8; ++e) { const int npe = (tot_l[e] + 255) >> 8; for (int p = base_l[e] + tot_l[e] + tid; p < base_l[e] + npe * 256; p += NTHR) { ROWGATE[p] = 0.f; ROWRS[p] = 0.f; } }
                        if (tid == 0) { int np = 0; for (int e = 0; e < 8; ++e) { const int npe = (tot_l[e] + 255) >> 8; for (int j = 0; j < npe; ++j) PANE[np++] = e; } PANE[MAXPAN] = np; } }
                    __syncthreads();
                    for (int i = 0; i < 16; ++i) { const int sl = wave * 16 + i; const int m = blk * 64 + (sl >> 1); const int p = pos_l[sl];
                        const v4u* s = (const v4u*)(XB + (size_t)m * D) + lane; v4u* d = (v4u*)(XS + (size_t)p * D) + lane; d[0] = s[0]; d[64] = s[64]; }
                }
            }
            SEAM(pb + 6);
            if (IN(pb + 7)) {
                pg8::Gemm g{XS, WE13, MAXROWS, 2 * FE, D, D}; pg8::MoeOrder S{PANE, PANE[MAXPAN], 28, 4, G, bx};
                pg8::EpiGlu<true> E{HE, FE, ROWRS};
                pg8::gemm_phase<pg8::EpiGlu<true>, pg8::MoeOrder, true, true>(ldsl, g, S, E, noepi);
            }
            SEAM(pb + 7);
            if (IN(pb + 8)) {
                const int tid = pg8::tid_here(), lane = tid & 63; (void)lane;
                unsigned* scr = (unsigned*)(lds + wave * 8704);
                constexpr int T_J = 56 * 16;
                for (int it = gw; it < 8 * T_J; it += NGW) { const int e = it / T_J, r = it % T_J;
                    transpose_tile(args.moe_w2 + (size_t)e * FE * D, D, 64 * (r / 16), 64 * (r % 16), WE2 + (size_t)e * D * FE, FE, 64 * (r % 16), nullptr, scr, lane); }
            }
            SEAM(pb + 8);
            if (IN(pb + 9)) {
                const int npan = PANE[MAXPAN]; int npf = ((npan * 4) / G) * G / 4; if (npan - npf > 8 || npf == 0) npf = npan;
                { pg8::Gemm g{HE, WE2, MAXROWS, D, FE, FE}; pg8::MoeOrder S{PANE, npf, 4, 8, G, bx};
                  pg8::EpiMoeDown E{Y, ROWGATE};
                  pg8::gemm_phase<pg8::EpiMoeDown, pg8::MoeOrder, true, true>(ldsl, g, S, E, noepi); }
                if (npan > npf) { __syncthreads();
                  pg8::Gemm g{HE, WE2, MAXROWS, D, 896, FE}; pg8::MoeTailOrder S{PANE, npf, npan - npf, G, bx};
                  pg8::EpiMoeDownPart E{(float*)(ws + WS_YT), ROWGATE, npf * 256};
                  pg8::gemm_phase<pg8::EpiMoeDownPart, pg8::MoeTailOrder, true, true>(ldsl, g, S, E, noepi); }
            }
            SEAM(pb + 9);
            if (IN(pb + 10)) {
                const int tid = pg8::tid_here(), lane = tid & 63; (void)lane;
                const int npan_f = PANE[MAXPAN]; int npf_f = ((npan_f * 4) / G) * G / 4; if (npan_f - npf_f > 8 || npf_f == 0) npf_f = npan_f; const int tail0 = npf_f * 256;
                for (int m = gw; m < M; m += NGW) {
                    f32x4* xr = (f32x4*)(X + (size_t)m * D) + lane; const int p0 = POS[m * 2], p1 = POS[m * 2 + 1];
                    const unsigned long long* xb = (const unsigned long long*)(XB + (size_t)m * D) + lane;
                    f32x4 v[4]; float s = 0.f;
#pragma unroll
                    for (int j = 0; j < 4; ++j) { const unsigned long long xw = xb[64 * j]; v[j] = (f32x4){bflo((unsigned)xw), bfhi((unsigned)xw), bflo((unsigned)(xw >> 32)), bfhi((unsigned)(xw >> 32))}; }
#pragma unroll
                    for (int sl = 0; sl < 2; ++sl) { const int p = sl ? p1 : p0;
                        if (p < tail0) { const unsigned long long* yp = (const unsigned long long*)(Y + (size_t)p * D) + lane;
#pragma unroll
                            for (int j = 0; j < 4; ++j) { const unsigned long long a = yp[64 * j]; v[j] += (f32x4){bflo((unsigned)a), bfhi((unsigned)a), bflo((unsigned)(a >> 32)), bfhi((unsigned)(a >> 32))}; } }
                        else { const f32x4* tp = (const f32x4*)((const float*)(ws + WS_YT) + (size_t)(p - tail0) * D) + lane;
#pragma unroll
                            for (int kq = 0; kq < 4; ++kq)
#pragma unroll
                                for (int j = 0; j < 4; ++j) v[j] += tp[(size_t)kq * 2048 * (D / 4) + 64 * j]; } }
#pragma unroll
                    for (int j = 0; j < 4; ++j) s += (v[j][0] * v[j][0] + v[j][1] * v[j][1]) + (v[j][2] * v[j][2] + v[j][3] * v[j][3]);
                    const float rs = 1.0f / sqrtf(wave_sum(s) * (1.0f / D) + pg8::RMS_EPS);
                    const f32x4* gf = (const f32x4*)args.g_final + lane;
#pragma unroll
                    for (int j = 0; j < 4; ++j) (dry ? (f32x4*)((float*)(ws + WS_HE) + (size_t)m * D) + lane : xr)[64 * j] = v[j] * rs * gf[64 * j];
                }
            }
        }
}

__global__ void __launch_bounds__(NTHR, 2) hybrid_fwd(Args args) {
    extern __shared__ __attribute__((aligned(16))) unsigned char lds[];
    LAS unsigned char* ldsl = (LAS unsigned char*)lds;
    volatile LAS unsigned* MISC = (volatile LAS unsigned*)(ldsl + MISC_OFF);
    const int tid = threadIdx.x, lane = tid & 63, wave = __builtin_amdgcn_readfirstlane(tid >> 6);
    const int G = gridDim.x; const int bx = blockIdx.x;
    const int gw = bx * NWAVES + wave, NGW = G * NWAVES;
    unsigned char* ws = args.ws;
    for (int u = tid; u < (LDS_BYTES - LDSCTL_OFF) / 4; u += NTHR) ((LAS unsigned*)(ldsl + LDSCTL_OFF))[u] = 0u;
    __syncthreads();
    XcdBarrier bar; bar.bar = (unsigned*)(ws + WS_CTL) + CW_BAR + args.li * XCD_BAR_WORDS; bar.x = 0; bar.st = nullptr;
    if (MK_N_LAUNCHES == 1) bar = xcd_barrier_post((unsigned*)(ws + WS_CTL) + CW_BAR + args.li * XCD_BAR_WORDS, MISC + 8);
    const int lo = args.ph_lo, hi = args.ph_hi;

    WS_PTRS

    if (IN(0)) {
        unsigned* scr = (unsigned*)(lds + wave * 8704);
        constexpr int T_A = 16 * 36, T_B = 16 * 12, T_D = 16 * 16, T_L = T_A + T_B + T_D;
        constexpr int T_F = 16 * 44, T_G = 44 * 16, T_E = 16 * 56;
        constexpr int NT0 = 2 * T_L + 2 * T_F + T_G + 16 * T_E;
        for (int it = gw; it < NT0; it += NGW) {
            int r = it;
            if (r < 2 * T_L) { const int l = r / T_L; r -= l * T_L; const float* win = args.w_mix_in + (size_t)l * D * INC; const float* gm = args.g_mix + l * D;
                bf16* WIN = (bf16*)(ws + WS_WIN) + (size_t)l * NU * D;
                if (r < T_A) { transpose_tile(win, INC, 64 * (r / 36), 64 * (r % 36), WIN, D, 64 * (r % 36), gm, scr, lane); continue; } r -= T_A;
                if (r < T_B) { transpose_tile(win, INC, 64 * (r / 12), 2320 + 64 * (r % 12), WIN, D, 2304 + 64 * (r % 12), gm, scr, lane); continue; } r -= T_B;
                transpose_tile(args.w_mix_out + (size_t)l * D * D, D, 64 * (r / 16), 64 * (r % 16), (bf16*)(ws + WS_WOUT) + (size_t)l * D * D, D, 64 * (r % 16), nullptr, scr, lane); continue; }
            r -= 2 * T_L;
            if (r < 2 * T_F) { const int w3 = r / T_F; r -= w3 * T_F; const int n0 = 64 * (r % 44);
                transpose_tile(w3 ? args.ffn_w3 : args.ffn_w1, FF, 64 * (r / 44), n0, W13, D, (n0 >> 7) * 256 + (n0 & 127) + 128 * w3, args.g_ffn, scr, lane); continue; }
            r -= 2 * T_F;
            if (r < T_G) { transpose_tile(args.ffn_w2, D, 64 * (r / 16), 64 * (r % 16), W2, FF, 64 * (r % 16), nullptr, scr, lane); continue; }
            r -= T_G;
            { const int ew = r / T_E; r -= ew * T_E; const int e = ew >> 1, w3 = ew & 1; const int n0 = 64 * (r % 56);
              transpose_tile((w3 ? args.moe_w3 : args.moe_w1) + (size_t)e * D * FE, FE, 64 * (r / 56), n0, WE13 + (size_t)e * 2 * FE * D, D, (n0 >> 7) * 256 + (n0 & 127) + 128 * w3, args.g_ffn + D, scr, lane); }
        }
        for (int m = gw; m < M; m += NGW) {
            const f32x4* xr = (const f32x4*)(args.x + (size_t)m * D) + lane; float s = 0.f;
            unsigned long long* o8 = (unsigned long long*)(XB + (size_t)m * D) + lane;
#pragma unroll
            for (int j = 0; j < 4; ++j) { const f32x4 v = xr[64 * j]; s += (v[0] * v[0] + v[1] * v[1]) + (v[2] * v[2] + v[3] * v[3]);
                o8[64 * j] = (unsigned long long)pk2(v[0], v[1]) | ((unsigned long long)pk2(v[2], v[3]) << 32); }
            s = wave_sum(s);
            if (lane < 16) SS[(size_t)m * 16 + lane] = (lane == 0) ? s : 0.f;
        }
        for (int i = bx * NTHR + tid; i < 2049 * 4; i += G * NTHR) { const int d = i >> 2, h = i & 3; BL[i] = args.rel_bias[rel_bucket(d) * 4 + h] * LOG2E; }
        for (int i = bx * NTHR + tid; i < 2 * 16 * D; i += G * NTHR) { const int k = i & (D - 1), r = (i >> 10) & 15, l = i >> 14;
            ((bf16*)(ws + WS_WGLR))[i] = (bf16)f2bf(args.g_mix[l * D + k] * args.w_mix_in[((size_t)l * D + k) * INC + 2304 + r]); }
    }
    SEAM(0);

    Ctx c; c.args = args; c.tid = tid; c.lane = lane; c.wave = wave; c.G = G; c.bx = bx; c.gw = gw; c.NGW = NGW; c.lo = lo; c.hi = hi; c.bar = bar;
    layer_phases<0>(c, lds);
    layer_phases<1>(c, lds);
}
#undef IN
#undef SEAM
#undef GRID_BAR


extern "C" void kernel_launch(void* const* d_in, const int* in_sizes, int n_in, void* d_out, int out_size, void* d_ws, size_t ws_size, hipStream_t stream) {
    static int grid = 0;
    if (grid == 0) {
        if (n_in != 18 || in_sizes[0] != M * D || out_size != M * D || ws_size < WS_END) { fprintf(stderr, "kernel_launch: unexpected shapes / workspace (%zu < %zu)\n", ws_size, (size_t)WS_END); grid = -1; return; }
        int dev = 0, cus = 0, per_cu = 0;
        if (hipGetDevice(&dev) != hipSuccess || hipDeviceGetAttribute(&cus, hipDeviceAttributeMultiprocessorCount, dev) != hipSuccess) { grid = -1; return; }
        if (hipFuncSetAttribute((const void*)hybrid_fwd, hipFuncAttributeMaxDynamicSharedMemorySize, LDS_BYTES) != hipSuccess) { fprintf(stderr, "kernel_launch: hipFuncSetAttribute failed\n"); grid = -1; return; }
        if (hipOccupancyMaxActiveBlocksPerMultiprocessor(&per_cu, (const void*)hybrid_fwd, NTHR, LDS_BYTES) != hipSuccess || per_cu < 1) { fprintf(stderr, "kernel_launch: occupancy query says %d\n", per_cu); }
        (void)hipGetLastError();
        grid = cus;
    }
    if (grid < 0) return;
    if (hipMemsetAsync((char*)d_ws + WS_CTL, 0, CTL_ZERO_BYTES, stream) != hipSuccess) return;
    Args a{};
    const float** f = (const float**)&a;
    for (int i = 0; i < 18; ++i) f[i] = (const float*)d_in[i];
    a.out = (float*)d_out; a.ws = (unsigned char*)d_ws;
    if (MK_N_LAUNCHES == 1) {
#ifndef PROBE_MODE
#define PROBE_MODE 0
#endif
#ifdef PROBE_PHASE
        const int cuts[4][2] = {{0, PROBE_PHASE + 1}, {PROBE_PHASE, PROBE_PHASE + 1}, {PROBE_PHASE + 1, 64}, {0, 0}};
        for (int li = 0; li < 3; ++li) { a.ph_lo = cuts[li][0]; a.ph_hi = cuts[li][1]; a.li = li; a.pad = (li == 1) ? PROBE_MODE : 0; hipLaunchKernelGGL(hybrid_fwd, dim3(grid), dim3(NTHR), LDS_BYTES, stream, a); }
#else
        a.ph_lo = 0; a.ph_hi = 64; a.li = 0; hipLaunchKernelGGL(hybrid_fwd, dim3(grid), dim3(NTHR), LDS_BYTES, stream, a);
#endif
    }
    else {
        static const int phases[] = {0, 1, 2, 3, 4, 5, 6, 7, 17, 18, 19, 20, 21, 22, 23, 24, 25, 26, 27};
        for (int p : phases) { a.ph_lo = p; a.ph_hi = p + 1; hipLaunchKernelGGL(hybrid_fwd, dim3(grid), dim3(NTHR), LDS_BYTES, stream, a); }
    }
}
```

```cpp
#include <hip/hip_runtime.h>
#include <cstdio>
#include <cstdint>

#ifndef MK_N_LAUNCHES
#define MK_N_LAUNCHES 1
#endif

namespace pg8 {
#define PG8_LAS __attribute__((address_space(3)))
__device__ __forceinline__ int tid_here() { int t = threadIdx.x; asm volatile("" : "+v"(t)); return t; }
typedef unsigned short bf16_t;
typedef short bf16x8 __attribute__((ext_vector_type(8)));
typedef float f32x4 __attribute__((ext_vector_type(4)));
typedef unsigned u32x4 __attribute__((ext_vector_type(4)));
typedef unsigned u32x2 __attribute__((ext_vector_type(2)));
constexpr int BM = 256, BK = 64, HALF = 128, HTB = HALF * BK * 2, STAGE_BYTES = 8 * HTB, NXCD = 8, WGM = 8;

__host__ __device__ __forceinline__ int lds_byte(int r, int c) { const int st = (r >> 4) * 2 + (c >> 5), rr = r & 15, cc = c & 31, ob = rr * 64 + cc * 2; return st * 1024 + (ob ^ (((ob >> 9) & 1) << 5)); }
__host__ __device__ __forceinline__ void stage_rc(int b, int& R, int& C) { const int st = b / 1024, sb = b % 1024, swz = sb ^ (((sb >> 9) & 1) << 5); R = (st >> 1) * 16 + swz / 64; C = (st & 1) * 32 + (swz % 64) / 2; }
__host__ __device__ __forceinline__ int perm32(int rho) { const int n = rho >> 4, i = rho & 15; return 8 * (i >> 2) + 4 * n + (i & 3); }

struct Unit { int pm, pn, ko; };
struct Gemm { const bf16_t* A; const bf16_t* Bt; int M, N, K, ld; };

struct StaticOrder {
    int nM, nN, nwg, G, c;
    __host__ __device__ void init(int M, int N, int G_, int c_) { nM = M / BM; nN = N / BM; nwg = nM * nN; G = G_; c = c_; }
    __host__ __device__ bool next(int i, Unit& u) const {
        const long L = (long)i * G + c; if (L >= nwg) return false;
        int wgid = (int)L; { const int q = nwg / NXCD, r = nwg % NXCD, xcd = wgid % NXCD, off = wgid / NXCD; wgid = (xcd < r ? xcd * (q + 1) : r * (q + 1) + (xcd - r) * q) + off; }
        const int nig = WGM * nN, gid = wgid / nig, fm = gid * WGM, gsz = (nM - fm) < WGM ? (nM - fm) : WGM;
        u.pm = fm + ((wgid % nig) % gsz); u.pn = (wgid % nig) / gsz; u.ko = 0; return true;
    }
    __device__ __forceinline__ void a_ready(const Unit&) const {}
    __device__ __forceinline__ void done(const Unit&) const {}
};
struct MoeOrder {
    const int* panel_e; int npan, NT, GP, G, c;
    __device__ bool next(int i, Unit& u) const {
        const int nwg = npan * NT; const long L = (long)i * G + c; if (L >= nwg) return false;
        int wgid = (int)L; { const int q = nwg / NXCD, r = nwg % NXCD, xcd = wgid % NXCD, off = wgid / NXCD; wgid = (xcd < r ? xcd * (q + 1) : r * (q + 1) + (xcd - r) * q) + off; }
        const int nig = GP * NT, grp = wgid / nig, fm = grp * GP, gsz = (npan - fm) < GP ? (npan - fm) : GP; const int rr = wgid % nig;
        const int p = fm + rr % gsz; u.pm = p; u.pn = panel_e[p] * NT + rr / gsz; u.ko = 0; return true;
    }
    __device__ __forceinline__ void a_ready(const Unit&) const {}
    __device__ __forceinline__ void done(const Unit&) const {}
};

struct MoeTailOrder {
    const int* panel_e; int p0, ntp, G, c;
    __device__ bool next(int i, Unit& u) const {
        const long L = (long)i * G + c; if (L >= (long)ntp * 16) return false;
        const int kq = (int)L & 3, r = (int)L >> 2, p = p0 + (r >> 2); u.pm = p; u.pn = panel_e[p] * 4 + (r & 3); u.ko = kq * 896 * 2; return true;
    }
    __device__ __forceinline__ void a_ready(const Unit&) const {}
    __device__ __forceinline__ void done(const Unit&) const {}
};
__device__ __forceinline__ unsigned cvt_pk_bf16(float lo, float hi) { unsigned r; asm volatile("v_cvt_pk_bf16_f32 %0, %1, %2" : "=v"(r) : "v"(lo), "v"(hi)); return r; }

constexpr float RMS_EPS = 1e-6f;
__device__ __forceinline__ float rstd_of(const float* ss16) {
    const f32x4 a = *(const f32x4*)ss16, b = *(const f32x4*)(ss16 + 4), c = *(const f32x4*)(ss16 + 8), d = *(const f32x4*)(ss16 + 12);
    const float s = ((a[0] + a[1]) + (a[2] + a[3])) + ((b[0] + b[1]) + (b[2] + b[3])) + ((c[0] + c[1]) + (c[2] + c[3])) + ((d[0] + d[1]) + (d[2] + d[3]));
    return 1.0f / sqrtf(s * (1.0f / 1024.0f) + RMS_EPS);
}
__device__ __forceinline__ void rstd4(const float* SS, int row0, float (&rs)[4]) {
    f32x4 p[4][4];
#pragma unroll
    for (int m = 0; m < 4; ++m)
#pragma unroll
        for (int q = 0; q < 4; ++q) p[m][q] = *(const f32x4*)(SS + (size_t)(row0 + 16 * m) * 16 + 4 * q);
    asm volatile("" : "+v"(p[0][0]), "+v"(p[0][1]), "+v"(p[0][2]), "+v"(p[0][3]), "+v"(p[1][0]), "+v"(p[1][1]), "+v"(p[1][2]), "+v"(p[1][3]),
                      "+v"(p[2][0]), "+v"(p[2][1]), "+v"(p[2][2]), "+v"(p[2][3]), "+v"(p[3][0]), "+v"(p[3][1]), "+v"(p[3][2]), "+v"(p[3][3]));
#pragma unroll
    for (int m = 0; m < 4; ++m) { const f32x4 a = p[m][0], b = p[m][1], c = p[m][2], d = p[m][3];
        const float s = ((a[0] + a[1]) + (a[2] + a[3])) + ((b[0] + b[1]) + (b[2] + b[3])) + ((c[0] + c[1]) + (c[2] + c[3])) + ((d[0] + d[1]) + (d[2] + d[3]));
        rs[m] = 1.0f / sqrtf(s * (1.0f / 1024.0f) + RMS_EPS); }
}
__device__ __forceinline__ float logsig16(float x) { return ((x < 0.f ? x : 0.f) - __logf(1.0f + __expf(-fabsf(x)))) * (1.0f / 16.0f); }
__device__ __forceinline__ float silu_f(float a) { return a / (1.0f + __expf(-a)); }

struct EpiU {
    static constexpr bool PERM = true, AFTER_DRAIN = false;
    bf16_t* U; int ldu; const float* SS; float qs;
    __device__ __forceinline__ void operator()(const f32x4 (&acc)[2][2][4][2], const Unit& u, int wr, int wc, int fr, int fq) const {
        const int row0 = u.pm * BM + wr * 64 + fr, col0 = u.pn * BM + wc * 32 + 8 * fq;
        const float sc = (u.pn == 0) ? qs : ((u.pn == 3) ? 0.125f : 1.0f);
#pragma unroll
        for (int ai = 0; ai < 2; ++ai) { float rs4[4]; rstd4(SS, row0 + ai * HALF, rs4);
#pragma unroll
            for (int m = 0; m < 4; ++m) { const int row = row0 + ai * HALF + m * 16; const float rs = rs4[m] * sc;
                bf16_t* rowp = U + (size_t)row * ldu + col0;
#pragma unroll
                for (int bj = 0; bj < 2; ++bj) { const f32x4 v0 = acc[ai][bj][m][0] * rs, v1 = acc[ai][bj][m][1] * rs;
                    u32x4 w; w.x = cvt_pk_bf16(v0[0], v0[1]); w.y = cvt_pk_bf16(v0[2], v0[3]); w.z = cvt_pk_bf16(v1[0], v1[1]); w.w = cvt_pk_bf16(v1[2], v1[3]);
                    *(u32x4*)(rowp + bj * HALF) = w; } } }
    }
};
template <bool IN_F32, int PM = 0> struct EpiRes {
    static constexpr bool PERM = true, AFTER_DRAIN = false;
    const void* Xin; bf16_t* XB; float* SS;
    __device__ __forceinline__ void operator()(const f32x4 (&acc)[2][2][4][2], const Unit& u, int wr, int wc, int fr, int fq) const {
        const int row0 = u.pm * BM + wr * 64 + fr, col0 = u.pn * BM + wc * 32 + 8 * fq;
        if constexpr (IN_F32) {
#pragma unroll
            for (int ai = 0; ai < 2; ++ai) { f32x4 xo[4][2][2];
#pragma unroll
                for (int m = 0; m < 4; ++m)
#pragma unroll
                    for (int bj = 0; bj < 2; ++bj) { const float* p = (const float*)Xin + (size_t)(row0 + ai * HALF + m * 16) * 1024 + col0 + bj * HALF; xo[m][bj][0] = *(const f32x4*)p; xo[m][bj][1] = *(const f32x4*)(p + 4); }
                asm volatile("" : "+v"(xo[0][0][0]), "+v"(xo[0][0][1]), "+v"(xo[0][1][0]), "+v"(xo[0][1][1]), "+v"(xo[1][0][0]), "+v"(xo[1][0][1]), "+v"(xo[1][1][0]), "+v"(xo[1][1][1]),
                                  "+v"(xo[2][0][0]), "+v"(xo[2][0][1]), "+v"(xo[2][1][0]), "+v"(xo[2][1][1]), "+v"(xo[3][0][0]), "+v"(xo[3][0][1]), "+v"(xo[3][1][0]), "+v"(xo[3][1][1]));
#pragma unroll
                for (int m = 0; m < 4; ++m) { const int row = row0 + ai * HALF + m * 16; float ssum = 0.f;
#pragma unroll
                    for (int bj = 0; bj < 2; ++bj) { const f32x4 v0 = xo[m][bj][0] + acc[ai][bj][m][0], v1 = xo[m][bj][1] + acc[ai][bj][m][1];
                        u32x4 w; w.x = cvt_pk_bf16(v0[0], v0[1]); w.y = cvt_pk_bf16(v0[2], v0[3]); w.z = cvt_pk_bf16(v1[0], v1[1]); w.w = cvt_pk_bf16(v1[2], v1[3]);
                        *(u32x4*)(XB + (size_t)row * 1024 + col0 + bj * HALF) = w;
                        ssum += ((v0[0] * v0[0] + v0[1] * v0[1]) + (v0[2] * v0[2] + v0[3] * v0[3])) + ((v1[0] * v1[0] + v1[1] * v1[1]) + (v1[2] * v1[2] + v1[3] * v1[3])); }
                    ssum += __shfl_xor(ssum, 16); ssum += __shfl_xor(ssum, 32);
                    if (fq == 0) SS[(size_t)row * 16 + u.pn * 4 + wc] = ssum; } }
        } else {
            u32x4 xo[2][4][2];
#pragma unroll
            for (int ai = 0; ai < 2; ++ai)
#pragma unroll
                for (int m = 0; m < 4; ++m)
#pragma unroll
                    for (int bj = 0; bj < 2; ++bj) xo[ai][m][bj] = *(const u32x4*)((const bf16_t*)Xin + (size_t)(row0 + ai * HALF + m * 16) * 1024 + col0 + bj * HALF);
            asm volatile("" : "+v"(xo[0][0][0]), "+v"(xo[0][0][1]), "+v"(xo[0][1][0]), "+v"(xo[0][1][1]), "+v"(xo[0][2][0]), "+v"(xo[0][2][1]), "+v"(xo[0][3][0]), "+v"(xo[0][3][1]),
                              "+v"(xo[1][0][0]), "+v"(xo[1][0][1]), "+v"(xo[1][1][0]), "+v"(xo[1][1][1]), "+v"(xo[1][2][0]), "+v"(xo[1][2][1]), "+v"(xo[1][3][0]), "+v"(xo[1][3][1]));
#pragma unroll
            for (int ai = 0; ai < 2; ++ai)
#pragma unroll
                for (int m = 0; m < 4; ++m) { const int row = row0 + ai * HALF + m * 16; float ssum = 0.f;
#pragma unroll
                    for (int bj = 0; bj < 2; ++bj) { const u32x4 x = xo[ai][m][bj]; f32x4 v0, v1;
                        v0[0] = __builtin_bit_cast(float, x.x << 16) + acc[ai][bj][m][0][0]; v0[1] = __builtin_bit_cast(float, x.x & 0xffff0000u) + acc[ai][bj][m][0][1];
                        v0[2] = __builtin_bit_cast(float, x.y << 16) + acc[ai][bj][m][0][2]; v0[3] = __builtin_bit_cast(float, x.y & 0xffff0000u) + acc[ai][bj][m][0][3];
                        v1[0] = __builtin_bit_cast(float, x.z << 16) + acc[ai][bj][m][1][0]; v1[1] = __builtin_bit_cast(float, x.z & 0xffff0000u) + acc[ai][bj][m][1][1];
                        v1[2] = __builtin_bit_cast(float, x.w << 16) + acc[ai][bj][m][1][2]; v1[3] = __builtin_bit_cast(float, x.w & 0xffff0000u) + acc[ai][bj][m][1][3];
                        u32x4 w; w.x = cvt_pk_bf16(v0[0], v0[1]); w.y = cvt_pk_bf16(v0[2], v0[3]); w.z = cvt_pk_bf16(v1[0], v1[1]); w.w = cvt_pk_bf16(v1[2], v1[3]);
                        if constexpr (!(PM & 8)) *(u32x4*)(XB + (size_t)row * 1024 + col0 + bj * HALF) = w;
                        ssum += ((v0[0] * v0[0] + v0[1] * v0[1]) + (v0[2] * v0[2] + v0[3] * v0[3])) + ((v1[0] * v1[0] + v1[1] * v1[1]) + (v1[2] * v1[2] + v1[3] * v1[3])); }
                    if constexpr (!(PM & 16)) { ssum += __shfl_xor(ssum, 16); ssum += __shfl_xor(ssum, 32); }
                    if constexpr (!(PM & 4)) { if (fq == 0) SS[(size_t)row * 16 + u.pn * 4 + wc] = ssum; }
                    if constexpr ((PM & 12) == 12) asm volatile("" :: "v"(ssum)); }
        }
    }
};
template <bool MOE> struct EpiGlu {
    static constexpr bool PERM = true, AFTER_DRAIN = false;
    bf16_t* O; int ldo; const float* SS;
    __device__ __forceinline__ void operator()(const f32x4 (&acc)[2][2][4][2], const Unit& u, int wr, int wc, int fr, int fq) const {
        const int row0 = u.pm * BM + wr * 64 + fr; const int pnl = MOE ? (u.pn % 28) : u.pn; const int col0 = pnl * HALF + wc * 32 + 8 * fq;
#pragma unroll
        for (int ai = 0; ai < 2; ++ai) { float rs4[4];
            if constexpr (MOE) {
#pragma unroll
                for (int m = 0; m < 4; ++m) rs4[m] = SS[row0 + ai * HALF + m * 16];
                asm volatile("" : "+v"(rs4[0]), "+v"(rs4[1]), "+v"(rs4[2]), "+v"(rs4[3]));
            } else rstd4(SS, row0 + ai * HALF, rs4);
#pragma unroll
            for (int m = 0; m < 4; ++m) { const int row = row0 + ai * HALF + m * 16; const float rs = rs4[m];
                const f32x4 a0 = acc[ai][0][m][0] * rs, a1 = acc[ai][0][m][1] * rs, b0 = acc[ai][1][m][0] * rs, b1 = acc[ai][1][m][1] * rs;
                f32x4 g0, g1;
#pragma unroll
                for (int j = 0; j < 4; ++j) { g0[j] = silu_f(a0[j]) * b0[j]; g1[j] = silu_f(a1[j]) * b1[j]; }
                u32x4 w; w.x = cvt_pk_bf16(g0[0], g0[1]); w.y = cvt_pk_bf16(g0[2], g0[3]); w.z = cvt_pk_bf16(g1[0], g1[1]); w.w = cvt_pk_bf16(g1[2], g1[3]);
                *(u32x4*)(O + (size_t)row * ldo + col0) = w; } }
    }
};
struct EpiMoeDown {
    static constexpr bool PERM = true, AFTER_DRAIN = false;
    bf16_t* Y; const float* gate;
    __device__ __forceinline__ void operator()(const f32x4 (&acc)[2][2][4][2], const Unit& u, int wr, int wc, int fr, int fq) const {
        const int row0 = u.pm * BM + wr * 64 + fr, col0 = (u.pn & 3) * BM + wc * 32 + 8 * fq;
        float gt[2][4];
#pragma unroll
        for (int ai = 0; ai < 2; ++ai)
#pragma unroll
            for (int m = 0; m < 4; ++m) gt[ai][m] = gate[row0 + ai * HALF + m * 16];
        asm volatile("" : "+v"(gt[0][0]), "+v"(gt[0][1]), "+v"(gt[0][2]), "+v"(gt[0][3]), "+v"(gt[1][0]), "+v"(gt[1][1]), "+v"(gt[1][2]), "+v"(gt[1][3]));
#pragma unroll
        for (int ai = 0; ai < 2; ++ai)
#pragma unroll
            for (int m = 0; m < 4; ++m) { const int row = row0 + ai * HALF + m * 16; const float g = gt[ai][m]; bf16_t* rowp = Y + (size_t)row * 1024 + col0;
#pragma unroll
                for (int bj = 0; bj < 2; ++bj) { const f32x4 v0 = acc[ai][bj][m][0] * g, v1 = acc[ai][bj][m][1] * g;
                    u32x4 w; w.x = cvt_pk_bf16(v0[0], v0[1]); w.y = cvt_pk_bf16(v0[2], v0[3]); w.z = cvt_pk_bf16(v1[0], v1[1]); w.w = cvt_pk_bf16(v1[2], v1[3]);
                    *(u32x4*)(rowp + bj * HALF) = w; } }
    }
};

struct EpiMoeDownPart {
    static constexpr bool PERM = false, AFTER_DRAIN = false;
    float* YT; const float* gate; int row_base;
    __device__ __forceinline__ void operator()(const f32x4 (&acc)[2][2][4][2], const Unit& u, int wr, int wc, int fr, int fq) const {
        const int row0 = u.pm * BM + wr * 64 + fr, col0 = (u.pn & 3) * BM + wc * 32 + 4 * fq; const int kq = u.ko / 1792;
#pragma unroll
        for (int ai = 0; ai < 2; ++ai)
#pragma unroll
            for (int m = 0; m < 4; ++m) { const int row = row0 + ai * HALF + m * 16; const float gtv = gate[row]; float* rowp = YT + ((size_t)kq * 2048 + (row - row_base)) * 1024 + col0;
#pragma unroll
                for (int bj = 0; bj < 2; ++bj)
#pragma unroll
                    for (int n = 0; n < 2; ++n) *(f32x4*)(rowp + bj * HALF + n * 16) = acc[ai][bj][m][n] * gtv; }
    }
};
template <class Epi, class Sched, bool ALIGN_EPI = false, bool SP2 = false>
__device__ __forceinline__ void gemm_phase(PG8_LAS unsigned char* lds, const Gemm g, const Sched& S, const Epi& E, const bool skip_epi = false) {
    const int tid = tid_here(), wid = __builtin_amdgcn_readfirstlane(tid >> 6), lane = tid & 63, wr = wid >> 2, wc = wid & 3, fr = lane & 15, fq = lane >> 4;
    const int K = g.ld, nt = g.K / BK;
    unsigned voffA[2], voffB[2];
#pragma unroll
    for (int i = 0; i < 2; ++i) { int R, C; stage_rc(tid * 16 + i * 8192, R, C); const int Rb = Epi::PERM ? ((R & ~31) + perm32(R & 31)) : R;
        voffA[i] = (unsigned)(R * K + C) * 2u; voffB[i] = (unsigned)(Rb * K + C) * 2u; }
    const size_t kstep = (size_t)(BK * 2);
    const size_t hstep = (size_t)HALF * K * 2;
    const size_t tstep = 2 * hstep;
    const unsigned ldsw = (unsigned)wid * 1024u;
    const int aoff = lds_byte(wr * 64 + fr, fq * 8), boff = lds_byte(wc * 32 + fr, fq * 8);
#define PG8_SA(b, h) (((b) * 2 + (h)) * HTB)
#define PG8_SB(b, h) ((4 + (b) * 2 + (h)) * HTB)
#define PG8_STAGE(bufoff, gbase, voff) do { _Pragma("unroll") for (int _i = 0; _i < 2; ++_i) \
        __builtin_amdgcn_global_load_lds((const unsigned*)((const char*)(gbase) + (voff)[_i]), (PG8_LAS unsigned*)(lds + (bufoff) + ldsw + _i * 8192), 16, 0, 0); } while (0)
#define PG8_LDA(dst, b, h) do { _Pragma("unroll") for (int m = 0; m < 4; ++m) _Pragma("unroll") for (int k = 0; k < 2; ++k) dst[m][k] = *(const PG8_LAS bf16x8*)(lds + PG8_SA(b, h) + aoff + m * 2048 + k * 1024); } while (0)
#define PG8_LDB(dst, b, h) do { _Pragma("unroll") for (int n = 0; n < 2; ++n) _Pragma("unroll") for (int k = 0; k < 2; ++k) dst[n][k] = *(const PG8_LAS bf16x8*)(lds + PG8_SB(b, h) + boff + n * 2048 + k * 1024); } while (0)
#define PG8_MMA(ai, bj, At, Bt) do { __builtin_amdgcn_s_setprio(1); _Pragma("unroll") for (int m = 0; m < 4; ++m) _Pragma("unroll") for (int n = 0; n < 2; ++n) _Pragma("unroll") for (int k = 0; k < 2; ++k) \
        acc[ai][bj][m][n] = __builtin_amdgcn_mfma_f32_16x16x32_bf16(Bt[n][k], At[m][k], acc[ai][bj][m][n], 0, 0, 0); __builtin_amdgcn_s_setprio(0); } while (0)
#define PG8_WAIT_V(n) asm volatile("s_waitcnt vmcnt(" #n ")" ::: "memory")
#define PG8_WAIT_L(n) asm volatile("s_waitcnt lgkmcnt(" #n ")" ::: "memory")
#define PG8_BAR __builtin_amdgcn_s_barrier()
#define PG8_SCHED __builtin_amdgcn_sched_barrier(0)
    Unit cur, nxt; int ui = 0;
    if (!S.next(0, cur)) return;
    f32x4 acc[2][2][4][2];
#pragma unroll
    for (int a = 0; a < 2; ++a)
#pragma unroll
        for (int b = 0; b < 2; ++b)
#pragma unroll
            for (int m = 0; m < 4; ++m)
#pragma unroll
                for (int n = 0; n < 2; ++n) acc[a][b][m][n] = (f32x4){0.f, 0.f, 0.f, 0.f};
    bf16x8 At[4][2], B0[2][2], B1[2][2];
    const char* cA = (const char*)g.A + (size_t)cur.pm * tstep + cur.ko; const char* cB = (const char*)g.Bt + (size_t)cur.pn * tstep + cur.ko;
    S.a_ready(cur);
    if constexpr (SP2) {
        PG8_STAGE(PG8_SB(0, 0), cB, voffB); PG8_STAGE(PG8_SB(0, 1), cB + hstep, voffB); PG8_STAGE(PG8_SA(0, 0), cA, voffA); PG8_STAGE(PG8_SA(0, 1), cA + hstep, voffA);
        if (wr == 1) PG8_BAR;
        PG8_WAIT_V(2); PG8_BAR;
        PG8_STAGE(PG8_SB(1, 0), cB + kstep, voffB); PG8_STAGE(PG8_SA(1, 0), cA + kstep, voffA); PG8_STAGE(PG8_SB(1, 1), cB + hstep + kstep, voffB);
        PG8_WAIT_V(6); PG8_BAR;
    } else {
        PG8_STAGE(PG8_SB(0, 0), cB, voffB); PG8_STAGE(PG8_SA(0, 0), cA, voffA); PG8_STAGE(PG8_SB(0, 1), cB + hstep, voffB); PG8_STAGE(PG8_SA(0, 1), cA + hstep, voffA);
        if (wr == 1) PG8_BAR;
        PG8_WAIT_V(4); PG8_BAR;
        PG8_STAGE(PG8_SB(1, 0), cB + kstep, voffB); PG8_STAGE(PG8_SA(1, 0), cA + kstep, voffA); PG8_STAGE(PG8_SB(1, 1), cB + hstep + kstep, voffB);
        PG8_WAIT_V(6); PG8_BAR;
    }
    for (;;) {
        const bool has_next = S.next(ui + 1, nxt);
        const char* nA = has_next ? (const char*)g.A + (size_t)nxt.pm * tstep + nxt.ko : cA; const char* nB = has_next ? (const char*)g.Bt + (size_t)nxt.pn * tstep + nxt.ko : cB;
        for (int t = 0; t < nt; t += 2) {
            const bool last = (t == nt - 2);
            const char* a1 = cA + (size_t)(t + 1) * kstep;
            const char* a2 = last ? nA : cA + (size_t)(t + 2) * kstep; const char* b2 = last ? nB : cB + (size_t)(t + 2) * kstep;
            const char* a3 = a2 + kstep; const char* b3 = b2 + kstep;
            if (last && has_next) S.a_ready(nxt);
            if constexpr (SP2) {
            PG8_LDB(B0, 0, 0); PG8_LDB(B1, 0, 1); PG8_SCHED; PG8_LDA(At, 0, 0); PG8_STAGE(PG8_SA(1, 1), a1 + hstep, voffA);
            PG8_WAIT_V(8); PG8_WAIT_L(0); PG8_BAR; PG8_MMA(0, 0, At, B0); PG8_MMA(0, 1, At, B1); PG8_BAR; PG8_SCHED;
            PG8_LDA(At, 0, 1); PG8_STAGE(PG8_SB(0, 0), b2, voffB); PG8_STAGE(PG8_SB(0, 1), b2 + hstep, voffB); PG8_STAGE(PG8_SA(0, 0), a2, voffA);
            PG8_WAIT_V(8); PG8_WAIT_L(0); PG8_BAR; PG8_MMA(1, 0, At, B0); PG8_MMA(1, 1, At, B1); PG8_BAR; PG8_SCHED;
            PG8_LDB(B0, 1, 0); PG8_LDB(B1, 1, 1); PG8_SCHED; PG8_LDA(At, 1, 0); PG8_STAGE(PG8_SA(0, 1), a2 + hstep, voffA);
            PG8_WAIT_V(8); PG8_WAIT_L(0); PG8_BAR; PG8_MMA(0, 0, At, B0); PG8_MMA(0, 1, At, B1); PG8_BAR; PG8_SCHED;
            PG8_LDA(At, 1, 1); PG8_STAGE(PG8_SB(1, 0), b3, voffB); PG8_STAGE(PG8_SB(1, 1), b3 + hstep, voffB); PG8_STAGE(PG8_SA(1, 0), a3, voffA);
            PG8_WAIT_V(8); PG8_WAIT_L(0); PG8_BAR; PG8_MMA(1, 0, At, B0); PG8_MMA(1, 1, At, B1); PG8_BAR; PG8_SCHED;
            } else {
            PG8_LDB(B0, 0, 0); PG8_SCHED; PG8_LDA(At, 0, 0); PG8_STAGE(PG8_SA(1, 1), a1 + hstep, voffA);
            PG8_WAIT_L(8); PG8_BAR; PG8_WAIT_L(0); PG8_MMA(0, 0, At, B0); PG8_BAR; PG8_SCHED;
            PG8_LDB(B1, 0, 1); PG8_STAGE(PG8_SB(0, 0), b2, voffB);
            PG8_BAR; PG8_WAIT_L(0); PG8_MMA(0, 1, At, B1); PG8_BAR;
            PG8_LDA(At, 0, 1); PG8_STAGE(PG8_SA(0, 0), a2, voffA);
            PG8_BAR; PG8_WAIT_L(0); PG8_MMA(1, 0, At, B0); PG8_BAR; PG8_SCHED;
            PG8_STAGE(PG8_SB(0, 1), b2 + hstep, voffB);
            PG8_WAIT_V(6); PG8_BAR; PG8_MMA(1, 1, At, B1); PG8_BAR;
            PG8_LDB(B0, 1, 0); PG8_SCHED; PG8_LDA(At, 1, 0); PG8_STAGE(PG8_SA(0, 1), a2 + hstep, voffA);
            PG8_WAIT_L(8); PG8_BAR; PG8_WAIT_L(0); PG8_MMA(0, 0, At, B0); PG8_BAR; PG8_SCHED;
            PG8_LDB(B1, 1, 1); PG8_STAGE(PG8_SB(1, 0), b3, voffB);
            PG8_BAR; PG8_WAIT_L(0); PG8_MMA(0, 1, At, B1); PG8_BAR;
            PG8_LDA(At, 1, 1); PG8_STAGE(PG8_SA(1, 0), a3, voffA);
            PG8_BAR; PG8_WAIT_L(0); PG8_MMA(1, 0, At, B0); PG8_BAR; PG8_SCHED;
            PG8_STAGE(PG8_SB(1, 1), b3 + hstep, voffB);
            PG8_WAIT_V(6); PG8_BAR; PG8_MMA(1, 1, At, B1); PG8_BAR;
            }
        }
        if constexpr (ALIGN_EPI) { if (wr == 0) PG8_BAR; }
        if constexpr (!Epi::AFTER_DRAIN) { if (!skip_epi) E(acc, cur, wr, wc, fr, fq); S.done(cur); }
        if (!has_next) break;
#pragma unroll
        for (int a = 0; a < 2; ++a)
#pragma unroll
            for (int b = 0; b < 2; ++b)
#pragma unroll
                for (int m = 0; m < 4; ++m)
#pragma unroll
                    for (int n = 0; n < 2; ++n) acc[a][b][m][n] = (f32x4){0.f, 0.f, 0.f, 0.f};
        cur = nxt; cA = nA; cB = nB; ++ui;
        if constexpr (ALIGN_EPI) { if (wr == 1) PG8_BAR; }
    }
    PG8_WAIT_V(0);
    if constexpr (!ALIGN_EPI) { if (wr == 0) PG8_BAR; }
    PG8_BAR;
#undef PG8_SA
#undef PG8_SB
#undef PG8_STAGE
#undef PG8_LDA
#undef PG8_LDB
#undef PG8_MMA
#undef PG8_WAIT_V
#undef PG8_WAIT_L
#undef PG8_BAR
#undef PG8_SCHED
}
}

constexpr int NWAVES = 8, NTHR = NWAVES * 64;
constexpr int NB = 8, SEQ = 2048, D = 1024, M = NB * SEQ;
constexpr int INC = 3088;
constexpr int NU = 3072;
constexpr int UQ = 0, UK = 256, UV = 512, UGQ = 768, UGK = 1024, UGV = 1280, UGR = 1792, UCI = 2304, UCB = 2560, UCC = 2816;
constexpr int FF = 2816, FE = 3584, NE = 8;
constexpr int MAXPAN = 136, MAXROWS = MAXPAN * 256;
constexpr float LOG2E = 1.4426950408889634f;
constexpr float QS_ATT = 0.125f * LOG2E;

constexpr size_t MiB = 1u << 20;
constexpr size_t WS_CTL = 0, CTL_ZERO_BYTES = 1 * MiB;
constexpr size_t WS_SS = 1 * MiB;
constexpr size_t WS_BL = 2 * MiB;
constexpr size_t WS_DEC = 2 * MiB + 64 * 1024;
constexpr size_t WS_TOPI = 3 * MiB;
constexpr size_t WS_TOPW = 3 * MiB + 128 * 1024;
constexpr size_t WS_POS = 3 * MiB + 256 * 1024;
constexpr size_t WS_RS3 = 3 * MiB + 384 * 1024;
constexpr size_t WS_CNT = 3 * MiB + 448 * 1024;
constexpr size_t WS_PANE = 3 * MiB + 456 * 1024;
constexpr size_t WS_ROWGATE = 4 * MiB;
constexpr size_t WS_ROWRS = 4 * MiB + 256 * 1024;
constexpr size_t WS_WE13 = 8 * MiB;
constexpr size_t WS_Y = WS_WE13;
constexpr size_t WS_YT = WS_WE13 + 68 * MiB;
constexpr size_t WS_XS = 120 * MiB;
constexpr size_t WS_WE2 = WS_XS;
constexpr size_t WS_HE = 188 * MiB;
constexpr size_t WS_WIN = WS_HE;
constexpr size_t WS_WGLR = WS_HE + 12 * MiB;
constexpr size_t WS_LA = WS_HE + 34 * MiB;
constexpr size_t WS_WOUT = WS_HE + 13 * MiB;
constexpr size_t WS_W13 = WS_HE + 17 * MiB;
constexpr size_t WS_W2 = WS_HE + 28 * MiB;
constexpr size_t WS_XB = WS_HE + 238 * MiB;
constexpr size_t WS_U = WS_HE + 66 * MiB;
constexpr size_t WS_H = WS_U;
constexpr size_t WS_MIX = WS_HE + 170 * MiB;
constexpr size_t WS_CST = WS_HE + 202 * MiB;
constexpr size_t WS_END = WS_HE + 270 * MiB;
static_assert(WS_CST + 32 * MiB <= WS_END, "ws map");
constexpr int CW_BAR = 4096;
constexpr int CW_SC = 32768;
constexpr int CW_TMO2 = 65536;

constexpr int LDS_BYTES = 147456;
constexpr int LDSCTL_OFF = 131072 + 14 * 1024, MISC_OFF = LDSCTL_OFF + 320;

#define GAS __attribute__((address_space(1)))
#define LAS __attribute__((address_space(3)))
typedef unsigned short bf16;
typedef float f32x4 __attribute__((ext_vector_type(4)));
typedef unsigned v4u __attribute__((ext_vector_type(4)));
__device__ __forceinline__ unsigned f2bf(float f) { unsigned u = __builtin_bit_cast(unsigned, f); return (u + 0x7fffu + ((u >> 16) & 1u)) >> 16; }
__device__ __forceinline__ unsigned pk2(float lo, float hi) { return f2bf(lo) | (f2bf(hi) << 16); }
__device__ __forceinline__ float bf2f(unsigned short b) { return __builtin_bit_cast(float, (unsigned)b << 16); }
__device__ __forceinline__ float bflo(unsigned w) { return __builtin_bit_cast(float, w << 16); }
__device__ __forceinline__ float bfhi(unsigned w) { return __builtin_bit_cast(float, w & 0xffff0000u); }
__device__ __forceinline__ float wave_sum(float v) {
#pragma unroll
    for (int o = 1; o < 64; o <<= 1) v += __shfl_xor(v, o);
    return v;
}
__device__ __forceinline__ float wave_max(float v) {
#pragma unroll
    for (int o = 1; o < 64; o <<= 1) v = fmaxf(v, __shfl_xor(v, o));
    return v;
}

#define XB_TMO      128
#define XB_XCNT(j)  (256  + 64 * (j))
#define XB_XSUB(j)  (1280 + 64 * (j))
#define XB_XGEN(j)  (2304 + 64 * (j))
#define XB_TOP      3328
#define XB_TOPGEN   3392
#define XCD_BAR_WORDS 3456
#define XB_SPIN_CAP (1u << 18)
__device__ __forceinline__ unsigned xb_ld(unsigned* p)              { return __hip_atomic_load(p, __ATOMIC_RELAXED, __HIP_MEMORY_SCOPE_AGENT); }
__device__ __forceinline__ unsigned xb_add(unsigned* p, unsigned v) { return __hip_atomic_fetch_add(p, v, __ATOMIC_RELAXED, __HIP_MEMORY_SCOPE_AGENT); }
__device__ __forceinline__ unsigned xb_xcc_id() { return (unsigned)__builtin_amdgcn_s_getreg((3 << 11) | 20) & 0xFu; }
#define XB_SPIN(cond, bar) do { unsigned _sp = 0; while (cond) { __builtin_amdgcn_s_sleep(1); \
    if ((++_sp & 255u) == 0u) { if (xb_ld(&(bar)[XB_TMO])) break; if (_sp > XB_SPIN_CAP) { atomicAdd(&(bar)[XB_TMO], 1u); break; } } } } while (0)
struct XcdBarrier { unsigned* bar; unsigned x; volatile LAS unsigned* st; };
__device__ __forceinline__ XcdBarrier xcd_barrier_post(unsigned* bar, volatile LAS unsigned* st) {
    XcdBarrier b; b.bar = bar; b.x = xb_xcc_id(); b.st = st;
    if (threadIdx.x == 0) (void)xb_add(&bar[XB_XCNT(b.x)], 1u);
    return b;
}
__device__ __forceinline__ void xcd_barrier_complete(unsigned* bar, unsigned x, unsigned& nloc, unsigned& nx) {
    const unsigned G = gridDim.x * gridDim.y * gridDim.z;
    unsigned sum, cnt, mine, sp = 0u;
    for (;;) {
        sum = 0u; cnt = 0u; mine = 0u;
#pragma unroll
        for (unsigned j = 0; j < 16; ++j) { const unsigned c = xb_ld(&bar[XB_XCNT(j)]); sum += c; cnt += (c > 0u) ? 1u : 0u; mine = (j == x) ? c : mine; }
        if (sum == G) break;
        __builtin_amdgcn_s_sleep(1);
        if ((++sp & 255u) == 0u) { if (xb_ld(&bar[XB_TMO])) break; if (sp > XB_SPIN_CAP) { atomicAdd(&bar[XB_TMO], 1u); break; } }
    }
    nloc = mine > 0u ? mine : 1u; nx = cnt > 0u ? cnt : 1u;
}
__device__ __forceinline__ void xcd_barrier(const XcdBarrier& b) {
    asm volatile("s_waitcnt vmcnt(0)" ::: "memory");
    __syncthreads();
    if (threadIdx.x == 0) {
        unsigned* bar = b.bar;
        __builtin_amdgcn_s_waitcnt(0);
        unsigned nloc = b.st[0], nx = b.st[1];
        if (nloc == 0u) { xcd_barrier_complete(bar, b.x, nloc, nx); b.st[0] = nloc; b.st[1] = nx; }
        const unsigned old = xb_add(&bar[XB_XSUB(b.x)], 1u);
        const unsigned gen = old / nloc;
        if (old + 1u == (gen + 1u) * nloc) {
            __builtin_amdgcn_fence(__ATOMIC_RELEASE, "agent");
            asm volatile("s_waitcnt vmcnt(0)" ::: "memory");
            const unsigned og = xb_add(&bar[XB_TOP], 1u);
            const unsigned tg = og / nx;
            if (og + 1u == (tg + 1u) * nx) xb_add(&bar[XB_TOPGEN], 1u);
            else XB_SPIN(xb_ld(&bar[XB_TOPGEN]) == tg, bar);
            __builtin_amdgcn_fence(__ATOMIC_ACQUIRE, "agent");
            xb_add(&bar[XB_XGEN(b.x)], 1u);
            asm volatile("s_waitcnt vmcnt(0)" ::: "memory");
        } else {
            XB_SPIN(xb_ld(&bar[XB_XGEN(b.x)]) == gen, bar);
            __builtin_amdgcn_fence(__ATOMIC_ACQUIRE, "agent");
            asm volatile("s_waitcnt vmcnt(0)" ::: "memory");
        }
    }
    __syncthreads();
}

struct Args {
    const float* x; const float* w_mix_in; const float* w_mix_out; const float* g_mix; const float* rel_bias; const float* gla_w_gate; const float* gla_b_gate;
    const float* gla_g_norm; const float* conv_w; const float* g_ffn; const float* ffn_w1; const float* ffn_w3; const float* ffn_w2; const float* moe_router;
    const float* moe_w1; const float* moe_w3; const float* moe_w2; const float* g_final;
    float* out; unsigned char* ws; int ph_lo, ph_hi, li, pad;
};

__device__ __forceinline__ void transpose_tile(const float* src, int ldsrc, int k0, int n0, bf16* dst, int ldd, int drow0, const float* ksc, unsigned* scr, int lane) {
    const int nq = lane & 15, kk = lane >> 4;
#pragma unroll
    for (int i = 0; i < 8; ++i) { const int k = 8 * i + 2 * kk; const float* p = src + (size_t)(k0 + k) * ldsrc + n0 + 4 * nq;
        const f32x4 r0 = *(const f32x4*)p, r1 = *(const f32x4*)(p + ldsrc);
        const float s0 = ksc ? ksc[k0 + k] : 1.f, s1 = ksc ? ksc[k0 + k + 1] : 1.f;
#pragma unroll
        for (int j = 0; j < 4; ++j) scr[(4 * nq + j) * 33 + 4 * i + kk] = pk2(r0[j] * s0, r1[j] * s1); }
    asm volatile("s_waitcnt lgkmcnt(0)" ::: "memory");
#pragma unroll 8
    for (int i2 = 0; i2 < 32; ++i2) { const int n = 2 * i2 + (lane >> 5), d = lane & 31;
        ((unsigned*)(dst + (size_t)(drow0 + n) * ldd + k0))[d] = scr[n * 33 + d]; }
    asm volatile("s_waitcnt lgkmcnt(0)" ::: "memory");
}
__device__ __forceinline__ void glr_tile(const float* win, const float* wg, const float* g, int k0, int n0, bf16* dst, int drow0, int lane) {
    float w[16];
#pragma unroll
    for (int r = 0; r < 16; ++r) w[r] = wg[r * 256 + n0 + lane];
    unsigned* drow = (unsigned*)(dst + (size_t)(drow0 + n0 + lane) * 1024 + k0);
    for (int kp = 0; kp < 32; ++kp) { float v[2];
#pragma unroll
        for (int q = 0; q < 2; ++q) { const int k = k0 + 2 * kp + q; const float* s = win + (size_t)k * INC + 2304; float a = 0.f;
#pragma unroll
            for (int r = 0; r < 16; ++r) a += s[r] * w[r];
            v[q] = a * g[k]; }
        drow[kp] = pk2(v[0], v[1]); }
}
__device__ __forceinline__ int rel_bucket(int d) {
    if (d < 16) return d;
    const float lr = logf((float)d / 16.0f) / logf(128.0f);
    int b = 16 + (int)(lr * 16.0f); return b < 31 ? b : 31;
}


typedef short bf16x8 __attribute__((ext_vector_type(8)));
typedef short v4i16_t __attribute__((ext_vector_type(4)));
#define MFMA16(a, b, c) __builtin_amdgcn_mfma_f32_16x16x32_bf16((a), (b), (c), 0, 0, 0)
__device__ __forceinline__ v4i16_t tr16(LAS unsigned char* p) { return __builtin_amdgcn_ds_read_tr16_b64_v4i16((LAS v4i16_t*)p); }
__device__ __forceinline__ bf16x8 cat8(v4i16_t lo, v4i16_t hi) { return __builtin_shufflevector(lo, hi, 0, 1, 2, 3, 4, 5, 6, 7); }
__device__ __forceinline__ bf16x8 frag_rm(LAS unsigned char* base, int pitch, int c0, int k0, int lane) { return *(LAS bf16x8*)(base + (c0 + (lane & 15)) * pitch + (k0 + 8 * (lane >> 4)) * 2); }
__device__ __forceinline__ bf16x8 frag_tr(LAS unsigned char* base, int pitch, int c0, int k0, int lane) {
    const int i = lane & 15, g = lane >> 4; LAS unsigned char* p = base + (k0 + 8 * g + (i >> 2)) * pitch + (c0 + 4 * (i & 3)) * 2;
    return cat8(tr16(p), tr16(p + 4 * pitch)); }
__device__ __forceinline__ bf16x8 frag_trp(LAS unsigned char* base, int pitch, int c0, int k0, int lane) {
    const int i = lane & 15, g = lane >> 4; LAS unsigned char* p = base + (k0 + 4 * g + (i >> 2)) * pitch + (c0 + 4 * (i & 3)) * 2;
    return cat8(tr16(p), tr16(p + 16 * pitch)); }
__device__ __forceinline__ bf16x8 pack8(const f32x4& a, const f32x4& b) {
    v4u w; w.x = pg8::cvt_pk_bf16(a[0], a[1]); w.y = pg8::cvt_pk_bf16(a[2], a[3]); w.z = pg8::cvt_pk_bf16(b[0], b[1]); w.w = pg8::cvt_pk_bf16(b[2], b[3]); return __builtin_bit_cast(bf16x8, w); }

struct Ctx { Args args; int tid, lane, wave, G, bx, gw, NGW, lo, hi; XcdBarrier bar; };
#define GRID_BAR() do { if (MK_N_LAUNCHES == 1) xcd_barrier(bar); } while (0)
#define IN(k) (lo <= (k) && (k) < hi)
#define SEAM(k) do { if (IN(k) && IN((k) + 1)) GRID_BAR(); } while (0)
#define WS_PTRS \
    float* SS = (float*)(ws + WS_SS); float* BL = (float*)(ws + WS_BL); float* DEC = (float*)(ws + WS_DEC); \
    bf16* XB = (bf16*)(ws + WS_XB); bf16* U = (bf16*)(ws + WS_U); bf16* MIX = (bf16*)(ws + WS_MIX); float* CST = (float*)(ws + WS_CST); \
    bf16* H = (bf16*)(ws + WS_H); bf16* W13 = (bf16*)(ws + WS_W13); bf16* W2 = (bf16*)(ws + WS_W2); \
    bf16* WE13 = (bf16*)(ws + WS_WE13); bf16* WE2 = (bf16*)(ws + WS_WE2); bf16* XS = (bf16*)(ws + WS_XS); bf16* HE = (bf16*)(ws + WS_HE); bf16* Y = (bf16*)(ws + WS_Y); \
    int* TOPI = (int*)(ws + WS_TOPI); float* TOPW = (float*)(ws + WS_TOPW); int* POS = (int*)(ws + WS_POS); float* RS3 = (float*)(ws + WS_RS3); \
    int* CNT = (int*)(ws + WS_CNT); int* PANE = (int*)(ws + WS_PANE); float* ROWGATE = (float*)(ws + WS_ROWGATE); float* ROWRS = (float*)(ws + WS_ROWRS); \
    float* X = args.out; \
    (void)SS; (void)BL; (void)DEC; (void)XB; (void)U; (void)MIX; (void)CST; (void)H; (void)W13; (void)W2; (void)WE13; (void)WE2; (void)XS; (void)HE; (void)Y; \
    (void)TOPI; (void)TOPW; (void)POS; (void)RS3; (void)CNT; (void)PANE; (void)ROWGATE; (void)ROWRS; (void)X;

template <int layer> __device__ __forceinline__ void layer_phases(const Ctx& c, unsigned char* lds) {
    const Args& args = c.args; LAS unsigned char* ldsl = (LAS unsigned char*)lds;
    const int tid = c.tid, lane = c.lane, wave = c.wave, G = c.G, bx = c.bx, gw = c.gw, NGW = c.NGW, lo = c.lo, hi = c.hi; const XcdBarrier bar = c.bar;
    unsigned char* ws = args.ws;
    WS_PTRS
    (void)tid; (void)lane; (void)wave; (void)gw; (void)NGW;
    const int pmode = args.pad >> 4; (void)pmode;
    const bool dry = (args.pad & 1) != 0, noepi = (args.pad & 2) != 0;
    bf16* XBD = dry ? (bf16*)(ws + WS_XS) : XB; float* SSD = dry ? (float*)(ws + WS_XS) : SS; (void)XBD; (void)SSD;
        const int pb = 1 + 16 * layer;
        if (IN(pb + 0)) {
            pg8::Gemm g{XB, (const bf16*)(ws + WS_WIN) + (size_t)layer * NU * D, M, NU, D, D}; pg8::StaticOrder S; S.init(M, NU, G, bx);
            pg8::EpiU E{U, NU, SS, QS_ATT};
            pg8::gemm_phase<pg8::EpiU, pg8::StaticOrder, true, true>(ldsl, g, S, E, noepi);
            { const bf16* wg = (const bf16*)(ws + WS_WGLR) + (size_t)layer * 16 * D; float* LA = (float*)(ws + WS_LA); f32x4* xch = (f32x4*)lds; float* glrl = (float*)(lds + 4096);
              const int tid = pg8::tid_here(), lane = tid & 63;
              float wgc[16]; { const float* wgp = args.gla_w_gate + layer * 16 * 256 + (tid & 255);
#pragma unroll
                for (int r = 0; r < 16; ++r) wgc[r] = wgp[r * 256]; }
              const float bgv = args.gla_b_gate[layer * 256 + (tid & 255)];
              for (int blk = bx; blk < 256; blk += G) {
                  const int rt = wave & 3, kh = wave >> 2, ql = lane & 15, g4 = lane >> 4;
                  const bf16* ap = XB + (size_t)(blk * 64 + rt * 16 + ql) * D + kh * 512 + 8 * g4; const bf16* bp = wg + (size_t)ql * D + kh * 512 + 8 * g4;
                  f32x4 acc = (f32x4){0.f, 0.f, 0.f, 0.f};
#pragma unroll
                  for (int ks = 0; ks < 16; ++ks) acc = MFMA16(*(const bf16x8*)(ap + 32 * ks), *(const bf16x8*)(bp + 32 * ks), acc);
                  if (kh == 1) xch[rt * 64 + lane] = acc;
                  __syncthreads();
                  if (kh == 0) { acc += xch[rt * 64 + lane];
#pragma unroll
                      for (int rg = 0; rg < 4; ++rg) { const int rl = rt * 16 + 4 * g4 + rg; glrl[rl * 16 + ql] = acc[rg] * pg8::rstd_of(SS + (size_t)(blk * 64 + rl) * 16); } }
                  __syncthreads();
                  { const int c = tid & 255, r0 = (tid >> 8) * 32;
#pragma unroll 4
                    for (int i = 0; i < 32; ++i) { const f32x4* gp = (const f32x4*)(glrl + (r0 + i) * 16); float z = bgv;
#pragma unroll
                        for (int q4 = 0; q4 < 4; ++q4) { const f32x4 gv = gp[q4]; z += gv[0] * wgc[4 * q4] + gv[1] * wgc[4 * q4 + 1] + gv[2] * wgc[4 * q4 + 2] + gv[3] * wgc[4 * q4 + 3]; }
                        LA[(size_t)(blk * 64 + r0 + i) * 256 + c] = pg8::logsig16(z); } }
                  __syncthreads();
              } }
        }
        SEAM(pb + 0);
        if (IN(pb + 1)) {
            const int tid = pg8::tid_here(), lane = tid & 63; (void)lane;
            float* cum = (float*)lds; float* seg = cum + 4096;
            LAS unsigned char* kdl = ldsl + 18432;
            LAS unsigned char* vvl = ldsl + 27648;
            for (int u = bx; u < 1024; u += G) {
                const int h = u & 3, n = (u >> 2) & 31, b = u >> 7; const size_t row0 = (size_t)b * SEQ + n * 64;
                const int tr = tid >> 3, c8 = tid & 7;
                const v4u kraw = *(const v4u*)(U + (row0 + tr) * NU + UGK + h * 64 + 8 * c8);
                const v4u* vp = (const v4u*)(U + (row0 + tr) * NU + UGV + h * 128 + c8 * 16); const v4u x0 = vp[0], x1 = vp[1];
                { float c = 0.f; float lav[8]; const float* lap = (const float*)(ws + WS_LA) + (row0 + 8 * wave) * 256 + h * 64 + lane;
#pragma unroll
                  for (int i = 0; i < 8; ++i) lav[i] = lap[i * 256];
#pragma unroll
                  for (int i = 0; i < 8; ++i) { c += lav[i]; cum[(8 * wave + i) * 64 + lane] = c; }
                  seg[wave * 64 + lane] = c; }
                __syncthreads();
                { f32x4 offa = (f32x4){0.f, 0.f, 0.f, 0.f}, offb = offa, lasta = offa, lastb = offa; const int wq = tr >> 3;
#pragma unroll
                  for (int w = 0; w < 8; ++w) { const f32x4 sa = *(const f32x4*)(seg + w * 64 + 8 * c8), sb = *(const f32x4*)(seg + w * 64 + 8 * c8 + 4); lasta += sa; lastb += sb; if (w < wq) { offa += sa; offb += sb; } }
                  const f32x4 ca = *(const f32x4*)(cum + tr * 64 + 8 * c8) + offa, cb = *(const f32x4*)(cum + tr * 64 + 8 * c8 + 4) + offb;
                  v4u w; w.x = pk2(bflo(kraw.x) * __expf(lasta[0] - ca[0]), bfhi(kraw.x) * __expf(lasta[1] - ca[1])); w.y = pk2(bflo(kraw.y) * __expf(lasta[2] - ca[2]), bfhi(kraw.y) * __expf(lasta[3] - ca[3]));
                  w.z = pk2(bflo(kraw.z) * __expf(lastb[0] - cb[0]), bfhi(kraw.z) * __expf(lastb[1] - cb[1])); w.w = pk2(bflo(kraw.w) * __expf(lastb[2] - cb[2]), bfhi(kraw.w) * __expf(lastb[3] - cb[3]));
                  *(LAS v4u*)(kdl + tr * 144 + c8 * 16) = w;
                  if (tr == 0) {
#pragma unroll
                      for (int j = 0; j < 4; ++j) { __hip_atomic_store(DEC + u * 64 + 8 * c8 + j, __expf(lasta[j]), __ATOMIC_RELAXED, __HIP_MEMORY_SCOPE_AGENT); __hip_atomic_store(DEC + u * 64 + 8 * c8 + 4 + j, __expf(lastb[j]), __ATOMIC_RELAXED, __HIP_MEMORY_SCOPE_AGENT); } }
                  LAS v4u* vd = (LAS v4u*)(vvl + tr * 272 + c8 * 32); vd[0] = x0; vd[1] = x1; }
                __syncthreads();
                { f32x4 acc[4];
#pragma unroll
                  for (int kt = 0; kt < 4; ++kt) acc[kt] = (f32x4){0.f, 0.f, 0.f, 0.f};
#pragma unroll
                  for (int ks = 0; ks < 2; ++ks) { const bf16x8 bv = frag_tr(vvl, 272, 16 * wave, 32 * ks, lane);
#pragma unroll
                      for (int kt = 0; kt < 4; ++kt) { const bf16x8 ak = frag_tr(kdl, 144, 16 * kt, 32 * ks, lane); acc[kt] = MFMA16(ak, bv, acc[kt]); } }
                  const int g4 = lane >> 4, ql = lane & 15;
                  const __amdgpu_buffer_rsrc_t rsrc = __builtin_amdgcn_make_buffer_rsrc((void*)CST, 0, 32 * 1024 * 1024, 0x00020000);
#pragma unroll
                  for (int kt = 0; kt < 4; ++kt)
                      __builtin_amdgcn_raw_buffer_store_b128(__builtin_bit_cast(v4u, acc[kt]), rsrc, (int)((((unsigned)u * 128u + 16u * wave + ql) * 64u + 16u * kt + 4u * g4) * 4u), 0, 16); }
                asm volatile("s_waitcnt vmcnt(0)" ::: "memory");
                __syncthreads();
                if (tid == 0) __hip_atomic_fetch_add((unsigned*)(ws + WS_CTL) + CW_SC + ((u >> 7) * 4 + (u & 3)) * 64, 1u, __ATOMIC_RELAXED, __HIP_MEMORY_SCOPE_AGENT);
            }
            const float* cw = args.conv_w + layer * 3 * 256;
            for (int rep_ = 0; rep_ < 1 + ((args.pad >> 10) & 1); ++rep_)
            for (int it = bx * NTHR + tid; it < M * 32; it += G * NTHR) {
                const int row = it >> 5, c0 = (it & 31) * 8, t = row & (SEQ - 1);
                const bf16* ur = U + (size_t)row * NU;
                const v4u cb = *(const v4u*)(ur + UCB + c0);
                v4u ci[3], cc[3];
#pragma unroll
                for (int d = 0; d < 3; ++d) { if (t >= d) { ci[d] = *(const v4u*)(ur - (size_t)d * NU + UCI + c0); cc[d] = *(const v4u*)(ur - (size_t)d * NU + UCC + c0); } else { ci[d] = (v4u){0u, 0u, 0u, 0u}; cc[d] = ci[d]; } }
                float o[8];
#pragma unroll
                for (int j = 0; j < 4; ++j) {
                    float a0 = 0.f, a1 = 0.f;
#pragma unroll
                    for (int d = 0; d < 3; ++d) { const float w0 = cw[(2 - d) * 256 + c0 + 2 * j], w1 = cw[(2 - d) * 256 + c0 + 2 * j + 1];
                        a0 += w0 * (bflo(cc[d][j]) * bflo(ci[d][j])); a1 += w1 * (bfhi(cc[d][j]) * bfhi(ci[d][j])); }
                    o[2 * j] = bflo(cb[j]) * a0; o[2 * j + 1] = bfhi(cb[j]) * a1; }
                v4u w; w.x = pk2(o[0], o[1]); w.y = pk2(o[2], o[3]); w.z = pk2(o[4], o[5]); w.w = pk2(o[6], o[7]);
                *(v4u*)(MIX + (size_t)row * D + 768 + c0) = w;
            }
            __syncthreads();
            {
                float* BLl = (float*)lds;
                for (int i = tid; i < 4 * 2049; i += NTHR) BLl[(i & 3) * 2049 + (i >> 2)] = BL[i];
                __syncthreads();
                LAS unsigned char* vst = ldsl + 33280 + wave * 5120;
                const int ql = lane & 15, g4 = lane >> 4;
                for (int rep_ = 0; rep_ < 1 + ((args.pad >> 11) & 1); ++rep_)
                for (int uu = bx; uu < 512; uu += G) {
                    int u = uu; if (G == 256) { const int j = (uu & 255) >> 3; u = ((((uu >> 8) * 16 + (uu & 7) * 2 + (j >> 4)) << 4) | (j & 15)); }
                    const int c = u & 15, h = (u >> 4) & 3, b = u >> 6; const int i0 = 16 * (((uu / G) & 1) ? 7 - wave : wave); const size_t rowb = (size_t)b * SEQ;
                    const int tq = c + 16 * (i0 + ql);
                    const bf16* ub = U + rowb * NU + h * 64;
                    const bf16x8 qf0 = *(const bf16x8*)(ub + (size_t)tq * NU + UQ + 8 * g4), qf1 = *(const bf16x8*)(ub + (size_t)tq * NU + UQ + 8 * g4 + 32);
                    const float* blh = BLl + h * 2049;
                    const int t0 = c + 16 * i0, t1 = t0 + 240;
                    const int base0 = ((t0 >> 4) - 128) & ~31, mhi0 = t1 >> 4, np0 = ((mhi0 - base0) >> 5) + 1, pz0 = base0 < 0 ? ((-base0) >> 5) : 0;
                    const int base1 = ((t0 >> 2) - 128) & ~31, mhi1 = t1 >> 2, np1 = ((mhi1 - base1) >> 5) + 1, pz1 = base1 < 0 ? ((-base1) >> 5) : 0;
                    const int base2 = (t0 - 128) & ~31, mhi2 = t1, np2 = ((mhi2 - base2) >> 5) + 1, pz2 = base2 < 0 ? ((-base2) >> 5) : 0;
                    const int n0 = np0 - pz0, n1 = np1 - pz1, n2 = np2 - pz2, NT = n0 + n1 + n2;
                    bf16x8 kc[2][2], kn[2][2]; v4u vc[4], vn[4];
#define ATT_ITEM(it, LR, MB, MHI, RHO) do { if ((it) < n0) { LR = 4; MB = base0 + 32 * (np0 - 1 - (it)); MHI = mhi0; RHO = c; } \
                        else if ((it) < n0 + n1) { LR = 2; MB = base1 + 32 * (pz1 + (it) - n0); MHI = mhi1; RHO = c & 3; } \
                        else { LR = 0; MB = base2 + 32 * (pz2 + (it) - n0 - n1); MHI = mhi2; RHO = 0; } } while (0)
#define ATT_LOAD(K_, V_, LR, MB, MHI, RHO) do { _Pragma("unroll") for (int tau = 0; tau < 2; ++tau) { int mk = (MB) + 16 * tau + ql; mk = mk < 0 ? 0 : (mk > (MHI) ? (MHI) : mk); \
                            const bf16* kp = ub + (size_t)((mk << (LR)) + (RHO)) * NU + UK + 8 * g4; K_[tau][0] = *(const bf16x8*)kp; K_[tau][1] = *(const bf16x8*)(kp + 32); } \
                        _Pragma("unroll") for (int j = 0; j < 4; ++j) { int mv = (MB) + (lane >> 3) + 8 * j; mv = mv < 0 ? 0 : (mv > (MHI) ? (MHI) : mv); \
                            V_[j] = *(const v4u*)(ub + (size_t)((mv << (LR)) + (RHO)) * NU + UV + 8 * (lane & 7)); } } while (0)
                    int lr, mb, mhi, rho; ATT_ITEM(0, lr, mb, mhi, rho); ATT_LOAD(kc, vc, lr, mb, mhi, rho);
                    float m_ref = -INFINITY, l_run = 0.f; f32x4 o[4];
#pragma unroll
                    for (int d = 0; d < 4; ++d) o[d] = (f32x4){0.f, 0.f, 0.f, 0.f};
                    for (int it = 0; it < NT; ++it) {
                        int lrn = lr, mbn = mb, mhin = mhi, rhon = rho;
                        if (it + 1 < NT) { ATT_ITEM(it + 1, lrn, mbn, mhin, rhon); ATT_LOAD(kn, vn, lrn, mbn, mhin, rhon); }
                        { LAS unsigned char* vd = vst + (lane >> 3) * 160 + (lane & 7) * 16;
#pragma unroll
                          for (int j = 0; j < 4; ++j) *(LAS v4u*)(vd + j * 8 * 160) = vc[j]; }
                        f32x4 s[2];
#pragma unroll
                        for (int tau = 0; tau < 2; ++tau) { s[tau] = MFMA16(kc[tau][0], qf0, ((f32x4){0.f, 0.f, 0.f, 0.f})); s[tau] = MFMA16(kc[tau][1], qf1, s[tau]); }
                        const int d0 = (tq >> lr) - mb - 4 * g4, k0 = mb + 4 * g4; float tmax = -INFINITY;
#pragma unroll
                        for (int tau = 0; tau < 2; ++tau)
#pragma unroll
                            for (int rg = 0; rg < 4; ++rg) { const int dist = d0 - (16 * tau + rg); const bool ok = ((unsigned)dist <= 128u) && (k0 + 16 * tau + rg >= 0);
                                const float bias = blh[ok ? (dist << lr) : 0]; const float v = ok ? s[tau][rg] + bias : -INFINITY; s[tau][rg] = v; tmax = fmaxf(tmax, v); }
                        if (__any(tmax > m_ref + 16.0f)) {
                            float tm = fmaxf(tmax, __shfl_xor(tmax, 16)); tm = fmaxf(tm, __shfl_xor(tm, 32));
                            const float mn = fmaxf(m_ref, tm); const float ms = (mn == -INFINITY) ? 0.f : mn; const float alpha = __builtin_amdgcn_exp2f(m_ref - ms); m_ref = ms;
                            l_run *= alpha;
#pragma unroll
                            for (int d = 0; d < 4; ++d) o[d] = o[d] * alpha;
                        }
                        float ps = 0.f;
#pragma unroll
                        for (int tau = 0; tau < 2; ++tau)
#pragma unroll
                            for (int rg = 0; rg < 4; ++rg) { const float p = __builtin_amdgcn_exp2f(s[tau][rg] - m_ref); s[tau][rg] = p; ps += p; }
                        l_run += ps;
                        const bf16x8 pb = pack8(s[0], s[1]);
                        asm volatile("" ::: "memory");
#pragma unroll
                        for (int d = 0; d < 4; ++d) { const bf16x8 va = frag_trp(vst, 160, 16 * d, 0, lane); o[d] = MFMA16(va, pb, o[d]); }
                        asm volatile("" ::: "memory");
#pragma unroll
                        for (int tau = 0; tau < 2; ++tau) { kc[tau][0] = kn[tau][0]; kc[tau][1] = kn[tau][1]; }
#pragma unroll
                        for (int j = 0; j < 4; ++j) vc[j] = vn[j];
                        lr = lrn; mb = mbn; mhi = mhin; rho = rhon;
                    }
#undef ATT_ITEM
#undef ATT_LOAD
                    l_run += __shfl_xor(l_run, 16); l_run += __shfl_xor(l_run, 32); const float inv = 1.0f / l_run;
                    bf16* op = MIX + (rowb + tq) * D + h * 64 + 4 * g4;
#pragma unroll
                    for (int d = 0; d < 4; ++d) { pg8::u32x2 w; w.x = pg8::cvt_pk_bf16(o[d][0] * inv, o[d][1] * inv); w.y = pg8::cvt_pk_bf16(o[d][2] * inv, o[d][3] * inv); *(pg8::u32x2*)(op + 16 * d) = w; }
                }
            }
            for (int u = bx; u < 1024; u += G) {
                const int h = u & 3, n = (u >> 2) & 31, b = u >> 7;
                unsigned* cw = (unsigned*)(ws + WS_CTL) + CW_SC + (b * 4 + h) * 64; unsigned* tmo = (unsigned*)(ws + WS_CTL) + CW_TMO2; const unsigned need = 32u * (unsigned)(layer + 1);
                if (wave == 0) { unsigned sp = 0; while (__hip_atomic_load(cw, __ATOMIC_RELAXED, __HIP_MEMORY_SCOPE_AGENT) < need) { __builtin_amdgcn_s_sleep(2);
                        if ((++sp & 255u) == 0u) { if (__hip_atomic_load(tmo, __ATOMIC_RELAXED, __HIP_MEMORY_SCOPE_AGENT) != 0u) break; if (sp > (1u << 20)) { __hip_atomic_store(tmo, 1u, __ATOMIC_RELAXED, __HIP_MEMORY_SCOPE_AGENT); break; } } } }
                __syncthreads();
                if (tid < 256) { const int idx = n * 256 + tid; float cc[32], dd[32];
                    float* cp = CST + (size_t)(b * 128 + h) * 8192 + idx; const float* dp = DEC + (b * 128 + h) * 64 + (idx & 63);
#pragma unroll
                    for (int m2 = 0; m2 < 32; ++m2) { cc[m2] = __hip_atomic_load(cp + (size_t)m2 * 4 * 8192, __ATOMIC_RELAXED, __HIP_MEMORY_SCOPE_AGENT); dd[m2] = __hip_atomic_load(dp + m2 * 4 * 64, __ATOMIC_RELAXED, __HIP_MEMORY_SCOPE_AGENT); }
                    float S = 0.f;
#pragma unroll
                    for (int m2 = 0; m2 < 32; ++m2) { cp[(size_t)m2 * 4 * 8192] = S; S = dd[m2] * S + cc[m2]; } }
            }
        }
        SEAM(pb + 1);
        if (IN(pb + 3)) {
            const int tid = pg8::tid_here(), lane = tid & 63; (void)lane;
            float* cum = (float*)lds; float* seg = cum + 4096;
            LAS unsigned char* qel = ldsl + 18432;
            LAS unsigned char* kel = ldsl + 27648;
            LAS unsigned char* vvl = ldsl + 36864;
            LAS unsigned char* stl = ldsl + 54272;
            float* rsq = (float*)(lds + 72704);
            const float* gn = args.gla_g_norm + layer * 128;
            for (int rep_ = 0; rep_ < 1 + ((args.pad >> 8) & 1); ++rep_)
            for (int u = bx; u < 1024; u += G) {
                const int h = u & 3, n = (u >> 2) & 31, b = u >> 7; const size_t row0 = (size_t)b * SEQ + n * 64;
                const int tr = tid >> 3, c8 = tid & 7;
                const v4u qraw = *(const v4u*)(U + (row0 + tr) * NU + UGQ + h * 64 + 8 * c8), kraw = *(const v4u*)(U + (row0 + tr) * NU + UGK + h * 64 + 8 * c8);
                const v4u* vp = (const v4u*)(U + (row0 + tr) * NU + UGV + h * 128 + c8 * 16); const v4u x0 = vp[0], x1 = vp[1];
                const int sv = tid >> 2, skq = (tid & 3) * 16; const f32x4* sp = (const f32x4*)(CST + ((size_t)u * 128 + sv) * 64 + skq);
                const f32x4 a0 = sp[0], a1 = sp[1], a2 = sp[2], a3 = sp[3];
                { float c = 0.f; float lav[8]; const float* lap = (const float*)(ws + WS_LA) + (row0 + 8 * wave) * 256 + h * 64 + lane;
#pragma unroll
                  for (int i = 0; i < 8; ++i) lav[i] = lap[i * 256];
#pragma unroll
                  for (int i = 0; i < 8; ++i) { c += lav[i]; cum[(8 * wave + i) * 64 + lane] = c; }
                  seg[wave * 64 + lane] = c; }
                __syncthreads();
                { f32x4 offa = (f32x4){0.f, 0.f, 0.f, 0.f}, offb = offa; const int wq = tr >> 3;
#pragma unroll
                  for (int w = 0; w < 7; ++w) { if (w < wq) { offa += *(const f32x4*)(seg + w * 64 + 8 * c8); offb += *(const f32x4*)(seg + w * 64 + 8 * c8 + 4); } }
                  const f32x4 ca = *(const f32x4*)(cum + tr * 64 + 8 * c8) + offa, cb = *(const f32x4*)(cum + tr * 64 + 8 * c8 + 4) + offb;
                  float ea[8];
#pragma unroll
                  for (int j = 0; j < 4; ++j) { ea[j] = __expf(ca[j]); ea[4 + j] = __expf(cb[j]); }
                  v4u wq_, wk_;
                  wq_.x = pk2(bflo(qraw.x) * ea[0], bfhi(qraw.x) * ea[1]); wq_.y = pk2(bflo(qraw.y) * ea[2], bfhi(qraw.y) * ea[3]); wq_.z = pk2(bflo(qraw.z) * ea[4], bfhi(qraw.z) * ea[5]); wq_.w = pk2(bflo(qraw.w) * ea[6], bfhi(qraw.w) * ea[7]);
                  wk_.x = pk2(bflo(kraw.x) / ea[0], bfhi(kraw.x) / ea[1]); wk_.y = pk2(bflo(kraw.y) / ea[2], bfhi(kraw.y) / ea[3]); wk_.z = pk2(bflo(kraw.z) / ea[4], bfhi(kraw.z) / ea[5]); wk_.w = pk2(bflo(kraw.w) / ea[6], bfhi(kraw.w) / ea[7]);
                  *(LAS v4u*)(qel + tr * 144 + c8 * 16) = wq_; *(LAS v4u*)(kel + tr * 144 + c8 * 16) = wk_;
                  LAS v4u* vd = (LAS v4u*)(vvl + tr * 272 + c8 * 32); vd[0] = x0; vd[1] = x1;
                  v4u w0, w1; w0.x = pk2(a0[0], a0[1]); w0.y = pk2(a0[2], a0[3]); w0.z = pk2(a1[0], a1[1]); w0.w = pk2(a1[2], a1[3]);
                  w1.x = pk2(a2[0], a2[1]); w1.y = pk2(a2[2], a2[3]); w1.z = pk2(a3[0], a3[1]); w1.w = pk2(a3[2], a3[3]);
                  LAS v4u* sd = (LAS v4u*)(stl + sv * 144 + skq * 2); sd[0] = w0; sd[1] = w1; }
                __syncthreads();
                { const int tt = wave & 3, vh = wave >> 2, ql = lane & 15, g4 = lane >> 4; const int t = 16 * tt + ql;
                  const bf16x8 qb0 = frag_rm(qel, 144, 16 * tt, 0, lane), qb1 = frag_rm(qel, 144, 16 * tt, 32, lane);
                  f32x4 sT[4];
#pragma unroll
                  for (int st = 0; st < 4; ++st) { sT[st] = (f32x4){0.f, 0.f, 0.f, 0.f};
                      if (st <= tt) { sT[st] = MFMA16(frag_rm(kel, 144, 16 * st, 0, lane), qb0, sT[st]); sT[st] = MFMA16(frag_rm(kel, 144, 16 * st, 32, lane), qb1, sT[st]);
#pragma unroll
                          for (int rg = 0; rg < 4; ++rg) if (16 * st + 4 * g4 + rg > t) sT[st][rg] = 0.f; } }
                  const bf16x8 pb0 = pack8(sT[0], sT[1]), pb1 = pack8(sT[2], sT[3]);
                  f32x4 acc[4]; float ss = 0.f;
#pragma unroll
                  for (int vt = 0; vt < 4; ++vt) { const int V0 = 16 * (4 * vh + vt); f32x4 a = (f32x4){0.f, 0.f, 0.f, 0.f};
                      a = MFMA16(frag_trp(vvl, 272, V0, 0, lane), pb0, a); a = MFMA16(frag_trp(vvl, 272, V0, 32, lane), pb1, a);
                      a = MFMA16(frag_rm(stl, 144, V0, 0, lane), qb0, a); a = MFMA16(frag_rm(stl, 144, V0, 32, lane), qb1, a);
                      acc[vt] = a; ss += (a[0] * a[0] + a[1] * a[1]) + (a[2] * a[2] + a[3] * a[3]); }
                  ss += __shfl_xor(ss, 16); ss += __shfl_xor(ss, 32);
                  if (g4 == 0) rsq[(tt * 2 + vh) * 16 + ql] = ss;
                  __syncthreads();
                  const float rs = 1.0f / sqrtf((rsq[(tt * 2) * 16 + ql] + rsq[(tt * 2 + 1) * 16 + ql]) * (1.0f / 128.0f) + pg8::RMS_EPS);
#pragma unroll
                  for (int vt = 0; vt < 4; ++vt) { const int v0 = 16 * (4 * vh + vt) + 4 * g4;
                      const pg8::u32x2 gr = *(const pg8::u32x2*)(U + (row0 + t) * NU + UGR + h * 128 + v0); const f32x4 gv = *(const f32x4*)(gn + v0);
                      const float o0 = acc[vt][0] * rs * gv[0] * pg8::silu_f(bflo(gr.x)), o1 = acc[vt][1] * rs * gv[1] * pg8::silu_f(bfhi(gr.x));
                      const float o2 = acc[vt][2] * rs * gv[2] * pg8::silu_f(bflo(gr.y)), o3 = acc[vt][3] * rs * gv[3] * pg8::silu_f(bfhi(gr.y));
                      pg8::u32x2 w; w.x = pg8::cvt_pk_bf16(o0, o1); w.y = pg8::cvt_pk_bf16(o2, o3);
                      *(pg8::u32x2*)(MIX + (row0 + t) * D + 256 + h * 128 + v0) = w; } }
                __syncthreads();
            }
        }
        SEAM(pb + 3);
        if (IN(pb + 4)) {
            pg8::Gemm g{MIX, (const bf16*)(ws + WS_WOUT) + (size_t)layer * D * D, M, D, D, D}; pg8::StaticOrder S; S.init(M, D, G, bx);
            if constexpr (layer == 0) { pg8::EpiRes<true> E{args.x, XBD, SSD}; pg8::gemm_phase<pg8::EpiRes<true>, pg8::StaticOrder, true, true>(ldsl, g, S, E, noepi); }
            else { pg8::EpiRes<false> E{XB, XBD, SSD}; pg8::gemm_phase<pg8::EpiRes<false>, pg8::StaticOrder, true, true>(ldsl, g, S, E, noepi); }
        }
        SEAM(pb + 4);
        if (layer == 0) {
            if (IN(pb + 5)) {
                pg8::Gemm g{XB, W13, M, 2 * FF, D, D}; pg8::StaticOrder S; S.init(M, 2 * FF, G, bx);
                pg8::EpiGlu<false> E{H, FF, SS};
                pg8::gemm_phase<pg8::EpiGlu<false>, pg8::StaticOrder, true, true>(ldsl, g, S, E, noepi);
            }
            SEAM(pb + 5);
            if (IN(pb + 6)) {
                pg8::Gemm g{H, W2, M, D, FF, FF}; pg8::StaticOrder S; S.init(M, D, G, bx);
#if defined(PROBE_EPI) && PROBE_EPI
                if (dry) { pg8::EpiRes<false, PROBE_EPI> E{XB, XBD, SSD}; pg8::gemm_phase<pg8::EpiRes<false, PROBE_EPI>, pg8::StaticOrder, true, true>(ldsl, g, S, E, noepi); } else
#endif
                { pg8::EpiRes<false> E{XB, XBD, SSD}; pg8::gemm_phase<pg8::EpiRes<false>, pg8::StaticOrder, true, true>(ldsl, g, S, E, noepi); }
            }
            SEAM(pb + 6);
        } else {
            if (IN(pb + 5)) {
                const int tid = pg8::tid_here(), lane = tid & 63; (void)lane;
                float* wr_l = (float*)lds;
                int* cnt_l = (int*)(lds + 32768);
                const float* gf = args.g_ffn + D;
                for (int i = tid; i < D * 8; i += NTHR) wr_l[(i & 7) * D + (i >> 3)] = args.moe_router[i] * gf[i >> 3];
                if (tid < 8) cnt_l[tid] = 0;
                __syncthreads();
                for (int blk = bx; blk < 256; blk += G) {
                    if (blk != bx) { __syncthreads(); if (tid < 8) cnt_l[tid] = 0; __syncthreads(); }
                    v4u xpre[8][2];
#pragma unroll
                    for (int i = 0; i < 8; ++i) { const v4u* xr = (const v4u*)(XB + (size_t)(blk * 64 + wave * 8 + i) * D) + lane; xpre[i][0] = xr[0]; xpre[i][1] = xr[64]; }
#pragma unroll
                    for (int i = 0; i < 8; ++i) { const int m = blk * 64 + wave * 8 + i; float lg[8];
#pragma unroll
                        for (int e = 0; e < 8; ++e) lg[e] = 0.f;
#pragma unroll
                        for (int j = 0; j < 2; ++j) { const v4u xw = xpre[i][j]; const int k0 = 8 * (lane + 64 * j);
                            const f32x4 va = (f32x4){bflo(xw.x), bfhi(xw.x), bflo(xw.y), bfhi(xw.y)}, vb = (f32x4){bflo(xw.z), bfhi(xw.z), bflo(xw.w), bfhi(xw.w)};
#pragma unroll
                            for (int e = 0; e < 8; ++e) { const f32x4 w0 = *(const f32x4*)(wr_l + e * D + k0), w1 = *(const f32x4*)(wr_l + e * D + k0 + 4);
                                lg[e] += ((va[0] * w0[0] + va[1] * w0[1]) + (va[2] * w0[2] + va[3] * w0[3])) + ((vb[0] * w1[0] + vb[1] * w1[1]) + (vb[2] * w1[2] + vb[3] * w1[3])); } }
                        const float rs = pg8::rstd_of(SS + (size_t)m * 16);
#pragma unroll
                        for (int e = 0; e < 8; ++e) lg[e] = wave_sum(lg[e]) * rs;
                        int i0 = 0; float v0 = lg[0];
#pragma unroll
                        for (int e = 1; e < 8; ++e) if (lg[e] > v0) { v0 = lg[e]; i0 = e; }
                        int i1 = -1; float v1 = -INFINITY;
#pragma unroll
                        for (int e = 0; e < 8; ++e) if (e != i0 && lg[e] > v1) { v1 = lg[e]; i1 = e; }
                        const float w1 = 1.0f / (1.0f + __expf(v0 - v1)), w0 = 1.0f - w1;
                        if (lane == 0) { TOPI[m * 2] = i0; TOPI[m * 2 + 1] = i1; TOPW[m * 2] = w0; TOPW[m * 2 + 1] = w1; RS3[m] = rs; atomicAdd(&cnt_l[i0], 1); atomicAdd(&cnt_l[i1], 1); } }
                    __syncthreads();
                    if (tid < 8) CNT[blk * 8 + tid] = cnt_l[tid];
                }
            }
            SEAM(pb + 5);
            if (IN(pb + 6)) {
                const int tid = pg8::tid_here(), lane = tid & 63; (void)lane;
                int* base_l = (int*)lds;
                int* pre_l = base_l + 8;
                int* tot_l = pre_l + 8;
                int* pos_l = tot_l + 8;
                int* ent_l = pos_l + 128;
                for (int blk = bx; blk < 256; blk += G) {
                    __syncthreads();
                    if (tid < 8) { tot_l[tid] = 0; pre_l[tid] = 0; }
                    if (tid < 128) ent_l[tid] = TOPI[blk * 128 + tid];
                    __syncthreads();
                    { const int g2 = tid >> 1, e0 = (tid & 1) * 4; const int4 c = *(const int4*)(CNT + g2 * 8 + e0);
                      atomicAdd(&tot_l[e0], c.x); atomicAdd(&tot_l[e0 + 1], c.y); atomicAdd(&tot_l[e0 + 2], c.z); atomicAdd(&tot_l[e0 + 3], c.w);
                      if (g2 < blk) { atomicAdd(&pre_l[e0], c.x); atomicAdd(&pre_l[e0 + 1], c.y); atomicAdd(&pre_l[e0 + 2], c.z); atomicAdd(&pre_l[e0 + 3], c.w); } }
                    __syncthreads();
                    if (tid == 0) { int bs = 0; for (int e = 0; e < 8; ++e) { base_l[e] = bs; bs += (tot_l[e] + 255) & ~255; } }
                    __syncthreads();
                    if (tid < 128) { const int e = ent_l[tid]; int rank = 0; for (int j = 0; j < tid; ++j) rank += (ent_l[j] == e) ? 1 : 0;
                        const int p = base_l[e] + pre_l[e] + rank; pos_l[tid] = p; POS[blk * 128 + tid] = p; ROWGATE[p] = TOPW[blk * 128 + tid]; ROWRS[p] = RS3[blk * 64 + (tid >> 1)]; }
                    if (blk == 0) {
                        for (int e = 0; e < 8; ++e) { const int npe = (tot_l[e] + 255) >> 8; for (int p = base_l[e] + tot_l[e] + tid; p < base_l[e] + npe * 256; p += NTHR) { ROWGATE[p] = 0.f; ROWRS[p] = 0.f; } }
                        if (tid == 0) { int np = 0; for (int e = 0; e < 8; ++e) { const int npe = (tot_l[e] + 255) >> 8; for (int j = 0; j < npe; ++j) PANE[np++] = e; } PANE[MAXPAN] = np; } }
                    __syncthreads();
                    for (int i = 0; i < 16; ++i) { const int sl = wave * 16 + i; const int m = blk * 64 + (sl >> 1); const int p = pos_l[sl];
                        const v4u* s = (const v4u*)(XB + (size_t)m * D) + lane; v4u* d = (v4u*)(XS + (size_t)p * D) + lane; d[0] = s[0]; d[64] = s[64]; }
                }
            }
            SEAM(pb + 6);
            if (IN(pb + 7)) {
                pg8::Gemm g{XS, WE13, MAXROWS, 2 * FE, D, D}; pg8::MoeOrder S{PANE, PANE[MAXPAN], 28, 4, G, bx};
                pg8::EpiGlu<true> E{HE, FE, ROWRS};
                pg8::gemm_phase<pg8::EpiGlu<true>, pg8::MoeOrder, true, true>(ldsl, g, S, E, noepi);
            }
            SEAM(pb + 7);
            if (IN(pb + 8)) {
                const int tid = pg8::tid_here(), lane = tid & 63; (void)lane;
                unsigned* scr = (unsigned*)(lds + wave * 8704);
                constexpr int T_J = 56 * 16;
                for (int it = gw; it < 8 * T_J; it += NGW) { const int e = it / T_J, r = it % T_J;
                    transpose_tile(args.moe_w2 + (size_t)e * FE * D, D, 64 * (r / 16), 64 * (r % 16), WE2 + (size_t)e * D * FE, FE, 64 * (r % 16), nullptr, scr, lane); }
            }
            SEAM(pb + 8);
            if (IN(pb + 9)) {
                const int npan = PANE[MAXPAN]; int npf = ((npan * 4) / G) * G / 4; if (npan - npf > 8 || npf == 0) npf = npan;
                { pg8::Gemm g{HE, WE2, MAXROWS, D, FE, FE}; pg8::MoeOrder S{PANE, npf, 4, 8, G, bx};
                  pg8::EpiMoeDown E{Y, ROWGATE};
                  pg8::gemm_phase<pg8::EpiMoeDown, pg8::MoeOrder, true, true>(ldsl, g, S, E, noepi); }
                if (npan > npf) { __syncthreads();
                  pg8::Gemm g{HE, WE2, MAXROWS, D, 896, FE}; pg8::MoeTailOrder S{PANE, npf, npan - npf, G, bx};
                  pg8::EpiMoeDownPart E{(float*)(ws + WS_YT), ROWGATE, npf * 256};
                  pg8::gemm_phase<pg8::EpiMoeDownPart, pg8::MoeTailOrder, true, true>(ldsl, g, S, E, noepi); }
            }
            SEAM(pb + 9);
            if (IN(pb + 10)) {
                const int tid = pg8::tid_here(), lane = tid & 63; (void)lane;
                const int npan_f = PANE[MAXPAN]; int npf_f = ((npan_f * 4) / G) * G / 4; if (npan_f - npf_f > 8 || npf_f == 0) npf_f = npan_f; const int tail0 = npf_f * 256;
                for (int rep_ = 0; rep_ < 1 + ((args.pad >> 12) & 1); ++rep_)
                for (int m = gw; m < M; m += NGW) {
                    f32x4* xr = (f32x4*)(X + (size_t)m * D) + lane; const int p0 = POS[m * 2], p1 = POS[m * 2 + 1];
                    const unsigned long long* xb = (const unsigned long long*)(XB + (size_t)m * D) + lane;
                    f32x4 v[4]; float s = 0.f;
#pragma unroll
                    for (int j = 0; j < 4; ++j) { const unsigned long long xw = xb[64 * j]; v[j] = (f32x4){bflo((unsigned)xw), bfhi((unsigned)xw), bflo((unsigned)(xw >> 32)), bfhi((unsigned)(xw >> 32))}; }
#pragma unroll
                    for (int sl = 0; sl < 2; ++sl) { const int p = sl ? p1 : p0;
                        if (p < tail0) { const unsigned long long* yp = (const unsigned long long*)(Y + (size_t)p * D) + lane;
#pragma unroll
                            for (int j = 0; j < 4; ++j) { const unsigned long long a = yp[64 * j]; v[j] += (f32x4){bflo((unsigned)a), bfhi((unsigned)a), bflo((unsigned)(a >> 32)), bfhi((unsigned)(a >> 32))}; } }
                        else { const f32x4* tp = (const f32x4*)((const float*)(ws + WS_YT) + (size_t)(p - tail0) * D) + lane;
#pragma unroll
                            for (int kq = 0; kq < 4; ++kq)
#pragma unroll
                                for (int j = 0; j < 4; ++j) v[j] += tp[(size_t)kq * 2048 * (D / 4) + 64 * j]; } }
#pragma unroll
                    for (int j = 0; j < 4; ++j) s += (v[j][0] * v[j][0] + v[j][1] * v[j][1]) + (v[j][2] * v[j][2] + v[j][3] * v[j][3]);
                    const float rs = 1.0f / sqrtf(wave_sum(s) * (1.0f / D) + pg8::RMS_EPS);
                    const f32x4* gf = (const f32x4*)args.g_final + lane;
#pragma unroll
                    for (int j = 0; j < 4; ++j) (dry ? (f32x4*)((float*)(ws + WS_HE) + (size_t)m * D) + lane : xr)[64 * j] = v[j] * rs * gf[64 * j];
                }
            }
        }
}

__global__ void __launch_bounds__(NTHR, 2) hybrid_fwd(Args args) {
    extern __shared__ __attribute__((aligned(16))) unsigned char lds[];
    LAS unsigned char* ldsl = (LAS unsigned char*)lds;
    volatile LAS unsigned* MISC = (volatile LAS unsigned*)(ldsl + MISC_OFF);
    const int tid = threadIdx.x, lane = tid & 63, wave = __builtin_amdgcn_readfirstlane(tid >> 6);
    const int G = gridDim.x; const int bx = blockIdx.x;
    const int gw = bx * NWAVES + wave, NGW = G * NWAVES;
    unsigned char* ws = args.ws;
    for (int u = tid; u < (LDS_BYTES - LDSCTL_OFF) / 4; u += NTHR) ((LAS unsigned*)(ldsl + LDSCTL_OFF))[u] = 0u;
    __syncthreads();
    XcdBarrier bar; bar.bar = (unsigned*)(ws + WS_CTL) + CW_BAR + args.li * XCD_BAR_WORDS; bar.x = 0; bar.st = nullptr;
    if (MK_N_LAUNCHES == 1) bar = xcd_barrier_post((unsigned*)(ws + WS_CTL) + CW_BAR + args.li * XCD_BAR_WORDS, MISC + 8);
    const int lo = args.ph_lo, hi = args.ph_hi;

    WS_PTRS

    if (IN(0)) {
        unsigned* scr = (unsigned*)(lds + wave * 8704);
        constexpr int T_A = 16 * 36, T_B = 16 * 12, T_D = 16 * 16, T_L = T_A + T_B + T_D;
        constexpr int T_F = 16 * 44, T_G = 44 * 16, T_E = 16 * 56;
        constexpr int NT0 = 2 * T_L + 2 * T_F + T_G + 16 * T_E;
        for (int it = gw; it < NT0; it += NGW) {
            int r = it;
            if (r < 2 * T_L) { const int l = r / T_L; r -= l * T_L; const float* win = args.w_mix_in + (size_t)l * D * INC; const float* gm = args.g_mix + l * D;
                bf16* WIN = (bf16*)(ws + WS_WIN) + (size_t)l * NU * D;
                if (r < T_A) { transpose_tile(win, INC, 64 * (r / 36), 64 * (r % 36), WIN, D, 64 * (r % 36), gm, scr, lane); continue; } r -= T_A;
                if (r < T_B) { transpose_tile(win, INC, 64 * (r / 12), 2320 + 64 * (r % 12), WIN, D, 2304 + 64 * (r % 12), gm, scr, lane); continue; } r -= T_B;
                transpose_tile(args.w_mix_out + (size_t)l * D * D, D, 64 * (r / 16), 64 * (r % 16), (bf16*)(ws + WS_WOUT) + (size_t)l * D * D, D, 64 * (r % 16), nullptr, scr, lane); continue; }
            r -= 2 * T_L;
            if (r < 2 * T_F) { const int w3 = r / T_F; r -= w3 * T_F; const int n0 = 64 * (r % 44);
                transpose_tile(w3 ? args.ffn_w3 : args.ffn_w1, FF, 64 * (r / 44), n0, W13, D, (n0 >> 7) * 256 + (n0 & 127) + 128 * w3, args.g_ffn, scr, lane); continue; }
            r -= 2 * T_F;
            if (r < T_G) { transpose_tile(args.ffn_w2, D, 64 * (r / 16), 64 * (r % 16), W2, FF, 64 * (r % 16), nullptr, scr, lane); continue; }
            r -= T_G;
            { const int ew = r / T_E; r -= ew * T_E; const int e = ew >> 1, w3 = ew & 1; const int n0 = 64 * (r % 56);
              transpose_tile((w3 ? args.moe_w3 : args.moe_w1) + (size_t)e * D * FE, FE, 64 * (r / 56), n0, WE13 + (size_t)e * 2 * FE * D, D, (n0 >> 7) * 256 + (n0 & 127) + 128 * w3, args.g_ffn + D, scr, lane); }
        }
        for (int m = gw; m < M; m += NGW) {
            const f32x4* xr = (const f32x4*)(args.x + (size_t)m * D) + lane; float s = 0.f;
            unsigned long long* o8 = (unsigned long long*)(XB + (size_t)m * D) + lane;
#pragma unroll
            for (int j = 0; j < 4; ++j) { const f32x4 v = xr[64 * j]; s += (v[0] * v[0] + v[1] * v[1]) + (v[2] * v[2] + v[3] * v[3]);
                o8[64 * j] = (unsigned long long)pk2(v[0], v[1]) | ((unsigned long long)pk2(v[2], v[3]) << 32); }
            s = wave_sum(s);
            if (lane < 16) SS[(size_t)m * 16 + lane] = (lane == 0) ? s : 0.f;
        }
        for (int i = bx * NTHR + tid; i < 2049 * 4; i += G * NTHR) { const int d = i >> 2, h = i & 3; BL[i] = args.rel_bias[rel_bucket(d) * 4 + h] * LOG2E; }
        for (int i = bx * NTHR + tid; i < 2 * 16 * D; i += G * NTHR) { const int k = i & (D - 1), r = (i >> 10) & 15, l = i >> 14;
            ((bf16*)(ws + WS_WGLR))[i] = (bf16)f2bf(args.g_mix[l * D + k] * args.w_mix_in[((size_t)l * D + k) * INC + 2304 + r]); }
    }
    SEAM(0);

    Ctx c; c.args = args; c.tid = tid; c.lane = lane; c.wave = wave; c.G = G; c.bx = bx; c.gw = gw; c.NGW = NGW; c.lo = lo; c.hi = hi; c.bar = bar;
    layer_phases<0>(c, lds);
    layer_phases<1>(c, lds);
}
#undef IN
#undef SEAM
#undef GRID_BAR


extern "C" void kernel_launch(void* const* d_in, const int* in_sizes, int n_in, void* d_out, int out_size, void* d_ws, size_t ws_size, hipStream_t stream) {
    static int grid = 0;
    if (grid == 0) {
        if (n_in != 18 || in_sizes[0] != M * D || out_size != M * D || ws_size < WS_END) { fprintf(stderr, "kernel_launch: unexpected shapes / workspace (%zu < %zu)\n", ws_size, (size_t)WS_END); grid = -1; return; }
        int dev = 0, cus = 0, per_cu = 0;
        if (hipGetDevice(&dev) != hipSuccess || hipDeviceGetAttribute(&cus, hipDeviceAttributeMultiprocessorCount, dev) != hipSuccess) { grid = -1; return; }
        if (hipFuncSetAttribute((const void*)hybrid_fwd, hipFuncAttributeMaxDynamicSharedMemorySize, LDS_BYTES) != hipSuccess) { fprintf(stderr, "kernel_launch: hipFuncSetAttribute failed\n"); grid = -1; return; }
        if (hipOccupancyMaxActiveBlocksPerMultiprocessor(&per_cu, (const void*)hybrid_fwd, NTHR, LDS_BYTES) != hipSuccess || per_cu < 1) { fprintf(stderr, "kernel_launch: occupancy query says %d\n", per_cu); }
        (void)hipGetLastError();
        grid = cus;
    }
    if (grid < 0) return;
    if (hipMemsetAsync((char*)d_ws + WS_CTL, 0, CTL_ZERO_BYTES, stream) != hipSuccess) return;
    Args a{};
    const float** f = (const float**)&a;
    for (int i = 0; i < 18; ++i) f[i] = (const float*)d_in[i];
    a.out = (float*)d_out; a.ws = (unsigned char*)d_ws;
    if (MK_N_LAUNCHES == 1) {
#ifndef PROBE_MODE
#define PROBE_MODE 0
#endif
#ifdef PROBE_PHASE
        const int cuts[4][2] = {{0, PROBE_PHASE}, {PROBE_PHASE, PROBE_PHASE + 1}, {PROBE_PHASE, 64}, {0, 0}};
        for (int li = 0; li < 3; ++li) { a.ph_lo = cuts[li][0]; a.ph_hi = cuts[li][1]; a.li = li; a.pad = (li == 1) ? PROBE_MODE : 0; hipLaunchKernelGGL(hybrid_fwd, dim3(grid), dim3(NTHR), LDS_BYTES, stream, a); }
#else
        a.ph_lo = 0; a.ph_hi = 64; a.li = 0;
#ifdef PROBE_REP
        a.pad = PROBE_REP << 8;
#endif
        hipLaunchKernelGGL(hybrid_fwd, dim3(grid), dim3(NTHR), LDS_BYTES, stream, a);
#endif
    }
    else {
        static const int phases[] = {0, 1, 2, 3, 4, 5, 6, 7, 17, 18, 19, 20, 21, 22, 23, 24, 25, 26, 27};
        for (int p : phases) { a.ph_lo = p; a.ph_hi = p + 1; hipLaunchKernelGGL(hybrid_fwd, dim3(grid), dim3(NTHR), LDS_BYTES, stream, a); }
    }
}
```

```cpp
#include <hip/hip_runtime.h>
#include <cstdio>
#include <cstdint>

#ifndef MK_N_LAUNCHES
#define MK_N_LAUNCHES 1
#endif

namespace pg8 {
#define PG8_LAS __attribute__((address_space(3)))
__device__ __forceinline__ int tid_here() { int t = threadIdx.x; asm volatile("" : "+v"(t)); return t; }
typedef unsigned short bf16_t;
typedef short bf16x8 __attribute__((ext_vector_type(8)));
typedef float f32x4 __attribute__((ext_vector_type(4)));
typedef unsigned u32x4 __attribute__((ext_vector_type(4)));
typedef unsigned u32x2 __attribute__((ext_vector_type(2)));
constexpr int BM = 256, BK = 64, HALF = 128, HTB = HALF * BK * 2, STAGE_BYTES = 8 * HTB, NXCD = 8, WGM = 8;

__host__ __device__ __forceinline__ int lds_byte(int r, int c) { const int st = (r >> 4) * 2 + (c >> 5), rr = r & 15, cc = c & 31, ob = rr * 64 + cc * 2; return st * 1024 + (ob ^ (((ob >> 9) & 1) << 5)); }
__host__ __device__ __forceinline__ void stage_rc(int b, int& R, int& C) { const int st = b / 1024, sb = b % 1024, swz = sb ^ (((sb >> 9) & 1) << 5); R = (st >> 1) * 16 + swz / 64; C = (st & 1) * 32 + (swz % 64) / 2; }
__host__ __device__ __forceinline__ int perm32(int rho) { const int n = rho >> 4, i = rho & 15; return 8 * (i >> 2) + 4 * n + (i & 3); }

struct Unit { int pm, pn, ko; };
struct Gemm { const bf16_t* A; const bf16_t* Bt; int M, N, K, ld; };

struct StaticOrder {
    int nM, nN, nwg, G, c;
    __host__ __device__ void init(int M, int N, int G_, int c_) { nM = M / BM; nN = N / BM; nwg = nM * nN; G = G_; c = c_; }
    __host__ __device__ bool next(int i, Unit& u) const {
        const long L = (long)i * G + c; if (L >= nwg) return false;
        int wgid = (int)L; { const int q = nwg / NXCD, r = nwg % NXCD, xcd = wgid % NXCD, off = wgid / NXCD; wgid = (xcd < r ? xcd * (q + 1) : r * (q + 1) + (xcd - r) * q) + off; }
        const int nig = WGM * nN, gid = wgid / nig, fm = gid * WGM, gsz = (nM - fm) < WGM ? (nM - fm) : WGM;
        u.pm = fm + ((wgid % nig) % gsz); u.pn = (wgid % nig) / gsz; u.ko = 0; return true;
    }
    __device__ __forceinline__ void a_ready(const Unit&) const {}
    __device__ __forceinline__ void done(const Unit&) const {}
};
struct MoeOrder {
    const int* panel_e; int npan, NT, GP, G, c;
    __device__ bool next(int i, Unit& u) const {
        const int nwg = npan * NT; const long L = (long)i * G + c; if (L >= nwg) return false;
        int wgid = (int)L; { const int q = nwg / NXCD, r = nwg % NXCD, xcd = wgid % NXCD, off = wgid / NXCD; wgid = (xcd < r ? xcd * (q + 1) : r * (q + 1) + (xcd - r) * q) + off; }
        const int nig = GP * NT, grp = wgid / nig, fm = grp * GP, gsz = (npan - fm) < GP ? (npan - fm) : GP; const int rr = wgid % nig;
        const int p = fm + rr % gsz; u.pm = p; u.pn = panel_e[p] * NT + rr / gsz; u.ko = 0; return true;
    }
    __device__ __forceinline__ void a_ready(const Unit&) const {}
    __device__ __forceinline__ void done(const Unit&) const {}
};

struct MoeTailOrder {
    const int* panel_e; int p0, ntp, G, c;
    __device__ bool next(int i, Unit& u) const {
        const long L = (long)i * G + c; if (L >= (long)ntp * 16) return false;
        const int kq = (int)L & 3, r = (int)L >> 2, p = p0 + (r >> 2); u.pm = p; u.pn = panel_e[p] * 4 + (r & 3); u.ko = kq * 896 * 2; return true;
    }
    __device__ __forceinline__ void a_ready(const Unit&) const {}
    __device__ __forceinline__ void done(const Unit&) const {}
};
__device__ __forceinline__ unsigned cvt_pk_bf16(float lo, float hi) { unsigned r; asm volatile("v_cvt_pk_bf16_f32 %0, %1, %2" : "=v"(r) : "v"(lo), "v"(hi)); return r; }

constexpr float RMS_EPS = 1e-6f;
__device__ __forceinline__ float rstd_of(const float* ss16) {
    const f32x4 a = *(const f32x4*)ss16, b = *(const f32x4*)(ss16 + 4), c = *(const f32x4*)(ss16 + 8), d = *(const f32x4*)(ss16 + 12);
    const float s = ((a[0] + a[1]) + (a[2] + a[3])) + ((b[0] + b[1]) + (b[2] + b[3])) + ((c[0] + c[1]) + (c[2] + c[3])) + ((d[0] + d[1]) + (d[2] + d[3]));
    return 1.0f / sqrtf(s * (1.0f / 1024.0f) + RMS_EPS);
}
__device__ __forceinline__ void rstd4(const float* SS, int row0, float (&rs)[4]) {
    f32x4 p[4][4];
#pragma unroll
    for (int m = 0; m < 4; ++m)
#pragma unroll
        for (int q = 0; q < 4; ++q) p[m][q] = *(const f32x4*)(SS + (size_t)(row0 + 16 * m) * 16 + 4 * q);
    asm volatile("" : "+v"(p[0][0]), "+v"(p[0][1]), "+v"(p[0][2]), "+v"(p[0][3]), "+v"(p[1][0]), "+v"(p[1][1]), "+v"(p[1][2]), "+v"(p[1][3]),
                      "+v"(p[2][0]), "+v"(p[2][1]), "+v"(p[2][2]), "+v"(p[2][3]), "+v"(p[3][0]), "+v"(p[3][1]), "+v"(p[3][2]), "+v"(p[3][3]));
#pragma unroll
    for (int m = 0; m < 4; ++m) { const f32x4 a = p[m][0], b = p[m][1], c = p[m][2], d = p[m][3];
        const float s = ((a[0] + a[1]) + (a[2] + a[3])) + ((b[0] + b[1]) + (b[2] + b[3])) + ((c[0] + c[1]) + (c[2] + c[3])) + ((d[0] + d[1]) + (d[2] + d[3]));
        rs[m] = 1.0f / sqrtf(s * (1.0f / 1024.0f) + RMS_EPS); }
}
__device__ __forceinline__ float logsig16(float x) { return ((x < 0.f ? x : 0.f) - __logf(1.0f + __expf(-fabsf(x)))) * (1.0f / 16.0f); }
__device__ __forceinline__ float silu_f(float a) { return a / (1.0f + __expf(-a)); }

struct EpiU {
    static constexpr bool PERM = true, AFTER_DRAIN = false;
    bf16_t* U; int ldu; const float* SS; float qs;
    __device__ __forceinline__ void operator()(const f32x4 (&acc)[2][2][4][2], const Unit& u, int wr, int wc, int fr, int fq) const {
        const int row0 = u.pm * BM + wr * 64 + fr, col0 = u.pn * BM + wc * 32 + 8 * fq;
        const float sc = (u.pn == 0) ? qs : ((u.pn == 3) ? 0.125f : 1.0f);
#pragma unroll
        for (int ai = 0; ai < 2; ++ai) { float rs4[4]; rstd4(SS, row0 + ai * HALF, rs4);
#pragma unroll
            for (int m = 0; m < 4; ++m) { const int row = row0 + ai * HALF + m * 16; const float rs = rs4[m] * sc;
                bf16_t* rowp = U + (size_t)row * ldu + col0;
#pragma unroll
                for (int bj = 0; bj < 2; ++bj) { const f32x4 v0 = acc[ai][bj][m][0] * rs, v1 = acc[ai][bj][m][1] * rs;
                    u32x4 w; w.x = cvt_pk_bf16(v0[0], v0[1]); w.y = cvt_pk_bf16(v0[2], v0[3]); w.z = cvt_pk_bf16(v1[0], v1[1]); w.w = cvt_pk_bf16(v1[2], v1[3]);
                    *(u32x4*)(rowp + bj * HALF) = w; } } }
    }
};
template <bool IN_F32, int PM = 0> struct EpiRes {
    static constexpr bool PERM = true, AFTER_DRAIN = false;
    const void* Xin; bf16_t* XB; float* SS;
    __device__ __forceinline__ void operator()(const f32x4 (&acc)[2][2][4][2], const Unit& u, int wr, int wc, int fr, int fq) const {
        const int row0 = u.pm * BM + wr * 64 + fr, col0 = u.pn * BM + wc * 32 + 8 * fq;
        if constexpr (IN_F32) {
#pragma unroll
            for (int ai = 0; ai < 2; ++ai) { f32x4 xo[4][2][2];
#pragma unroll
                for (int m = 0; m < 4; ++m)
#pragma unroll
                    for (int bj = 0; bj < 2; ++bj) { const float* p = (const float*)Xin + (size_t)(row0 + ai * HALF + m * 16) * 1024 + col0 + bj * HALF; xo[m][bj][0] = *(const f32x4*)p; xo[m][bj][1] = *(const f32x4*)(p + 4); }
                asm volatile("" : "+v"(xo[0][0][0]), "+v"(xo[0][0][1]), "+v"(xo[0][1][0]), "+v"(xo[0][1][1]), "+v"(xo[1][0][0]), "+v"(xo[1][0][1]), "+v"(xo[1][1][0]), "+v"(xo[1][1][1]),
                                  "+v"(xo[2][0][0]), "+v"(xo[2][0][1]), "+v"(xo[2][1][0]), "+v"(xo[2][1][1]), "+v"(xo[3][0][0]), "+v"(xo[3][0][1]), "+v"(xo[3][1][0]), "+v"(xo[3][1][1]));
#pragma unroll
                for (int m = 0; m < 4; ++m) { const int row = row0 + ai * HALF + m * 16; float ssum = 0.f;
#pragma unroll
                    for (int bj = 0; bj < 2; ++bj) { const f32x4 v0 = xo[m][bj][0] + acc[ai][bj][m][0], v1 = xo[m][bj][1] + acc[ai][bj][m][1];
                        u32x4 w; w.x = cvt_pk_bf16(v0[0], v0[1]); w.y = cvt_pk_bf16(v0[2], v0[3]); w.z = cvt_pk_bf16(v1[0], v1[1]); w.w = cvt_pk_bf16(v1[2], v1[3]);
                        *(u32x4*)(XB + (size_t)row * 1024 + col0 + bj * HALF) = w;
                        ssum += ((v0[0] * v0[0] + v0[1] * v0[1]) + (v0[2] * v0[2] + v0[3] * v0[3])) + ((v1[0] * v1[0] + v1[1] * v1[1]) + (v1[2] * v1[2] + v1[3] * v1[3])); }
                    ssum += __shfl_xor(ssum, 16); ssum += __shfl_xor(ssum, 32);
                    if (fq == 0) SS[(size_t)row * 16 + u.pn * 4 + wc] = ssum; } }
        } else {
            u32x4 xo[2][4][2];
#pragma unroll
            for (int ai = 0; ai < 2; ++ai)
#pragma unroll
                for (int m = 0; m < 4; ++m)
#pragma unroll
                    for (int bj = 0; bj < 2; ++bj) xo[ai][m][bj] = *(const u32x4*)((const bf16_t*)Xin + (size_t)(row0 + ai * HALF + m * 16) * 1024 + col0 + bj * HALF);
            asm volatile("" : "+v"(xo[0][0][0]), "+v"(xo[0][0][1]), "+v"(xo[0][1][0]), "+v"(xo[0][1][1]), "+v"(xo[0][2][0]), "+v"(xo[0][2][1]), "+v"(xo[0][3][0]), "+v"(xo[0][3][1]),
                              "+v"(xo[1][0][0]), "+v"(xo[1][0][1]), "+v"(xo[1][1][0]), "+v"(xo[1][1][1]), "+v"(xo[1][2][0]), "+v"(xo[1][2][1]), "+v"(xo[1][3][0]), "+v"(xo[1][3][1]));
#pragma unroll
            for (int ai = 0; ai < 2; ++ai)
#pragma unroll
                for (int m = 0; m < 4; ++m) { const int row = row0 + ai * HALF + m * 16; float ssum = 0.f;
#pragma unroll
                    for (int bj = 0; bj < 2; ++bj) { const u32x4 x = xo[ai][m][bj]; f32x4 v0, v1;
                        v0[0] = __builtin_bit_cast(float, x.x << 16) + acc[ai][bj][m][0][0]; v0[1] = __builtin_bit_cast(float, x.x & 0xffff0000u) + acc[ai][bj][m][0][1];
                        v0[2] = __builtin_bit_cast(float, x.y << 16) + acc[ai][bj][m][0][2]; v0[3] = __builtin_bit_cast(float, x.y & 0xffff0000u) + acc[ai][bj][m][0][3];
                        v1[0] = __builtin_bit_cast(float, x.z << 16) + acc[ai][bj][m][1][0]; v1[1] = __builtin_bit_cast(float, x.z & 0xffff0000u) + acc[ai][bj][m][1][1];
                        v1[2] = __builtin_bit_cast(float, x.w << 16) + acc[ai][bj][m][1][2]; v1[3] = __builtin_bit_cast(float, x.w & 0xffff0000u) + acc[ai][bj][m][1][3];
                        u32x4 w; w.x = cvt_pk_bf16(v0[0], v0[1]); w.y = cvt_pk_bf16(v0[2], v0[3]); w.z = cvt_pk_bf16(v1[0], v1[1]); w.w = cvt_pk_bf16(v1[2], v1[3]);
                        if constexpr (!(PM & 8)) *(u32x4*)(XB + (size_t)row * 1024 + col0 + bj * HALF) = w;
                        ssum += ((v0[0] * v0[0] + v0[1] * v0[1]) + (v0[2] * v0[2] + v0[3] * v0[3])) + ((v1[0] * v1[0] + v1[1] * v1[1]) + (v1[2] * v1[2] + v1[3] * v1[3])); }
                    if constexpr (!(PM & 16)) { ssum += __shfl_xor(ssum, 16); ssum += __shfl_xor(ssum, 32); }
                    if constexpr (!(PM & 4)) { if (fq == 0) SS[(size_t)row * 16 + u.pn * 4 + wc] = ssum; }
                    if constexpr ((PM & 12) == 12) asm volatile("" :: "v"(ssum)); }
        }
    }
};
template <bool MOE> struct EpiGlu {
    static constexpr bool PERM = true, AFTER_DRAIN = false;
    bf16_t* O; int ldo; const float* SS;
    __device__ __forceinline__ void operator()(const f32x4 (&acc)[2][2][4][2], const Unit& u, int wr, int wc, int fr, int fq) const {
        const int row0 = u.pm * BM + wr * 64 + fr; const int pnl = MOE ? (u.pn % 28) : u.pn; const int col0 = pnl * HALF + wc * 32 + 8 * fq;
#pragma unroll
        for (int ai = 0; ai < 2; ++ai) { float rs4[4];
            if constexpr (MOE) {
#pragma unroll
                for (int m = 0; m < 4; ++m) rs4[m] = SS[row0 + ai * HALF + m * 16];
                asm volatile("" : "+v"(rs4[0]), "+v"(rs4[1]), "+v"(rs4[2]), "+v"(rs4[3]));
            } else rstd4(SS, row0 + ai * HALF, rs4);
#pragma unroll
            for (int m = 0; m < 4; ++m) { const int row = row0 + ai * HALF + m * 16; const float rs = rs4[m];
                const f32x4 a0 = acc[ai][0][m][0] * rs, a1 = acc[ai][0][m][1] * rs, b0 = acc[ai][1][m][0] * rs, b1 = acc[ai][1][m][1] * rs;
                f32x4 g0, g1;
#pragma unroll
                for (int j = 0; j < 4; ++j) { g0[j] = silu_f(a0[j]) * b0[j]; g1[j] = silu_f(a1[j]) * b1[j]; }
                u32x4 w; w.x = cvt_pk_bf16(g0[0], g0[1]); w.y = cvt_pk_bf16(g0[2], g0[3]); w.z = cvt_pk_bf16(g1[0], g1[1]); w.w = cvt_pk_bf16(g1[2], g1[3]);
                *(u32x4*)(O + (size_t)row * ldo + col0) = w; } }
    }
};
struct EpiMoeDown {
    static constexpr bool PERM = true, AFTER_DRAIN = false;
    bf16_t* Y; const float* gate;
    __device__ __forceinline__ void operator()(const f32x4 (&acc)[2][2][4][2], const Unit& u, int wr, int wc, int fr, int fq) const {
        const int row0 = u.pm * BM + wr * 64 + fr, col0 = (u.pn & 3) * BM + wc * 32 + 8 * fq;
        float gt[2][4];
#pragma unroll
        for (int ai = 0; ai < 2; ++ai)
#pragma unroll
            for (int m = 0; m < 4; ++m) gt[ai][m] = gate[row0 + ai * HALF + m * 16];
        asm volatile("" : "+v"(gt[0][0]), "+v"(gt[0][1]), "+v"(gt[0][2]), "+v"(gt[0][3]), "+v"(gt[1][0]), "+v"(gt[1][1]), "+v"(gt[1][2]), "+v"(gt[1][3]));
#pragma unroll
        for (int ai = 0; ai < 2; ++ai)
#pragma unroll
            for (int m = 0; m < 4; ++m) { const int row = row0 + ai * HALF + m * 16; const float g = gt[ai][m]; bf16_t* rowp = Y + (size_t)row * 1024 + col0;
#pragma unroll
                for (int bj = 0; bj < 2; ++bj) { const f32x4 v0 = acc[ai][bj][m][0] * g, v1 = acc[ai][bj][m][1] * g;
                    u32x4 w; w.x = cvt_pk_bf16(v0[0], v0[1]); w.y = cvt_pk_bf16(v0[2], v0[3]); w.z = cvt_pk_bf16(v1[0], v1[1]); w.w = cvt_pk_bf16(v1[2], v1[3]);
                    *(u32x4*)(rowp + bj * HALF) = w; } }
    }
};

struct EpiMoeDownPart {
    static constexpr bool PERM = false, AFTER_DRAIN = false;
    float* YT; const float* gate; int row_base;
    __device__ __forceinline__ void operator()(const f32x4 (&acc)[2][2][4][2], const Unit& u, int wr, int wc, int fr, int fq) const {
        const int row0 = u.pm * BM + wr * 64 + fr, col0 = (u.pn & 3) * BM + wc * 32 + 4 * fq; const int kq = u.ko / 1792;
#pragma unroll
        for (int ai = 0; ai < 2; ++ai)
#pragma unroll
            for (int m = 0; m < 4; ++m) { const int row = row0 + ai * HALF + m * 16; const float gtv = gate[row]; float* rowp = YT + ((size_t)kq * 2048 + (row - row_base)) * 1024 + col0;
#pragma unroll
                for (int bj = 0; bj < 2; ++bj)
#pragma unroll
                    for (int n = 0; n < 2; ++n) *(f32x4*)(rowp + bj * HALF + n * 16) = acc[ai][bj][m][n] * gtv; }
    }
};
template <class Epi, class Sched, bool ALIGN_EPI = false, bool SP2 = false>
__device__ __forceinline__ void gemm_phase(PG8_LAS unsigned char* lds, const Gemm g, const Sched& S, const Epi& E, const bool skip_epi = false) {
    const int tid = tid_here(), wid = __builtin_amdgcn_readfirstlane(tid >> 6), lane = tid & 63, wr = wid >> 2, wc = wid & 3, fr = lane & 15, fq = lane >> 4;
    const int K = g.ld, nt = g.K / BK;
    unsigned voffA[2], voffB[2];
#pragma unroll
    for (int i = 0; i < 2; ++i) { int R, C; stage_rc(tid * 16 + i * 8192, R, C); const int Rb = Epi::PERM ? ((R & ~31) + perm32(R & 31)) : R;
        voffA[i] = (unsigned)(R * K + C) * 2u; voffB[i] = (unsigned)(Rb * K + C) * 2u; }
    const size_t kstep = (size_t)(BK * 2);
    const size_t hstep = (size_t)HALF * K * 2;
    const size_t tstep = 2 * hstep;
    const unsigned ldsw = (unsigned)wid * 1024u;
    const int aoff = lds_byte(wr * 64 + fr, fq * 8), boff = lds_byte(wc * 32 + fr, fq * 8);
#define PG8_SA(b, h) (((b) * 2 + (h)) * HTB)
#define PG8_SB(b, h) ((4 + (b) * 2 + (h)) * HTB)
#define PG8_STAGE(bufoff, gbase, voff) do { _Pragma("unroll") for (int _i = 0; _i < 2; ++_i) \
        __builtin_amdgcn_global_load_lds((const unsigned*)((const char*)(gbase) + (voff)[_i]), (PG8_LAS unsigned*)(lds + (bufoff) + ldsw + _i * 8192), 16, 0, 0); } while (0)
#define PG8_LDA(dst, b, h) do { _Pragma("unroll") for (int m = 0; m < 4; ++m) _Pragma("unroll") for (int k = 0; k < 2; ++k) dst[m][k] = *(const PG8_LAS bf16x8*)(lds + PG8_SA(b, h) + aoff + m * 2048 + k * 1024); } while (0)
#define PG8_LDB(dst, b, h) do { _Pragma("unroll") for (int n = 0; n < 2; ++n) _Pragma("unroll") for (int k = 0; k < 2; ++k) dst[n][k] = *(const PG8_LAS bf16x8*)(lds + PG8_SB(b, h) + boff + n * 2048 + k * 1024); } while (0)
#define PG8_MMA(ai, bj, At, Bt) do { __builtin_amdgcn_s_setprio(1); _Pragma("unroll") for (int m = 0; m < 4; ++m) _Pragma("unroll") for (int n = 0; n < 2; ++n) _Pragma("unroll") for (int k = 0; k < 2; ++k) \
        acc[ai][bj][m][n] = __builtin_amdgcn_mfma_f32_16x16x32_bf16(Bt[n][k], At[m][k], acc[ai][bj][m][n], 0, 0, 0); __builtin_amdgcn_s_setprio(0); } while (0)
#define PG8_WAIT_V(n) asm volatile("s_waitcnt vmcnt(" #n ")" ::: "memory")
#define PG8_WAIT_L(n) asm volatile("s_waitcnt lgkmcnt(" #n ")" ::: "memory")
#define PG8_BAR __builtin_amdgcn_s_barrier()
#define PG8_SCHED __builtin_amdgcn_sched_barrier(0)
    Unit cur, nxt; int ui = 0;
    if (!S.next(0, cur)) return;
    f32x4 acc[2][2][4][2];
#pragma unroll
    for (int a = 0; a < 2; ++a)
#pragma unroll
        for (int b = 0; b < 2; ++b)
#pragma unroll
            for (int m = 0; m < 4; ++m)
#pragma unroll
                for (int n = 0; n < 2; ++n) acc[a][b][m][n] = (f32x4){0.f, 0.f, 0.f, 0.f};
    bf16x8 At[4][2], B0[2][2], B1[2][2];
    const char* cA = (const char*)g.A + (size_t)cur.pm * tstep + cur.ko; const char* cB = (const char*)g.Bt + (size_t)cur.pn * tstep + cur.ko;
    S.a_ready(cur);
    if constexpr (SP2) {
        PG8_STAGE(PG8_SB(0, 0), cB, voffB); PG8_STAGE(PG8_SB(0, 1), cB + hstep, voffB); PG8_STAGE(PG8_SA(0, 0), cA, voffA); PG8_STAGE(PG8_SA(0, 1), cA + hstep, voffA);
        if (wr == 1) PG8_BAR;
        PG8_WAIT_V(2); PG8_BAR;
        PG8_STAGE(PG8_SB(1, 0), cB + kstep, voffB); PG8_STAGE(PG8_SA(1, 0), cA + kstep, voffA); PG8_STAGE(PG8_SB(1, 1), cB + hstep + kstep, voffB);
        PG8_WAIT_V(6); PG8_BAR;
    } else {
        PG8_STAGE(PG8_SB(0, 0), cB, voffB); PG8_STAGE(PG8_SA(0, 0), cA, voffA); PG8_STAGE(PG8_SB(0, 1), cB + hstep, voffB); PG8_STAGE(PG8_SA(0, 1), cA + hstep, voffA);
        if (wr == 1) PG8_BAR;
        PG8_WAIT_V(4); PG8_BAR;
        PG8_STAGE(PG8_SB(1, 0), cB + kstep, voffB); PG8_STAGE(PG8_SA(1, 0), cA + kstep, voffA); PG8_STAGE(PG8_SB(1, 1), cB + hstep + kstep, voffB);
        PG8_WAIT_V(6); PG8_BAR;
    }
    for (;;) {
        const bool has_next = S.next(ui + 1, nxt);
        const char* nA = has_next ? (const char*)g.A + (size_t)nxt.pm * tstep + nxt.ko : cA; const char* nB = has_next ? (const char*)g.Bt + (size_t)nxt.pn * tstep + nxt.ko : cB;
        for (int t = 0; t < nt; t += 2) {
            const bool last = (t == nt - 2);
            const char* a1 = cA + (size_t)(t + 1) * kstep;
            const char* a2 = last ? nA : cA + (size_t)(t + 2) * kstep; const char* b2 = last ? nB : cB + (size_t)(t + 2) * kstep;
            const char* a3 = a2 + kstep; const char* b3 = b2 + kstep;
            if (last && has_next) S.a_ready(nxt);
            if constexpr (SP2) {
            PG8_LDB(B0, 0, 0); PG8_LDB(B1, 0, 1); PG8_SCHED; PG8_LDA(At, 0, 0); PG8_STAGE(PG8_SA(1, 1), a1 + hstep, voffA);
            PG8_WAIT_V(8); PG8_WAIT_L(0); PG8_BAR; PG8_MMA(0, 0, At, B0); PG8_MMA(0, 1, At, B1); PG8_BAR; PG8_SCHED;
            PG8_LDA(At, 0, 1); PG8_STAGE(PG8_SB(0, 0), b2, voffB); PG8_STAGE(PG8_SB(0, 1), b2 + hstep, voffB); PG8_STAGE(PG8_SA(0, 0), a2, voffA);
            PG8_WAIT_V(8); PG8_WAIT_L(0); PG8_BAR; PG8_MMA(1, 0, At, B0); PG8_MMA(1, 1, At, B1); PG8_BAR; PG8_SCHED;
            PG8_LDB(B0, 1, 0); PG8_LDB(B1, 1, 1); PG8_SCHED; PG8_LDA(At, 1, 0); PG8_STAGE(PG8_SA(0, 1), a2 + hstep, voffA);
            PG8_WAIT_V(8); PG8_WAIT_L(0); PG8_BAR; PG8_MMA(0, 0, At, B0); PG8_MMA(0, 1, At, B1); PG8_BAR; PG8_SCHED;
            PG8_LDA(At, 1, 1); PG8_STAGE(PG8_SB(1, 0), b3, voffB); PG8_STAGE(PG8_SB(1, 1), b3 + hstep, voffB); PG8_STAGE(PG8_SA(1, 0), a3, voffA);
            PG8_WAIT_V(8); PG8_WAIT_L(0); PG8_BAR; PG8_MMA(1, 0, At, B0); PG8_MMA(1, 1, At, B1); PG8_BAR; PG8_SCHED;
            } else {
            PG8_LDB(B0, 0, 0); PG8_SCHED; PG8_LDA(At, 0, 0); PG8_STAGE(PG8_SA(1, 1), a1 + hstep, voffA);
            PG8_WAIT_L(8); PG8_BAR; PG8_WAIT_L(0); PG8_MMA(0, 0, At, B0); PG8_BAR; PG8_SCHED;
            PG8_LDB(B1, 0, 1); PG8_STAGE(PG8_SB(0, 0), b2, voffB);
            PG8_BAR; PG8_WAIT_L(0); PG8_MMA(0, 1, At, B1); PG8_BAR;
            PG8_LDA(At, 0, 1); PG8_STAGE(PG8_SA(0, 0), a2, voffA);
            PG8_BAR; PG8_WAIT_L(0); PG8_MMA(1, 0, At, B0); PG8_BAR; PG8_SCHED;
            PG8_STAGE(PG8_SB(0, 1), b2 + hstep, voffB);
            PG8_WAIT_V(6); PG8_BAR; PG8_MMA(1, 1, At, B1); PG8_BAR;
            PG8_LDB(B0, 1, 0); PG8_SCHED; PG8_LDA(At, 1, 0); PG8_STAGE(PG8_SA(0, 1), a2 + hstep, voffA);
            PG8_WAIT_L(8); PG8_BAR; PG8_WAIT_L(0); PG8_MMA(0, 0, At, B0); PG8_BAR; PG8_SCHED;
            PG8_LDB(B1, 1, 1); PG8_STAGE(PG8_SB(1, 0), b3, voffB);
            PG8_BAR; PG8_WAIT_L(0); PG8_MMA(0, 1, At, B1); PG8_BAR;
            PG8_LDA(At, 1, 1); PG8_STAGE(PG8_SA(1, 0), a3, voffA);
            PG8_BAR; PG8_WAIT_L(0); PG8_MMA(1, 0, At, B0); PG8_BAR; PG8_SCHED;
            PG8_STAGE(PG8_SB(1, 1), b3 + hstep, voffB);
            PG8_WAIT_V(6); PG8_BAR; PG8_MMA(1, 1, At, B1); PG8_BAR;
            }
        }
        if constexpr (ALIGN_EPI) { if (wr == 0) PG8_BAR; }
        if constexpr (!Epi::AFTER_DRAIN) { if (!skip_epi) E(acc, cur, wr, wc, fr, fq); S.done(cur); }
        if (!has_next) break;
#pragma unroll
        for (int a = 0; a < 2; ++a)
#pragma unroll
            for (int b = 0; b < 2; ++b)
#pragma unroll
                for (int m = 0; m < 4; ++m)
#pragma unroll
                    for (int n = 0; n < 2; ++n) acc[a][b][m][n] = (f32x4){0.f, 0.f, 0.f, 0.f};
        cur = nxt; cA = nA; cB = nB; ++ui;
        if constexpr (ALIGN_EPI) { if (wr == 1) PG8_BAR; }
    }
    PG8_WAIT_V(0);
    if constexpr (!ALIGN_EPI) { if (wr == 0) PG8_BAR; }
    PG8_BAR;
#undef PG8_SA
#undef PG8_SB
#undef PG8_STAGE
#undef PG8_LDA
#undef PG8_LDB
#undef PG8_MMA
#undef PG8_WAIT_V
#undef PG8_WAIT_L
#undef PG8_BAR
#undef PG8_SCHED
}
}

constexpr int NWAVES = 8, NTHR = NWAVES * 64;
constexpr int NB = 8, SEQ = 2048, D = 1024, M = NB * SEQ;
constexpr int INC = 3088;
constexpr int NU = 3072;
constexpr int UQ = 0, UK = 256, UV = 512, UGQ = 768, UGK = 1024, UGV = 1280, UGR = 1792, UCI = 2304, UCB = 2560, UCC = 2816;
constexpr int FF = 2816, FE = 3584, NE = 8;
constexpr int MAXPAN = 136, MAXROWS = MAXPAN * 256;
constexpr float LOG2E = 1.4426950408889634f;
constexpr float QS_ATT = 0.125f * LOG2E;

constexpr size_t MiB = 1u << 20;
constexpr size_t WS_CTL = 0, CTL_ZERO_BYTES = 1 * MiB;
constexpr size_t WS_SS = 1 * MiB;
constexpr size_t WS_BL = 2 * MiB;
constexpr size_t WS_DEC = 2 * MiB + 64 * 1024;
constexpr size_t WS_TOPI = 3 * MiB;
constexpr size_t WS_TOPW = 3 * MiB + 128 * 1024;
constexpr size_t WS_POS = 3 * MiB + 256 * 1024;
constexpr size_t WS_RS3 = 3 * MiB + 384 * 1024;
constexpr size_t WS_CNT = 3 * MiB + 448 * 1024;
constexpr size_t WS_PANE = 3 * MiB + 456 * 1024;
constexpr size_t WS_ROWGATE = 4 * MiB;
constexpr size_t WS_ROWRS = 4 * MiB + 256 * 1024;
constexpr size_t WS_WE13 = 8 * MiB;
constexpr size_t WS_Y = WS_WE13;
constexpr size_t WS_YT = WS_WE13 + 68 * MiB;
constexpr size_t WS_XS = 120 * MiB;
constexpr size_t WS_WE2 = WS_XS;
constexpr size_t WS_HE = 188 * MiB;
constexpr size_t WS_WIN = WS_HE;
constexpr size_t WS_WGLR = WS_HE + 12 * MiB;
constexpr size_t WS_LA = WS_HE + 34 * MiB;
constexpr size_t WS_WOUT = WS_HE + 13 * MiB;
constexpr size_t WS_W13 = WS_HE + 17 * MiB;
constexpr size_t WS_W2 = WS_HE + 28 * MiB;
constexpr size_t WS_XB = WS_HE + 238 * MiB;
constexpr size_t WS_U = WS_HE + 66 * MiB;
constexpr size_t WS_H = WS_U;
constexpr size_t WS_MIX = WS_HE + 170 * MiB;
constexpr size_t WS_CST = WS_HE + 202 * MiB;
constexpr size_t WS_END = WS_HE + 270 * MiB;
static_assert(WS_CST + 32 * MiB <= WS_END, "ws map");
constexpr int CW_BAR = 4096;
constexpr int CW_SC = 32768;
constexpr int CW_TMO2 = 65536;

constexpr int LDS_BYTES = 147456;
constexpr int LDSCTL_OFF = 131072 + 14 * 1024, MISC_OFF = LDSCTL_OFF + 320;

#define GAS __attribute__((address_space(1)))
#define LAS __attribute__((address_space(3)))
typedef unsigned short bf16;
typedef float f32x4 __attribute__((ext_vector_type(4)));
typedef unsigned v4u __attribute__((ext_vector_type(4)));
__device__ __forceinline__ unsigned f2bf(float f) { unsigned u = __builtin_bit_cast(unsigned, f); return (u + 0x7fffu + ((u >> 16) & 1u)) >> 16; }
__device__ __forceinline__ unsigned pk2(float lo, float hi) { return f2bf(lo) | (f2bf(hi) << 16); }
__device__ __forceinline__ float bf2f(unsigned short b) { return __builtin_bit_cast(float, (unsigned)b << 16); }
__device__ __forceinline__ float bflo(unsigned w) { return __builtin_bit_cast(float, w << 16); }
__device__ __forceinline__ float bfhi(unsigned w) { return __builtin_bit_cast(float, w & 0xffff0000u); }
__device__ __forceinline__ float wave_sum(float v) {
#pragma unroll
    for (int o = 1; o < 64; o <<= 1) v += __shfl_xor(v, o);
    return v;
}
__device__ __forceinline__ float wave_max(float v) {
#pragma unroll
    for (int o = 1; o < 64; o <<= 1) v = fmaxf(v, __shfl_xor(v, o));
    return v;
}

#define XB_TMO      128
#define XB_XCNT(j)  (256  + 64 * (j))
#define XB_XSUB(j)  (1280 + 64 * (j))
#define XB_XGEN(j)  (2304 + 64 * (j))
#define XB_TOP      3328
#define XB_TOPGEN   3392
#define XCD_BAR_WORDS 3456
#define XB_SPIN_CAP (1u << 18)
__device__ __forceinline__ unsigned xb_ld(unsigned* p)              { return __hip_atomic_load(p, __ATOMIC_RELAXED, __HIP_MEMORY_SCOPE_AGENT); }
__device__ __forceinline__ unsigned xb_add(unsigned* p, unsigned v) { return __hip_atomic_fetch_add(p, v, __ATOMIC_RELAXED, __HIP_MEMORY_SCOPE_AGENT); }
__device__ __forceinline__ unsigned xb_xcc_id() { return (unsigned)__builtin_amdgcn_s_getreg((3 << 11) | 20) & 0xFu; }
#define XB_SPIN(cond, bar) do { unsigned _sp = 0; while (cond) { __builtin_amdgcn_s_sleep(1); \
    if ((++_sp & 255u) == 0u) { if (xb_ld(&(bar)[XB_TMO])) break; if (_sp > XB_SPIN_CAP) { atomicAdd(&(bar)[XB_TMO], 1u); break; } } } } while (0)
struct XcdBarrier { unsigned* bar; unsigned x; volatile LAS unsigned* st; };
__device__ __forceinline__ XcdBarrier xcd_barrier_post(unsigned* bar, volatile LAS unsigned* st) {
    XcdBarrier b; b.bar = bar; b.x = xb_xcc_id(); b.st = st;
    if (threadIdx.x == 0) (void)xb_add(&bar[XB_XCNT(b.x)], 1u);
    return b;
}
__device__ __forceinline__ void xcd_barrier_complete(unsigned* bar, unsigned x, unsigned& nloc, unsigned& nx) {
    const unsigned G = gridDim.x * gridDim.y * gridDim.z;
    unsigned sum, cnt, mine, sp = 0u;
    for (;;) {
        sum = 0u; cnt = 0u; mine = 0u;
#pragma unroll
        for (unsigned j = 0; j < 16; ++j) { const unsigned c = xb_ld(&bar[XB_XCNT(j)]); sum += c; cnt += (c > 0u) ? 1u : 0u; mine = (j == x) ? c : mine; }
        if (sum == G) break;
        __builtin_amdgcn_s_sleep(1);
        if ((++sp & 255u) == 0u) { if (xb_ld(&bar[XB_TMO])) break; if (sp > XB_SPIN_CAP) { atomicAdd(&bar[XB_TMO], 1u); break; } }
    }
    nloc = mine > 0u ? mine : 1u; nx = cnt > 0u ? cnt : 1u;
}
__device__ __forceinline__ void xcd_barrier(const XcdBarrier& b) {
    asm volatile("s_waitcnt vmcnt(0)" ::: "memory");
    __syncthreads();
    if (threadIdx.x == 0) {
        unsigned* bar = b.bar;
        __builtin_amdgcn_s_waitcnt(0);
        unsigned nloc = b.st[0], nx = b.st[1];
        if (nloc == 0u) { xcd_barrier_complete(bar, b.x, nloc, nx); b.st[0] = nloc; b.st[1] = nx; }
        const unsigned old = xb_add(&bar[XB_XSUB(b.x)], 1u);
        const unsigned gen = old / nloc;
        if (old + 1u == (gen + 1u) * nloc) {
            __builtin_amdgcn_fence(__ATOMIC_RELEASE, "agent");
            asm volatile("s_waitcnt vmcnt(0)" ::: "memory");
            const unsigned og = xb_add(&bar[XB_TOP], 1u);
            const unsigned tg = og / nx;
            if (og + 1u == (tg + 1u) * nx) xb_add(&bar[XB_TOPGEN], 1u);
            else XB_SPIN(xb_ld(&bar[XB_TOPGEN]) == tg, bar);
            __builtin_amdgcn_fence(__ATOMIC_ACQUIRE, "agent");
            xb_add(&bar[XB_XGEN(b.x)], 1u);
            asm volatile("s_waitcnt vmcnt(0)" ::: "memory");
        } else {
            XB_SPIN(xb_ld(&bar[XB_XGEN(b.x)]) == gen, bar);
            __builtin_amdgcn_fence(__ATOMIC_ACQUIRE, "agent");
            asm volatile("s_waitcnt vmcnt(0)" ::: "memory");
        }
    }
    __syncthreads();
}

struct Args {
    const float* x; const float* w_mix_in; const float* w_mix_out; const float* g_mix; const float* rel_bias; const float* gla_w_gate; const float* gla_b_gate;
    const float* gla_g_norm; const float* conv_w; const float* g_ffn; const float* ffn_w1; const float* ffn_w3; const float* ffn_w2; const float* moe_router;
    const float* moe_w1; const float* moe_w3; const float* moe_w2; const float* g_final;
    float* out; unsigned char* ws; int ph_lo, ph_hi, li, pad;
};

__device__ __forceinline__ void transpose_tile(const float* src, int ldsrc, int k0, int n0, bf16* dst, int ldd, int drow0, const float* ksc, unsigned* scr, int lane) {
    const int nq = lane & 15, kk = lane >> 4;
#pragma unroll
    for (int i = 0; i < 8; ++i) { const int k = 8 * i + 2 * kk; const float* p = src + (size_t)(k0 + k) * ldsrc + n0 + 4 * nq;
        const f32x4 r0 = *(const f32x4*)p, r1 = *(const f32x4*)(p + ldsrc);
        const float s0 = ksc ? ksc[k0 + k] : 1.f, s1 = ksc ? ksc[k0 + k + 1] : 1.f;
#pragma unroll
        for (int j = 0; j < 4; ++j) scr[(4 * nq + j) * 33 + 4 * i + kk] = pk2(r0[j] * s0, r1[j] * s1); }
    asm volatile("s_waitcnt lgkmcnt(0)" ::: "memory");
#pragma unroll 8
    for (int i2 = 0; i2 < 32; ++i2) { const int n = 2 * i2 + (lane >> 5), d = lane & 31;
        ((unsigned*)(dst + (size_t)(drow0 + n) * ldd + k0))[d] = scr[n * 33 + d]; }
    asm volatile("s_waitcnt lgkmcnt(0)" ::: "memory");
}
__device__ __forceinline__ void glr_tile(const float* win, const float* wg, const float* g, int k0, int n0, bf16* dst, int drow0, int lane) {
    float w[16];
#pragma unroll
    for (int r = 0; r < 16; ++r) w[r] = wg[r * 256 + n0 + lane];
    unsigned* drow = (unsigned*)(dst + (size_t)(drow0 + n0 + lane) * 1024 + k0);
    for (int kp = 0; kp < 32; ++kp) { float v[2];
#pragma unroll
        for (int q = 0; q < 2; ++q) { const int k = k0 + 2 * kp + q; const float* s = win + (size_t)k * INC + 2304; float a = 0.f;
#pragma unroll
            for (int r = 0; r < 16; ++r) a += s[r] * w[r];
            v[q] = a * g[k]; }
        drow[kp] = pk2(v[0], v[1]); }
}
__device__ __forceinline__ int rel_bucket(int d) {
    if (d < 16) return d;
    const float lr = logf((float)d / 16.0f) / logf(128.0f);
    int b = 16 + (int)(lr * 16.0f); return b < 31 ? b : 31;
}


typedef short bf16x8 __attribute__((ext_vector_type(8)));
typedef short v4i16_t __attribute__((ext_vector_type(4)));
#define MFMA16(a, b, c) __builtin_amdgcn_mfma_f32_16x16x32_bf16((a), (b), (c), 0, 0, 0)
__device__ __forceinline__ v4i16_t tr16(LAS unsigned char* p) { return __builtin_amdgcn_ds_read_tr16_b64_v4i16((LAS v4i16_t*)p); }
__device__ __forceinline__ bf16x8 cat8(v4i16_t lo, v4i16_t hi) { return __builtin_shufflevector(lo, hi, 0, 1, 2, 3, 4, 5, 6, 7); }
__device__ __forceinline__ bf16x8 frag_rm(LAS unsigned char* base, int pitch, int c0, int k0, int lane) { return *(LAS bf16x8*)(base + (c0 + (lane & 15)) * pitch + (k0 + 8 * (lane >> 4)) * 2); }
__device__ __forceinline__ bf16x8 frag_tr(LAS unsigned char* base, int pitch, int c0, int k0, int lane) {
    const int i = lane & 15, g = lane >> 4; LAS unsigned char* p = base + (k0 + 8 * g + (i >> 2)) * pitch + (c0 + 4 * (i & 3)) * 2;
    return cat8(tr16(p), tr16(p + 4 * pitch)); }
__device__ __forceinline__ bf16x8 frag_trp(LAS unsigned char* base, int pitch, int c0, int k0, int lane) {
    const int i = lane & 15, g = lane >> 4; LAS unsigned char* p = base + (k0 + 4 * g + (i >> 2)) * pitch + (c0 + 4 * (i & 3)) * 2;
    return cat8(tr16(p), tr16(p + 16 * pitch)); }
__device__ __forceinline__ bf16x8 pack8(const f32x4& a, const f32x4& b) {
    v4u w; w.x = pg8::cvt_pk_bf16(a[0], a[1]); w.y = pg8::cvt_pk_bf16(a[2], a[3]); w.z = pg8::cvt_pk_bf16(b[0], b[1]); w.w = pg8::cvt_pk_bf16(b[2], b[3]); return __builtin_bit_cast(bf16x8, w); }

struct Ctx { Args args; int tid, lane, wave, G, bx, gw, NGW, lo, hi; XcdBarrier bar; };
#define GRID_BAR() do { if (MK_N_LAUNCHES == 1) xcd_barrier(bar); } while (0)
#define IN(k) (lo <= (k) && (k) < hi)
#define SEAM(k) do { if (IN(k) && IN((k) + 1)) GRID_BAR(); } while (0)
#define WS_PTRS \
    float* SS = (float*)(ws + WS_SS); float* BL = (float*)(ws + WS_BL); float* DEC = (float*)(ws + WS_DEC); \
    bf16* XB = (bf16*)(ws + WS_XB); bf16* U = (bf16*)(ws + WS_U); bf16* MIX = (bf16*)(ws + WS_MIX); float* CST = (float*)(ws + WS_CST); \
    bf16* H = (bf16*)(ws + WS_H); bf16* W13 = (bf16*)(ws + WS_W13); bf16* W2 = (bf16*)(ws + WS_W2); \
    bf16* WE13 = (bf16*)(ws + WS_WE13); bf16* WE2 = (bf16*)(ws + WS_WE2); bf16* XS = (bf16*)(ws + WS_XS); bf16* HE = (bf16*)(ws + WS_HE); bf16* Y = (bf16*)(ws + WS_Y); \
    int* TOPI = (int*)(ws + WS_TOPI); float* TOPW = (float*)(ws + WS_TOPW); int* POS = (int*)(ws + WS_POS); float* RS3 = (float*)(ws + WS_RS3); \
    int* CNT = (int*)(ws + WS_CNT); int* PANE = (int*)(ws + WS_PANE); float* ROWGATE = (float*)(ws + WS_ROWGATE); float* ROWRS = (float*)(ws + WS_ROWRS); \
    float* X = args.out; \
    (void)SS; (void)BL; (void)DEC; (void)XB; (void)U; (void)MIX; (void)CST; (void)H; (void)W13; (void)W2; (void)WE13; (void)WE2; (void)XS; (void)HE; (void)Y; \
    (void)TOPI; (void)TOPW; (void)POS; (void)RS3; (void)CNT; (void)PANE; (void)ROWGATE; (void)ROWRS; (void)X;

template <int layer> __device__ __forceinline__ void layer_phases(const Ctx& c, unsigned char* lds) {
    const Args& args = c.args; LAS unsigned char* ldsl = (LAS unsigned char*)lds;
    const int tid = c.tid, lane = c.lane, wave = c.wave, G = c.G, bx = c.bx, gw = c.gw, NGW = c.NGW, lo = c.lo, hi = c.hi; const XcdBarrier bar = c.bar;
    unsigned char* ws = args.ws;
    WS_PTRS
    (void)tid; (void)lane; (void)wave; (void)gw; (void)NGW;
    const int pmode = args.pad >> 4; (void)pmode;
    const bool dry = (args.pad & 1) != 0, noepi = (args.pad & 2) != 0;
    bf16* XBD = dry ? (bf16*)(ws + WS_XS) : XB; float* SSD = dry ? (float*)(ws + WS_XS) : SS; (void)XBD; (void)SSD;
        const int pb = 1 + 16 * layer;
        if (IN(pb + 0)) {
            pg8::Gemm g{XB, (const bf16*)(ws + WS_WIN) + (size_t)layer * NU * D, M, NU, D, D}; pg8::StaticOrder S; S.init(M, NU, G, bx);
            pg8::EpiU E{U, NU, SS, QS_ATT};
            pg8::gemm_phase<pg8::EpiU, pg8::StaticOrder, true, true>(ldsl, g, S, E, noepi);
            { const bf16* wg = (const bf16*)(ws + WS_WGLR) + (size_t)layer * 16 * D; float* LA = (float*)(ws + WS_LA); f32x4* xch = (f32x4*)lds; float* glrl = (float*)(lds + 4096);
              const int tid = pg8::tid_here(), lane = tid & 63;
              float wgc[16]; { const float* wgp = args.gla_w_gate + layer * 16 * 256 + (tid & 255);
#pragma unroll
                for (int r = 0; r < 16; ++r) wgc[r] = wgp[r * 256]; }
              const float bgv = args.gla_b_gate[layer * 256 + (tid & 255)];
              for (int blk = bx; blk < 256; blk += G) {
                  const int rt = wave & 3, kh = wave >> 2, ql = lane & 15, g4 = lane >> 4;
                  const bf16* ap = XB + (size_t)(blk * 64 + rt * 16 + ql) * D + kh * 512 + 8 * g4; const bf16* bp = wg + (size_t)ql * D + kh * 512 + 8 * g4;
                  f32x4 acc = (f32x4){0.f, 0.f, 0.f, 0.f};
#pragma unroll
                  for (int ks = 0; ks < 16; ++ks) acc = MFMA16(*(const bf16x8*)(ap + 32 * ks), *(const bf16x8*)(bp + 32 * ks), acc);
                  if (kh == 1) xch[rt * 64 + lane] = acc;
                  __syncthreads();
                  if (kh == 0) { acc += xch[rt * 64 + lane];
#pragma unroll
                      for (int rg = 0; rg < 4; ++rg) { const int rl = rt * 16 + 4 * g4 + rg; glrl[rl * 16 + ql] = acc[rg] * pg8::rstd_of(SS + (size_t)(blk * 64 + rl) * 16); } }
                  __syncthreads();
                  { const int c = tid & 255, r0 = (tid >> 8) * 32;
#pragma unroll 4
                    for (int i = 0; i < 32; ++i) { const f32x4* gp = (const f32x4*)(glrl + (r0 + i) * 16); float z = bgv;
#pragma unroll
                        for (int q4 = 0; q4 < 4; ++q4) { const f32x4 gv = gp[q4]; z += gv[0] * wgc[4 * q4] + gv[1] * wgc[4 * q4 + 1] + gv[2] * wgc[4 * q4 + 2] + gv[3] * wgc[4 * q4 + 3]; }
                        LA[(size_t)(blk * 64 + r0 + i) * 256 + c] = pg8::logsig16(z); } }
                  __syncthreads();
              } }
        }
        SEAM(pb + 0);
        if (IN(pb + 1)) {
            const int tid = pg8::tid_here(), lane = tid & 63; (void)lane;
            float* cum = (float*)lds; float* seg = cum + 4096;
            LAS unsigned char* kdl = ldsl + 18432;
            LAS unsigned char* vvl = ldsl + 27648;
            for (int u = bx; u < 1024; u += G) {
                const int h = u & 3, n = (u >> 2) & 31, b = u >> 7; const size_t row0 = (size_t)b * SEQ + n * 64;
                const int tr = tid >> 3, c8 = tid & 7;
                const v4u kraw = *(const v4u*)(U + (row0 + tr) * NU + UGK + h * 64 + 8 * c8);
                const v4u* vp = (const v4u*)(U + (row0 + tr) * NU + UGV + h * 128 + c8 * 16); const v4u x0 = vp[0], x1 = vp[1];
                { float c = 0.f; float lav[8]; const float* lap = (const float*)(ws + WS_LA) + (row0 + 8 * wave) * 256 + h * 64 + lane;
#pragma unroll
                  for (int i = 0; i < 8; ++i) lav[i] = lap[i * 256];
#pragma unroll
                  for (int i = 0; i < 8; ++i) { c += lav[i]; cum[(8 * wave + i) * 64 + lane] = c; }
                  seg[wave * 64 + lane] = c; }
                __syncthreads();
                { f32x4 offa = (f32x4){0.f, 0.f, 0.f, 0.f}, offb = offa, lasta = offa, lastb = offa; const int wq = tr >> 3;
#pragma unroll
                  for (int w = 0; w < 8; ++w) { const f32x4 sa = *(const f32x4*)(seg + w * 64 + 8 * c8), sb = *(const f32x4*)(seg + w * 64 + 8 * c8 + 4); lasta += sa; lastb += sb; if (w < wq) { offa += sa; offb += sb; } }
                  const f32x4 ca = *(const f32x4*)(cum + tr * 64 + 8 * c8) + offa, cb = *(const f32x4*)(cum + tr * 64 + 8 * c8 + 4) + offb;
                  v4u w; w.x = pk2(bflo(kraw.x) * __expf(lasta[0] - ca[0]), bfhi(kraw.x) * __expf(lasta[1] - ca[1])); w.y = pk2(bflo(kraw.y) * __expf(lasta[2] - ca[2]), bfhi(kraw.y) * __expf(lasta[3] - ca[3]));
                  w.z = pk2(bflo(kraw.z) * __expf(lastb[0] - cb[0]), bfhi(kraw.z) * __expf(lastb[1] - cb[1])); w.w = pk2(bflo(kraw.w) * __expf(lastb[2] - cb[2]), bfhi(kraw.w) * __expf(lastb[3] - cb[3]));
                  *(LAS v4u*)(kdl + tr * 144 + c8 * 16) = w;
                  if (tr == 0) {
#pragma unroll
                      for (int j = 0; j < 4; ++j) { __hip_atomic_store(DEC + u * 64 + 8 * c8 + j, __expf(lasta[j]), __ATOMIC_RELAXED, __HIP_MEMORY_SCOPE_AGENT); __hip_atomic_store(DEC + u * 64 + 8 * c8 + 4 + j, __expf(lastb[j]), __ATOMIC_RELAXED, __HIP_MEMORY_SCOPE_AGENT); } }
                  LAS v4u* vd = (LAS v4u*)(vvl + tr * 272 + c8 * 32); vd[0] = x0; vd[1] = x1; }
                __syncthreads();
                { f32x4 acc[4];
#pragma unroll
                  for (int kt = 0; kt < 4; ++kt) acc[kt] = (f32x4){0.f, 0.f, 0.f, 0.f};
#pragma unroll
                  for (int ks = 0; ks < 2; ++ks) { const bf16x8 bv = frag_tr(vvl, 272, 16 * wave, 32 * ks, lane);
#pragma unroll
                      for (int kt = 0; kt < 4; ++kt) { const bf16x8 ak = frag_tr(kdl, 144, 16 * kt, 32 * ks, lane); acc[kt] = MFMA16(ak, bv, acc[kt]); } }
                  const int g4 = lane >> 4, ql = lane & 15;
                  const __amdgpu_buffer_rsrc_t rsrc = __builtin_amdgcn_make_buffer_rsrc((void*)CST, 0, 32 * 1024 * 1024, 0x00020000);
#pragma unroll
                  for (int kt = 0; kt < 4; ++kt)
                      __builtin_amdgcn_raw_buffer_store_b128(__builtin_bit_cast(v4u, acc[kt]), rsrc, (int)((((unsigned)u * 128u + 16u * wave + ql) * 64u + 16u * kt + 4u * g4) * 4u), 0, 16); }
                asm volatile("s_waitcnt vmcnt(0)" ::: "memory");
                __syncthreads();
                if (tid == 0) __hip_atomic_fetch_add((unsigned*)(ws + WS_CTL) + CW_SC + ((u >> 7) * 4 + (u & 3)) * 64, 1u, __ATOMIC_RELAXED, __HIP_MEMORY_SCOPE_AGENT);
            }
            const float* cw = args.conv_w + layer * 3 * 256;
            for (int rep_ = 0; rep_ < 1 + ((args.pad >> 10) & 1); ++rep_)
            for (int it = bx * NTHR + tid; it < M * 32; it += G * NTHR) {
                const int row = it >> 5, c0 = (it & 31) * 8, t = row & (SEQ - 1);
                const bf16* ur = U + (size_t)row * NU;
                const v4u cb = *(const v4u*)(ur + UCB + c0);
                v4u ci[3], cc[3];
#pragma unroll
                for (int d = 0; d < 3; ++d) { if (t >= d) { ci[d] = *(const v4u*)(ur - (size_t)d * NU + UCI + c0); cc[d] = *(const v4u*)(ur - (size_t)d * NU + UCC + c0); } else { ci[d] = (v4u){0u, 0u, 0u, 0u}; cc[d] = ci[d]; } }
                float o[8];
#pragma unroll
                for (int j = 0; j < 4; ++j) {
                    float a0 = 0.f, a1 = 0.f;
#pragma unroll
                    for (int d = 0; d < 3; ++d) { const float w0 = cw[(2 - d) * 256 + c0 + 2 * j], w1 = cw[(2 - d) * 256 + c0 + 2 * j + 1];
                        a0 += w0 * (bflo(cc[d][j]) * bflo(ci[d][j])); a1 += w1 * (bfhi(cc[d][j]) * bfhi(ci[d][j])); }
                    o[2 * j] = bflo(cb[j]) * a0; o[2 * j + 1] = bfhi(cb[j]) * a1; }
                v4u w; w.x = pk2(o[0], o[1]); w.y = pk2(o[2], o[3]); w.z = pk2(o[4], o[5]); w.w = pk2(o[6], o[7]);
                *(v4u*)(MIX + (size_t)row * D + 768 + c0) = w;
            }
            __syncthreads();
            {
                float* BLl = (float*)lds;
                for (int i = tid; i < 4 * 2049; i += NTHR) BLl[(i & 3) * 2049 + (i >> 2)] = BL[i];
                __syncthreads();
                LAS unsigned char* vst = ldsl + 33280 + wave * 5120;
                const int ql = lane & 15, g4 = lane >> 4;
                for (int rep_ = 0; rep_ < 1 + ((args.pad >> 11) & 1); ++rep_)
                for (int uu = bx; uu < 512; uu += G) {
                    int u = uu; if (G == 256) { const int j = (uu & 255) >> 3; u = ((((uu >> 8) * 16 + (uu & 7) * 2 + (j >> 4)) << 4) | (j & 15)); }
                    const int c = u & 15, h = (u >> 4) & 3, b = u >> 6; const int i0 = 16 * (((uu / G) & 1) ? 7 - wave : wave); const size_t rowb = (size_t)b * SEQ;
                    const int tq = c + 16 * (i0 + ql);
                    const bf16* ub = U + rowb * NU + h * 64;
                    const bf16x8 qf0 = *(const bf16x8*)(ub + (size_t)tq * NU + UQ + 8 * g4), qf1 = *(const bf16x8*)(ub + (size_t)tq * NU + UQ + 8 * g4 + 32);
                    const float* blh = BLl + h * 2049;
                    const int t0 = c + 16 * i0, t1 = t0 + 240;
                    const int base0 = ((t0 >> 4) - 128) & ~31, mhi0 = t1 >> 4, np0 = ((mhi0 - base0) >> 5) + 1, pz0 = base0 < 0 ? ((-base0) >> 5) : 0;
                    const int base1 = ((t0 >> 2) - 128) & ~31, mhi1 = t1 >> 2, np1 = ((mhi1 - base1) >> 5) + 1, pz1 = base1 < 0 ? ((-base1) >> 5) : 0;
                    const int base2 = (t0 - 128) & ~31, mhi2 = t1, np2 = ((mhi2 - base2) >> 5) + 1, pz2 = base2 < 0 ? ((-base2) >> 5) : 0;
                    const int n0 = np0 - pz0, n1 = np1 - pz1, n2 = np2 - pz2, NT = n0 + n1 + n2;
                    bf16x8 ka[2][2], kb[2][2]; v4u va_[4], vb_[4];
                    const unsigned char* ubb = (const unsigned char*)ub;
                    const unsigned koff = (unsigned)(UK + 8 * g4) * 2u, voff = (unsigned)(UV + 8 * (lane & 7)) * 2u; const int vrow = lane >> 3;
#define ATT_ITEM(it, LR, MB, MHI, RHO) do { if ((it) < n0) { LR = 4; MB = base0 + 32 * (np0 - 1 - (it)); MHI = mhi0; RHO = c; } \
                        else if ((it) < n0 + n1) { LR = 2; MB = base1 + 32 * (pz1 + (it) - n0); MHI = mhi1; RHO = c & 3; } \
                        else { LR = 0; MB = base2 + 32 * (pz2 + (it) - n0 - n1); MHI = mhi2; RHO = 0; } } while (0)
#define ATT_CLAMP(x, hi) __builtin_amdgcn_med3 ## _i(x, hi)
#define ATT_LOAD(K_, V_, LR, MB, MHI, RHO) do { _Pragma("unroll") for (int tau = 0; tau < 2; ++tau) { int mk = (MB) + 16 * tau + ql; mk = max(0, min(mk, (MHI))); \
                            const unsigned char* kp = ubb + ((unsigned)((mk << (LR)) + (RHO)) * (unsigned)(NU * 2) + koff); K_[tau][0] = *(const bf16x8*)kp; K_[tau][1] = *(const bf16x8*)(kp + 64); } \
                        _Pragma("unroll") for (int j = 0; j < 4; ++j) { int mv = (MB) + vrow + 8 * j; mv = max(0, min(mv, (MHI))); \
                            V_[j] = *(const v4u*)(ubb + ((unsigned)((mv << (LR)) + (RHO)) * (unsigned)(NU * 2) + voff)); } } while (0)
#define ATT_STEP(KC_, VC_, KN_, VN_) do { \
                        int lrn = lr, mbn = mb, mhin = mhi, rhon = rho; \
                        if (it + 1 < NT) { ATT_ITEM(it + 1, lrn, mbn, mhin, rhon); ATT_LOAD(KN_, VN_, lrn, mbn, mhin, rhon); } \
                        { LAS unsigned char* vd = vst + vrow * 160 + (lane & 7) * 16; \
                          _Pragma("unroll") for (int j = 0; j < 4; ++j) *(LAS v4u*)(vd + j * 8 * 160) = VC_[j]; } \
                        f32x4 s[2]; \
                        _Pragma("unroll") for (int tau = 0; tau < 2; ++tau) { s[tau] = MFMA16(KC_[tau][0], qf0, ((f32x4){0.f, 0.f, 0.f, 0.f})); s[tau] = MFMA16(KC_[tau][1], qf1, s[tau]); } \
                        const int d0 = (tq >> lr) - mb - 4 * g4; const int kneg = -(mb + 4 * g4); float tmax = -INFINITY; \
                        _Pragma("unroll") for (int tau = 0; tau < 2; ++tau) \
                            _Pragma("unroll") for (int rg = 0; rg < 4; ++rg) { const int dist = d0 - (16 * tau + rg); const int dcl = max(0, min(dist, 128)); \
                                const float bias = blh[dcl << lr]; const bool ok = (dist == dcl) && ((16 * tau + rg) >= kneg); \
                                const float v = ok ? s[tau][rg] + bias : -INFINITY; s[tau][rg] = v; tmax = fmaxf(tmax, v); } \
                        if (__any(tmax > m_ref + 16.0f)) { \
                            float tm = fmaxf(tmax, __shfl_xor(tmax, 16)); tm = fmaxf(tm, __shfl_xor(tm, 32)); \
                            const float mn = fmaxf(m_ref, tm); const float ms = (mn == -INFINITY) ? 0.f : mn; const float alpha = __builtin_amdgcn_exp2f(m_ref - ms); m_ref = ms; \
                            l_run *= alpha; \
                            _Pragma("unroll") for (int d = 0; d < 4; ++d) o[d] = o[d] * alpha; \
                        } \
                        float ps = 0.f; \
                        _Pragma("unroll") for (int tau = 0; tau < 2; ++tau) \
                            _Pragma("unroll") for (int rg = 0; rg < 4; ++rg) { const float p = __builtin_amdgcn_exp2f(s[tau][rg] - m_ref); s[tau][rg] = p; ps += p; } \
                        l_run += ps; \
                        const bf16x8 pb = pack8(s[0], s[1]); \
                        asm volatile("" ::: "memory"); \
                        _Pragma("unroll") for (int d = 0; d < 4; ++d) { const bf16x8 vf = frag_trp(vst, 160, 16 * d, 0, lane); o[d] = MFMA16(vf, pb, o[d]); } \
                        asm volatile("" ::: "memory"); \
                        lr = lrn; mb = mbn; mhi = mhin; rho = rhon; ++it; } while (0)
                    int lr, mb, mhi, rho; ATT_ITEM(0, lr, mb, mhi, rho); ATT_LOAD(ka, va_, lr, mb, mhi, rho);
                    float m_ref = -INFINITY, l_run = 0.f; f32x4 o[4];
#pragma unroll
                    for (int d = 0; d < 4; ++d) o[d] = (f32x4){0.f, 0.f, 0.f, 0.f};
                    for (int it = 0; it < NT;) {
                        ATT_STEP(ka, va_, kb, vb_);
                        if (it >= NT) break;
                        ATT_STEP(kb, vb_, ka, va_);
                    }
#undef ATT_ITEM
#undef ATT_LOAD
#undef ATT_STEP
#undef ATT_CLAMP
                    l_run += __shfl_xor(l_run, 16); l_run += __shfl_xor(l_run, 32); const float inv = 1.0f / l_run;
                    bf16* op = MIX + (rowb + tq) * D + h * 64 + 4 * g4;
#pragma unroll
                    for (int d = 0; d < 4; ++d) { pg8::u32x2 w; w.x = pg8::cvt_pk_bf16(o[d][0] * inv, o[d][1] * inv); w.y = pg8::cvt_pk_bf16(o[d][2] * inv, o[d][3] * inv); *(pg8::u32x2*)(op + 16 * d) = w; }
                }
            }
            for (int u = bx; u < 1024; u += G) {
                const int h = u & 3, n = (u >> 2) & 31, b = u >> 7;
                unsigned* cw = (unsigned*)(ws + WS_CTL) + CW_SC + (b * 4 + h) * 64; unsigned* tmo = (unsigned*)(ws + WS_CTL) + CW_TMO2; const unsigned need = 32u * (unsigned)(layer + 1);
                if (wave == 0) { unsigned sp = 0; while (__hip_atomic_load(cw, __ATOMIC_RELAXED, __HIP_MEMORY_SCOPE_AGENT) < need) { __builtin_amdgcn_s_sleep(2);
                        if ((++sp & 255u) == 0u) { if (__hip_atomic_load(tmo, __ATOMIC_RELAXED, __HIP_MEMORY_SCOPE_AGENT) != 0u) break; if (sp > (1u << 20)) { __hip_atomic_store(tmo, 1u, __ATOMIC_RELAXED, __HIP_MEMORY_SCOPE_AGENT); break; } } } }
                __syncthreads();
                if (tid < 256) { const int idx = n * 256 + tid; float cc[32], dd[32];
                    float* cp = CST + (size_t)(b * 128 + h) * 8192 + idx; const float* dp = DEC + (b * 128 + h) * 64 + (idx & 63);
#pragma unroll
                    for (int m2 = 0; m2 < 32; ++m2) { cc[m2] = __hip_atomic_load(cp + (size_t)m2 * 4 * 8192, __ATOMIC_RELAXED, __HIP_MEMORY_SCOPE_AGENT); dd[m2] = __hip_atomic_load(dp + m2 * 4 * 64, __ATOMIC_RELAXED, __HIP_MEMORY_SCOPE_AGENT); }
                    float S = 0.f;
#pragma unroll
                    for (int m2 = 0; m2 < 32; ++m2) { cp[(size_t)m2 * 4 * 8192] = S; S = dd[m2] * S + cc[m2]; } }
            }
        }
        SEAM(pb + 1);
        if (IN(pb + 3)) {
            const int tid = pg8::tid_here(), lane = tid & 63; (void)lane;
            float* cum = (float*)lds; float* seg = cum + 4096;
            LAS unsigned char* qel = ldsl + 18432;
            LAS unsigned char* kel = ldsl + 27648;
            LAS unsigned char* vvl = ldsl + 36864;
            LAS unsigned char* stl = ldsl + 54272;
            float* rsq = (float*)(lds + 72704);
            const float* gn = args.gla_g_norm + layer * 128;
            for (int rep_ = 0; rep_ < 1 + ((args.pad >> 8) & 1); ++rep_)
            for (int u = bx; u < 1024; u += G) {
                const int h = u & 3, n = (u >> 2) & 31, b = u >> 7; const size_t row0 = (size_t)b * SEQ + n * 64;
                const int tr = tid >> 3, c8 = tid & 7;
                const v4u qraw = *(const v4u*)(U + (row0 + tr) * NU + UGQ + h * 64 + 8 * c8), kraw = *(const v4u*)(U + (row0 + tr) * NU + UGK + h * 64 + 8 * c8);
                const v4u* vp = (const v4u*)(U + (row0 + tr) * NU + UGV + h * 128 + c8 * 16); const v4u x0 = vp[0], x1 = vp[1];
                const int sv = tid >> 2, skq = (tid & 3) * 16; const f32x4* sp = (const f32x4*)(CST + ((size_t)u * 128 + sv) * 64 + skq);
                const f32x4 a0 = sp[0], a1 = sp[1], a2 = sp[2], a3 = sp[3];
                { float c = 0.f; float lav[8]; const float* lap = (const float*)(ws + WS_LA) + (row0 + 8 * wave) * 256 + h * 64 + lane;
#pragma unroll
                  for (int i = 0; i < 8; ++i) lav[i] = lap[i * 256];
#pragma unroll
                  for (int i = 0; i < 8; ++i) { c += lav[i]; cum[(8 * wave + i) * 64 + lane] = c; }
                  seg[wave * 64 + lane] = c; }
                __syncthreads();
                { f32x4 offa = (f32x4){0.f, 0.f, 0.f, 0.f}, offb = offa; const int wq = tr >> 3;
#pragma unroll
                  for (int w = 0; w < 7; ++w) { if (w < wq) { offa += *(const f32x4*)(seg + w * 64 + 8 * c8); offb += *(const f32x4*)(seg + w * 64 + 8 * c8 + 4); } }
                  const f32x4 ca = *(const f32x4*)(cum + tr * 64 + 8 * c8) + offa, cb = *(const f32x4*)(cum + tr * 64 + 8 * c8 + 4) + offb;
                  float ea[8];
#pragma unroll
                  for (int j = 0; j < 4; ++j) { ea[j] = __expf(ca[j]); ea[4 + j] = __expf(cb[j]); }
                  v4u wq_, wk_;
                  wq_.x = pk2(bflo(qraw.x) * ea[0], bfhi(qraw.x) * ea[1]); wq_.y = pk2(bflo(qraw.y) * ea[2], bfhi(qraw.y) * ea[3]); wq_.z = pk2(bflo(qraw.z) * ea[4], bfhi(qraw.z) * ea[5]); wq_.w = pk2(bflo(qraw.w) * ea[6], bfhi(qraw.w) * ea[7]);
                  wk_.x = pk2(bflo(kraw.x) / ea[0], bfhi(kraw.x) / ea[1]); wk_.y = pk2(bflo(kraw.y) / ea[2], bfhi(kraw.y) / ea[3]); wk_.z = pk2(bflo(kraw.z) / ea[4], bfhi(kraw.z) / ea[5]); wk_.w = pk2(bflo(kraw.w) / ea[6], bfhi(kraw.w) / ea[7]);
                  *(LAS v4u*)(qel + tr * 144 + c8 * 16) = wq_; *(LAS v4u*)(kel + tr * 144 + c8 * 16) = wk_;
                  LAS v4u* vd = (LAS v4u*)(vvl + tr * 272 + c8 * 32); vd[0] = x0; vd[1] = x1;
                  v4u w0, w1; w0.x = pk2(a0[0], a0[1]); w0.y = pk2(a0[2], a0[3]); w0.z = pk2(a1[0], a1[1]); w0.w = pk2(a1[2], a1[3]);
                  w1.x = pk2(a2[0], a2[1]); w1.y = pk2(a2[2], a2[3]); w1.z = pk2(a3[0], a3[1]); w1.w = pk2(a3[2], a3[3]);
                  LAS v4u* sd = (LAS v4u*)(stl + sv * 144 + skq * 2); sd[0] = w0; sd[1] = w1; }
                __syncthreads();
                { const int tt = wave & 3, vh = wave >> 2, ql = lane & 15, g4 = lane >> 4; const int t = 16 * tt + ql;
                  const bf16x8 qb0 = frag_rm(qel, 144, 16 * tt, 0, lane), qb1 = frag_rm(qel, 144, 16 * tt, 32, lane);
                  f32x4 sT[4];
#pragma unroll
                  for (int st = 0; st < 4; ++st) { sT[st] = (f32x4){0.f, 0.f, 0.f, 0.f};
                      if (st <= tt) { sT[st] = MFMA16(frag_rm(kel, 144, 16 * st, 0, lane), qb0, sT[st]); sT[st] = MFMA16(frag_rm(kel, 144, 16 * st, 32, lane), qb1, sT[st]);
#pragma unroll
                          for (int rg = 0; rg < 4; ++rg) if (16 * st + 4 * g4 + rg > t) sT[st][rg] = 0.f; } }
                  const bf16x8 pb0 = pack8(sT[0], sT[1]), pb1 = pack8(sT[2], sT[3]);
                  f32x4 acc[4]; float ss = 0.f;
#pragma unroll
                  for (int vt = 0; vt < 4; ++vt) { const int V0 = 16 * (4 * vh + vt); f32x4 a = (f32x4){0.f, 0.f, 0.f, 0.f};
                      a = MFMA16(frag_trp(vvl, 272, V0, 0, lane), pb0, a); a = MFMA16(frag_trp(vvl, 272, V0, 32, lane), pb1, a);
                      a = MFMA16(frag_rm(stl, 144, V0, 0, lane), qb0, a); a = MFMA16(frag_rm(stl, 144, V0, 32, lane), qb1, a);
                      acc[vt] = a; ss += (a[0] * a[0] + a[1] * a[1]) + (a[2] * a[2] + a[3] * a[3]); }
                  ss += __shfl_xor(ss, 16); ss += __shfl_xor(ss, 32);
                  if (g4 == 0) rsq[(tt * 2 + vh) * 16 + ql] = ss;
                  __syncthreads();
                  const float rs = 1.0f / sqrtf((rsq[(tt * 2) * 16 + ql] + rsq[(tt * 2 + 1) * 16 + ql]) * (1.0f / 128.0f) + pg8::RMS_EPS);
#pragma unroll
                  for (int vt = 0; vt < 4; ++vt) { const int v0 = 16 * (4 * vh + vt) + 4 * g4;
                      const pg8::u32x2 gr = *(const pg8::u32x2*)(U + (row0 + t) * NU + UGR + h * 128 + v0); const f32x4 gv = *(const f32x4*)(gn + v0);
                      const float o0 = acc[vt][0] * rs * gv[0] * pg8::silu_f(bflo(gr.x)), o1 = acc[vt][1] * rs * gv[1] * pg8::silu_f(bfhi(gr.x));
                      const float o2 = acc[vt][2] * rs * gv[2] * pg8::silu_f(bflo(gr.y)), o3 = acc[vt][3] * rs * gv[3] * pg8::silu_f(bfhi(gr.y));
                      pg8::u32x2 w; w.x = pg8::cvt_pk_bf16(o0, o1); w.y = pg8::cvt_pk_bf16(o2, o3);
                      *(pg8::u32x2*)(MIX + (row0 + t) * D + 256 + h * 128 + v0) = w; } }
                __syncthreads();
            }
        }
        SEAM(pb + 3);
        if (IN(pb + 4)) {
            pg8::Gemm g{MIX, (const bf16*)(ws + WS_WOUT) + (size_t)layer * D * D, M, D, D, D}; pg8::StaticOrder S; S.init(M, D, G, bx);
            if constexpr (layer == 0) { pg8::EpiRes<true> E{args.x, XBD, SSD}; pg8::gemm_phase<pg8::EpiRes<true>, pg8::StaticOrder, true, true>(ldsl, g, S, E, noepi); }
            else { pg8::EpiRes<false> E{XB, XBD, SSD}; pg8::gemm_phase<pg8::EpiRes<false>, pg8::StaticOrder, true, true>(ldsl, g, S, E, noepi); }
        }
        SEAM(pb + 4);
        if (layer == 0) {
            if (IN(pb + 5)) {
                pg8::Gemm g{XB, W13, M, 2 * FF, D, D}; pg8::StaticOrder S; S.init(M, 2 * FF, G, bx);
                pg8::EpiGlu<false> E{H, FF, SS};
                pg8::gemm_phase<pg8::EpiGlu<false>, pg8::StaticOrder, true, true>(ldsl, g, S, E, noepi);
            }
            SEAM(pb + 5);
            if (IN(pb + 6)) {
                pg8::Gemm g{H, W2, M, D, FF, FF}; pg8::StaticOrder S; S.init(M, D, G, bx);
#if defined(PROBE_EPI) && PROBE_EPI
                if (dry) { pg8::EpiRes<false, PROBE_EPI> E{XB, XBD, SSD}; pg8::gemm_phase<pg8::EpiRes<false, PROBE_EPI>, pg8::StaticOrder, true, true>(ldsl, g, S, E, noepi); } else
#endif
                { pg8::EpiRes<false> E{XB, XBD, SSD}; pg8::gemm_phase<pg8::EpiRes<false>, pg8::StaticOrder, true, true>(ldsl, g, S, E, noepi); }
            }
            SEAM(pb + 6);
        } else {
            for (int rp_ = 0; rp_ < 1 + ((args.pad >> 14) & 1); ++rp_)
            if (IN(pb + 5)) {
                const int tid = pg8::tid_here(), lane = tid & 63; (void)lane;
                float* wr_l = (float*)lds;
                int* cnt_l = (int*)(lds + 32768);
                const float* gf = args.g_ffn + D;
                { f32x4 ra[2][2]; float gk[2];
#pragma unroll
                  for (int j = 0; j < 2; ++j) { const int k = tid + NTHR * j; ra[j][0] = *(const f32x4*)(args.moe_router + k * 8); ra[j][1] = *(const f32x4*)(args.moe_router + k * 8 + 4); gk[j] = gf[k]; }
#pragma unroll
                  for (int j = 0; j < 2; ++j) { const int k = tid + NTHR * j;
#pragma unroll
                      for (int e = 0; e < 4; ++e) { wr_l[e * D + k] = ra[j][0][e] * gk[j]; wr_l[(4 + e) * D + k] = ra[j][1][e] * gk[j]; } } }
                if (tid < 8) cnt_l[tid] = 0;
                __syncthreads();
                for (int blk = bx; blk < 256; blk += G) {
                    if (blk != bx) { __syncthreads(); if (tid < 8) cnt_l[tid] = 0; __syncthreads(); }
                    v4u xpre[8][2];
#pragma unroll
                    for (int i = 0; i < 8; ++i) { const v4u* xr = (const v4u*)(XB + (size_t)(blk * 64 + wave * 8 + i) * D) + lane; xpre[i][0] = xr[0]; xpre[i][1] = xr[64]; }
                    const int mi = blk * 64 + wave * 8 + (lane >> 3);
                    typedef float f32x2_t __attribute__((ext_vector_type(2))); const f32x2_t ssp = *(const f32x2_t*)(SS + (size_t)mi * 16 + 2 * (lane & 7));
                    float v[64];
#pragma unroll
                    for (int q = 0; q < 64; ++q) v[q] = 0.f;
#pragma unroll
                    for (int eh = 0; eh < 2; ++eh) { f32x4 w[4][2][2];
#pragma unroll
                        for (int e = 0; e < 4; ++e)
#pragma unroll
                            for (int j = 0; j < 2; ++j) { const float* wp = wr_l + (4 * eh + e) * D + 8 * (lane + 64 * j); w[e][j][0] = *(const f32x4*)wp; w[e][j][1] = *(const f32x4*)(wp + 4); }
#pragma unroll
                        for (int i = 0; i < 8; ++i)
#pragma unroll
                            for (int j = 0; j < 2; ++j) { const v4u xw = xpre[i][j];
                                const f32x4 va = (f32x4){bflo(xw.x), bfhi(xw.x), bflo(xw.y), bfhi(xw.y)}, vb = (f32x4){bflo(xw.z), bfhi(xw.z), bflo(xw.w), bfhi(xw.w)};
#pragma unroll
                                for (int e = 0; e < 4; ++e) v[i * 8 + 4 * eh + e] += ((va[0] * w[e][j][0][0] + va[1] * w[e][j][0][1]) + (va[2] * w[e][j][0][2] + va[3] * w[e][j][0][3])) + ((vb[0] * w[e][j][1][0] + vb[1] * w[e][j][1][1]) + (vb[2] * w[e][j][1][2] + vb[3] * w[e][j][1][3])); } }
#pragma unroll
                    for (int st = 32; st >= 1; st >>= 1) { const bool up = (lane & st) != 0;
#pragma unroll
                        for (int q = 0; q < st; ++q) { const float send = up ? v[q] : v[q + st]; const float keep = up ? v[q + st] : v[q]; v[q] = keep + __shfl_xor(send, st); } }
                    float ssq = ssp[0] + ssp[1]; ssq += __shfl_xor(ssq, 1); ssq += __shfl_xor(ssq, 2); ssq += __shfl_xor(ssq, 4);
                    const float rs = 1.0f / sqrtf(ssq * (1.0f / 1024.0f) + pg8::RMS_EPS);
                    const float lg = v[0] * rs; const int me = lane & 7;
                    float bv = lg; int bi = me;
#pragma unroll
                    for (int st = 1; st < 8; st <<= 1) { const float ov = __shfl_xor(bv, st); const int oi = __shfl_xor(bi, st); if (ov > bv || (ov == bv && oi < bi)) { bv = ov; bi = oi; } }
                    float cv = (me == bi) ? -INFINITY : lg; int ci = me;
#pragma unroll
                    for (int st = 1; st < 8; st <<= 1) { const float ov = __shfl_xor(cv, st); const int oi = __shfl_xor(ci, st); if (ov > cv || (ov == cv && oi < ci)) { cv = ov; ci = oi; } }
                    if (me == 0) { const float w1 = 1.0f / (1.0f + __expf(bv - cv)), w0 = 1.0f - w1;
                        TOPI[mi * 2] = bi; TOPI[mi * 2 + 1] = ci; TOPW[mi * 2] = w0; TOPW[mi * 2 + 1] = w1; RS3[mi] = rs; atomicAdd(&cnt_l[bi], 1); atomicAdd(&cnt_l[ci], 1); }
                    __syncthreads();
                    if (tid < 8) CNT[blk * 8 + tid] = cnt_l[tid];
                }
            }
            SEAM(pb + 5);
            for (int rp_ = 0; rp_ < 1 + ((args.pad >> 15) & 1); ++rp_)
            if (IN(pb + 6)) {
                const int tid = pg8::tid_here(), lane = tid & 63; (void)lane;
                int* base_l = (int*)lds;
                int* pre_l = base_l + 8;
                int* tot_l = pre_l + 8;
                int* pos_l = tot_l + 8;
                int* ent_l = pos_l + 128;
                for (int blk = bx; blk < 256; blk += G) {
                    __syncthreads();
                    if (tid < 8) { tot_l[tid] = 0; pre_l[tid] = 0; }
                    if (tid < 128) ent_l[tid] = TOPI[blk * 128 + tid];
                    __syncthreads();
                    { const int g2 = tid >> 1, e0 = (tid & 1) * 4; const int4 c = *(const int4*)(CNT + g2 * 8 + e0);
                      atomicAdd(&tot_l[e0], c.x); atomicAdd(&tot_l[e0 + 1], c.y); atomicAdd(&tot_l[e0 + 2], c.z); atomicAdd(&tot_l[e0 + 3], c.w);
                      if (g2 < blk) { atomicAdd(&pre_l[e0], c.x); atomicAdd(&pre_l[e0 + 1], c.y); atomicAdd(&pre_l[e0 + 2], c.z); atomicAdd(&pre_l[e0 + 3], c.w); } }
                    __syncthreads();
                    if (tid == 0) { int bs = 0; for (int e = 0; e < 8; ++e) { base_l[e] = bs; bs += (tot_l[e] + 255) & ~255; } }
                    __syncthreads();
                    if (tid < 128) { const int e = ent_l[tid]; int rank = 0; for (int j = 0; j < tid; ++j) rank += (ent_l[j] == e) ? 1 : 0;
                        const int p = base_l[e] + pre_l[e] + rank; pos_l[tid] = p; POS[blk * 128 + tid] = p; ROWGATE[p] = TOPW[blk * 128 + tid]; ROWRS[p] = RS3[blk * 64 + (tid >> 1)]; }
                    if (blk == 0) {
                        for (int e = 0; e < 8; ++e) { const int npe = (tot_l[e] + 255) >> 8; for (int p = base_l[e] + tot_l[e] + tid; p < base_l[e] + npe * 256; p += NTHR) { ROWGATE[p] = 0.f; ROWRS[p] = 0.f; } }
                        if (tid == 0) { int np = 0; for (int e = 0; e < 8; ++e) { const int npe = (tot_l[e] + 255) >> 8; for (int j = 0; j < npe; ++j) PANE[np++] = e; } PANE[MAXPAN] = np; } }
                    __syncthreads();
                    for (int i = 0; i < 16; ++i) { const int sl = wave * 16 + i; const int m = blk * 64 + (sl >> 1); const int p = pos_l[sl];
                        const v4u* s = (const v4u*)(XB + (size_t)m * D) + lane; v4u* d = (v4u*)(XS + (size_t)p * D) + lane; d[0] = s[0]; d[64] = s[64]; }
                }
            }
            SEAM(pb + 6);
            if (IN(pb + 7)) {
                pg8::Gemm g{XS, WE13, MAXROWS, 2 * FE, D, D}; pg8::MoeOrder S{PANE, PANE[MAXPAN], 28, 4, G, bx};
                pg8::EpiGlu<true> E{HE, FE, ROWRS};
                pg8::gemm_phase<pg8::EpiGlu<true>, pg8::MoeOrder, true, true>(ldsl, g, S, E, noepi);
            }
            SEAM(pb + 7);
            for (int rp_ = 0; rp_ < 1 + ((args.pad >> 7) & 1); ++rp_)
            if (IN(pb + 8)) {
                const int tid = pg8::tid_here(), lane = tid & 63; (void)lane;
                unsigned* scr = (unsigned*)(lds + wave * 8704);
                constexpr int T_J = 56 * 16;
                for (int it = gw; it < 8 * T_J; it += NGW) { const int e = it / T_J, r = it % T_J;
                    transpose_tile(args.moe_w2 + (size_t)e * FE * D, D, 64 * (r / 16), 64 * (r % 16), WE2 + (size_t)e * D * FE, FE, 64 * (r % 16), nullptr, scr, lane); }
            }
            SEAM(pb + 8);
            if (IN(pb + 9)) {
                const int npan = PANE[MAXPAN]; int npf = ((npan * 4) / G) * G / 4; if (npan - npf > 8 || npf == 0) npf = npan;
                { pg8::Gemm g{HE, WE2, MAXROWS, D, FE, FE}; pg8::MoeOrder S{PANE, npf, 4, 8, G, bx};
                  pg8::EpiMoeDown E{Y, ROWGATE};
                  pg8::gemm_phase<pg8::EpiMoeDown, pg8::MoeOrder, true, true>(ldsl, g, S, E, noepi); }
                if (npan > npf) { __syncthreads();
                  pg8::Gemm g{HE, WE2, MAXROWS, D, 896, FE}; pg8::MoeTailOrder S{PANE, npf, npan - npf, G, bx};
                  pg8::EpiMoeDownPart E{(float*)(ws + WS_YT), ROWGATE, npf * 256};
                  pg8::gemm_phase<pg8::EpiMoeDownPart, pg8::MoeTailOrder, true, true>(ldsl, g, S, E, noepi); }
            }
            SEAM(pb + 9);
            if (IN(pb + 10)) {
                const int tid = pg8::tid_here(), lane = tid & 63; (void)lane;
                const int npan_f = PANE[MAXPAN]; int npf_f = ((npan_f * 4) / G) * G / 4; if (npan_f - npf_f > 8 || npf_f == 0) npf_f = npan_f; const int tail0 = npf_f * 256;
                for (int rep_ = 0; rep_ < 1 + ((args.pad >> 12) & 1); ++rep_)
                for (int m = gw; m < M; m += NGW) {
                    f32x4* xr = (f32x4*)(X + (size_t)m * D) + lane; const int p0 = POS[m * 2], p1 = POS[m * 2 + 1];
                    const unsigned long long* xb = (const unsigned long long*)(XB + (size_t)m * D) + lane;
                    f32x4 v[4]; float s = 0.f;
#pragma unroll
                    for (int j = 0; j < 4; ++j) { const unsigned long long xw = xb[64 * j]; v[j] = (f32x4){bflo((unsigned)xw), bfhi((unsigned)xw), bflo((unsigned)(xw >> 32)), bfhi((unsigned)(xw >> 32))}; }
#pragma unroll
                    for (int sl = 0; sl < 2; ++sl) { const int p = sl ? p1 : p0;
                        if (p < tail0) { const unsigned long long* yp = (const unsigned long long*)(Y + (size_t)p * D) + lane;
#pragma unroll
                            for (int j = 0; j < 4; ++j) { const unsigned long long a = yp[64 * j]; v[j] += (f32x4){bflo((unsigned)a), bfhi((unsigned)a), bflo((unsigned)(a >> 32)), bfhi((unsigned)(a >> 32))}; } }
                        else { const f32x4* tp = (const f32x4*)((const float*)(ws + WS_YT) + (size_t)(p - tail0) * D) + lane;
#pragma unroll
                            for (int kq = 0; kq < 4; ++kq)
#pragma unroll
                                for (int j = 0; j < 4; ++j) v[j] += tp[(size_t)kq * 2048 * (D / 4) + 64 * j]; } }
#pragma unroll
                    for (int j = 0; j < 4; ++j) s += (v[j][0] * v[j][0] + v[j][1] * v[j][1]) + (v[j][2] * v[j][2] + v[j][3] * v[j][3]);
                    const float rs = 1.0f / sqrtf(wave_sum(s) * (1.0f / D) + pg8::RMS_EPS);
                    const f32x4* gf = (const f32x4*)args.g_final + lane;
#pragma unroll
                    for (int j = 0; j < 4; ++j) (dry ? (f32x4*)((float*)(ws + WS_HE) + (size_t)m * D) + lane : xr)[64 * j] = v[j] * rs * gf[64 * j];
                }
            }
        }
}

__global__ void __launch_bounds__(NTHR, 2) hybrid_fwd(Args args) {
    extern __shared__ __attribute__((aligned(16))) unsigned char lds[];
    LAS unsigned char* ldsl = (LAS unsigned char*)lds;
    volatile LAS unsigned* MISC = (volatile LAS unsigned*)(ldsl + MISC_OFF);
    const int tid = threadIdx.x, lane = tid & 63, wave = __builtin_amdgcn_readfirstlane(tid >> 6);
    const int G = gridDim.x; const int bx = blockIdx.x;
    const int gw = bx * NWAVES + wave, NGW = G * NWAVES;
    unsigned char* ws = args.ws;
    for (int u = tid; u < (LDS_BYTES - LDSCTL_OFF) / 4; u += NTHR) ((LAS unsigned*)(ldsl + LDSCTL_OFF))[u] = 0u;
    __syncthreads();
    XcdBarrier bar; bar.bar = (unsigned*)(ws + WS_CTL) + CW_BAR + args.li * XCD_BAR_WORDS; bar.x = 0; bar.st = nullptr;
    if (MK_N_LAUNCHES == 1) bar = xcd_barrier_post((unsigned*)(ws + WS_CTL) + CW_BAR + args.li * XCD_BAR_WORDS, MISC + 8);
    const int lo = args.ph_lo, hi = args.ph_hi;

    WS_PTRS

    for (int rp_ = 0; rp_ < 1 + ((args.pad >> 6) & 1); ++rp_)
    if (IN(0)) {
        unsigned* scr = (unsigned*)(lds + wave * 8704);
        constexpr int T_A = 16 * 36, T_B = 16 * 12, T_D = 16 * 16, T_L = T_A + T_B + T_D;
        constexpr int T_F = 16 * 44, T_G = 44 * 16, T_E = 16 * 56;
        constexpr int NT0 = 2 * T_L + 2 * T_F + T_G + 16 * T_E;
        for (int it = gw; it < NT0; it += NGW) {
            int r = it;
            if (r < 2 * T_L) { const int l = r / T_L; r -= l * T_L; const float* win = args.w_mix_in + (size_t)l * D * INC; const float* gm = args.g_mix + l * D;
                bf16* WIN = (bf16*)(ws + WS_WIN) + (size_t)l * NU * D;
                if (r < T_A) { transpose_tile(win, INC, 64 * (r / 36), 64 * (r % 36), WIN, D, 64 * (r % 36), gm, scr, lane); continue; } r -= T_A;
                if (r < T_B) { transpose_tile(win, INC, 64 * (r / 12), 2320 + 64 * (r % 12), WIN, D, 2304 + 64 * (r % 12), gm, scr, lane); continue; } r -= T_B;
                transpose_tile(args.w_mix_out + (size_t)l * D * D, D, 64 * (r / 16), 64 * (r % 16), (bf16*)(ws + WS_WOUT) + (size_t)l * D * D, D, 64 * (r % 16), nullptr, scr, lane); continue; }
            r -= 2 * T_L;
            if (r < 2 * T_F) { const int w3 = r / T_F; r -= w3 * T_F; const int n0 = 64 * (r % 44);
                transpose_tile(w3 ? args.ffn_w3 : args.ffn_w1, FF, 64 * (r / 44), n0, W13, D, (n0 >> 7) * 256 + (n0 & 127) + 128 * w3, args.g_ffn, scr, lane); continue; }
            r -= 2 * T_F;
            if (r < T_G) { transpose_tile(args.ffn_w2, D, 64 * (r / 16), 64 * (r % 16), W2, FF, 64 * (r % 16), nullptr, scr, lane); continue; }
            r -= T_G;
            { const int ew = r / T_E; r -= ew * T_E; const int e = ew >> 1, w3 = ew & 1; const int n0 = 64 * (r % 56);
              transpose_tile((w3 ? args.moe_w3 : args.moe_w1) + (size_t)e * D * FE, FE, 64 * (r / 56), n0, WE13 + (size_t)e * 2 * FE * D, D, (n0 >> 7) * 256 + (n0 & 127) + 128 * w3, args.g_ffn + D, scr, lane); }
        }
        for (int m = gw; m < M; m += NGW) {
            const f32x4* xr = (const f32x4*)(args.x + (size_t)m * D) + lane; float s = 0.f;
            unsigned long long* o8 = (unsigned long long*)(XB + (size_t)m * D) + lane;
#pragma unroll
            for (int j = 0; j < 4; ++j) { const f32x4 v = xr[64 * j]; s += (v[0] * v[0] + v[1] * v[1]) + (v[2] * v[2] + v[3] * v[3]);
                o8[64 * j] = (unsigned long long)pk2(v[0], v[1]) | ((unsigned long long)pk2(v[2], v[3]) << 32); }
            s = wave_sum(s);
            if (lane < 16) SS[(size_t)m * 16 + lane] = (lane == 0) ? s : 0.f;
        }
        for (int i = bx * NTHR + tid; i < 2049 * 4; i += G * NTHR) { const int d = i >> 2, h = i & 3; BL[i] = args.rel_bias[rel_bucket(d) * 4 + h] * LOG2E; }
        for (int i = bx * NTHR + tid; i < 2 * 16 * D; i += G * NTHR) { const int k = i & (D - 1), r = (i >> 10) & 15, l = i >> 14;
            ((bf16*)(ws + WS_WGLR))[i] = (bf16)f2bf(args.g_mix[l * D + k] * args.w_mix_in[((size_t)l * D + k) * INC + 2304 + r]); }
    }
    SEAM(0);

    Ctx c; c.args = args; c.tid = tid; c.lane = lane; c.wave = wave; c.G = G; c.bx = bx; c.gw = gw; c.NGW = NGW; c.lo = lo; c.hi = hi; c.bar = bar;
    layer_phases<0>(c, lds);
    layer_phases<1>(c, lds);
}
#undef IN
#undef SEAM
#undef GRID_BAR


extern "C" void kernel_launch(void* const* d_in, const int* in_sizes, int n_in, void* d_out, int out_size, void* d_ws, size_t ws_size, hipStream_t stream) {
    static int grid = 0;
    if (grid == 0) {
        if (n_in != 18 || in_sizes[0] != M * D || out_size != M * D || ws_size < WS_END) { fprintf(stderr, "kernel_launch: unexpected shapes / workspace (%zu < %zu)\n", ws_size, (size_t)WS_END); grid = -1; return; }
        int dev = 0, cus = 0, per_cu = 0;
        if (hipGetDevice(&dev) != hipSuccess || hipDeviceGetAttribute(&cus, hipDeviceAttributeMultiprocessorCount, dev) != hipSuccess) { grid = -1; return; }
        if (hipFuncSetAttribute((const void*)hybrid_fwd, hipFuncAttributeMaxDynamicSharedMemorySize, LDS_BYTES) != hipSuccess) { fprintf(stderr, "kernel_launch: hipFuncSetAttribute failed\n"); grid = -1; return; }
        if (hipOccupancyMaxActiveBlocksPerMultiprocessor(&per_cu, (const void*)hybrid_fwd, NTHR, LDS_BYTES) != hipSuccess || per_cu < 1) { fprintf(stderr, "kernel_launch: occupancy query says %d\n", per_cu); }
        (void)hipGetLastError();
        grid = cus;
    }
    if (grid < 0) return;
    if (hipMemsetAsync((char*)d_ws + WS_CTL, 0, CTL_ZERO_BYTES, stream) != hipSuccess) return;
    Args a{};
    const float** f = (const float**)&a;
    for (int i = 0; i < 18; ++i) f[i] = (const float*)d_in[i];
    a.out = (float*)d_out; a.ws = (unsigned char*)d_ws;
    if (MK_N_LAUNCHES == 1) {
#ifndef PROBE_MODE
#define PROBE_MODE 0
#endif
#ifdef PROBE_PHASE
        const int cuts[4][2] = {{0, PROBE_PHASE}, {PROBE_PHASE, PROBE_PHASE + 1}, {PROBE_PHASE, 64}, {0, 0}};
        for (int li = 0; li < 3; ++li) { a.ph_lo = cuts[li][0]; a.ph_hi = cuts[li][1]; a.li = li; a.pad = (li == 1) ? PROBE_MODE : 0; hipLaunchKernelGGL(hybrid_fwd, dim3(grid), dim3(NTHR), LDS_BYTES, stream, a); }
#else
        a.ph_lo = 0; a.ph_hi = 64; a.li = 0;
#ifndef PROBE_LOW
#define PROBE_LOW 0
#endif
#ifdef PROBE_REP
        a.pad = (PROBE_REP << 8) | PROBE_LOW;
#endif
        hipLaunchKernelGGL(hybrid_fwd, dim3(grid), dim3(NTHR), LDS_BYTES, stream, a);
#endif
    }
    else {
        static const int phases[] = {0, 1, 2, 3, 4, 5, 6, 7, 17, 18, 19, 20, 21, 22, 23, 24, 25, 26, 27};
        for (int p : phases) { a.ph_lo = p; a.ph_hi = p + 1; hipLaunchKernelGGL(hybrid_fwd, dim3(grid), dim3(NTHR), LDS_BYTES, stream, a); }
    }
}
```

```cpp
#include <hip/hip_runtime.h>
#include <cstdio>
#include <cstdint>

#ifndef MK_N_LAUNCHES
#define MK_N_LAUNCHES 1
#endif

namespace pg8 {
#define PG8_LAS __attribute__((address_space(3)))
__device__ __forceinline__ int tid_here() { int t = threadIdx.x; asm volatile("" : "+v"(t)); return t; }
typedef unsigned short bf16_t;
typedef short bf16x8 __attribute__((ext_vector_type(8)));
typedef float f32x4 __attribute__((ext_vector_type(4)));
typedef unsigned u32x4 __attribute__((ext_vector_type(4)));
typedef unsigned u32x2 __attribute__((ext_vector_type(2)));
constexpr int BM = 256, BK = 64, HALF = 128, HTB = HALF * BK * 2, STAGE_BYTES = 8 * HTB, NXCD = 8, WGM = 8;

__host__ __device__ __forceinline__ int lds_byte(int r, int c) { const int st = (r >> 4) * 2 + (c >> 5), rr = r & 15, cc = c & 31, ob = rr * 64 + cc * 2; return st * 1024 + (ob ^ (((ob >> 9) & 1) << 5)); }
__host__ __device__ __forceinline__ void stage_rc(int b, int& R, int& C) { const int st = b / 1024, sb = b % 1024, swz = sb ^ (((sb >> 9) & 1) << 5); R = (st >> 1) * 16 + swz / 64; C = (st & 1) * 32 + (swz % 64) / 2; }
__host__ __device__ __forceinline__ int perm32(int rho) { const int n = rho >> 4, i = rho & 15; return 8 * (i >> 2) + 4 * n + (i & 3); }

struct Unit { int pm, pn, ko; };
struct Gemm { const bf16_t* A; const bf16_t* Bt; int M, N, K, ld; };

struct StaticOrder {
    int nM, nN, nwg, G, c;
    __host__ __device__ void init(int M, int N, int G_, int c_) { nM = M / BM; nN = N / BM; nwg = nM * nN; G = G_; c = c_; }
    __host__ __device__ bool next(int i, Unit& u) const {
        const long L = (long)i * G + c; if (L >= nwg) return false;
        int wgid = (int)L; { const int q = nwg / NXCD, r = nwg % NXCD, xcd = wgid % NXCD, off = wgid / NXCD; wgid = (xcd < r ? xcd * (q + 1) : r * (q + 1) + (xcd - r) * q) + off; }
        const int nig = WGM * nN, gid = wgid / nig, fm = gid * WGM, gsz = (nM - fm) < WGM ? (nM - fm) : WGM;
        u.pm = fm + ((wgid % nig) % gsz); u.pn = (wgid % nig) / gsz; u.ko = 0; return true;
    }
    __device__ __forceinline__ void a_ready(const Unit&) const {}
    __device__ __forceinline__ void done(const Unit&) const {}
};
struct MoeOrder {
    const int* panel_e; int npan, NT, GP, G, c;
    __device__ bool next(int i, Unit& u) const {
        const int nwg = npan * NT; const long L = (long)i * G + c; if (L >= nwg) return false;
        int wgid = (int)L; { const int q = nwg / NXCD, r = nwg % NXCD, xcd = wgid % NXCD, off = wgid / NXCD; wgid = (xcd < r ? xcd * (q + 1) : r * (q + 1) + (xcd - r) * q) + off; }
        const int nig = GP * NT, grp = wgid / nig, fm = grp * GP, gsz = (npan - fm) < GP ? (npan - fm) : GP; const int rr = wgid % nig;
        const int p = fm + rr % gsz; u.pm = p; u.pn = panel_e[p] * NT + rr / gsz; u.ko = 0; return true;
    }
    __device__ __forceinline__ void a_ready(const Unit&) const {}
    __device__ __forceinline__ void done(const Unit&) const {}
};

struct MoeTailOrder {
    const int* panel_e; int p0, ntp, G, c;
    __device__ bool next(int i, Unit& u) const {
        const long L = (long)i * G + c; if (L >= (long)ntp * 16) return false;
        const int kq = (int)L & 3, r = (int)L >> 2, p = p0 + (r >> 2); u.pm = p; u.pn = panel_e[p] * 4 + (r & 3); u.ko = kq * 896 * 2; return true;
    }
    __device__ __forceinline__ void a_ready(const Unit&) const {}
    __device__ __forceinline__ void done(const Unit&) const {}
};
typedef float f32x2c_t __attribute__((ext_vector_type(2))); typedef __bf16 bf16x2c_t __attribute__((ext_vector_type(2)));
__device__ __forceinline__ unsigned cvt_pk_bf16(float lo, float hi) { const f32x2c_t v = {lo, hi}; return __builtin_bit_cast(unsigned, __builtin_convertvector(v, bf16x2c_t)); }

constexpr float RMS_EPS = 1e-6f;
__device__ __forceinline__ float rstd_of(const float* ss16) {
    const f32x4 a = *(const f32x4*)ss16, b = *(const f32x4*)(ss16 + 4), c = *(const f32x4*)(ss16 + 8), d = *(const f32x4*)(ss16 + 12);
    const float s = ((a[0] + a[1]) + (a[2] + a[3])) + ((b[0] + b[1]) + (b[2] + b[3])) + ((c[0] + c[1]) + (c[2] + c[3])) + ((d[0] + d[1]) + (d[2] + d[3]));
    return __builtin_amdgcn_rsqf(s * (1.0f / 1024.0f) + RMS_EPS);
}
__device__ __forceinline__ void rstd4(const float* SS, int row0, float (&rs)[4]) {
    f32x4 p[4][4];
#pragma unroll
    for (int m = 0; m < 4; ++m)
#pragma unroll
        for (int q = 0; q < 4; ++q) p[m][q] = *(const f32x4*)(SS + (size_t)(row0 + 16 * m) * 16 + 4 * q);
    asm volatile("" : "+v"(p[0][0]), "+v"(p[0][1]), "+v"(p[0][2]), "+v"(p[0][3]), "+v"(p[1][0]), "+v"(p[1][1]), "+v"(p[1][2]), "+v"(p[1][3]),
                      "+v"(p[2][0]), "+v"(p[2][1]), "+v"(p[2][2]), "+v"(p[2][3]), "+v"(p[3][0]), "+v"(p[3][1]), "+v"(p[3][2]), "+v"(p[3][3]));
#pragma unroll
    for (int m = 0; m < 4; ++m) { const f32x4 a = p[m][0], b = p[m][1], c = p[m][2], d = p[m][3];
        const float s = ((a[0] + a[1]) + (a[2] + a[3])) + ((b[0] + b[1]) + (b[2] + b[3])) + ((c[0] + c[1]) + (c[2] + c[3])) + ((d[0] + d[1]) + (d[2] + d[3]));
        rs[m] = __builtin_amdgcn_rsqf(s * (1.0f / 1024.0f) + RMS_EPS); }
}
__device__ __forceinline__ float logsig16(float x) { return ((x < 0.f ? x : 0.f) - __logf(1.0f + __expf(-fabsf(x)))) * (1.0f / 16.0f); }
__device__ __forceinline__ float silu_f(float a) { return a * __builtin_amdgcn_rcpf(1.0f + __builtin_amdgcn_exp2f(a * -1.4426950408889634f)); }

struct EpiU {
    static constexpr bool PERM = true, AFTER_DRAIN = false;
    bf16_t* U; int ldu; const float* SS; float qs;
    __device__ __forceinline__ void operator()(const f32x4 (&acc)[2][2][4][2], const Unit& u, int wr, int wc, int fr, int fq) const {
        const int row0 = u.pm * BM + wr * 64 + fr, col0 = u.pn * BM + wc * 32 + 8 * fq;
        const float sc = (u.pn == 0) ? qs : ((u.pn == 3) ? 0.125f : 1.0f);
#pragma unroll
        for (int ai = 0; ai < 2; ++ai) { float rs4[4]; rstd4(SS, row0 + ai * HALF, rs4);
#pragma unroll
            for (int m = 0; m < 4; ++m) { const int row = row0 + ai * HALF + m * 16; const float rs = rs4[m] * sc;
                bf16_t* rowp = U + (size_t)row * ldu + col0;
#pragma unroll
                for (int bj = 0; bj < 2; ++bj) { const f32x4 v0 = acc[ai][bj][m][0] * rs, v1 = acc[ai][bj][m][1] * rs;
                    u32x4 w; w.x = cvt_pk_bf16(v0[0], v0[1]); w.y = cvt_pk_bf16(v0[2], v0[3]); w.z = cvt_pk_bf16(v1[0], v1[1]); w.w = cvt_pk_bf16(v1[2], v1[3]);
                    *(u32x4*)(rowp + bj * HALF) = w; } } }
    }
};
template <bool IN_F32, int PM = 0> struct EpiRes {
    static constexpr bool PERM = true, AFTER_DRAIN = false;
    const void* Xin; bf16_t* XB; float* SS;
    __device__ __forceinline__ void operator()(const f32x4 (&acc)[2][2][4][2], const Unit& u, int wr, int wc, int fr, int fq) const {
        const int row0 = u.pm * BM + wr * 64 + fr, col0 = u.pn * BM + wc * 32 + 8 * fq;
        if constexpr (IN_F32) {
#pragma unroll
            for (int ai = 0; ai < 2; ++ai) { f32x4 xo[4][2][2];
#pragma unroll
                for (int m = 0; m < 4; ++m)
#pragma unroll
                    for (int bj = 0; bj < 2; ++bj) { const float* p = (const float*)Xin + (size_t)(row0 + ai * HALF + m * 16) * 1024 + col0 + bj * HALF; xo[m][bj][0] = *(const f32x4*)p; xo[m][bj][1] = *(const f32x4*)(p + 4); }
                asm volatile("" : "+v"(xo[0][0][0]), "+v"(xo[0][0][1]), "+v"(xo[0][1][0]), "+v"(xo[0][1][1]), "+v"(xo[1][0][0]), "+v"(xo[1][0][1]), "+v"(xo[1][1][0]), "+v"(xo[1][1][1]),
                                  "+v"(xo[2][0][0]), "+v"(xo[2][0][1]), "+v"(xo[2][1][0]), "+v"(xo[2][1][1]), "+v"(xo[3][0][0]), "+v"(xo[3][0][1]), "+v"(xo[3][1][0]), "+v"(xo[3][1][1]));
#pragma unroll
                for (int m = 0; m < 4; ++m) { const int row = row0 + ai * HALF + m * 16; float ssum = 0.f;
#pragma unroll
                    for (int bj = 0; bj < 2; ++bj) { const f32x4 v0 = xo[m][bj][0] + acc[ai][bj][m][0], v1 = xo[m][bj][1] + acc[ai][bj][m][1];
                        u32x4 w; w.x = cvt_pk_bf16(v0[0], v0[1]); w.y = cvt_pk_bf16(v0[2], v0[3]); w.z = cvt_pk_bf16(v1[0], v1[1]); w.w = cvt_pk_bf16(v1[2], v1[3]);
                        *(u32x4*)(XB + (size_t)row * 1024 + col0 + bj * HALF) = w;
                        ssum += ((v0[0] * v0[0] + v0[1] * v0[1]) + (v0[2] * v0[2] + v0[3] * v0[3])) + ((v1[0] * v1[0] + v1[1] * v1[1]) + (v1[2] * v1[2] + v1[3] * v1[3])); }
                    ssum += __shfl_xor(ssum, 16); ssum += __shfl_xor(ssum, 32);
                    if (fq == 0) SS[(size_t)row * 16 + u.pn * 4 + wc] = ssum; } }
        } else {
            u32x4 xo[2][4][2];
#pragma unroll
            for (int ai = 0; ai < 2; ++ai)
#pragma unroll
                for (int m = 0; m < 4; ++m)
#pragma unroll
                    for (int bj = 0; bj < 2; ++bj) xo[ai][m][bj] = *(const u32x4*)((const bf16_t*)Xin + (size_t)(row0 + ai * HALF + m * 16) * 1024 + col0 + bj * HALF);
            asm volatile("" : "+v"(xo[0][0][0]), "+v"(xo[0][0][1]), "+v"(xo[0][1][0]), "+v"(xo[0][1][1]), "+v"(xo[0][2][0]), "+v"(xo[0][2][1]), "+v"(xo[0][3][0]), "+v"(xo[0][3][1]),
                              "+v"(xo[1][0][0]), "+v"(xo[1][0][1]), "+v"(xo[1][1][0]), "+v"(xo[1][1][1]), "+v"(xo[1][2][0]), "+v"(xo[1][2][1]), "+v"(xo[1][3][0]), "+v"(xo[1][3][1]));
#pragma unroll
            for (int ai = 0; ai < 2; ++ai)
#pragma unroll
                for (int m = 0; m < 4; ++m) { const int row = row0 + ai * HALF + m * 16; float ssum = 0.f;
#pragma unroll
                    for (int bj = 0; bj < 2; ++bj) { const u32x4 x = xo[ai][m][bj]; f32x4 v0, v1;
                        v0[0] = __builtin_bit_cast(float, x.x << 16) + acc[ai][bj][m][0][0]; v0[1] = __builtin_bit_cast(float, x.x & 0xffff0000u) + acc[ai][bj][m][0][1];
                        v0[2] = __builtin_bit_cast(float, x.y << 16) + acc[ai][bj][m][0][2]; v0[3] = __builtin_bit_cast(float, x.y & 0xffff0000u) + acc[ai][bj][m][0][3];
                        v1[0] = __builtin_bit_cast(float, x.z << 16) + acc[ai][bj][m][1][0]; v1[1] = __builtin_bit_cast(float, x.z & 0xffff0000u) + acc[ai][bj][m][1][1];
                        v1[2] = __builtin_bit_cast(float, x.w << 16) + acc[ai][bj][m][1][2]; v1[3] = __builtin_bit_cast(float, x.w & 0xffff0000u) + acc[ai][bj][m][1][3];
                        u32x4 w; w.x = cvt_pk_bf16(v0[0], v0[1]); w.y = cvt_pk_bf16(v0[2], v0[3]); w.z = cvt_pk_bf16(v1[0], v1[1]); w.w = cvt_pk_bf16(v1[2], v1[3]);
                        if constexpr (!(PM & 8)) *(u32x4*)(XB + (size_t)row * 1024 + col0 + bj * HALF) = w;
                        ssum += ((v0[0] * v0[0] + v0[1] * v0[1]) + (v0[2] * v0[2] + v0[3] * v0[3])) + ((v1[0] * v1[0] + v1[1] * v1[1]) + (v1[2] * v1[2] + v1[3] * v1[3])); }
                    if constexpr (!(PM & 16)) { ssum += __shfl_xor(ssum, 16); ssum += __shfl_xor(ssum, 32); }
                    if constexpr (!(PM & 4)) { if (fq == 0) SS[(size_t)row * 16 + u.pn * 4 + wc] = ssum; }
                    if constexpr ((PM & 12) == 12) asm volatile("" :: "v"(ssum)); }
        }
    }
};
template <bool MOE> struct EpiGlu {
    static constexpr bool PERM = true, AFTER_DRAIN = false;
    bf16_t* O; int ldo; const float* SS;
    __device__ __forceinline__ void operator()(const f32x4 (&acc)[2][2][4][2], const Unit& u, int wr, int wc, int fr, int fq) const {
        const int row0 = u.pm * BM + wr * 64 + fr; const int pnl = MOE ? (u.pn % 28) : u.pn; const int col0 = pnl * HALF + wc * 32 + 8 * fq;
#pragma unroll
        for (int ai = 0; ai < 2; ++ai) { float rs4[4];
            if constexpr (MOE) {
#pragma unroll
                for (int m = 0; m < 4; ++m) rs4[m] = SS[row0 + ai * HALF + m * 16];
                asm volatile("" : "+v"(rs4[0]), "+v"(rs4[1]), "+v"(rs4[2]), "+v"(rs4[3]));
            } else rstd4(SS, row0 + ai * HALF, rs4);
#pragma unroll
            for (int m = 0; m < 4; ++m) { const int row = row0 + ai * HALF + m * 16; const float rs = rs4[m];
                const f32x4 a0 = acc[ai][0][m][0] * rs, a1 = acc[ai][0][m][1] * rs, b0 = acc[ai][1][m][0] * rs, b1 = acc[ai][1][m][1] * rs;
                f32x4 g0, g1;
#pragma unroll
                for (int j = 0; j < 4; ++j) { g0[j] = silu_f(a0[j]) * b0[j]; g1[j] = silu_f(a1[j]) * b1[j]; }
                u32x4 w; w.x = cvt_pk_bf16(g0[0], g0[1]); w.y = cvt_pk_bf16(g0[2], g0[3]); w.z = cvt_pk_bf16(g1[0], g1[1]); w.w = cvt_pk_bf16(g1[2], g1[3]);
                *(u32x4*)(O + (size_t)row * ldo + col0) = w; } }
    }
};
struct EpiMoeDown {
    static constexpr bool PERM = true, AFTER_DRAIN = false;
    bf16_t* Y; const float* gate;
    __device__ __forceinline__ void operator()(const f32x4 (&acc)[2][2][4][2], const Unit& u, int wr, int wc, int fr, int fq) const {
        const int row0 = u.pm * BM + wr * 64 + fr, col0 = (u.pn & 3) * BM + wc * 32 + 8 * fq;
        float gt[2][4];
#pragma unroll
        for (int ai = 0; ai < 2; ++ai)
#pragma unroll
            for (int m = 0; m < 4; ++m) gt[ai][m] = gate[row0 + ai * HALF + m * 16];
        asm volatile("" : "+v"(gt[0][0]), "+v"(gt[0][1]), "+v"(gt[0][2]), "+v"(gt[0][3]), "+v"(gt[1][0]), "+v"(gt[1][1]), "+v"(gt[1][2]), "+v"(gt[1][3]));
#pragma unroll
        for (int ai = 0; ai < 2; ++ai)
#pragma unroll
            for (int m = 0; m < 4; ++m) { const int row = row0 + ai * HALF + m * 16; const float g = gt[ai][m]; bf16_t* rowp = Y + (size_t)row * 1024 + col0;
#pragma unroll
                for (int bj = 0; bj < 2; ++bj) { const f32x4 v0 = acc[ai][bj][m][0] * g, v1 = acc[ai][bj][m][1] * g;
                    u32x4 w; w.x = cvt_pk_bf16(v0[0], v0[1]); w.y = cvt_pk_bf16(v0[2], v0[3]); w.z = cvt_pk_bf16(v1[0], v1[1]); w.w = cvt_pk_bf16(v1[2], v1[3]);
                    *(u32x4*)(rowp + bj * HALF) = w; } }
    }
};

struct EpiMoeDownPart {
    static constexpr bool PERM = false, AFTER_DRAIN = false;
    float* YT; const float* gate; int row_base;
    __device__ __forceinline__ void operator()(const f32x4 (&acc)[2][2][4][2], const Unit& u, int wr, int wc, int fr, int fq) const {
        const int row0 = u.pm * BM + wr * 64 + fr, col0 = (u.pn & 3) * BM + wc * 32 + 4 * fq; const int kq = u.ko / 1792;
#pragma unroll
        for (int ai = 0; ai < 2; ++ai)
#pragma unroll
            for (int m = 0; m < 4; ++m) { const int row = row0 + ai * HALF + m * 16; const float gtv = gate[row]; float* rowp = YT + ((size_t)kq * 2048 + (row - row_base)) * 1024 + col0;
#pragma unroll
                for (int bj = 0; bj < 2; ++bj)
#pragma unroll
                    for (int n = 0; n < 2; ++n) *(f32x4*)(rowp + bj * HALF + n * 16) = acc[ai][bj][m][n] * gtv; }
    }
};
template <class Epi, class Sched, bool ALIGN_EPI = false, bool SP2 = false>
__device__ __forceinline__ void gemm_phase(PG8_LAS unsigned char* lds, const Gemm g, const Sched& S, const Epi& E, const bool skip_epi = false) {
    const int tid = tid_here(), wid = __builtin_amdgcn_readfirstlane(tid >> 6), lane = tid & 63, wr = wid >> 2, wc = wid & 3, fr = lane & 15, fq = lane >> 4;
    const int K = g.ld, nt = g.K / BK;
    unsigned voffA[2], voffB[2];
#pragma unroll
    for (int i = 0; i < 2; ++i) { int R, C; stage_rc(tid * 16 + i * 8192, R, C); const int Rb = Epi::PERM ? ((R & ~31) + perm32(R & 31)) : R;
        voffA[i] = (unsigned)(R * K + C) * 2u; voffB[i] = (unsigned)(Rb * K + C) * 2u; }
    const size_t kstep = (size_t)(BK * 2);
    const size_t hstep = (size_t)HALF * K * 2;
    const size_t tstep = 2 * hstep;
    const unsigned ldsw = (unsigned)wid * 1024u;
    const int aoff = lds_byte(wr * 64 + fr, fq * 8), boff = lds_byte(wc * 32 + fr, fq * 8);
#define PG8_SA(b, h) (((b) * 2 + (h)) * HTB)
#define PG8_SB(b, h) ((4 + (b) * 2 + (h)) * HTB)
#define PG8_STAGE(bufoff, gbase, voff) do { _Pragma("unroll") for (int _i = 0; _i < 2; ++_i) \
        __builtin_amdgcn_global_load_lds((const unsigned*)((const char*)(gbase) + (voff)[_i]), (PG8_LAS unsigned*)(lds + (bufoff) + ldsw + _i * 8192), 16, 0, 0); } while (0)
#define PG8_LDA(dst, b, h) do { _Pragma("unroll") for (int m = 0; m < 4; ++m) _Pragma("unroll") for (int k = 0; k < 2; ++k) dst[m][k] = *(const PG8_LAS bf16x8*)(lds + PG8_SA(b, h) + aoff + m * 2048 + k * 1024); } while (0)
#define PG8_LDB(dst, b, h) do { _Pragma("unroll") for (int n = 0; n < 2; ++n) _Pragma("unroll") for (int k = 0; k < 2; ++k) dst[n][k] = *(const PG8_LAS bf16x8*)(lds + PG8_SB(b, h) + boff + n * 2048 + k * 1024); } while (0)
#define PG8_MMA(ai, bj, At, Bt) do { __builtin_amdgcn_s_setprio(1); _Pragma("unroll") for (int m = 0; m < 4; ++m) _Pragma("unroll") for (int n = 0; n < 2; ++n) _Pragma("unroll") for (int k = 0; k < 2; ++k) \
        acc[ai][bj][m][n] = __builtin_amdgcn_mfma_f32_16x16x32_bf16(Bt[n][k], At[m][k], acc[ai][bj][m][n], 0, 0, 0); __builtin_amdgcn_s_setprio(0); } while (0)
#define PG8_WAIT_V(n) asm volatile("s_waitcnt vmcnt(" #n ")" ::: "memory")
#define PG8_WAIT_L(n) asm volatile("s_waitcnt lgkmcnt(" #n ")" ::: "memory")
#define PG8_BAR __builtin_amdgcn_s_barrier()
#define PG8_SCHED __builtin_amdgcn_sched_barrier(0)
    Unit cur, nxt; int ui = 0;
    if (!S.next(0, cur)) return;
    f32x4 acc[2][2][4][2];
#pragma unroll
    for (int a = 0; a < 2; ++a)
#pragma unroll
        for (int b = 0; b < 2; ++b)
#pragma unroll
            for (int m = 0; m < 4; ++m)
#pragma unroll
                for (int n = 0; n < 2; ++n) acc[a][b][m][n] = (f32x4){0.f, 0.f, 0.f, 0.f};
    bf16x8 At[4][2], B0[2][2], B1[2][2];
    const char* cA = (const char*)g.A + (size_t)cur.pm * tstep + cur.ko; const char* cB = (const char*)g.Bt + (size_t)cur.pn * tstep + cur.ko;
    S.a_ready(cur);
    if constexpr (SP2) {
        PG8_STAGE(PG8_SB(0, 0), cB, voffB); PG8_STAGE(PG8_SB(0, 1), cB + hstep, voffB); PG8_STAGE(PG8_SA(0, 0), cA, voffA); PG8_STAGE(PG8_SA(0, 1), cA + hstep, voffA);
        if (wr == 1) PG8_BAR;
        PG8_WAIT_V(2); PG8_BAR;
        PG8_STAGE(PG8_SB(1, 0), cB + kstep, voffB); PG8_STAGE(PG8_SA(1, 0), cA + kstep, voffA); PG8_STAGE(PG8_SB(1, 1), cB + hstep + kstep, voffB);
        PG8_WAIT_V(6); PG8_BAR;
    } else {
        PG8_STAGE(PG8_SB(0, 0), cB, voffB); PG8_STAGE(PG8_SA(0, 0), cA, voffA); PG8_STAGE(PG8_SB(0, 1), cB + hstep, voffB); PG8_STAGE(PG8_SA(0, 1), cA + hstep, voffA);
        if (wr == 1) PG8_BAR;
        PG8_WAIT_V(4); PG8_BAR;
        PG8_STAGE(PG8_SB(1, 0), cB + kstep, voffB); PG8_STAGE(PG8_SA(1, 0), cA + kstep, voffA); PG8_STAGE(PG8_SB(1, 1), cB + hstep + kstep, voffB);
        PG8_WAIT_V(6); PG8_BAR;
    }
    for (;;) {
        const bool has_next = S.next(ui + 1, nxt);
        const char* nA = has_next ? (const char*)g.A + (size_t)nxt.pm * tstep + nxt.ko : cA; const char* nB = has_next ? (const char*)g.Bt + (size_t)nxt.pn * tstep + nxt.ko : cB;
        for (int t = 0; t < nt; t += 2) {
            const bool last = (t == nt - 2);
            const char* a1 = cA + (size_t)(t + 1) * kstep;
            const char* a2 = last ? nA : cA + (size_t)(t + 2) * kstep; const char* b2 = last ? nB : cB + (size_t)(t + 2) * kstep;
            const char* a3 = a2 + kstep; const char* b3 = b2 + kstep;
            if (last && has_next) S.a_ready(nxt);
            if constexpr (SP2) {
            PG8_LDB(B0, 0, 0); PG8_LDB(B1, 0, 1); PG8_SCHED; PG8_LDA(At, 0, 0); PG8_STAGE(PG8_SA(1, 1), a1 + hstep, voffA);
            PG8_WAIT_V(8); PG8_WAIT_L(0); PG8_BAR; PG8_MMA(0, 0, At, B0); PG8_MMA(0, 1, At, B1); PG8_BAR; PG8_SCHED;
            PG8_LDA(At, 0, 1); PG8_STAGE(PG8_SB(0, 0), b2, voffB); PG8_STAGE(PG8_SB(0, 1), b2 + hstep, voffB); PG8_STAGE(PG8_SA(0, 0), a2, voffA);
            PG8_WAIT_V(8); PG8_WAIT_L(0); PG8_BAR; PG8_MMA(1, 0, At, B0); PG8_MMA(1, 1, At, B1); PG8_BAR; PG8_SCHED;
            PG8_LDB(B0, 1, 0); PG8_LDB(B1, 1, 1); PG8_SCHED; PG8_LDA(At, 1, 0); PG8_STAGE(PG8_SA(0, 1), a2 + hstep, voffA);
            PG8_WAIT_V(8); PG8_WAIT_L(0); PG8_BAR; PG8_MMA(0, 0, At, B0); PG8_MMA(0, 1, At, B1); PG8_BAR; PG8_SCHED;
            PG8_LDA(At, 1, 1); PG8_STAGE(PG8_SB(1, 0), b3, voffB); PG8_STAGE(PG8_SB(1, 1), b3 + hstep, voffB); PG8_STAGE(PG8_SA(1, 0), a3, voffA);
            PG8_WAIT_V(8); PG8_WAIT_L(0); PG8_BAR; PG8_MMA(1, 0, At, B0); PG8_MMA(1, 1, At, B1); PG8_BAR; PG8_SCHED;
            } else {
            PG8_LDB(B0, 0, 0); PG8_SCHED; PG8_LDA(At, 0, 0); PG8_STAGE(PG8_SA(1, 1), a1 + hstep, voffA);
            PG8_WAIT_L(8); PG8_BAR; PG8_WAIT_L(0); PG8_MMA(0, 0, At, B0); PG8_BAR; PG8_SCHED;
            PG8_LDB(B1, 0, 1); PG8_STAGE(PG8_SB(0, 0), b2, voffB);
            PG8_BAR; PG8_WAIT_L(0); PG8_MMA(0, 1, At, B1); PG8_BAR;
            PG8_LDA(At, 0, 1); PG8_STAGE(PG8_SA(0, 0), a2, voffA);
            PG8_BAR; PG8_WAIT_L(0); PG8_MMA(1, 0, At, B0); PG8_BAR; PG8_SCHED;
            PG8_STAGE(PG8_SB(0, 1), b2 + hstep, voffB);
            PG8_WAIT_V(6); PG8_BAR; PG8_MMA(1, 1, At, B1); PG8_BAR;
            PG8_LDB(B0, 1, 0); PG8_SCHED; PG8_LDA(At, 1, 0); PG8_STAGE(PG8_SA(0, 1), a2 + hstep, voffA);
            PG8_WAIT_L(8); PG8_BAR; PG8_WAIT_L(0); PG8_MMA(0, 0, At, B0); PG8_BAR; PG8_SCHED;
            PG8_LDB(B1, 1, 1); PG8_STAGE(PG8_SB(1, 0), b3, voffB);
            PG8_BAR; PG8_WAIT_L(0); PG8_MMA(0, 1, At, B1); PG8_BAR;
            PG8_LDA(At, 1, 1); PG8_STAGE(PG8_SA(1, 0), a3, voffA);
            PG8_BAR; PG8_WAIT_L(0); PG8_MMA(1, 0, At, B0); PG8_BAR; PG8_SCHED;
            PG8_STAGE(PG8_SB(1, 1), b3 + hstep, voffB);
            PG8_WAIT_V(6); PG8_BAR; PG8_MMA(1, 1, At, B1); PG8_BAR;
            }
        }
        if constexpr (ALIGN_EPI) { if (wr == 0) PG8_BAR; }
        if constexpr (!Epi::AFTER_DRAIN) { if (!skip_epi) E(acc, cur, wr, wc, fr, fq); S.done(cur); }
        if (!has_next) break;
#pragma unroll
        for (int a = 0; a < 2; ++a)
#pragma unroll
            for (int b = 0; b < 2; ++b)
#pragma unroll
                for (int m = 0; m < 4; ++m)
#pragma unroll
                    for (int n = 0; n < 2; ++n) acc[a][b][m][n] = (f32x4){0.f, 0.f, 0.f, 0.f};
        cur = nxt; cA = nA; cB = nB; ++ui;
        if constexpr (ALIGN_EPI) { if (wr == 1) PG8_BAR; }
    }
    PG8_WAIT_V(0);
    if constexpr (!ALIGN_EPI) { if (wr == 0) PG8_BAR; }
    PG8_BAR;
#undef PG8_SA
#undef PG8_SB
#undef PG8_STAGE
#undef PG8_LDA
#undef PG8_LDB
#undef PG8_MMA
#undef PG8_WAIT_V
#undef PG8_WAIT_L
#undef PG8_BAR
#undef PG8_SCHED
}
}

constexpr int NWAVES = 8, NTHR = NWAVES * 64;
constexpr int NB = 8, SEQ = 2048, D = 1024, M = NB * SEQ;
constexpr int INC = 3088;
constexpr int NU = 3072;
constexpr int UQ = 0, UK = 256, UV = 512, UGQ = 768, UGK = 1024, UGV = 1280, UGR = 1792, UCI = 2304, UCB = 2560, UCC = 2816;
constexpr int FF = 2816, FE = 3584, NE = 8;
constexpr int MAXPAN = 136, MAXROWS = MAXPAN * 256;
constexpr float LOG2E = 1.4426950408889634f;
constexpr float QS_ATT = 0.125f * LOG2E;

constexpr size_t MiB = 1u << 20;
constexpr size_t WS_CTL = 0, CTL_ZERO_BYTES = 1 * MiB;
constexpr size_t WS_SS = 1 * MiB;
constexpr size_t WS_BL = 2 * MiB;
constexpr size_t WS_DEC = 2 * MiB + 64 * 1024;
constexpr size_t WS_TOPI = 3 * MiB;
constexpr size_t WS_TOPW = 3 * MiB + 128 * 1024;
constexpr size_t WS_POS = 3 * MiB + 256 * 1024;
constexpr size_t WS_RS3 = 3 * MiB + 384 * 1024;
constexpr size_t WS_CNT = 3 * MiB + 448 * 1024;
constexpr size_t WS_PANE = 3 * MiB + 456 * 1024;
constexpr size_t WS_ROWGATE = 4 * MiB;
constexpr size_t WS_ROWRS = 4 * MiB + 256 * 1024;
constexpr size_t WS_WE13 = 8 * MiB;
constexpr size_t WS_Y = WS_WE13;
constexpr size_t WS_YT = WS_WE13 + 68 * MiB;
constexpr size_t WS_XS = 120 * MiB;
constexpr size_t WS_WE2 = WS_XS;
constexpr size_t WS_HE = 188 * MiB;
constexpr size_t WS_WIN = WS_HE;
constexpr size_t WS_WGLR = WS_HE + 12 * MiB;
constexpr size_t WS_LA = WS_HE + 34 * MiB;
constexpr size_t WS_WOUT = WS_HE + 13 * MiB;
constexpr size_t WS_W13 = WS_HE + 17 * MiB;
constexpr size_t WS_W2 = WS_HE + 28 * MiB;
constexpr size_t WS_XB = WS_HE + 238 * MiB;
constexpr size_t WS_U = WS_HE + 66 * MiB;
constexpr size_t WS_H = WS_U;
constexpr size_t WS_MIX = WS_HE + 170 * MiB;
constexpr size_t WS_CST = WS_HE + 202 * MiB;
constexpr size_t WS_END = WS_HE + 270 * MiB;
static_assert(WS_CST + 32 * MiB <= WS_END, "ws map");
constexpr int CW_BAR = 4096;
constexpr int CW_SC = 32768;
constexpr int CW_TMO2 = 65536;

constexpr int LDS_BYTES = 147456;
constexpr int LDSCTL_OFF = 131072 + 14 * 1024, MISC_OFF = LDSCTL_OFF + 320;

#define GAS __attribute__((address_space(1)))
#define LAS __attribute__((address_space(3)))
typedef unsigned short bf16;
typedef float f32x4 __attribute__((ext_vector_type(4)));
typedef unsigned v4u __attribute__((ext_vector_type(4)));
__device__ __forceinline__ unsigned f2bf(float f) { unsigned u = __builtin_bit_cast(unsigned, f); return (u + 0x7fffu + ((u >> 16) & 1u)) >> 16; }
__device__ __forceinline__ unsigned pk2(float lo, float hi) { return pg8::cvt_pk_bf16(lo, hi); }
__device__ __forceinline__ float bf2f(unsigned short b) { return __builtin_bit_cast(float, (unsigned)b << 16); }
__device__ __forceinline__ float bflo(unsigned w) { return __builtin_bit_cast(float, w << 16); }
__device__ __forceinline__ float bfhi(unsigned w) { return __builtin_bit_cast(float, w & 0xffff0000u); }
__device__ __forceinline__ float wave_sum(float v) {
#pragma unroll
    for (int o = 1; o < 64; o <<= 1) v += __shfl_xor(v, o);
    return v;
}
__device__ __forceinline__ float wave_max(float v) {
#pragma unroll
    for (int o = 1; o < 64; o <<= 1) v = fmaxf(v, __shfl_xor(v, o));
    return v;
}

#define XB_TMO      128
#define XB_XCNT(j)  (256  + 64 * (j))
#define XB_XSUB(j)  (1280 + 64 * (j))
#define XB_XGEN(j)  (2304 + 64 * (j))
#define XB_TOP      3328
#define XB_TOPGEN   3392
#define XCD_BAR_WORDS 3456
#define XB_SPIN_CAP (1u << 18)
__device__ __forceinline__ unsigned xb_ld(unsigned* p)              { return __hip_atomic_load(p, __ATOMIC_RELAXED, __HIP_MEMORY_SCOPE_AGENT); }
__device__ __forceinline__ unsigned xb_add(unsigned* p, unsigned v) { return __hip_atomic_fetch_add(p, v, __ATOMIC_RELAXED, __HIP_MEMORY_SCOPE_AGENT); }
__device__ __forceinline__ unsigned xb_xcc_id() { return (unsigned)__builtin_amdgcn_s_getreg((3 << 11) | 20) & 0xFu; }
#define XB_SPIN(cond, bar) do { unsigned _sp = 0; while (cond) { __builtin_amdgcn_s_sleep(1); \
    if ((++_sp & 255u) == 0u) { if (xb_ld(&(bar)[XB_TMO])) break; if (_sp > XB_SPIN_CAP) { atomicAdd(&(bar)[XB_TMO], 1u); break; } } } } while (0)
struct XcdBarrier { unsigned* bar; unsigned x; volatile LAS unsigned* st; };
__device__ __forceinline__ XcdBarrier xcd_barrier_post(unsigned* bar, volatile LAS unsigned* st) {
    XcdBarrier b; b.bar = bar; b.x = xb_xcc_id(); b.st = st;
    if (threadIdx.x == 0) (void)xb_add(&bar[XB_XCNT(b.x)], 1u);
    return b;
}
__device__ __forceinline__ void xcd_barrier_complete(unsigned* bar, unsigned x, unsigned& nloc, unsigned& nx) {
    const unsigned G = gridDim.x * gridDim.y * gridDim.z;
    unsigned sum, cnt, mine, sp = 0u;
    for (;;) {
        sum = 0u; cnt = 0u; mine = 0u;
#pragma unroll
        for (unsigned j = 0; j < 16; ++j) { const unsigned c = xb_ld(&bar[XB_XCNT(j)]); sum += c; cnt += (c > 0u) ? 1u : 0u; mine = (j == x) ? c : mine; }
        if (sum == G) break;
        __builtin_amdgcn_s_sleep(1);
        if ((++sp & 255u) == 0u) { if (xb_ld(&bar[XB_TMO])) break; if (sp > XB_SPIN_CAP) { atomicAdd(&bar[XB_TMO], 1u); break; } }
    }
    nloc = mine > 0u ? mine : 1u; nx = cnt > 0u ? cnt : 1u;
}
__device__ __forceinline__ void xcd_barrier(const XcdBarrier& b) {
    asm volatile("s_waitcnt vmcnt(0)" ::: "memory");
    __syncthreads();
    if (threadIdx.x == 0) {
        unsigned* bar = b.bar;
        __builtin_amdgcn_s_waitcnt(0);
        unsigned nloc = b.st[0], nx = b.st[1];
        if (nloc == 0u) { xcd_barrier_complete(bar, b.x, nloc, nx); b.st[0] = nloc; b.st[1] = nx; }
        const unsigned old = xb_add(&bar[XB_XSUB(b.x)], 1u);
        const unsigned gen = old / nloc;
        if (old + 1u == (gen + 1u) * nloc) {
            __builtin_amdgcn_fence(__ATOMIC_RELEASE, "agent");
            asm volatile("s_waitcnt vmcnt(0)" ::: "memory");
            const unsigned og = xb_add(&bar[XB_TOP], 1u);
            const unsigned tg = og / nx;
            if (og + 1u == (tg + 1u) * nx) xb_add(&bar[XB_TOPGEN], 1u);
            else XB_SPIN(xb_ld(&bar[XB_TOPGEN]) == tg, bar);
            __builtin_amdgcn_fence(__ATOMIC_ACQUIRE, "agent");
            xb_add(&bar[XB_XGEN(b.x)], 1u);
            asm volatile("s_waitcnt vmcnt(0)" ::: "memory");
        } else {
            XB_SPIN(xb_ld(&bar[XB_XGEN(b.x)]) == gen, bar);
            __builtin_amdgcn_fence(__ATOMIC_ACQUIRE, "agent");
            asm volatile("s_waitcnt vmcnt(0)" ::: "memory");
        }
    }
    __syncthreads();
}

struct Args {
    const float* x; const float* w_mix_in; const float* w_mix_out; const float* g_mix; const float* rel_bias; const float* gla_w_gate; const float* gla_b_gate;
    const float* gla_g_norm; const float* conv_w; const float* g_ffn; const float* ffn_w1; const float* ffn_w3; const float* ffn_w2; const float* moe_router;
    const float* moe_w1; const float* moe_w3; const float* moe_w2; const float* g_final;
    float* out; unsigned char* ws; int ph_lo, ph_hi, li, pad;
};

__device__ __forceinline__ void transpose_tile(const float* src, int ldsrc, int k0, int n0, bf16* dst, int ldd, int drow0, const float* ksc, unsigned* scr, int lane) {
    const int nq = lane & 15, kk = lane >> 4;
#pragma unroll
    for (int i = 0; i < 8; ++i) { const int k = 8 * i + 2 * kk; const float* p = src + (size_t)(k0 + k) * ldsrc + n0 + 4 * nq;
        const f32x4 r0 = *(const f32x4*)p, r1 = *(const f32x4*)(p + ldsrc);
        const float s0 = ksc ? ksc[k0 + k] : 1.f, s1 = ksc ? ksc[k0 + k + 1] : 1.f;
#pragma unroll
        for (int j = 0; j < 4; ++j) scr[(4 * nq + j) * 33 + 4 * i + kk] = pk2(r0[j] * s0, r1[j] * s1); }
    asm volatile("s_waitcnt lgkmcnt(0)" ::: "memory");
#pragma unroll 8
    for (int i2 = 0; i2 < 32; ++i2) { const int n = 2 * i2 + (lane >> 5), d = lane & 31;
        ((unsigned*)(dst + (size_t)(drow0 + n) * ldd + k0))[d] = scr[n * 33 + d]; }
    asm volatile("s_waitcnt lgkmcnt(0)" ::: "memory");
}
__device__ __forceinline__ void glr_tile(const float* win, const float* wg, const float* g, int k0, int n0, bf16* dst, int drow0, int lane) {
    float w[16];
#pragma unroll
    for (int r = 0; r < 16; ++r) w[r] = wg[r * 256 + n0 + lane];
    unsigned* drow = (unsigned*)(dst + (size_t)(drow0 + n0 + lane) * 1024 + k0);
    for (int kp = 0; kp < 32; ++kp) { float v[2];
#pragma unroll
        for (int q = 0; q < 2; ++q) { const int k = k0 + 2 * kp + q; const float* s = win + (size_t)k * INC + 2304; float a = 0.f;
#pragma unroll
            for (int r = 0; r < 16; ++r) a += s[r] * w[r];
            v[q] = a * g[k]; }
        drow[kp] = pk2(v[0], v[1]); }
}
__device__ __forceinline__ int rel_bucket(int d) {
    if (d < 16) return d;
    const float lr = logf((float)d / 16.0f) / logf(128.0f);
    int b = 16 + (int)(lr * 16.0f); return b < 31 ? b : 31;
}


typedef short bf16x8 __attribute__((ext_vector_type(8)));
typedef short v4i16_t __attribute__((ext_vector_type(4)));
#define MFMA16(a, b, c) __builtin_amdgcn_mfma_f32_16x16x32_bf16((a), (b), (c), 0, 0, 0)
__device__ __forceinline__ v4i16_t tr16(LAS unsigned char* p) { return __builtin_amdgcn_ds_read_tr16_b64_v4i16((LAS v4i16_t*)p); }
__device__ __forceinline__ bf16x8 cat8(v4i16_t lo, v4i16_t hi) { return __builtin_shufflevector(lo, hi, 0, 1, 2, 3, 4, 5, 6, 7); }
__device__ __forceinline__ bf16x8 frag_rm(LAS unsigned char* base, int pitch, int c0, int k0, int lane) { return *(LAS bf16x8*)(base + (c0 + (lane & 15)) * pitch + (k0 + 8 * (lane >> 4)) * 2); }
__device__ __forceinline__ bf16x8 frag_tr(LAS unsigned char* base, int pitch, int c0, int k0, int lane) {
    const int i = lane & 15, g = lane >> 4; LAS unsigned char* p = base + (k0 + 8 * g + (i >> 2)) * pitch + (c0 + 4 * (i & 3)) * 2;
    return cat8(tr16(p), tr16(p + 4 * pitch)); }
__device__ __forceinline__ bf16x8 frag_trp(LAS unsigned char* base, int pitch, int c0, int k0, int lane) {
    const int i = lane & 15, g = lane >> 4; LAS unsigned char* p = base + (k0 + 4 * g + (i >> 2)) * pitch + (c0 + 4 * (i & 3)) * 2;
    return cat8(tr16(p), tr16(p + 16 * pitch)); }
__device__ __forceinline__ bf16x8 pack8(const f32x4& a, const f32x4& b) {
    v4u w; w.x = pg8::cvt_pk_bf16(a[0], a[1]); w.y = pg8::cvt_pk_bf16(a[2], a[3]); w.z = pg8::cvt_pk_bf16(b[0], b[1]); w.w = pg8::cvt_pk_bf16(b[2], b[3]); return __builtin_bit_cast(bf16x8, w); }

struct Ctx { Args args; int tid, lane, wave, G, bx, gw, NGW, lo, hi; XcdBarrier bar; };
#define GRID_BAR() do { if (MK_N_LAUNCHES == 1) xcd_barrier(bar); } while (0)
#define IN(k) (lo <= (k) && (k) < hi)
#define SEAM(k) do { if (IN(k) && IN((k) + 1)) GRID_BAR(); } while (0)
#define WS_PTRS \
    float* SS = (float*)(ws + WS_SS); float* BL = (float*)(ws + WS_BL); float* DEC = (float*)(ws + WS_DEC); \
    bf16* XB = (bf16*)(ws + WS_XB); bf16* U = (bf16*)(ws + WS_U); bf16* MIX = (bf16*)(ws + WS_MIX); float* CST = (float*)(ws + WS_CST); \
    bf16* H = (bf16*)(ws + WS_H); bf16* W13 = (bf16*)(ws + WS_W13); bf16* W2 = (bf16*)(ws + WS_W2); \
    bf16* WE13 = (bf16*)(ws + WS_WE13); bf16* WE2 = (bf16*)(ws + WS_WE2); bf16* XS = (bf16*)(ws + WS_XS); bf16* HE = (bf16*)(ws + WS_HE); bf16* Y = (bf16*)(ws + WS_Y); \
    int* TOPI = (int*)(ws + WS_TOPI); float* TOPW = (float*)(ws + WS_TOPW); int* POS = (int*)(ws + WS_POS); float* RS3 = (float*)(ws + WS_RS3); \
    int* CNT = (int*)(ws + WS_CNT); int* PANE = (int*)(ws + WS_PANE); float* ROWGATE = (float*)(ws + WS_ROWGATE); float* ROWRS = (float*)(ws + WS_ROWRS); \
    float* X = args.out; \
    (void)SS; (void)BL; (void)DEC; (void)XB; (void)U; (void)MIX; (void)CST; (void)H; (void)W13; (void)W2; (void)WE13; (void)WE2; (void)XS; (void)HE; (void)Y; \
    (void)TOPI; (void)TOPW; (void)POS; (void)RS3; (void)CNT; (void)PANE; (void)ROWGATE; (void)ROWRS; (void)X;

template <int layer> __device__ __forceinline__ void layer_phases(const Ctx& c, unsigned char* lds) {
    const Args& args = c.args; LAS unsigned char* ldsl = (LAS unsigned char*)lds;
    const int tid = c.tid, lane = c.lane, wave = c.wave, G = c.G, bx = c.bx, gw = c.gw, NGW = c.NGW, lo = c.lo, hi = c.hi; const XcdBarrier bar = c.bar;
    unsigned char* ws = args.ws;
    WS_PTRS
    (void)tid; (void)lane; (void)wave; (void)gw; (void)NGW;
#if defined(PROBE_PHASE) || defined(PROBE_REP)
    const int pad_ = args.pad;
#else
    constexpr int pad_ = 0;
#endif
    const int pmode = pad_ >> 4; (void)pmode;
    const bool dry = (pad_ & 1) != 0, noepi = (pad_ & 2) != 0;
    bf16* XBD = dry ? (bf16*)(ws + WS_XS) : XB; float* SSD = dry ? (float*)(ws + WS_XS) : SS; (void)XBD; (void)SSD;
        const int pb = 1 + 16 * layer;
        if (IN(pb + 0)) {
            pg8::Gemm g{XB, (const bf16*)(ws + WS_WIN) + (size_t)layer * NU * D, M, NU, D, D}; pg8::StaticOrder S; S.init(M, NU, G, bx);
            pg8::EpiU E{U, NU, SS, QS_ATT};
            pg8::gemm_phase<pg8::EpiU, pg8::StaticOrder, true, true>(ldsl, g, S, E, noepi);
            { const bf16* wg = (const bf16*)(ws + WS_WGLR) + (size_t)layer * 16 * D; float* LA = (float*)(ws + WS_LA); f32x4* xch = (f32x4*)lds; float* glrl = (float*)(lds + 4096);
              const int tid = pg8::tid_here(), lane = tid & 63;
              float wgc[16]; { const float* wgp = args.gla_w_gate + layer * 16 * 256 + (tid & 255);
#pragma unroll
                for (int r = 0; r < 16; ++r) wgc[r] = wgp[r * 256]; }
              const float bgv = args.gla_b_gate[layer * 256 + (tid & 255)];
              for (int blk = bx; blk < 256; blk += G) {
                  const int rt = wave & 3, kh = wave >> 2, ql = lane & 15, g4 = lane >> 4;
                  const bf16* ap = XB + (size_t)(blk * 64 + rt * 16 + ql) * D + kh * 512 + 8 * g4; const bf16* bp = wg + (size_t)ql * D + kh * 512 + 8 * g4;
                  f32x4 acc = (f32x4){0.f, 0.f, 0.f, 0.f};
#pragma unroll
                  for (int ks = 0; ks < 16; ++ks) acc = MFMA16(*(const bf16x8*)(ap + 32 * ks), *(const bf16x8*)(bp + 32 * ks), acc);
                  if (kh == 1) xch[rt * 64 + lane] = acc;
                  __syncthreads();
                  if (kh == 0) { acc += xch[rt * 64 + lane];
#pragma unroll
                      for (int rg = 0; rg < 4; ++rg) { const int rl = rt * 16 + 4 * g4 + rg; glrl[rl * 16 + ql] = acc[rg] * pg8::rstd_of(SS + (size_t)(blk * 64 + rl) * 16); } }
                  __syncthreads();
                  { const int c = tid & 255, r0 = (tid >> 8) * 32;
#pragma unroll 4
                    for (int i = 0; i < 32; ++i) { const f32x4* gp = (const f32x4*)(glrl + (r0 + i) * 16); float z = bgv;
#pragma unroll
                        for (int q4 = 0; q4 < 4; ++q4) { const f32x4 gv = gp[q4]; z += gv[0] * wgc[4 * q4] + gv[1] * wgc[4 * q4 + 1] + gv[2] * wgc[4 * q4 + 2] + gv[3] * wgc[4 * q4 + 3]; }
                        LA[(size_t)(blk * 64 + r0 + i) * 256 + c] = pg8::logsig16(z); } }
                  __syncthreads();
              } }
        }
        SEAM(pb + 0);
        if (IN(pb + 1)) {
            const int tid = pg8::tid_here(), lane = tid & 63; (void)lane;
            float* cum = (float*)lds; float* seg = cum + 4096;
            LAS unsigned char* kdl = ldsl + 18432;
            LAS unsigned char* vvl = ldsl + 27648;
            for (int u = bx; u < 1024; u += G) {
                const int h = u & 3, n = (u >> 2) & 31, b = u >> 7; const size_t row0 = (size_t)b * SEQ + n * 64;
                const int tr = tid >> 3, c8 = tid & 7;
                const v4u kraw = *(const v4u*)(U + (row0 + tr) * NU + UGK + h * 64 + 8 * c8);
                const v4u* vp = (const v4u*)(U + (row0 + tr) * NU + UGV + h * 128 + c8 * 16); const v4u x0 = vp[0], x1 = vp[1];
                { float c = 0.f; float lav[8]; const float* lap = (const float*)(ws + WS_LA) + (row0 + 8 * wave) * 256 + h * 64 + lane;
#pragma unroll
                  for (int i = 0; i < 8; ++i) lav[i] = lap[i * 256];
#pragma unroll
                  for (int i = 0; i < 8; ++i) { c += lav[i]; cum[(8 * wave + i) * 64 + lane] = c; }
                  seg[wave * 64 + lane] = c; }
                __syncthreads();
                { f32x4 offa = (f32x4){0.f, 0.f, 0.f, 0.f}, offb = offa, lasta = offa, lastb = offa; const int wq = tr >> 3;
#pragma unroll
                  for (int w = 0; w < 8; ++w) { const f32x4 sa = *(const f32x4*)(seg + w * 64 + 8 * c8), sb = *(const f32x4*)(seg + w * 64 + 8 * c8 + 4); lasta += sa; lastb += sb; if (w < wq) { offa += sa; offb += sb; } }
                  const f32x4 ca = *(const f32x4*)(cum + tr * 64 + 8 * c8) + offa, cb = *(const f32x4*)(cum + tr * 64 + 8 * c8 + 4) + offb;
                  v4u w; w.x = pk2(bflo(kraw.x) * __expf(lasta[0] - ca[0]), bfhi(kraw.x) * __expf(lasta[1] - ca[1])); w.y = pk2(bflo(kraw.y) * __expf(lasta[2] - ca[2]), bfhi(kraw.y) * __expf(lasta[3] - ca[3]));
                  w.z = pk2(bflo(kraw.z) * __expf(lastb[0] - cb[0]), bfhi(kraw.z) * __expf(lastb[1] - cb[1])); w.w = pk2(bflo(kraw.w) * __expf(lastb[2] - cb[2]), bfhi(kraw.w) * __expf(lastb[3] - cb[3]));
                  *(LAS v4u*)(kdl + tr * 144 + c8 * 16) = w;
                  if (tr == 0) {
#pragma unroll
                      for (int j = 0; j < 4; ++j) { __hip_atomic_store(DEC + u * 64 + 8 * c8 + j, __expf(lasta[j]), __ATOMIC_RELAXED, __HIP_MEMORY_SCOPE_AGENT); __hip_atomic_store(DEC + u * 64 + 8 * c8 + 4 + j, __expf(lastb[j]), __ATOMIC_RELAXED, __HIP_MEMORY_SCOPE_AGENT); } }
                  LAS v4u* vd = (LAS v4u*)(vvl + tr * 272 + c8 * 32); vd[0] = x0; vd[1] = x1; }
                __syncthreads();
                { f32x4 acc[4];
#pragma unroll
                  for (int kt = 0; kt < 4; ++kt) acc[kt] = (f32x4){0.f, 0.f, 0.f, 0.f};
#pragma unroll
                  for (int ks = 0; ks < 2; ++ks) { const bf16x8 bv = frag_tr(vvl, 272, 16 * wave, 32 * ks, lane);
#pragma unroll
                      for (int kt = 0; kt < 4; ++kt) { const bf16x8 ak = frag_tr(kdl, 144, 16 * kt, 32 * ks, lane); acc[kt] = MFMA16(ak, bv, acc[kt]); } }
                  const int g4 = lane >> 4, ql = lane & 15;
                  const __amdgpu_buffer_rsrc_t rsrc = __builtin_amdgcn_make_buffer_rsrc((void*)CST, 0, 32 * 1024 * 1024, 0x00020000);
#pragma unroll
                  for (int kt = 0; kt < 4; ++kt)
                      __builtin_amdgcn_raw_buffer_store_b128(__builtin_bit_cast(v4u, acc[kt]), rsrc, (int)((((unsigned)u * 128u + 16u * wave + ql) * 64u + 16u * kt + 4u * g4) * 4u), 0, 16); }
                asm volatile("s_waitcnt vmcnt(0)" ::: "memory");
                __syncthreads();
                if (tid == 0) __hip_atomic_fetch_add((unsigned*)(ws + WS_CTL) + CW_SC + ((u >> 7) * 4 + (u & 3)) * 64, 1u, __ATOMIC_RELAXED, __HIP_MEMORY_SCOPE_AGENT);
            }
            const float* cw = args.conv_w + layer * 3 * 256;
            for (int rep_ = 0; rep_ < 1 + ((pad_ >> 10) & 1); ++rep_)
            for (int it = bx * NTHR + tid; it < M * 32; it += G * NTHR) {
                const int row = it >> 5, c0 = (it & 31) * 8, t = row & (SEQ - 1);
                const bf16* ur = U + (size_t)row * NU;
                const v4u cb = *(const v4u*)(ur + UCB + c0);
                v4u ci[3], cc[3];
#pragma unroll
                for (int d = 0; d < 3; ++d) { if (t >= d) { ci[d] = *(const v4u*)(ur - (size_t)d * NU + UCI + c0); cc[d] = *(const v4u*)(ur - (size_t)d * NU + UCC + c0); } else { ci[d] = (v4u){0u, 0u, 0u, 0u}; cc[d] = ci[d]; } }
                float o[8];
#pragma unroll
                for (int j = 0; j < 4; ++j) {
                    float a0 = 0.f, a1 = 0.f;
#pragma unroll
                    for (int d = 0; d < 3; ++d) { const float w0 = cw[(2 - d) * 256 + c0 + 2 * j], w1 = cw[(2 - d) * 256 + c0 + 2 * j + 1];
                        a0 += w0 * (bflo(cc[d][j]) * bflo(ci[d][j])); a1 += w1 * (bfhi(cc[d][j]) * bfhi(ci[d][j])); }
                    o[2 * j] = bflo(cb[j]) * a0; o[2 * j + 1] = bfhi(cb[j]) * a1; }
                v4u w; w.x = pk2(o[0], o[1]); w.y = pk2(o[2], o[3]); w.z = pk2(o[4], o[5]); w.w = pk2(o[6], o[7]);
                *(v4u*)(MIX + (size_t)row * D + 768 + c0) = w;
            }
            __syncthreads();
            {
                float* BLl = (float*)lds;
                for (int i = tid; i < 4 * 2049; i += NTHR) BLl[(i & 3) * 2049 + (i >> 2)] = BL[i];
                __syncthreads();
                LAS unsigned char* vst = ldsl + 33280 + wave * 5120;
                const int ql = lane & 15, g4 = lane >> 4;
                for (int rep_ = 0; rep_ < 1 + ((pad_ >> 11) & 1); ++rep_)
                for (int uu = bx; uu < 512; uu += G) {
                    int u = uu; if (G == 256) { const int j = (uu & 255) >> 3; u = ((((uu >> 8) * 16 + (uu & 7) * 2 + (j >> 4)) << 4) | (j & 15)); }
                    const int c = u & 15, h = (u >> 4) & 3, b = u >> 6; const int i0 = 16 * (((uu / G) & 1) ? 7 - wave : wave); const size_t rowb = (size_t)b * SEQ;
                    const int tq = c + 16 * (i0 + ql);
                    const bf16* ub = U + rowb * NU + h * 64;
                    const bf16x8 qf0 = *(const bf16x8*)(ub + (size_t)tq * NU + UQ + 8 * g4), qf1 = *(const bf16x8*)(ub + (size_t)tq * NU + UQ + 8 * g4 + 32);
                    const float* blh = BLl + h * 2049;
                    const int t0 = c + 16 * i0, t1 = t0 + 240;
                    const int base0 = ((t0 >> 4) - 128) & ~31, mhi0 = t1 >> 4, np0 = ((mhi0 - base0) >> 5) + 1, pz0 = base0 < 0 ? ((-base0) >> 5) : 0;
                    const int base1 = ((t0 >> 2) - 128) & ~31, mhi1 = t1 >> 2, np1 = ((mhi1 - base1) >> 5) + 1, pz1 = base1 < 0 ? ((-base1) >> 5) : 0;
                    const int base2 = (t0 - 128) & ~31, mhi2 = t1, np2 = ((mhi2 - base2) >> 5) + 1, pz2 = base2 < 0 ? ((-base2) >> 5) : 0;
                    const int n0 = np0 - pz0, n1 = np1 - pz1, n2 = np2 - pz2, NT = n0 + n1 + n2;
                    bf16x8 ka[2][2], kb[2][2]; v4u va_[4], vb_[4];
                    const unsigned char* ubb = (const unsigned char*)ub;
                    const unsigned koff = (unsigned)(UK + 8 * g4) * 2u, voff = (unsigned)(UV + 8 * (lane & 7)) * 2u; const int vrow = lane >> 3;
#define ATT_ITEM(it, LR, MB, MHI, RHO) do { if ((it) < n0) { LR = 4; MB = base0 + 32 * (np0 - 1 - (it)); MHI = mhi0; RHO = c; } \
                        else if ((it) < n0 + n1) { LR = 2; MB = base1 + 32 * (pz1 + (it) - n0); MHI = mhi1; RHO = c & 3; } \
                        else { LR = 0; MB = base2 + 32 * (pz2 + (it) - n0 - n1); MHI = mhi2; RHO = 0; } } while (0)
#define ATT_CLAMP(x, hi) __builtin_amdgcn_med3 ## _i(x, hi)
#define ATT_LOAD(K_, V_, LR, MB, MHI, RHO) do { _Pragma("unroll") for (int tau = 0; tau < 2; ++tau) { int mk = (MB) + 16 * tau + ql; mk = max(0, min(mk, (MHI))); \
                            const unsigned char* kp = ubb + ((unsigned)((mk << (LR)) + (RHO)) * (unsigned)(NU * 2) + koff); K_[tau][0] = *(const bf16x8*)kp; K_[tau][1] = *(const bf16x8*)(kp + 64); } \
                        _Pragma("unroll") for (int j = 0; j < 4; ++j) { int mv = (MB) + vrow + 8 * j; mv = max(0, min(mv, (MHI))); \
                            V_[j] = *(const v4u*)(ubb + ((unsigned)((mv << (LR)) + (RHO)) * (unsigned)(NU * 2) + voff)); } } while (0)
#define ATT_STEP(KC_, VC_, KN_, VN_) do { \
                        int lrn = lr, mbn = mb, mhin = mhi, rhon = rho; \
                        if (it + 1 < NT) { ATT_ITEM(it + 1, lrn, mbn, mhin, rhon); ATT_LOAD(KN_, VN_, lrn, mbn, mhin, rhon); } \
                        { LAS unsigned char* vd = vst + vrow * 160 + (lane & 7) * 16; \
                          _Pragma("unroll") for (int j = 0; j < 4; ++j) *(LAS v4u*)(vd + j * 8 * 160) = VC_[j]; } \
                        f32x4 s[2]; \
                        _Pragma("unroll") for (int tau = 0; tau < 2; ++tau) { s[tau] = MFMA16(KC_[tau][0], qf0, ((f32x4){0.f, 0.f, 0.f, 0.f})); s[tau] = MFMA16(KC_[tau][1], qf1, s[tau]); } \
                        const int d0 = (tq >> lr) - mb - 4 * g4; const int kneg = -(mb + 4 * g4); float tmax = -INFINITY; float bias_[2][4]; \
                        _Pragma("unroll") for (int tau = 0; tau < 2; ++tau) \
                            _Pragma("unroll") for (int rg = 0; rg < 4; ++rg) { const int dcl = max(0, min(d0 - (16 * tau + rg), 128)); bias_[tau][rg] = blh[dcl << lr]; } \
                        asm volatile("" : "+v"(bias_[0][0]), "+v"(bias_[0][1]), "+v"(bias_[0][2]), "+v"(bias_[0][3]), "+v"(bias_[1][0]), "+v"(bias_[1][1]), "+v"(bias_[1][2]), "+v"(bias_[1][3]));   \
                        _Pragma("unroll") for (int tau = 0; tau < 2; ++tau) \
                            _Pragma("unroll") for (int rg = 0; rg < 4; ++rg) { const int dist = d0 - (16 * tau + rg); const bool ok = ((unsigned)dist <= 128u) && ((16 * tau + rg) >= kneg); \
                                const float v = ok ? s[tau][rg] + bias_[tau][rg] : -INFINITY; s[tau][rg] = v; tmax = fmaxf(tmax, v); } \
                        if (__any(tmax > m_ref + 16.0f)) { \
                            float tm = fmaxf(tmax, __shfl_xor(tmax, 16)); tm = fmaxf(tm, __shfl_xor(tm, 32)); \
                            const float mn = fmaxf(m_ref, tm); const float ms = (mn == -INFINITY) ? 0.f : mn; const float alpha = __builtin_amdgcn_exp2f(m_ref - ms); m_ref = ms; \
                            l_run *= alpha; \
                            _Pragma("unroll") for (int d = 0; d < 4; ++d) o[d] = o[d] * alpha; \
                        } \
                        float ps = 0.f; \
                        _Pragma("unroll") for (int tau = 0; tau < 2; ++tau) \
                            _Pragma("unroll") for (int rg = 0; rg < 4; ++rg) { const float p = __builtin_amdgcn_exp2f(s[tau][rg] - m_ref); s[tau][rg] = p; ps += p; } \
                        l_run += ps; \
                        const bf16x8 pb = pack8(s[0], s[1]); \
                        asm volatile("" ::: "memory"); \
                        _Pragma("unroll") for (int d = 0; d < 4; ++d) { const bf16x8 vf = frag_trp(vst, 160, 16 * d, 0, lane); o[d] = MFMA16(vf, pb, o[d]); } \
                        asm volatile("" ::: "memory"); \
                        lr = lrn; mb = mbn; mhi = mhin; rho = rhon; ++it; } while (0)
                    int lr, mb, mhi, rho; ATT_ITEM(0, lr, mb, mhi, rho); ATT_LOAD(ka, va_, lr, mb, mhi, rho);
                    float m_ref = -INFINITY, l_run = 0.f; f32x4 o[4];
#pragma unroll
                    for (int d = 0; d < 4; ++d) o[d] = (f32x4){0.f, 0.f, 0.f, 0.f};
                    for (int it = 0; it < NT;) {
                        ATT_STEP(ka, va_, kb, vb_);
                        if (it >= NT) break;
                        ATT_STEP(kb, vb_, ka, va_);
                    }
#undef ATT_ITEM
#undef ATT_LOAD
#undef ATT_STEP
#undef ATT_CLAMP
                    l_run += __shfl_xor(l_run, 16); l_run += __shfl_xor(l_run, 32); const float inv = 1.0f / l_run;
                    bf16* op = MIX + (rowb + tq) * D + h * 64 + 4 * g4;
#pragma unroll
                    for (int d = 0; d < 4; ++d) { pg8::u32x2 w; w.x = pg8::cvt_pk_bf16(o[d][0] * inv, o[d][1] * inv); w.y = pg8::cvt_pk_bf16(o[d][2] * inv, o[d][3] * inv); *(pg8::u32x2*)(op + 16 * d) = w; }
                }
            }
            for (int u = bx; u < 1024; u += G) {
                const int h = u & 3, n = (u >> 2) & 31, b = u >> 7;
                unsigned* cw = (unsigned*)(ws + WS_CTL) + CW_SC + (b * 4 + h) * 64; unsigned* tmo = (unsigned*)(ws + WS_CTL) + CW_TMO2; const unsigned need = 32u * (unsigned)(layer + 1);
                if (wave == 0) { unsigned sp = 0; while (__hip_atomic_load(cw, __ATOMIC_RELAXED, __HIP_MEMORY_SCOPE_AGENT) < need) { __builtin_amdgcn_s_sleep(2);
                        if ((++sp & 255u) == 0u) { if (__hip_atomic_load(tmo, __ATOMIC_RELAXED, __HIP_MEMORY_SCOPE_AGENT) != 0u) break; if (sp > (1u << 20)) { __hip_atomic_store(tmo, 1u, __ATOMIC_RELAXED, __HIP_MEMORY_SCOPE_AGENT); break; } } } }
                __syncthreads();
                if (tid < 256) { const int idx = n * 256 + tid; float cc[32], dd[32];
                    float* cp = CST + (size_t)(b * 128 + h) * 8192 + idx; const float* dp = DEC + (b * 128 + h) * 64 + (idx & 63);
#pragma unroll
                    for (int m2 = 0; m2 < 32; ++m2) { cc[m2] = __hip_atomic_load(cp + (size_t)m2 * 4 * 8192, __ATOMIC_RELAXED, __HIP_MEMORY_SCOPE_AGENT); dd[m2] = __hip_atomic_load(dp + m2 * 4 * 64, __ATOMIC_RELAXED, __HIP_MEMORY_SCOPE_AGENT); }
                    float S = 0.f;
#pragma unroll
                    for (int m2 = 0; m2 < 32; ++m2) { cp[(size_t)m2 * 4 * 8192] = S; S = dd[m2] * S + cc[m2]; } }
            }
        }
        SEAM(pb + 1);
        if (IN(pb + 3)) {
            const int tid = pg8::tid_here(), lane = tid & 63; (void)lane;
            float* cum = (float*)lds; float* seg = cum + 4096;
            LAS unsigned char* qel = ldsl + 18432;
            LAS unsigned char* kel = ldsl + 27648;
            LAS unsigned char* vvl = ldsl + 36864;
            LAS unsigned char* stl = ldsl + 54272;
            float* rsq = (float*)(lds + 72704);
            const float* gn = args.gla_g_norm + layer * 128;
            for (int rep_ = 0; rep_ < 1 + ((pad_ >> 8) & 1); ++rep_)
            for (int u = bx; u < 1024; u += G) {
                const int h = u & 3, n = (u >> 2) & 31, b = u >> 7; const size_t row0 = (size_t)b * SEQ + n * 64;
                const int tr = tid >> 3, c8 = tid & 7;
                const v4u qraw = *(const v4u*)(U + (row0 + tr) * NU + UGQ + h * 64 + 8 * c8), kraw = *(const v4u*)(U + (row0 + tr) * NU + UGK + h * 64 + 8 * c8);
                const v4u* vp = (const v4u*)(U + (row0 + tr) * NU + UGV + h * 128 + c8 * 16); const v4u x0 = vp[0], x1 = vp[1];
                const int sv = tid >> 2, skq = (tid & 3) * 16; const f32x4* sp = (const f32x4*)(CST + ((size_t)u * 128 + sv) * 64 + skq);
                const f32x4 a0 = sp[0], a1 = sp[1], a2 = sp[2], a3 = sp[3];
                { float c = 0.f; float lav[8]; const float* lap = (const float*)(ws + WS_LA) + (row0 + 8 * wave) * 256 + h * 64 + lane;
#pragma unroll
                  for (int i = 0; i < 8; ++i) lav[i] = lap[i * 256];
#pragma unroll
                  for (int i = 0; i < 8; ++i) { c += lav[i]; cum[(8 * wave + i) * 64 + lane] = c; }
                  seg[wave * 64 + lane] = c; }
                __syncthreads();
                { f32x4 offa = (f32x4){0.f, 0.f, 0.f, 0.f}, offb = offa; const int wq = tr >> 3;
#pragma unroll
                  for (int w = 0; w < 7; ++w) { if (w < wq) { offa += *(const f32x4*)(seg + w * 64 + 8 * c8); offb += *(const f32x4*)(seg + w * 64 + 8 * c8 + 4); } }
                  const f32x4 ca = *(const f32x4*)(cum + tr * 64 + 8 * c8) + offa, cb = *(const f32x4*)(cum + tr * 64 + 8 * c8 + 4) + offb;
                  float ea[8];
#pragma unroll
                  for (int j = 0; j < 4; ++j) { ea[j] = __expf(ca[j]); ea[4 + j] = __expf(cb[j]); }
                  v4u wq_, wk_;
                  wq_.x = pk2(bflo(qraw.x) * ea[0], bfhi(qraw.x) * ea[1]); wq_.y = pk2(bflo(qraw.y) * ea[2], bfhi(qraw.y) * ea[3]); wq_.z = pk2(bflo(qraw.z) * ea[4], bfhi(qraw.z) * ea[5]); wq_.w = pk2(bflo(qraw.w) * ea[6], bfhi(qraw.w) * ea[7]);
                  float ia[8];
#pragma unroll
                  for (int j = 0; j < 8; ++j) ia[j] = __builtin_amdgcn_rcpf(ea[j]);
                  wk_.x = pk2(bflo(kraw.x) * ia[0], bfhi(kraw.x) * ia[1]); wk_.y = pk2(bflo(kraw.y) * ia[2], bfhi(kraw.y) * ia[3]); wk_.z = pk2(bflo(kraw.z) * ia[4], bfhi(kraw.z) * ia[5]); wk_.w = pk2(bflo(kraw.w) * ia[6], bfhi(kraw.w) * ia[7]);
                  *(LAS v4u*)(qel + tr * 144 + c8 * 16) = wq_; *(LAS v4u*)(kel + tr * 144 + c8 * 16) = wk_;
                  LAS v4u* vd = (LAS v4u*)(vvl + tr * 272 + c8 * 32); vd[0] = x0; vd[1] = x1;
                  v4u w0, w1; w0.x = pk2(a0[0], a0[1]); w0.y = pk2(a0[2], a0[3]); w0.z = pk2(a1[0], a1[1]); w0.w = pk2(a1[2], a1[3]);
                  w1.x = pk2(a2[0], a2[1]); w1.y = pk2(a2[2], a2[3]); w1.z = pk2(a3[0], a3[1]); w1.w = pk2(a3[2], a3[3]);
                  LAS v4u* sd = (LAS v4u*)(stl + sv * 144 + skq * 2); sd[0] = w0; sd[1] = w1; }
                __syncthreads();
                { const int tt = wave & 3, vh = wave >> 2, ql = lane & 15, g4 = lane >> 4; const int t = 16 * tt + ql;
                  const bf16x8 qb0 = frag_rm(qel, 144, 16 * tt, 0, lane), qb1 = frag_rm(qel, 144, 16 * tt, 32, lane);
                  f32x4 sT[4];
#pragma unroll
                  for (int st = 0; st < 4; ++st) { sT[st] = (f32x4){0.f, 0.f, 0.f, 0.f};
                      if (st <= tt) { sT[st] = MFMA16(frag_rm(kel, 144, 16 * st, 0, lane), qb0, sT[st]); sT[st] = MFMA16(frag_rm(kel, 144, 16 * st, 32, lane), qb1, sT[st]);
#pragma unroll
                          for (int rg = 0; rg < 4; ++rg) if (16 * st + 4 * g4 + rg > t) sT[st][rg] = 0.f; } }
                  const bf16x8 pb0 = pack8(sT[0], sT[1]), pb1 = pack8(sT[2], sT[3]);
                  f32x4 acc[4]; float ss = 0.f;
#pragma unroll
                  for (int vt = 0; vt < 4; ++vt) { const int V0 = 16 * (4 * vh + vt); f32x4 a = (f32x4){0.f, 0.f, 0.f, 0.f};
                      a = MFMA16(frag_trp(vvl, 272, V0, 0, lane), pb0, a); a = MFMA16(frag_trp(vvl, 272, V0, 32, lane), pb1, a);
                      a = MFMA16(frag_rm(stl, 144, V0, 0, lane), qb0, a); a = MFMA16(frag_rm(stl, 144, V0, 32, lane), qb1, a);
                      acc[vt] = a; ss += (a[0] * a[0] + a[1] * a[1]) + (a[2] * a[2] + a[3] * a[3]); }
                  ss += __shfl_xor(ss, 16); ss += __shfl_xor(ss, 32);
                  if (g4 == 0) rsq[(tt * 2 + vh) * 16 + ql] = ss;
                  __syncthreads();
                  const float rs = 1.0f / sqrtf((rsq[(tt * 2) * 16 + ql] + rsq[(tt * 2 + 1) * 16 + ql]) * (1.0f / 128.0f) + pg8::RMS_EPS);
#pragma unroll
                  for (int vt = 0; vt < 4; ++vt) { const int v0 = 16 * (4 * vh + vt) + 4 * g4;
                      const pg8::u32x2 gr = *(const pg8::u32x2*)(U + (row0 + t) * NU + UGR + h * 128 + v0); const f32x4 gv = *(const f32x4*)(gn + v0);
                      const float o0 = acc[vt][0] * rs * gv[0] * pg8::silu_f(bflo(gr.x)), o1 = acc[vt][1] * rs * gv[1] * pg8::silu_f(bfhi(gr.x));
                      const float o2 = acc[vt][2] * rs * gv[2] * pg8::silu_f(bflo(gr.y)), o3 = acc[vt][3] * rs * gv[3] * pg8::silu_f(bfhi(gr.y));
                      pg8::u32x2 w; w.x = pg8::cvt_pk_bf16(o0, o1); w.y = pg8::cvt_pk_bf16(o2, o3);
                      *(pg8::u32x2*)(MIX + (row0 + t) * D + 256 + h * 128 + v0) = w; } }
                __syncthreads();
            }
        }
        SEAM(pb + 3);
        if (IN(pb + 4)) {
            pg8::Gemm g{MIX, (const bf16*)(ws + WS_WOUT) + (size_t)layer * D * D, M, D, D, D}; pg8::StaticOrder S; S.init(M, D, G, bx);
            if constexpr (layer == 0) { pg8::EpiRes<true> E{args.x, XBD, SSD}; pg8::gemm_phase<pg8::EpiRes<true>, pg8::StaticOrder, true, true>(ldsl, g, S, E, noepi); }
            else { pg8::EpiRes<false> E{XB, XBD, SSD}; pg8::gemm_phase<pg8::EpiRes<false>, pg8::StaticOrder, true, true>(ldsl, g, S, E, noepi); }
        }
        SEAM(pb + 4);
        if (layer == 0) {
            if (IN(pb + 5)) {
                pg8::Gemm g{XB, W13, M, 2 * FF, D, D}; pg8::StaticOrder S; S.init(M, 2 * FF, G, bx);
                pg8::EpiGlu<false> E{H, FF, SS};
                pg8::gemm_phase<pg8::EpiGlu<false>, pg8::StaticOrder, true, true>(ldsl, g, S, E, noepi);
            }
            SEAM(pb + 5);
            if (IN(pb + 6)) {
                pg8::Gemm g{H, W2, M, D, FF, FF}; pg8::StaticOrder S; S.init(M, D, G, bx);
#if defined(PROBE_EPI) && PROBE_EPI
                if (dry) { pg8::EpiRes<false, PROBE_EPI> E{XB, XBD, SSD}; pg8::gemm_phase<pg8::EpiRes<false, PROBE_EPI>, pg8::StaticOrder, true, true>(ldsl, g, S, E, noepi); } else
#endif
                { pg8::EpiRes<false> E{XB, XBD, SSD}; pg8::gemm_phase<pg8::EpiRes<false>, pg8::StaticOrder, true, true>(ldsl, g, S, E, noepi); }
            }
            SEAM(pb + 6);
        } else {
            for (int rp_ = 0; rp_ < 1 + ((pad_ >> 14) & 1); ++rp_)
            if (IN(pb + 5)) {
                const int tid = pg8::tid_here(), lane = tid & 63; (void)lane;
                float* wr_l = (float*)lds;
                int* cnt_l = (int*)(lds + 32768);
                const float* gf = args.g_ffn + D;
                { f32x4 ra[2][2]; float gk[2];
#pragma unroll
                  for (int j = 0; j < 2; ++j) { const int k = tid + NTHR * j; ra[j][0] = *(const f32x4*)(args.moe_router + k * 8); ra[j][1] = *(const f32x4*)(args.moe_router + k * 8 + 4); gk[j] = gf[k]; }
#pragma unroll
                  for (int j = 0; j < 2; ++j) { const int k = tid + NTHR * j;
#pragma unroll
                      for (int e = 0; e < 4; ++e) { wr_l[e * D + k] = ra[j][0][e] * gk[j]; wr_l[(4 + e) * D + k] = ra[j][1][e] * gk[j]; } } }
                if (tid < 8) cnt_l[tid] = 0;
                __syncthreads();
                for (int blk = bx; blk < 256; blk += G) {
                    if (blk != bx) { __syncthreads(); if (tid < 8) cnt_l[tid] = 0; __syncthreads(); }
                    v4u xpre[8][2];
#pragma unroll
                    for (int i = 0; i < 8; ++i) { const v4u* xr = (const v4u*)(XB + (size_t)(blk * 64 + wave * 8 + i) * D) + lane; xpre[i][0] = xr[0]; xpre[i][1] = xr[64]; }
                    const int mi = blk * 64 + wave * 8 + (lane >> 3);
                    typedef float f32x2_t __attribute__((ext_vector_type(2))); const f32x2_t ssp = *(const f32x2_t*)(SS + (size_t)mi * 16 + 2 * (lane & 7));
                    float v[64];
#pragma unroll
                    for (int q = 0; q < 64; ++q) v[q] = 0.f;
#pragma unroll
                    for (int eh = 0; eh < 2; ++eh) { f32x4 w[4][2][2];
#pragma unroll
                        for (int e = 0; e < 4; ++e)
#pragma unroll
                            for (int j = 0; j < 2; ++j) { const float* wp = wr_l + (4 * eh + e) * D + 8 * (lane + 64 * j); w[e][j][0] = *(const f32x4*)wp; w[e][j][1] = *(const f32x4*)(wp + 4); }
#pragma unroll
                        for (int i = 0; i < 8; ++i)
#pragma unroll
                            for (int j = 0; j < 2; ++j) { const v4u xw = xpre[i][j];
                                const f32x4 va = (f32x4){bflo(xw.x), bfhi(xw.x), bflo(xw.y), bfhi(xw.y)}, vb = (f32x4){bflo(xw.z), bfhi(xw.z), bflo(xw.w), bfhi(xw.w)};
#pragma unroll
                                for (int e = 0; e < 4; ++e) v[i * 8 + 4 * eh + e] += ((va[0] * w[e][j][0][0] + va[1] * w[e][j][0][1]) + (va[2] * w[e][j][0][2] + va[3] * w[e][j][0][3])) + ((vb[0] * w[e][j][1][0] + vb[1] * w[e][j][1][1]) + (vb[2] * w[e][j][1][2] + vb[3] * w[e][j][1][3])); } }
#pragma unroll
                    for (int st = 32; st >= 1; st >>= 1) { const bool up = (lane & st) != 0;
#pragma unroll
                        for (int q = 0; q < st; ++q) { const float send = up ? v[q] : v[q + st]; const float keep = up ? v[q + st] : v[q]; v[q] = keep + __shfl_xor(send, st); } }
                    float ssq = ssp[0] + ssp[1]; ssq += __shfl_xor(ssq, 1); ssq += __shfl_xor(ssq, 2); ssq += __shfl_xor(ssq, 4);
                    const float rs = 1.0f / sqrtf(ssq * (1.0f / 1024.0f) + pg8::RMS_EPS);
                    const float lg = v[0] * rs; const int me = lane & 7;
                    float bv = lg; int bi = me;
#pragma unroll
                    for (int st = 1; st < 8; st <<= 1) { const float ov = __shfl_xor(bv, st); const int oi = __shfl_xor(bi, st); if (ov > bv || (ov == bv && oi < bi)) { bv = ov; bi = oi; } }
                    float cv = (me == bi) ? -INFINITY : lg; int ci = me;
#pragma unroll
                    for (int st = 1; st < 8; st <<= 1) { const float ov = __shfl_xor(cv, st); const int oi = __shfl_xor(ci, st); if (ov > cv || (ov == cv && oi < ci)) { cv = ov; ci = oi; } }
                    if (me == 0) { const float w1 = 1.0f / (1.0f + __expf(bv - cv)), w0 = 1.0f - w1;
                        TOPI[mi * 2] = bi; TOPI[mi * 2 + 1] = ci; TOPW[mi * 2] = w0; TOPW[mi * 2 + 1] = w1; RS3[mi] = rs; atomicAdd(&cnt_l[bi], 1); atomicAdd(&cnt_l[ci], 1); }
                    __syncthreads();
                    if (tid < 8) CNT[blk * 8 + tid] = cnt_l[tid];
                }
            }
            SEAM(pb + 5);
            for (int rp_ = 0; rp_ < 1 + ((pad_ >> 15) & 1); ++rp_)
            if (IN(pb + 6)) {
                const int tid = pg8::tid_here(), lane = tid & 63; (void)lane;
                int* base_l = (int*)lds;
                int* pre_l = base_l + 8;
                int* tot_l = pre_l + 8;
                int* pos_l = tot_l + 8;
                int* ent_l = pos_l + 128;
                for (int blk = bx; blk < 256; blk += G) {
                    __syncthreads();
                    if (tid < 8) { tot_l[tid] = 0; pre_l[tid] = 0; }
                    if (tid < 128) ent_l[tid] = TOPI[blk * 128 + tid];
                    __syncthreads();
                    { const int g2 = tid >> 1, e0 = (tid & 1) * 4; const int4 c = *(const int4*)(CNT + g2 * 8 + e0);
                      atomicAdd(&tot_l[e0], c.x); atomicAdd(&tot_l[e0 + 1], c.y); atomicAdd(&tot_l[e0 + 2], c.z); atomicAdd(&tot_l[e0 + 3], c.w);
                      if (g2 < blk) { atomicAdd(&pre_l[e0], c.x); atomicAdd(&pre_l[e0 + 1], c.y); atomicAdd(&pre_l[e0 + 2], c.z); atomicAdd(&pre_l[e0 + 3], c.w); } }
                    __syncthreads();
                    if (tid == 0) { int bs = 0; for (int e = 0; e < 8; ++e) { base_l[e] = bs; bs += (tot_l[e] + 255) & ~255; } }
                    __syncthreads();
                    if (tid < 128) { const int e = ent_l[tid]; int rank = 0; for (int j = 0; j < tid; ++j) rank += (ent_l[j] == e) ? 1 : 0;
                        const int p = base_l[e] + pre_l[e] + rank; pos_l[tid] = p; POS[blk * 128 + tid] = p; ROWGATE[p] = TOPW[blk * 128 + tid]; ROWRS[p] = RS3[blk * 64 + (tid >> 1)]; }
                    if (blk == 0) {
                        for (int e = 0; e < 8; ++e) { const int npe = (tot_l[e] + 255) >> 8; for (int p = base_l[e] + tot_l[e] + tid; p < base_l[e] + npe * 256; p += NTHR) { ROWGATE[p] = 0.f; ROWRS[p] = 0.f; } }
                        if (tid == 0) { int np = 0; for (int e = 0; e < 8; ++e) { const int npe = (tot_l[e] + 255) >> 8; for (int j = 0; j < npe; ++j) PANE[np++] = e; } PANE[MAXPAN] = np; } }
                    __syncthreads();
                    for (int i = 0; i < 16; ++i) { const int sl = wave * 16 + i; const int m = blk * 64 + (sl >> 1); const int p = pos_l[sl];
                        const v4u* s = (const v4u*)(XB + (size_t)m * D) + lane; v4u* d = (v4u*)(XS + (size_t)p * D) + lane; d[0] = s[0]; d[64] = s[64]; }
                }
            }
            SEAM(pb + 6);
            if (IN(pb + 7)) {
                pg8::Gemm g{XS, WE13, MAXROWS, 2 * FE, D, D}; pg8::MoeOrder S{PANE, PANE[MAXPAN], 28, 4, G, bx};
                pg8::EpiGlu<true> E{HE, FE, ROWRS};
                pg8::gemm_phase<pg8::EpiGlu<true>, pg8::MoeOrder, true, true>(ldsl, g, S, E, noepi);
            }
            SEAM(pb + 7);
            for (int rp_ = 0; rp_ < 1 + ((pad_ >> 7) & 1); ++rp_)
            if (IN(pb + 8)) {
                const int tid = pg8::tid_here(), lane = tid & 63; (void)lane;
                unsigned* scr = (unsigned*)(lds + wave * 8704);
                constexpr int T_J = 56 * 16;
                for (int it = gw; it < 8 * T_J; it += NGW) { const int e = it / T_J, r = it % T_J;
                    transpose_tile(args.moe_w2 + (size_t)e * FE * D, D, 64 * (r / 16), 64 * (r % 16), WE2 + (size_t)e * D * FE, FE, 64 * (r % 16), nullptr, scr, lane); }
            }
            SEAM(pb + 8);
            if (IN(pb + 9)) {
                const int npan = PANE[MAXPAN]; int npf = ((npan * 4) / G) * G / 4; if (npan - npf > 8 || npf == 0) npf = npan;
                { pg8::Gemm g{HE, WE2, MAXROWS, D, FE, FE}; pg8::MoeOrder S{PANE, npf, 4, 8, G, bx};
                  pg8::EpiMoeDown E{Y, ROWGATE};
                  pg8::gemm_phase<pg8::EpiMoeDown, pg8::MoeOrder, true, true>(ldsl, g, S, E, noepi); }
                if (npan > npf) { __syncthreads();
                  pg8::Gemm g{HE, WE2, MAXROWS, D, 896, FE}; pg8::MoeTailOrder S{PANE, npf, npan - npf, G, bx};
                  pg8::EpiMoeDownPart E{(float*)(ws + WS_YT), ROWGATE, npf * 256};
                  pg8::gemm_phase<pg8::EpiMoeDownPart, pg8::MoeTailOrder, true, true>(ldsl, g, S, E, noepi); }
            }
            SEAM(pb + 9);
            if (IN(pb + 10)) {
                const int tid = pg8::tid_here(), lane = tid & 63; (void)lane;
                const int npan_f = PANE[MAXPAN]; int npf_f = ((npan_f * 4) / G) * G / 4; if (npan_f - npf_f > 8 || npf_f == 0) npf_f = npan_f; const int tail0 = npf_f * 256;
                for (int rep_ = 0; rep_ < 1 + ((pad_ >> 12) & 1); ++rep_)
                for (int m = gw; m < M; m += NGW) {
                    f32x4* xr = (f32x4*)(X + (size_t)m * D) + lane; const int p0 = POS[m * 2], p1 = POS[m * 2 + 1];
                    const unsigned long long* xb = (const unsigned long long*)(XB + (size_t)m * D) + lane;
                    f32x4 v[4]; float s = 0.f;
#pragma unroll
                    for (int j = 0; j < 4; ++j) { const unsigned long long xw = xb[64 * j]; v[j] = (f32x4){bflo((unsigned)xw), bfhi((unsigned)xw), bflo((unsigned)(xw >> 32)), bfhi((unsigned)(xw >> 32))}; }
#pragma unroll
                    for (int sl = 0; sl < 2; ++sl) { const int p = sl ? p1 : p0;
                        if (p < tail0) { const unsigned long long* yp = (const unsigned long long*)(Y + (size_t)p * D) + lane;
#pragma unroll
                            for (int j = 0; j < 4; ++j) { const unsigned long long a = yp[64 * j]; v[j] += (f32x4){bflo((unsigned)a), bfhi((unsigned)a), bflo((unsigned)(a >> 32)), bfhi((unsigned)(a >> 32))}; } }
                        else { const f32x4* tp = (const f32x4*)((const float*)(ws + WS_YT) + (size_t)(p - tail0) * D) + lane;
#pragma unroll
                            for (int kq = 0; kq < 4; ++kq)
#pragma unroll
                                for (int j = 0; j < 4; ++j) v[j] += tp[(size_t)kq * 2048 * (D / 4) + 64 * j]; } }
#pragma unroll
                    for (int j = 0; j < 4; ++j) s += (v[j][0] * v[j][0] + v[j][1] * v[j][1]) + (v[j][2] * v[j][2] + v[j][3] * v[j][3]);
                    const float rs = 1.0f / sqrtf(wave_sum(s) * (1.0f / D) + pg8::RMS_EPS);
                    const f32x4* gf = (const f32x4*)args.g_final + lane;
#pragma unroll
                    for (int j = 0; j < 4; ++j) (dry ? (f32x4*)((float*)(ws + WS_HE) + (size_t)m * D) + lane : xr)[64 * j] = v[j] * rs * gf[64 * j];
                }
            }
        }
}

__global__ void __launch_bounds__(NTHR, 2) hybrid_fwd(Args args) {
    extern __shared__ __attribute__((aligned(16))) unsigned char lds[];
    LAS unsigned char* ldsl = (LAS unsigned char*)lds;
    volatile LAS unsigned* MISC = (volatile LAS unsigned*)(ldsl + MISC_OFF);
    const int tid = threadIdx.x, lane = tid & 63, wave = __builtin_amdgcn_readfirstlane(tid >> 6);
    const int G = gridDim.x; const int bx = blockIdx.x;
    const int gw = bx * NWAVES + wave, NGW = G * NWAVES;
    unsigned char* ws = args.ws;
    for (int u = tid; u < (LDS_BYTES - LDSCTL_OFF) / 4; u += NTHR) ((LAS unsigned*)(ldsl + LDSCTL_OFF))[u] = 0u;
    __syncthreads();
    XcdBarrier bar; bar.bar = (unsigned*)(ws + WS_CTL) + CW_BAR + args.li * XCD_BAR_WORDS; bar.x = 0; bar.st = nullptr;
    if (MK_N_LAUNCHES == 1) bar = xcd_barrier_post((unsigned*)(ws + WS_CTL) + CW_BAR + args.li * XCD_BAR_WORDS, MISC + 8);
    const int lo = args.ph_lo, hi = args.ph_hi;

    WS_PTRS

    for (int rp_ = 0; rp_ < 1 + ((args.pad >> 6) & 1); ++rp_)
    if (IN(0)) {
        unsigned* scr = (unsigned*)(lds + wave * 8704);
        constexpr int T_A = 16 * 36, T_B = 16 * 12, T_D = 16 * 16, T_L = T_A + T_B + T_D;
        constexpr int T_F = 16 * 44, T_G = 44 * 16, T_E = 16 * 56;
        constexpr int NT0 = 2 * T_L + 2 * T_F + T_G + 16 * T_E;
        for (int it = gw; it < NT0; it += NGW) {
            int r = it;
            if (r < 2 * T_L) { const int l = r / T_L; r -= l * T_L; const float* win = args.w_mix_in + (size_t)l * D * INC; const float* gm = args.g_mix + l * D;
                bf16* WIN = (bf16*)(ws + WS_WIN) + (size_t)l * NU * D;
                if (r < T_A) { transpose_tile(win, INC, 64 * (r / 36), 64 * (r % 36), WIN, D, 64 * (r % 36), gm, scr, lane); continue; } r -= T_A;
                if (r < T_B) { transpose_tile(win, INC, 64 * (r / 12), 2320 + 64 * (r % 12), WIN, D, 2304 + 64 * (r % 12), gm, scr, lane); continue; } r -= T_B;
                transpose_tile(args.w_mix_out + (size_t)l * D * D, D, 64 * (r / 16), 64 * (r % 16), (bf16*)(ws + WS_WOUT) + (size_t)l * D * D, D, 64 * (r % 16), nullptr, scr, lane); continue; }
            r -= 2 * T_L;
            if (r < 2 * T_F) { const int w3 = r / T_F; r -= w3 * T_F; const int n0 = 64 * (r % 44);
                transpose_tile(w3 ? args.ffn_w3 : args.ffn_w1, FF, 64 * (r / 44), n0, W13, D, (n0 >> 7) * 256 + (n0 & 127) + 128 * w3, args.g_ffn, scr, lane); continue; }
            r -= 2 * T_F;
            if (r < T_G) { transpose_tile(args.ffn_w2, D, 64 * (r / 16), 64 * (r % 16), W2, FF, 64 * (r % 16), nullptr, scr, lane); continue; }
            r -= T_G;
            { const int ew = r / T_E; r -= ew * T_E; const int e = ew >> 1, w3 = ew & 1; const int n0 = 64 * (r % 56);
              transpose_tile((w3 ? args.moe_w3 : args.moe_w1) + (size_t)e * D * FE, FE, 64 * (r / 56), n0, WE13 + (size_t)e * 2 * FE * D, D, (n0 >> 7) * 256 + (n0 & 127) + 128 * w3, args.g_ffn + D, scr, lane); }
        }
        for (int m = gw; m < M; m += NGW) {
            const f32x4* xr = (const f32x4*)(args.x + (size_t)m * D) + lane; float s = 0.f;
            unsigned long long* o8 = (unsigned long long*)(XB + (size_t)m * D) + lane;
#pragma unroll
            for (int j = 0; j < 4; ++j) { const f32x4 v = xr[64 * j]; s += (v[0] * v[0] + v[1] * v[1]) + (v[2] * v[2] + v[3] * v[3]);
                o8[64 * j] = (unsigned long long)pk2(v[0], v[1]) | ((unsigned long long)pk2(v[2], v[3]) << 32); }
            s = wave_sum(s);
            if (lane < 16) SS[(size_t)m * 16 + lane] = (lane == 0) ? s : 0.f;
        }
        for (int i = bx * NTHR + tid; i < 2049 * 4; i += G * NTHR) { const int d = i >> 2, h = i & 3; BL[i] = args.rel_bias[rel_bucket(d) * 4 + h] * LOG2E; }
        for (int i = bx * NTHR + tid; i < 2 * 16 * D; i += G * NTHR) { const int k = i & (D - 1), r = (i >> 10) & 15, l = i >> 14;
            ((bf16*)(ws + WS_WGLR))[i] = (bf16)f2bf(args.g_mix[l * D + k] * args.w_mix_in[((size_t)l * D + k) * INC + 2304 + r]); }
    }
    SEAM(0);

    Ctx c; c.args = args; c.tid = tid; c.lane = lane; c.wave = wave; c.G = G; c.bx = bx; c.gw = gw; c.NGW = NGW; c.lo = lo; c.hi = hi; c.bar = bar;
    layer_phases<0>(c, lds);
    layer_phases<1>(c, lds);
}
#undef IN
#undef SEAM
#undef GRID_BAR


extern "C" void kernel_launch(void* const* d_in, const int* in_sizes, int n_in, void* d_out, int out_size, void* d_ws, size_t ws_size, hipStream_t stream) {
    static int grid = 0;
    if (grid == 0) {
        if (n_in != 18 || in_sizes[0] != M * D || out_size != M * D || ws_size < WS_END) { fprintf(stderr, "kernel_launch: unexpected shapes / workspace (%zu < %zu)\n", ws_size, (size_t)WS_END); grid = -1; return; }
        int dev = 0, cus = 0, per_cu = 0;
        if (hipGetDevice(&dev) != hipSuccess || hipDeviceGetAttribute(&cus, hipDeviceAttributeMultiprocessorCount, dev) != hipSuccess) { grid = -1; return; }
        if (hipFuncSetAttribute((const void*)hybrid_fwd, hipFuncAttributeMaxDynamicSharedMemorySize, LDS_BYTES) != hipSuccess) { fprintf(stderr, "kernel_launch: hipFuncSetAttribute failed\n"); grid = -1; return; }
        if (hipOccupancyMaxActiveBlocksPerMultiprocessor(&per_cu, (const void*)hybrid_fwd, NTHR, LDS_BYTES) != hipSuccess || per_cu < 1) { fprintf(stderr, "kernel_launch: occupancy query says %d\n", per_cu); }
        (void)hipGetLastError();
        grid = cus;
    }
    if (grid < 0) return;
    if (hipMemsetAsync((char*)d_ws + WS_CTL, 0, CTL_ZERO_BYTES, stream) != hipSuccess) return;
    Args a{};
    const float** f = (const float**)&a;
    for (int i = 0; i < 18; ++i) f[i] = (const float*)d_in[i];
    a.out = (float*)d_out; a.ws = (unsigned char*)d_ws;
    if (MK_N_LAUNCHES == 1) {
#ifndef PROBE_MODE
#define PROBE_MODE 0
#endif
#ifdef PROBE_PHASE
        const int cuts[4][2] = {{0, PROBE_PHASE}, {PROBE_PHASE, PROBE_PHASE + 1}, {PROBE_PHASE, 64}, {0, 0}};
        for (int li = 0; li < 3; ++li) { a.ph_lo = cuts[li][0]; a.ph_hi = cuts[li][1]; a.li = li; a.pad = (li == 1) ? PROBE_MODE : 0; hipLaunchKernelGGL(hybrid_fwd, dim3(grid), dim3(NTHR), LDS_BYTES, stream, a); }
#else
        a.ph_lo = 0; a.ph_hi = 64; a.li = 0;
#ifndef PROBE_LOW
#define PROBE_LOW 0
#endif
#ifdef PROBE_REP
        a.pad = (PROBE_REP << 8) | PROBE_LOW;
#endif
        hipLaunchKernelGGL(hybrid_fwd, dim3(grid), dim3(NTHR), LDS_BYTES, stream, a);
#endif
    }
    else {
        static const int phases[] = {0, 1, 2, 3, 4, 5, 6, 7, 17, 18, 19, 20, 21, 22, 23, 24, 25, 26, 27};
        for (int p : phases) { a.ph_lo = p; a.ph_hi = p + 1; hipLaunchKernelGGL(hybrid_fwd, dim3(grid), dim3(NTHR), LDS_BYTES, stream, a); }
    }
}
```

```cpp
#include <hip/hip_runtime.h>
#include <cstdio>
#include <cstdint>

#ifndef MK_N_LAUNCHES
#define MK_N_LAUNCHES 1
#endif

namespace pg8 {
#define PG8_LAS __attribute__((address_space(3)))
__device__ __forceinline__ int tid_here() { int t = threadIdx.x; asm volatile("" : "+v"(t)); return t; }
typedef unsigned short bf16_t;
typedef short bf16x8 __attribute__((ext_vector_type(8)));
typedef float f32x4 __attribute__((ext_vector_type(4)));
typedef unsigned u32x4 __attribute__((ext_vector_type(4)));
typedef unsigned u32x2 __attribute__((ext_vector_type(2)));
constexpr int BM = 256, BK = 64, HALF = 128, HTB = HALF * BK * 2, STAGE_BYTES = 8 * HTB, NXCD = 8, WGM = 8;

__host__ __device__ __forceinline__ int lds_byte(int r, int c) { const int st = (r >> 4) * 2 + (c >> 5), rr = r & 15, cc = c & 31, ob = rr * 64 + cc * 2; return st * 1024 + (ob ^ (((ob >> 9) & 1) << 5)); }
__host__ __device__ __forceinline__ void stage_rc(int b, int& R, int& C) { const int st = b / 1024, sb = b % 1024, swz = sb ^ (((sb >> 9) & 1) << 5); R = (st >> 1) * 16 + swz / 64; C = (st & 1) * 32 + (swz % 64) / 2; }
__host__ __device__ __forceinline__ int perm32(int rho) { const int n = rho >> 4, i = rho & 15; return 8 * (i >> 2) + 4 * n + (i & 3); }

struct Unit { int pm, pn, ko; };
struct Gemm { const bf16_t* A; const bf16_t* Bt; int M, N, K, ld; };

struct StaticOrder {
    int nM, nN, nwg, G, c;
    __host__ __device__ void init(int M, int N, int G_, int c_) { nM = M / BM; nN = N / BM; nwg = nM * nN; G = G_; c = c_; }
    __host__ __device__ bool next(int i, Unit& u) const {
        const long L = (long)i * G + c; if (L >= nwg) return false;
        int wgid = (int)L; { const int q = nwg / NXCD, r = nwg % NXCD, xcd = wgid % NXCD, off = wgid / NXCD; wgid = (xcd < r ? xcd * (q + 1) : r * (q + 1) + (xcd - r) * q) + off; }
        const int nig = WGM * nN, gid = wgid / nig, fm = gid * WGM, gsz = (nM - fm) < WGM ? (nM - fm) : WGM;
        u.pm = fm + ((wgid % nig) % gsz); u.pn = (wgid % nig) / gsz; u.ko = 0; return true;
    }
    __device__ __forceinline__ void a_ready(const Unit&) const {}
    __device__ __forceinline__ void done(const Unit&) const {}
};
struct MoeOrder {
    const int* panel_e; int npan, NT, GP, G, c;
    __device__ bool next(int i, Unit& u) const {
        const int nwg = npan * NT; const long L = (long)i * G + c; if (L >= nwg) return false;
        int wgid = (int)L; { const int q = nwg / NXCD, r = nwg % NXCD, xcd = wgid % NXCD, off = wgid / NXCD; wgid = (xcd < r ? xcd * (q + 1) : r * (q + 1) + (xcd - r) * q) + off; }
        const int nig = GP * NT, grp = wgid / nig, fm = grp * GP, gsz = (npan - fm) < GP ? (npan - fm) : GP; const int rr = wgid % nig;
        const int p = fm + rr % gsz; u.pm = p; u.pn = panel_e[p] * NT + rr / gsz; u.ko = 0; return true;
    }
    __device__ __forceinline__ void a_ready(const Unit&) const {}
    __device__ __forceinline__ void done(const Unit&) const {}
};

struct MoeTailOrder {
    const int* panel_e; int p0, ntp, G, c;
    __device__ bool next(int i, Unit& u) const {
        const long L = (long)i * G + c; if (L >= (long)ntp * 16) return false;
        const int kq = (int)L & 3, r = (int)L >> 2, p = p0 + (r >> 2); u.pm = p; u.pn = panel_e[p] * 4 + (r & 3); u.ko = kq * 896 * 2; return true;
    }
    __device__ __forceinline__ void a_ready(const Unit&) const {}
    __device__ __forceinline__ void done(const Unit&) const {}
};
typedef float f32x2c_t __attribute__((ext_vector_type(2))); typedef __bf16 bf16x2c_t __attribute__((ext_vector_type(2)));
__device__ __forceinline__ unsigned cvt_pk_bf16(float lo, float hi) { const f32x2c_t v = {lo, hi}; return __builtin_bit_cast(unsigned, __builtin_convertvector(v, bf16x2c_t)); }

constexpr float RMS_EPS = 1e-6f;
__device__ __forceinline__ float rstd_of(const float* ss16) {
    const f32x4 a = *(const f32x4*)ss16, b = *(const f32x4*)(ss16 + 4), c = *(const f32x4*)(ss16 + 8), d = *(const f32x4*)(ss16 + 12);
    const float s = ((a[0] + a[1]) + (a[2] + a[3])) + ((b[0] + b[1]) + (b[2] + b[3])) + ((c[0] + c[1]) + (c[2] + c[3])) + ((d[0] + d[1]) + (d[2] + d[3]));
    return __builtin_amdgcn_rsqf(s * (1.0f / 1024.0f) + RMS_EPS);
}
__device__ __forceinline__ void rstd4(const float* SS, int row0, float (&rs)[4]) {
    f32x4 p[4][4];
#pragma unroll
    for (int m = 0; m < 4; ++m)
#pragma unroll
        for (int q = 0; q < 4; ++q) p[m][q] = *(const f32x4*)(SS + (size_t)(row0 + 16 * m) * 16 + 4 * q);
    asm volatile("" : "+v"(p[0][0]), "+v"(p[0][1]), "+v"(p[0][2]), "+v"(p[0][3]), "+v"(p[1][0]), "+v"(p[1][1]), "+v"(p[1][2]), "+v"(p[1][3]),
                      "+v"(p[2][0]), "+v"(p[2][1]), "+v"(p[2][2]), "+v"(p[2][3]), "+v"(p[3][0]), "+v"(p[3][1]), "+v"(p[3][2]), "+v"(p[3][3]));
#pragma unroll
    for (int m = 0; m < 4; ++m) { const f32x4 a = p[m][0], b = p[m][1], c = p[m][2], d = p[m][3];
        const float s = ((a[0] + a[1]) + (a[2] + a[3])) + ((b[0] + b[1]) + (b[2] + b[3])) + ((c[0] + c[1]) + (c[2] + c[3])) + ((d[0] + d[1]) + (d[2] + d[3]));
        rs[m] = __builtin_amdgcn_rsqf(s * (1.0f / 1024.0f) + RMS_EPS); }
}
__device__ __forceinline__ float logsig16(float x) { return ((x < 0.f ? x : 0.f) - __logf(1.0f + __expf(-fabsf(x)))) * (1.0f / 16.0f); }
__device__ __forceinline__ float silu_f(float a) { return a * __builtin_amdgcn_rcpf(1.0f + __builtin_amdgcn_exp2f(a * -1.4426950408889634f)); }

struct EpiU {
    static constexpr bool PERM = true, AFTER_DRAIN = false;
    bf16_t* U; int ldu; const float* SS; float qs;
    __device__ __forceinline__ void operator()(const f32x4 (&acc)[2][2][4][2], const Unit& u, int wr, int wc, int fr, int fq) const {
        const int row0 = u.pm * BM + wr * 64 + fr, col0 = u.pn * BM + wc * 32 + 8 * fq;
        const float sc = (u.pn == 0) ? qs : ((u.pn == 3) ? 0.125f : 1.0f);
#pragma unroll
        for (int ai = 0; ai < 2; ++ai) { float rs4[4]; rstd4(SS, row0 + ai * HALF, rs4);
#pragma unroll
            for (int m = 0; m < 4; ++m) { const int row = row0 + ai * HALF + m * 16; const float rs = rs4[m] * sc;
                bf16_t* rowp = U + (size_t)row * ldu + col0;
#pragma unroll
                for (int bj = 0; bj < 2; ++bj) { const f32x4 v0 = acc[ai][bj][m][0] * rs, v1 = acc[ai][bj][m][1] * rs;
                    u32x4 w; w.x = cvt_pk_bf16(v0[0], v0[1]); w.y = cvt_pk_bf16(v0[2], v0[3]); w.z = cvt_pk_bf16(v1[0], v1[1]); w.w = cvt_pk_bf16(v1[2], v1[3]);
                    *(u32x4*)(rowp + bj * HALF) = w; } } }
    }
};
template <bool IN_F32, int PM = 0> struct EpiRes {
    static constexpr bool PERM = true, AFTER_DRAIN = false;
    const void* Xin; bf16_t* XB; float* SS;
    __device__ __forceinline__ void operator()(const f32x4 (&acc)[2][2][4][2], const Unit& u, int wr, int wc, int fr, int fq) const {
        const int row0 = u.pm * BM + wr * 64 + fr, col0 = u.pn * BM + wc * 32 + 8 * fq;
        if constexpr (IN_F32) {
#pragma unroll
            for (int ai = 0; ai < 2; ++ai) { f32x4 xo[4][2][2];
#pragma unroll
                for (int m = 0; m < 4; ++m)
#pragma unroll
                    for (int bj = 0; bj < 2; ++bj) { const float* p = (const float*)Xin + (size_t)(row0 + ai * HALF + m * 16) * 1024 + col0 + bj * HALF; xo[m][bj][0] = *(const f32x4*)p; xo[m][bj][1] = *(const f32x4*)(p + 4); }
                asm volatile("" : "+v"(xo[0][0][0]), "+v"(xo[0][0][1]), "+v"(xo[0][1][0]), "+v"(xo[0][1][1]), "+v"(xo[1][0][0]), "+v"(xo[1][0][1]), "+v"(xo[1][1][0]), "+v"(xo[1][1][1]),
                                  "+v"(xo[2][0][0]), "+v"(xo[2][0][1]), "+v"(xo[2][1][0]), "+v"(xo[2][1][1]), "+v"(xo[3][0][0]), "+v"(xo[3][0][1]), "+v"(xo[3][1][0]), "+v"(xo[3][1][1]));
#pragma unroll
                for (int m = 0; m < 4; ++m) { const int row = row0 + ai * HALF + m * 16; float ssum = 0.f;
#pragma unroll
                    for (int bj = 0; bj < 2; ++bj) { const f32x4 v0 = xo[m][bj][0] + acc[ai][bj][m][0], v1 = xo[m][bj][1] + acc[ai][bj][m][1];
                        u32x4 w; w.x = cvt_pk_bf16(v0[0], v0[1]); w.y = cvt_pk_bf16(v0[2], v0[3]); w.z = cvt_pk_bf16(v1[0], v1[1]); w.w = cvt_pk_bf16(v1[2], v1[3]);
                        *(u32x4*)(XB + (size_t)row * 1024 + col0 + bj * HALF) = w;
                        ssum += ((v0[0] * v0[0] + v0[1] * v0[1]) + (v0[2] * v0[2] + v0[3] * v0[3])) + ((v1[0] * v1[0] + v1[1] * v1[1]) + (v1[2] * v1[2] + v1[3] * v1[3])); }
                    ssum += __shfl_xor(ssum, 16); ssum += __shfl_xor(ssum, 32);
                    if (fq == 0) SS[(size_t)row * 16 + u.pn * 4 + wc] = ssum; } }
        } else {
            u32x4 xo[2][4][2];
#pragma unroll
            for (int ai = 0; ai < 2; ++ai)
#pragma unroll
                for (int m = 0; m < 4; ++m)
#pragma unroll
                    for (int bj = 0; bj < 2; ++bj) xo[ai][m][bj] = *(const u32x4*)((const bf16_t*)Xin + (size_t)(row0 + ai * HALF + m * 16) * 1024 + col0 + bj * HALF);
            asm volatile("" : "+v"(xo[0][0][0]), "+v"(xo[0][0][1]), "+v"(xo[0][1][0]), "+v"(xo[0][1][1]), "+v"(xo[0][2][0]), "+v"(xo[0][2][1]), "+v"(xo[0][3][0]), "+v"(xo[0][3][1]),
                              "+v"(xo[1][0][0]), "+v"(xo[1][0][1]), "+v"(xo[1][1][0]), "+v"(xo[1][1][1]), "+v"(xo[1][2][0]), "+v"(xo[1][2][1]), "+v"(xo[1][3][0]), "+v"(xo[1][3][1]));
#pragma unroll
            for (int ai = 0; ai < 2; ++ai)
#pragma unroll
                for (int m = 0; m < 4; ++m) { const int row = row0 + ai * HALF + m * 16; float ssum = 0.f;
#pragma unroll
                    for (int bj = 0; bj < 2; ++bj) { const u32x4 x = xo[ai][m][bj]; f32x4 v0, v1;
                        v0[0] = __builtin_bit_cast(float, x.x << 16) + acc[ai][bj][m][0][0]; v0[1] = __builtin_bit_cast(float, x.x & 0xffff0000u) + acc[ai][bj][m][0][1];
                        v0[2] = __builtin_bit_cast(float, x.y << 16) + acc[ai][bj][m][0][2]; v0[3] = __builtin_bit_cast(float, x.y & 0xffff0000u) + acc[ai][bj][m][0][3];
                        v1[0] = __builtin_bit_cast(float, x.z << 16) + acc[ai][bj][m][1][0]; v1[1] = __builtin_bit_cast(float, x.z & 0xffff0000u) + acc[ai][bj][m][1][1];
                        v1[2] = __builtin_bit_cast(float, x.w << 16) + acc[ai][bj][m][1][2]; v1[3] = __builtin_bit_cast(float, x.w & 0xffff0000u) + acc[ai][bj][m][1][3];
                        u32x4 w; w.x = cvt_pk_bf16(v0[0], v0[1]); w.y = cvt_pk_bf16(v0[2], v0[3]); w.z = cvt_pk_bf16(v1[0], v1[1]); w.w = cvt_pk_bf16(v1[2], v1[3]);
                        if constexpr (!(PM & 8)) *(u32x4*)(XB + (size_t)row * 1024 + col0 + bj * HALF) = w;
                        ssum += ((v0[0] * v0[0] + v0[1] * v0[1]) + (v0[2] * v0[2] + v0[3] * v0[3])) + ((v1[0] * v1[0] + v1[1] * v1[1]) + (v1[2] * v1[2] + v1[3] * v1[3])); }
                    if constexpr (!(PM & 16)) { ssum += __shfl_xor(ssum, 16); ssum += __shfl_xor(ssum, 32); }
                    if constexpr (!(PM & 4)) { if (fq == 0) SS[(size_t)row * 16 + u.pn * 4 + wc] = ssum; }
                    if constexpr ((PM & 12) == 12) asm volatile("" :: "v"(ssum)); }
        }
    }
};
template <bool MOE> struct EpiGlu {
    static constexpr bool PERM = true, AFTER_DRAIN = false;
    bf16_t* O; int ldo; const float* SS;
    __device__ __forceinline__ void operator()(const f32x4 (&acc)[2][2][4][2], const Unit& u, int wr, int wc, int fr, int fq) const {
        const int row0 = u.pm * BM + wr * 64 + fr; const int pnl = MOE ? (u.pn % 28) : u.pn; const int col0 = pnl * HALF + wc * 32 + 8 * fq;
#pragma unroll
        for (int ai = 0; ai < 2; ++ai) { float rs4[4];
            if constexpr (MOE) {
#pragma unroll
                for (int m = 0; m < 4; ++m) rs4[m] = SS[row0 + ai * HALF + m * 16];
                asm volatile("" : "+v"(rs4[0]), "+v"(rs4[1]), "+v"(rs4[2]), "+v"(rs4[3]));
            } else rstd4(SS, row0 + ai * HALF, rs4);
#pragma unroll
            for (int m = 0; m < 4; ++m) { const int row = row0 + ai * HALF + m * 16; const float rs = rs4[m];
                const f32x4 a0 = acc[ai][0][m][0] * rs, a1 = acc[ai][0][m][1] * rs, b0 = acc[ai][1][m][0] * rs, b1 = acc[ai][1][m][1] * rs;
                f32x4 g0, g1;
#pragma unroll
                for (int j = 0; j < 4; ++j) { g0[j] = silu_f(a0[j]) * b0[j]; g1[j] = silu_f(a1[j]) * b1[j]; }
                u32x4 w; w.x = cvt_pk_bf16(g0[0], g0[1]); w.y = cvt_pk_bf16(g0[2], g0[3]); w.z = cvt_pk_bf16(g1[0], g1[1]); w.w = cvt_pk_bf16(g1[2], g1[3]);
                *(u32x4*)(O + (size_t)row * ldo + col0) = w; } }
    }
};
struct EpiMoeDown {
    static constexpr bool PERM = true, AFTER_DRAIN = false;
    bf16_t* Y; const float* gate;
    __device__ __forceinline__ void operator()(const f32x4 (&acc)[2][2][4][2], const Unit& u, int wr, int wc, int fr, int fq) const {
        const int row0 = u.pm * BM + wr * 64 + fr, col0 = (u.pn & 3) * BM + wc * 32 + 8 * fq;
        float gt[2][4];
#pragma unroll
        for (int ai = 0; ai < 2; ++ai)
#pragma unroll
            for (int m = 0; m < 4; ++m) gt[ai][m] = gate[row0 + ai * HALF + m * 16];
        asm volatile("" : "+v"(gt[0][0]), "+v"(gt[0][1]), "+v"(gt[0][2]), "+v"(gt[0][3]), "+v"(gt[1][0]), "+v"(gt[1][1]), "+v"(gt[1][2]), "+v"(gt[1][3]));
#pragma unroll
        for (int ai = 0; ai < 2; ++ai)
#pragma unroll
            for (int m = 0; m < 4; ++m) { const int row = row0 + ai * HALF + m * 16; const float g = gt[ai][m]; bf16_t* rowp = Y + (size_t)row * 1024 + col0;
#pragma unroll
                for (int bj = 0; bj < 2; ++bj) { const f32x4 v0 = acc[ai][bj][m][0] * g, v1 = acc[ai][bj][m][1] * g;
                    u32x4 w; w.x = cvt_pk_bf16(v0[0], v0[1]); w.y = cvt_pk_bf16(v0[2], v0[3]); w.z = cvt_pk_bf16(v1[0], v1[1]); w.w = cvt_pk_bf16(v1[2], v1[3]);
                    *(u32x4*)(rowp + bj * HALF) = w; } }
    }
};

struct EpiMoeDownPart {
    static constexpr bool PERM = false, AFTER_DRAIN = false;
    float* YT; const float* gate; int row_base;
    __device__ __forceinline__ void operator()(const f32x4 (&acc)[2][2][4][2], const Unit& u, int wr, int wc, int fr, int fq) const {
        const int row0 = u.pm * BM + wr * 64 + fr, col0 = (u.pn & 3) * BM + wc * 32 + 4 * fq; const int kq = u.ko / 1792;
#pragma unroll
        for (int ai = 0; ai < 2; ++ai)
#pragma unroll
            for (int m = 0; m < 4; ++m) { const int row = row0 + ai * HALF + m * 16; const float gtv = gate[row]; float* rowp = YT + ((size_t)kq * 2048 + (row - row_base)) * 1024 + col0;
#pragma unroll
                for (int bj = 0; bj < 2; ++bj)
#pragma unroll
                    for (int n = 0; n < 2; ++n) *(f32x4*)(rowp + bj * HALF + n * 16) = acc[ai][bj][m][n] * gtv; }
    }
};
template <class Epi, class Sched, bool ALIGN_EPI = false, bool SP2 = false>
__device__ __forceinline__ void gemm_phase(PG8_LAS unsigned char* lds, const Gemm g, const Sched& S, const Epi& E, const bool skip_epi = false) {
    const int tid = tid_here(), wid = __builtin_amdgcn_readfirstlane(tid >> 6), lane = tid & 63, wr = wid >> 2, wc = wid & 3, fr = lane & 15, fq = lane >> 4;
    const int K = g.ld, nt = g.K / BK;
    unsigned voffA[2], voffB[2];
#pragma unroll
    for (int i = 0; i < 2; ++i) { int R, C; stage_rc(tid * 16 + i * 8192, R, C); const int Rb = Epi::PERM ? ((R & ~31) + perm32(R & 31)) : R;
        voffA[i] = (unsigned)(R * K + C) * 2u; voffB[i] = (unsigned)(Rb * K + C) * 2u; }
    const size_t kstep = (size_t)(BK * 2);
    const size_t hstep = (size_t)HALF * K * 2;
    const size_t tstep = 2 * hstep;
    const unsigned ldsw = (unsigned)wid * 1024u;
    const int aoff = lds_byte(wr * 64 + fr, fq * 8), boff = lds_byte(wc * 32 + fr, fq * 8);
#define PG8_SA(b, h) (((b) * 2 + (h)) * HTB)
#define PG8_SB(b, h) ((4 + (b) * 2 + (h)) * HTB)
#define PG8_STAGE(bufoff, gbase, voff) do { _Pragma("unroll") for (int _i = 0; _i < 2; ++_i) \
        __builtin_amdgcn_global_load_lds((const unsigned*)((const char*)(gbase) + (voff)[_i]), (PG8_LAS unsigned*)(lds + (bufoff) + ldsw + _i * 8192), 16, 0, 0); } while (0)
#define PG8_LDA(dst, b, h) do { _Pragma("unroll") for (int m = 0; m < 4; ++m) _Pragma("unroll") for (int k = 0; k < 2; ++k) dst[m][k] = *(const PG8_LAS bf16x8*)(lds + PG8_SA(b, h) + aoff + m * 2048 + k * 1024); } while (0)
#define PG8_LDB(dst, b, h) do { _Pragma("unroll") for (int n = 0; n < 2; ++n) _Pragma("unroll") for (int k = 0; k < 2; ++k) dst[n][k] = *(const PG8_LAS bf16x8*)(lds + PG8_SB(b, h) + boff + n * 2048 + k * 1024); } while (0)
#define PG8_MMA(ai, bj, At, Bt) do { __builtin_amdgcn_s_setprio(1); _Pragma("unroll") for (int m = 0; m < 4; ++m) _Pragma("unroll") for (int n = 0; n < 2; ++n) _Pragma("unroll") for (int k = 0; k < 2; ++k) \
        acc[ai][bj][m][n] = __builtin_amdgcn_mfma_f32_16x16x32_bf16(Bt[n][k], At[m][k], acc[ai][bj][m][n], 0, 0, 0); __builtin_amdgcn_s_setprio(0); } while (0)
#define PG8_WAIT_V(n) asm volatile("s_waitcnt vmcnt(" #n ")" ::: "memory")
#define PG8_WAIT_L(n) asm volatile("s_waitcnt lgkmcnt(" #n ")" ::: "memory")
#define PG8_BAR __builtin_amdgcn_s_barrier()
#define PG8_SCHED __builtin_amdgcn_sched_barrier(0)
    Unit cur, nxt; int ui = 0;
    if (!S.next(0, cur)) return;
    f32x4 acc[2][2][4][2];
#pragma unroll
    for (int a = 0; a < 2; ++a)
#pragma unroll
        for (int b = 0; b < 2; ++b)
#pragma unroll
            for (int m = 0; m < 4; ++m)
#pragma unroll
                for (int n = 0; n < 2; ++n) acc[a][b][m][n] = (f32x4){0.f, 0.f, 0.f, 0.f};
    bf16x8 At[4][2], B0[2][2], B1[2][2];
    const char* cA = (const char*)g.A + (size_t)cur.pm * tstep + cur.ko; const char* cB = (const char*)g.Bt + (size_t)cur.pn * tstep + cur.ko;
    S.a_ready(cur);
    if constexpr (SP2) {
        PG8_STAGE(PG8_SB(0, 0), cB, voffB); PG8_STAGE(PG8_SB(0, 1), cB + hstep, voffB); PG8_STAGE(PG8_SA(0, 0), cA, voffA); PG8_STAGE(PG8_SA(0, 1), cA + hstep, voffA);
        if (wr == 1) PG8_BAR;
        PG8_WAIT_V(2); PG8_BAR;
        PG8_STAGE(PG8_SB(1, 0), cB + kstep, voffB); PG8_STAGE(PG8_SA(1, 0), cA + kstep, voffA); PG8_STAGE(PG8_SB(1, 1), cB + hstep + kstep, voffB);
        PG8_WAIT_V(6); PG8_BAR;
    } else {
        PG8_STAGE(PG8_SB(0, 0), cB, voffB); PG8_STAGE(PG8_SA(0, 0), cA, voffA); PG8_STAGE(PG8_SB(0, 1), cB + hstep, voffB); PG8_STAGE(PG8_SA(0, 1), cA + hstep, voffA);
        if (wr == 1) PG8_BAR;
        PG8_WAIT_V(4); PG8_BAR;
        PG8_STAGE(PG8_SB(1, 0), cB + kstep, voffB); PG8_STAGE(PG8_SA(1, 0), cA + kstep, voffA); PG8_STAGE(PG8_SB(1, 1), cB + hstep + kstep, voffB);
        PG8_WAIT_V(6); PG8_BAR;
    }
    for (;;) {
        const bool has_next = S.next(ui + 1, nxt);
        const char* nA = has_next ? (const char*)g.A + (size_t)nxt.pm * tstep + nxt.ko : cA; const char* nB = has_next ? (const char*)g.Bt + (size_t)nxt.pn * tstep + nxt.ko : cB;
        for (int t = 0; t < nt; t += 2) {
            const bool last = (t == nt - 2);
            const char* a1 = cA + (size_t)(t + 1) * kstep;
            const char* a2 = last ? nA : cA + (size_t)(t + 2) * kstep; const char* b2 = last ? nB : cB + (size_t)(t + 2) * kstep;
            const char* a3 = a2 + kstep; const char* b3 = b2 + kstep;
            if (last && has_next) S.a_ready(nxt);
            if constexpr (SP2) {
            PG8_LDB(B0, 0, 0); PG8_LDB(B1, 0, 1); PG8_SCHED; PG8_LDA(At, 0, 0); PG8_STAGE(PG8_SA(1, 1), a1 + hstep, voffA);
            PG8_WAIT_V(8); PG8_WAIT_L(0); PG8_BAR; PG8_MMA(0, 0, At, B0); PG8_MMA(0, 1, At, B1); PG8_BAR; PG8_SCHED;
            PG8_LDA(At, 0, 1); PG8_STAGE(PG8_SB(0, 0), b2, voffB); PG8_STAGE(PG8_SB(0, 1), b2 + hstep, voffB); PG8_STAGE(PG8_SA(0, 0), a2, voffA);
            PG8_WAIT_V(8); PG8_WAIT_L(0); PG8_BAR; PG8_MMA(1, 0, At, B0); PG8_MMA(1, 1, At, B1); PG8_BAR; PG8_SCHED;
            PG8_LDB(B0, 1, 0); PG8_LDB(B1, 1, 1); PG8_SCHED; PG8_LDA(At, 1, 0); PG8_STAGE(PG8_SA(0, 1), a2 + hstep, voffA);
            PG8_WAIT_V(8); PG8_WAIT_L(0); PG8_BAR; PG8_MMA(0, 0, At, B0); PG8_MMA(0, 1, At, B1); PG8_BAR; PG8_SCHED;
            PG8_LDA(At, 1, 1); PG8_STAGE(PG8_SB(1, 0), b3, voffB); PG8_STAGE(PG8_SB(1, 1), b3 + hstep, voffB); PG8_STAGE(PG8_SA(1, 0), a3, voffA);
            PG8_WAIT_V(8); PG8_WAIT_L(0); PG8_BAR; PG8_MMA(1, 0, At, B0); PG8_MMA(1, 1, At, B1); PG8_BAR; PG8_SCHED;
            } else {
            PG8_LDB(B0, 0, 0); PG8_SCHED; PG8_LDA(At, 0, 0); PG8_STAGE(PG8_SA(1, 1), a1 + hstep, voffA);
            PG8_WAIT_L(8); PG8_BAR; PG8_WAIT_L(0); PG8_MMA(0, 0, At, B0); PG8_BAR; PG8_SCHED;
            PG8_LDB(B1, 0, 1); PG8_STAGE(PG8_SB(0, 0), b2, voffB);
            PG8_BAR; PG8_WAIT_L(0); PG8_MMA(0, 1, At, B1); PG8_BAR;
            PG8_LDA(At, 0, 1); PG8_STAGE(PG8_SA(0, 0), a2, voffA);
            PG8_BAR; PG8_WAIT_L(0); PG8_MMA(1, 0, At, B0); PG8_BAR; PG8_SCHED;
            PG8_STAGE(PG8_SB(0, 1), b2 + hstep, voffB);
            PG8_WAIT_V(6); PG8_BAR; PG8_MMA(1, 1, At, B1); PG8_BAR;
            PG8_LDB(B0, 1, 0); PG8_SCHED; PG8_LDA(At, 1, 0); PG8_STAGE(PG8_SA(0, 1), a2 + hstep, voffA);
            PG8_WAIT_L(8); PG8_BAR; PG8_WAIT_L(0); PG8_MMA(0, 0, At, B0); PG8_BAR; PG8_SCHED;
            PG8_LDB(B1, 1, 1); PG8_STAGE(PG8_SB(1, 0), b3, voffB);
            PG8_BAR; PG8_WAIT_L(0); PG8_MMA(0, 1, At, B1); PG8_BAR;
            PG8_LDA(At, 1, 1); PG8_STAGE(PG8_SA(1, 0), a3, voffA);
            PG8_BAR; PG8_WAIT_L(0); PG8_MMA(1, 0, At, B0); PG8_BAR; PG8_SCHED;
            PG8_STAGE(PG8_SB(1, 1), b3 + hstep, voffB);
            PG8_WAIT_V(6); PG8_BAR; PG8_MMA(1, 1, At, B1); PG8_BAR;
            }
        }
        if constexpr (ALIGN_EPI) { if (wr == 0) PG8_BAR; }
        if constexpr (!Epi::AFTER_DRAIN) { if (!skip_epi) E(acc, cur, wr, wc, fr, fq); S.done(cur); }
        if (!has_next) break;
#pragma unroll
        for (int a = 0; a < 2; ++a)
#pragma unroll
            for (int b = 0; b < 2; ++b)
#pragma unroll
                for (int m = 0; m < 4; ++m)
#pragma unroll
                    for (int n = 0; n < 2; ++n) acc[a][b][m][n] = (f32x4){0.f, 0.f, 0.f, 0.f};
        cur = nxt; cA = nA; cB = nB; ++ui;
        if constexpr (ALIGN_EPI) { if (wr == 1) PG8_BAR; }
    }
    PG8_WAIT_V(0);
    if constexpr (!ALIGN_EPI) { if (wr == 0) PG8_BAR; }
    PG8_BAR;
#undef PG8_SA
#undef PG8_SB
#undef PG8_STAGE
#undef PG8_LDA
#undef PG8_LDB
#undef PG8_MMA
#undef PG8_WAIT_V
#undef PG8_WAIT_L
#undef PG8_BAR
#undef PG8_SCHED
}
}

constexpr int NWAVES = 8, NTHR = NWAVES * 64;
constexpr int NB = 8, SEQ = 2048, D = 1024, M = NB * SEQ;
constexpr int INC = 3088;
constexpr int NU = 3072;
constexpr int UQ = 0, UK = 256, UV = 512, UGQ = 768, UGK = 1024, UGV = 1280, UGR = 1792, UCI = 2304, UCB = 2560, UCC = 2816;
constexpr int FF = 2816, FE = 3584, NE = 8;
constexpr int MAXPAN = 136, MAXROWS = MAXPAN * 256;
constexpr float LOG2E = 1.4426950408889634f;
constexpr float QS_ATT = 0.125f * LOG2E;

constexpr size_t MiB = 1u << 20;
constexpr size_t WS_CTL = 0, CTL_ZERO_BYTES = 1 * MiB;
constexpr size_t WS_SS = 1 * MiB;
constexpr size_t WS_BL = 2 * MiB;
constexpr size_t WS_DEC = 2 * MiB + 64 * 1024;
constexpr size_t WS_TOPI = 3 * MiB;
constexpr size_t WS_TOPW = 3 * MiB + 128 * 1024;
constexpr size_t WS_POS = 3 * MiB + 256 * 1024;
constexpr size_t WS_RS3 = 3 * MiB + 384 * 1024;
constexpr size_t WS_CNT = 3 * MiB + 448 * 1024;
constexpr size_t WS_PANE = 3 * MiB + 456 * 1024;
constexpr size_t WS_ROWGATE = 4 * MiB;
constexpr size_t WS_ROWRS = 4 * MiB + 256 * 1024;
constexpr size_t WS_WE13 = 8 * MiB;
constexpr size_t WS_Y = WS_WE13;
constexpr size_t WS_YT = WS_WE13 + 68 * MiB;
constexpr size_t WS_XS = 120 * MiB;
constexpr size_t WS_WE2 = WS_XS;
constexpr size_t WS_HE = 188 * MiB;
constexpr size_t WS_WIN = WS_HE;
constexpr size_t WS_WGLR = WS_HE + 12 * MiB;
constexpr size_t WS_LA = WS_HE + 34 * MiB;
constexpr size_t WS_WOUT = WS_HE + 13 * MiB;
constexpr size_t WS_W13 = WS_HE + 17 * MiB;
constexpr size_t WS_W2 = WS_HE + 28 * MiB;
constexpr size_t WS_XB = WS_HE + 238 * MiB;
constexpr size_t WS_U = WS_HE + 66 * MiB;
constexpr size_t WS_H = WS_U;
constexpr size_t WS_MIX = WS_HE + 170 * MiB;
constexpr size_t WS_CST = WS_HE + 202 * MiB;
constexpr size_t WS_END = WS_HE + 270 * MiB;
static_assert(WS_CST + 32 * MiB <= WS_END, "ws map");
constexpr int CW_BAR = 4096;
constexpr int CW_SC = 32768;
constexpr int CW_TMO2 = 65536;
constexpr int CW_W2Q = 65600;

constexpr int LDS_BYTES = 147456;
constexpr int LDSCTL_OFF = 131072 + 14 * 1024, MISC_OFF = LDSCTL_OFF + 320;

#define GAS __attribute__((address_space(1)))
#define LAS __attribute__((address_space(3)))
typedef unsigned short bf16;
typedef float f32x4 __attribute__((ext_vector_type(4)));
typedef unsigned v4u __attribute__((ext_vector_type(4)));
__device__ __forceinline__ unsigned f2bf(float f) { unsigned u = __builtin_bit_cast(unsigned, f); return (u + 0x7fffu + ((u >> 16) & 1u)) >> 16; }
__device__ __forceinline__ unsigned pk2(float lo, float hi) { return pg8::cvt_pk_bf16(lo, hi); }
__device__ __forceinline__ float bf2f(unsigned short b) { return __builtin_bit_cast(float, (unsigned)b << 16); }
__device__ __forceinline__ float bflo(unsigned w) { return __builtin_bit_cast(float, w << 16); }
__device__ __forceinline__ float bfhi(unsigned w) { return __builtin_bit_cast(float, w & 0xffff0000u); }
__device__ __forceinline__ float wave_sum(float v) {
#pragma unroll
    for (int o = 1; o < 64; o <<= 1) v += __shfl_xor(v, o);
    return v;
}
__device__ __forceinline__ float wave_max(float v) {
#pragma unroll
    for (int o = 1; o < 64; o <<= 1) v = fmaxf(v, __shfl_xor(v, o));
    return v;
}

#define XB_TMO      128
#define XB_XCNT(j)  (256  + 64 * (j))
#define XB_XSUB(j)  (1280 + 64 * (j))
#define XB_XGEN(j)  (2304 + 64 * (j))
#define XB_TOP      3328
#define XB_TOPGEN   3392
#define XCD_BAR_WORDS 3456
#define XB_SPIN_CAP (1u << 18)
__device__ __forceinline__ unsigned xb_ld(unsigned* p)              { return __hip_atomic_load(p, __ATOMIC_RELAXED, __HIP_MEMORY_SCOPE_AGENT); }
__device__ __forceinline__ unsigned xb_add(unsigned* p, unsigned v) { return __hip_atomic_fetch_add(p, v, __ATOMIC_RELAXED, __HIP_MEMORY_SCOPE_AGENT); }
__device__ __forceinline__ unsigned xb_xcc_id() { return (unsigned)__builtin_amdgcn_s_getreg((3 << 11) | 20) & 0xFu; }
#define XB_SPIN(cond, bar) do { unsigned _sp = 0; while (cond) { __builtin_amdgcn_s_sleep(1); \
    if ((++_sp & 255u) == 0u) { if (xb_ld(&(bar)[XB_TMO])) break; if (_sp > XB_SPIN_CAP) { atomicAdd(&(bar)[XB_TMO], 1u); break; } } } } while (0)
struct XcdBarrier { unsigned* bar; unsigned x; volatile LAS unsigned* st; };
__device__ __forceinline__ XcdBarrier xcd_barrier_post(unsigned* bar, volatile LAS unsigned* st) {
    XcdBarrier b; b.bar = bar; b.x = xb_xcc_id(); b.st = st;
    if (threadIdx.x == 0) (void)xb_add(&bar[XB_XCNT(b.x)], 1u);
    return b;
}
__device__ __forceinline__ void xcd_barrier_complete(unsigned* bar, unsigned x, unsigned& nloc, unsigned& nx) {
    const unsigned G = gridDim.x * gridDim.y * gridDim.z;
    unsigned sum, cnt, mine, sp = 0u;
    for (;;) {
        sum = 0u; cnt = 0u; mine = 0u;
#pragma unroll
        for (unsigned j = 0; j < 16; ++j) { const unsigned c = xb_ld(&bar[XB_XCNT(j)]); sum += c; cnt += (c > 0u) ? 1u : 0u; mine = (j == x) ? c : mine; }
        if (sum == G) break;
        __builtin_amdgcn_s_sleep(1);
        if ((++sp & 255u) == 0u) { if (xb_ld(&bar[XB_TMO])) break; if (sp > XB_SPIN_CAP) { atomicAdd(&bar[XB_TMO], 1u); break; } }
    }
    nloc = mine > 0u ? mine : 1u; nx = cnt > 0u ? cnt : 1u;
}
__device__ __forceinline__ void xcd_barrier(const XcdBarrier& b) {
    asm volatile("s_waitcnt vmcnt(0)" ::: "memory");
    __syncthreads();
    if (threadIdx.x == 0) {
        unsigned* bar = b.bar;
        __builtin_amdgcn_s_waitcnt(0);
        unsigned nloc = b.st[0], nx = b.st[1];
        if (nloc == 0u) { xcd_barrier_complete(bar, b.x, nloc, nx); b.st[0] = nloc; b.st[1] = nx; }
        const unsigned old = xb_add(&bar[XB_XSUB(b.x)], 1u);
        const unsigned gen = old / nloc;
        if (old + 1u == (gen + 1u) * nloc) {
            __builtin_amdgcn_fence(__ATOMIC_RELEASE, "agent");
            asm volatile("s_waitcnt vmcnt(0)" ::: "memory");
            const unsigned og = xb_add(&bar[XB_TOP], 1u);
            const unsigned tg = og / nx;
            if (og + 1u == (tg + 1u) * nx) xb_add(&bar[XB_TOPGEN], 1u);
            else XB_SPIN(xb_ld(&bar[XB_TOPGEN]) == tg, bar);
            __builtin_amdgcn_fence(__ATOMIC_ACQUIRE, "agent");
            xb_add(&bar[XB_XGEN(b.x)], 1u);
            asm volatile("s_waitcnt vmcnt(0)" ::: "memory");
        } else {
            XB_SPIN(xb_ld(&bar[XB_XGEN(b.x)]) == gen, bar);
            __builtin_amdgcn_fence(__ATOMIC_ACQUIRE, "agent");
            asm volatile("s_waitcnt vmcnt(0)" ::: "memory");
        }
    }
    __syncthreads();
}

struct Args {
    const float* x; const float* w_mix_in; const float* w_mix_out; const float* g_mix; const float* rel_bias; const float* gla_w_gate; const float* gla_b_gate;
    const float* gla_g_norm; const float* conv_w; const float* g_ffn; const float* ffn_w1; const float* ffn_w3; const float* ffn_w2; const float* moe_router;
    const float* moe_w1; const float* moe_w3; const float* moe_w2; const float* g_final;
    float* out; unsigned char* ws; int ph_lo, ph_hi, li, pad;
};

__device__ __forceinline__ void transpose_tile(const float* src, int ldsrc, int k0, int n0, bf16* dst, int ldd, int drow0, const float* ksc, unsigned* scr, int lane) {
    const int nq = lane & 15, kk = lane >> 4;
#pragma unroll
    for (int i = 0; i < 8; ++i) { const int k = 8 * i + 2 * kk; const float* p = src + (size_t)(k0 + k) * ldsrc + n0 + 4 * nq;
        const f32x4 r0 = *(const f32x4*)p, r1 = *(const f32x4*)(p + ldsrc);
        const float s0 = ksc ? ksc[k0 + k] : 1.f, s1 = ksc ? ksc[k0 + k + 1] : 1.f;
#pragma unroll
        for (int j = 0; j < 4; ++j) scr[(4 * nq + j) * 33 + 4 * i + kk] = pk2(r0[j] * s0, r1[j] * s1); }
    asm volatile("s_waitcnt lgkmcnt(0)" ::: "memory");
#pragma unroll 8
    for (int i2 = 0; i2 < 32; ++i2) { const int n = 2 * i2 + (lane >> 5), d = lane & 31;
        ((unsigned*)(dst + (size_t)(drow0 + n) * ldd + k0))[d] = scr[n * 33 + d]; }
    asm volatile("s_waitcnt lgkmcnt(0)" ::: "memory");
}
__device__ __forceinline__ void glr_tile(const float* win, const float* wg, const float* g, int k0, int n0, bf16* dst, int drow0, int lane) {
    float w[16];
#pragma unroll
    for (int r = 0; r < 16; ++r) w[r] = wg[r * 256 + n0 + lane];
    unsigned* drow = (unsigned*)(dst + (size_t)(drow0 + n0 + lane) * 1024 + k0);
    for (int kp = 0; kp < 32; ++kp) { float v[2];
#pragma unroll
        for (int q = 0; q < 2; ++q) { const int k = k0 + 2 * kp + q; const float* s = win + (size_t)k * INC + 2304; float a = 0.f;
#pragma unroll
            for (int r = 0; r < 16; ++r) a += s[r] * w[r];
            v[q] = a * g[k]; }
        drow[kp] = pk2(v[0], v[1]); }
}
__device__ __forceinline__ int rel_bucket(int d) {
    if (d < 16) return d;
    const float lr = logf((float)d / 16.0f) / logf(128.0f);
    int b = 16 + (int)(lr * 16.0f); return b < 31 ? b : 31;
}


typedef short bf16x8 __attribute__((ext_vector_type(8)));
typedef short v4i16_t __attribute__((ext_vector_type(4)));
#define MFMA16(a, b, c) __builtin_amdgcn_mfma_f32_16x16x32_bf16((a), (b), (c), 0, 0, 0)
__device__ __forceinline__ v4i16_t tr16(LAS unsigned char* p) { return __builtin_amdgcn_ds_read_tr16_b64_v4i16((LAS v4i16_t*)p); }
__device__ __forceinline__ bf16x8 cat8(v4i16_t lo, v4i16_t hi) { return __builtin_shufflevector(lo, hi, 0, 1, 2, 3, 4, 5, 6, 7); }
__device__ __forceinline__ bf16x8 frag_rm(LAS unsigned char* base, int pitch, int c0, int k0, int lane) { return *(LAS bf16x8*)(base + (c0 + (lane & 15)) * pitch + (k0 + 8 * (lane >> 4)) * 2); }
__device__ __forceinline__ bf16x8 frag_tr(LAS unsigned char* base, int pitch, int c0, int k0, int lane) {
    const int i = lane & 15, g = lane >> 4; LAS unsigned char* p = base + (k0 + 8 * g + (i >> 2)) * pitch + (c0 + 4 * (i & 3)) * 2;
    return cat8(tr16(p), tr16(p + 4 * pitch)); }
__device__ __forceinline__ bf16x8 frag_trp(LAS unsigned char* base, int pitch, int c0, int k0, int lane) {
    const int i = lane & 15, g = lane >> 4; LAS unsigned char* p = base + (k0 + 4 * g + (i >> 2)) * pitch + (c0 + 4 * (i & 3)) * 2;
    return cat8(tr16(p), tr16(p + 16 * pitch)); }
__device__ __forceinline__ bf16x8 pack8(const f32x4& a, const f32x4& b) {
    v4u w; w.x = pg8::cvt_pk_bf16(a[0], a[1]); w.y = pg8::cvt_pk_bf16(a[2], a[3]); w.z = pg8::cvt_pk_bf16(b[0], b[1]); w.w = pg8::cvt_pk_bf16(b[2], b[3]); return __builtin_bit_cast(bf16x8, w); }

struct Ctx { Args args; int tid, lane, wave, G, bx, gw, NGW, lo, hi; XcdBarrier bar; };
#define GRID_BAR() do { if (MK_N_LAUNCHES == 1) xcd_barrier(bar); } while (0)
#define IN(k) (lo <= (k) && (k) < hi)
#define SEAM(k) do { if (IN(k) && IN((k) + 1)) GRID_BAR(); } while (0)
#define WS_PTRS \
    float* SS = (float*)(ws + WS_SS); float* BL = (float*)(ws + WS_BL); float* DEC = (float*)(ws + WS_DEC); \
    bf16* XB = (bf16*)(ws + WS_XB); bf16* U = (bf16*)(ws + WS_U); bf16* MIX = (bf16*)(ws + WS_MIX); float* CST = (float*)(ws + WS_CST); \
    bf16* H = (bf16*)(ws + WS_H); bf16* W13 = (bf16*)(ws + WS_W13); bf16* W2 = (bf16*)(ws + WS_W2); \
    bf16* WE13 = (bf16*)(ws + WS_WE13); bf16* WE2 = (bf16*)args.out;     bf16* XS = (bf16*)(ws + WS_XS); bf16* HE = (bf16*)(ws + WS_HE); bf16* Y = (bf16*)(ws + WS_Y); \
    int* TOPI = (int*)(ws + WS_TOPI); float* TOPW = (float*)(ws + WS_TOPW); int* POS = (int*)(ws + WS_POS); float* RS3 = (float*)(ws + WS_RS3); \
    int* CNT = (int*)(ws + WS_CNT); int* PANE = (int*)(ws + WS_PANE); float* ROWGATE = (float*)(ws + WS_ROWGATE); float* ROWRS = (float*)(ws + WS_ROWRS); \
    float* X = args.out; \
    (void)SS; (void)BL; (void)DEC; (void)XB; (void)U; (void)MIX; (void)CST; (void)H; (void)W13; (void)W2; (void)WE13; (void)WE2; (void)XS; (void)HE; (void)Y; \
    (void)TOPI; (void)TOPW; (void)POS; (void)RS3; (void)CNT; (void)PANE; (void)ROWGATE; (void)ROWRS; (void)X;

template <int layer> __device__ __forceinline__ void layer_phases(const Ctx& c, unsigned char* lds) {
    const Args& args = c.args; LAS unsigned char* ldsl = (LAS unsigned char*)lds;
    const int tid = c.tid, lane = c.lane, wave = c.wave, G = c.G, bx = c.bx, gw = c.gw, NGW = c.NGW, lo = c.lo, hi = c.hi; const XcdBarrier bar = c.bar;
    unsigned char* ws = args.ws;
    WS_PTRS
    (void)tid; (void)lane; (void)wave; (void)gw; (void)NGW;
#if defined(PROBE_PHASE) || defined(PROBE_REP)
    const int pad_ = args.pad;
#else
    constexpr int pad_ = 0;
#endif
    const int pmode = pad_ >> 4; (void)pmode;
    const bool dry = (pad_ & 1) != 0, noepi = (pad_ & 2) != 0;
    bf16* XBD = dry ? (bf16*)(ws + WS_XS) : XB; float* SSD = dry ? (float*)(ws + WS_XS) : SS; (void)XBD; (void)SSD;
        const int pb = 1 + 16 * layer;
        if (IN(pb + 0)) {
            pg8::Gemm g{XB, (const bf16*)(ws + WS_WIN) + (size_t)layer * NU * D, M, NU, D, D}; pg8::StaticOrder S; S.init(M, NU, G, bx);
            pg8::EpiU E{U, NU, SS, QS_ATT};
            pg8::gemm_phase<pg8::EpiU, pg8::StaticOrder, true, true>(ldsl, g, S, E, noepi);
            { const bf16* wg = (const bf16*)(ws + WS_WGLR) + (size_t)layer * 16 * D; float* LA = (float*)(ws + WS_LA); f32x4* xch = (f32x4*)lds; float* glrl = (float*)(lds + 4096);
              const int tid = pg8::tid_here(), lane = tid & 63;
              float wgc[16]; { const float* wgp = args.gla_w_gate + layer * 16 * 256 + (tid & 255);
#pragma unroll
                for (int r = 0; r < 16; ++r) wgc[r] = wgp[r * 256]; }
              const float bgv = args.gla_b_gate[layer * 256 + (tid & 255)];
              for (int blk = bx; blk < 256; blk += G) {
                  const int rt = wave & 3, kh = wave >> 2, ql = lane & 15, g4 = lane >> 4;
                  const bf16* ap = XB + (size_t)(blk * 64 + rt * 16 + ql) * D + kh * 512 + 8 * g4; const bf16* bp = wg + (size_t)ql * D + kh * 512 + 8 * g4;
                  f32x4 acc = (f32x4){0.f, 0.f, 0.f, 0.f};
#pragma unroll
                  for (int ks = 0; ks < 16; ++ks) acc = MFMA16(*(const bf16x8*)(ap + 32 * ks), *(const bf16x8*)(bp + 32 * ks), acc);
                  if (kh == 1) xch[rt * 64 + lane] = acc;
                  __syncthreads();
                  if (kh == 0) { acc += xch[rt * 64 + lane];
#pragma unroll
                      for (int rg = 0; rg < 4; ++rg) { const int rl = rt * 16 + 4 * g4 + rg; glrl[rl * 16 + ql] = acc[rg] * pg8::rstd_of(SS + (size_t)(blk * 64 + rl) * 16); } }
                  __syncthreads();
                  { const int c = tid & 255, r0 = (tid >> 8) * 32;
#pragma unroll 4
                    for (int i = 0; i < 32; ++i) { const f32x4* gp = (const f32x4*)(glrl + (r0 + i) * 16); float z = bgv;
#pragma unroll
                        for (int q4 = 0; q4 < 4; ++q4) { const f32x4 gv = gp[q4]; z += gv[0] * wgc[4 * q4] + gv[1] * wgc[4 * q4 + 1] + gv[2] * wgc[4 * q4 + 2] + gv[3] * wgc[4 * q4 + 3]; }
                        LA[(size_t)(blk * 64 + r0 + i) * 256 + c] = pg8::logsig16(z); } }
                  __syncthreads();
              } }
        }
        SEAM(pb + 0);
        if (IN(pb + 1)) {
            const int tid = pg8::tid_here(), lane = tid & 63; (void)lane;
            float* cum = (float*)lds; float* seg = cum + 4096;
            LAS unsigned char* kdl = ldsl + 18432;
            LAS unsigned char* vvl = ldsl + 27648;
            for (int u = bx; u < 1024; u += G) {
                const int h = u & 3, n = (u >> 2) & 31, b = u >> 7; const size_t row0 = (size_t)b * SEQ + n * 64;
                const int tr = tid >> 3, c8 = tid & 7;
                const v4u kraw = *(const v4u*)(U + (row0 + tr) * NU + UGK + h * 64 + 8 * c8);
                const v4u* vp = (const v4u*)(U + (row0 + tr) * NU + UGV + h * 128 + c8 * 16); const v4u x0 = vp[0], x1 = vp[1];
                { float c = 0.f; float lav[8]; const float* lap = (const float*)(ws + WS_LA) + (row0 + 8 * wave) * 256 + h * 64 + lane;
#pragma unroll
                  for (int i = 0; i < 8; ++i) lav[i] = lap[i * 256];
#pragma unroll
                  for (int i = 0; i < 8; ++i) { c += lav[i]; cum[(8 * wave + i) * 64 + lane] = c; }
                  seg[wave * 64 + lane] = c; }
                __syncthreads();
                { f32x4 offa = (f32x4){0.f, 0.f, 0.f, 0.f}, offb = offa, lasta = offa, lastb = offa; const int wq = tr >> 3;
#pragma unroll
                  for (int w = 0; w < 8; ++w) { const f32x4 sa = *(const f32x4*)(seg + w * 64 + 8 * c8), sb = *(const f32x4*)(seg + w * 64 + 8 * c8 + 4); lasta += sa; lastb += sb; if (w < wq) { offa += sa; offb += sb; } }
                  const f32x4 ca = *(const f32x4*)(cum + tr * 64 + 8 * c8) + offa, cb = *(const f32x4*)(cum + tr * 64 + 8 * c8 + 4) + offb;
                  v4u w; w.x = pk2(bflo(kraw.x) * __expf(lasta[0] - ca[0]), bfhi(kraw.x) * __expf(lasta[1] - ca[1])); w.y = pk2(bflo(kraw.y) * __expf(lasta[2] - ca[2]), bfhi(kraw.y) * __expf(lasta[3] - ca[3]));
                  w.z = pk2(bflo(kraw.z) * __expf(lastb[0] - cb[0]), bfhi(kraw.z) * __expf(lastb[1] - cb[1])); w.w = pk2(bflo(kraw.w) * __expf(lastb[2] - cb[2]), bfhi(kraw.w) * __expf(lastb[3] - cb[3]));
                  *(LAS v4u*)(kdl + tr * 144 + c8 * 16) = w;
                  if (tr == 0) {
#pragma unroll
                      for (int j = 0; j < 4; ++j) { __hip_atomic_store(DEC + u * 64 + 8 * c8 + j, __expf(lasta[j]), __ATOMIC_RELAXED, __HIP_MEMORY_SCOPE_AGENT); __hip_atomic_store(DEC + u * 64 + 8 * c8 + 4 + j, __expf(lastb[j]), __ATOMIC_RELAXED, __HIP_MEMORY_SCOPE_AGENT); } }
                  LAS v4u* vd = (LAS v4u*)(vvl + tr * 272 + c8 * 32); vd[0] = x0; vd[1] = x1; }
                __syncthreads();
                { f32x4 acc[4];
#pragma unroll
                  for (int kt = 0; kt < 4; ++kt) acc[kt] = (f32x4){0.f, 0.f, 0.f, 0.f};
#pragma unroll
                  for (int ks = 0; ks < 2; ++ks) { const bf16x8 bv = frag_tr(vvl, 272, 16 * wave, 32 * ks, lane);
#pragma unroll
                      for (int kt = 0; kt < 4; ++kt) { const bf16x8 ak = frag_tr(kdl, 144, 16 * kt, 32 * ks, lane); acc[kt] = MFMA16(ak, bv, acc[kt]); } }
                  const int g4 = lane >> 4, ql = lane & 15;
                  const __amdgpu_buffer_rsrc_t rsrc = __builtin_amdgcn_make_buffer_rsrc((void*)CST, 0, 32 * 1024 * 1024, 0x00020000);
#pragma unroll
                  for (int kt = 0; kt < 4; ++kt)
                      __builtin_amdgcn_raw_buffer_store_b128(__builtin_bit_cast(v4u, acc[kt]), rsrc, (int)((((unsigned)u * 128u + 16u * wave + ql) * 64u + 16u * kt + 4u * g4) * 4u), 0, 16); }
                asm volatile("s_waitcnt vmcnt(0)" ::: "memory");
                __syncthreads();
                if (tid == 0) __hip_atomic_fetch_add((unsigned*)(ws + WS_CTL) + CW_SC + ((u >> 7) * 4 + (u & 3)) * 64, 1u, __ATOMIC_RELAXED, __HIP_MEMORY_SCOPE_AGENT);
            }
            const float* cw = args.conv_w + layer * 3 * 256;
            for (int rep_ = 0; rep_ < 1 + ((pad_ >> 10) & 1); ++rep_)
            for (int it = bx * NTHR + tid; it < M * 32; it += G * NTHR) {
                const int row = it >> 5, c0 = (it & 31) * 8, t = row & (SEQ - 1);
                const bf16* ur = U + (size_t)row * NU;
                const v4u cb = *(const v4u*)(ur + UCB + c0);
                v4u ci[3], cc[3];
#pragma unroll
                for (int d = 0; d < 3; ++d) { if (t >= d) { ci[d] = *(const v4u*)(ur - (size_t)d * NU + UCI + c0); cc[d] = *(const v4u*)(ur - (size_t)d * NU + UCC + c0); } else { ci[d] = (v4u){0u, 0u, 0u, 0u}; cc[d] = ci[d]; } }
                float o[8];
#pragma unroll
                for (int j = 0; j < 4; ++j) {
                    float a0 = 0.f, a1 = 0.f;
#pragma unroll
                    for (int d = 0; d < 3; ++d) { const float w0 = cw[(2 - d) * 256 + c0 + 2 * j], w1 = cw[(2 - d) * 256 + c0 + 2 * j + 1];
                        a0 += w0 * (bflo(cc[d][j]) * bflo(ci[d][j])); a1 += w1 * (bfhi(cc[d][j]) * bfhi(ci[d][j])); }
                    o[2 * j] = bflo(cb[j]) * a0; o[2 * j + 1] = bfhi(cb[j]) * a1; }
                v4u w; w.x = pk2(o[0], o[1]); w.y = pk2(o[2], o[3]); w.z = pk2(o[4], o[5]); w.w = pk2(o[6], o[7]);
                *(v4u*)(MIX + (size_t)row * D + 768 + c0) = w;
            }
            __syncthreads();
            {
                float* BLl = (float*)lds;
                for (int i = tid; i < 4 * 2049; i += NTHR) BLl[(i & 3) * 2049 + (i >> 2)] = BL[i];
                __syncthreads();
                LAS unsigned char* vst = ldsl + 33280 + wave * 5120;
                const int ql = lane & 15, g4 = lane >> 4;
                for (int rep_ = 0; rep_ < 1 + ((pad_ >> 11) & 1); ++rep_)
                for (int uu = bx; uu < 512; uu += G) {
                    int u = uu; if (G == 256) { const int j = (uu & 255) >> 3; u = ((((uu >> 8) * 16 + (uu & 7) * 2 + (j >> 4)) << 4) | (j & 15)); }
                    const int c = u & 15, h = (u >> 4) & 3, b = u >> 6; const int i0 = 16 * (((uu / G) & 1) ? 7 - wave : wave); const size_t rowb = (size_t)b * SEQ;
                    const int tq = c + 16 * (i0 + ql);
                    const bf16* ub = U + rowb * NU + h * 64;
                    const bf16x8 qf0 = *(const bf16x8*)(ub + (size_t)tq * NU + UQ + 8 * g4), qf1 = *(const bf16x8*)(ub + (size_t)tq * NU + UQ + 8 * g4 + 32);
                    const float* blh = BLl + h * 2049;
                    const int t0 = c + 16 * i0, t1 = t0 + 240;
                    const int base0 = ((t0 >> 4) - 128) & ~31, mhi0 = t1 >> 4, np0 = ((mhi0 - base0) >> 5) + 1, pz0 = base0 < 0 ? ((-base0) >> 5) : 0;
                    const int base1 = ((t0 >> 2) - 128) & ~31, mhi1 = t1 >> 2, np1 = ((mhi1 - base1) >> 5) + 1, pz1 = base1 < 0 ? ((-base1) >> 5) : 0;
                    const int base2 = (t0 - 128) & ~31, mhi2 = t1, np2 = ((mhi2 - base2) >> 5) + 1, pz2 = base2 < 0 ? ((-base2) >> 5) : 0;
                    const int n0 = np0 - pz0, n1 = np1 - pz1, n2 = np2 - pz2, NT = n0 + n1 + n2;
                    bf16x8 ka[2][2], kb[2][2]; v4u va_[4], vb_[4];
                    const unsigned char* ubb = (const unsigned char*)ub;
                    const unsigned koff = (unsigned)(UK + 8 * g4) * 2u, voff = (unsigned)(UV + 8 * (lane & 7)) * 2u; const int vrow = lane >> 3;
#define ATT_ITEM(it, LR, MB, MHI, RHO) do { if ((it) < n0) { LR = 4; MB = base0 + 32 * (np0 - 1 - (it)); MHI = mhi0; RHO = c; } \
                        else if ((it) < n0 + n1) { LR = 2; MB = base1 + 32 * (pz1 + (it) - n0); MHI = mhi1; RHO = c & 3; } \
                        else { LR = 0; MB = base2 + 32 * (pz2 + (it) - n0 - n1); MHI = mhi2; RHO = 0; } } while (0)
#define ATT_CLAMP(x, hi) __builtin_amdgcn_med3 ## _i(x, hi)
#define ATT_LOAD(K_, V_, LR, MB, MHI, RHO) do { _Pragma("unroll") for (int tau = 0; tau < 2; ++tau) { int mk = (MB) + 16 * tau + ql; mk = max(0, min(mk, (MHI))); \
                            const unsigned char* kp = ubb + ((unsigned)((mk << (LR)) + (RHO)) * (unsigned)(NU * 2) + koff); K_[tau][0] = *(const bf16x8*)kp; K_[tau][1] = *(const bf16x8*)(kp + 64); } \
                        _Pragma("unroll") for (int j = 0; j < 4; ++j) { int mv = (MB) + vrow + 8 * j; mv = max(0, min(mv, (MHI))); \
                            V_[j] = *(const v4u*)(ubb + ((unsigned)((mv << (LR)) + (RHO)) * (unsigned)(NU * 2) + voff)); } } while (0)
#define ATT_STEP(KC_, VC_, KN_, VN_) do { \
                        int lrn = lr, mbn = mb, mhin = mhi, rhon = rho; \
                        if (it + 1 < NT) { ATT_ITEM(it + 1, lrn, mbn, mhin, rhon); ATT_LOAD(KN_, VN_, lrn, mbn, mhin, rhon); } \
                        { LAS unsigned char* vd = vst + vrow * 160 + (lane & 7) * 16; \
                          _Pragma("unroll") for (int j = 0; j < 4; ++j) *(LAS v4u*)(vd + j * 8 * 160) = VC_[j]; } \
                        f32x4 s[2]; \
                        _Pragma("unroll") for (int tau = 0; tau < 2; ++tau) { s[tau] = MFMA16(KC_[tau][0], qf0, ((f32x4){0.f, 0.f, 0.f, 0.f})); s[tau] = MFMA16(KC_[tau][1], qf1, s[tau]); } \
                        const int d0 = (tq >> lr) - mb - 4 * g4; const int kneg = -(mb + 4 * g4); float tmax = -INFINITY; float bias_[2][4]; \
                        _Pragma("unroll") for (int tau = 0; tau < 2; ++tau) \
                            _Pragma("unroll") for (int rg = 0; rg < 4; ++rg) { const int dcl = max(0, min(d0 - (16 * tau + rg), 128)); bias_[tau][rg] = blh[dcl << lr]; } \
                        asm volatile("" : "+v"(bias_[0][0]), "+v"(bias_[0][1]), "+v"(bias_[0][2]), "+v"(bias_[0][3]), "+v"(bias_[1][0]), "+v"(bias_[1][1]), "+v"(bias_[1][2]), "+v"(bias_[1][3]));   \
                        _Pragma("unroll") for (int tau = 0; tau < 2; ++tau) \
                            _Pragma("unroll") for (int rg = 0; rg < 4; ++rg) { const int dist = d0 - (16 * tau + rg); const bool ok = ((unsigned)dist <= 128u) && ((16 * tau + rg) >= kneg); \
                                const float v = ok ? s[tau][rg] + bias_[tau][rg] : -INFINITY; s[tau][rg] = v; tmax = fmaxf(tmax, v); } \
                        if (__any(tmax > m_ref + 16.0f)) { \
                            float tm = fmaxf(tmax, __shfl_xor(tmax, 16)); tm = fmaxf(tm, __shfl_xor(tm, 32)); \
                            const float mn = fmaxf(m_ref, tm); const float ms = (mn == -INFINITY) ? 0.f : mn; const float alpha = __builtin_amdgcn_exp2f(m_ref - ms); m_ref = ms; \
                            l_run *= alpha; \
                            _Pragma("unroll") for (int d = 0; d < 4; ++d) o[d] = o[d] * alpha; \
                        } \
                        float ps = 0.f; \
                        _Pragma("unroll") for (int tau = 0; tau < 2; ++tau) \
                            _Pragma("unroll") for (int rg = 0; rg < 4; ++rg) { const float p = __builtin_amdgcn_exp2f(s[tau][rg] - m_ref); s[tau][rg] = p; ps += p; } \
                        l_run += ps; \
                        const bf16x8 pb = pack8(s[0], s[1]); \
                        asm volatile("" ::: "memory"); \
                        _Pragma("unroll") for (int d = 0; d < 4; ++d) { const bf16x8 vf = frag_trp(vst, 160, 16 * d, 0, lane); o[d] = MFMA16(vf, pb, o[d]); } \
                        asm volatile("" ::: "memory"); \
                        lr = lrn; mb = mbn; mhi = mhin; rho = rhon; ++it; } while (0)
                    int lr, mb, mhi, rho; ATT_ITEM(0, lr, mb, mhi, rho); ATT_LOAD(ka, va_, lr, mb, mhi, rho);
                    float m_ref = -INFINITY, l_run = 0.f; f32x4 o[4];
#pragma unroll
                    for (int d = 0; d < 4; ++d) o[d] = (f32x4){0.f, 0.f, 0.f, 0.f};
                    for (int it = 0; it < NT;) {
                        ATT_STEP(ka, va_, kb, vb_);
                        if (it >= NT) break;
                        ATT_STEP(kb, vb_, ka, va_);
                    }
#undef ATT_ITEM
#undef ATT_LOAD
#undef ATT_STEP
#undef ATT_CLAMP
                    l_run += __shfl_xor(l_run, 16); l_run += __shfl_xor(l_run, 32); const float inv = 1.0f / l_run;
                    bf16* op = MIX + (rowb + tq) * D + h * 64 + 4 * g4;
#pragma unroll
                    for (int d = 0; d < 4; ++d) { pg8::u32x2 w; w.x = pg8::cvt_pk_bf16(o[d][0] * inv, o[d][1] * inv); w.y = pg8::cvt_pk_bf16(o[d][2] * inv, o[d][3] * inv); *(pg8::u32x2*)(op + 16 * d) = w; }
                }
            }
            for (int u = bx; u < 1024; u += G) {
                const int h = u & 3, n = (u >> 2) & 31, b = u >> 7;
                unsigned* cw = (unsigned*)(ws + WS_CTL) + CW_SC + (b * 4 + h) * 64; unsigned* tmo = (unsigned*)(ws + WS_CTL) + CW_TMO2; const unsigned need = 32u * (unsigned)(layer + 1);
                if (wave == 0) { unsigned sp = 0; while (__hip_atomic_load(cw, __ATOMIC_RELAXED, __HIP_MEMORY_SCOPE_AGENT) < need) { __builtin_amdgcn_s_sleep(2);
                        if ((++sp & 255u) == 0u) { if (__hip_atomic_load(tmo, __ATOMIC_RELAXED, __HIP_MEMORY_SCOPE_AGENT) != 0u) break; if (sp > (1u << 20)) { __hip_atomic_store(tmo, 1u, __ATOMIC_RELAXED, __HIP_MEMORY_SCOPE_AGENT); break; } } } }
                __syncthreads();
                if (tid < 256) { const int idx = n * 256 + tid; float cc[32], dd[32];
                    float* cp = CST + (size_t)(b * 128 + h) * 8192 + idx; const float* dp = DEC + (b * 128 + h) * 64 + (idx & 63);
#pragma unroll
                    for (int m2 = 0; m2 < 32; ++m2) { cc[m2] = __hip_atomic_load(cp + (size_t)m2 * 4 * 8192, __ATOMIC_RELAXED, __HIP_MEMORY_SCOPE_AGENT); dd[m2] = __hip_atomic_load(dp + m2 * 4 * 64, __ATOMIC_RELAXED, __HIP_MEMORY_SCOPE_AGENT); }
                    float S = 0.f;
#pragma unroll
                    for (int m2 = 0; m2 < 32; ++m2) { cp[(size_t)m2 * 4 * 8192] = S; S = dd[m2] * S + cc[m2]; } }
            }
        }
        SEAM(pb + 1);
        if (IN(pb + 3)) {
            const int tid = pg8::tid_here(), lane = tid & 63; (void)lane;
            float* cum = (float*)lds; float* seg = cum + 4096;
            LAS unsigned char* qel = ldsl + 18432;
            LAS unsigned char* kel = ldsl + 27648;
            LAS unsigned char* vvl = ldsl + 36864;
            LAS unsigned char* stl = ldsl + 54272;
            float* rsq = (float*)(lds + 72704);
            const float* gn = args.gla_g_norm + layer * 128;
            for (int rep_ = 0; rep_ < 1 + ((pad_ >> 8) & 1); ++rep_)
            for (int u = bx; u < 1024; u += G) {
                const int h = u & 3, n = (u >> 2) & 31, b = u >> 7; const size_t row0 = (size_t)b * SEQ + n * 64;
                const int tr = tid >> 3, c8 = tid & 7;
                const v4u qraw = *(const v4u*)(U + (row0 + tr) * NU + UGQ + h * 64 + 8 * c8), kraw = *(const v4u*)(U + (row0 + tr) * NU + UGK + h * 64 + 8 * c8);
                const v4u* vp = (const v4u*)(U + (row0 + tr) * NU + UGV + h * 128 + c8 * 16); const v4u x0 = vp[0], x1 = vp[1];
                const int sv = tid >> 2, skq = (tid & 3) * 16; const f32x4* sp = (const f32x4*)(CST + ((size_t)u * 128 + sv) * 64 + skq);
                const f32x4 a0 = sp[0], a1 = sp[1], a2 = sp[2], a3 = sp[3];
                { float c = 0.f; float lav[8]; const float* lap = (const float*)(ws + WS_LA) + (row0 + 8 * wave) * 256 + h * 64 + lane;
#pragma unroll
                  for (int i = 0; i < 8; ++i) lav[i] = lap[i * 256];
#pragma unroll
                  for (int i = 0; i < 8; ++i) { c += lav[i]; cum[(8 * wave + i) * 64 + lane] = c; }
                  seg[wave * 64 + lane] = c; }
                __syncthreads();
                { f32x4 offa = (f32x4){0.f, 0.f, 0.f, 0.f}, offb = offa; const int wq = tr >> 3;
#pragma unroll
                  for (int w = 0; w < 7; ++w) { if (w < wq) { offa += *(const f32x4*)(seg + w * 64 + 8 * c8); offb += *(const f32x4*)(seg + w * 64 + 8 * c8 + 4); } }
                  const f32x4 ca = *(const f32x4*)(cum + tr * 64 + 8 * c8) + offa, cb = *(const f32x4*)(cum + tr * 64 + 8 * c8 + 4) + offb;
                  float ea[8];
#pragma unroll
                  for (int j = 0; j < 4; ++j) { ea[j] = __expf(ca[j]); ea[4 + j] = __expf(cb[j]); }
                  v4u wq_, wk_;
                  wq_.x = pk2(bflo(qraw.x) * ea[0], bfhi(qraw.x) * ea[1]); wq_.y = pk2(bflo(qraw.y) * ea[2], bfhi(qraw.y) * ea[3]); wq_.z = pk2(bflo(qraw.z) * ea[4], bfhi(qraw.z) * ea[5]); wq_.w = pk2(bflo(qraw.w) * ea[6], bfhi(qraw.w) * ea[7]);
                  float ia[8];
#pragma unroll
                  for (int j = 0; j < 8; ++j) ia[j] = __builtin_amdgcn_rcpf(ea[j]);
                  wk_.x = pk2(bflo(kraw.x) * ia[0], bfhi(kraw.x) * ia[1]); wk_.y = pk2(bflo(kraw.y) * ia[2], bfhi(kraw.y) * ia[3]); wk_.z = pk2(bflo(kraw.z) * ia[4], bfhi(kraw.z) * ia[5]); wk_.w = pk2(bflo(kraw.w) * ia[6], bfhi(kraw.w) * ia[7]);
                  *(LAS v4u*)(qel + tr * 144 + c8 * 16) = wq_; *(LAS v4u*)(kel + tr * 144 + c8 * 16) = wk_;
                  LAS v4u* vd = (LAS v4u*)(vvl + tr * 272 + c8 * 32); vd[0] = x0; vd[1] = x1;
                  v4u w0, w1; w0.x = pk2(a0[0], a0[1]); w0.y = pk2(a0[2], a0[3]); w0.z = pk2(a1[0], a1[1]); w0.w = pk2(a1[2], a1[3]);
                  w1.x = pk2(a2[0], a2[1]); w1.y = pk2(a2[2], a2[3]); w1.z = pk2(a3[0], a3[1]); w1.w = pk2(a3[2], a3[3]);
                  LAS v4u* sd = (LAS v4u*)(stl + sv * 144 + skq * 2); sd[0] = w0; sd[1] = w1; }
                __syncthreads();
                { const int tt = wave & 3, vh = wave >> 2, ql = lane & 15, g4 = lane >> 4; const int t = 16 * tt + ql;
                  const bf16x8 qb0 = frag_rm(qel, 144, 16 * tt, 0, lane), qb1 = frag_rm(qel, 144, 16 * tt, 32, lane);
                  f32x4 sT[4];
#pragma unroll
                  for (int st = 0; st < 4; ++st) { sT[st] = (f32x4){0.f, 0.f, 0.f, 0.f};
                      if (st <= tt) { sT[st] = MFMA16(frag_rm(kel, 144, 16 * st, 0, lane), qb0, sT[st]); sT[st] = MFMA16(frag_rm(kel, 144, 16 * st, 32, lane), qb1, sT[st]);
#pragma unroll
                          for (int rg = 0; rg < 4; ++rg) if (16 * st + 4 * g4 + rg > t) sT[st][rg] = 0.f; } }
                  const bf16x8 pb0 = pack8(sT[0], sT[1]), pb1 = pack8(sT[2], sT[3]);
                  f32x4 acc[4]; float ss = 0.f;
#pragma unroll
                  for (int vt = 0; vt < 4; ++vt) { const int V0 = 16 * (4 * vh + vt); f32x4 a = (f32x4){0.f, 0.f, 0.f, 0.f};
                      a = MFMA16(frag_trp(vvl, 272, V0, 0, lane), pb0, a); a = MFMA16(frag_trp(vvl, 272, V0, 32, lane), pb1, a);
                      a = MFMA16(frag_rm(stl, 144, V0, 0, lane), qb0, a); a = MFMA16(frag_rm(stl, 144, V0, 32, lane), qb1, a);
                      acc[vt] = a; ss += (a[0] * a[0] + a[1] * a[1]) + (a[2] * a[2] + a[3] * a[3]); }
                  ss += __shfl_xor(ss, 16); ss += __shfl_xor(ss, 32);
                  if (g4 == 0) rsq[(tt * 2 + vh) * 16 + ql] = ss;
                  __syncthreads();
                  const float rs = 1.0f / sqrtf((rsq[(tt * 2) * 16 + ql] + rsq[(tt * 2 + 1) * 16 + ql]) * (1.0f / 128.0f) + pg8::RMS_EPS);
#pragma unroll
                  for (int vt = 0; vt < 4; ++vt) { const int v0 = 16 * (4 * vh + vt) + 4 * g4;
                      const pg8::u32x2 gr = *(const pg8::u32x2*)(U + (row0 + t) * NU + UGR + h * 128 + v0); const f32x4 gv = *(const f32x4*)(gn + v0);
                      const float o0 = acc[vt][0] * rs * gv[0] * pg8::silu_f(bflo(gr.x)), o1 = acc[vt][1] * rs * gv[1] * pg8::silu_f(bfhi(gr.x));
                      const float o2 = acc[vt][2] * rs * gv[2] * pg8::silu_f(bflo(gr.y)), o3 = acc[vt][3] * rs * gv[3] * pg8::silu_f(bfhi(gr.y));
                      pg8::u32x2 w; w.x = pg8::cvt_pk_bf16(o0, o1); w.y = pg8::cvt_pk_bf16(o2, o3);
                      *(pg8::u32x2*)(MIX + (row0 + t) * D + 256 + h * 128 + v0) = w; } }
                __syncthreads();
            }
        }
        SEAM(pb + 3);
        if (IN(pb + 4)) {
            pg8::Gemm g{MIX, (const bf16*)(ws + WS_WOUT) + (size_t)layer * D * D, M, D, D, D}; pg8::StaticOrder S; S.init(M, D, G, bx);
            if constexpr (layer == 0) { pg8::EpiRes<true> E{args.x, XBD, SSD}; pg8::gemm_phase<pg8::EpiRes<true>, pg8::StaticOrder, true, true>(ldsl, g, S, E, noepi); }
            else { pg8::EpiRes<false> E{XB, XBD, SSD}; pg8::gemm_phase<pg8::EpiRes<false>, pg8::StaticOrder, true, true>(ldsl, g, S, E, noepi); }
        }
        SEAM(pb + 4);
        if (layer == 0) {
            if (IN(pb + 5)) {
                pg8::Gemm g{XB, W13, M, 2 * FF, D, D}; pg8::StaticOrder S; S.init(M, 2 * FF, G, bx);
                pg8::EpiGlu<false> E{H, FF, SS};
                pg8::gemm_phase<pg8::EpiGlu<false>, pg8::StaticOrder, true, true>(ldsl, g, S, E, noepi);
            }
            SEAM(pb + 5);
            if (IN(pb + 6)) {
                pg8::Gemm g{H, W2, M, D, FF, FF}; pg8::StaticOrder S; S.init(M, D, G, bx);
#if defined(PROBE_EPI) && PROBE_EPI
                if (dry) { pg8::EpiRes<false, PROBE_EPI> E{XB, XBD, SSD}; pg8::gemm_phase<pg8::EpiRes<false, PROBE_EPI>, pg8::StaticOrder, true, true>(ldsl, g, S, E, noepi); } else
#endif
                { pg8::EpiRes<false> E{XB, XBD, SSD}; pg8::gemm_phase<pg8::EpiRes<false>, pg8::StaticOrder, true, true>(ldsl, g, S, E, noepi); }
            }
            SEAM(pb + 6);
        } else {
            for (int rp_ = 0; rp_ < 1 + ((pad_ >> 14) & 1); ++rp_)
            if (IN(pb + 5)) {
                const int tid = pg8::tid_here(), lane = tid & 63; (void)lane;
                float* wr_l = (float*)lds;
                int* cnt_l = (int*)(lds + 32768);
                const float* gf = args.g_ffn + D;
                { f32x4 ra[2][2]; float gk[2];
#pragma unroll
                  for (int j = 0; j < 2; ++j) { const int k = tid + NTHR * j; ra[j][0] = *(const f32x4*)(args.moe_router + k * 8); ra[j][1] = *(const f32x4*)(args.moe_router + k * 8 + 4); gk[j] = gf[k]; }
#pragma unroll
                  for (int j = 0; j < 2; ++j) { const int k = tid + NTHR * j;
#pragma unroll
                      for (int e = 0; e < 4; ++e) { wr_l[e * D + k] = ra[j][0][e] * gk[j]; wr_l[(4 + e) * D + k] = ra[j][1][e] * gk[j]; } } }
                if (tid < 8) cnt_l[tid] = 0;
                __syncthreads();
                for (int blk = bx; blk < 256; blk += G) {
                    if (blk != bx) { __syncthreads(); if (tid < 8) cnt_l[tid] = 0; __syncthreads(); }
                    v4u xpre[8][2];
#pragma unroll
                    for (int i = 0; i < 8; ++i) { const v4u* xr = (const v4u*)(XB + (size_t)(blk * 64 + wave * 8 + i) * D) + lane; xpre[i][0] = xr[0]; xpre[i][1] = xr[64]; }
                    const int mi = blk * 64 + wave * 8 + (lane >> 3);
                    typedef float f32x2_t __attribute__((ext_vector_type(2))); const f32x2_t ssp = *(const f32x2_t*)(SS + (size_t)mi * 16 + 2 * (lane & 7));
                    float v[64];
#pragma unroll
                    for (int q = 0; q < 64; ++q) v[q] = 0.f;
#pragma unroll
                    for (int eh = 0; eh < 2; ++eh) { f32x4 w[4][2][2];
#pragma unroll
                        for (int e = 0; e < 4; ++e)
#pragma unroll
                            for (int j = 0; j < 2; ++j) { const float* wp = wr_l + (4 * eh + e) * D + 8 * (lane + 64 * j); w[e][j][0] = *(const f32x4*)wp; w[e][j][1] = *(const f32x4*)(wp + 4); }
#pragma unroll
                        for (int i = 0; i < 8; ++i)
#pragma unroll
                            for (int j = 0; j < 2; ++j) { const v4u xw = xpre[i][j];
                                const f32x4 va = (f32x4){bflo(xw.x), bfhi(xw.x), bflo(xw.y), bfhi(xw.y)}, vb = (f32x4){bflo(xw.z), bfhi(xw.z), bflo(xw.w), bfhi(xw.w)};
#pragma unroll
                                for (int e = 0; e < 4; ++e) v[i * 8 + 4 * eh + e] += ((va[0] * w[e][j][0][0] + va[1] * w[e][j][0][1]) + (va[2] * w[e][j][0][2] + va[3] * w[e][j][0][3])) + ((vb[0] * w[e][j][1][0] + vb[1] * w[e][j][1][1]) + (vb[2] * w[e][j][1][2] + vb[3] * w[e][j][1][3])); } }
#pragma unroll
                    for (int st = 32; st >= 1; st >>= 1) { const bool up = (lane & st) != 0;
#pragma unroll
                        for (int q = 0; q < st; ++q) { const float send = up ? v[q] : v[q + st]; const float keep = up ? v[q + st] : v[q]; v[q] = keep + __shfl_xor(send, st); } }
                    float ssq = ssp[0] + ssp[1]; ssq += __shfl_xor(ssq, 1); ssq += __shfl_xor(ssq, 2); ssq += __shfl_xor(ssq, 4);
                    const float rs = 1.0f / sqrtf(ssq * (1.0f / 1024.0f) + pg8::RMS_EPS);
                    const float lg = v[0] * rs; const int me = lane & 7;
                    float bv = lg; int bi = me;
#pragma unroll
                    for (int st = 1; st < 8; st <<= 1) { const float ov = __shfl_xor(bv, st); const int oi = __shfl_xor(bi, st); if (ov > bv || (ov == bv && oi < bi)) { bv = ov; bi = oi; } }
                    float cv = (me == bi) ? -INFINITY : lg; int ci = me;
#pragma unroll
                    for (int st = 1; st < 8; st <<= 1) { const float ov = __shfl_xor(cv, st); const int oi = __shfl_xor(ci, st); if (ov > cv || (ov == cv && oi < ci)) { cv = ov; ci = oi; } }
                    if (me == 0) { const float w1 = 1.0f / (1.0f + __expf(bv - cv)), w0 = 1.0f - w1;
                        TOPI[mi * 2] = bi; TOPI[mi * 2 + 1] = ci; TOPW[mi * 2] = w0; TOPW[mi * 2 + 1] = w1; RS3[mi] = rs; atomicAdd(&cnt_l[bi], 1); atomicAdd(&cnt_l[ci], 1); }
                    __syncthreads();
                    if (tid < 8) CNT[blk * 8 + tid] = cnt_l[tid];
                }
            }
            SEAM(pb + 5);
            for (int rp_ = 0; rp_ < 1 + ((pad_ >> 15) & 1); ++rp_)
            if (IN(pb + 6)) {
                const int tid = pg8::tid_here(), lane = tid & 63; (void)lane;
                int* base_l = (int*)lds;
                int* pre_l = base_l + 8;
                int* tot_l = pre_l + 8;
                int* pos_l = tot_l + 8;
                int* ent_l = pos_l + 128;
                for (int blk = bx; blk < 256; blk += G) {
                    __syncthreads();
                    if (tid < 8) { tot_l[tid] = 0; pre_l[tid] = 0; }
                    if (tid < 128) ent_l[tid] = TOPI[blk * 128 + tid];
                    __syncthreads();
                    { const int g2 = tid >> 1, e0 = (tid & 1) * 4; const int4 c = *(const int4*)(CNT + g2 * 8 + e0);
                      atomicAdd(&tot_l[e0], c.x); atomicAdd(&tot_l[e0 + 1], c.y); atomicAdd(&tot_l[e0 + 2], c.z); atomicAdd(&tot_l[e0 + 3], c.w);
                      if (g2 < blk) { atomicAdd(&pre_l[e0], c.x); atomicAdd(&pre_l[e0 + 1], c.y); atomicAdd(&pre_l[e0 + 2], c.z); atomicAdd(&pre_l[e0 + 3], c.w); } }
                    __syncthreads();
                    if (tid == 0) { int bs = 0; for (int e = 0; e < 8; ++e) { base_l[e] = bs; bs += (tot_l[e] + 255) & ~255; } }
                    __syncthreads();
                    if (tid < 128) { const int e = ent_l[tid]; int rank = 0; for (int j = 0; j < tid; ++j) rank += (ent_l[j] == e) ? 1 : 0;
                        const int p = base_l[e] + pre_l[e] + rank; pos_l[tid] = p; POS[blk * 128 + tid] = p; ROWGATE[p] = TOPW[blk * 128 + tid]; ROWRS[p] = RS3[blk * 64 + (tid >> 1)]; }
                    if (blk == 0) {
                        for (int e = 0; e < 8; ++e) { const int npe = (tot_l[e] + 255) >> 8; for (int p = base_l[e] + tot_l[e] + tid; p < base_l[e] + npe * 256; p += NTHR) { ROWGATE[p] = 0.f; ROWRS[p] = 0.f; } }
                        if (tid == 0) { int np = 0; for (int e = 0; e < 8; ++e) { const int npe = (tot_l[e] + 255) >> 8; for (int j = 0; j < npe; ++j) PANE[np++] = e; } PANE[MAXPAN] = np; } }
                    __syncthreads();
                    for (int i = 0; i < 16; ++i) { const int sl = wave * 16 + i; const int m = blk * 64 + (sl >> 1); const int p = pos_l[sl];
                        const v4u* s = (const v4u*)(XB + (size_t)m * D) + lane; v4u* d = (v4u*)(XS + (size_t)p * D) + lane; d[0] = s[0]; d[64] = s[64]; }
                }
            }
            SEAM(pb + 6);
            if (IN(pb + 7)) {
                pg8::Gemm g{XS, WE13, MAXROWS, 2 * FE, D, D}; pg8::MoeOrder S{PANE, PANE[MAXPAN], 28, 4, G, bx};
                pg8::EpiGlu<true> E{HE, FE, ROWRS};
                pg8::gemm_phase<pg8::EpiGlu<true>, pg8::MoeOrder, true, true>(ldsl, g, S, E, noepi);
                { const int lane = pg8::tid_here() & 63; unsigned* scr = (unsigned*)(lds + wave * 8704); unsigned* qh = (unsigned*)(ws + WS_CTL) + CW_W2Q;
                  constexpr int T_J = 56 * 16, NTJ = 8 * T_J;
                  for (;;) { int t0 = 0; if (lane == 0) t0 = (int)__hip_atomic_fetch_add(qh, 4u, __ATOMIC_RELAXED, __HIP_MEMORY_SCOPE_AGENT); t0 = __builtin_amdgcn_readfirstlane(t0);
                      if (t0 >= NTJ) break;
                      for (int it = t0; it < t0 + 4 && it < NTJ; ++it) { const int e = it / T_J, r = it % T_J;
                          transpose_tile(args.moe_w2 + (size_t)e * FE * D, D, 64 * (r / 16), 64 * (r % 16), WE2 + (size_t)e * D * FE, FE, 64 * (r % 16), nullptr, scr, lane); } } }
            }
            SEAM(pb + 7);
            if (IN(pb + 9)) {
                const int npan = PANE[MAXPAN]; int npf = ((npan * 4) / G) * G / 4; if (npan - npf > 8 || npf == 0) npf = npan;
                { pg8::Gemm g{HE, WE2, MAXROWS, D, FE, FE}; pg8::MoeOrder S{PANE, npf, 4, 8, G, bx};
                  pg8::EpiMoeDown E{Y, ROWGATE};
                  pg8::gemm_phase<pg8::EpiMoeDown, pg8::MoeOrder, true, true>(ldsl, g, S, E, noepi); }
                if (npan > npf) { __syncthreads();
                  pg8::Gemm g{HE, WE2, MAXROWS, D, 896, FE}; pg8::MoeTailOrder S{PANE, npf, npan - npf, G, bx};
                  pg8::EpiMoeDownPart E{(float*)(ws + WS_YT), ROWGATE, npf * 256};
                  pg8::gemm_phase<pg8::EpiMoeDownPart, pg8::MoeTailOrder, true, true>(ldsl, g, S, E, noepi); }
            }
            SEAM(pb + 9);
            if (IN(pb + 10)) {
                const int tid = pg8::tid_here(), lane = tid & 63; (void)lane;
                const int npan_f = PANE[MAXPAN]; int npf_f = ((npan_f * 4) / G) * G / 4; if (npan_f - npf_f > 8 || npf_f == 0) npf_f = npan_f; const int tail0 = npf_f * 256;
                for (int rep_ = 0; rep_ < 1 + ((pad_ >> 12) & 1); ++rep_)
                for (int m = gw; m < M; m += NGW) {
                    f32x4* xr = (f32x4*)(X + (size_t)m * D) + lane; const int p0 = POS[m * 2], p1 = POS[m * 2 + 1];
                    const unsigned long long* xb = (const unsigned long long*)(XB + (size_t)m * D) + lane;
                    f32x4 v[4]; float s = 0.f;
#pragma unroll
                    for (int j = 0; j < 4; ++j) { const unsigned long long xw = xb[64 * j]; v[j] = (f32x4){bflo((unsigned)xw), bfhi((unsigned)xw), bflo((unsigned)(xw >> 32)), bfhi((unsigned)(xw >> 32))}; }
#pragma unroll
                    for (int sl = 0; sl < 2; ++sl) { const int p = sl ? p1 : p0;
                        if (p < tail0) { const unsigned long long* yp = (const unsigned long long*)(Y + (size_t)p * D) + lane;
#pragma unroll
                            for (int j = 0; j < 4; ++j) { const unsigned long long a = yp[64 * j]; v[j] += (f32x4){bflo((unsigned)a), bfhi((unsigned)a), bflo((unsigned)(a >> 32)), bfhi((unsigned)(a >> 32))}; } }
                        else { const f32x4* tp = (const f32x4*)((const float*)(ws + WS_YT) + (size_t)(p - tail0) * D) + lane;
#pragma unroll
                            for (int kq = 0; kq < 4; ++kq)
#pragma unroll
                                for (int j = 0; j < 4; ++j) v[j] += tp[(size_t)kq * 2048 * (D / 4) + 64 * j]; } }
#pragma unroll
                    for (int j = 0; j < 4; ++j) s += (v[j][0] * v[j][0] + v[j][1] * v[j][1]) + (v[j][2] * v[j][2] + v[j][3] * v[j][3]);
                    const float rs = 1.0f / sqrtf(wave_sum(s) * (1.0f / D) + pg8::RMS_EPS);
                    const f32x4* gf = (const f32x4*)args.g_final + lane;
#pragma unroll
                    for (int j = 0; j < 4; ++j) (dry ? (f32x4*)((float*)(ws + WS_HE) + (size_t)m * D) + lane : xr)[64 * j] = v[j] * rs * gf[64 * j];
                }
            }
        }
}

__global__ void __launch_bounds__(NTHR, 2) hybrid_fwd(Args args) {
    extern __shared__ __attribute__((aligned(16))) unsigned char lds[];
    LAS unsigned char* ldsl = (LAS unsigned char*)lds;
    volatile LAS unsigned* MISC = (volatile LAS unsigned*)(ldsl + MISC_OFF);
    const int tid = threadIdx.x, lane = tid & 63, wave = __builtin_amdgcn_readfirstlane(tid >> 6);
    const int G = gridDim.x; const int bx = blockIdx.x;
    const int gw = bx * NWAVES + wave, NGW = G * NWAVES;
    unsigned char* ws = args.ws;
    for (int u = tid; u < (LDS_BYTES - LDSCTL_OFF) / 4; u += NTHR) ((LAS unsigned*)(ldsl + LDSCTL_OFF))[u] = 0u;
    __syncthreads();
    XcdBarrier bar; bar.bar = (unsigned*)(ws + WS_CTL) + CW_BAR + args.li * XCD_BAR_WORDS; bar.x = 0; bar.st = nullptr;
    if (MK_N_LAUNCHES == 1) bar = xcd_barrier_post((unsigned*)(ws + WS_CTL) + CW_BAR + args.li * XCD_BAR_WORDS, MISC + 8);
    const int lo = args.ph_lo, hi = args.ph_hi;

    WS_PTRS

    for (int rp_ = 0; rp_ < 1 + ((args.pad >> 6) & 1); ++rp_)
    if (IN(0)) {
        unsigned* scr = (unsigned*)(lds + wave * 8704);
        constexpr int T_A = 16 * 36, T_B = 16 * 12, T_D = 16 * 16, T_L = T_A + T_B + T_D;
        constexpr int T_F = 16 * 44, T_G = 44 * 16, T_E = 16 * 56;
        constexpr int NT0 = 2 * T_L + 2 * T_F + T_G + 16 * T_E;
        for (int it = gw; it < NT0; it += NGW) {
            int r = it;
            if (r < 2 * T_L) { const int l = r / T_L; r -= l * T_L; const float* win = args.w_mix_in + (size_t)l * D * INC; const float* gm = args.g_mix + l * D;
                bf16* WIN = (bf16*)(ws + WS_WIN) + (size_t)l * NU * D;
                if (r < T_A) { transpose_tile(win, INC, 64 * (r / 36), 64 * (r % 36), WIN, D, 64 * (r % 36), gm, scr, lane); continue; } r -= T_A;
                if (r < T_B) { transpose_tile(win, INC, 64 * (r / 12), 2320 + 64 * (r % 12), WIN, D, 2304 + 64 * (r % 12), gm, scr, lane); continue; } r -= T_B;
                transpose_tile(args.w_mix_out + (size_t)l * D * D, D, 64 * (r / 16), 64 * (r % 16), (bf16*)(ws + WS_WOUT) + (size_t)l * D * D, D, 64 * (r % 16), nullptr, scr, lane); continue; }
            r -= 2 * T_L;
            if (r < 2 * T_F) { const int w3 = r / T_F; r -= w3 * T_F; const int n0 = 64 * (r % 44);
                transpose_tile(w3 ? args.ffn_w3 : args.ffn_w1, FF, 64 * (r / 44), n0, W13, D, (n0 >> 7) * 256 + (n0 & 127) + 128 * w3, args.g_ffn, scr, lane); continue; }
            r -= 2 * T_F;
            if (r < T_G) { transpose_tile(args.ffn_w2, D, 64 * (r / 16), 64 * (r % 16), W2, FF, 64 * (r % 16), nullptr, scr, lane); continue; }
            r -= T_G;
            { const int ew = r / T_E; r -= ew * T_E; const int e = ew >> 1, w3 = ew & 1; const int n0 = 64 * (r % 56);
              transpose_tile((w3 ? args.moe_w3 : args.moe_w1) + (size_t)e * D * FE, FE, 64 * (r / 56), n0, WE13 + (size_t)e * 2 * FE * D, D, (n0 >> 7) * 256 + (n0 & 127) + 128 * w3, args.g_ffn + D, scr, lane); }
        }
        for (int m = gw; m < M; m += NGW) {
            const f32x4* xr = (const f32x4*)(args.x + (size_t)m * D) + lane; float s = 0.f;
            unsigned long long* o8 = (unsigned long long*)(XB + (size_t)m * D) + lane;
#pragma unroll
            for (int j = 0; j < 4; ++j) { const f32x4 v = xr[64 * j]; s += (v[0] * v[0] + v[1] * v[1]) + (v[2] * v[2] + v[3] * v[3]);
                o8[64 * j] = (unsigned long long)pk2(v[0], v[1]) | ((unsigned long long)pk2(v[2], v[3]) << 32); }
            s = wave_sum(s);
            if (lane < 16) SS[(size_t)m * 16 + lane] = (lane == 0) ? s : 0.f;
        }
        for (int i = bx * NTHR + tid; i < 2049 * 4; i += G * NTHR) { const int d = i >> 2, h = i & 3; BL[i] = args.rel_bias[rel_bucket(d) * 4 + h] * LOG2E; }
        for (int i = bx * NTHR + tid; i < 2 * 16 * D; i += G * NTHR) { const int k = i & (D - 1), r = (i >> 10) & 15, l = i >> 14;
            ((bf16*)(ws + WS_WGLR))[i] = (bf16)f2bf(args.g_mix[l * D + k] * args.w_mix_in[((size_t)l * D + k) * INC + 2304 + r]); }
    }
    SEAM(0);

    Ctx c; c.args = args; c.tid = tid; c.lane = lane; c.wave = wave; c.G = G; c.bx = bx; c.gw = gw; c.NGW = NGW; c.lo = lo; c.hi = hi; c.bar = bar;
    layer_phases<0>(c, lds);
    layer_phases<1>(c, lds);
}
#undef IN
#undef SEAM
#undef GRID_BAR


extern "C" void kernel_launch(void* const* d_in, const int* in_sizes, int n_in, void* d_out, int out_size, void* d_ws, size_t ws_size, hipStream_t stream) {
    static int grid = 0;
    if (grid == 0) {
        if (n_in != 18 || in_sizes[0] != M * D || out_size != M * D || ws_size < WS_END) { fprintf(stderr, "kernel_launch: unexpected shapes / workspace (%zu < %zu)\n", ws_size, (size_t)WS_END); grid = -1; return; }
        int dev = 0, cus = 0, per_cu = 0;
        if (hipGetDevice(&dev) != hipSuccess || hipDeviceGetAttribute(&cus, hipDeviceAttributeMultiprocessorCount, dev) != hipSuccess) { grid = -1; return; }
        if (hipFuncSetAttribute((const void*)hybrid_fwd, hipFuncAttributeMaxDynamicSharedMemorySize, LDS_BYTES) != hipSuccess) { fprintf(stderr, "kernel_launch: hipFuncSetAttribute failed\n"); grid = -1; return; }
        if (hipOccupancyMaxActiveBlocksPerMultiprocessor(&per_cu, (const void*)hybrid_fwd, NTHR, LDS_BYTES) != hipSuccess || per_cu < 1) { fprintf(stderr, "kernel_launch: occupancy query says %d\n", per_cu); }
        (void)hipGetLastError();
        grid = cus;
    }
    if (grid < 0) return;
    if (hipMemsetAsync((char*)d_ws + WS_CTL, 0, CTL_ZERO_BYTES, stream) != hipSuccess) return;
    Args a{};
    const float** f = (const float**)&a;
    for (int i = 0; i < 18; ++i) f[i] = (const float*)d_in[i];
    a.out = (float*)d_out; a.ws = (unsigned char*)d_ws;
    if (MK_N_LAUNCHES == 1) {
#ifndef PROBE_MODE
#define PROBE_MODE 0
#endif
#ifdef PROBE_PHASE
        const int cuts[4][2] = {{0, PROBE_PHASE}, {PROBE_PHASE, PROBE_PHASE + 1}, {PROBE_PHASE, 64}, {0, 0}};
        for (int li = 0; li < 3; ++li) { a.ph_lo = cuts[li][0]; a.ph_hi = cuts[li][1]; a.li = li; a.pad = (li == 1) ? PROBE_MODE : 0; hipLaunchKernelGGL(hybrid_fwd, dim3(grid), dim3(NTHR), LDS_BYTES, stream, a); }
#else
        a.ph_lo = 0; a.ph_hi = 64; a.li = 0;
#ifndef PROBE_LOW
#define PROBE_LOW 0
#endif
#ifdef PROBE_REP
        a.pad = (PROBE_REP << 8) | PROBE_LOW;
#endif
        hipLaunchKernelGGL(hybrid_fwd, dim3(grid), dim3(NTHR), LDS_BYTES, stream, a);
#endif
    }
    else {
        static const int phases[] = {0, 1, 2, 3, 4, 5, 6, 7, 17, 18, 19, 20, 21, 22, 23, 24, 25, 26, 27};
        for (int p : phases) { a.ph_lo = p; a.ph_hi = p + 1; hipLaunchKernelGGL(hybrid_fwd, dim3(grid), dim3(NTHR), LDS_BYTES, stream, a); }
    }
}
```

```cpp
#include <hip/hip_runtime.h>
#include <cstdio>
#include <cstdint>

#ifndef MK_N_LAUNCHES
#define MK_N_LAUNCHES 1
#endif

namespace pg8 {
#define PG8_LAS __attribute__((address_space(3)))
__device__ __forceinline__ int tid_here() { int t = threadIdx.x; asm volatile("" : "+v"(t)); return t; }
typedef unsigned short bf16_t;
typedef short bf16x8 __attribute__((ext_vector_type(8)));
typedef float f32x4 __attribute__((ext_vector_type(4)));
typedef unsigned u32x4 __attribute__((ext_vector_type(4)));
typedef unsigned u32x2 __attribute__((ext_vector_type(2)));
constexpr int BM = 256, BK = 64, HALF = 128, HTB = HALF * BK * 2, STAGE_BYTES = 8 * HTB, NXCD = 8, WGM = 8;

__host__ __device__ __forceinline__ int lds_byte(int r, int c) { const int st = (r >> 4) * 2 + (c >> 5), rr = r & 15, cc = c & 31, ob = rr * 64 + cc * 2; return st * 1024 + (ob ^ (((ob >> 9) & 1) << 5)); }
__host__ __device__ __forceinline__ void stage_rc(int b, int& R, int& C) { const int st = b / 1024, sb = b % 1024, swz = sb ^ (((sb >> 9) & 1) << 5); R = (st >> 1) * 16 + swz / 64; C = (st & 1) * 32 + (swz % 64) / 2; }
__host__ __device__ __forceinline__ int perm32(int rho) { const int n = rho >> 4, i = rho & 15; return 8 * (i >> 2) + 4 * n + (i & 3); }

struct Unit { int pm, pn, ko; };
struct Gemm { const bf16_t* A; const bf16_t* Bt; int M, N, K, ld; };

struct StaticOrder {
    int nM, nN, nwg, G, c;
    __host__ __device__ void init(int M, int N, int G_, int c_) { nM = M / BM; nN = N / BM; nwg = nM * nN; G = G_; c = c_; }
    __host__ __device__ bool next(int i, Unit& u) const {
        const long L = (long)i * G + c; if (L >= nwg) return false;
        int wgid = (int)L; { const int q = nwg / NXCD, r = nwg % NXCD, xcd = wgid % NXCD, off = wgid / NXCD; wgid = (xcd < r ? xcd * (q + 1) : r * (q + 1) + (xcd - r) * q) + off; }
        const int nig = WGM * nN, gid = wgid / nig, fm = gid * WGM, gsz = (nM - fm) < WGM ? (nM - fm) : WGM;
        u.pm = fm + ((wgid % nig) % gsz); u.pn = (wgid % nig) / gsz; u.ko = 0; return true;
    }
    __device__ __forceinline__ void a_ready(const Unit&) const {}
    __device__ __forceinline__ void done(const Unit&) const {}
};
struct MoeOrder {
    const int* panel_e; int npan, NT, GP, G, c;
    __device__ bool next(int i, Unit& u) const {
        const int nwg = npan * NT; const long L = (long)i * G + c; if (L >= nwg) return false;
        int wgid = (int)L; { const int q = nwg / NXCD, r = nwg % NXCD, xcd = wgid % NXCD, off = wgid / NXCD; wgid = (xcd < r ? xcd * (q + 1) : r * (q + 1) + (xcd - r) * q) + off; }
        const int nig = GP * NT, grp = wgid / nig, fm = grp * GP, gsz = (npan - fm) < GP ? (npan - fm) : GP; const int rr = wgid % nig;
        const int p = fm + rr % gsz; u.pm = p; u.pn = panel_e[p] * NT + rr / gsz; u.ko = 0; return true;
    }
    __device__ __forceinline__ void a_ready(const Unit&) const {}
    __device__ __forceinline__ void done(const Unit&) const {}
};

struct MoeTailOrder {
    const int* panel_e; int p0, ntp, G, c;
    __device__ bool next(int i, Unit& u) const {
        const long L = (long)i * G + c; if (L >= (long)ntp * 16) return false;
        const int kq = (int)L & 3, r = (int)L >> 2, p = p0 + (r >> 2); u.pm = p; u.pn = panel_e[p] * 4 + (r & 3); u.ko = kq * 896 * 2; return true;
    }
    __device__ __forceinline__ void a_ready(const Unit&) const {}
    __device__ __forceinline__ void done(const Unit&) const {}
};
typedef float f32x2c_t __attribute__((ext_vector_type(2))); typedef __bf16 bf16x2c_t __attribute__((ext_vector_type(2)));
__device__ __forceinline__ unsigned cvt_pk_bf16(float lo, float hi) { const f32x2c_t v = {lo, hi}; return __builtin_bit_cast(unsigned, __builtin_convertvector(v, bf16x2c_t)); }

constexpr float RMS_EPS = 1e-6f;
__device__ __forceinline__ float rstd_of(const float* ss16) {
    const f32x4 a = *(const f32x4*)ss16, b = *(const f32x4*)(ss16 + 4), c = *(const f32x4*)(ss16 + 8), d = *(const f32x4*)(ss16 + 12);
    const float s = ((a[0] + a[1]) + (a[2] + a[3])) + ((b[0] + b[1]) + (b[2] + b[3])) + ((c[0] + c[1]) + (c[2] + c[3])) + ((d[0] + d[1]) + (d[2] + d[3]));
    return __builtin_amdgcn_rsqf(s * (1.0f / 1024.0f) + RMS_EPS);
}
__device__ __forceinline__ void rstd4(const float* SS, int row0, float (&rs)[4]) {
    f32x4 p[4][4];
#pragma unroll
    for (int m = 0; m < 4; ++m)
#pragma unroll
        for (int q = 0; q < 4; ++q) p[m][q] = *(const f32x4*)(SS + (size_t)(row0 + 16 * m) * 16 + 4 * q);
    asm volatile("" : "+v"(p[0][0]), "+v"(p[0][1]), "+v"(p[0][2]), "+v"(p[0][3]), "+v"(p[1][0]), "+v"(p[1][1]), "+v"(p[1][2]), "+v"(p[1][3]),
                      "+v"(p[2][0]), "+v"(p[2][1]), "+v"(p[2][2]), "+v"(p[2][3]), "+v"(p[3][0]), "+v"(p[3][1]), "+v"(p[3][2]), "+v"(p[3][3]));
#pragma unroll
    for (int m = 0; m < 4; ++m) { const f32x4 a = p[m][0], b = p[m][1], c = p[m][2], d = p[m][3];
        const float s = ((a[0] + a[1]) + (a[2] + a[3])) + ((b[0] + b[1]) + (b[2] + b[3])) + ((c[0] + c[1]) + (c[2] + c[3])) + ((d[0] + d[1]) + (d[2] + d[3]));
        rs[m] = __builtin_amdgcn_rsqf(s * (1.0f / 1024.0f) + RMS_EPS); }
}
__device__ __forceinline__ float logsig16(float x) { return ((x < 0.f ? x : 0.f) - 0.6931471805599453f * __builtin_amdgcn_logf(1.0f + __builtin_amdgcn_exp2f(-1.4426950408889634f * fabsf(x)))) * (1.0f / 16.0f); }
__device__ __forceinline__ float silu_f(float a) { return a * __builtin_amdgcn_rcpf(1.0f + __builtin_amdgcn_exp2f(a * -1.4426950408889634f)); }

struct EpiU {
    static constexpr bool PERM = true, AFTER_DRAIN = false;
    bf16_t* U; int ldu; const float* SS; float qs;
    __device__ __forceinline__ void operator()(const f32x4 (&acc)[2][2][4][2], const Unit& u, int wr, int wc, int fr, int fq) const {
        const int row0 = u.pm * BM + wr * 64 + fr, col0 = u.pn * BM + wc * 32 + 8 * fq;
        const float sc = (u.pn == 0) ? qs : ((u.pn == 3) ? 0.125f : 1.0f);
#pragma unroll
        for (int ai = 0; ai < 2; ++ai) { float rs4[4]; rstd4(SS, row0 + ai * HALF, rs4);
#pragma unroll
            for (int m = 0; m < 4; ++m) { const int row = row0 + ai * HALF + m * 16; const float rs = rs4[m] * sc;
                bf16_t* rowp = U + (size_t)row * ldu + col0;
#pragma unroll
                for (int bj = 0; bj < 2; ++bj) { const f32x4 v0 = acc[ai][bj][m][0] * rs, v1 = acc[ai][bj][m][1] * rs;
                    u32x4 w; w.x = cvt_pk_bf16(v0[0], v0[1]); w.y = cvt_pk_bf16(v0[2], v0[3]); w.z = cvt_pk_bf16(v1[0], v1[1]); w.w = cvt_pk_bf16(v1[2], v1[3]);
                    *(u32x4*)(rowp + bj * HALF) = w; } } }
    }
};
template <bool IN_F32, int PM = 0> struct EpiRes {
    static constexpr bool PERM = true, AFTER_DRAIN = false;
    const void* Xin; bf16_t* XB; float* SS;
    __device__ __forceinline__ void operator()(const f32x4 (&acc)[2][2][4][2], const Unit& u, int wr, int wc, int fr, int fq) const {
        const int row0 = u.pm * BM + wr * 64 + fr, col0 = u.pn * BM + wc * 32 + 8 * fq;
        if constexpr (IN_F32) {
#pragma unroll
            for (int ai = 0; ai < 2; ++ai) { f32x4 xo[4][2][2];
#pragma unroll
                for (int m = 0; m < 4; ++m)
#pragma unroll
                    for (int bj = 0; bj < 2; ++bj) { const float* p = (const float*)Xin + (size_t)(row0 + ai * HALF + m * 16) * 1024 + col0 + bj * HALF; xo[m][bj][0] = *(const f32x4*)p; xo[m][bj][1] = *(const f32x4*)(p + 4); }
                asm volatile("" : "+v"(xo[0][0][0]), "+v"(xo[0][0][1]), "+v"(xo[0][1][0]), "+v"(xo[0][1][1]), "+v"(xo[1][0][0]), "+v"(xo[1][0][1]), "+v"(xo[1][1][0]), "+v"(xo[1][1][1]),
                                  "+v"(xo[2][0][0]), "+v"(xo[2][0][1]), "+v"(xo[2][1][0]), "+v"(xo[2][1][1]), "+v"(xo[3][0][0]), "+v"(xo[3][0][1]), "+v"(xo[3][1][0]), "+v"(xo[3][1][1]));
#pragma unroll
                for (int m = 0; m < 4; ++m) { const int row = row0 + ai * HALF + m * 16; float ssum = 0.f;
#pragma unroll
                    for (int bj = 0; bj < 2; ++bj) { const f32x4 v0 = xo[m][bj][0] + acc[ai][bj][m][0], v1 = xo[m][bj][1] + acc[ai][bj][m][1];
                        u32x4 w; w.x = cvt_pk_bf16(v0[0], v0[1]); w.y = cvt_pk_bf16(v0[2], v0[3]); w.z = cvt_pk_bf16(v1[0], v1[1]); w.w = cvt_pk_bf16(v1[2], v1[3]);
                        *(u32x4*)(XB + (size_t)row * 1024 + col0 + bj * HALF) = w;
                        ssum += ((v0[0] * v0[0] + v0[1] * v0[1]) + (v0[2] * v0[2] + v0[3] * v0[3])) + ((v1[0] * v1[0] + v1[1] * v1[1]) + (v1[2] * v1[2] + v1[3] * v1[3])); }
                    ssum += __shfl_xor(ssum, 16); ssum += __shfl_xor(ssum, 32);
                    if (fq == 0) SS[(size_t)row * 16 + u.pn * 4 + wc] = ssum; } }
        } else {
            u32x4 xo[2][4][2];
#pragma unroll
            for (int ai = 0; ai < 2; ++ai)
#pragma unroll
                for (int m = 0; m < 4; ++m)
#pragma unroll
                    for (int bj = 0; bj < 2; ++bj) xo[ai][m][bj] = *(const u32x4*)((const bf16_t*)Xin + (size_t)(row0 + ai * HALF + m * 16) * 1024 + col0 + bj * HALF);
            asm volatile("" : "+v"(xo[0][0][0]), "+v"(xo[0][0][1]), "+v"(xo[0][1][0]), "+v"(xo[0][1][1]), "+v"(xo[0][2][0]), "+v"(xo[0][2][1]), "+v"(xo[0][3][0]), "+v"(xo[0][3][1]),
                              "+v"(xo[1][0][0]), "+v"(xo[1][0][1]), "+v"(xo[1][1][0]), "+v"(xo[1][1][1]), "+v"(xo[1][2][0]), "+v"(xo[1][2][1]), "+v"(xo[1][3][0]), "+v"(xo[1][3][1]));
#pragma unroll
            for (int ai = 0; ai < 2; ++ai)
#pragma unroll
                for (int m = 0; m < 4; ++m) { const int row = row0 + ai * HALF + m * 16; float ssum = 0.f;
#pragma unroll
                    for (int bj = 0; bj < 2; ++bj) { const u32x4 x = xo[ai][m][bj]; f32x4 v0, v1;
                        v0[0] = __builtin_bit_cast(float, x.x << 16) + acc[ai][bj][m][0][0]; v0[1] = __builtin_bit_cast(float, x.x & 0xffff0000u) + acc[ai][bj][m][0][1];
                        v0[2] = __builtin_bit_cast(float, x.y << 16) + acc[ai][bj][m][0][2]; v0[3] = __builtin_bit_cast(float, x.y & 0xffff0000u) + acc[ai][bj][m][0][3];
                        v1[0] = __builtin_bit_cast(float, x.z << 16) + acc[ai][bj][m][1][0]; v1[1] = __builtin_bit_cast(float, x.z & 0xffff0000u) + acc[ai][bj][m][1][1];
                        v1[2] = __builtin_bit_cast(float, x.w << 16) + acc[ai][bj][m][1][2]; v1[3] = __builtin_bit_cast(float, x.w & 0xffff0000u) + acc[ai][bj][m][1][3];
                        u32x4 w; w.x = cvt_pk_bf16(v0[0], v0[1]); w.y = cvt_pk_bf16(v0[2], v0[3]); w.z = cvt_pk_bf16(v1[0], v1[1]); w.w = cvt_pk_bf16(v1[2], v1[3]);
                        if constexpr (!(PM & 8)) *(u32x4*)(XB + (size_t)row * 1024 + col0 + bj * HALF) = w;
                        ssum += ((v0[0] * v0[0] + v0[1] * v0[1]) + (v0[2] * v0[2] + v0[3] * v0[3])) + ((v1[0] * v1[0] + v1[1] * v1[1]) + (v1[2] * v1[2] + v1[3] * v1[3])); }
                    if constexpr (!(PM & 16)) { ssum += __shfl_xor(ssum, 16); ssum += __shfl_xor(ssum, 32); }
                    if constexpr (!(PM & 4)) { if (fq == 0) SS[(size_t)row * 16 + u.pn * 4 + wc] = ssum; }
                    if constexpr ((PM & 12) == 12) asm volatile("" :: "v"(ssum)); }
        }
    }
};
template <bool MOE> struct EpiGlu {
    static constexpr bool PERM = true, AFTER_DRAIN = false;
    bf16_t* O; int ldo; const float* SS;
    __device__ __forceinline__ void operator()(const f32x4 (&acc)[2][2][4][2], const Unit& u, int wr, int wc, int fr, int fq) const {
        const int row0 = u.pm * BM + wr * 64 + fr; const int pnl = MOE ? (u.pn % 28) : u.pn; const int col0 = pnl * HALF + wc * 32 + 8 * fq;
#pragma unroll
        for (int ai = 0; ai < 2; ++ai) { float rs4[4];
            if constexpr (MOE) {
#pragma unroll
                for (int m = 0; m < 4; ++m) rs4[m] = SS[row0 + ai * HALF + m * 16];
                asm volatile("" : "+v"(rs4[0]), "+v"(rs4[1]), "+v"(rs4[2]), "+v"(rs4[3]));
            } else rstd4(SS, row0 + ai * HALF, rs4);
#pragma unroll
            for (int m = 0; m < 4; ++m) { const int row = row0 + ai * HALF + m * 16; const float rs = rs4[m];
                const f32x4 a0 = acc[ai][0][m][0] * rs, a1 = acc[ai][0][m][1] * rs, b0 = acc[ai][1][m][0] * rs, b1 = acc[ai][1][m][1] * rs;
                f32x4 g0, g1;
#pragma unroll
                for (int j = 0; j < 4; ++j) { g0[j] = silu_f(a0[j]) * b0[j]; g1[j] = silu_f(a1[j]) * b1[j]; }
                u32x4 w; w.x = cvt_pk_bf16(g0[0], g0[1]); w.y = cvt_pk_bf16(g0[2], g0[3]); w.z = cvt_pk_bf16(g1[0], g1[1]); w.w = cvt_pk_bf16(g1[2], g1[3]);
                *(u32x4*)(O + (size_t)row * ldo + col0) = w; } }
    }
};
struct EpiMoeDown {
    static constexpr bool PERM = true, AFTER_DRAIN = false;
    bf16_t* Y; const float* gate;
    __device__ __forceinline__ void operator()(const f32x4 (&acc)[2][2][4][2], const Unit& u, int wr, int wc, int fr, int fq) const {
        const int row0 = u.pm * BM + wr * 64 + fr, col0 = (u.pn & 3) * BM + wc * 32 + 8 * fq;
        float gt[2][4];
#pragma unroll
        for (int ai = 0; ai < 2; ++ai)
#pragma unroll
            for (int m = 0; m < 4; ++m) gt[ai][m] = gate[row0 + ai * HALF + m * 16];
        asm volatile("" : "+v"(gt[0][0]), "+v"(gt[0][1]), "+v"(gt[0][2]), "+v"(gt[0][3]), "+v"(gt[1][0]), "+v"(gt[1][1]), "+v"(gt[1][2]), "+v"(gt[1][3]));
#pragma unroll
        for (int ai = 0; ai < 2; ++ai)
#pragma unroll
            for (int m = 0; m < 4; ++m) { const int row = row0 + ai * HALF + m * 16; const float g = gt[ai][m]; bf16_t* rowp = Y + (size_t)row * 1024 + col0;
#pragma unroll
                for (int bj = 0; bj < 2; ++bj) { const f32x4 v0 = acc[ai][bj][m][0] * g, v1 = acc[ai][bj][m][1] * g;
                    u32x4 w; w.x = cvt_pk_bf16(v0[0], v0[1]); w.y = cvt_pk_bf16(v0[2], v0[3]); w.z = cvt_pk_bf16(v1[0], v1[1]); w.w = cvt_pk_bf16(v1[2], v1[3]);
                    *(u32x4*)(rowp + bj * HALF) = w; } }
    }
};

struct EpiMoeDownPart {
    static constexpr bool PERM = false, AFTER_DRAIN = false;
    float* YT; const float* gate; int row_base;
    __device__ __forceinline__ void operator()(const f32x4 (&acc)[2][2][4][2], const Unit& u, int wr, int wc, int fr, int fq) const {
        const int row0 = u.pm * BM + wr * 64 + fr, col0 = (u.pn & 3) * BM + wc * 32 + 4 * fq; const int kq = u.ko / 1792;
#pragma unroll
        for (int ai = 0; ai < 2; ++ai)
#pragma unroll
            for (int m = 0; m < 4; ++m) { const int row = row0 + ai * HALF + m * 16; const float gtv = gate[row]; float* rowp = YT + ((size_t)kq * 2048 + (row - row_base)) * 1024 + col0;
#pragma unroll
                for (int bj = 0; bj < 2; ++bj)
#pragma unroll
                    for (int n = 0; n < 2; ++n) *(f32x4*)(rowp + bj * HALF + n * 16) = acc[ai][bj][m][n] * gtv; }
    }
};
template <class Epi, class Sched, bool ALIGN_EPI = false, bool SP2 = false>
__device__ __forceinline__ void gemm_phase(PG8_LAS unsigned char* lds, const Gemm g, const Sched& S, const Epi& E, const bool skip_epi = false) {
    const int tid = tid_here(), wid = __builtin_amdgcn_readfirstlane(tid >> 6), lane = tid & 63, wr = wid >> 2, wc = wid & 3, fr = lane & 15, fq = lane >> 4;
    const int K = g.ld, nt = g.K / BK;
    unsigned voffA[2], voffB[2];
#pragma unroll
    for (int i = 0; i < 2; ++i) { int R, C; stage_rc(tid * 16 + i * 8192, R, C); const int Rb = Epi::PERM ? ((R & ~31) + perm32(R & 31)) : R;
        voffA[i] = (unsigned)(R * K + C) * 2u; voffB[i] = (unsigned)(Rb * K + C) * 2u; }
    const size_t kstep = (size_t)(BK * 2);
    const size_t hstep = (size_t)HALF * K * 2;
    const size_t tstep = 2 * hstep;
    const unsigned ldsw = (unsigned)wid * 1024u;
    const int aoff = lds_byte(wr * 64 + fr, fq * 8), boff = lds_byte(wc * 32 + fr, fq * 8);
#define PG8_SA(b, h) (((b) * 2 + (h)) * HTB)
#define PG8_SB(b, h) ((4 + (b) * 2 + (h)) * HTB)
#define PG8_STAGE(bufoff, gbase, voff) do { _Pragma("unroll") for (int _i = 0; _i < 2; ++_i) \
        __builtin_amdgcn_global_load_lds((const unsigned*)((const char*)(gbase) + (voff)[_i]), (PG8_LAS unsigned*)(lds + (bufoff) + ldsw + _i * 8192), 16, 0, 0); } while (0)
#define PG8_LDA(dst, b, h) do { _Pragma("unroll") for (int m = 0; m < 4; ++m) _Pragma("unroll") for (int k = 0; k < 2; ++k) dst[m][k] = *(const PG8_LAS bf16x8*)(lds + PG8_SA(b, h) + aoff + m * 2048 + k * 1024); } while (0)
#define PG8_LDB(dst, b, h) do { _Pragma("unroll") for (int n = 0; n < 2; ++n) _Pragma("unroll") for (int k = 0; k < 2; ++k) dst[n][k] = *(const PG8_LAS bf16x8*)(lds + PG8_SB(b, h) + boff + n * 2048 + k * 1024); } while (0)
#define PG8_MMA(ai, bj, At, Bt) do { __builtin_amdgcn_s_setprio(1); _Pragma("unroll") for (int m = 0; m < 4; ++m) _Pragma("unroll") for (int n = 0; n < 2; ++n) _Pragma("unroll") for (int k = 0; k < 2; ++k) \
        acc[ai][bj][m][n] = __builtin_amdgcn_mfma_f32_16x16x32_bf16(Bt[n][k], At[m][k], acc[ai][bj][m][n], 0, 0, 0); __builtin_amdgcn_s_setprio(0); } while (0)
#define PG8_WAIT_V(n) asm volatile("s_waitcnt vmcnt(" #n ")" ::: "memory")
#define PG8_WAIT_L(n) asm volatile("s_waitcnt lgkmcnt(" #n ")" ::: "memory")
#define PG8_BAR __builtin_amdgcn_s_barrier()
#define PG8_SCHED __builtin_amdgcn_sched_barrier(0)
    Unit cur, nxt; int ui = 0;
    if (!S.next(0, cur)) return;
    f32x4 acc[2][2][4][2];
#pragma unroll
    for (int a = 0; a < 2; ++a)
#pragma unroll
        for (int b = 0; b < 2; ++b)
#pragma unroll
            for (int m = 0; m < 4; ++m)
#pragma unroll
                for (int n = 0; n < 2; ++n) acc[a][b][m][n] = (f32x4){0.f, 0.f, 0.f, 0.f};
    bf16x8 At[4][2], B0[2][2], B1[2][2];
    const char* cA = (const char*)g.A + (size_t)cur.pm * tstep + cur.ko; const char* cB = (const char*)g.Bt + (size_t)cur.pn * tstep + cur.ko;
    S.a_ready(cur);
    if constexpr (SP2) {
        PG8_STAGE(PG8_SB(0, 0), cB, voffB); PG8_STAGE(PG8_SB(0, 1), cB + hstep, voffB); PG8_STAGE(PG8_SA(0, 0), cA, voffA); PG8_STAGE(PG8_SA(0, 1), cA + hstep, voffA);
        if (wr == 1) PG8_BAR;
        PG8_WAIT_V(2); PG8_BAR;
        PG8_STAGE(PG8_SB(1, 0), cB + kstep, voffB); PG8_STAGE(PG8_SA(1, 0), cA + kstep, voffA); PG8_STAGE(PG8_SB(1, 1), cB + hstep + kstep, voffB);
        PG8_WAIT_V(6); PG8_BAR;
    } else {
        PG8_STAGE(PG8_SB(0, 0), cB, voffB); PG8_STAGE(PG8_SA(0, 0), cA, voffA); PG8_STAGE(PG8_SB(0, 1), cB + hstep, voffB); PG8_STAGE(PG8_SA(0, 1), cA + hstep, voffA);
        if (wr == 1) PG8_BAR;
        PG8_WAIT_V(4); PG8_BAR;
        PG8_STAGE(PG8_SB(1, 0), cB + kstep, voffB); PG8_STAGE(PG8_SA(1, 0), cA + kstep, voffA); PG8_STAGE(PG8_SB(1, 1), cB + hstep + kstep, voffB);
        PG8_WAIT_V(6); PG8_BAR;
    }
    for (;;) {
        const bool has_next = S.next(ui + 1, nxt);
        const char* nA = has_next ? (const char*)g.A + (size_t)nxt.pm * tstep + nxt.ko : cA; const char* nB = has_next ? (const char*)g.Bt + (size_t)nxt.pn * tstep + nxt.ko : cB;
        for (int t = 0; t < nt; t += 2) {
            const bool last = (t == nt - 2);
            const char* a1 = cA + (size_t)(t + 1) * kstep;
            const char* a2 = last ? nA : cA + (size_t)(t + 2) * kstep; const char* b2 = last ? nB : cB + (size_t)(t + 2) * kstep;
            const char* a3 = a2 + kstep; const char* b3 = b2 + kstep;
            if (last && has_next) S.a_ready(nxt);
            if constexpr (SP2) {
            PG8_LDB(B0, 0, 0); PG8_LDB(B1, 0, 1); PG8_SCHED; PG8_LDA(At, 0, 0); PG8_STAGE(PG8_SA(1, 1), a1 + hstep, voffA);
            PG8_WAIT_V(8); PG8_WAIT_L(0); PG8_BAR; PG8_MMA(0, 0, At, B0); PG8_MMA(0, 1, At, B1); PG8_BAR; PG8_SCHED;
            PG8_LDA(At, 0, 1); PG8_STAGE(PG8_SB(0, 0), b2, voffB); PG8_STAGE(PG8_SB(0, 1), b2 + hstep, voffB); PG8_STAGE(PG8_SA(0, 0), a2, voffA);
            PG8_WAIT_V(8); PG8_WAIT_L(0); PG8_BAR; PG8_MMA(1, 0, At, B0); PG8_MMA(1, 1, At, B1); PG8_BAR; PG8_SCHED;
            PG8_LDB(B0, 1, 0); PG8_LDB(B1, 1, 1); PG8_SCHED; PG8_LDA(At, 1, 0); PG8_STAGE(PG8_SA(0, 1), a2 + hstep, voffA);
            PG8_WAIT_V(8); PG8_WAIT_L(0); PG8_BAR; PG8_MMA(0, 0, At, B0); PG8_MMA(0, 1, At, B1); PG8_BAR; PG8_SCHED;
            PG8_LDA(At, 1, 1); PG8_STAGE(PG8_SB(1, 0), b3, voffB); PG8_STAGE(PG8_SB(1, 1), b3 + hstep, voffB); PG8_STAGE(PG8_SA(1, 0), a3, voffA);
            PG8_WAIT_V(8); PG8_WAIT_L(0); PG8_BAR; PG8_MMA(1, 0, At, B0); PG8_MMA(1, 1, At, B1); PG8_BAR; PG8_SCHED;
            } else {
            PG8_LDB(B0, 0, 0); PG8_SCHED; PG8_LDA(At, 0, 0); PG8_STAGE(PG8_SA(1, 1), a1 + hstep, voffA);
            PG8_WAIT_L(8); PG8_BAR; PG8_WAIT_L(0); PG8_MMA(0, 0, At, B0); PG8_BAR; PG8_SCHED;
            PG8_LDB(B1, 0, 1); PG8_STAGE(PG8_SB(0, 0), b2, voffB);
            PG8_BAR; PG8_WAIT_L(0); PG8_MMA(0, 1, At, B1); PG8_BAR;
            PG8_LDA(At, 0, 1); PG8_STAGE(PG8_SA(0, 0), a2, voffA);
            PG8_BAR; PG8_WAIT_L(0); PG8_MMA(1, 0, At, B0); PG8_BAR; PG8_SCHED;
            PG8_STAGE(PG8_SB(0, 1), b2 + hstep, voffB);
            PG8_WAIT_V(6); PG8_BAR; PG8_MMA(1, 1, At, B1); PG8_BAR;
            PG8_LDB(B0, 1, 0); PG8_SCHED; PG8_LDA(At, 1, 0); PG8_STAGE(PG8_SA(0, 1), a2 + hstep, voffA);
            PG8_WAIT_L(8); PG8_BAR; PG8_WAIT_L(0); PG8_MMA(0, 0, At, B0); PG8_BAR; PG8_SCHED;
            PG8_LDB(B1, 1, 1); PG8_STAGE(PG8_SB(1, 0), b3, voffB);
            PG8_BAR; PG8_WAIT_L(0); PG8_MMA(0, 1, At, B1); PG8_BAR;
            PG8_LDA(At, 1, 1); PG8_STAGE(PG8_SA(1, 0), a3, voffA);
            PG8_BAR; PG8_WAIT_L(0); PG8_MMA(1, 0, At, B0); PG8_BAR; PG8_SCHED;
            PG8_STAGE(PG8_SB(1, 1), b3 + hstep, voffB);
            PG8_WAIT_V(6); PG8_BAR; PG8_MMA(1, 1, At, B1); PG8_BAR;
            }
        }
        if constexpr (ALIGN_EPI) { if (wr == 0) PG8_BAR; }
        if constexpr (!Epi::AFTER_DRAIN) { if (!skip_epi) E(acc, cur, wr, wc, fr, fq); S.done(cur); }
        if (!has_next) break;
#pragma unroll
        for (int a = 0; a < 2; ++a)
#pragma unroll
            for (int b = 0; b < 2; ++b)
#pragma unroll
                for (int m = 0; m < 4; ++m)
#pragma unroll
                    for (int n = 0; n < 2; ++n) acc[a][b][m][n] = (f32x4){0.f, 0.f, 0.f, 0.f};
        cur = nxt; cA = nA; cB = nB; ++ui;
        if constexpr (ALIGN_EPI) { if (wr == 1) PG8_BAR; }
    }
    PG8_WAIT_V(0);
    if constexpr (!ALIGN_EPI) { if (wr == 0) PG8_BAR; }
    PG8_BAR;
#undef PG8_SA
#undef PG8_SB
#undef PG8_STAGE
#undef PG8_LDA
#undef PG8_LDB
#undef PG8_MMA
#undef PG8_WAIT_V
#undef PG8_WAIT_L
#undef PG8_BAR
#undef PG8_SCHED
}
}

constexpr int NWAVES = 8, NTHR = NWAVES * 64;
constexpr int NB = 8, SEQ = 2048, D = 1024, M = NB * SEQ;
constexpr int INC = 3088;
constexpr int NU = 3072;
constexpr int UQ = 0, UK = 256, UV = 512, UGQ = 768, UGK = 1024, UGV = 1280, UGR = 1792, UCI = 2304, UCB = 2560, UCC = 2816;
constexpr int FF = 2816, FE = 3584, NE = 8;
constexpr int MAXPAN = 136, MAXROWS = MAXPAN * 256;
constexpr float LOG2E = 1.4426950408889634f;
constexpr float QS_ATT = 0.125f * LOG2E;

constexpr size_t MiB = 1u << 20;
constexpr size_t WS_CTL = 0, CTL_ZERO_BYTES = 1 * MiB;
constexpr size_t WS_SS = 1 * MiB;
constexpr size_t WS_BL = 2 * MiB;
constexpr size_t WS_DEC = 2 * MiB + 64 * 1024;
constexpr size_t WS_TOPI = 3 * MiB;
constexpr size_t WS_TOPW = 3 * MiB + 128 * 1024;
constexpr size_t WS_POS = 3 * MiB + 256 * 1024;
constexpr size_t WS_RS3 = 3 * MiB + 384 * 1024;
constexpr size_t WS_CNT = 3 * MiB + 448 * 1024;
constexpr size_t WS_PANE = 3 * MiB + 456 * 1024;
constexpr size_t WS_ROWGATE = 4 * MiB;
constexpr size_t WS_ROWRS = 4 * MiB + 256 * 1024;
constexpr size_t WS_WE13 = 8 * MiB;
constexpr size_t WS_Y = WS_WE13;
constexpr size_t WS_YT = WS_WE13 + 68 * MiB;
constexpr size_t WS_XS = 120 * MiB;
constexpr size_t WS_WE2 = WS_XS;
constexpr size_t WS_HE = 188 * MiB;
constexpr size_t WS_WIN = WS_HE;
constexpr size_t WS_WGLR = WS_HE + 12 * MiB;
constexpr size_t WS_LA = WS_HE + 34 * MiB;
constexpr size_t WS_WOUT = WS_HE + 13 * MiB;
constexpr size_t WS_W13 = WS_HE + 17 * MiB;
constexpr size_t WS_W2 = WS_HE + 28 * MiB;
constexpr size_t WS_XB = WS_HE + 238 * MiB;
constexpr size_t WS_U = WS_HE + 66 * MiB;
constexpr size_t WS_H = WS_U;
constexpr size_t WS_MIX = WS_HE + 170 * MiB;
constexpr size_t WS_CST = WS_HE + 202 * MiB;
constexpr size_t WS_END = WS_HE + 270 * MiB;
static_assert(WS_CST + 32 * MiB <= WS_END, "ws map");
constexpr int CW_BAR = 4096;
constexpr int CW_SC = 32768;
constexpr int CW_TMO2 = 65536;
constexpr int CW_W2Q = 65600;

constexpr int LDS_BYTES = 147456;
constexpr int LDSCTL_OFF = 131072 + 14 * 1024, MISC_OFF = LDSCTL_OFF + 320;

#define GAS __attribute__((address_space(1)))
#define LAS __attribute__((address_space(3)))
typedef unsigned short bf16;
typedef float f32x4 __attribute__((ext_vector_type(4)));
typedef unsigned v4u __attribute__((ext_vector_type(4)));
__device__ __forceinline__ unsigned f2bf(float f) { unsigned u = __builtin_bit_cast(unsigned, f); return (u + 0x7fffu + ((u >> 16) & 1u)) >> 16; }
__device__ __forceinline__ unsigned pk2(float lo, float hi) { return pg8::cvt_pk_bf16(lo, hi); }
__device__ __forceinline__ float fexp_(float x) { return __builtin_amdgcn_exp2f(x * 1.4426950408889634f); }
__device__ __forceinline__ float bf2f(unsigned short b) { return __builtin_bit_cast(float, (unsigned)b << 16); }
__device__ __forceinline__ float bflo(unsigned w) { return __builtin_bit_cast(float, w << 16); }
__device__ __forceinline__ float bfhi(unsigned w) { return __builtin_bit_cast(float, w & 0xffff0000u); }
__device__ __forceinline__ float wave_sum(float v) {
#pragma unroll
    for (int o = 1; o < 64; o <<= 1) v += __shfl_xor(v, o);
    return v;
}
__device__ __forceinline__ float wave_max(float v) {
#pragma unroll
    for (int o = 1; o < 64; o <<= 1) v = fmaxf(v, __shfl_xor(v, o));
    return v;
}

#define XB_TMO      128
#define XB_XCNT(j)  (256  + 64 * (j))
#define XB_XSUB(j)  (1280 + 64 * (j))
#define XB_XGEN(j)  (2304 + 64 * (j))
#define XB_TOP      3328
#define XB_TOPGEN   3392
#define XCD_BAR_WORDS 3456
#define XB_SPIN_CAP (1u << 18)
__device__ __forceinline__ unsigned xb_ld(unsigned* p)              { return __hip_atomic_load(p, __ATOMIC_RELAXED, __HIP_MEMORY_SCOPE_AGENT); }
__device__ __forceinline__ unsigned xb_add(unsigned* p, unsigned v) { return __hip_atomic_fetch_add(p, v, __ATOMIC_RELAXED, __HIP_MEMORY_SCOPE_AGENT); }
__device__ __forceinline__ unsigned xb_xcc_id() { return (unsigned)__builtin_amdgcn_s_getreg((3 << 11) | 20) & 0xFu; }
#define XB_SPIN(cond, bar) do { unsigned _sp = 0; while (cond) { __builtin_amdgcn_s_sleep(1); \
    if ((++_sp & 255u) == 0u) { if (xb_ld(&(bar)[XB_TMO])) break; if (_sp > XB_SPIN_CAP) { atomicAdd(&(bar)[XB_TMO], 1u); break; } } } } while (0)
struct XcdBarrier { unsigned* bar; unsigned x; volatile LAS unsigned* st; };
__device__ __forceinline__ XcdBarrier xcd_barrier_post(unsigned* bar, volatile LAS unsigned* st) {
    XcdBarrier b; b.bar = bar; b.x = xb_xcc_id(); b.st = st;
    if (threadIdx.x == 0) (void)xb_add(&bar[XB_XCNT(b.x)], 1u);
    return b;
}
__device__ __forceinline__ void xcd_barrier_complete(unsigned* bar, unsigned x, unsigned& nloc, unsigned& nx) {
    const unsigned G = gridDim.x * gridDim.y * gridDim.z;
    unsigned sum, cnt, mine, sp = 0u;
    for (;;) {
        sum = 0u; cnt = 0u; mine = 0u;
#pragma unroll
        for (unsigned j = 0; j < 16; ++j) { const unsigned c = xb_ld(&bar[XB_XCNT(j)]); sum += c; cnt += (c > 0u) ? 1u : 0u; mine = (j == x) ? c : mine; }
        if (sum == G) break;
        __builtin_amdgcn_s_sleep(1);
        if ((++sp & 255u) == 0u) { if (xb_ld(&bar[XB_TMO])) break; if (sp > XB_SPIN_CAP) { atomicAdd(&bar[XB_TMO], 1u); break; } }
    }
    nloc = mine > 0u ? mine : 1u; nx = cnt > 0u ? cnt : 1u;
}
__device__ __forceinline__ void xcd_barrier(const XcdBarrier& b) {
    asm volatile("s_waitcnt vmcnt(0)" ::: "memory");
    __syncthreads();
    if (threadIdx.x == 0) {
        unsigned* bar = b.bar;
        __builtin_amdgcn_s_waitcnt(0);
        unsigned nloc = b.st[0], nx = b.st[1];
        if (nloc == 0u) { xcd_barrier_complete(bar, b.x, nloc, nx); b.st[0] = nloc; b.st[1] = nx; }
        const unsigned old = xb_add(&bar[XB_XSUB(b.x)], 1u);
        const unsigned gen = old / nloc;
        if (old + 1u == (gen + 1u) * nloc) {
            __builtin_amdgcn_fence(__ATOMIC_RELEASE, "agent");
            asm volatile("s_waitcnt vmcnt(0)" ::: "memory");
            const unsigned og = xb_add(&bar[XB_TOP], 1u);
            const unsigned tg = og / nx;
            if (og + 1u == (tg + 1u) * nx) xb_add(&bar[XB_TOPGEN], 1u);
            else XB_SPIN(xb_ld(&bar[XB_TOPGEN]) == tg, bar);
            __builtin_amdgcn_fence(__ATOMIC_ACQUIRE, "agent");
            xb_add(&bar[XB_XGEN(b.x)], 1u);
            asm volatile("s_waitcnt vmcnt(0)" ::: "memory");
        } else {
            XB_SPIN(xb_ld(&bar[XB_XGEN(b.x)]) == gen, bar);
            __builtin_amdgcn_fence(__ATOMIC_ACQUIRE, "agent");
            asm volatile("s_waitcnt vmcnt(0)" ::: "memory");
        }
    }
    __syncthreads();
}

struct Args {
    const float* x; const float* w_mix_in; const float* w_mix_out; const float* g_mix; const float* rel_bias; const float* gla_w_gate; const float* gla_b_gate;
    const float* gla_g_norm; const float* conv_w; const float* g_ffn; const float* ffn_w1; const float* ffn_w3; const float* ffn_w2; const float* moe_router;
    const float* moe_w1; const float* moe_w3; const float* moe_w2; const float* g_final;
    float* out; unsigned char* ws; int ph_lo, ph_hi, li, pad;
};

__device__ __forceinline__ void transpose_tile(const float* src, int ldsrc, int k0, int n0, bf16* dst, int ldd, int drow0, const float* ksc, unsigned* scr, int lane) {
    const int nq = lane & 15, kk = lane >> 4;
#pragma unroll
    for (int i = 0; i < 8; ++i) { const int k = 8 * i + 2 * kk; const float* p = src + (size_t)(k0 + k) * ldsrc + n0 + 4 * nq;
        const f32x4 r0 = *(const f32x4*)p, r1 = *(const f32x4*)(p + ldsrc);
        const float s0 = ksc ? ksc[k0 + k] : 1.f, s1 = ksc ? ksc[k0 + k + 1] : 1.f;
#pragma unroll
        for (int j = 0; j < 4; ++j) scr[(4 * nq + j) * 33 + 4 * i + kk] = pk2(r0[j] * s0, r1[j] * s1); }
    asm volatile("s_waitcnt lgkmcnt(0)" ::: "memory");
#pragma unroll 8
    for (int i2 = 0; i2 < 32; ++i2) { const int n = 2 * i2 + (lane >> 5), d = lane & 31;
        ((unsigned*)(dst + (size_t)(drow0 + n) * ldd + k0))[d] = scr[n * 33 + d]; }
    asm volatile("s_waitcnt lgkmcnt(0)" ::: "memory");
}
__device__ __forceinline__ void glr_tile(const float* win, const float* wg, const float* g, int k0, int n0, bf16* dst, int drow0, int lane) {
    float w[16];
#pragma unroll
    for (int r = 0; r < 16; ++r) w[r] = wg[r * 256 + n0 + lane];
    unsigned* drow = (unsigned*)(dst + (size_t)(drow0 + n0 + lane) * 1024 + k0);
    for (int kp = 0; kp < 32; ++kp) { float v[2];
#pragma unroll
        for (int q = 0; q < 2; ++q) { const int k = k0 + 2 * kp + q; const float* s = win + (size_t)k * INC + 2304; float a = 0.f;
#pragma unroll
            for (int r = 0; r < 16; ++r) a += s[r] * w[r];
            v[q] = a * g[k]; }
        drow[kp] = pk2(v[0], v[1]); }
}
__device__ __forceinline__ int rel_bucket(int d) {
    if (d < 16) return d;
    const float lr = logf((float)d / 16.0f) / logf(128.0f);
    int b = 16 + (int)(lr * 16.0f); return b < 31 ? b : 31;
}


typedef short bf16x8 __attribute__((ext_vector_type(8)));
typedef short v4i16_t __attribute__((ext_vector_type(4)));
#define MFMA16(a, b, c) __builtin_amdgcn_mfma_f32_16x16x32_bf16((a), (b), (c), 0, 0, 0)
__device__ __forceinline__ v4i16_t tr16(LAS unsigned char* p) { return __builtin_amdgcn_ds_read_tr16_b64_v4i16((LAS v4i16_t*)p); }
__device__ __forceinline__ bf16x8 cat8(v4i16_t lo, v4i16_t hi) { return __builtin_shufflevector(lo, hi, 0, 1, 2, 3, 4, 5, 6, 7); }
__device__ __forceinline__ bf16x8 frag_rm(LAS unsigned char* base, int pitch, int c0, int k0, int lane) { return *(LAS bf16x8*)(base + (c0 + (lane & 15)) * pitch + (k0 + 8 * (lane >> 4)) * 2); }
__device__ __forceinline__ bf16x8 frag_tr(LAS unsigned char* base, int pitch, int c0, int k0, int lane) {
    const int i = lane & 15, g = lane >> 4; LAS unsigned char* p = base + (k0 + 8 * g + (i >> 2)) * pitch + (c0 + 4 * (i & 3)) * 2;
    return cat8(tr16(p), tr16(p + 4 * pitch)); }
__device__ __forceinline__ bf16x8 frag_trp(LAS unsigned char* base, int pitch, int c0, int k0, int lane) {
    const int i = lane & 15, g = lane >> 4; LAS unsigned char* p = base + (k0 + 4 * g + (i >> 2)) * pitch + (c0 + 4 * (i & 3)) * 2;
    return cat8(tr16(p), tr16(p + 16 * pitch)); }
__device__ __forceinline__ bf16x8 pack8(const f32x4& a, const f32x4& b) {
    v4u w; w.x = pg8::cvt_pk_bf16(a[0], a[1]); w.y = pg8::cvt_pk_bf16(a[2], a[3]); w.z = pg8::cvt_pk_bf16(b[0], b[1]); w.w = pg8::cvt_pk_bf16(b[2], b[3]); return __builtin_bit_cast(bf16x8, w); }

struct Ctx { Args args; int tid, lane, wave, G, bx, gw, NGW, lo, hi; XcdBarrier bar; };
#define GRID_BAR() do { if (MK_N_LAUNCHES == 1) xcd_barrier(bar); } while (0)
#define IN(k) (lo <= (k) && (k) < hi)
#define SEAM(k) do { if (IN(k) && IN((k) + 1)) GRID_BAR(); } while (0)
#define WS_PTRS \
    float* SS = (float*)(ws + WS_SS); float* BL = (float*)(ws + WS_BL); float* DEC = (float*)(ws + WS_DEC); \
    bf16* XB = (bf16*)(ws + WS_XB); bf16* U = (bf16*)(ws + WS_U); bf16* MIX = (bf16*)(ws + WS_MIX); float* CST = (float*)(ws + WS_CST); \
    bf16* H = (bf16*)(ws + WS_H); bf16* W13 = (bf16*)(ws + WS_W13); bf16* W2 = (bf16*)(ws + WS_W2); \
    bf16* WE13 = (bf16*)(ws + WS_WE13); bf16* WE2 = (bf16*)args.out;     bf16* XS = (bf16*)(ws + WS_XS); bf16* HE = (bf16*)(ws + WS_HE); bf16* Y = (bf16*)(ws + WS_Y); \
    int* TOPI = (int*)(ws + WS_TOPI); float* TOPW = (float*)(ws + WS_TOPW); int* POS = (int*)(ws + WS_POS); float* RS3 = (float*)(ws + WS_RS3); \
    int* CNT = (int*)(ws + WS_CNT); int* PANE = (int*)(ws + WS_PANE); float* ROWGATE = (float*)(ws + WS_ROWGATE); float* ROWRS = (float*)(ws + WS_ROWRS); \
    float* X = args.out; \
    (void)SS; (void)BL; (void)DEC; (void)XB; (void)U; (void)MIX; (void)CST; (void)H; (void)W13; (void)W2; (void)WE13; (void)WE2; (void)XS; (void)HE; (void)Y; \
    (void)TOPI; (void)TOPW; (void)POS; (void)RS3; (void)CNT; (void)PANE; (void)ROWGATE; (void)ROWRS; (void)X;

template <int layer> __device__ __forceinline__ void layer_phases(const Ctx& c, unsigned char* lds) {
    const Args& args = c.args; LAS unsigned char* ldsl = (LAS unsigned char*)lds;
    const int tid = c.tid, lane = c.lane, wave = c.wave, G = c.G, bx = c.bx, gw = c.gw, NGW = c.NGW, lo = c.lo, hi = c.hi; const XcdBarrier bar = c.bar;
    unsigned char* ws = args.ws;
    WS_PTRS
    (void)tid; (void)lane; (void)wave; (void)gw; (void)NGW;
#if defined(PROBE_PHASE) || defined(PROBE_REP)
    const int pad_ = args.pad;
#else
    constexpr int pad_ = 0;
#endif
    const int pmode = pad_ >> 4; (void)pmode;
    const bool dry = (pad_ & 1) != 0, noepi = (pad_ & 2) != 0;
    bf16* XBD = dry ? (bf16*)(ws + WS_XS) : XB; float* SSD = dry ? (float*)(ws + WS_XS) : SS; (void)XBD; (void)SSD;
        const int pb = 1 + 16 * layer;
        if (IN(pb + 0)) {
            pg8::Gemm g{XB, (const bf16*)(ws + WS_WIN) + (size_t)layer * NU * D, M, NU, D, D}; pg8::StaticOrder S; S.init(M, NU, G, bx);
            pg8::EpiU E{U, NU, SS, QS_ATT};
            pg8::gemm_phase<pg8::EpiU, pg8::StaticOrder, true, true>(ldsl, g, S, E, noepi);
            { const bf16* wg = (const bf16*)(ws + WS_WGLR) + (size_t)layer * 16 * D; float* LA = (float*)(ws + WS_LA); f32x4* xch = (f32x4*)lds; float* glrl = (float*)(lds + 4096);
              const int tid = pg8::tid_here(), lane = tid & 63; const int rt = wave & 3, kh = wave >> 2, ql = lane & 15, g4 = lane >> 4;
              bf16x8 wfr[8]; float bcl[8];
#pragma unroll
              for (int ct = 0; ct < 8; ++ct) { const int col = 16 * (8 * kh + ct) + ql; float w8[8];
#pragma unroll
                  for (int j = 0; j < 8; ++j) w8[j] = (g4 < 2) ? args.gla_w_gate[layer * 16 * 256 + (8 * g4 + j) * 256 + col] : 0.f;
                  v4u pw; pw.x = pk2(w8[0], w8[1]); pw.y = pk2(w8[2], w8[3]); pw.z = pk2(w8[4], w8[5]); pw.w = pk2(w8[6], w8[7]); wfr[ct] = __builtin_bit_cast(bf16x8, pw);
                  bcl[ct] = args.gla_b_gate[layer * 256 + col]; }
              for (int blk = bx; blk < 256; blk += G) {
                  const bf16* ap = XB + (size_t)(blk * 64 + rt * 16 + ql) * D + kh * 512 + 8 * g4; const bf16* bp = wg + (size_t)ql * D + kh * 512 + 8 * g4;
                  bf16x8 af[16], bfr[16];
#pragma unroll
                  for (int ks = 0; ks < 16; ++ks) { af[ks] = *(const bf16x8*)(ap + 32 * ks); bfr[ks] = *(const bf16x8*)(bp + 32 * ks); }
                  f32x4 rsp[4];
                  { const int rl = rt * 16 + 4 * g4;
#pragma unroll
                    for (int rg = 0; rg < 4; ++rg) { const f32x4* sp = (const f32x4*)(SS + (size_t)(blk * 64 + rl + rg) * 16); rsp[rg] = (sp[0] + sp[1]) + (sp[2] + sp[3]); } }
                  f32x4 acc = (f32x4){0.f, 0.f, 0.f, 0.f};
#pragma unroll
                  for (int ks = 0; ks < 16; ++ks) acc = MFMA16(af[ks], bfr[ks], acc);
                  if (kh == 1) xch[rt * 64 + lane] = acc;
                  __syncthreads();
                  if (kh == 0) { acc += xch[rt * 64 + lane];
#pragma unroll
                      for (int rg = 0; rg < 4; ++rg) { const int rl = rt * 16 + 4 * g4 + rg; const float s = (rsp[rg][0] + rsp[rg][1]) + (rsp[rg][2] + rsp[rg][3]);
                          glrl[rl * 16 + ql] = acc[rg] * __builtin_amdgcn_rsqf(s * (1.0f / 1024.0f) + pg8::RMS_EPS); } }
                  __syncthreads();
                  {
                    bf16x8 afr = (bf16x8){0, 0, 0, 0, 0, 0, 0, 0};
                    if (g4 < 2) { const f32x4 x0 = *(const f32x4*)(glrl + (rt * 16 + ql) * 16 + 8 * g4), x1 = *(const f32x4*)(glrl + (rt * 16 + ql) * 16 + 8 * g4 + 4);
                        v4u pa; pa.x = pk2(x0[0], x0[1]); pa.y = pk2(x0[2], x0[3]); pa.z = pk2(x1[0], x1[1]); pa.w = pk2(x1[2], x1[3]); afr = __builtin_bit_cast(bf16x8, pa); }
#pragma unroll
                    for (int ct = 0; ct < 8; ++ct) { const f32x4 z = MFMA16(afr, wfr[ct], ((f32x4){0.f, 0.f, 0.f, 0.f}));
#pragma unroll
                        for (int rg = 0; rg < 4; ++rg) LA[(size_t)(blk * 64 + rt * 16 + 4 * g4 + rg) * 256 + 16 * (8 * kh + ct) + ql] = pg8::logsig16(z[rg] + bcl[ct]); } }
                  __syncthreads();
              } }
        }
        SEAM(pb + 0);
        if (IN(pb + 1)) {
            const int tid = pg8::tid_here(), lane = tid & 63; (void)lane;
            float* cum = (float*)lds; float* seg = cum + 4096;
            LAS unsigned char* kdl = ldsl + 18432;
            LAS unsigned char* vvl = ldsl + 27648;
            for (int u = bx; u < 1024; u += G) {
                const int h = u & 3, n = (u >> 2) & 31, b = u >> 7; const size_t row0 = (size_t)b * SEQ + n * 64;
                const int tr = tid >> 3, c8 = tid & 7;
                const v4u kraw = *(const v4u*)(U + (row0 + tr) * NU + UGK + h * 64 + 8 * c8);
                const v4u* vp = (const v4u*)(U + (row0 + tr) * NU + UGV + h * 128 + c8 * 16); const v4u x0 = vp[0], x1 = vp[1];
                { float c = 0.f; float lav[8]; const float* lap = (const float*)(ws + WS_LA) + (row0 + 8 * wave) * 256 + h * 64 + lane;
#pragma unroll
                  for (int i = 0; i < 8; ++i) lav[i] = lap[i * 256];
#pragma unroll
                  for (int i = 0; i < 8; ++i) { c += lav[i]; cum[(8 * wave + i) * 64 + lane] = c; }
                  seg[wave * 64 + lane] = c; }
                __syncthreads();
                { f32x4 offa = (f32x4){0.f, 0.f, 0.f, 0.f}, offb = offa, lasta = offa, lastb = offa; const int wq = tr >> 3;
#pragma unroll
                  for (int w = 0; w < 8; ++w) { const f32x4 sa = *(const f32x4*)(seg + w * 64 + 8 * c8), sb = *(const f32x4*)(seg + w * 64 + 8 * c8 + 4); lasta += sa; lastb += sb; if (w < wq) { offa += sa; offb += sb; } }
                  const f32x4 ca = *(const f32x4*)(cum + tr * 64 + 8 * c8) + offa, cb = *(const f32x4*)(cum + tr * 64 + 8 * c8 + 4) + offb;
                  v4u w; w.x = pk2(bflo(kraw.x) * fexp_(lasta[0] - ca[0]), bfhi(kraw.x) * fexp_(lasta[1] - ca[1])); w.y = pk2(bflo(kraw.y) * fexp_(lasta[2] - ca[2]), bfhi(kraw.y) * fexp_(lasta[3] - ca[3]));
                  w.z = pk2(bflo(kraw.z) * fexp_(lastb[0] - cb[0]), bfhi(kraw.z) * fexp_(lastb[1] - cb[1])); w.w = pk2(bflo(kraw.w) * fexp_(lastb[2] - cb[2]), bfhi(kraw.w) * fexp_(lastb[3] - cb[3]));
                  *(LAS v4u*)(kdl + tr * 144 + c8 * 16) = w;
                  if (tr == 0) {
#pragma unroll
                      for (int j = 0; j < 4; ++j) { __hip_atomic_store(DEC + u * 64 + 8 * c8 + j, fexp_(lasta[j]), __ATOMIC_RELAXED, __HIP_MEMORY_SCOPE_AGENT); __hip_atomic_store(DEC + u * 64 + 8 * c8 + 4 + j, fexp_(lastb[j]), __ATOMIC_RELAXED, __HIP_MEMORY_SCOPE_AGENT); } }
                  LAS v4u* vd = (LAS v4u*)(vvl + tr * 272 + c8 * 32); vd[0] = x0; vd[1] = x1; }
                __syncthreads();
                { f32x4 acc[4];
#pragma unroll
                  for (int kt = 0; kt < 4; ++kt) acc[kt] = (f32x4){0.f, 0.f, 0.f, 0.f};
#pragma unroll
                  for (int ks = 0; ks < 2; ++ks) { const bf16x8 bv = frag_tr(vvl, 272, 16 * wave, 32 * ks, lane);
#pragma unroll
                      for (int kt = 0; kt < 4; ++kt) { const bf16x8 ak = frag_tr(kdl, 144, 16 * kt, 32 * ks, lane); acc[kt] = MFMA16(ak, bv, acc[kt]); } }
                  const int g4 = lane >> 4, ql = lane & 15;
                  const __amdgpu_buffer_rsrc_t rsrc = __builtin_amdgcn_make_buffer_rsrc((void*)CST, 0, 32 * 1024 * 1024, 0x00020000);
#pragma unroll
                  for (int kt = 0; kt < 4; ++kt)
                      __builtin_amdgcn_raw_buffer_store_b128(__builtin_bit_cast(v4u, acc[kt]), rsrc, (int)((((unsigned)u * 128u + 16u * wave + ql) * 64u + 16u * kt + 4u * g4) * 4u), 0, 16); }
                asm volatile("s_waitcnt vmcnt(0)" ::: "memory");
                __syncthreads();
                if (tid == 0) __hip_atomic_fetch_add((unsigned*)(ws + WS_CTL) + CW_SC + ((u >> 7) * 4 + (u & 3)) * 64, 1u, __ATOMIC_RELAXED, __HIP_MEMORY_SCOPE_AGENT);
            }
            const float* cw = args.conv_w + layer * 3 * 256;
            for (int rep_ = 0; rep_ < 1 + ((pad_ >> 10) & 1); ++rep_)
            for (int it = bx * NTHR + tid; it < M * 32; it += G * NTHR) {
                const int row = it >> 5, c0 = (it & 31) * 8, t = row & (SEQ - 1);
                const bf16* ur = U + (size_t)row * NU;
                const v4u cb = *(const v4u*)(ur + UCB + c0);
                v4u ci[3], cc[3];
#pragma unroll
                for (int d = 0; d < 3; ++d) { if (t >= d) { ci[d] = *(const v4u*)(ur - (size_t)d * NU + UCI + c0); cc[d] = *(const v4u*)(ur - (size_t)d * NU + UCC + c0); } else { ci[d] = (v4u){0u, 0u, 0u, 0u}; cc[d] = ci[d]; } }
                float o[8];
#pragma unroll
                for (int j = 0; j < 4; ++j) {
                    float a0 = 0.f, a1 = 0.f;
#pragma unroll
                    for (int d = 0; d < 3; ++d) { const float w0 = cw[(2 - d) * 256 + c0 + 2 * j], w1 = cw[(2 - d) * 256 + c0 + 2 * j + 1];
                        a0 += w0 * (bflo(cc[d][j]) * bflo(ci[d][j])); a1 += w1 * (bfhi(cc[d][j]) * bfhi(ci[d][j])); }
                    o[2 * j] = bflo(cb[j]) * a0; o[2 * j + 1] = bfhi(cb[j]) * a1; }
                v4u w; w.x = pk2(o[0], o[1]); w.y = pk2(o[2], o[3]); w.z = pk2(o[4], o[5]); w.w = pk2(o[6], o[7]);
                *(v4u*)(MIX + (size_t)row * D + 768 + c0) = w;
            }
            __syncthreads();
            {
                float* BLl = (float*)lds;
                for (int i = tid; i < 4 * 2049; i += NTHR) BLl[(i & 3) * 2049 + (i >> 2)] = BL[i];
                __syncthreads();
                LAS unsigned char* vst = ldsl + 33280 + wave * 5120;
                const int ql = lane & 15, g4 = lane >> 4;
                for (int rep_ = 0; rep_ < 1 + ((pad_ >> 11) & 1); ++rep_)
                for (int uu = bx; uu < 512; uu += G) {
                    int u = uu; if (G == 256) { const int j = (uu & 255) >> 3; u = ((((uu >> 8) * 16 + (uu & 7) * 2 + (j >> 4)) << 4) | (j & 15)); }
                    const int c = u & 15, h = (u >> 4) & 3, b = u >> 6; const int i0 = 16 * (((uu / G) & 1) ? 7 - wave : wave); const size_t rowb = (size_t)b * SEQ;
                    const int tq = c + 16 * (i0 + ql);
                    const bf16* ub = U + rowb * NU + h * 64;
                    const bf16x8 qf0 = *(const bf16x8*)(ub + (size_t)tq * NU + UQ + 8 * g4), qf1 = *(const bf16x8*)(ub + (size_t)tq * NU + UQ + 8 * g4 + 32);
                    const float* blh = BLl + h * 2049;
                    const int t0 = c + 16 * i0, t1 = t0 + 240;
                    const int base0 = ((t0 >> 4) - 128) & ~31, mhi0 = t1 >> 4, np0 = ((mhi0 - base0) >> 5) + 1, pz0 = base0 < 0 ? ((-base0) >> 5) : 0;
                    const int base1 = ((t0 >> 2) - 128) & ~31, mhi1 = t1 >> 2, np1 = ((mhi1 - base1) >> 5) + 1, pz1 = base1 < 0 ? ((-base1) >> 5) : 0;
                    const int base2 = (t0 - 128) & ~31, mhi2 = t1, np2 = ((mhi2 - base2) >> 5) + 1, pz2 = base2 < 0 ? ((-base2) >> 5) : 0;
                    const int n0 = np0 - pz0, n1 = np1 - pz1, n2 = np2 - pz2, NT = n0 + n1 + n2;
                    bf16x8 ka[2][2], kb[2][2]; v4u va_[4], vb_[4];
                    const unsigned char* ubb = (const unsigned char*)ub;
                    const unsigned koff = (unsigned)(UK + 8 * g4) * 2u, voff = (unsigned)(UV + 8 * (lane & 7)) * 2u; const int vrow = lane >> 3;
#define ATT_ITEM(it, LR, MB, MHI, RHO) do { if ((it) < n0) { LR = 4; MB = base0 + 32 * (np0 - 1 - (it)); MHI = mhi0; RHO = c; } \
                        else if ((it) < n0 + n1) { LR = 2; MB = base1 + 32 * (pz1 + (it) - n0); MHI = mhi1; RHO = c & 3; } \
                        else { LR = 0; MB = base2 + 32 * (pz2 + (it) - n0 - n1); MHI = mhi2; RHO = 0; } } while (0)
#define ATT_CLAMP(x, hi) __builtin_amdgcn_med3 ## _i(x, hi)
#define ATT_LOAD(K_, V_, LR, MB, MHI, RHO) do { _Pragma("unroll") for (int tau = 0; tau < 2; ++tau) { int mk = (MB) + 16 * tau + ql; mk = max(0, min(mk, (MHI))); \
                            const unsigned char* kp = ubb + ((unsigned)((mk << (LR)) + (RHO)) * (unsigned)(NU * 2) + koff); K_[tau][0] = *(const bf16x8*)kp; K_[tau][1] = *(const bf16x8*)(kp + 64); } \
                        _Pragma("unroll") for (int j = 0; j < 4; ++j) { int mv = (MB) + vrow + 8 * j; mv = max(0, min(mv, (MHI))); \
                            V_[j] = *(const v4u*)(ubb + ((unsigned)((mv << (LR)) + (RHO)) * (unsigned)(NU * 2) + voff)); } } while (0)
#define ATT_STEP(KC_, VC_, KN_, VN_) do { \
                        int lrn = lr, mbn = mb, mhin = mhi, rhon = rho; \
                        if (it + 1 < NT) { ATT_ITEM(it + 1, lrn, mbn, mhin, rhon); ATT_LOAD(KN_, VN_, lrn, mbn, mhin, rhon); } \
                        { LAS unsigned char* vd = vst + vrow * 160 + (lane & 7) * 16; \
                          _Pragma("unroll") for (int j = 0; j < 4; ++j) *(LAS v4u*)(vd + j * 8 * 160) = VC_[j]; } \
                        f32x4 s[2]; \
                        _Pragma("unroll") for (int tau = 0; tau < 2; ++tau) { s[tau] = MFMA16(KC_[tau][0], qf0, ((f32x4){0.f, 0.f, 0.f, 0.f})); s[tau] = MFMA16(KC_[tau][1], qf1, s[tau]); } \
                        const int d0 = (tq >> lr) - mb - 4 * g4; const int kneg = -(mb + 4 * g4); float tmax = -INFINITY; float bias_[2][4]; \
                        _Pragma("unroll") for (int tau = 0; tau < 2; ++tau) \
                            _Pragma("unroll") for (int rg = 0; rg < 4; ++rg) { const int dcl = max(0, min(d0 - (16 * tau + rg), 128)); bias_[tau][rg] = blh[dcl << lr]; } \
                        asm volatile("" : "+v"(bias_[0][0]), "+v"(bias_[0][1]), "+v"(bias_[0][2]), "+v"(bias_[0][3]), "+v"(bias_[1][0]), "+v"(bias_[1][1]), "+v"(bias_[1][2]), "+v"(bias_[1][3]));   \
                        _Pragma("unroll") for (int tau = 0; tau < 2; ++tau) \
                            _Pragma("unroll") for (int rg = 0; rg < 4; ++rg) { const int dist = d0 - (16 * tau + rg); const bool ok = ((unsigned)dist <= 128u) && ((16 * tau + rg) >= kneg); \
                                const float v = ok ? s[tau][rg] + bias_[tau][rg] : -INFINITY; s[tau][rg] = v; tmax = fmaxf(tmax, v); } \
                        if (__any(tmax > m_ref + 16.0f)) { \
                            float tm = fmaxf(tmax, __shfl_xor(tmax, 16)); tm = fmaxf(tm, __shfl_xor(tm, 32)); \
                            const float mn = fmaxf(m_ref, tm); const float ms = (mn == -INFINITY) ? 0.f : mn; const float alpha = __builtin_amdgcn_exp2f(m_ref - ms); m_ref = ms; \
                            l_run *= alpha; \
                            _Pragma("unroll") for (int d = 0; d < 4; ++d) o[d] = o[d] * alpha; \
                        } \
                        float ps = 0.f; \
                        _Pragma("unroll") for (int tau = 0; tau < 2; ++tau) \
                            _Pragma("unroll") for (int rg = 0; rg < 4; ++rg) { const float p = __builtin_amdgcn_exp2f(s[tau][rg] - m_ref); s[tau][rg] = p; ps += p; } \
                        l_run += ps; \
                        const bf16x8 pb = pack8(s[0], s[1]); \
                        asm volatile("" ::: "memory"); \
                        _Pragma("unroll") for (int d = 0; d < 4; ++d) { const bf16x8 vf = frag_trp(vst, 160, 16 * d, 0, lane); o[d] = MFMA16(vf, pb, o[d]); } \
                        asm volatile("" ::: "memory"); \
                        lr = lrn; mb = mbn; mhi = mhin; rho = rhon; ++it; } while (0)
                    int lr, mb, mhi, rho; ATT_ITEM(0, lr, mb, mhi, rho); ATT_LOAD(ka, va_, lr, mb, mhi, rho);
                    float m_ref = -INFINITY, l_run = 0.f; f32x4 o[4];
#pragma unroll
                    for (int d = 0; d < 4; ++d) o[d] = (f32x4){0.f, 0.f, 0.f, 0.f};
                    for (int it = 0; it < NT;) {
                        ATT_STEP(ka, va_, kb, vb_);
                        if (it >= NT) break;
                        ATT_STEP(kb, vb_, ka, va_);
                    }
#undef ATT_ITEM
#undef ATT_LOAD
#undef ATT_STEP
#undef ATT_CLAMP
                    l_run += __shfl_xor(l_run, 16); l_run += __shfl_xor(l_run, 32); const float inv = 1.0f / l_run;
                    bf16* op = MIX + (rowb + tq) * D + h * 64 + 4 * g4;
#pragma unroll
                    for (int d = 0; d < 4; ++d) { pg8::u32x2 w; w.x = pg8::cvt_pk_bf16(o[d][0] * inv, o[d][1] * inv); w.y = pg8::cvt_pk_bf16(o[d][2] * inv, o[d][3] * inv); *(pg8::u32x2*)(op + 16 * d) = w; }
                }
            }
            for (int u = bx; u < 1024; u += G) {
                const int h = u & 3, n = (u >> 2) & 31, b = u >> 7;
                unsigned* cw = (unsigned*)(ws + WS_CTL) + CW_SC + (b * 4 + h) * 64; unsigned* tmo = (unsigned*)(ws + WS_CTL) + CW_TMO2; const unsigned need = 32u * (unsigned)(layer + 1);
                if (wave == 0) { unsigned sp = 0; while (__hip_atomic_load(cw, __ATOMIC_RELAXED, __HIP_MEMORY_SCOPE_AGENT) < need) { __builtin_amdgcn_s_sleep(2);
                        if ((++sp & 255u) == 0u) { if (__hip_atomic_load(tmo, __ATOMIC_RELAXED, __HIP_MEMORY_SCOPE_AGENT) != 0u) break; if (sp > (1u << 20)) { __hip_atomic_store(tmo, 1u, __ATOMIC_RELAXED, __HIP_MEMORY_SCOPE_AGENT); break; } } } }
                __syncthreads();
                if (tid < 256) { const int idx = n * 256 + tid; float cc[32], dd[32];
                    float* cp = CST + (size_t)(b * 128 + h) * 8192 + idx; const float* dp = DEC + (b * 128 + h) * 64 + (idx & 63);
#pragma unroll
                    for (int m2 = 0; m2 < 32; ++m2) { cc[m2] = __hip_atomic_load(cp + (size_t)m2 * 4 * 8192, __ATOMIC_RELAXED, __HIP_MEMORY_SCOPE_AGENT); dd[m2] = __hip_atomic_load(dp + m2 * 4 * 64, __ATOMIC_RELAXED, __HIP_MEMORY_SCOPE_AGENT); }
                    float S = 0.f;
#pragma unroll
                    for (int m2 = 0; m2 < 32; ++m2) { cp[(size_t)m2 * 4 * 8192] = S; S = dd[m2] * S + cc[m2]; } }
            }
        }
        SEAM(pb + 1);
        if (IN(pb + 3)) {
            const int tid = pg8::tid_here(), lane = tid & 63; (void)lane;
            float* cum = (float*)lds; float* seg = cum + 4096;
            LAS unsigned char* qel = ldsl + 18432;
            LAS unsigned char* kel = ldsl + 27648;
            LAS unsigned char* vvl = ldsl + 36864;
            LAS unsigned char* stl = ldsl + 54272;
            float* rsq = (float*)(lds + 72704);
            const float* gn = args.gla_g_norm + layer * 128;
            for (int rep_ = 0; rep_ < 1 + ((pad_ >> 8) & 1); ++rep_)
            for (int u = bx; u < 1024; u += G) {
                const int h = u & 3, n = (u >> 2) & 31, b = u >> 7; const size_t row0 = (size_t)b * SEQ + n * 64;
                const int tr = tid >> 3, c8 = tid & 7;
                const v4u qraw = *(const v4u*)(U + (row0 + tr) * NU + UGQ + h * 64 + 8 * c8), kraw = *(const v4u*)(U + (row0 + tr) * NU + UGK + h * 64 + 8 * c8);
                const v4u* vp = (const v4u*)(U + (row0 + tr) * NU + UGV + h * 128 + c8 * 16); const v4u x0 = vp[0], x1 = vp[1];
                const int sv = tid >> 2, skq = (tid & 3) * 16; const f32x4* sp = (const f32x4*)(CST + ((size_t)u * 128 + sv) * 64 + skq);
                const f32x4 a0 = sp[0], a1 = sp[1], a2 = sp[2], a3 = sp[3];
                { float c = 0.f; float lav[8]; const float* lap = (const float*)(ws + WS_LA) + (row0 + 8 * wave) * 256 + h * 64 + lane;
#pragma unroll
                  for (int i = 0; i < 8; ++i) lav[i] = lap[i * 256];
#pragma unroll
                  for (int i = 0; i < 8; ++i) { c += lav[i]; cum[(8 * wave + i) * 64 + lane] = c; }
                  seg[wave * 64 + lane] = c; }
                __syncthreads();
                { f32x4 offa = (f32x4){0.f, 0.f, 0.f, 0.f}, offb = offa; const int wq = tr >> 3;
#pragma unroll
                  for (int w = 0; w < 7; ++w) { if (w < wq) { offa += *(const f32x4*)(seg + w * 64 + 8 * c8); offb += *(const f32x4*)(seg + w * 64 + 8 * c8 + 4); } }
                  const f32x4 ca = *(const f32x4*)(cum + tr * 64 + 8 * c8) + offa, cb = *(const f32x4*)(cum + tr * 64 + 8 * c8 + 4) + offb;
                  float ea[8];
#pragma unroll
                  for (int j = 0; j < 4; ++j) { ea[j] = fexp_(ca[j]); ea[4 + j] = fexp_(cb[j]); }
                  v4u wq_, wk_;
                  wq_.x = pk2(bflo(qraw.x) * ea[0], bfhi(qraw.x) * ea[1]); wq_.y = pk2(bflo(qraw.y) * ea[2], bfhi(qraw.y) * ea[3]); wq_.z = pk2(bflo(qraw.z) * ea[4], bfhi(qraw.z) * ea[5]); wq_.w = pk2(bflo(qraw.w) * ea[6], bfhi(qraw.w) * ea[7]);
                  float ia[8];
#pragma unroll
                  for (int j = 0; j < 8; ++j) ia[j] = __builtin_amdgcn_rcpf(ea[j]);
                  wk_.x = pk2(bflo(kraw.x) * ia[0], bfhi(kraw.x) * ia[1]); wk_.y = pk2(bflo(kraw.y) * ia[2], bfhi(kraw.y) * ia[3]); wk_.z = pk2(bflo(kraw.z) * ia[4], bfhi(kraw.z) * ia[5]); wk_.w = pk2(bflo(kraw.w) * ia[6], bfhi(kraw.w) * ia[7]);
                  *(LAS v4u*)(qel + tr * 144 + c8 * 16) = wq_; *(LAS v4u*)(kel + tr * 144 + c8 * 16) = wk_;
                  LAS v4u* vd = (LAS v4u*)(vvl + tr * 272 + c8 * 32); vd[0] = x0; vd[1] = x1;
                  v4u w0, w1; w0.x = pk2(a0[0], a0[1]); w0.y = pk2(a0[2], a0[3]); w0.z = pk2(a1[0], a1[1]); w0.w = pk2(a1[2], a1[3]);
                  w1.x = pk2(a2[0], a2[1]); w1.y = pk2(a2[2], a2[3]); w1.z = pk2(a3[0], a3[1]); w1.w = pk2(a3[2], a3[3]);
                  LAS v4u* sd = (LAS v4u*)(stl + sv * 144 + skq * 2); sd[0] = w0; sd[1] = w1; }
                __syncthreads();
                { const int tt = wave & 3, vh = wave >> 2, ql = lane & 15, g4 = lane >> 4; const int t = 16 * tt + ql;
                  const bf16x8 qb0 = frag_rm(qel, 144, 16 * tt, 0, lane), qb1 = frag_rm(qel, 144, 16 * tt, 32, lane);
                  f32x4 sT[4];
#pragma unroll
                  for (int st = 0; st < 4; ++st) { sT[st] = (f32x4){0.f, 0.f, 0.f, 0.f};
                      if (st <= tt) { sT[st] = MFMA16(frag_rm(kel, 144, 16 * st, 0, lane), qb0, sT[st]); sT[st] = MFMA16(frag_rm(kel, 144, 16 * st, 32, lane), qb1, sT[st]);
#pragma unroll
                          for (int rg = 0; rg < 4; ++rg) if (16 * st + 4 * g4 + rg > t) sT[st][rg] = 0.f; } }
                  const bf16x8 pb0 = pack8(sT[0], sT[1]), pb1 = pack8(sT[2], sT[3]);
                  f32x4 acc[4]; float ss = 0.f;
#pragma unroll
                  for (int vt = 0; vt < 4; ++vt) { const int V0 = 16 * (4 * vh + vt); f32x4 a = (f32x4){0.f, 0.f, 0.f, 0.f};
                      a = MFMA16(frag_trp(vvl, 272, V0, 0, lane), pb0, a); a = MFMA16(frag_trp(vvl, 272, V0, 32, lane), pb1, a);
                      a = MFMA16(frag_rm(stl, 144, V0, 0, lane), qb0, a); a = MFMA16(frag_rm(stl, 144, V0, 32, lane), qb1, a);
                      acc[vt] = a; ss += (a[0] * a[0] + a[1] * a[1]) + (a[2] * a[2] + a[3] * a[3]); }
                  ss += __shfl_xor(ss, 16); ss += __shfl_xor(ss, 32);
                  if (g4 == 0) rsq[(tt * 2 + vh) * 16 + ql] = ss;
                  __syncthreads();
                  const float rs = 1.0f / sqrtf((rsq[(tt * 2) * 16 + ql] + rsq[(tt * 2 + 1) * 16 + ql]) * (1.0f / 128.0f) + pg8::RMS_EPS);
#pragma unroll
                  for (int vt = 0; vt < 4; ++vt) { const int v0 = 16 * (4 * vh + vt) + 4 * g4;
                      const pg8::u32x2 gr = *(const pg8::u32x2*)(U + (row0 + t) * NU + UGR + h * 128 + v0); const f32x4 gv = *(const f32x4*)(gn + v0);
                      const float o0 = acc[vt][0] * rs * gv[0] * pg8::silu_f(bflo(gr.x)), o1 = acc[vt][1] * rs * gv[1] * pg8::silu_f(bfhi(gr.x));
                      const float o2 = acc[vt][2] * rs * gv[2] * pg8::silu_f(bflo(gr.y)), o3 = acc[vt][3] * rs * gv[3] * pg8::silu_f(bfhi(gr.y));
                      pg8::u32x2 w; w.x = pg8::cvt_pk_bf16(o0, o1); w.y = pg8::cvt_pk_bf16(o2, o3);
                      *(pg8::u32x2*)(MIX + (row0 + t) * D + 256 + h * 128 + v0) = w; } }
                __syncthreads();
            }
        }
        SEAM(pb + 3);
        if (IN(pb + 4)) {
            pg8::Gemm g{MIX, (const bf16*)(ws + WS_WOUT) + (size_t)layer * D * D, M, D, D, D}; pg8::StaticOrder S; S.init(M, D, G, bx);
            if constexpr (layer == 0) { pg8::EpiRes<true> E{args.x, XBD, SSD}; pg8::gemm_phase<pg8::EpiRes<true>, pg8::StaticOrder, true, true>(ldsl, g, S, E, noepi); }
            else { pg8::EpiRes<false> E{XB, XBD, SSD}; pg8::gemm_phase<pg8::EpiRes<false>, pg8::StaticOrder, true, true>(ldsl, g, S, E, noepi); }
        }
        SEAM(pb + 4);
        if (layer == 0) {
            if (IN(pb + 5)) {
                pg8::Gemm g{XB, W13, M, 2 * FF, D, D}; pg8::StaticOrder S; S.init(M, 2 * FF, G, bx);
                pg8::EpiGlu<false> E{H, FF, SS};
                pg8::gemm_phase<pg8::EpiGlu<false>, pg8::StaticOrder, true, true>(ldsl, g, S, E, noepi);
            }
            SEAM(pb + 5);
            if (IN(pb + 6)) {
                pg8::Gemm g{H, W2, M, D, FF, FF}; pg8::StaticOrder S; S.init(M, D, G, bx);
#if defined(PROBE_EPI) && PROBE_EPI
                if (dry) { pg8::EpiRes<false, PROBE_EPI> E{XB, XBD, SSD}; pg8::gemm_phase<pg8::EpiRes<false, PROBE_EPI>, pg8::StaticOrder, true, true>(ldsl, g, S, E, noepi); } else
#endif
                { pg8::EpiRes<false> E{XB, XBD, SSD}; pg8::gemm_phase<pg8::EpiRes<false>, pg8::StaticOrder, true, true>(ldsl, g, S, E, noepi); }
            }
            SEAM(pb + 6);
        } else {
            for (int rp_ = 0; rp_ < 1 + ((pad_ >> 14) & 1); ++rp_)
            if (IN(pb + 5)) {
                const int tid = pg8::tid_here(), lane = tid & 63; (void)lane;
                float* wr_l = (float*)lds;
                int* cnt_l = (int*)(lds + 32768);
                const float* gf = args.g_ffn + D;
                { f32x4 ra[2][2]; float gk[2];
#pragma unroll
                  for (int j = 0; j < 2; ++j) { const int k = tid + NTHR * j; ra[j][0] = *(const f32x4*)(args.moe_router + k * 8); ra[j][1] = *(const f32x4*)(args.moe_router + k * 8 + 4); gk[j] = gf[k]; }
#pragma unroll
                  for (int j = 0; j < 2; ++j) { const int k = tid + NTHR * j;
#pragma unroll
                      for (int e = 0; e < 4; ++e) { wr_l[e * D + k] = ra[j][0][e] * gk[j]; wr_l[(4 + e) * D + k] = ra[j][1][e] * gk[j]; } } }
                if (tid < 8) cnt_l[tid] = 0;
                __syncthreads();
                for (int blk = bx; blk < 256; blk += G) {
                    if (blk != bx) { __syncthreads(); if (tid < 8) cnt_l[tid] = 0; __syncthreads(); }
                    v4u xpre[8][2];
#pragma unroll
                    for (int i = 0; i < 8; ++i) { const v4u* xr = (const v4u*)(XB + (size_t)(blk * 64 + wave * 8 + i) * D) + lane; xpre[i][0] = xr[0]; xpre[i][1] = xr[64]; }
                    const int mi = blk * 64 + wave * 8 + (lane >> 3);
                    typedef float f32x2_t __attribute__((ext_vector_type(2))); const f32x2_t ssp = *(const f32x2_t*)(SS + (size_t)mi * 16 + 2 * (lane & 7));
                    float v[64];
#pragma unroll
                    for (int q = 0; q < 64; ++q) v[q] = 0.f;
#pragma unroll
                    for (int eh = 0; eh < 2; ++eh) { f32x4 w[4][2][2];
#pragma unroll
                        for (int e = 0; e < 4; ++e)
#pragma unroll
                            for (int j = 0; j < 2; ++j) { const float* wp = wr_l + (4 * eh + e) * D + 8 * (lane + 64 * j); w[e][j][0] = *(const f32x4*)wp; w[e][j][1] = *(const f32x4*)(wp + 4); }
#pragma unroll
                        for (int i = 0; i < 8; ++i)
#pragma unroll
                            for (int j = 0; j < 2; ++j) { const v4u xw = xpre[i][j];
                                const f32x4 va = (f32x4){bflo(xw.x), bfhi(xw.x), bflo(xw.y), bfhi(xw.y)}, vb = (f32x4){bflo(xw.z), bfhi(xw.z), bflo(xw.w), bfhi(xw.w)};
#pragma unroll
                                for (int e = 0; e < 4; ++e) v[i * 8 + 4 * eh + e] += ((va[0] * w[e][j][0][0] + va[1] * w[e][j][0][1]) + (va[2] * w[e][j][0][2] + va[3] * w[e][j][0][3])) + ((vb[0] * w[e][j][1][0] + vb[1] * w[e][j][1][1]) + (vb[2] * w[e][j][1][2] + vb[3] * w[e][j][1][3])); } }
#pragma unroll
                    for (int st = 32; st >= 1; st >>= 1) { const bool up = (lane & st) != 0;
#pragma unroll
                        for (int q = 0; q < st; ++q) { const float send = up ? v[q] : v[q + st]; const float keep = up ? v[q + st] : v[q]; v[q] = keep + __shfl_xor(send, st); } }
                    float ssq = ssp[0] + ssp[1]; ssq += __shfl_xor(ssq, 1); ssq += __shfl_xor(ssq, 2); ssq += __shfl_xor(ssq, 4);
                    const float rs = 1.0f / sqrtf(ssq * (1.0f / 1024.0f) + pg8::RMS_EPS);
                    const float lg = v[0] * rs; const int me = lane & 7;
                    float bv = lg; int bi = me;
#pragma unroll
                    for (int st = 1; st < 8; st <<= 1) { const float ov = __shfl_xor(bv, st); const int oi = __shfl_xor(bi, st); if (ov > bv || (ov == bv && oi < bi)) { bv = ov; bi = oi; } }
                    float cv = (me == bi) ? -INFINITY : lg; int ci = me;
#pragma unroll
                    for (int st = 1; st < 8; st <<= 1) { const float ov = __shfl_xor(cv, st); const int oi = __shfl_xor(ci, st); if (ov > cv || (ov == cv && oi < ci)) { cv = ov; ci = oi; } }
                    if (me == 0) { const float w1 = 1.0f / (1.0f + fexp_(bv - cv)), w0 = 1.0f - w1;
                        TOPI[mi * 2] = bi; TOPI[mi * 2 + 1] = ci; TOPW[mi * 2] = w0; TOPW[mi * 2 + 1] = w1; RS3[mi] = rs; atomicAdd(&cnt_l[bi], 1); atomicAdd(&cnt_l[ci], 1); }
                    __syncthreads();
                    if (tid < 8) CNT[blk * 8 + tid] = cnt_l[tid];
                }
            }
            SEAM(pb + 5);
            for (int rp_ = 0; rp_ < 1 + ((pad_ >> 15) & 1); ++rp_)
            if (IN(pb + 6)) {
                const int tid = pg8::tid_here(), lane = tid & 63; (void)lane;
                int* base_l = (int*)lds;
                int* pre_l = base_l + 8;
                int* tot_l = pre_l + 8;
                int* pos_l = tot_l + 8;
                int* ent_l = pos_l + 128;
                for (int blk = bx; blk < 256; blk += G) {
                    __syncthreads();
                    if (tid < 8) { tot_l[tid] = 0; pre_l[tid] = 0; }
                    if (tid < 128) ent_l[tid] = TOPI[blk * 128 + tid];
                    __syncthreads();
                    { const int g2 = tid >> 1, e0 = (tid & 1) * 4; const int4 c = *(const int4*)(CNT + g2 * 8 + e0);
                      atomicAdd(&tot_l[e0], c.x); atomicAdd(&tot_l[e0 + 1], c.y); atomicAdd(&tot_l[e0 + 2], c.z); atomicAdd(&tot_l[e0 + 3], c.w);
                      if (g2 < blk) { atomicAdd(&pre_l[e0], c.x); atomicAdd(&pre_l[e0 + 1], c.y); atomicAdd(&pre_l[e0 + 2], c.z); atomicAdd(&pre_l[e0 + 3], c.w); } }
                    __syncthreads();
                    if (tid == 0) { int bs = 0; for (int e = 0; e < 8; ++e) { base_l[e] = bs; bs += (tot_l[e] + 255) & ~255; } }
                    __syncthreads();
                    if (tid < 128) { const int e = ent_l[tid]; int rank = 0; for (int j = 0; j < tid; ++j) rank += (ent_l[j] == e) ? 1 : 0;
                        const int p = base_l[e] + pre_l[e] + rank; pos_l[tid] = p; POS[blk * 128 + tid] = p; ROWGATE[p] = TOPW[blk * 128 + tid]; ROWRS[p] = RS3[blk * 64 + (tid >> 1)]; }
                    if (blk == 0) {
                        for (int e = 0; e < 8; ++e) { const int npe = (tot_l[e] + 255) >> 8; for (int p = base_l[e] + tot_l[e] + tid; p < base_l[e] + npe * 256; p += NTHR) { ROWGATE[p] = 0.f; ROWRS[p] = 0.f; } }
                        if (tid == 0) { int np = 0; for (int e = 0; e < 8; ++e) { const int npe = (tot_l[e] + 255) >> 8; for (int j = 0; j < npe; ++j) PANE[np++] = e; } PANE[MAXPAN] = np; } }
                    __syncthreads();
                    for (int i = 0; i < 16; ++i) { const int sl = wave * 16 + i; const int m = blk * 64 + (sl >> 1); const int p = pos_l[sl];
                        const v4u* s = (const v4u*)(XB + (size_t)m * D) + lane; v4u* d = (v4u*)(XS + (size_t)p * D) + lane; d[0] = s[0]; d[64] = s[64]; }
                }
            }
            SEAM(pb + 6);
            if (IN(pb + 7)) {
                pg8::Gemm g{XS, WE13, MAXROWS, 2 * FE, D, D}; pg8::MoeOrder S{PANE, PANE[MAXPAN], 28, 4, G, bx};
                pg8::EpiGlu<true> E{HE, FE, ROWRS};
                pg8::gemm_phase<pg8::EpiGlu<true>, pg8::MoeOrder, true, true>(ldsl, g, S, E, noepi);
                { const int lane = pg8::tid_here() & 63; unsigned* scr = (unsigned*)(lds + wave * 8704); unsigned* qh = (unsigned*)(ws + WS_CTL) + CW_W2Q;
                  constexpr int T_J = 56 * 16, NTJ = 8 * T_J;
                  for (;;) { int t0 = 0; if (lane == 0) t0 = (int)__hip_atomic_fetch_add(qh, 4u, __ATOMIC_RELAXED, __HIP_MEMORY_SCOPE_AGENT); t0 = __builtin_amdgcn_readfirstlane(t0);
                      if (t0 >= NTJ) break;
                      for (int it = t0; it < t0 + 4 && it < NTJ; ++it) { const int e = it / T_J, r = it % T_J;
                          transpose_tile(args.moe_w2 + (size_t)e * FE * D, D, 64 * (r / 16), 64 * (r % 16), WE2 + (size_t)e * D * FE, FE, 64 * (r % 16), nullptr, scr, lane); } } }
            }
            SEAM(pb + 7);
            if (IN(pb + 9)) {
                const int npan = PANE[MAXPAN]; int npf = ((npan * 4) / G) * G / 4; if (npan - npf > 8 || npf == 0) npf = npan;
                { pg8::Gemm g{HE, WE2, MAXROWS, D, FE, FE}; pg8::MoeOrder S{PANE, npf, 4, 8, G, bx};
                  pg8::EpiMoeDown E{Y, ROWGATE};
                  pg8::gemm_phase<pg8::EpiMoeDown, pg8::MoeOrder, true, true>(ldsl, g, S, E, noepi); }
                if (npan > npf) { __syncthreads();
                  pg8::Gemm g{HE, WE2, MAXROWS, D, 896, FE}; pg8::MoeTailOrder S{PANE, npf, npan - npf, G, bx};
                  pg8::EpiMoeDownPart E{(float*)(ws + WS_YT), ROWGATE, npf * 256};
                  pg8::gemm_phase<pg8::EpiMoeDownPart, pg8::MoeTailOrder, true, true>(ldsl, g, S, E, noepi); }
            }
            SEAM(pb + 9);
            if (IN(pb + 10)) {
                const int tid = pg8::tid_here(), lane = tid & 63; (void)lane;
                const int npan_f = PANE[MAXPAN]; int npf_f = ((npan_f * 4) / G) * G / 4; if (npan_f - npf_f > 8 || npf_f == 0) npf_f = npan_f; const int tail0 = npf_f * 256;
                for (int rep_ = 0; rep_ < 1 + ((pad_ >> 12) & 1); ++rep_)
                for (int m = gw; m < M; m += NGW) {
                    f32x4* xr = (f32x4*)(X + (size_t)m * D) + lane; const int p0 = POS[m * 2], p1 = POS[m * 2 + 1];
                    const unsigned long long* xb = (const unsigned long long*)(XB + (size_t)m * D) + lane;
                    f32x4 v[4]; float s = 0.f;
#pragma unroll
                    for (int j = 0; j < 4; ++j) { const unsigned long long xw = xb[64 * j]; v[j] = (f32x4){bflo((unsigned)xw), bfhi((unsigned)xw), bflo((unsigned)(xw >> 32)), bfhi((unsigned)(xw >> 32))}; }
#pragma unroll
                    for (int sl = 0; sl < 2; ++sl) { const int p = sl ? p1 : p0;
                        if (p < tail0) { const unsigned long long* yp = (const unsigned long long*)(Y + (size_t)p * D) + lane;
#pragma unroll
                            for (int j = 0; j < 4; ++j) { const unsigned long long a = yp[64 * j]; v[j] += (f32x4){bflo((unsigned)a), bfhi((unsigned)a), bflo((unsigned)(a >> 32)), bfhi((unsigned)(a >> 32))}; } }
                        else { const f32x4* tp = (const f32x4*)((const float*)(ws + WS_YT) + (size_t)(p - tail0) * D) + lane;
#pragma unroll
                            for (int kq = 0; kq < 4; ++kq)
#pragma unroll
                                for (int j = 0; j < 4; ++j) v[j] += tp[(size_t)kq * 2048 * (D / 4) + 64 * j]; } }
#pragma unroll
                    for (int j = 0; j < 4; ++j) s += (v[j][0] * v[j][0] + v[j][1] * v[j][1]) + (v[j][2] * v[j][2] + v[j][3] * v[j][3]);
                    const float rs = 1.0f / sqrtf(wave_sum(s) * (1.0f / D) + pg8::RMS_EPS);
                    const f32x4* gf = (const f32x4*)args.g_final + lane;
#pragma unroll
                    for (int j = 0; j < 4; ++j) (dry ? (f32x4*)((float*)(ws + WS_HE) + (size_t)m * D) + lane : xr)[64 * j] = v[j] * rs * gf[64 * j];
                }
            }
        }
}

__global__ void __launch_bounds__(NTHR, 2) hybrid_fwd(Args args) {
    extern __shared__ __attribute__((aligned(16))) unsigned char lds[];
    LAS unsigned char* ldsl = (LAS unsigned char*)lds;
    volatile LAS unsigned* MISC = (volatile LAS unsigned*)(ldsl + MISC_OFF);
    const int tid = threadIdx.x, lane = tid & 63, wave = __builtin_amdgcn_readfirstlane(tid >> 6);
    const int G = gridDim.x; const int bx = blockIdx.x;
    const int gw = bx * NWAVES + wave, NGW = G * NWAVES;
    unsigned char* ws = args.ws;
    for (int u = tid; u < (LDS_BYTES - LDSCTL_OFF) / 4; u += NTHR) ((LAS unsigned*)(ldsl + LDSCTL_OFF))[u] = 0u;
    __syncthreads();
    XcdBarrier bar; bar.bar = (unsigned*)(ws + WS_CTL) + CW_BAR + args.li * XCD_BAR_WORDS; bar.x = 0; bar.st = nullptr;
    if (MK_N_LAUNCHES == 1) bar = xcd_barrier_post((unsigned*)(ws + WS_CTL) + CW_BAR + args.li * XCD_BAR_WORDS, MISC + 8);
    const int lo = args.ph_lo, hi = args.ph_hi;

    WS_PTRS

    for (int rp_ = 0; rp_ < 1 + ((args.pad >> 6) & 1); ++rp_)
    if (IN(0)) {
        unsigned* scr = (unsigned*)(lds + wave * 8704);
        constexpr int T_A = 16 * 36, T_B = 16 * 12, T_D = 16 * 16, T_L = T_A + T_B + T_D;
        constexpr int T_F = 16 * 44, T_G = 44 * 16, T_E = 16 * 56;
        constexpr int NT0 = 2 * T_L + 2 * T_F + T_G + 16 * T_E;
        for (int it = gw; it < NT0; it += NGW) {
            int r = it;
            if (r < 2 * T_L) { const int l = r / T_L; r -= l * T_L; const float* win = args.w_mix_in + (size_t)l * D * INC; const float* gm = args.g_mix + l * D;
                bf16* WIN = (bf16*)(ws + WS_WIN) + (size_t)l * NU * D;
                if (r < T_A) { transpose_tile(win, INC, 64 * (r / 36), 64 * (r % 36), WIN, D, 64 * (r % 36), gm, scr, lane); continue; } r -= T_A;
                if (r < T_B) { transpose_tile(win, INC, 64 * (r / 12), 2320 + 64 * (r % 12), WIN, D, 2304 + 64 * (r % 12), gm, scr, lane); continue; } r -= T_B;
                transpose_tile(args.w_mix_out + (size_t)l * D * D, D, 64 * (r / 16), 64 * (r % 16), (bf16*)(ws + WS_WOUT) + (size_t)l * D * D, D, 64 * (r % 16), nullptr, scr, lane); continue; }
            r -= 2 * T_L;
            if (r < 2 * T_F) { const int w3 = r / T_F; r -= w3 * T_F; const int n0 = 64 * (r % 44);
                transpose_tile(w3 ? args.ffn_w3 : args.ffn_w1, FF, 64 * (r / 44), n0, W13, D, (n0 >> 7) * 256 + (n0 & 127) + 128 * w3, args.g_ffn, scr, lane); continue; }
            r -= 2 * T_F;
            if (r < T_G) { transpose_tile(args.ffn_w2, D, 64 * (r / 16), 64 * (r % 16), W2, FF, 64 * (r % 16), nullptr, scr, lane); continue; }
            r -= T_G;
            { const int ew = r / T_E; r -= ew * T_E; const int e = ew >> 1, w3 = ew & 1; const int n0 = 64 * (r % 56);
              transpose_tile((w3 ? args.moe_w3 : args.moe_w1) + (size_t)e * D * FE, FE, 64 * (r / 56), n0, WE13 + (size_t)e * 2 * FE * D, D, (n0 >> 7) * 256 + (n0 & 127) + 128 * w3, args.g_ffn + D, scr, lane); }
        }
        for (int m = gw; m < M; m += NGW) {
            const f32x4* xr = (const f32x4*)(args.x + (size_t)m * D) + lane; float s = 0.f;
            unsigned long long* o8 = (unsigned long long*)(XB + (size_t)m * D) + lane;
#pragma unroll
            for (int j = 0; j < 4; ++j) { const f32x4 v = xr[64 * j]; s += (v[0] * v[0] + v[1] * v[1]) + (v[2] * v[2] + v[3] * v[3]);
                o8[64 * j] = (unsigned long long)pk2(v[0], v[1]) | ((unsigned long long)pk2(v[2], v[3]) << 32); }
            s = wave_sum(s);
            if (lane < 16) SS[(size_t)m * 16 + lane] = (lane == 0) ? s : 0.f;
        }
        for (int i = bx * NTHR + tid; i < 2049 * 4; i += G * NTHR) { const int d = i >> 2, h = i & 3; BL[i] = args.rel_bias[rel_bucket(d) * 4 + h] * LOG2E; }
        for (int i = bx * NTHR + tid; i < 2 * 16 * D; i += G * NTHR) { const int k = i & (D - 1), r = (i >> 10) & 15, l = i >> 14;
            ((bf16*)(ws + WS_WGLR))[i] = (bf16)f2bf(args.g_mix[l * D + k] * args.w_mix_in[((size_t)l * D + k) * INC + 2304 + r]); }
    }
    SEAM(0);

    Ctx c; c.args = args; c.tid = tid; c.lane = lane; c.wave = wave; c.G = G; c.bx = bx; c.gw = gw; c.NGW = NGW; c.lo = lo; c.hi = hi; c.bar = bar;
    layer_phases<0>(c, lds);
    layer_phases<1>(c, lds);
}
#undef IN
#undef SEAM
#undef GRID_BAR


extern "C" void kernel_launch(void* const* d_in, const int* in_sizes, int n_in, void* d_out, int out_size, void* d_ws, size_t ws_size, hipStream_t stream) {
    static int grid = 0;
    if (grid == 0) {
        if (n_in != 18 || in_sizes[0] != M * D || out_size != M * D || ws_size < WS_END) { fprintf(stderr, "kernel_launch: unexpected shapes / workspace (%zu < %zu)\n", ws_size, (size_t)WS_END); grid = -1; return; }
        int dev = 0, cus = 0, per_cu = 0;
        if (hipGetDevice(&dev) != hipSuccess || hipDeviceGetAttribute(&cus, hipDeviceAttributeMultiprocessorCount, dev) != hipSuccess) { grid = -1; return; }
        if (hipFuncSetAttribute((const void*)hybrid_fwd, hipFuncAttributeMaxDynamicSharedMemorySize, LDS_BYTES) != hipSuccess) { fprintf(stderr, "kernel_launch: hipFuncSetAttribute failed\n"); grid = -1; return; }
        if (hipOccupancyMaxActiveBlocksPerMultiprocessor(&per_cu, (const void*)hybrid_fwd, NTHR, LDS_BYTES) != hipSuccess || per_cu < 1) { fprintf(stderr, "kernel_launch: occupancy query says %d\n", per_cu); }
        (void)hipGetLastError();
        grid = cus;
    }
    if (grid < 0) return;
    if (hipMemsetAsync((char*)d_ws + WS_CTL, 0, CTL_ZERO_BYTES, stream) != hipSuccess) return;
    Args a{};
    const float** f = (const float**)&a;
    for (int i = 0; i < 18; ++i) f[i] = (const float*)d_in[i];
    a.out = (float*)d_out; a.ws = (unsigned char*)d_ws;
    if (MK_N_LAUNCHES == 1) {
#ifndef PROBE_MODE
#define PROBE_MODE 0
#endif
#ifdef PROBE_PHASE
        const int cuts[4][2] = {{0, PROBE_PHASE}, {PROBE_PHASE, PROBE_PHASE + 1}, {PROBE_PHASE, 64}, {0, 0}};
        for (int li = 0; li < 3; ++li) { a.ph_lo = cuts[li][0]; a.ph_hi = cuts[li][1]; a.li = li; a.pad = (li == 1) ? PROBE_MODE : 0; hipLaunchKernelGGL(hybrid_fwd, dim3(grid), dim3(NTHR), LDS_BYTES, stream, a); }
#else
        a.ph_lo = 0; a.ph_hi = 64; a.li = 0;
#ifndef PROBE_LOW
#define PROBE_LOW 0
#endif
#ifdef PROBE_REP
        a.pad = (PROBE_REP << 8) | PROBE_LOW;
#endif
        hipLaunchKernelGGL(hybrid_fwd, dim3(grid), dim3(NTHR), LDS_BYTES, stream, a);
#endif
    }
    else {
        static const int phases[] = {0, 1, 2, 3, 4, 5, 6, 7, 17, 18, 19, 20, 21, 22, 23, 24, 25, 26, 27};
        for (int p : phases) { a.ph_lo = p; a.ph_hi = p + 1; hipLaunchKernelGGL(hybrid_fwd, dim3(grid), dim3(NTHR), LDS_BYTES, stream, a); }
    }
}
```

```cpp
#include <hip/hip_runtime.h>
#include <cstdio>
#include <cstdint>

#ifndef MK_N_LAUNCHES
#define MK_N_LAUNCHES 1
#endif

namespace pg8 {
#define PG8_LAS __attribute__((address_space(3)))
__device__ __forceinline__ int tid_here() { int t = threadIdx.x; asm volatile("" : "+v"(t)); return t; }
typedef unsigned short bf16_t;
typedef short bf16x8 __attribute__((ext_vector_type(8)));
typedef float f32x4 __attribute__((ext_vector_type(4)));
typedef unsigned u32x4 __attribute__((ext_vector_type(4)));
typedef unsigned u32x2 __attribute__((ext_vector_type(2)));
constexpr int BM = 256, BK = 64, HALF = 128, HTB = HALF * BK * 2, STAGE_BYTES = 8 * HTB, NXCD = 8, WGM = 8;

__host__ __device__ __forceinline__ int lds_byte(int r, int c) { const int st = (r >> 4) * 2 + (c >> 5), rr = r & 15, cc = c & 31, ob = rr * 64 + cc * 2; return st * 1024 + (ob ^ (((ob >> 9) & 1) << 5)); }
__host__ __device__ __forceinline__ void stage_rc(int b, int& R, int& C) { const int st = b / 1024, sb = b % 1024, swz = sb ^ (((sb >> 9) & 1) << 5); R = (st >> 1) * 16 + swz / 64; C = (st & 1) * 32 + (swz % 64) / 2; }
__host__ __device__ __forceinline__ int perm32(int rho) { const int n = rho >> 4, i = rho & 15; return 8 * (i >> 2) + 4 * n + (i & 3); }

struct Unit { int pm, pn, ko; };
struct Gemm { const bf16_t* A; const bf16_t* Bt; int M, N, K, ld; };

struct StaticOrder {
    int nM, nN, nwg, G, c;
    __host__ __device__ void init(int M, int N, int G_, int c_) { nM = M / BM; nN = N / BM; nwg = nM * nN; G = G_; c = c_; }
    __host__ __device__ bool next(int i, Unit& u) const {
        const long L = (long)i * G + c; if (L >= nwg) return false;
        int wgid = (int)L; { const int q = nwg / NXCD, r = nwg % NXCD, xcd = wgid % NXCD, off = wgid / NXCD; wgid = (xcd < r ? xcd * (q + 1) : r * (q + 1) + (xcd - r) * q) + off; }
        const int nig = WGM * nN, gid = wgid / nig, fm = gid * WGM, gsz = (nM - fm) < WGM ? (nM - fm) : WGM;
        u.pm = fm + ((wgid % nig) % gsz); u.pn = (wgid % nig) / gsz; u.ko = 0; return true;
    }
    __device__ __forceinline__ void a_ready(const Unit&) const {}
    __device__ __forceinline__ void done(const Unit&) const {}
};
struct MoeOrder {
    const int* panel_e; int npan, NT, GP, G, c;
    __device__ bool next(int i, Unit& u) const {
        const int nwg = npan * NT; const long L = (long)i * G + c; if (L >= nwg) return false;
        int wgid = (int)L; { const int q = nwg / NXCD, r = nwg % NXCD, xcd = wgid % NXCD, off = wgid / NXCD; wgid = (xcd < r ? xcd * (q + 1) : r * (q + 1) + (xcd - r) * q) + off; }
        const int nig = GP * NT, grp = wgid / nig, fm = grp * GP, gsz = (npan - fm) < GP ? (npan - fm) : GP; const int rr = wgid % nig;
        const int p = fm + rr % gsz; u.pm = p; u.pn = panel_e[p] * NT + rr / gsz; u.ko = 0; return true;
    }
    __device__ __forceinline__ void a_ready(const Unit&) const {}
    __device__ __forceinline__ void done(const Unit&) const {}
};

struct MoeTailOrder {
    const int* panel_e; int p0, ntp, G, c;
    __device__ bool next(int i, Unit& u) const {
        const long L = (long)i * G + c; if (L >= (long)ntp * 16) return false;
        const int kq = (int)L & 3, r = (int)L >> 2, p = p0 + (r >> 2); u.pm = p; u.pn = panel_e[p] * 4 + (r & 3); u.ko = kq * 896 * 2; return true;
    }
    __device__ __forceinline__ void a_ready(const Unit&) const {}
    __device__ __forceinline__ void done(const Unit&) const {}
};
typedef float f32x2c_t __attribute__((ext_vector_type(2))); typedef __bf16 bf16x2c_t __attribute__((ext_vector_type(2)));
__device__ __forceinline__ unsigned cvt_pk_bf16(float lo, float hi) { const f32x2c_t v = {lo, hi}; return __builtin_bit_cast(unsigned, __builtin_convertvector(v, bf16x2c_t)); }

constexpr float RMS_EPS = 1e-6f;
__device__ __forceinline__ float rstd_of(const float* ss16) {
    const f32x4 a = *(const f32x4*)ss16, b = *(const f32x4*)(ss16 + 4), c = *(const f32x4*)(ss16 + 8), d = *(const f32x4*)(ss16 + 12);
    const float s = ((a[0] + a[1]) + (a[2] + a[3])) + ((b[0] + b[1]) + (b[2] + b[3])) + ((c[0] + c[1]) + (c[2] + c[3])) + ((d[0] + d[1]) + (d[2] + d[3]));
    return __builtin_amdgcn_rsqf(s * (1.0f / 1024.0f) + RMS_EPS);
}
__device__ __forceinline__ void rstd4(const float* SS, int row0, float (&rs)[4]) {
    f32x4 p[4][4];
#pragma unroll
    for (int m = 0; m < 4; ++m)
#pragma unroll
        for (int q = 0; q < 4; ++q) p[m][q] = *(const f32x4*)(SS + (size_t)(row0 + 16 * m) * 16 + 4 * q);
    asm volatile("" : "+v"(p[0][0]), "+v"(p[0][1]), "+v"(p[0][2]), "+v"(p[0][3]), "+v"(p[1][0]), "+v"(p[1][1]), "+v"(p[1][2]), "+v"(p[1][3]),
                      "+v"(p[2][0]), "+v"(p[2][1]), "+v"(p[2][2]), "+v"(p[2][3]), "+v"(p[3][0]), "+v"(p[3][1]), "+v"(p[3][2]), "+v"(p[3][3]));
#pragma unroll
    for (int m = 0; m < 4; ++m) { const f32x4 a = p[m][0], b = p[m][1], c = p[m][2], d = p[m][3];
        const float s = ((a[0] + a[1]) + (a[2] + a[3])) + ((b[0] + b[1]) + (b[2] + b[3])) + ((c[0] + c[1]) + (c[2] + c[3])) + ((d[0] + d[1]) + (d[2] + d[3]));
        rs[m] = __builtin_amdgcn_rsqf(s * (1.0f / 1024.0f) + RMS_EPS); }
}
__device__ __forceinline__ float logsig16(float x) { return ((x < 0.f ? x : 0.f) - 0.6931471805599453f * __builtin_amdgcn_logf(1.0f + __builtin_amdgcn_exp2f(-1.4426950408889634f * fabsf(x)))) * (1.0f / 16.0f); }
__device__ __forceinline__ float silu_f(float a) { return a * __builtin_amdgcn_rcpf(1.0f + __builtin_amdgcn_exp2f(a * -1.4426950408889634f)); }

struct EpiU {
    static constexpr bool PERM = true, AFTER_DRAIN = false;
    bf16_t* U; int ldu; const float* SS; float qs;
    __device__ __forceinline__ void operator()(const f32x4 (&acc)[2][2][4][2], const Unit& u, int wr, int wc, int fr, int fq) const {
        const int row0 = u.pm * BM + wr * 64 + fr, col0 = u.pn * BM + wc * 32 + 8 * fq;
        const float sc = (u.pn == 0) ? qs : ((u.pn == 3) ? 0.125f : 1.0f);
#pragma unroll
        for (int ai = 0; ai < 2; ++ai) { float rs4[4]; rstd4(SS, row0 + ai * HALF, rs4);
#pragma unroll
            for (int m = 0; m < 4; ++m) { const int row = row0 + ai * HALF + m * 16; const float rs = rs4[m] * sc;
                bf16_t* rowp = U + (size_t)row * ldu + col0;
#pragma unroll
                for (int bj = 0; bj < 2; ++bj) { const f32x4 v0 = acc[ai][bj][m][0] * rs, v1 = acc[ai][bj][m][1] * rs;
                    u32x4 w; w.x = cvt_pk_bf16(v0[0], v0[1]); w.y = cvt_pk_bf16(v0[2], v0[3]); w.z = cvt_pk_bf16(v1[0], v1[1]); w.w = cvt_pk_bf16(v1[2], v1[3]);
                    *(u32x4*)(rowp + bj * HALF) = w; } } }
    }
};
template <bool IN_F32, int PM = 0> struct EpiRes {
    static constexpr bool PERM = true, AFTER_DRAIN = false;
    const void* Xin; bf16_t* XB; float* SS;
    __device__ __forceinline__ void operator()(const f32x4 (&acc)[2][2][4][2], const Unit& u, int wr, int wc, int fr, int fq) const {
        const int row0 = u.pm * BM + wr * 64 + fr, col0 = u.pn * BM + wc * 32 + 8 * fq;
        if constexpr (IN_F32) {
#pragma unroll
            for (int ai = 0; ai < 2; ++ai) { f32x4 xo[4][2][2];
#pragma unroll
                for (int m = 0; m < 4; ++m)
#pragma unroll
                    for (int bj = 0; bj < 2; ++bj) { const float* p = (const float*)Xin + (size_t)(row0 + ai * HALF + m * 16) * 1024 + col0 + bj * HALF; xo[m][bj][0] = *(const f32x4*)p; xo[m][bj][1] = *(const f32x4*)(p + 4); }
                asm volatile("" : "+v"(xo[0][0][0]), "+v"(xo[0][0][1]), "+v"(xo[0][1][0]), "+v"(xo[0][1][1]), "+v"(xo[1][0][0]), "+v"(xo[1][0][1]), "+v"(xo[1][1][0]), "+v"(xo[1][1][1]),
                                  "+v"(xo[2][0][0]), "+v"(xo[2][0][1]), "+v"(xo[2][1][0]), "+v"(xo[2][1][1]), "+v"(xo[3][0][0]), "+v"(xo[3][0][1]), "+v"(xo[3][1][0]), "+v"(xo[3][1][1]));
#pragma unroll
                for (int m = 0; m < 4; ++m) { const int row = row0 + ai * HALF + m * 16; float ssum = 0.f;
#pragma unroll
                    for (int bj = 0; bj < 2; ++bj) { const f32x4 v0 = xo[m][bj][0] + acc[ai][bj][m][0], v1 = xo[m][bj][1] + acc[ai][bj][m][1];
                        u32x4 w; w.x = cvt_pk_bf16(v0[0], v0[1]); w.y = cvt_pk_bf16(v0[2], v0[3]); w.z = cvt_pk_bf16(v1[0], v1[1]); w.w = cvt_pk_bf16(v1[2], v1[3]);
                        *(u32x4*)(XB + (size_t)row * 1024 + col0 + bj * HALF) = w;
                        ssum += ((v0[0] * v0[0] + v0[1] * v0[1]) + (v0[2] * v0[2] + v0[3] * v0[3])) + ((v1[0] * v1[0] + v1[1] * v1[1]) + (v1[2] * v1[2] + v1[3] * v1[3])); }
                    ssum += __shfl_xor(ssum, 16); ssum += __shfl_xor(ssum, 32);
                    if (fq == 0) SS[(size_t)row * 16 + u.pn * 4 + wc] = ssum; } }
        } else {
            u32x4 xo[2][4][2];
#pragma unroll
            for (int ai = 0; ai < 2; ++ai)
#pragma unroll
                for (int m = 0; m < 4; ++m)
#pragma unroll
                    for (int bj = 0; bj < 2; ++bj) xo[ai][m][bj] = *(const u32x4*)((const bf16_t*)Xin + (size_t)(row0 + ai * HALF + m * 16) * 1024 + col0 + bj * HALF);
            asm volatile("" : "+v"(xo[0][0][0]), "+v"(xo[0][0][1]), "+v"(xo[0][1][0]), "+v"(xo[0][1][1]), "+v"(xo[0][2][0]), "+v"(xo[0][2][1]), "+v"(xo[0][3][0]), "+v"(xo[0][3][1]),
                              "+v"(xo[1][0][0]), "+v"(xo[1][0][1]), "+v"(xo[1][1][0]), "+v"(xo[1][1][1]), "+v"(xo[1][2][0]), "+v"(xo[1][2][1]), "+v"(xo[1][3][0]), "+v"(xo[1][3][1]));
#pragma unroll
            for (int ai = 0; ai < 2; ++ai)
#pragma unroll
                for (int m = 0; m < 4; ++m) { const int row = row0 + ai * HALF + m * 16; float ssum = 0.f;
#pragma unroll
                    for (int bj = 0; bj < 2; ++bj) { const u32x4 x = xo[ai][m][bj]; f32x4 v0, v1;
                        v0[0] = __builtin_bit_cast(float, x.x << 16) + acc[ai][bj][m][0][0]; v0[1] = __builtin_bit_cast(float, x.x & 0xffff0000u) + acc[ai][bj][m][0][1];
                        v0[2] = __builtin_bit_cast(float, x.y << 16) + acc[ai][bj][m][0][2]; v0[3] = __builtin_bit_cast(float, x.y & 0xffff0000u) + acc[ai][bj][m][0][3];
                        v1[0] = __builtin_bit_cast(float, x.z << 16) + acc[ai][bj][m][1][0]; v1[1] = __builtin_bit_cast(float, x.z & 0xffff0000u) + acc[ai][bj][m][1][1];
                        v1[2] = __builtin_bit_cast(float, x.w << 16) + acc[ai][bj][m][1][2]; v1[3] = __builtin_bit_cast(float, x.w & 0xffff0000u) + acc[ai][bj][m][1][3];
                        u32x4 w; w.x = cvt_pk_bf16(v0[0], v0[1]); w.y = cvt_pk_bf16(v0[2], v0[3]); w.z = cvt_pk_bf16(v1[0], v1[1]); w.w = cvt_pk_bf16(v1[2], v1[3]);
                        if constexpr (!(PM & 8)) *(u32x4*)(XB + (size_t)row * 1024 + col0 + bj * HALF) = w;
                        ssum += ((v0[0] * v0[0] + v0[1] * v0[1]) + (v0[2] * v0[2] + v0[3] * v0[3])) + ((v1[0] * v1[0] + v1[1] * v1[1]) + (v1[2] * v1[2] + v1[3] * v1[3])); }
                    if constexpr (!(PM & 16)) { ssum += __shfl_xor(ssum, 16); ssum += __shfl_xor(ssum, 32); }
                    if constexpr (!(PM & 4)) { if (fq == 0) SS[(size_t)row * 16 + u.pn * 4 + wc] = ssum; }
                    if constexpr ((PM & 12) == 12) asm volatile("" :: "v"(ssum)); }
        }
    }
};
template <bool MOE> struct EpiGlu {
    static constexpr bool PERM = true, AFTER_DRAIN = false;
    bf16_t* O; int ldo; const float* SS;
    __device__ __forceinline__ void operator()(const f32x4 (&acc)[2][2][4][2], const Unit& u, int wr, int wc, int fr, int fq) const {
        const int row0 = u.pm * BM + wr * 64 + fr; const int pnl = MOE ? (u.pn % 28) : u.pn; const int col0 = pnl * HALF + wc * 32 + 8 * fq;
#pragma unroll
        for (int ai = 0; ai < 2; ++ai) { float rs4[4];
            if constexpr (MOE) {
#pragma unroll
                for (int m = 0; m < 4; ++m) rs4[m] = SS[row0 + ai * HALF + m * 16];
                asm volatile("" : "+v"(rs4[0]), "+v"(rs4[1]), "+v"(rs4[2]), "+v"(rs4[3]));
            } else rstd4(SS, row0 + ai * HALF, rs4);
#pragma unroll
            for (int m = 0; m < 4; ++m) { const int row = row0 + ai * HALF + m * 16; const float rs = rs4[m];
                const f32x4 a0 = acc[ai][0][m][0] * rs, a1 = acc[ai][0][m][1] * rs, b0 = acc[ai][1][m][0] * rs, b1 = acc[ai][1][m][1] * rs;
                f32x4 g0, g1;
#pragma unroll
                for (int j = 0; j < 4; ++j) { g0[j] = silu_f(a0[j]) * b0[j]; g1[j] = silu_f(a1[j]) * b1[j]; }
                u32x4 w; w.x = cvt_pk_bf16(g0[0], g0[1]); w.y = cvt_pk_bf16(g0[2], g0[3]); w.z = cvt_pk_bf16(g1[0], g1[1]); w.w = cvt_pk_bf16(g1[2], g1[3]);
                *(u32x4*)(O + (size_t)row * ldo + col0) = w; } }
    }
};
struct EpiMoeDown {
    static constexpr bool PERM = true, AFTER_DRAIN = false;
    bf16_t* Y; const float* gate;
    __device__ __forceinline__ void operator()(const f32x4 (&acc)[2][2][4][2], const Unit& u, int wr, int wc, int fr, int fq) const {
        const int row0 = u.pm * BM + wr * 64 + fr, col0 = (u.pn & 3) * BM + wc * 32 + 8 * fq;
        float gt[2][4];
#pragma unroll
        for (int ai = 0; ai < 2; ++ai)
#pragma unroll
            for (int m = 0; m < 4; ++m) gt[ai][m] = gate[row0 + ai * HALF + m * 16];
        asm volatile("" : "+v"(gt[0][0]), "+v"(gt[0][1]), "+v"(gt[0][2]), "+v"(gt[0][3]), "+v"(gt[1][0]), "+v"(gt[1][1]), "+v"(gt[1][2]), "+v"(gt[1][3]));
#pragma unroll
        for (int ai = 0; ai < 2; ++ai)
#pragma unroll
            for (int m = 0; m < 4; ++m) { const int row = row0 + ai * HALF + m * 16; const float g = gt[ai][m]; bf16_t* rowp = Y + (size_t)row * 1024 + col0;
#pragma unroll
                for (int bj = 0; bj < 2; ++bj) { const f32x4 v0 = acc[ai][bj][m][0] * g, v1 = acc[ai][bj][m][1] * g;
                    u32x4 w; w.x = cvt_pk_bf16(v0[0], v0[1]); w.y = cvt_pk_bf16(v0[2], v0[3]); w.z = cvt_pk_bf16(v1[0], v1[1]); w.w = cvt_pk_bf16(v1[2], v1[3]);
                    *(u32x4*)(rowp + bj * HALF) = w; } }
    }
};

struct EpiMoeDownPart {
    static constexpr bool PERM = false, AFTER_DRAIN = false;
    float* YT; const float* gate; int row_base;
    __device__ __forceinline__ void operator()(const f32x4 (&acc)[2][2][4][2], const Unit& u, int wr, int wc, int fr, int fq) const {
        const int row0 = u.pm * BM + wr * 64 + fr, col0 = (u.pn & 3) * BM + wc * 32 + 4 * fq; const int kq = u.ko / 1792;
#pragma unroll
        for (int ai = 0; ai < 2; ++ai)
#pragma unroll
            for (int m = 0; m < 4; ++m) { const int row = row0 + ai * HALF + m * 16; const float gtv = gate[row]; float* rowp = YT + ((size_t)kq * 2048 + (row - row_base)) * 1024 + col0;
#pragma unroll
                for (int bj = 0; bj < 2; ++bj)
#pragma unroll
                    for (int n = 0; n < 2; ++n) *(f32x4*)(rowp + bj * HALF + n * 16) = acc[ai][bj][m][n] * gtv; }
    }
};
template <class Epi, class Sched, bool ALIGN_EPI = false, bool SP2 = false>
__device__ __forceinline__ void gemm_phase(PG8_LAS unsigned char* lds, const Gemm g, const Sched& S, const Epi& E, const bool skip_epi = false) {
    const int tid = tid_here(), wid = __builtin_amdgcn_readfirstlane(tid >> 6), lane = tid & 63, wr = wid >> 2, wc = wid & 3, fr = lane & 15, fq = lane >> 4;
    const int K = g.ld, nt = g.K / BK;
    unsigned voffA[2], voffB[2];
#pragma unroll
    for (int i = 0; i < 2; ++i) { int R, C; stage_rc(tid * 16 + i * 8192, R, C); const int Rb = Epi::PERM ? ((R & ~31) + perm32(R & 31)) : R;
        voffA[i] = (unsigned)(R * K + C) * 2u; voffB[i] = (unsigned)(Rb * K + C) * 2u; }
    const size_t kstep = (size_t)(BK * 2);
    const size_t hstep = (size_t)HALF * K * 2;
    const size_t tstep = 2 * hstep;
    const unsigned ldsw = (unsigned)wid * 1024u;
    const int aoff = lds_byte(wr * 64 + fr, fq * 8), boff = lds_byte(wc * 32 + fr, fq * 8);
#define PG8_SA(b, h) (((b) * 2 + (h)) * HTB)
#define PG8_SB(b, h) ((4 + (b) * 2 + (h)) * HTB)
#define PG8_STAGE(bufoff, gbase, voff) do { _Pragma("unroll") for (int _i = 0; _i < 2; ++_i) \
        __builtin_amdgcn_global_load_lds((const unsigned*)((const char*)(gbase) + (voff)[_i]), (PG8_LAS unsigned*)(lds + (bufoff) + ldsw + _i * 8192), 16, 0, 0); } while (0)
#define PG8_LDA(dst, b, h) do { _Pragma("unroll") for (int m = 0; m < 4; ++m) _Pragma("unroll") for (int k = 0; k < 2; ++k) dst[m][k] = *(const PG8_LAS bf16x8*)(lds + PG8_SA(b, h) + aoff + m * 2048 + k * 1024); } while (0)
#define PG8_LDB(dst, b, h) do { _Pragma("unroll") for (int n = 0; n < 2; ++n) _Pragma("unroll") for (int k = 0; k < 2; ++k) dst[n][k] = *(const PG8_LAS bf16x8*)(lds + PG8_SB(b, h) + boff + n * 2048 + k * 1024); } while (0)
#define PG8_MMA(ai, bj, At, Bt) do { __builtin_amdgcn_s_setprio(1); _Pragma("unroll") for (int m = 0; m < 4; ++m) _Pragma("unroll") for (int n = 0; n < 2; ++n) _Pragma("unroll") for (int k = 0; k < 2; ++k) \
        acc[ai][bj][m][n] = __builtin_amdgcn_mfma_f32_16x16x32_bf16(Bt[n][k], At[m][k], acc[ai][bj][m][n], 0, 0, 0); __builtin_amdgcn_s_setprio(0); } while (0)
#define PG8_WAIT_V(n) asm volatile("s_waitcnt vmcnt(" #n ")" ::: "memory")
#define PG8_WAIT_L(n) asm volatile("s_waitcnt lgkmcnt(" #n ")" ::: "memory")
#define PG8_BAR __builtin_amdgcn_s_barrier()
#define PG8_SCHED __builtin_amdgcn_sched_barrier(0)
    Unit cur, nxt; int ui = 0;
    if (!S.next(0, cur)) return;
    f32x4 acc[2][2][4][2];
#pragma unroll
    for (int a = 0; a < 2; ++a)
#pragma unroll
        for (int b = 0; b < 2; ++b)
#pragma unroll
            for (int m = 0; m < 4; ++m)
#pragma unroll
                for (int n = 0; n < 2; ++n) acc[a][b][m][n] = (f32x4){0.f, 0.f, 0.f, 0.f};
    bf16x8 At[4][2], B0[2][2], B1[2][2];
    const char* cA = (const char*)g.A + (size_t)cur.pm * tstep + cur.ko; const char* cB = (const char*)g.Bt + (size_t)cur.pn * tstep + cur.ko;
    S.a_ready(cur);
    if constexpr (SP2) {
        PG8_STAGE(PG8_SB(0, 0), cB, voffB); PG8_STAGE(PG8_SB(0, 1), cB + hstep, voffB); PG8_STAGE(PG8_SA(0, 0), cA, voffA); PG8_STAGE(PG8_SA(0, 1), cA + hstep, voffA);
        if (wr == 1) PG8_BAR;
        PG8_WAIT_V(2); PG8_BAR;
        PG8_STAGE(PG8_SB(1, 0), cB + kstep, voffB); PG8_STAGE(PG8_SA(1, 0), cA + kstep, voffA); PG8_STAGE(PG8_SB(1, 1), cB + hstep + kstep, voffB);
        PG8_WAIT_V(6); PG8_BAR;
    } else {
        PG8_STAGE(PG8_SB(0, 0), cB, voffB); PG8_STAGE(PG8_SA(0, 0), cA, voffA); PG8_STAGE(PG8_SB(0, 1), cB + hstep, voffB); PG8_STAGE(PG8_SA(0, 1), cA + hstep, voffA);
        if (wr == 1) PG8_BAR;
        PG8_WAIT_V(4); PG8_BAR;
        PG8_STAGE(PG8_SB(1, 0), cB + kstep, voffB); PG8_STAGE(PG8_SA(1, 0), cA + kstep, voffA); PG8_STAGE(PG8_SB(1, 1), cB + hstep + kstep, voffB);
        PG8_WAIT_V(6); PG8_BAR;
    }
    for (;;) {
        const bool has_next = S.next(ui + 1, nxt);
        const char* nA = has_next ? (const char*)g.A + (size_t)nxt.pm * tstep + nxt.ko : cA; const char* nB = has_next ? (const char*)g.Bt + (size_t)nxt.pn * tstep + nxt.ko : cB;
        for (int t = 0; t < nt; t += 2) {
            const bool last = (t == nt - 2);
            const char* a1 = cA + (size_t)(t + 1) * kstep;
            const char* a2 = last ? nA : cA + (size_t)(t + 2) * kstep; const char* b2 = last ? nB : cB + (size_t)(t + 2) * kstep;
            const char* a3 = a2 + kstep; const char* b3 = b2 + kstep;
            if (last && has_next) S.a_ready(nxt);
            if constexpr (SP2) {
            PG8_LDB(B0, 0, 0); PG8_LDB(B1, 0, 1); PG8_SCHED; PG8_LDA(At, 0, 0); PG8_STAGE(PG8_SA(1, 1), a1 + hstep, voffA);
            PG8_WAIT_V(8); PG8_WAIT_L(0); PG8_BAR; PG8_MMA(0, 0, At, B0); PG8_MMA(0, 1, At, B1); PG8_BAR; PG8_SCHED;
            PG8_LDA(At, 0, 1); PG8_STAGE(PG8_SB(0, 0), b2, voffB); PG8_STAGE(PG8_SB(0, 1), b2 + hstep, voffB); PG8_STAGE(PG8_SA(0, 0), a2, voffA);
            PG8_WAIT_V(8); PG8_WAIT_L(0); PG8_BAR; PG8_MMA(1, 0, At, B0); PG8_MMA(1, 1, At, B1); PG8_BAR; PG8_SCHED;
            PG8_LDB(B0, 1, 0); PG8_LDB(B1, 1, 1); PG8_SCHED; PG8_LDA(At, 1, 0); PG8_STAGE(PG8_SA(0, 1), a2 + hstep, voffA);
            PG8_WAIT_V(8); PG8_WAIT_L(0); PG8_BAR; PG8_MMA(0, 0, At, B0); PG8_MMA(0, 1, At, B1); PG8_BAR; PG8_SCHED;
            PG8_LDA(At, 1, 1); PG8_STAGE(PG8_SB(1, 0), b3, voffB); PG8_STAGE(PG8_SB(1, 1), b3 + hstep, voffB); PG8_STAGE(PG8_SA(1, 0), a3, voffA);
            PG8_WAIT_V(8); PG8_WAIT_L(0); PG8_BAR; PG8_MMA(1, 0, At, B0); PG8_MMA(1, 1, At, B1); PG8_BAR; PG8_SCHED;
            } else {
            PG8_LDB(B0, 0, 0); PG8_SCHED; PG8_LDA(At, 0, 0); PG8_STAGE(PG8_SA(1, 1), a1 + hstep, voffA);
            PG8_WAIT_L(8); PG8_BAR; PG8_WAIT_L(0); PG8_MMA(0, 0, At, B0); PG8_BAR; PG8_SCHED;
            PG8_LDB(B1, 0, 1); PG8_STAGE(PG8_SB(0, 0), b2, voffB);
            PG8_BAR; PG8_WAIT_L(0); PG8_MMA(0, 1, At, B1); PG8_BAR;
            PG8_LDA(At, 0, 1); PG8_STAGE(PG8_SA(0, 0), a2, voffA);
            PG8_BAR; PG8_WAIT_L(0); PG8_MMA(1, 0, At, B0); PG8_BAR; PG8_SCHED;
            PG8_STAGE(PG8_SB(0, 1), b2 + hstep, voffB);
            PG8_WAIT_V(6); PG8_BAR; PG8_MMA(1, 1, At, B1); PG8_BAR;
            PG8_LDB(B0, 1, 0); PG8_SCHED; PG8_LDA(At, 1, 0); PG8_STAGE(PG8_SA(0, 1), a2 + hstep, voffA);
            PG8_WAIT_L(8); PG8_BAR; PG8_WAIT_L(0); PG8_MMA(0, 0, At, B0); PG8_BAR; PG8_SCHED;
            PG8_LDB(B1, 1, 1); PG8_STAGE(PG8_SB(1, 0), b3, voffB);
            PG8_BAR; PG8_WAIT_L(0); PG8_MMA(0, 1, At, B1); PG8_BAR;
            PG8_LDA(At, 1, 1); PG8_STAGE(PG8_SA(1, 0), a3, voffA);
            PG8_BAR; PG8_WAIT_L(0); PG8_MMA(1, 0, At, B0); PG8_BAR; PG8_SCHED;
            PG8_STAGE(PG8_SB(1, 1), b3 + hstep, voffB);
            PG8_WAIT_V(6); PG8_BAR; PG8_MMA(1, 1, At, B1); PG8_BAR;
            }
        }
        if constexpr (ALIGN_EPI) { if (wr == 0) PG8_BAR; }
        if constexpr (!Epi::AFTER_DRAIN) { if (!skip_epi) E(acc, cur, wr, wc, fr, fq); S.done(cur); }
        if (!has_next) break;
#pragma unroll
        for (int a = 0; a < 2; ++a)
#pragma unroll
            for (int b = 0; b < 2; ++b)
#pragma unroll
                for (int m = 0; m < 4; ++m)
#pragma unroll
                    for (int n = 0; n < 2; ++n) acc[a][b][m][n] = (f32x4){0.f, 0.f, 0.f, 0.f};
        cur = nxt; cA = nA; cB = nB; ++ui;
        if constexpr (ALIGN_EPI) { if (wr == 1) PG8_BAR; }
    }
    PG8_WAIT_V(0);
    if constexpr (!ALIGN_EPI) { if (wr == 0) PG8_BAR; }
    PG8_BAR;
#undef PG8_SA
#undef PG8_SB
#undef PG8_STAGE
#undef PG8_LDA
#undef PG8_LDB
#undef PG8_MMA
#undef PG8_WAIT_V
#undef PG8_WAIT_L
#undef PG8_BAR
#undef PG8_SCHED
}
}

constexpr int NWAVES = 8, NTHR = NWAVES * 64;
constexpr int NB = 8, SEQ = 2048, D = 1024, M = NB * SEQ;
constexpr int INC = 3088;
constexpr int NU = 3072;
constexpr int UQ = 0, UK = 256, UV = 512, UGQ = 768, UGK = 1024, UGV = 1280, UGR = 1792, UCI = 2304, UCB = 2560, UCC = 2816;
constexpr int FF = 2816, FE = 3584, NE = 8;
constexpr int MAXPAN = 136, MAXROWS = MAXPAN * 256;
constexpr float LOG2E = 1.4426950408889634f;
constexpr float QS_ATT = 0.125f * LOG2E;

constexpr size_t MiB = 1u << 20;
constexpr size_t WS_CTL = 0, CTL_ZERO_BYTES = 1 * MiB;
constexpr size_t WS_SS = 1 * MiB;
constexpr size_t WS_BL = 2 * MiB;
constexpr size_t WS_DEC = 2 * MiB + 64 * 1024;
constexpr size_t WS_TOPI = 3 * MiB;
constexpr size_t WS_TOPW = 3 * MiB + 128 * 1024;
constexpr size_t WS_POS = 3 * MiB + 256 * 1024;
constexpr size_t WS_RS3 = 3 * MiB + 384 * 1024;
constexpr size_t WS_CNT = 3 * MiB + 448 * 1024;
constexpr size_t WS_PANE = 3 * MiB + 456 * 1024;
constexpr size_t WS_ROWGATE = 4 * MiB;
constexpr size_t WS_ROWRS = 4 * MiB + 256 * 1024;
constexpr size_t WS_WE13 = 8 * MiB;
constexpr size_t WS_Y = WS_WE13;
constexpr size_t WS_YT = WS_WE13 + 68 * MiB;
constexpr size_t WS_XS = 120 * MiB;
constexpr size_t WS_WE2 = WS_XS;
constexpr size_t WS_HE = 188 * MiB;
constexpr size_t WS_WIN = WS_HE;
constexpr size_t WS_WGLR = WS_HE + 12 * MiB;
constexpr size_t WS_LA = WS_HE + 34 * MiB;
constexpr size_t WS_WOUT = WS_HE + 13 * MiB;
constexpr size_t WS_W13 = WS_HE + 17 * MiB;
constexpr size_t WS_W2 = WS_HE + 28 * MiB;
constexpr size_t WS_XB = WS_HE + 238 * MiB;
constexpr size_t WS_U = WS_HE + 66 * MiB;
constexpr size_t WS_H = WS_U;
constexpr size_t WS_MIX = WS_HE + 170 * MiB;
constexpr size_t WS_CST = WS_HE + 202 * MiB;
constexpr size_t WS_END = WS_HE + 270 * MiB;
static_assert(WS_CST + 32 * MiB <= WS_END, "ws map");
constexpr int CW_BAR = 4096;
constexpr int CW_SC = 32768;
constexpr int CW_TMO2 = 65536;
constexpr int CW_W2Q = 65600;

constexpr int LDS_BYTES = 147456;
constexpr int LDSCTL_OFF = 131072 + 14 * 1024, MISC_OFF = LDSCTL_OFF + 320;

#define GAS __attribute__((address_space(1)))
#define LAS __attribute__((address_space(3)))
typedef unsigned short bf16;
typedef float f32x4 __attribute__((ext_vector_type(4)));
typedef unsigned v4u __attribute__((ext_vector_type(4)));
__device__ __forceinline__ unsigned f2bf(float f) { unsigned u = __builtin_bit_cast(unsigned, f); return (u + 0x7fffu + ((u >> 16) & 1u)) >> 16; }
__device__ __forceinline__ unsigned pk2(float lo, float hi) { return pg8::cvt_pk_bf16(lo, hi); }
__device__ __forceinline__ float fexp_(float x) { return __builtin_amdgcn_exp2f(x * 1.4426950408889634f); }
__device__ __forceinline__ float bf2f(unsigned short b) { return __builtin_bit_cast(float, (unsigned)b << 16); }
__device__ __forceinline__ float bflo(unsigned w) { return __builtin_bit_cast(float, w << 16); }
__device__ __forceinline__ float bfhi(unsigned w) { return __builtin_bit_cast(float, w & 0xffff0000u); }
__device__ __forceinline__ float wave_sum(float v) {
#pragma unroll
    for (int o = 1; o < 64; o <<= 1) v += __shfl_xor(v, o);
    return v;
}
__device__ __forceinline__ float wave_max(float v) {
#pragma unroll
    for (int o = 1; o < 64; o <<= 1) v = fmaxf(v, __shfl_xor(v, o));
    return v;
}

#define XB_TMO      128
#define XB_XCNT(j)  (256  + 64 * (j))
#define XB_XSUB(j)  (1280 + 64 * (j))
#define XB_XGEN(j)  (2304 + 64 * (j))
#define XB_TOP      3328
#define XB_TOPGEN   3392
#define XCD_BAR_WORDS 3456
#define XB_SPIN_CAP (1u << 18)
__device__ __forceinline__ unsigned xb_ld(unsigned* p)              { return __hip_atomic_load(p, __ATOMIC_RELAXED, __HIP_MEMORY_SCOPE_AGENT); }
__device__ __forceinline__ unsigned xb_add(unsigned* p, unsigned v) { return __hip_atomic_fetch_add(p, v, __ATOMIC_RELAXED, __HIP_MEMORY_SCOPE_AGENT); }
__device__ __forceinline__ unsigned xb_xcc_id() { return (unsigned)__builtin_amdgcn_s_getreg((3 << 11) | 20) & 0xFu; }
#define XB_SPIN(cond, bar) do { unsigned _sp = 0; while (cond) { __builtin_amdgcn_s_sleep(1); \
    if ((++_sp & 255u) == 0u) { if (xb_ld(&(bar)[XB_TMO])) break; if (_sp > XB_SPIN_CAP) { atomicAdd(&(bar)[XB_TMO], 1u); break; } } } } while (0)
struct XcdBarrier { unsigned* bar; unsigned x; volatile LAS unsigned* st; };
__device__ __forceinline__ XcdBarrier xcd_barrier_post(unsigned* bar, volatile LAS unsigned* st) {
    XcdBarrier b; b.bar = bar; b.x = xb_xcc_id(); b.st = st;
    if (threadIdx.x == 0) (void)xb_add(&bar[XB_XCNT(b.x)], 1u);
    return b;
}
__device__ __forceinline__ void xcd_barrier_complete(unsigned* bar, unsigned x, unsigned& nloc, unsigned& nx) {
    const unsigned G = gridDim.x * gridDim.y * gridDim.z;
    unsigned sum, cnt, mine, sp = 0u;
    for (;;) {
        sum = 0u; cnt = 0u; mine = 0u;
#pragma unroll
        for (unsigned j = 0; j < 16; ++j) { const unsigned c = xb_ld(&bar[XB_XCNT(j)]); sum += c; cnt += (c > 0u) ? 1u : 0u; mine = (j == x) ? c : mine; }
        if (sum == G) break;
        __builtin_amdgcn_s_sleep(1);
        if ((++sp & 255u) == 0u) { if (xb_ld(&bar[XB_TMO])) break; if (sp > XB_SPIN_CAP) { atomicAdd(&bar[XB_TMO], 1u); break; } }
    }
    nloc = mine > 0u ? mine : 1u; nx = cnt > 0u ? cnt : 1u;
}
__device__ __forceinline__ void xcd_barrier(const XcdBarrier& b) {
    asm volatile("s_waitcnt vmcnt(0)" ::: "memory");
    __syncthreads();
    if (threadIdx.x == 0) {
        unsigned* bar = b.bar;
        __builtin_amdgcn_s_waitcnt(0);
        unsigned nloc = b.st[0], nx = b.st[1];
        if (nloc == 0u) { xcd_barrier_complete(bar, b.x, nloc, nx); b.st[0] = nloc; b.st[1] = nx; }
        const unsigned old = xb_add(&bar[XB_XSUB(b.x)], 1u);
        const unsigned gen = old / nloc;
        if (old + 1u == (gen + 1u) * nloc) {
            __builtin_amdgcn_fence(__ATOMIC_RELEASE, "agent");
            asm volatile("s_waitcnt vmcnt(0)" ::: "memory");
            const unsigned og = xb_add(&bar[XB_TOP], 1u);
            const unsigned tg = og / nx;
            if (og + 1u == (tg + 1u) * nx) xb_add(&bar[XB_TOPGEN], 1u);
            else XB_SPIN(xb_ld(&bar[XB_TOPGEN]) == tg, bar);
            __builtin_amdgcn_fence(__ATOMIC_ACQUIRE, "agent");
            xb_add(&bar[XB_XGEN(b.x)], 1u);
            asm volatile("s_waitcnt vmcnt(0)" ::: "memory");
        } else {
            XB_SPIN(xb_ld(&bar[XB_XGEN(b.x)]) == gen, bar);
            __builtin_amdgcn_fence(__ATOMIC_ACQUIRE, "agent");
            asm volatile("s_waitcnt vmcnt(0)" ::: "memory");
        }
    }
    __syncthreads();
}

struct Args {
    const float* x; const float* w_mix_in; const float* w_mix_out; const float* g_mix; const float* rel_bias; const float* gla_w_gate; const float* gla_b_gate;
    const float* gla_g_norm; const float* conv_w; const float* g_ffn; const float* ffn_w1; const float* ffn_w3; const float* ffn_w2; const float* moe_router;
    const float* moe_w1; const float* moe_w3; const float* moe_w2; const float* g_final;
    float* out; unsigned char* ws; int ph_lo, ph_hi, li, pad;
};

__device__ __forceinline__ void transpose_tile(const float* src, int ldsrc, int k0, int n0, bf16* dst, int ldd, int drow0, const float* ksc, unsigned* scr, int lane) {
    const int nq = lane & 15, kk = lane >> 4;
#pragma unroll
    for (int i = 0; i < 8; ++i) { const int k = 8 * i + 2 * kk; const float* p = src + (size_t)(k0 + k) * ldsrc + n0 + 4 * nq;
        const f32x4 r0 = *(const f32x4*)p, r1 = *(const f32x4*)(p + ldsrc);
        const float s0 = ksc ? ksc[k0 + k] : 1.f, s1 = ksc ? ksc[k0 + k + 1] : 1.f;
#pragma unroll
        for (int j = 0; j < 4; ++j) scr[(4 * nq + j) * 33 + 4 * i + kk] = pk2(r0[j] * s0, r1[j] * s1); }
    asm volatile("s_waitcnt lgkmcnt(0)" ::: "memory");
#pragma unroll 8
    for (int i2 = 0; i2 < 32; ++i2) { const int n = 2 * i2 + (lane >> 5), d = lane & 31;
        ((unsigned*)(dst + (size_t)(drow0 + n) * ldd + k0))[d] = scr[n * 33 + d]; }
    asm volatile("s_waitcnt lgkmcnt(0)" ::: "memory");
}
__device__ __forceinline__ void glr_tile(const float* win, const float* wg, const float* g, int k0, int n0, bf16* dst, int drow0, int lane) {
    float w[16];
#pragma unroll
    for (int r = 0; r < 16; ++r) w[r] = wg[r * 256 + n0 + lane];
    unsigned* drow = (unsigned*)(dst + (size_t)(drow0 + n0 + lane) * 1024 + k0);
    for (int kp = 0; kp < 32; ++kp) { float v[2];
#pragma unroll
        for (int q = 0; q < 2; ++q) { const int k = k0 + 2 * kp + q; const float* s = win + (size_t)k * INC + 2304; float a = 0.f;
#pragma unroll
            for (int r = 0; r < 16; ++r) a += s[r] * w[r];
            v[q] = a * g[k]; }
        drow[kp] = pk2(v[0], v[1]); }
}
__device__ __forceinline__ int rel_bucket(int d) {
    if (d < 16) return d;
    const float lr = logf((float)d / 16.0f) / logf(128.0f);
    int b = 16 + (int)(lr * 16.0f); return b < 31 ? b : 31;
}


typedef short bf16x8 __attribute__((ext_vector_type(8)));
typedef short v4i16_t __attribute__((ext_vector_type(4)));
#define MFMA16(a, b, c) __builtin_amdgcn_mfma_f32_16x16x32_bf16((a), (b), (c), 0, 0, 0)
__device__ __forceinline__ v4i16_t tr16(LAS unsigned char* p) { return __builtin_amdgcn_ds_read_tr16_b64_v4i16((LAS v4i16_t*)p); }
__device__ __forceinline__ bf16x8 cat8(v4i16_t lo, v4i16_t hi) { return __builtin_shufflevector(lo, hi, 0, 1, 2, 3, 4, 5, 6, 7); }
__device__ __forceinline__ bf16x8 frag_rm(LAS unsigned char* base, int pitch, int c0, int k0, int lane) { return *(LAS bf16x8*)(base + (c0 + (lane & 15)) * pitch + (k0 + 8 * (lane >> 4)) * 2); }
__device__ __forceinline__ bf16x8 frag_tr(LAS unsigned char* base, int pitch, int c0, int k0, int lane) {
    const int i = lane & 15, g = lane >> 4; LAS unsigned char* p = base + (k0 + 8 * g + (i >> 2)) * pitch + (c0 + 4 * (i & 3)) * 2;
    return cat8(tr16(p), tr16(p + 4 * pitch)); }
__device__ __forceinline__ bf16x8 frag_trp(LAS unsigned char* base, int pitch, int c0, int k0, int lane) {
    const int i = lane & 15, g = lane >> 4; LAS unsigned char* p = base + (k0 + 4 * g + (i >> 2)) * pitch + (c0 + 4 * (i & 3)) * 2;
    return cat8(tr16(p), tr16(p + 16 * pitch)); }
__device__ __forceinline__ bf16x8 pack8(const f32x4& a, const f32x4& b) {
    v4u w; w.x = pg8::cvt_pk_bf16(a[0], a[1]); w.y = pg8::cvt_pk_bf16(a[2], a[3]); w.z = pg8::cvt_pk_bf16(b[0], b[1]); w.w = pg8::cvt_pk_bf16(b[2], b[3]); return __builtin_bit_cast(bf16x8, w); }

struct Ctx { Args args; int tid, lane, wave, G, bx, gw, NGW, lo, hi; XcdBarrier bar; };
#define GRID_BAR() do { if (MK_N_LAUNCHES == 1) xcd_barrier(bar); } while (0)
#define IN(k) (lo <= (k) && (k) < hi)
#define SEAM(k) do { if (IN(k) && IN((k) + 1)) GRID_BAR(); } while (0)
#define WS_PTRS \
    float* SS = (float*)(ws + WS_SS); float* BL = (float*)(ws + WS_BL); float* DEC = (float*)(ws + WS_DEC); \
    bf16* XB = (bf16*)(ws + WS_XB); bf16* U = (bf16*)(ws + WS_U); bf16* MIX = (bf16*)(ws + WS_MIX); float* CST = (float*)(ws + WS_CST); \
    bf16* H = (bf16*)(ws + WS_H); bf16* W13 = (bf16*)(ws + WS_W13); bf16* W2 = (bf16*)(ws + WS_W2); \
    bf16* WE13 = (bf16*)(ws + WS_WE13); bf16* WE2 = (bf16*)args.out;     bf16* XS = (bf16*)(ws + WS_XS); bf16* HE = (bf16*)(ws + WS_HE); bf16* Y = (bf16*)(ws + WS_Y); \
    int* TOPI = (int*)(ws + WS_TOPI); float* TOPW = (float*)(ws + WS_TOPW); int* POS = (int*)(ws + WS_POS); float* RS3 = (float*)(ws + WS_RS3); \
    int* CNT = (int*)(ws + WS_CNT); int* PANE = (int*)(ws + WS_PANE); float* ROWGATE = (float*)(ws + WS_ROWGATE); float* ROWRS = (float*)(ws + WS_ROWRS); \
    float* X = args.out; \
    (void)SS; (void)BL; (void)DEC; (void)XB; (void)U; (void)MIX; (void)CST; (void)H; (void)W13; (void)W2; (void)WE13; (void)WE2; (void)XS; (void)HE; (void)Y; \
    (void)TOPI; (void)TOPW; (void)POS; (void)RS3; (void)CNT; (void)PANE; (void)ROWGATE; (void)ROWRS; (void)X;

template <int layer> __device__ __forceinline__ void layer_phases(const Ctx& c, unsigned char* lds) {
    const Args& args = c.args; LAS unsigned char* ldsl = (LAS unsigned char*)lds;
    const int tid = c.tid, lane = c.lane, wave = c.wave, G = c.G, bx = c.bx, gw = c.gw, NGW = c.NGW, lo = c.lo, hi = c.hi; const XcdBarrier bar = c.bar;
    unsigned char* ws = args.ws;
    WS_PTRS
    (void)tid; (void)lane; (void)wave; (void)gw; (void)NGW;
#if defined(PROBE_PHASE) || defined(PROBE_REP)
    const int pad_ = args.pad;
#else
    constexpr int pad_ = 0;
#endif
    const int pmode = pad_ >> 4; (void)pmode;
    const bool dry = (pad_ & 1) != 0, noepi = (pad_ & 2) != 0;
    bf16* XBD = dry ? (bf16*)(ws + WS_XS) : XB; float* SSD = dry ? (float*)(ws + WS_XS) : SS; (void)XBD; (void)SSD;
        const int pb = 1 + 16 * layer;
        if (IN(pb + 0)) {
            pg8::Gemm g{XB, (const bf16*)(ws + WS_WIN) + (size_t)layer * NU * D, M, NU, D, D}; pg8::StaticOrder S; S.init(M, NU, G, bx);
            pg8::EpiU E{U, NU, SS, QS_ATT};
            pg8::gemm_phase<pg8::EpiU, pg8::StaticOrder, true, true>(ldsl, g, S, E, noepi);
            { const bf16* wg = (const bf16*)(ws + WS_WGLR) + (size_t)layer * 16 * D; float* LA = (float*)(ws + WS_LA); f32x4* xch = (f32x4*)lds; float* glrl = (float*)(lds + 4096);
              const int tid = pg8::tid_here(), lane = tid & 63; const int rt = wave & 3, kh = wave >> 2, ql = lane & 15, g4 = lane >> 4;
              bf16x8 wfr[8]; float bcl[8];
#pragma unroll
              for (int ct = 0; ct < 8; ++ct) { const int col = 16 * (8 * kh + ct) + ql; float w8[8];
#pragma unroll
                  for (int j = 0; j < 8; ++j) w8[j] = (g4 < 2) ? args.gla_w_gate[layer * 16 * 256 + (8 * g4 + j) * 256 + col] : 0.f;
                  v4u pw; pw.x = pk2(w8[0], w8[1]); pw.y = pk2(w8[2], w8[3]); pw.z = pk2(w8[4], w8[5]); pw.w = pk2(w8[6], w8[7]); wfr[ct] = __builtin_bit_cast(bf16x8, pw);
                  bcl[ct] = args.gla_b_gate[layer * 256 + col]; }
              for (int blk = bx; blk < 256; blk += G) {
                  const bf16* ap = XB + (size_t)(blk * 64 + rt * 16 + ql) * D + kh * 512 + 8 * g4; const bf16* bp = wg + (size_t)ql * D + kh * 512 + 8 * g4;
                  bf16x8 af[16], bfr[16];
#pragma unroll
                  for (int ks = 0; ks < 16; ++ks) { af[ks] = *(const bf16x8*)(ap + 32 * ks); bfr[ks] = *(const bf16x8*)(bp + 32 * ks); }
                  f32x4 rsp[4];
                  { const int rl = rt * 16 + 4 * g4;
#pragma unroll
                    for (int rg = 0; rg < 4; ++rg) { const f32x4* sp = (const f32x4*)(SS + (size_t)(blk * 64 + rl + rg) * 16); rsp[rg] = (sp[0] + sp[1]) + (sp[2] + sp[3]); } }
                  f32x4 acc = (f32x4){0.f, 0.f, 0.f, 0.f};
#pragma unroll
                  for (int ks = 0; ks < 16; ++ks) acc = MFMA16(af[ks], bfr[ks], acc);
                  if (kh == 1) xch[rt * 64 + lane] = acc;
                  __syncthreads();
                  if (kh == 0) { acc += xch[rt * 64 + lane];
#pragma unroll
                      for (int rg = 0; rg < 4; ++rg) { const int rl = rt * 16 + 4 * g4 + rg; const float s = (rsp[rg][0] + rsp[rg][1]) + (rsp[rg][2] + rsp[rg][3]);
                          glrl[rl * 16 + ql] = acc[rg] * __builtin_amdgcn_rsqf(s * (1.0f / 1024.0f) + pg8::RMS_EPS); } }
                  __syncthreads();
                  {
                    bf16x8 afr = (bf16x8){0, 0, 0, 0, 0, 0, 0, 0};
                    if (g4 < 2) { const f32x4 x0 = *(const f32x4*)(glrl + (rt * 16 + ql) * 16 + 8 * g4), x1 = *(const f32x4*)(glrl + (rt * 16 + ql) * 16 + 8 * g4 + 4);
                        v4u pa; pa.x = pk2(x0[0], x0[1]); pa.y = pk2(x0[2], x0[3]); pa.z = pk2(x1[0], x1[1]); pa.w = pk2(x1[2], x1[3]); afr = __builtin_bit_cast(bf16x8, pa); }
#pragma unroll
                    for (int ct = 0; ct < 8; ++ct) { const f32x4 z = MFMA16(afr, wfr[ct], ((f32x4){0.f, 0.f, 0.f, 0.f}));
#pragma unroll
                        for (int rg = 0; rg < 4; ++rg) LA[(size_t)(blk * 64 + rt * 16 + 4 * g4 + rg) * 256 + 16 * (8 * kh + ct) + ql] = pg8::logsig16(z[rg] + bcl[ct]); } }
                  __syncthreads();
              } }
        }
        SEAM(pb + 0);
        if (IN(pb + 1)) {
            const int tid = pg8::tid_here(), lane = tid & 63; (void)lane;
            float* cum = (float*)lds; float* seg = cum + 4096;
            LAS unsigned char* kdl = ldsl + 18432;
            LAS unsigned char* vvl = ldsl + 27648;
            for (int u = bx; u < 1024; u += G) {
                const int h = u & 3, n = (u >> 2) & 31, b = u >> 7; const size_t row0 = (size_t)b * SEQ + n * 64;
                const int tr = tid >> 3, c8 = tid & 7;
                const v4u kraw = *(const v4u*)(U + (row0 + tr) * NU + UGK + h * 64 + 8 * c8);
                const v4u* vp = (const v4u*)(U + (row0 + tr) * NU + UGV + h * 128 + c8 * 16); const v4u x0 = vp[0], x1 = vp[1];
                { float c = 0.f; float lav[8]; const float* lap = (const float*)(ws + WS_LA) + (row0 + 8 * wave) * 256 + h * 64 + lane;
#pragma unroll
                  for (int i = 0; i < 8; ++i) lav[i] = lap[i * 256];
#pragma unroll
                  for (int i = 0; i < 8; ++i) { c += lav[i]; cum[(8 * wave + i) * 64 + lane] = c; }
                  seg[wave * 64 + lane] = c; }
                __syncthreads();
                { f32x4 offa = (f32x4){0.f, 0.f, 0.f, 0.f}, offb = offa, lasta = offa, lastb = offa; const int wq = tr >> 3;
#pragma unroll
                  for (int w = 0; w < 8; ++w) { const f32x4 sa = *(const f32x4*)(seg + w * 64 + 8 * c8), sb = *(const f32x4*)(seg + w * 64 + 8 * c8 + 4); lasta += sa; lastb += sb; if (w < wq) { offa += sa; offb += sb; } }
                  const f32x4 ca = *(const f32x4*)(cum + tr * 64 + 8 * c8) + offa, cb = *(const f32x4*)(cum + tr * 64 + 8 * c8 + 4) + offb;
                  v4u w; w.x = pk2(bflo(kraw.x) * fexp_(lasta[0] - ca[0]), bfhi(kraw.x) * fexp_(lasta[1] - ca[1])); w.y = pk2(bflo(kraw.y) * fexp_(lasta[2] - ca[2]), bfhi(kraw.y) * fexp_(lasta[3] - ca[3]));
                  w.z = pk2(bflo(kraw.z) * fexp_(lastb[0] - cb[0]), bfhi(kraw.z) * fexp_(lastb[1] - cb[1])); w.w = pk2(bflo(kraw.w) * fexp_(lastb[2] - cb[2]), bfhi(kraw.w) * fexp_(lastb[3] - cb[3]));
                  *(LAS v4u*)(kdl + tr * 144 + c8 * 16) = w;
                  if (tr == 0) {
#pragma unroll
                      for (int j = 0; j < 4; ++j) { __hip_atomic_store(DEC + u * 64 + 8 * c8 + j, fexp_(lasta[j]), __ATOMIC_RELAXED, __HIP_MEMORY_SCOPE_AGENT); __hip_atomic_store(DEC + u * 64 + 8 * c8 + 4 + j, fexp_(lastb[j]), __ATOMIC_RELAXED, __HIP_MEMORY_SCOPE_AGENT); } }
                  LAS v4u* vd = (LAS v4u*)(vvl + tr * 272 + c8 * 32); vd[0] = x0; vd[1] = x1; }
                __syncthreads();
                { f32x4 acc[4];
#pragma unroll
                  for (int kt = 0; kt < 4; ++kt) acc[kt] = (f32x4){0.f, 0.f, 0.f, 0.f};
#pragma unroll
                  for (int ks = 0; ks < 2; ++ks) { const bf16x8 bv = frag_tr(vvl, 272, 16 * wave, 32 * ks, lane);
#pragma unroll
                      for (int kt = 0; kt < 4; ++kt) { const bf16x8 ak = frag_tr(kdl, 144, 16 * kt, 32 * ks, lane); acc[kt] = MFMA16(ak, bv, acc[kt]); } }
                  const int g4 = lane >> 4, ql = lane & 15;
                  const __amdgpu_buffer_rsrc_t rsrc = __builtin_amdgcn_make_buffer_rsrc((void*)CST, 0, 32 * 1024 * 1024, 0x00020000);
#pragma unroll
                  for (int kt = 0; kt < 4; ++kt)
                      __builtin_amdgcn_raw_buffer_store_b128(__builtin_bit_cast(v4u, acc[kt]), rsrc, (int)((((unsigned)u * 128u + 16u * wave + ql) * 64u + 16u * kt + 4u * g4) * 4u), 0, 16); }
                asm volatile("s_waitcnt vmcnt(0)" ::: "memory");
                __syncthreads();
                if (tid == 0) __hip_atomic_fetch_add((unsigned*)(ws + WS_CTL) + CW_SC + ((u >> 7) * 4 + (u & 3)) * 64, 1u, __ATOMIC_RELAXED, __HIP_MEMORY_SCOPE_AGENT);
            }
            const float* cw = args.conv_w + layer * 3 * 256;
            for (int rep_ = 0; rep_ < 1 + ((pad_ >> 10) & 1); ++rep_)
            for (int it = bx * NTHR + tid; it < M * 32; it += G * NTHR) {
                const int row = it >> 5, c0 = (it & 31) * 8, t = row & (SEQ - 1);
                const bf16* ur = U + (size_t)row * NU;
                const v4u cb = *(const v4u*)(ur + UCB + c0);
                v4u ci[3], cc[3];
#pragma unroll
                for (int d = 0; d < 3; ++d) { if (t >= d) { ci[d] = *(const v4u*)(ur - (size_t)d * NU + UCI + c0); cc[d] = *(const v4u*)(ur - (size_t)d * NU + UCC + c0); } else { ci[d] = (v4u){0u, 0u, 0u, 0u}; cc[d] = ci[d]; } }
                float o[8];
#pragma unroll
                for (int j = 0; j < 4; ++j) {
                    float a0 = 0.f, a1 = 0.f;
#pragma unroll
                    for (int d = 0; d < 3; ++d) { const float w0 = cw[(2 - d) * 256 + c0 + 2 * j], w1 = cw[(2 - d) * 256 + c0 + 2 * j + 1];
                        a0 += w0 * (bflo(cc[d][j]) * bflo(ci[d][j])); a1 += w1 * (bfhi(cc[d][j]) * bfhi(ci[d][j])); }
                    o[2 * j] = bflo(cb[j]) * a0; o[2 * j + 1] = bfhi(cb[j]) * a1; }
                v4u w; w.x = pk2(o[0], o[1]); w.y = pk2(o[2], o[3]); w.z = pk2(o[4], o[5]); w.w = pk2(o[6], o[7]);
                *(v4u*)(MIX + (size_t)row * D + 768 + c0) = w;
            }
            __syncthreads();
            {
                float* BLl = (float*)lds;
                for (int i = tid; i < 4 * 2049; i += NTHR) BLl[(i & 3) * 2049 + (i >> 2)] = BL[i];
                __syncthreads();
                LAS unsigned char* vst = ldsl + 33280 + wave * 5120;
                const int ql = lane & 15, g4 = lane >> 4;
                for (int rep_ = 0; rep_ < 1 + ((pad_ >> 11) & 1); ++rep_)
                for (int uu = bx; uu < 512; uu += G) {
                    int u = uu; if (G == 256) { const int j = (uu & 255) >> 3; u = ((((uu >> 8) * 16 + (uu & 7) * 2 + (j >> 4)) << 4) | (j & 15)); }
                    const int c = u & 15, h = (u >> 4) & 3, b = u >> 6; const int i0 = 16 * (((uu / G) & 1) ? 7 - wave : wave); const size_t rowb = (size_t)b * SEQ;
                    const int tq = c + 16 * (i0 + ql);
                    const bf16* ub = U + rowb * NU + h * 64;
                    const bf16x8 qf0 = *(const bf16x8*)(ub + (size_t)tq * NU + UQ + 8 * g4), qf1 = *(const bf16x8*)(ub + (size_t)tq * NU + UQ + 8 * g4 + 32);
                    const float* blh = BLl + h * 2049;
                    const int t0 = c + 16 * i0, t1 = t0 + 240;
                    const int base0 = ((t0 >> 4) - 128) & ~31, mhi0 = t1 >> 4, np0 = ((mhi0 - base0) >> 5) + 1, pz0 = base0 < 0 ? ((-base0) >> 5) : 0;
                    const int base1 = ((t0 >> 2) - 128) & ~31, mhi1 = t1 >> 2, np1 = ((mhi1 - base1) >> 5) + 1, pz1 = base1 < 0 ? ((-base1) >> 5) : 0;
                    const int base2 = (t0 - 128) & ~31, mhi2 = t1, np2 = ((mhi2 - base2) >> 5) + 1, pz2 = base2 < 0 ? ((-base2) >> 5) : 0;
                    const int n0 = np0 - pz0, n1 = np1 - pz1, n2 = np2 - pz2, NT = n0 + n1 + n2;
                    bf16x8 ka[2][2], kb[2][2]; v4u va_[4], vb_[4];
                    const unsigned char* ubb = (const unsigned char*)ub;
                    const unsigned koff = (unsigned)(UK + 8 * g4) * 2u, voff = (unsigned)(UV + 8 * (lane & 7)) * 2u; const int vrow = lane >> 3;
#define ATT_ITEM(it, LR, MB, MHI, RHO) do { if ((it) < n0) { LR = 4; MB = base0 + 32 * (np0 - 1 - (it)); MHI = mhi0; RHO = c; } \
                        else if ((it) < n0 + n1) { LR = 2; MB = base1 + 32 * (pz1 + (it) - n0); MHI = mhi1; RHO = c & 3; } \
                        else { LR = 0; MB = base2 + 32 * (pz2 + (it) - n0 - n1); MHI = mhi2; RHO = 0; } } while (0)
#define ATT_CLAMP(x, hi) __builtin_amdgcn_med3 ## _i(x, hi)
#define ATT_LOAD(K_, V_, LR, MB, MHI, RHO) do { _Pragma("unroll") for (int tau = 0; tau < 2; ++tau) { int mk = (MB) + 16 * tau + ql; mk = max(0, min(mk, (MHI))); \
                            const unsigned char* kp = ubb + ((unsigned)((mk << (LR)) + (RHO)) * (unsigned)(NU * 2) + koff); K_[tau][0] = *(const bf16x8*)kp; K_[tau][1] = *(const bf16x8*)(kp + 64); } \
                        _Pragma("unroll") for (int j = 0; j < 4; ++j) { int mv = (MB) + vrow + 8 * j; mv = max(0, min(mv, (MHI))); \
                            V_[j] = *(const v4u*)(ubb + ((unsigned)((mv << (LR)) + (RHO)) * (unsigned)(NU * 2) + voff)); } } while (0)
#define ATT_STEP(KC_, VC_, KN_, VN_) do { \
                        int lrn = lr, mbn = mb, mhin = mhi, rhon = rho; \
                        if (it + 1 < NT) { ATT_ITEM(it + 1, lrn, mbn, mhin, rhon); ATT_LOAD(KN_, VN_, lrn, mbn, mhin, rhon); } \
                        { LAS unsigned char* vd = vst + vrow * 160 + (lane & 7) * 16; \
                          _Pragma("unroll") for (int j = 0; j < 4; ++j) *(LAS v4u*)(vd + j * 8 * 160) = VC_[j]; } \
                        f32x4 s[2]; \
                        _Pragma("unroll") for (int tau = 0; tau < 2; ++tau) { s[tau] = MFMA16(KC_[tau][0], qf0, ((f32x4){0.f, 0.f, 0.f, 0.f})); s[tau] = MFMA16(KC_[tau][1], qf1, s[tau]); } \
                        const int d0 = (tq >> lr) - mb - 4 * g4; const int kneg = -(mb + 4 * g4); float tmax = -INFINITY; float bias_[2][4]; \
                        _Pragma("unroll") for (int tau = 0; tau < 2; ++tau) \
                            _Pragma("unroll") for (int rg = 0; rg < 4; ++rg) { const int dcl = max(0, min(d0 - (16 * tau + rg), 128)); bias_[tau][rg] = blh[dcl << lr]; } \
                        asm volatile("" : "+v"(bias_[0][0]), "+v"(bias_[0][1]), "+v"(bias_[0][2]), "+v"(bias_[0][3]), "+v"(bias_[1][0]), "+v"(bias_[1][1]), "+v"(bias_[1][2]), "+v"(bias_[1][3]));   \
                        _Pragma("unroll") for (int tau = 0; tau < 2; ++tau) \
                            _Pragma("unroll") for (int rg = 0; rg < 4; ++rg) { const int dist = d0 - (16 * tau + rg); const bool ok = ((unsigned)dist <= 128u) && ((16 * tau + rg) >= kneg); \
                                const float v = ok ? s[tau][rg] + bias_[tau][rg] : -INFINITY; s[tau][rg] = v; tmax = fmaxf(tmax, v); } \
                        if (__any(tmax > m_ref + 16.0f)) { \
                            float tm = fmaxf(tmax, __shfl_xor(tmax, 16)); tm = fmaxf(tm, __shfl_xor(tm, 32)); \
                            const float mn = fmaxf(m_ref, tm); const float ms = (mn == -INFINITY) ? 0.f : mn; const float alpha = __builtin_amdgcn_exp2f(m_ref - ms); m_ref = ms; \
                            l_run *= alpha; \
                            _Pragma("unroll") for (int d = 0; d < 4; ++d) o[d] = o[d] * alpha; \
                        } \
                        float ps = 0.f; \
                        _Pragma("unroll") for (int tau = 0; tau < 2; ++tau) \
                            _Pragma("unroll") for (int rg = 0; rg < 4; ++rg) { const float p = __builtin_amdgcn_exp2f(s[tau][rg] - m_ref); s[tau][rg] = p; ps += p; } \
                        l_run += ps; \
                        const bf16x8 pb = pack8(s[0], s[1]); \
                        asm volatile("" ::: "memory"); \
                        _Pragma("unroll") for (int d = 0; d < 4; ++d) { const bf16x8 vf = frag_trp(vst, 160, 16 * d, 0, lane); o[d] = MFMA16(vf, pb, o[d]); } \
                        asm volatile("" ::: "memory"); \
                        lr = lrn; mb = mbn; mhi = mhin; rho = rhon; ++it; } while (0)
                    int lr, mb, mhi, rho; ATT_ITEM(0, lr, mb, mhi, rho); ATT_LOAD(ka, va_, lr, mb, mhi, rho);
                    float m_ref = -INFINITY, l_run = 0.f; f32x4 o[4];
#pragma unroll
                    for (int d = 0; d < 4; ++d) o[d] = (f32x4){0.f, 0.f, 0.f, 0.f};
                    for (int it = 0; it < NT;) {
                        ATT_STEP(ka, va_, kb, vb_);
                        if (it >= NT) break;
                        ATT_STEP(kb, vb_, ka, va_);
                    }
#undef ATT_ITEM
#undef ATT_LOAD
#undef ATT_STEP
#undef ATT_CLAMP
                    l_run += __shfl_xor(l_run, 16); l_run += __shfl_xor(l_run, 32); const float inv = 1.0f / l_run;
                    bf16* op = MIX + (rowb + tq) * D + h * 64 + 4 * g4;
#pragma unroll
                    for (int d = 0; d < 4; ++d) { pg8::u32x2 w; w.x = pg8::cvt_pk_bf16(o[d][0] * inv, o[d][1] * inv); w.y = pg8::cvt_pk_bf16(o[d][2] * inv, o[d][3] * inv); *(pg8::u32x2*)(op + 16 * d) = w; }
                }
            }
            for (int u = bx; u < 1024; u += G) {
                const int h = u & 3, n = (u >> 2) & 31, b = u >> 7;
                unsigned* cw = (unsigned*)(ws + WS_CTL) + CW_SC + (b * 4 + h) * 64; unsigned* tmo = (unsigned*)(ws + WS_CTL) + CW_TMO2; const unsigned need = 32u * (unsigned)(layer + 1);
                if (wave == 0) { unsigned sp = 0; while (__hip_atomic_load(cw, __ATOMIC_RELAXED, __HIP_MEMORY_SCOPE_AGENT) < need) { __builtin_amdgcn_s_sleep(2);
                        if ((++sp & 255u) == 0u) { if (__hip_atomic_load(tmo, __ATOMIC_RELAXED, __HIP_MEMORY_SCOPE_AGENT) != 0u) break; if (sp > (1u << 20)) { __hip_atomic_store(tmo, 1u, __ATOMIC_RELAXED, __HIP_MEMORY_SCOPE_AGENT); break; } } } }
                __syncthreads();
                if (tid < 256) { const int idx = n * 256 + tid; float cc[32], dd[32];
                    float* cp = CST + (size_t)(b * 128 + h) * 8192 + idx; const float* dp = DEC + (b * 128 + h) * 64 + (idx & 63);
#pragma unroll
                    for (int m2 = 0; m2 < 32; ++m2) { cc[m2] = __hip_atomic_load(cp + (size_t)m2 * 4 * 8192, __ATOMIC_RELAXED, __HIP_MEMORY_SCOPE_AGENT); dd[m2] = __hip_atomic_load(dp + m2 * 4 * 64, __ATOMIC_RELAXED, __HIP_MEMORY_SCOPE_AGENT); }
                    float S = 0.f;
#pragma unroll
                    for (int m2 = 0; m2 < 32; ++m2) { cp[(size_t)m2 * 4 * 8192] = S; S = dd[m2] * S + cc[m2]; } }
            }
        }
        SEAM(pb + 1);
        if (IN(pb + 3)) {
            const int tid = pg8::tid_here(), lane = tid & 63; (void)lane;
            float* cum = (float*)lds; float* seg = cum + 4096;
            LAS unsigned char* qel = ldsl + 18432;
            LAS unsigned char* kel = ldsl + 27648;
            LAS unsigned char* vvl = ldsl + 36864;
            LAS unsigned char* stl = ldsl + 54272;
            float* rsq = (float*)(lds + 72704);
            const float* gn = args.gla_g_norm + layer * 128;
            for (int rep_ = 0; rep_ < 1 + ((pad_ >> 8) & 1); ++rep_)
            for (int u = bx; u < 1024; u += G) {
                const int h = u & 3, n = (u >> 2) & 31, b = u >> 7; const size_t row0 = (size_t)b * SEQ + n * 64;
                const int tr = tid >> 3, c8 = tid & 7;
                const v4u qraw = *(const v4u*)(U + (row0 + tr) * NU + UGQ + h * 64 + 8 * c8), kraw = *(const v4u*)(U + (row0 + tr) * NU + UGK + h * 64 + 8 * c8);
                const v4u* vp = (const v4u*)(U + (row0 + tr) * NU + UGV + h * 128 + c8 * 16); const v4u x0 = vp[0], x1 = vp[1];
                const int sv = tid >> 2, skq = (tid & 3) * 16; const f32x4* sp = (const f32x4*)(CST + ((size_t)u * 128 + sv) * 64 + skq);
                const f32x4 a0 = sp[0], a1 = sp[1], a2 = sp[2], a3 = sp[3];
                { float c = 0.f; float lav[8]; const float* lap = (const float*)(ws + WS_LA) + (row0 + 8 * wave) * 256 + h * 64 + lane;
#pragma unroll
                  for (int i = 0; i < 8; ++i) lav[i] = lap[i * 256];
#pragma unroll
                  for (int i = 0; i < 8; ++i) { c += lav[i]; cum[(8 * wave + i) * 64 + lane] = c; }
                  seg[wave * 64 + lane] = c; }
                __syncthreads();
                { f32x4 offa = (f32x4){0.f, 0.f, 0.f, 0.f}, offb = offa; const int wq = tr >> 3;
#pragma unroll
                  for (int w = 0; w < 7; ++w) { if (w < wq) { offa += *(const f32x4*)(seg + w * 64 + 8 * c8); offb += *(const f32x4*)(seg + w * 64 + 8 * c8 + 4); } }
                  const f32x4 ca = *(const f32x4*)(cum + tr * 64 + 8 * c8) + offa, cb = *(const f32x4*)(cum + tr * 64 + 8 * c8 + 4) + offb;
                  float ea[8];
#pragma unroll
                  for (int j = 0; j < 4; ++j) { ea[j] = fexp_(ca[j]); ea[4 + j] = fexp_(cb[j]); }
                  v4u wq_, wk_;
                  wq_.x = pk2(bflo(qraw.x) * ea[0], bfhi(qraw.x) * ea[1]); wq_.y = pk2(bflo(qraw.y) * ea[2], bfhi(qraw.y) * ea[3]); wq_.z = pk2(bflo(qraw.z) * ea[4], bfhi(qraw.z) * ea[5]); wq_.w = pk2(bflo(qraw.w) * ea[6], bfhi(qraw.w) * ea[7]);
                  float ia[8];
#pragma unroll
                  for (int j = 0; j < 8; ++j) ia[j] = __builtin_amdgcn_rcpf(ea[j]);
                  wk_.x = pk2(bflo(kraw.x) * ia[0], bfhi(kraw.x) * ia[1]); wk_.y = pk2(bflo(kraw.y) * ia[2], bfhi(kraw.y) * ia[3]); wk_.z = pk2(bflo(kraw.z) * ia[4], bfhi(kraw.z) * ia[5]); wk_.w = pk2(bflo(kraw.w) * ia[6], bfhi(kraw.w) * ia[7]);
                  *(LAS v4u*)(qel + tr * 144 + c8 * 16) = wq_; *(LAS v4u*)(kel + tr * 144 + c8 * 16) = wk_;
                  LAS v4u* vd = (LAS v4u*)(vvl + tr * 272 + c8 * 32); vd[0] = x0; vd[1] = x1;
                  v4u w0, w1; w0.x = pk2(a0[0], a0[1]); w0.y = pk2(a0[2], a0[3]); w0.z = pk2(a1[0], a1[1]); w0.w = pk2(a1[2], a1[3]);
                  w1.x = pk2(a2[0], a2[1]); w1.y = pk2(a2[2], a2[3]); w1.z = pk2(a3[0], a3[1]); w1.w = pk2(a3[2], a3[3]);
                  LAS v4u* sd = (LAS v4u*)(stl + sv * 144 + skq * 2); sd[0] = w0; sd[1] = w1; }
                __syncthreads();
                { const int tt = wave & 3, vh = wave >> 2, ql = lane & 15, g4 = lane >> 4; const int t = 16 * tt + ql;
                  const bf16x8 qb0 = frag_rm(qel, 144, 16 * tt, 0, lane), qb1 = frag_rm(qel, 144, 16 * tt, 32, lane);
                  f32x4 sT[4];
#pragma unroll
                  for (int st = 0; st < 4; ++st) { sT[st] = (f32x4){0.f, 0.f, 0.f, 0.f};
                      if (st <= tt) { sT[st] = MFMA16(frag_rm(kel, 144, 16 * st, 0, lane), qb0, sT[st]); sT[st] = MFMA16(frag_rm(kel, 144, 16 * st, 32, lane), qb1, sT[st]);
#pragma unroll
                          for (int rg = 0; rg < 4; ++rg) if (16 * st + 4 * g4 + rg > t) sT[st][rg] = 0.f; } }
                  const bf16x8 pb0 = pack8(sT[0], sT[1]), pb1 = pack8(sT[2], sT[3]);
                  f32x4 acc[4]; float ss = 0.f;
#pragma unroll
                  for (int vt = 0; vt < 4; ++vt) { const int V0 = 16 * (4 * vh + vt); f32x4 a = (f32x4){0.f, 0.f, 0.f, 0.f};
                      a = MFMA16(frag_trp(vvl, 272, V0, 0, lane), pb0, a); a = MFMA16(frag_trp(vvl, 272, V0, 32, lane), pb1, a);
                      a = MFMA16(frag_rm(stl, 144, V0, 0, lane), qb0, a); a = MFMA16(frag_rm(stl, 144, V0, 32, lane), qb1, a);
                      acc[vt] = a; ss += (a[0] * a[0] + a[1] * a[1]) + (a[2] * a[2] + a[3] * a[3]); }
                  ss += __shfl_xor(ss, 16); ss += __shfl_xor(ss, 32);
                  if (g4 == 0) rsq[(tt * 2 + vh) * 16 + ql] = ss;
                  __syncthreads();
                  const float rs = 1.0f / sqrtf((rsq[(tt * 2) * 16 + ql] + rsq[(tt * 2 + 1) * 16 + ql]) * (1.0f / 128.0f) + pg8::RMS_EPS);
#pragma unroll
                  for (int vt = 0; vt < 4; ++vt) { const int v0 = 16 * (4 * vh + vt) + 4 * g4;
                      const pg8::u32x2 gr = *(const pg8::u32x2*)(U + (row0 + t) * NU + UGR + h * 128 + v0); const f32x4 gv = *(const f32x4*)(gn + v0);
                      const float o0 = acc[vt][0] * rs * gv[0] * pg8::silu_f(bflo(gr.x)), o1 = acc[vt][1] * rs * gv[1] * pg8::silu_f(bfhi(gr.x));
                      const float o2 = acc[vt][2] * rs * gv[2] * pg8::silu_f(bflo(gr.y)), o3 = acc[vt][3] * rs * gv[3] * pg8::silu_f(bfhi(gr.y));
                      pg8::u32x2 w; w.x = pg8::cvt_pk_bf16(o0, o1); w.y = pg8::cvt_pk_bf16(o2, o3);
                      *(pg8::u32x2*)(MIX + (row0 + t) * D + 256 + h * 128 + v0) = w; } }
                __syncthreads();
            }
        }
        SEAM(pb + 3);
        if (IN(pb + 4)) {
            pg8::Gemm g{MIX, (const bf16*)(ws + WS_WOUT) + (size_t)layer * D * D, M, D, D, D}; pg8::StaticOrder S; S.init(M, D, G, bx);
            if constexpr (layer == 0) { pg8::EpiRes<true> E{args.x, XBD, SSD}; pg8::gemm_phase<pg8::EpiRes<true>, pg8::StaticOrder, true, true>(ldsl, g, S, E, noepi); }
            else { pg8::EpiRes<false> E{XB, XBD, SSD}; pg8::gemm_phase<pg8::EpiRes<false>, pg8::StaticOrder, true, true>(ldsl, g, S, E, noepi); }
        }
        SEAM(pb + 4);
        if (layer == 0) {
            if (IN(pb + 5)) {
                pg8::Gemm g{XB, W13, M, 2 * FF, D, D}; pg8::StaticOrder S; S.init(M, 2 * FF, G, bx);
                pg8::EpiGlu<false> E{H, FF, SS};
                pg8::gemm_phase<pg8::EpiGlu<false>, pg8::StaticOrder, true, true>(ldsl, g, S, E, noepi);
            }
            SEAM(pb + 5);
            if (IN(pb + 6)) {
                pg8::Gemm g{H, W2, M, D, FF, FF}; pg8::StaticOrder S; S.init(M, D, G, bx);
#if defined(PROBE_EPI) && PROBE_EPI
                if (dry) { pg8::EpiRes<false, PROBE_EPI> E{XB, XBD, SSD}; pg8::gemm_phase<pg8::EpiRes<false, PROBE_EPI>, pg8::StaticOrder, true, true>(ldsl, g, S, E, noepi); } else
#endif
                { pg8::EpiRes<false> E{XB, XBD, SSD}; pg8::gemm_phase<pg8::EpiRes<false>, pg8::StaticOrder, true, true>(ldsl, g, S, E, noepi); }
            }
            SEAM(pb + 6);
        } else {
            for (int rp_ = 0; rp_ < 1 + ((pad_ >> 14) & 1); ++rp_)
            if (IN(pb + 5)) {
                const int tid = pg8::tid_here(), lane = tid & 63; (void)lane;
                float* wr_l = (float*)lds;
                int* cnt_l = (int*)(lds + 32768);
                const float* gf = args.g_ffn + D;
                { f32x4 ra[2][2]; float gk[2];
#pragma unroll
                  for (int j = 0; j < 2; ++j) { const int k = tid + NTHR * j; ra[j][0] = *(const f32x4*)(args.moe_router + k * 8); ra[j][1] = *(const f32x4*)(args.moe_router + k * 8 + 4); gk[j] = gf[k]; }
#pragma unroll
                  for (int j = 0; j < 2; ++j) { const int k = tid + NTHR * j;
#pragma unroll
                      for (int e = 0; e < 4; ++e) { wr_l[e * D + k] = ra[j][0][e] * gk[j]; wr_l[(4 + e) * D + k] = ra[j][1][e] * gk[j]; } } }
                if (tid < 8) cnt_l[tid] = 0;
                __syncthreads();
                for (int blk = bx; blk < 256; blk += G) {
                    if (blk != bx) { __syncthreads(); if (tid < 8) cnt_l[tid] = 0; __syncthreads(); }
                    v4u xpre[8][2];
#pragma unroll
                    for (int i = 0; i < 8; ++i) { const v4u* xr = (const v4u*)(XB + (size_t)(blk * 64 + wave * 8 + i) * D) + lane; xpre[i][0] = xr[0]; xpre[i][1] = xr[64]; }
                    const int mi = blk * 64 + wave * 8 + (lane >> 3);
                    typedef float f32x2_t __attribute__((ext_vector_type(2))); const f32x2_t ssp = *(const f32x2_t*)(SS + (size_t)mi * 16 + 2 * (lane & 7));
                    float v[64];
#pragma unroll
                    for (int q = 0; q < 64; ++q) v[q] = 0.f;
#pragma unroll
                    for (int eh = 0; eh < 2; ++eh) { f32x4 w[4][2][2];
#pragma unroll
                        for (int e = 0; e < 4; ++e)
#pragma unroll
                            for (int j = 0; j < 2; ++j) { const float* wp = wr_l + (4 * eh + e) * D + 8 * (lane + 64 * j); w[e][j][0] = *(const f32x4*)wp; w[e][j][1] = *(const f32x4*)(wp + 4); }
#pragma unroll
                        for (int i = 0; i < 8; ++i)
#pragma unroll
                            for (int j = 0; j < 2; ++j) { const v4u xw = xpre[i][j];
                                const f32x4 va = (f32x4){bflo(xw.x), bfhi(xw.x), bflo(xw.y), bfhi(xw.y)}, vb = (f32x4){bflo(xw.z), bfhi(xw.z), bflo(xw.w), bfhi(xw.w)};
#pragma unroll
                                for (int e = 0; e < 4; ++e) v[i * 8 + 4 * eh + e] += ((va[0] * w[e][j][0][0] + va[1] * w[e][j][0][1]) + (va[2] * w[e][j][0][2] + va[3] * w[e][j][0][3])) + ((vb[0] * w[e][j][1][0] + vb[1] * w[e][j][1][1]) + (vb[2] * w[e][j][1][2] + vb[3] * w[e][j][1][3])); } }
#pragma unroll
                    for (int st = 32; st >= 1; st >>= 1) { const bool up = (lane & st) != 0;
#pragma unroll
                        for (int q = 0; q < st; ++q) { const float send = up ? v[q] : v[q + st]; const float keep = up ? v[q + st] : v[q]; v[q] = keep + __shfl_xor(send, st); } }
                    float ssq = ssp[0] + ssp[1]; ssq += __shfl_xor(ssq, 1); ssq += __shfl_xor(ssq, 2); ssq += __shfl_xor(ssq, 4);
                    const float rs = 1.0f / sqrtf(ssq * (1.0f / 1024.0f) + pg8::RMS_EPS);
                    const float lg = v[0] * rs; const int me = lane & 7;
                    float bv = lg; int bi = me;
#pragma unroll
                    for (int st = 1; st < 8; st <<= 1) { const float ov = __shfl_xor(bv, st); const int oi = __shfl_xor(bi, st); if (ov > bv || (ov == bv && oi < bi)) { bv = ov; bi = oi; } }
                    float cv = (me == bi) ? -INFINITY : lg; int ci = me;
#pragma unroll
                    for (int st = 1; st < 8; st <<= 1) { const float ov = __shfl_xor(cv, st); const int oi = __shfl_xor(ci, st); if (ov > cv || (ov == cv && oi < ci)) { cv = ov; ci = oi; } }
                    if (me == 0) { const float w1 = 1.0f / (1.0f + fexp_(bv - cv)), w0 = 1.0f - w1;
                        TOPI[mi * 2] = bi; TOPI[mi * 2 + 1] = ci; TOPW[mi * 2] = w0; TOPW[mi * 2 + 1] = w1; RS3[mi] = rs; atomicAdd(&cnt_l[bi], 1); atomicAdd(&cnt_l[ci], 1); }
                    __syncthreads();
                    if (tid < 8) CNT[blk * 8 + tid] = cnt_l[tid];
                }
            }
            SEAM(pb + 5);
            for (int rp_ = 0; rp_ < 1 + ((pad_ >> 15) & 1); ++rp_)
            if (IN(pb + 6)) {
                const int tid = pg8::tid_here(), lane = tid & 63; (void)lane;
                int* base_l = (int*)lds;
                int* pre_l = base_l + 8;
                int* tot_l = pre_l + 8;
                int* pos_l = tot_l + 8;
                int* ent_l = pos_l + 128;
                for (int blk = bx; blk < 256; blk += G) {
                    __syncthreads();
                    if (tid < 8) { tot_l[tid] = 0; pre_l[tid] = 0; }
                    if (tid < 128) ent_l[tid] = TOPI[blk * 128 + tid];
                    __syncthreads();
                    { const int g2 = tid >> 1, e0 = (tid & 1) * 4; const int4 c = *(const int4*)(CNT + g2 * 8 + e0);
                      atomicAdd(&tot_l[e0], c.x); atomicAdd(&tot_l[e0 + 1], c.y); atomicAdd(&tot_l[e0 + 2], c.z); atomicAdd(&tot_l[e0 + 3], c.w);
                      if (g2 < blk) { atomicAdd(&pre_l[e0], c.x); atomicAdd(&pre_l[e0 + 1], c.y); atomicAdd(&pre_l[e0 + 2], c.z); atomicAdd(&pre_l[e0 + 3], c.w); } }
                    __syncthreads();
                    if (tid == 0) { int bs = 0; for (int e = 0; e < 8; ++e) { base_l[e] = bs; bs += (tot_l[e] + 255) & ~255; } }
                    __syncthreads();
                    if (tid < 128) { const int e = ent_l[tid]; int rank = 0; for (int j = 0; j < tid; ++j) rank += (ent_l[j] == e) ? 1 : 0;
                        const int p = base_l[e] + pre_l[e] + rank; pos_l[tid] = p; POS[blk * 128 + tid] = p; ROWGATE[p] = TOPW[blk * 128 + tid]; ROWRS[p] = RS3[blk * 64 + (tid >> 1)]; }
                    if (blk == 0) {
                        for (int e = 0; e < 8; ++e) { const int npe = (tot_l[e] + 255) >> 8; for (int p = base_l[e] + tot_l[e] + tid; p < base_l[e] + npe * 256; p += NTHR) { ROWGATE[p] = 0.f; ROWRS[p] = 0.f; } }
                        if (tid == 0) { int np = 0; for (int e = 0; e < 8; ++e) { const int npe = (tot_l[e] + 255) >> 8; for (int j = 0; j < npe; ++j) PANE[np++] = e; } PANE[MAXPAN] = np; } }
                    __syncthreads();
#pragma unroll
                    for (int hb = 0; hb < 2; ++hb) { v4u r0[4], r1[4];
#pragma unroll
                        for (int i = 0; i < 4; ++i) { const int m = blk * 64 + wave * 8 + hb * 4 + i; const v4u* s = (const v4u*)(XB + (size_t)m * D) + lane; r0[i] = s[0]; r1[i] = s[64]; }
#pragma unroll
                        for (int i = 0; i < 4; ++i)
#pragma unroll
                            for (int k = 0; k < 2; ++k) { const int p = pos_l[(wave * 8 + hb * 4 + i) * 2 + k]; v4u* d = (v4u*)(XS + (size_t)p * D) + lane; d[0] = r0[i]; d[64] = r1[i]; } }
                }
            }
            SEAM(pb + 6);
            if (IN(pb + 7)) {
                pg8::Gemm g{XS, WE13, MAXROWS, 2 * FE, D, D}; pg8::MoeOrder S{PANE, PANE[MAXPAN], 28, 4, G, bx};
                pg8::EpiGlu<true> E{HE, FE, ROWRS};
                pg8::gemm_phase<pg8::EpiGlu<true>, pg8::MoeOrder, true, true>(ldsl, g, S, E, noepi);
                { const int lane = pg8::tid_here() & 63; unsigned* scr = (unsigned*)(lds + wave * 8704); unsigned* qh = (unsigned*)(ws + WS_CTL) + CW_W2Q;
                  constexpr int T_J = 56 * 16, NTJ = 8 * T_J;
                  for (;;) { int t0 = 0; if (lane == 0) t0 = (int)__hip_atomic_fetch_add(qh, 4u, __ATOMIC_RELAXED, __HIP_MEMORY_SCOPE_AGENT); t0 = __builtin_amdgcn_readfirstlane(t0);
                      if (t0 >= NTJ) break;
                      for (int it = t0; it < t0 + 4 && it < NTJ; ++it) { const int e = it / T_J, r = it % T_J;
                          transpose_tile(args.moe_w2 + (size_t)e * FE * D, D, 64 * (r / 16), 64 * (r % 16), WE2 + (size_t)e * D * FE, FE, 64 * (r % 16), nullptr, scr, lane); } } }
            }
            SEAM(pb + 7);
            if (IN(pb + 9)) {
                const int npan = PANE[MAXPAN]; int npf = ((npan * 4) / G) * G / 4; if (npan - npf > 8 || npf == 0) npf = npan;
                { pg8::Gemm g{HE, WE2, MAXROWS, D, FE, FE}; pg8::MoeOrder S{PANE, npf, 4, 8, G, bx};
                  pg8::EpiMoeDown E{Y, ROWGATE};
                  pg8::gemm_phase<pg8::EpiMoeDown, pg8::MoeOrder, true, true>(ldsl, g, S, E, noepi); }
                if (npan > npf) { __syncthreads();
                  pg8::Gemm g{HE, WE2, MAXROWS, D, 896, FE}; pg8::MoeTailOrder S{PANE, npf, npan - npf, G, bx};
                  pg8::EpiMoeDownPart E{(float*)(ws + WS_YT), ROWGATE, npf * 256};
                  pg8::gemm_phase<pg8::EpiMoeDownPart, pg8::MoeTailOrder, true, true>(ldsl, g, S, E, noepi); }
            }
            SEAM(pb + 9);
            if (IN(pb + 10)) {
                const int tid = pg8::tid_here(), lane = tid & 63; (void)lane;
                const int npan_f = PANE[MAXPAN]; int npf_f = ((npan_f * 4) / G) * G / 4; if (npan_f - npf_f > 8 || npf_f == 0) npf_f = npan_f; const int tail0 = npf_f * 256;
                const f32x4* gf = (const f32x4*)args.g_final + lane;
                for (int rep_ = 0; rep_ < 1 + ((pad_ >> 12) & 1); ++rep_)
                for (int mb_ = gw; mb_ < M; mb_ += 2 * NGW) {
                    int pp[2][2]; unsigned long long xw[2][4], yw[2][2][4]; bool live[2];
#pragma unroll
                    for (int r = 0; r < 2; ++r) { const int m = mb_ + r * NGW; live[r] = m < M; const int mc = live[r] ? m : mb_; pp[r][0] = POS[mc * 2]; pp[r][1] = POS[mc * 2 + 1]; }
#pragma unroll
                    for (int r = 0; r < 2; ++r) { const int m = live[r] ? mb_ + r * NGW : mb_; const unsigned long long* xb = (const unsigned long long*)(XB + (size_t)m * D) + lane;
#pragma unroll
                        for (int j = 0; j < 4; ++j) xw[r][j] = xb[64 * j];
#pragma unroll
                        for (int sl = 0; sl < 2; ++sl) { const int pc = pp[r][sl] < tail0 ? pp[r][sl] : 0; const unsigned long long* yp = (const unsigned long long*)(Y + (size_t)pc * D) + lane;
#pragma unroll
                            for (int j = 0; j < 4; ++j) yw[r][sl][j] = yp[64 * j]; } }
#pragma unroll
                    for (int r = 0; r < 2; ++r) { if (!live[r]) continue; const int m = mb_ + r * NGW; f32x4 v[4]; float s = 0.f;
#pragma unroll
                        for (int j = 0; j < 4; ++j) { const unsigned long long x = xw[r][j]; v[j] = (f32x4){bflo((unsigned)x), bfhi((unsigned)x), bflo((unsigned)(x >> 32)), bfhi((unsigned)(x >> 32))}; }
#pragma unroll
                        for (int sl = 0; sl < 2; ++sl) { const int p = pp[r][sl];
                            if (p < tail0) {
#pragma unroll
                                for (int j = 0; j < 4; ++j) { const unsigned long long a = yw[r][sl][j]; v[j] += (f32x4){bflo((unsigned)a), bfhi((unsigned)a), bflo((unsigned)(a >> 32)), bfhi((unsigned)(a >> 32))}; } }
                            else { const f32x4* tp = (const f32x4*)((const float*)(ws + WS_YT) + (size_t)(p - tail0) * D) + lane;
#pragma unroll
                                for (int kq = 0; kq < 4; ++kq)
#pragma unroll
                                    for (int j = 0; j < 4; ++j) v[j] += tp[(size_t)kq * 2048 * (D / 4) + 64 * j]; } }
#pragma unroll
                        for (int j = 0; j < 4; ++j) s += (v[j][0] * v[j][0] + v[j][1] * v[j][1]) + (v[j][2] * v[j][2] + v[j][3] * v[j][3]);
                        const float rs = __builtin_amdgcn_rsqf(wave_sum(s) * (1.0f / D) + pg8::RMS_EPS);
                        f32x4* xr = (f32x4*)(X + (size_t)m * D) + lane;
#pragma unroll
                        for (int j = 0; j < 4; ++j) xr[64 * j] = v[j] * rs * gf[64 * j]; }
                }
            }
        }
}

__global__ void __launch_bounds__(NTHR, 2) hybrid_fwd(Args args) {
    extern __shared__ __attribute__((aligned(16))) unsigned char lds[];
    LAS unsigned char* ldsl = (LAS unsigned char*)lds;
    volatile LAS unsigned* MISC = (volatile LAS unsigned*)(ldsl + MISC_OFF);
    const int tid = threadIdx.x, lane = tid & 63, wave = __builtin_amdgcn_readfirstlane(tid >> 6);
    const int G = gridDim.x; const int bx = blockIdx.x;
    const int gw = bx * NWAVES + wave, NGW = G * NWAVES;
    unsigned char* ws = args.ws;
    for (int u = tid; u < (LDS_BYTES - LDSCTL_OFF) / 4; u += NTHR) ((LAS unsigned*)(ldsl + LDSCTL_OFF))[u] = 0u;
    __syncthreads();
    XcdBarrier bar; bar.bar = (unsigned*)(ws + WS_CTL) + CW_BAR + args.li * XCD_BAR_WORDS; bar.x = 0; bar.st = nullptr;
    if (MK_N_LAUNCHES == 1) bar = xcd_barrier_post((unsigned*)(ws + WS_CTL) + CW_BAR + args.li * XCD_BAR_WORDS, MISC + 8);
    const int lo = args.ph_lo, hi = args.ph_hi;

    WS_PTRS

    for (int rp_ = 0; rp_ < 1 + ((args.pad >> 6) & 1); ++rp_)
    if (IN(0)) {
        unsigned* scr = (unsigned*)(lds + wave * 8704);
        constexpr int T_A = 16 * 36, T_B = 16 * 12, T_D = 16 * 16, T_L = T_A + T_B + T_D;
        constexpr int T_F = 16 * 44, T_G = 44 * 16, T_E = 16 * 56;
        constexpr int NT0 = 2 * T_L + 2 * T_F + T_G + 16 * T_E;
        for (int it = gw; it < NT0; it += NGW) {
            int r = it;
            if (r < 2 * T_L) { const int l = r / T_L; r -= l * T_L; const float* win = args.w_mix_in + (size_t)l * D * INC; const float* gm = args.g_mix + l * D;
                bf16* WIN = (bf16*)(ws + WS_WIN) + (size_t)l * NU * D;
                if (r < T_A) { transpose_tile(win, INC, 64 * (r / 36), 64 * (r % 36), WIN, D, 64 * (r % 36), gm, scr, lane); continue; } r -= T_A;
                if (r < T_B) { transpose_tile(win, INC, 64 * (r / 12), 2320 + 64 * (r % 12), WIN, D, 2304 + 64 * (r % 12), gm, scr, lane); continue; } r -= T_B;
                transpose_tile(args.w_mix_out + (size_t)l * D * D, D, 64 * (r / 16), 64 * (r % 16), (bf16*)(ws + WS_WOUT) + (size_t)l * D * D, D, 64 * (r % 16), nullptr, scr, lane); continue; }
            r -= 2 * T_L;
            if (r < 2 * T_F) { const int w3 = r / T_F; r -= w3 * T_F; const int n0 = 64 * (r % 44);
                transpose_tile(w3 ? args.ffn_w3 : args.ffn_w1, FF, 64 * (r / 44), n0, W13, D, (n0 >> 7) * 256 + (n0 & 127) + 128 * w3, args.g_ffn, scr, lane); continue; }
            r -= 2 * T_F;
            if (r < T_G) { transpose_tile(args.ffn_w2, D, 64 * (r / 16), 64 * (r % 16), W2, FF, 64 * (r % 16), nullptr, scr, lane); continue; }
            r -= T_G;
            { const int ew = r / T_E; r -= ew * T_E; const int e = ew >> 1, w3 = ew & 1; const int n0 = 64 * (r % 56);
              transpose_tile((w3 ? args.moe_w3 : args.moe_w1) + (size_t)e * D * FE, FE, 64 * (r / 56), n0, WE13 + (size_t)e * 2 * FE * D, D, (n0 >> 7) * 256 + (n0 & 127) + 128 * w3, args.g_ffn + D, scr, lane); }
        }
        for (int m0 = gw; m0 < M; m0 += 4 * NGW) {
            f32x4 xv[4][4];
#pragma unroll
            for (int r = 0; r < 4; ++r) { const int m = (m0 + r * NGW < M) ? m0 + r * NGW : m0; const f32x4* xr = (const f32x4*)(args.x + (size_t)m * D) + lane;
#pragma unroll
                for (int j = 0; j < 4; ++j) xv[r][j] = xr[64 * j]; }
#pragma unroll
            for (int r = 0; r < 4; ++r) { const int m = m0 + r * NGW; if (m >= M) continue; float s = 0.f;
                unsigned long long* o8 = (unsigned long long*)(XB + (size_t)m * D) + lane;
#pragma unroll
                for (int j = 0; j < 4; ++j) { const f32x4 v = xv[r][j]; s += (v[0] * v[0] + v[1] * v[1]) + (v[2] * v[2] + v[3] * v[3]);
                    o8[64 * j] = (unsigned long long)pk2(v[0], v[1]) | ((unsigned long long)pk2(v[2], v[3]) << 32); }
                s = wave_sum(s);
                if (lane < 16) SS[(size_t)m * 16 + lane] = (lane == 0) ? s : 0.f; }
        }
        for (int i = bx * NTHR + tid; i < 2049 * 4; i += G * NTHR) { const int d = i >> 2, h = i & 3; BL[i] = args.rel_bias[rel_bucket(d) * 4 + h] * LOG2E; }
        for (int i = bx * NTHR + tid; i < 2 * 16 * D; i += G * NTHR) { const int k = i & (D - 1), r = (i >> 10) & 15, l = i >> 14;
            ((bf16*)(ws + WS_WGLR))[i] = (bf16)f2bf(args.g_mix[l * D + k] * args.w_mix_in[((size_t)l * D + k) * INC + 2304 + r]); }
    }
    SEAM(0);

    Ctx c; c.args = args; c.tid = tid; c.lane = lane; c.wave = wave; c.G = G; c.bx = bx; c.gw = gw; c.NGW = NGW; c.lo = lo; c.hi = hi; c.bar = bar;
    layer_phases<0>(c, lds);
    layer_phases<1>(c, lds);
}
#undef IN
#undef SEAM
#undef GRID_BAR


extern "C" void kernel_launch(void* const* d_in, const int* in_sizes, int n_in, void* d_out, int out_size, void* d_ws, size_t ws_size, hipStream_t stream) {
    static int grid = 0;
    if (grid == 0) {
        if (n_in != 18 || in_sizes[0] != M * D || out_size != M * D || ws_size < WS_END) { fprintf(stderr, "kernel_launch: unexpected shapes / workspace (%zu < %zu)\n", ws_size, (size_t)WS_END); grid = -1; return; }
        int dev = 0, cus = 0, per_cu = 0;
        if (hipGetDevice(&dev) != hipSuccess || hipDeviceGetAttribute(&cus, hipDeviceAttributeMultiprocessorCount, dev) != hipSuccess) { grid = -1; return; }
        if (hipFuncSetAttribute((const void*)hybrid_fwd, hipFuncAttributeMaxDynamicSharedMemorySize, LDS_BYTES) != hipSuccess) { fprintf(stderr, "kernel_launch: hipFuncSetAttribute failed\n"); grid = -1; return; }
        if (hipOccupancyMaxActiveBlocksPerMultiprocessor(&per_cu, (const void*)hybrid_fwd, NTHR, LDS_BYTES) != hipSuccess || per_cu < 1) { fprintf(stderr, "kernel_launch: occupancy query says %d\n", per_cu); }
        (void)hipGetLastError();
        grid = cus;
    }
    if (grid < 0) return;
    if (hipMemsetAsync((char*)d_ws + WS_CTL, 0, CTL_ZERO_BYTES, stream) != hipSuccess) return;
    Args a{};
    const float** f = (const float**)&a;
    for (int i = 0; i < 18; ++i) f[i] = (const float*)d_in[i];
    a.out = (float*)d_out; a.ws = (unsigned char*)d_ws;
    if (MK_N_LAUNCHES == 1) {
#ifndef PROBE_MODE
#define PROBE_MODE 0
#endif
#ifdef PROBE_PHASE
        const int cuts[4][2] = {{0, PROBE_PHASE}, {PROBE_PHASE, PROBE_PHASE + 1}, {PROBE_PHASE, 64}, {0, 0}};
        for (int li = 0; li < 3; ++li) { a.ph_lo = cuts[li][0]; a.ph_hi = cuts[li][1]; a.li = li; a.pad = (li == 1) ? PROBE_MODE : 0; hipLaunchKernelGGL(hybrid_fwd, dim3(grid), dim3(NTHR), LDS_BYTES, stream, a); }
#else
        a.ph_lo = 0; a.ph_hi = 64; a.li = 0;
#ifndef PROBE_LOW
#define PROBE_LOW 0
#endif
#ifdef PROBE_REP
        a.pad = (PROBE_REP << 8) | PROBE_LOW;
#endif
        hipLaunchKernelGGL(hybrid_fwd, dim3(grid), dim3(NTHR), LDS_BYTES, stream, a);
#endif
    }
    else {
        static const int phases[] = {0, 1, 2, 3, 4, 5, 6, 7, 17, 18, 19, 20, 21, 22, 23, 24, 25, 26, 27};
        for (int p : phases) { a.ph_lo = p; a.ph_hi = p + 1; hipLaunchKernelGGL(hybrid_fwd, dim3(grid), dim3(NTHR), LDS_BYTES, stream, a); }
    }
}
```

```cpp
#include <hip/hip_runtime.h>
#include <cstdio>
#include <cstdint>

#ifndef MK_N_LAUNCHES
#define MK_N_LAUNCHES 1
#endif

namespace pg8 {
#define PG8_LAS __attribute__((address_space(3)))
__device__ __forceinline__ int tid_here() { int t = threadIdx.x; asm volatile("" : "+v"(t)); return t; }
typedef unsigned short bf16_t;
typedef short bf16x8 __attribute__((ext_vector_type(8)));
typedef float f32x4 __attribute__((ext_vector_type(4)));
typedef unsigned u32x4 __attribute__((ext_vector_type(4)));
typedef unsigned u32x2 __attribute__((ext_vector_type(2)));
constexpr int BM = 256, BK = 64, HALF = 128, HTB = HALF * BK * 2, STAGE_BYTES = 8 * HTB, NXCD = 8, WGM = 8;

__host__ __device__ __forceinline__ int lds_byte(int r, int c) { const int st = (r >> 4) * 2 + (c >> 5), rr = r & 15, cc = c & 31, ob = rr * 64 + cc * 2; return st * 1024 + (ob ^ (((ob >> 9) & 1) << 5)); }
__host__ __device__ __forceinline__ void stage_rc(int b, int& R, int& C) { const int st = b / 1024, sb = b % 1024, swz = sb ^ (((sb >> 9) & 1) << 5); R = (st >> 1) * 16 + swz / 64; C = (st & 1) * 32 + (swz % 64) / 2; }
__host__ __device__ __forceinline__ int perm32(int rho) { const int n = rho >> 4, i = rho & 15; return 8 * (i >> 2) + 4 * n + (i & 3); }

struct Unit { int pm, pn, ko; };
struct Gemm { const bf16_t* A; const bf16_t* Bt; int M, N, K, ld; };

struct StaticOrder {
    int nM, nN, nwg, G, c;
    __host__ __device__ void init(int M, int N, int G_, int c_) { nM = M / BM; nN = N / BM; nwg = nM * nN; G = G_; c = c_; }
    __host__ __device__ bool next(int i, Unit& u) const {
        const long L = (long)i * G + c; if (L >= nwg) return false;
        int wgid = (int)L; { const int q = nwg / NXCD, r = nwg % NXCD, xcd = wgid % NXCD, off = wgid / NXCD; wgid = (xcd < r ? xcd * (q + 1) : r * (q + 1) + (xcd - r) * q) + off; }
        const int nig = WGM * nN, gid = wgid / nig, fm = gid * WGM, gsz = (nM - fm) < WGM ? (nM - fm) : WGM;
        u.pm = fm + ((wgid % nig) % gsz); u.pn = (wgid % nig) / gsz; u.ko = 0; return true;
    }
    __device__ __forceinline__ void a_ready(const Unit&) const {}
    __device__ __forceinline__ void done(const Unit&) const {}
};
struct MoeOrder {
    const int* panel_e; int npan, NT, GP, G, c;
    __device__ bool next(int i, Unit& u) const {
        const int nwg = npan * NT; const long L = (long)i * G + c; if (L >= nwg) return false;
        int wgid = (int)L; { const int q = nwg / NXCD, r = nwg % NXCD, xcd = wgid % NXCD, off = wgid / NXCD; wgid = (xcd < r ? xcd * (q + 1) : r * (q + 1) + (xcd - r) * q) + off; }
        const int nig = GP * NT, grp = wgid / nig, fm = grp * GP, gsz = (npan - fm) < GP ? (npan - fm) : GP; const int rr = wgid % nig;
        const int p = fm + rr % gsz; u.pm = p; u.pn = panel_e[p] * NT + rr / gsz; u.ko = 0; return true;
    }
    __device__ __forceinline__ void a_ready(const Unit&) const {}
    __device__ __forceinline__ void done(const Unit&) const {}
};

struct MoeTailOrder {
    const int* panel_e; int p0, ntp, G, c;
    __device__ bool next(int i, Unit& u) const {
        const long L = (long)i * G + c; if (L >= (long)ntp * 16) return false;
        const int kq = (int)L & 3, r = (int)L >> 2, p = p0 + (r >> 2); u.pm = p; u.pn = panel_e[p] * 4 + (r & 3); u.ko = kq * 896 * 2; return true;
    }
    __device__ __forceinline__ void a_ready(const Unit&) const {}
    __device__ __forceinline__ void done(const Unit&) const {}
};
typedef float f32x2c_t __attribute__((ext_vector_type(2))); typedef __bf16 bf16x2c_t __attribute__((ext_vector_type(2)));
__device__ __forceinline__ unsigned cvt_pk_bf16(float lo, float hi) { const f32x2c_t v = {lo, hi}; return __builtin_bit_cast(unsigned, __builtin_convertvector(v, bf16x2c_t)); }

constexpr float RMS_EPS = 1e-6f;
__device__ __forceinline__ float rstd_of(const float* ss16) {
    const f32x4 a = *(const f32x4*)ss16, b = *(const f32x4*)(ss16 + 4), c = *(const f32x4*)(ss16 + 8), d = *(const f32x4*)(ss16 + 12);
    const float s = ((a[0] + a[1]) + (a[2] + a[3])) + ((b[0] + b[1]) + (b[2] + b[3])) + ((c[0] + c[1]) + (c[2] + c[3])) + ((d[0] + d[1]) + (d[2] + d[3]));
    return __builtin_amdgcn_rsqf(s * (1.0f / 1024.0f) + RMS_EPS);
}
__device__ __forceinline__ void rstd4(const float* SS, int row0, float (&rs)[4]) {
    f32x4 p[4][4];
#pragma unroll
    for (int m = 0; m < 4; ++m)
#pragma unroll
        for (int q = 0; q < 4; ++q) p[m][q] = *(const f32x4*)(SS + (size_t)(row0 + 16 * m) * 16 + 4 * q);
    asm volatile("" : "+v"(p[0][0]), "+v"(p[0][1]), "+v"(p[0][2]), "+v"(p[0][3]), "+v"(p[1][0]), "+v"(p[1][1]), "+v"(p[1][2]), "+v"(p[1][3]),
                      "+v"(p[2][0]), "+v"(p[2][1]), "+v"(p[2][2]), "+v"(p[2][3]), "+v"(p[3][0]), "+v"(p[3][1]), "+v"(p[3][2]), "+v"(p[3][3]));
#pragma unroll
    for (int m = 0; m < 4; ++m) { const f32x4 a = p[m][0], b = p[m][1], c = p[m][2], d = p[m][3];
        const float s = ((a[0] + a[1]) + (a[2] + a[3])) + ((b[0] + b[1]) + (b[2] + b[3])) + ((c[0] + c[1]) + (c[2] + c[3])) + ((d[0] + d[1]) + (d[2] + d[3]));
        rs[m] = __builtin_amdgcn_rsqf(s * (1.0f / 1024.0f) + RMS_EPS); }
}
__device__ __forceinline__ float logsig16(float x) { return ((x < 0.f ? x : 0.f) - 0.6931471805599453f * __builtin_amdgcn_logf(1.0f + __builtin_amdgcn_exp2f(-1.4426950408889634f * fabsf(x)))) * (1.0f / 16.0f); }
__device__ __forceinline__ float silu_f(float a) { return a * __builtin_amdgcn_rcpf(1.0f + __builtin_amdgcn_exp2f(a * -1.4426950408889634f)); }

struct EpiU {
    static constexpr bool PERM = true, AFTER_DRAIN = false;
    bf16_t* U; int ldu; const float* SS; float qs;
    __device__ __forceinline__ void operator()(const f32x4 (&acc)[2][2][4][2], const Unit& u, int wr, int wc, int fr, int fq) const {
        const int row0 = u.pm * BM + wr * 64 + fr, col0 = u.pn * BM + wc * 32 + 8 * fq;
        const float sc = (u.pn == 0) ? qs : ((u.pn == 3) ? 0.125f : 1.0f);
#pragma unroll
        for (int ai = 0; ai < 2; ++ai) { float rs4[4]; rstd4(SS, row0 + ai * HALF, rs4);
#pragma unroll
            for (int m = 0; m < 4; ++m) { const int row = row0 + ai * HALF + m * 16; const float rs = rs4[m] * sc;
                bf16_t* rowp = U + (size_t)row * ldu + col0;
#pragma unroll
                for (int bj = 0; bj < 2; ++bj) { const f32x4 v0 = acc[ai][bj][m][0] * rs, v1 = acc[ai][bj][m][1] * rs;
                    u32x4 w; w.x = cvt_pk_bf16(v0[0], v0[1]); w.y = cvt_pk_bf16(v0[2], v0[3]); w.z = cvt_pk_bf16(v1[0], v1[1]); w.w = cvt_pk_bf16(v1[2], v1[3]);
                    *(u32x4*)(rowp + bj * HALF) = w; } } }
    }
};
template <bool IN_F32, int PM = 0> struct EpiRes {
    static constexpr bool PERM = true, AFTER_DRAIN = false;
    const void* Xin; bf16_t* XB; float* SS;
    __device__ __forceinline__ void operator()(const f32x4 (&acc)[2][2][4][2], const Unit& u, int wr, int wc, int fr, int fq) const {
        const int row0 = u.pm * BM + wr * 64 + fr, col0 = u.pn * BM + wc * 32 + 8 * fq;
        if constexpr (IN_F32) {
#pragma unroll
            for (int ai = 0; ai < 2; ++ai) { f32x4 xo[4][2][2];
#pragma unroll
                for (int m = 0; m < 4; ++m)
#pragma unroll
                    for (int bj = 0; bj < 2; ++bj) { const float* p = (const float*)Xin + (size_t)(row0 + ai * HALF + m * 16) * 1024 + col0 + bj * HALF; xo[m][bj][0] = *(const f32x4*)p; xo[m][bj][1] = *(const f32x4*)(p + 4); }
                asm volatile("" : "+v"(xo[0][0][0]), "+v"(xo[0][0][1]), "+v"(xo[0][1][0]), "+v"(xo[0][1][1]), "+v"(xo[1][0][0]), "+v"(xo[1][0][1]), "+v"(xo[1][1][0]), "+v"(xo[1][1][1]),
                                  "+v"(xo[2][0][0]), "+v"(xo[2][0][1]), "+v"(xo[2][1][0]), "+v"(xo[2][1][1]), "+v"(xo[3][0][0]), "+v"(xo[3][0][1]), "+v"(xo[3][1][0]), "+v"(xo[3][1][1]));
#pragma unroll
                for (int m = 0; m < 4; ++m) { const int row = row0 + ai * HALF + m * 16; float ssum = 0.f;
#pragma unroll
                    for (int bj = 0; bj < 2; ++bj) { const f32x4 v0 = xo[m][bj][0] + acc[ai][bj][m][0], v1 = xo[m][bj][1] + acc[ai][bj][m][1];
                        u32x4 w; w.x = cvt_pk_bf16(v0[0], v0[1]); w.y = cvt_pk_bf16(v0[2], v0[3]); w.z = cvt_pk_bf16(v1[0], v1[1]); w.w = cvt_pk_bf16(v1[2], v1[3]);
                        *(u32x4*)(XB + (size_t)row * 1024 + col0 + bj * HALF) = w;
                        ssum += ((v0[0] * v0[0] + v0[1] * v0[1]) + (v0[2] * v0[2] + v0[3] * v0[3])) + ((v1[0] * v1[0] + v1[1] * v1[1]) + (v1[2] * v1[2] + v1[3] * v1[3])); }
                    ssum += __shfl_xor(ssum, 16); ssum += __shfl_xor(ssum, 32);
                    if (fq == 0) SS[(size_t)row * 16 + u.pn * 4 + wc] = ssum; } }
        } else {
            u32x4 xo[2][4][2];
#pragma unroll
            for (int ai = 0; ai < 2; ++ai)
#pragma unroll
                for (int m = 0; m < 4; ++m)
#pragma unroll
                    for (int bj = 0; bj < 2; ++bj) xo[ai][m][bj] = *(const u32x4*)((const bf16_t*)Xin + (size_t)(row0 + ai * HALF + m * 16) * 1024 + col0 + bj * HALF);
            asm volatile("" : "+v"(xo[0][0][0]), "+v"(xo[0][0][1]), "+v"(xo[0][1][0]), "+v"(xo[0][1][1]), "+v"(xo[0][2][0]), "+v"(xo[0][2][1]), "+v"(xo[0][3][0]), "+v"(xo[0][3][1]),
                              "+v"(xo[1][0][0]), "+v"(xo[1][0][1]), "+v"(xo[1][1][0]), "+v"(xo[1][1][1]), "+v"(xo[1][2][0]), "+v"(xo[1][2][1]), "+v"(xo[1][3][0]), "+v"(xo[1][3][1]));
#pragma unroll
            for (int ai = 0; ai < 2; ++ai)
#pragma unroll
                for (int m = 0; m < 4; ++m) { const int row = row0 + ai * HALF + m * 16; float ssum = 0.f;
#pragma unroll
                    for (int bj = 0; bj < 2; ++bj) { const u32x4 x = xo[ai][m][bj]; f32x4 v0, v1;
                        v0[0] = __builtin_bit_cast(float, x.x << 16) + acc[ai][bj][m][0][0]; v0[1] = __builtin_bit_cast(float, x.x & 0xffff0000u) + acc[ai][bj][m][0][1];
                        v0[2] = __builtin_bit_cast(float, x.y << 16) + acc[ai][bj][m][0][2]; v0[3] = __builtin_bit_cast(float, x.y & 0xffff0000u) + acc[ai][bj][m][0][3];
                        v1[0] = __builtin_bit_cast(float, x.z << 16) + acc[ai][bj][m][1][0]; v1[1] = __builtin_bit_cast(float, x.z & 0xffff0000u) + acc[ai][bj][m][1][1];
                        v1[2] = __builtin_bit_cast(float, x.w << 16) + acc[ai][bj][m][1][2]; v1[3] = __builtin_bit_cast(float, x.w & 0xffff0000u) + acc[ai][bj][m][1][3];
                        u32x4 w; w.x = cvt_pk_bf16(v0[0], v0[1]); w.y = cvt_pk_bf16(v0[2], v0[3]); w.z = cvt_pk_bf16(v1[0], v1[1]); w.w = cvt_pk_bf16(v1[2], v1[3]);
                        if constexpr (!(PM & 8)) *(u32x4*)(XB + (size_t)row * 1024 + col0 + bj * HALF) = w;
                        ssum += ((v0[0] * v0[0] + v0[1] * v0[1]) + (v0[2] * v0[2] + v0[3] * v0[3])) + ((v1[0] * v1[0] + v1[1] * v1[1]) + (v1[2] * v1[2] + v1[3] * v1[3])); }
                    if constexpr (!(PM & 16)) { ssum += __shfl_xor(ssum, 16); ssum += __shfl_xor(ssum, 32); }
                    if constexpr (!(PM & 4)) { if (fq == 0) SS[(size_t)row * 16 + u.pn * 4 + wc] = ssum; }
                    if constexpr ((PM & 12) == 12) asm volatile("" :: "v"(ssum)); }
        }
    }
};
template <bool MOE> struct EpiGlu {
    static constexpr bool PERM = true, AFTER_DRAIN = false;
    bf16_t* O; int ldo; const float* SS;
    __device__ __forceinline__ void operator()(const f32x4 (&acc)[2][2][4][2], const Unit& u, int wr, int wc, int fr, int fq) const {
        const int row0 = u.pm * BM + wr * 64 + fr; const int pnl = MOE ? (u.pn % 28) : u.pn; const int col0 = pnl * HALF + wc * 32 + 8 * fq;
#pragma unroll
        for (int ai = 0; ai < 2; ++ai) { float rs4[4];
            if constexpr (MOE) {
#pragma unroll
                for (int m = 0; m < 4; ++m) rs4[m] = SS[row0 + ai * HALF + m * 16];
                asm volatile("" : "+v"(rs4[0]), "+v"(rs4[1]), "+v"(rs4[2]), "+v"(rs4[3]));
            } else rstd4(SS, row0 + ai * HALF, rs4);
#pragma unroll
            for (int m = 0; m < 4; ++m) { const int row = row0 + ai * HALF + m * 16; const float rs = rs4[m];
                const f32x4 a0 = acc[ai][0][m][0] * rs, a1 = acc[ai][0][m][1] * rs, b0 = acc[ai][1][m][0] * rs, b1 = acc[ai][1][m][1] * rs;
                f32x4 g0, g1;
#pragma unroll
                for (int j = 0; j < 4; ++j) { g0[j] = silu_f(a0[j]) * b0[j]; g1[j] = silu_f(a1[j]) * b1[j]; }
                u32x4 w; w.x = cvt_pk_bf16(g0[0], g0[1]); w.y = cvt_pk_bf16(g0[2], g0[3]); w.z = cvt_pk_bf16(g1[0], g1[1]); w.w = cvt_pk_bf16(g1[2], g1[3]);
                *(u32x4*)(O + (size_t)row * ldo + col0) = w; } }
    }
};
struct EpiMoeDown {
    static constexpr bool PERM = true, AFTER_DRAIN = false;
    bf16_t* Y; const float* gate;
    __device__ __forceinline__ void operator()(const f32x4 (&acc)[2][2][4][2], const Unit& u, int wr, int wc, int fr, int fq) const {
        const int row0 = u.pm * BM + wr * 64 + fr, col0 = (u.pn & 3) * BM + wc * 32 + 8 * fq;
        float gt[2][4];
#pragma unroll
        for (int ai = 0; ai < 2; ++ai)
#pragma unroll
            for (int m = 0; m < 4; ++m) gt[ai][m] = gate[row0 + ai * HALF + m * 16];
        asm volatile("" : "+v"(gt[0][0]), "+v"(gt[0][1]), "+v"(gt[0][2]), "+v"(gt[0][3]), "+v"(gt[1][0]), "+v"(gt[1][1]), "+v"(gt[1][2]), "+v"(gt[1][3]));
#pragma unroll
        for (int ai = 0; ai < 2; ++ai)
#pragma unroll
            for (int m = 0; m < 4; ++m) { const int row = row0 + ai * HALF + m * 16; const float g = gt[ai][m]; bf16_t* rowp = Y + (size_t)row * 1024 + col0;
#pragma unroll
                for (int bj = 0; bj < 2; ++bj) { const f32x4 v0 = acc[ai][bj][m][0] * g, v1 = acc[ai][bj][m][1] * g;
                    u32x4 w; w.x = cvt_pk_bf16(v0[0], v0[1]); w.y = cvt_pk_bf16(v0[2], v0[3]); w.z = cvt_pk_bf16(v1[0], v1[1]); w.w = cvt_pk_bf16(v1[2], v1[3]);
                    *(u32x4*)(rowp + bj * HALF) = w; } }
    }
};

struct EpiMoeDownPart {
    static constexpr bool PERM = false, AFTER_DRAIN = false;
    float* YT; const float* gate; int row_base;
    __device__ __forceinline__ void operator()(const f32x4 (&acc)[2][2][4][2], const Unit& u, int wr, int wc, int fr, int fq) const {
        const int row0 = u.pm * BM + wr * 64 + fr, col0 = (u.pn & 3) * BM + wc * 32 + 4 * fq; const int kq = u.ko / 1792;
#pragma unroll
        for (int ai = 0; ai < 2; ++ai)
#pragma unroll
            for (int m = 0; m < 4; ++m) { const int row = row0 + ai * HALF + m * 16; const float gtv = gate[row]; float* rowp = YT + ((size_t)kq * 2048 + (row - row_base)) * 1024 + col0;
#pragma unroll
                for (int bj = 0; bj < 2; ++bj)
#pragma unroll
                    for (int n = 0; n < 2; ++n) *(f32x4*)(rowp + bj * HALF + n * 16) = acc[ai][bj][m][n] * gtv; }
    }
};
template <class Epi, class Sched, bool ALIGN_EPI = false, bool SP2 = false>
__device__ __forceinline__ void gemm_phase(PG8_LAS unsigned char* lds, const Gemm g, const Sched& S, const Epi& E, const bool skip_epi = false) {
    const int tid = tid_here(), wid = __builtin_amdgcn_readfirstlane(tid >> 6), lane = tid & 63, wr = wid >> 2, wc = wid & 3, fr = lane & 15, fq = lane >> 4;
    const int K = g.ld, nt = g.K / BK;
    unsigned voffA[2], voffB[2];
#pragma unroll
    for (int i = 0; i < 2; ++i) { int R, C; stage_rc(tid * 16 + i * 8192, R, C); const int Rb = Epi::PERM ? ((R & ~31) + perm32(R & 31)) : R;
        voffA[i] = (unsigned)(R * K + C) * 2u; voffB[i] = (unsigned)(Rb * K + C) * 2u; }
    const size_t kstep = (size_t)(BK * 2);
    const size_t hstep = (size_t)HALF * K * 2;
    const size_t tstep = 2 * hstep;
    const unsigned ldsw = (unsigned)wid * 1024u;
    const int aoff = lds_byte(wr * 64 + fr, fq * 8), boff = lds_byte(wc * 32 + fr, fq * 8);
#define PG8_SA(b, h) (((b) * 2 + (h)) * HTB)
#define PG8_SB(b, h) ((4 + (b) * 2 + (h)) * HTB)
#define PG8_STAGE(bufoff, gbase, voff) do { _Pragma("unroll") for (int _i = 0; _i < 2; ++_i) \
        __builtin_amdgcn_global_load_lds((const unsigned*)((const char*)(gbase) + (voff)[_i]), (PG8_LAS unsigned*)(lds + (bufoff) + ldsw + _i * 8192), 16, 0, 0); } while (0)
#define PG8_LDA(dst, b, h) do { _Pragma("unroll") for (int m = 0; m < 4; ++m) _Pragma("unroll") for (int k = 0; k < 2; ++k) dst[m][k] = *(const PG8_LAS bf16x8*)(lds + PG8_SA(b, h) + aoff + m * 2048 + k * 1024); } while (0)
#define PG8_LDB(dst, b, h) do { _Pragma("unroll") for (int n = 0; n < 2; ++n) _Pragma("unroll") for (int k = 0; k < 2; ++k) dst[n][k] = *(const PG8_LAS bf16x8*)(lds + PG8_SB(b, h) + boff + n * 2048 + k * 1024); } while (0)
#define PG8_MMA(ai, bj, At, Bt) do { __builtin_amdgcn_s_setprio(1); _Pragma("unroll") for (int m = 0; m < 4; ++m) _Pragma("unroll") for (int n = 0; n < 2; ++n) _Pragma("unroll") for (int k = 0; k < 2; ++k) \
        acc[ai][bj][m][n] = __builtin_amdgcn_mfma_f32_16x16x32_bf16(Bt[n][k], At[m][k], acc[ai][bj][m][n], 0, 0, 0); __builtin_amdgcn_s_setprio(0); } while (0)
#define PG8_WAIT_V(n) asm volatile("s_waitcnt vmcnt(" #n ")" ::: "memory")
#define PG8_WAIT_L(n) asm volatile("s_waitcnt lgkmcnt(" #n ")" ::: "memory")
#define PG8_BAR __builtin_amdgcn_s_barrier()
#define PG8_SCHED __builtin_amdgcn_sched_barrier(0)
    Unit cur, nxt; int ui = 0;
    if (!S.next(0, cur)) return;
    f32x4 acc[2][2][4][2];
#pragma unroll
    for (int a = 0; a < 2; ++a)
#pragma unroll
        for (int b = 0; b < 2; ++b)
#pragma unroll
            for (int m = 0; m < 4; ++m)
#pragma unroll
                for (int n = 0; n < 2; ++n) acc[a][b][m][n] = (f32x4){0.f, 0.f, 0.f, 0.f};
    bf16x8 At[4][2], B0[2][2], B1[2][2];
    const char* cA = (const char*)g.A + (size_t)cur.pm * tstep + cur.ko; const char* cB = (const char*)g.Bt + (size_t)cur.pn * tstep + cur.ko;
    S.a_ready(cur);
    if constexpr (SP2) {
        PG8_STAGE(PG8_SB(0, 0), cB, voffB); PG8_STAGE(PG8_SB(0, 1), cB + hstep, voffB); PG8_STAGE(PG8_SA(0, 0), cA, voffA); PG8_STAGE(PG8_SA(0, 1), cA + hstep, voffA);
        if (wr == 1) PG8_BAR;
        PG8_WAIT_V(2); PG8_BAR;
        PG8_STAGE(PG8_SB(1, 0), cB + kstep, voffB); PG8_STAGE(PG8_SA(1, 0), cA + kstep, voffA); PG8_STAGE(PG8_SB(1, 1), cB + hstep + kstep, voffB);
        PG8_WAIT_V(6); PG8_BAR;
    } else {
        PG8_STAGE(PG8_SB(0, 0), cB, voffB); PG8_STAGE(PG8_SA(0, 0), cA, voffA); PG8_STAGE(PG8_SB(0, 1), cB + hstep, voffB); PG8_STAGE(PG8_SA(0, 1), cA + hstep, voffA);
        if (wr == 1) PG8_BAR;
        PG8_WAIT_V(4); PG8_BAR;
        PG8_STAGE(PG8_SB(1, 0), cB + kstep, voffB); PG8_STAGE(PG8_SA(1, 0), cA + kstep, voffA); PG8_STAGE(PG8_SB(1, 1), cB + hstep + kstep, voffB);
        PG8_WAIT_V(6); PG8_BAR;
    }
    for (;;) {
        const bool has_next = S.next(ui + 1, nxt);
        const char* nA = has_next ? (const char*)g.A + (size_t)nxt.pm * tstep + nxt.ko : cA; const char* nB = has_next ? (const char*)g.Bt + (size_t)nxt.pn * tstep + nxt.ko : cB;
        for (int t = 0; t < nt; t += 2) {
            const bool last = (t == nt - 2);
            const char* a1 = cA + (size_t)(t + 1) * kstep;
            const char* a2 = last ? nA : cA + (size_t)(t + 2) * kstep; const char* b2 = last ? nB : cB + (size_t)(t + 2) * kstep;
            const char* a3 = a2 + kstep; const char* b3 = b2 + kstep;
            if (last && has_next) S.a_ready(nxt);
            if constexpr (SP2) {
            PG8_LDB(B0, 0, 0); PG8_LDB(B1, 0, 1); PG8_SCHED; PG8_LDA(At, 0, 0); PG8_STAGE(PG8_SA(1, 1), a1 + hstep, voffA);
            PG8_WAIT_V(8); PG8_WAIT_L(0); PG8_BAR; PG8_MMA(0, 0, At, B0); PG8_MMA(0, 1, At, B1); PG8_BAR; PG8_SCHED;
            PG8_LDA(At, 0, 1); PG8_STAGE(PG8_SB(0, 0), b2, voffB); PG8_STAGE(PG8_SB(0, 1), b2 + hstep, voffB); PG8_STAGE(PG8_SA(0, 0), a2, voffA);
            PG8_WAIT_V(8); PG8_WAIT_L(0); PG8_BAR; PG8_MMA(1, 0, At, B0); PG8_MMA(1, 1, At, B1); PG8_BAR; PG8_SCHED;
            PG8_LDB(B0, 1, 0); PG8_LDB(B1, 1, 1); PG8_SCHED; PG8_LDA(At, 1, 0); PG8_STAGE(PG8_SA(0, 1), a2 + hstep, voffA);
            PG8_WAIT_V(8); PG8_WAIT_L(0); PG8_BAR; PG8_MMA(0, 0, At, B0); PG8_MMA(0, 1, At, B1); PG8_BAR; PG8_SCHED;
            PG8_LDA(At, 1, 1); PG8_STAGE(PG8_SB(1, 0), b3, voffB); PG8_STAGE(PG8_SB(1, 1), b3 + hstep, voffB); PG8_STAGE(PG8_SA(1, 0), a3, voffA);
            PG8_WAIT_V(8); PG8_WAIT_L(0); PG8_BAR; PG8_MMA(1, 0, At, B0); PG8_MMA(1, 1, At, B1); PG8_BAR; PG8_SCHED;
            } else {
            PG8_LDB(B0, 0, 0); PG8_SCHED; PG8_LDA(At, 0, 0); PG8_STAGE(PG8_SA(1, 1), a1 + hstep, voffA);
            PG8_WAIT_L(8); PG8_BAR; PG8_WAIT_L(0); PG8_MMA(0, 0, At, B0); PG8_BAR; PG8_SCHED;
            PG8_LDB(B1, 0, 1); PG8_STAGE(PG8_SB(0, 0), b2, voffB);
            PG8_BAR; PG8_WAIT_L(0); PG8_MMA(0, 1, At, B1); PG8_BAR;
            PG8_LDA(At, 0, 1); PG8_STAGE(PG8_SA(0, 0), a2, voffA);
            PG8_BAR; PG8_WAIT_L(0); PG8_MMA(1, 0, At, B0); PG8_BAR; PG8_SCHED;
            PG8_STAGE(PG8_SB(0, 1), b2 + hstep, voffB);
            PG8_WAIT_V(6); PG8_BAR; PG8_MMA(1, 1, At, B1); PG8_BAR;
            PG8_LDB(B0, 1, 0); PG8_SCHED; PG8_LDA(At, 1, 0); PG8_STAGE(PG8_SA(0, 1), a2 + hstep, voffA);
            PG8_WAIT_L(8); PG8_BAR; PG8_WAIT_L(0); PG8_MMA(0, 0, At, B0); PG8_BAR; PG8_SCHED;
            PG8_LDB(B1, 1, 1); PG8_STAGE(PG8_SB(1, 0), b3, voffB);
            PG8_BAR; PG8_WAIT_L(0); PG8_MMA(0, 1, At, B1); PG8_BAR;
            PG8_LDA(At, 1, 1); PG8_STAGE(PG8_SA(1, 0), a3, voffA);
            PG8_BAR; PG8_WAIT_L(0); PG8_MMA(1, 0, At, B0); PG8_BAR; PG8_SCHED;
            PG8_STAGE(PG8_SB(1, 1), b3 + hstep, voffB);
            PG8_WAIT_V(6); PG8_BAR; PG8_MMA(1, 1, At, B1); PG8_BAR;
            }
        }
        if constexpr (ALIGN_EPI) { if (wr == 0) PG8_BAR; }
        if constexpr (!Epi::AFTER_DRAIN) { if (!skip_epi) E(acc, cur, wr, wc, fr, fq); S.done(cur); }
        if (!has_next) break;
#pragma unroll
        for (int a = 0; a < 2; ++a)
#pragma unroll
            for (int b = 0; b < 2; ++b)
#pragma unroll
                for (int m = 0; m < 4; ++m)
#pragma unroll
                    for (int n = 0; n < 2; ++n) acc[a][b][m][n] = (f32x4){0.f, 0.f, 0.f, 0.f};
        cur = nxt; cA = nA; cB = nB; ++ui;
        if constexpr (ALIGN_EPI) { if (wr == 1) PG8_BAR; }
    }
    PG8_WAIT_V(0);
    if constexpr (!ALIGN_EPI) { if (wr == 0) PG8_BAR; }
    PG8_BAR;
#undef PG8_SA
#undef PG8_SB
#undef PG8_STAGE
#undef PG8_LDA
#undef PG8_LDB
#undef PG8_MMA
#undef PG8_WAIT_V
#undef PG8_WAIT_L
#undef PG8_BAR
#undef PG8_SCHED
}
}

constexpr int NWAVES = 8, NTHR = NWAVES * 64;
constexpr int NB = 8, SEQ = 2048, D = 1024, M = NB * SEQ;
constexpr int INC = 3088;
constexpr int NU = 3072;
constexpr int UQ = 0, UK = 256, UV = 512, UGQ = 768, UGK = 1024, UGV = 1280, UGR = 1792, UCI = 2304, UCB = 2560, UCC = 2816;
constexpr int FF = 2816, FE = 3584, NE = 8;
constexpr int MAXPAN = 136, MAXROWS = MAXPAN * 256;
constexpr float LOG2E = 1.4426950408889634f;
constexpr float QS_ATT = 0.125f * LOG2E;

constexpr size_t MiB = 1u << 20;
constexpr size_t WS_CTL = 0, CTL_ZERO_BYTES = 1 * MiB;
constexpr size_t WS_SS = 1 * MiB;
constexpr size_t WS_BL = 2 * MiB;
constexpr size_t WS_DEC = 2 * MiB + 64 * 1024;
constexpr size_t WS_TOPI = 3 * MiB;
constexpr size_t WS_TOPW = 3 * MiB + 128 * 1024;
constexpr size_t WS_POS = 3 * MiB + 256 * 1024;
constexpr size_t WS_RS3 = 3 * MiB + 384 * 1024;
constexpr size_t WS_CNT = 3 * MiB + 448 * 1024;
constexpr size_t WS_PANE = 3 * MiB + 456 * 1024;
constexpr size_t WS_ROWGATE = 4 * MiB;
constexpr size_t WS_ROWRS = 4 * MiB + 256 * 1024;
constexpr size_t WS_WE13 = 8 * MiB;
constexpr size_t WS_Y = WS_WE13;
constexpr size_t WS_YT = WS_WE13 + 68 * MiB;
constexpr size_t WS_XS = 120 * MiB;
constexpr size_t WS_WE2 = WS_XS;
constexpr size_t WS_HE = 188 * MiB;
constexpr size_t WS_WIN = WS_HE;
constexpr size_t WS_WGLR = WS_HE + 12 * MiB;
constexpr size_t WS_LA = WS_HE + 34 * MiB;
constexpr size_t WS_WOUT = WS_HE + 13 * MiB;
constexpr size_t WS_W13 = WS_HE + 17 * MiB;
constexpr size_t WS_W2 = WS_HE + 28 * MiB;
constexpr size_t WS_XB = WS_HE + 238 * MiB;
constexpr size_t WS_U = WS_HE + 66 * MiB;
constexpr size_t WS_H = WS_U;
constexpr size_t WS_MIX = WS_HE + 170 * MiB;
constexpr size_t WS_CST = WS_HE + 202 * MiB;
constexpr size_t WS_END = WS_HE + 270 * MiB;
static_assert(WS_CST + 32 * MiB <= WS_END, "ws map");
constexpr int CW_BAR = 4096;
constexpr int CW_SC = 32768;
constexpr int CW_TMO2 = 65536;
constexpr int CW_W2Q = 65600;

constexpr int LDS_BYTES = 147456;
constexpr int LDSCTL_OFF = 131072 + 14 * 1024, MISC_OFF = LDSCTL_OFF + 320;

#define GAS __attribute__((address_space(1)))
#define LAS __attribute__((address_space(3)))
typedef unsigned short bf16;
typedef float f32x4 __attribute__((ext_vector_type(4)));
typedef unsigned v4u __attribute__((ext_vector_type(4)));
__device__ __forceinline__ unsigned f2bf(float f) { unsigned u = __builtin_bit_cast(unsigned, f); return (u + 0x7fffu + ((u >> 16) & 1u)) >> 16; }
__device__ __forceinline__ unsigned pk2(float lo, float hi) { return pg8::cvt_pk_bf16(lo, hi); }
__device__ __forceinline__ float fexp_(float x) { return __builtin_amdgcn_exp2f(x * 1.4426950408889634f); }
__device__ __forceinline__ float bf2f(unsigned short b) { return __builtin_bit_cast(float, (unsigned)b << 16); }
__device__ __forceinline__ float bflo(unsigned w) { return __builtin_bit_cast(float, w << 16); }
__device__ __forceinline__ float bfhi(unsigned w) { return __builtin_bit_cast(float, w & 0xffff0000u); }
__device__ __forceinline__ float wave_sum(float v) {
#pragma unroll
    for (int o = 1; o < 64; o <<= 1) v += __shfl_xor(v, o);
    return v;
}
__device__ __forceinline__ float wave_max(float v) {
#pragma unroll
    for (int o = 1; o < 64; o <<= 1) v = fmaxf(v, __shfl_xor(v, o));
    return v;
}

#define XB_TMO      128
#define XB_XCNT(j)  (256  + 64 * (j))
#define XB_XSUB(j)  (1280 + 64 * (j))
#define XB_XGEN(j)  (2304 + 64 * (j))
#define XB_TOP      3328
#define XB_TOPGEN   3392
#define XCD_BAR_WORDS 3456
#define XB_SPIN_CAP (1u << 18)
__device__ __forceinline__ unsigned xb_ld(unsigned* p)              { return __hip_atomic_load(p, __ATOMIC_RELAXED, __HIP_MEMORY_SCOPE_AGENT); }
__device__ __forceinline__ unsigned xb_add(unsigned* p, unsigned v) { return __hip_atomic_fetch_add(p, v, __ATOMIC_RELAXED, __HIP_MEMORY_SCOPE_AGENT); }
__device__ __forceinline__ unsigned xb_xcc_id() { return (unsigned)__builtin_amdgcn_s_getreg((3 << 11) | 20) & 0xFu; }
#define XB_SPIN(cond, bar) do { unsigned _sp = 0; while (cond) { __builtin_amdgcn_s_sleep(1); \
    if ((++_sp & 255u) == 0u) { if (xb_ld(&(bar)[XB_TMO])) break; if (_sp > XB_SPIN_CAP) { atomicAdd(&(bar)[XB_TMO], 1u); break; } } } } while (0)
struct XcdBarrier { unsigned* bar; unsigned x; volatile LAS unsigned* st; };
__device__ __forceinline__ XcdBarrier xcd_barrier_post(unsigned* bar, volatile LAS unsigned* st) {
    XcdBarrier b; b.bar = bar; b.x = xb_xcc_id(); b.st = st;
    if (threadIdx.x == 0) (void)xb_add(&bar[XB_XCNT(b.x)], 1u);
    return b;
}
__device__ __forceinline__ void xcd_barrier_complete(unsigned* bar, unsigned x, unsigned& nloc, unsigned& nx) {
    const unsigned G = gridDim.x * gridDim.y * gridDim.z;
    unsigned sum, cnt, mine, sp = 0u;
    for (;;) {
        sum = 0u; cnt = 0u; mine = 0u;
#pragma unroll
        for (unsigned j = 0; j < 16; ++j) { const unsigned c = xb_ld(&bar[XB_XCNT(j)]); sum += c; cnt += (c > 0u) ? 1u : 0u; mine = (j == x) ? c : mine; }
        if (sum == G) break;
        __builtin_amdgcn_s_sleep(1);
        if ((++sp & 255u) == 0u) { if (xb_ld(&bar[XB_TMO])) break; if (sp > XB_SPIN_CAP) { atomicAdd(&bar[XB_TMO], 1u); break; } }
    }
    nloc = mine > 0u ? mine : 1u; nx = cnt > 0u ? cnt : 1u;
}
__device__ __forceinline__ void xcd_barrier(const XcdBarrier& b) {
    asm volatile("s_waitcnt vmcnt(0)" ::: "memory");
    __syncthreads();
    if (threadIdx.x == 0) {
        unsigned* bar = b.bar;
        __builtin_amdgcn_s_waitcnt(0);
        unsigned nloc = b.st[0], nx = b.st[1];
        if (nloc == 0u) { xcd_barrier_complete(bar, b.x, nloc, nx); b.st[0] = nloc; b.st[1] = nx; }
        const unsigned old = xb_add(&bar[XB_XSUB(b.x)], 1u);
        const unsigned gen = old / nloc;
        if (old + 1u == (gen + 1u) * nloc) {
            __builtin_amdgcn_fence(__ATOMIC_RELEASE, "agent");
            asm volatile("s_waitcnt vmcnt(0)" ::: "memory");
            const unsigned og = xb_add(&bar[XB_TOP], 1u);
            const unsigned tg = og / nx;
            if (og + 1u == (tg + 1u) * nx) xb_add(&bar[XB_TOPGEN], 1u);
            else XB_SPIN(xb_ld(&bar[XB_TOPGEN]) == tg, bar);
            __builtin_amdgcn_fence(__ATOMIC_ACQUIRE, "agent");
            xb_add(&bar[XB_XGEN(b.x)], 1u);
            asm volatile("s_waitcnt vmcnt(0)" ::: "memory");
        } else {
            XB_SPIN(xb_ld(&bar[XB_XGEN(b.x)]) == gen, bar);
            __builtin_amdgcn_fence(__ATOMIC_ACQUIRE, "agent");
            asm volatile("s_waitcnt vmcnt(0)" ::: "memory");
        }
    }
    __syncthreads();
}

struct Args {
    const float* x; const float* w_mix_in; const float* w_mix_out; const float* g_mix; const float* rel_bias; const float* gla_w_gate; const float* gla_b_gate;
    const float* gla_g_norm; const float* conv_w; const float* g_ffn; const float* ffn_w1; const float* ffn_w3; const float* ffn_w2; const float* moe_router;
    const float* moe_w1; const float* moe_w3; const float* moe_w2; const float* g_final;
    float* out; unsigned char* ws; int ph_lo, ph_hi, li, pad;
};

__device__ __forceinline__ void transpose_tile(const float* src, int ldsrc, int k0, int n0, bf16* dst, int ldd, int drow0, const float* ksc, unsigned* scr, int lane) {
    const int nq = lane & 15, kk = lane >> 4;
#pragma unroll
    for (int i = 0; i < 8; ++i) { const int k = 8 * i + 2 * kk; const float* p = src + (size_t)(k0 + k) * ldsrc + n0 + 4 * nq;
        const f32x4 r0 = *(const f32x4*)p, r1 = *(const f32x4*)(p + ldsrc);
        const float s0 = ksc ? ksc[k0 + k] : 1.f, s1 = ksc ? ksc[k0 + k + 1] : 1.f;
#pragma unroll
        for (int j = 0; j < 4; ++j) scr[(4 * nq + j) * 33 + 4 * i + kk] = pk2(r0[j] * s0, r1[j] * s1); }
    asm volatile("s_waitcnt lgkmcnt(0)" ::: "memory");
#pragma unroll 8
    for (int i2 = 0; i2 < 32; ++i2) { const int n = 2 * i2 + (lane >> 5), d = lane & 31;
        ((unsigned*)(dst + (size_t)(drow0 + n) * ldd + k0))[d] = scr[n * 33 + d]; }
    asm volatile("s_waitcnt lgkmcnt(0)" ::: "memory");
}
struct TileDesc { const float* src; const float* ksc; bf16* dst; int ldsrc, k0, n0, ldd, drow0; };
struct TileRegs { f32x4 r0[8], r1[8]; };
__device__ __forceinline__ void tile_load(const TileDesc& t, TileRegs& R, int lane) {
    const int nq = lane & 15, kk = lane >> 4;
#pragma unroll
    for (int i = 0; i < 8; ++i) { const int k = 8 * i + 2 * kk; const float* p = t.src + (size_t)(t.k0 + k) * t.ldsrc + t.n0 + 4 * nq;
        R.r0[i] = *(const f32x4*)p; R.r1[i] = *(const f32x4*)(p + t.ldsrc); }
}
__device__ __forceinline__ void tile_store(const TileDesc& t, const TileRegs& R, unsigned* scr, int lane) {
    const int nq = lane & 15, kk = lane >> 4;
#pragma unroll
    for (int i = 0; i < 8; ++i) { const int k = t.k0 + 8 * i + 2 * kk; const float s0 = t.ksc ? t.ksc[k] : 1.f, s1 = t.ksc ? t.ksc[k + 1] : 1.f;
#pragma unroll
        for (int j = 0; j < 4; ++j) scr[(4 * nq + j) * 33 + 4 * i + kk] = pk2(R.r0[i][j] * s0, R.r1[i][j] * s1); }
    asm volatile("s_waitcnt lgkmcnt(0)" ::: "memory");
#pragma unroll 4
    for (int i2 = 0; i2 < 32; ++i2) { const int n = 2 * i2 + (lane >> 5), d = lane & 31;
        ((unsigned*)(t.dst + (size_t)(t.drow0 + n) * t.ldd + t.k0))[d] = scr[n * 33 + d]; }
    asm volatile("s_waitcnt lgkmcnt(0)" ::: "memory");
}
__device__ __forceinline__ void glr_tile(const float* win, const float* wg, const float* g, int k0, int n0, bf16* dst, int drow0, int lane) {
    float w[16];
#pragma unroll
    for (int r = 0; r < 16; ++r) w[r] = wg[r * 256 + n0 + lane];
    unsigned* drow = (unsigned*)(dst + (size_t)(drow0 + n0 + lane) * 1024 + k0);
    for (int kp = 0; kp < 32; ++kp) { float v[2];
#pragma unroll
        for (int q = 0; q < 2; ++q) { const int k = k0 + 2 * kp + q; const float* s = win + (size_t)k * INC + 2304; float a = 0.f;
#pragma unroll
            for (int r = 0; r < 16; ++r) a += s[r] * w[r];
            v[q] = a * g[k]; }
        drow[kp] = pk2(v[0], v[1]); }
}
__device__ __forceinline__ int rel_bucket(int d) {
    if (d < 16) return d;
    const float lr = logf((float)d / 16.0f) / logf(128.0f);
    int b = 16 + (int)(lr * 16.0f); return b < 31 ? b : 31;
}


typedef short bf16x8 __attribute__((ext_vector_type(8)));
typedef short v4i16_t __attribute__((ext_vector_type(4)));
#define MFMA16(a, b, c) __builtin_amdgcn_mfma_f32_16x16x32_bf16((a), (b), (c), 0, 0, 0)
__device__ __forceinline__ v4i16_t tr16(LAS unsigned char* p) { return __builtin_amdgcn_ds_read_tr16_b64_v4i16((LAS v4i16_t*)p); }
__device__ __forceinline__ bf16x8 cat8(v4i16_t lo, v4i16_t hi) { return __builtin_shufflevector(lo, hi, 0, 1, 2, 3, 4, 5, 6, 7); }
__device__ __forceinline__ bf16x8 frag_rm(LAS unsigned char* base, int pitch, int c0, int k0, int lane) { return *(LAS bf16x8*)(base + (c0 + (lane & 15)) * pitch + (k0 + 8 * (lane >> 4)) * 2); }
__device__ __forceinline__ bf16x8 frag_tr(LAS unsigned char* base, int pitch, int c0, int k0, int lane) {
    const int i = lane & 15, g = lane >> 4; LAS unsigned char* p = base + (k0 + 8 * g + (i >> 2)) * pitch + (c0 + 4 * (i & 3)) * 2;
    return cat8(tr16(p), tr16(p + 4 * pitch)); }
__device__ __forceinline__ bf16x8 frag_trp(LAS unsigned char* base, int pitch, int c0, int k0, int lane) {
    const int i = lane & 15, g = lane >> 4; LAS unsigned char* p = base + (k0 + 4 * g + (i >> 2)) * pitch + (c0 + 4 * (i & 3)) * 2;
    return cat8(tr16(p), tr16(p + 16 * pitch)); }
__device__ __forceinline__ bf16x8 pack8(const f32x4& a, const f32x4& b) {
    v4u w; w.x = pg8::cvt_pk_bf16(a[0], a[1]); w.y = pg8::cvt_pk_bf16(a[2], a[3]); w.z = pg8::cvt_pk_bf16(b[0], b[1]); w.w = pg8::cvt_pk_bf16(b[2], b[3]); return __builtin_bit_cast(bf16x8, w); }

struct Ctx { Args args; int tid, lane, wave, G, bx, gw, NGW, lo, hi; XcdBarrier bar; };
#define GRID_BAR() do { if (MK_N_LAUNCHES == 1) xcd_barrier(bar); } while (0)
#define IN(k) (lo <= (k) && (k) < hi)
#define SEAM(k) do { if (IN(k) && IN((k) + 1)) GRID_BAR(); } while (0)
#define WS_PTRS \
    float* SS = (float*)(ws + WS_SS); float* BL = (float*)(ws + WS_BL); float* DEC = (float*)(ws + WS_DEC); \
    bf16* XB = (bf16*)(ws + WS_XB); bf16* U = (bf16*)(ws + WS_U); bf16* MIX = (bf16*)(ws + WS_MIX); float* CST = (float*)(ws + WS_CST); \
    bf16* H = (bf16*)(ws + WS_H); bf16* W13 = (bf16*)(ws + WS_W13); bf16* W2 = (bf16*)(ws + WS_W2); \
    bf16* WE13 = (bf16*)(ws + WS_WE13); bf16* WE2 = (bf16*)args.out;     bf16* XS = (bf16*)(ws + WS_XS); bf16* HE = (bf16*)(ws + WS_HE); bf16* Y = (bf16*)(ws + WS_Y); \
    int* TOPI = (int*)(ws + WS_TOPI); float* TOPW = (float*)(ws + WS_TOPW); int* POS = (int*)(ws + WS_POS); float* RS3 = (float*)(ws + WS_RS3); \
    int* CNT = (int*)(ws + WS_CNT); int* PANE = (int*)(ws + WS_PANE); float* ROWGATE = (float*)(ws + WS_ROWGATE); float* ROWRS = (float*)(ws + WS_ROWRS); \
    float* X = args.out; \
    (void)SS; (void)BL; (void)DEC; (void)XB; (void)U; (void)MIX; (void)CST; (void)H; (void)W13; (void)W2; (void)WE13; (void)WE2; (void)XS; (void)HE; (void)Y; \
    (void)TOPI; (void)TOPW; (void)POS; (void)RS3; (void)CNT; (void)PANE; (void)ROWGATE; (void)ROWRS; (void)X;

template <int layer> __device__ __forceinline__ void layer_phases(const Ctx& c, unsigned char* lds) {
    const Args& args = c.args; LAS unsigned char* ldsl = (LAS unsigned char*)lds;
    const int tid = c.tid, lane = c.lane, wave = c.wave, G = c.G, bx = c.bx, gw = c.gw, NGW = c.NGW, lo = c.lo, hi = c.hi; const XcdBarrier bar = c.bar;
    unsigned char* ws = args.ws;
    WS_PTRS
    (void)tid; (void)lane; (void)wave; (void)gw; (void)NGW;
#if defined(PROBE_PHASE) || defined(PROBE_REP)
    const int pad_ = args.pad;
#else
    constexpr int pad_ = 0;
#endif
    const int pmode = pad_ >> 4; (void)pmode;
    const bool dry = (pad_ & 1) != 0, noepi = (pad_ & 2) != 0;
    bf16* XBD = dry ? (bf16*)(ws + WS_XS) : XB; float* SSD = dry ? (float*)(ws + WS_XS) : SS; (void)XBD; (void)SSD;
        const int pb = 1 + 16 * layer;
        if (IN(pb + 0)) {
            pg8::Gemm g{XB, (const bf16*)(ws + WS_WIN) + (size_t)layer * NU * D, M, NU, D, D}; pg8::StaticOrder S; S.init(M, NU, G, bx);
            pg8::EpiU E{U, NU, SS, QS_ATT};
            pg8::gemm_phase<pg8::EpiU, pg8::StaticOrder, true, true>(ldsl, g, S, E, noepi);
            { const bf16* wg = (const bf16*)(ws + WS_WGLR) + (size_t)layer * 16 * D; float* LA = (float*)(ws + WS_LA); f32x4* xch = (f32x4*)lds; float* glrl = (float*)(lds + 4096);
              const int tid = pg8::tid_here(), lane = tid & 63; const int rt = wave & 3, kh = wave >> 2, ql = lane & 15, g4 = lane >> 4;
              bf16x8 wfr[8]; float bcl[8];
#pragma unroll
              for (int ct = 0; ct < 8; ++ct) { const int col = 16 * (8 * kh + ct) + ql; float w8[8];
#pragma unroll
                  for (int j = 0; j < 8; ++j) w8[j] = (g4 < 2) ? args.gla_w_gate[layer * 16 * 256 + (8 * g4 + j) * 256 + col] : 0.f;
                  v4u pw; pw.x = pk2(w8[0], w8[1]); pw.y = pk2(w8[2], w8[3]); pw.z = pk2(w8[4], w8[5]); pw.w = pk2(w8[6], w8[7]); wfr[ct] = __builtin_bit_cast(bf16x8, pw);
                  bcl[ct] = args.gla_b_gate[layer * 256 + col]; }
              for (int blk = bx; blk < 256; blk += G) {
                  const bf16* ap = XB + (size_t)(blk * 64 + rt * 16 + ql) * D + kh * 512 + 8 * g4; const bf16* bp = wg + (size_t)ql * D + kh * 512 + 8 * g4;
                  bf16x8 af[16], bfr[16];
#pragma unroll
                  for (int ks = 0; ks < 16; ++ks) { af[ks] = *(const bf16x8*)(ap + 32 * ks); bfr[ks] = *(const bf16x8*)(bp + 32 * ks); }
                  f32x4 rsp[4];
                  { const int rl = rt * 16 + 4 * g4;
#pragma unroll
                    for (int rg = 0; rg < 4; ++rg) { const f32x4* sp = (const f32x4*)(SS + (size_t)(blk * 64 + rl + rg) * 16); rsp[rg] = (sp[0] + sp[1]) + (sp[2] + sp[3]); } }
                  f32x4 acc = (f32x4){0.f, 0.f, 0.f, 0.f};
#pragma unroll
                  for (int ks = 0; ks < 16; ++ks) acc = MFMA16(af[ks], bfr[ks], acc);
                  if (kh == 1) xch[rt * 64 + lane] = acc;
                  __syncthreads();
                  if (kh == 0) { acc += xch[rt * 64 + lane];
#pragma unroll
                      for (int rg = 0; rg < 4; ++rg) { const int rl = rt * 16 + 4 * g4 + rg; const float s = (rsp[rg][0] + rsp[rg][1]) + (rsp[rg][2] + rsp[rg][3]);
                          glrl[rl * 16 + ql] = acc[rg] * __builtin_amdgcn_rsqf(s * (1.0f / 1024.0f) + pg8::RMS_EPS); } }
                  __syncthreads();
                  {
                    bf16x8 afr = (bf16x8){0, 0, 0, 0, 0, 0, 0, 0};
                    if (g4 < 2) { const f32x4 x0 = *(const f32x4*)(glrl + (rt * 16 + ql) * 16 + 8 * g4), x1 = *(const f32x4*)(glrl + (rt * 16 + ql) * 16 + 8 * g4 + 4);
                        v4u pa; pa.x = pk2(x0[0], x0[1]); pa.y = pk2(x0[2], x0[3]); pa.z = pk2(x1[0], x1[1]); pa.w = pk2(x1[2], x1[3]); afr = __builtin_bit_cast(bf16x8, pa); }
#pragma unroll
                    for (int ct = 0; ct < 8; ++ct) { const f32x4 z = MFMA16(afr, wfr[ct], ((f32x4){0.f, 0.f, 0.f, 0.f}));
#pragma unroll
                        for (int rg = 0; rg < 4; ++rg) LA[(size_t)(blk * 64 + rt * 16 + 4 * g4 + rg) * 256 + 16 * (8 * kh + ct) + ql] = pg8::logsig16(z[rg] + bcl[ct]); } }
                  __syncthreads();
              } }
        }
        SEAM(pb + 0);
        if (IN(pb + 1)) {
            const int tid = pg8::tid_here(), lane = tid & 63; (void)lane;
            float* cum = (float*)lds; float* seg = cum + 4096;
            LAS unsigned char* kdl = ldsl + 18432;
            LAS unsigned char* vvl = ldsl + 27648;
            for (int u = bx; u < 1024; u += G) {
                const int h = u & 3, n = (u >> 2) & 31, b = u >> 7; const size_t row0 = (size_t)b * SEQ + n * 64;
                const int tr = tid >> 3, c8 = tid & 7;
                const v4u kraw = *(const v4u*)(U + (row0 + tr) * NU + UGK + h * 64 + 8 * c8);
                const v4u* vp = (const v4u*)(U + (row0 + tr) * NU + UGV + h * 128 + c8 * 16); const v4u x0 = vp[0], x1 = vp[1];
                { float c = 0.f; float lav[8]; const float* lap = (const float*)(ws + WS_LA) + (row0 + 8 * wave) * 256 + h * 64 + lane;
#pragma unroll
                  for (int i = 0; i < 8; ++i) lav[i] = lap[i * 256];
#pragma unroll
                  for (int i = 0; i < 8; ++i) { c += lav[i]; cum[(8 * wave + i) * 64 + lane] = c; }
                  seg[wave * 64 + lane] = c; }
                __syncthreads();
                { f32x4 offa = (f32x4){0.f, 0.f, 0.f, 0.f}, offb = offa, lasta = offa, lastb = offa; const int wq = tr >> 3;
#pragma unroll
                  for (int w = 0; w < 8; ++w) { const f32x4 sa = *(const f32x4*)(seg + w * 64 + 8 * c8), sb = *(const f32x4*)(seg + w * 64 + 8 * c8 + 4); lasta += sa; lastb += sb; if (w < wq) { offa += sa; offb += sb; } }
                  const f32x4 ca = *(const f32x4*)(cum + tr * 64 + 8 * c8) + offa, cb = *(const f32x4*)(cum + tr * 64 + 8 * c8 + 4) + offb;
                  v4u w; w.x = pk2(bflo(kraw.x) * fexp_(lasta[0] - ca[0]), bfhi(kraw.x) * fexp_(lasta[1] - ca[1])); w.y = pk2(bflo(kraw.y) * fexp_(lasta[2] - ca[2]), bfhi(kraw.y) * fexp_(lasta[3] - ca[3]));
                  w.z = pk2(bflo(kraw.z) * fexp_(lastb[0] - cb[0]), bfhi(kraw.z) * fexp_(lastb[1] - cb[1])); w.w = pk2(bflo(kraw.w) * fexp_(lastb[2] - cb[2]), bfhi(kraw.w) * fexp_(lastb[3] - cb[3]));
                  *(LAS v4u*)(kdl + tr * 144 + c8 * 16) = w;
                  if (tr == 0) {
#pragma unroll
                      for (int j = 0; j < 4; ++j) { __hip_atomic_store(DEC + u * 64 + 8 * c8 + j, fexp_(lasta[j]), __ATOMIC_RELAXED, __HIP_MEMORY_SCOPE_AGENT); __hip_atomic_store(DEC + u * 64 + 8 * c8 + 4 + j, fexp_(lastb[j]), __ATOMIC_RELAXED, __HIP_MEMORY_SCOPE_AGENT); } }
                  LAS v4u* vd = (LAS v4u*)(vvl + tr * 272 + c8 * 32); vd[0] = x0; vd[1] = x1; }
                __syncthreads();
                { f32x4 acc[4];
#pragma unroll
                  for (int kt = 0; kt < 4; ++kt) acc[kt] = (f32x4){0.f, 0.f, 0.f, 0.f};
#pragma unroll
                  for (int ks = 0; ks < 2; ++ks) { const bf16x8 bv = frag_tr(vvl, 272, 16 * wave, 32 * ks, lane);
#pragma unroll
                      for (int kt = 0; kt < 4; ++kt) { const bf16x8 ak = frag_tr(kdl, 144, 16 * kt, 32 * ks, lane); acc[kt] = MFMA16(ak, bv, acc[kt]); } }
                  const int g4 = lane >> 4, ql = lane & 15;
                  const __amdgpu_buffer_rsrc_t rsrc = __builtin_amdgcn_make_buffer_rsrc((void*)CST, 0, 32 * 1024 * 1024, 0x00020000);
#pragma unroll
                  for (int kt = 0; kt < 4; ++kt)
                      __builtin_amdgcn_raw_buffer_store_b128(__builtin_bit_cast(v4u, acc[kt]), rsrc, (int)((((unsigned)u * 128u + 16u * wave + ql) * 64u + 16u * kt + 4u * g4) * 4u), 0, 16); }
                asm volatile("s_waitcnt vmcnt(0)" ::: "memory");
                __syncthreads();
                if (tid == 0) __hip_atomic_fetch_add((unsigned*)(ws + WS_CTL) + CW_SC + ((u >> 7) * 4 + (u & 3)) * 64, 1u, __ATOMIC_RELAXED, __HIP_MEMORY_SCOPE_AGENT);
            }
            const float* cw = args.conv_w + layer * 3 * 256;
            for (int rep_ = 0; rep_ < 1 + ((pad_ >> 10) & 1); ++rep_)
            for (int it = bx * NTHR + tid; it < M * 32; it += G * NTHR) {
                const int row = it >> 5, c0 = (it & 31) * 8, t = row & (SEQ - 1);
                const bf16* ur = U + (size_t)row * NU;
                const v4u cb = *(const v4u*)(ur + UCB + c0);
                v4u ci[3], cc[3];
#pragma unroll
                for (int d = 0; d < 3; ++d) { if (t >= d) { ci[d] = *(const v4u*)(ur - (size_t)d * NU + UCI + c0); cc[d] = *(const v4u*)(ur - (size_t)d * NU + UCC + c0); } else { ci[d] = (v4u){0u, 0u, 0u, 0u}; cc[d] = ci[d]; } }
                float o[8];
#pragma unroll
                for (int j = 0; j < 4; ++j) {
                    float a0 = 0.f, a1 = 0.f;
#pragma unroll
                    for (int d = 0; d < 3; ++d) { const float w0 = cw[(2 - d) * 256 + c0 + 2 * j], w1 = cw[(2 - d) * 256 + c0 + 2 * j + 1];
                        a0 += w0 * (bflo(cc[d][j]) * bflo(ci[d][j])); a1 += w1 * (bfhi(cc[d][j]) * bfhi(ci[d][j])); }
                    o[2 * j] = bflo(cb[j]) * a0; o[2 * j + 1] = bfhi(cb[j]) * a1; }
                v4u w; w.x = pk2(o[0], o[1]); w.y = pk2(o[2], o[3]); w.z = pk2(o[4], o[5]); w.w = pk2(o[6], o[7]);
                *(v4u*)(MIX + (size_t)row * D + 768 + c0) = w;
            }
            __syncthreads();
            {
                float* BLl = (float*)lds;
                for (int i = tid; i < 4 * 2049; i += NTHR) BLl[(i & 3) * 2049 + (i >> 2)] = BL[i];
                __syncthreads();
                LAS unsigned char* vst = ldsl + 33280 + wave * 5120;
                const int ql = lane & 15, g4 = lane >> 4;
                for (int rep_ = 0; rep_ < 1 + ((pad_ >> 11) & 1); ++rep_)
                for (int uu = bx; uu < 512; uu += G) {
                    int u = uu; if (G == 256) { const int j = (uu & 255) >> 3; u = ((((uu >> 8) * 16 + (uu & 7) * 2 + (j >> 4)) << 4) | (j & 15)); }
                    const int c = u & 15, h = (u >> 4) & 3, b = u >> 6; const int i0 = 16 * (((uu / G) & 1) ? 7 - wave : wave); const size_t rowb = (size_t)b * SEQ;
                    const int tq = c + 16 * (i0 + ql);
                    const bf16* ub = U + rowb * NU + h * 64;
                    const bf16x8 qf0 = *(const bf16x8*)(ub + (size_t)tq * NU + UQ + 8 * g4), qf1 = *(const bf16x8*)(ub + (size_t)tq * NU + UQ + 8 * g4 + 32);
                    const float* blh = BLl + h * 2049;
                    const int t0 = c + 16 * i0, t1 = t0 + 240;
                    const int base0 = ((t0 >> 4) - 128) & ~31, mhi0 = t1 >> 4, np0 = ((mhi0 - base0) >> 5) + 1, pz0 = base0 < 0 ? ((-base0) >> 5) : 0;
                    const int base1 = ((t0 >> 2) - 128) & ~31, mhi1 = t1 >> 2, np1 = ((mhi1 - base1) >> 5) + 1, pz1 = base1 < 0 ? ((-base1) >> 5) : 0;
                    const int base2 = (t0 - 128) & ~31, mhi2 = t1, np2 = ((mhi2 - base2) >> 5) + 1, pz2 = base2 < 0 ? ((-base2) >> 5) : 0;
                    const int n0 = np0 - pz0, n1 = np1 - pz1, n2 = np2 - pz2, NT = n0 + n1 + n2;
                    bf16x8 ka[2][2], kb[2][2]; v4u va_[4], vb_[4];
                    const unsigned char* ubb = (const unsigned char*)ub;
                    const unsigned koff = (unsigned)(UK + 8 * g4) * 2u, voff = (unsigned)(UV + 8 * (lane & 7)) * 2u; const int vrow = lane >> 3;
#define ATT_ITEM(it, LR, MB, MHI, RHO) do { if ((it) < n0) { LR = 4; MB = base0 + 32 * (np0 - 1 - (it)); MHI = mhi0; RHO = c; } \
                        else if ((it) < n0 + n1) { LR = 2; MB = base1 + 32 * (pz1 + (it) - n0); MHI = mhi1; RHO = c & 3; } \
                        else { LR = 0; MB = base2 + 32 * (pz2 + (it) - n0 - n1); MHI = mhi2; RHO = 0; } } while (0)
#define ATT_CLAMP(x, hi) __builtin_amdgcn_med3 ## _i(x, hi)
#define ATT_LOAD(K_, V_, LR, MB, MHI, RHO) do { _Pragma("unroll") for (int tau = 0; tau < 2; ++tau) { int mk = (MB) + 16 * tau + ql; mk = max(0, min(mk, (MHI))); \
                            const unsigned char* kp = ubb + ((unsigned)((mk << (LR)) + (RHO)) * (unsigned)(NU * 2) + koff); K_[tau][0] = *(const bf16x8*)kp; K_[tau][1] = *(const bf16x8*)(kp + 64); } \
                        _Pragma("unroll") for (int j = 0; j < 4; ++j) { int mv = (MB) + vrow + 8 * j; mv = max(0, min(mv, (MHI))); \
                            V_[j] = *(const v4u*)(ubb + ((unsigned)((mv << (LR)) + (RHO)) * (unsigned)(NU * 2) + voff)); } } while (0)
#define ATT_STEP(KC_, VC_, KN_, VN_) do { \
                        int lrn = lr, mbn = mb, mhin = mhi, rhon = rho; \
                        if (it + 1 < NT) { ATT_ITEM(it + 1, lrn, mbn, mhin, rhon); ATT_LOAD(KN_, VN_, lrn, mbn, mhin, rhon); } \
                        { LAS unsigned char* vd = vst + vrow * 160 + (lane & 7) * 16; \
                          _Pragma("unroll") for (int j = 0; j < 4; ++j) *(LAS v4u*)(vd + j * 8 * 160) = VC_[j]; } \
                        f32x4 s[2]; \
                        _Pragma("unroll") for (int tau = 0; tau < 2; ++tau) { s[tau] = MFMA16(KC_[tau][0], qf0, ((f32x4){0.f, 0.f, 0.f, 0.f})); s[tau] = MFMA16(KC_[tau][1], qf1, s[tau]); } \
                        const int d0 = (tq >> lr) - mb - 4 * g4; const int kneg = -(mb + 4 * g4); float tmax = -INFINITY; float bias_[2][4]; \
                        _Pragma("unroll") for (int tau = 0; tau < 2; ++tau) \
                            _Pragma("unroll") for (int rg = 0; rg < 4; ++rg) { const int dcl = max(0, min(d0 - (16 * tau + rg), 128)); bias_[tau][rg] = blh[dcl << lr]; } \
                        asm volatile("" : "+v"(bias_[0][0]), "+v"(bias_[0][1]), "+v"(bias_[0][2]), "+v"(bias_[0][3]), "+v"(bias_[1][0]), "+v"(bias_[1][1]), "+v"(bias_[1][2]), "+v"(bias_[1][3]));   \
                        _Pragma("unroll") for (int tau = 0; tau < 2; ++tau) \
                            _Pragma("unroll") for (int rg = 0; rg < 4; ++rg) { const int dist = d0 - (16 * tau + rg); const bool ok = ((unsigned)dist <= 128u) && ((16 * tau + rg) >= kneg); \
                                const float v = ok ? s[tau][rg] + bias_[tau][rg] : -INFINITY; s[tau][rg] = v; tmax = fmaxf(tmax, v); } \
                        if (__any(tmax > m_ref + 16.0f)) { \
                            float tm = fmaxf(tmax, __shfl_xor(tmax, 16)); tm = fmaxf(tm, __shfl_xor(tm, 32)); \
                            const float mn = fmaxf(m_ref, tm); const float ms = (mn == -INFINITY) ? 0.f : mn; const float alpha = __builtin_amdgcn_exp2f(m_ref - ms); m_ref = ms; \
                            l_run *= alpha; \
                            _Pragma("unroll") for (int d = 0; d < 4; ++d) o[d] = o[d] * alpha; \
                        } \
                        float ps = 0.f; \
                        _Pragma("unroll") for (int tau = 0; tau < 2; ++tau) \
                            _Pragma("unroll") for (int rg = 0; rg < 4; ++rg) { const float p = __builtin_amdgcn_exp2f(s[tau][rg] - m_ref); s[tau][rg] = p; ps += p; } \
                        l_run += ps; \
                        const bf16x8 pb = pack8(s[0], s[1]); \
                        asm volatile("" ::: "memory"); \
                        _Pragma("unroll") for (int d = 0; d < 4; ++d) { const bf16x8 vf = frag_trp(vst, 160, 16 * d, 0, lane); o[d] = MFMA16(vf, pb, o[d]); } \
                        asm volatile("" ::: "memory"); \
                        lr = lrn; mb = mbn; mhi = mhin; rho = rhon; ++it; } while (0)
                    int lr, mb, mhi, rho; ATT_ITEM(0, lr, mb, mhi, rho); ATT_LOAD(ka, va_, lr, mb, mhi, rho);
                    float m_ref = -INFINITY, l_run = 0.f; f32x4 o[4];
#pragma unroll
                    for (int d = 0; d < 4; ++d) o[d] = (f32x4){0.f, 0.f, 0.f, 0.f};
                    for (int it = 0; it < NT;) {
                        ATT_STEP(ka, va_, kb, vb_);
                        if (it >= NT) break;
                        ATT_STEP(kb, vb_, ka, va_);
                    }
#undef ATT_ITEM
#undef ATT_LOAD
#undef ATT_STEP
#undef ATT_CLAMP
                    l_run += __shfl_xor(l_run, 16); l_run += __shfl_xor(l_run, 32); const float inv = 1.0f / l_run;
                    bf16* op = MIX + (rowb + tq) * D + h * 64 + 4 * g4;
#pragma unroll
                    for (int d = 0; d < 4; ++d) { pg8::u32x2 w; w.x = pg8::cvt_pk_bf16(o[d][0] * inv, o[d][1] * inv); w.y = pg8::cvt_pk_bf16(o[d][2] * inv, o[d][3] * inv); *(pg8::u32x2*)(op + 16 * d) = w; }
                }
            }
            for (int u = bx; u < 1024; u += G) {
                const int h = u & 3, n = (u >> 2) & 31, b = u >> 7;
                unsigned* cw = (unsigned*)(ws + WS_CTL) + CW_SC + (b * 4 + h) * 64; unsigned* tmo = (unsigned*)(ws + WS_CTL) + CW_TMO2; const unsigned need = 32u * (unsigned)(layer + 1);
                if (wave == 0) { unsigned sp = 0; while (__hip_atomic_load(cw, __ATOMIC_RELAXED, __HIP_MEMORY_SCOPE_AGENT) < need) { __builtin_amdgcn_s_sleep(2);
                        if ((++sp & 255u) == 0u) { if (__hip_atomic_load(tmo, __ATOMIC_RELAXED, __HIP_MEMORY_SCOPE_AGENT) != 0u) break; if (sp > (1u << 20)) { __hip_atomic_store(tmo, 1u, __ATOMIC_RELAXED, __HIP_MEMORY_SCOPE_AGENT); break; } } } }
                __syncthreads();
                if (tid < 256) { const int idx = n * 256 + tid; float cc[32], dd[32];
                    float* cp = CST + (size_t)(b * 128 + h) * 8192 + idx; const float* dp = DEC + (b * 128 + h) * 64 + (idx & 63);
#pragma unroll
                    for (int m2 = 0; m2 < 32; ++m2) { cc[m2] = __hip_atomic_load(cp + (size_t)m2 * 4 * 8192, __ATOMIC_RELAXED, __HIP_MEMORY_SCOPE_AGENT); dd[m2] = __hip_atomic_load(dp + m2 * 4 * 64, __ATOMIC_RELAXED, __HIP_MEMORY_SCOPE_AGENT); }
                    float S = 0.f;
#pragma unroll
                    for (int m2 = 0; m2 < 32; ++m2) { cp[(size_t)m2 * 4 * 8192] = S; S = dd[m2] * S + cc[m2]; } }
            }
        }
        SEAM(pb + 1);
        if (IN(pb + 3)) {
            const int tid = pg8::tid_here(), lane = tid & 63; (void)lane;
            float* cum = (float*)lds; float* seg = cum + 4096;
            LAS unsigned char* qel = ldsl + 18432;
            LAS unsigned char* kel = ldsl + 27648;
            LAS unsigned char* vvl = ldsl + 36864;
            LAS unsigned char* stl = ldsl + 54272;
            float* rsq = (float*)(lds + 72704);
            const float* gn = args.gla_g_norm + layer * 128;
            for (int rep_ = 0; rep_ < 1 + ((pad_ >> 8) & 1); ++rep_)
            for (int u = bx; u < 1024; u += G) {
                const int h = u & 3, n = (u >> 2) & 31, b = u >> 7; const size_t row0 = (size_t)b * SEQ + n * 64;
                const int tr = tid >> 3, c8 = tid & 7;
                const v4u qraw = *(const v4u*)(U + (row0 + tr) * NU + UGQ + h * 64 + 8 * c8), kraw = *(const v4u*)(U + (row0 + tr) * NU + UGK + h * 64 + 8 * c8);
                const v4u* vp = (const v4u*)(U + (row0 + tr) * NU + UGV + h * 128 + c8 * 16); const v4u x0 = vp[0], x1 = vp[1];
                const int sv = tid >> 2, skq = (tid & 3) * 16; const f32x4* sp = (const f32x4*)(CST + ((size_t)u * 128 + sv) * 64 + skq);
                const f32x4 a0 = sp[0], a1 = sp[1], a2 = sp[2], a3 = sp[3];
                { float c = 0.f; float lav[8]; const float* lap = (const float*)(ws + WS_LA) + (row0 + 8 * wave) * 256 + h * 64 + lane;
#pragma unroll
                  for (int i = 0; i < 8; ++i) lav[i] = lap[i * 256];
#pragma unroll
                  for (int i = 0; i < 8; ++i) { c += lav[i]; cum[(8 * wave + i) * 64 + lane] = c; }
                  seg[wave * 64 + lane] = c; }
                __syncthreads();
                { f32x4 offa = (f32x4){0.f, 0.f, 0.f, 0.f}, offb = offa; const int wq = tr >> 3;
#pragma unroll
                  for (int w = 0; w < 7; ++w) { if (w < wq) { offa += *(const f32x4*)(seg + w * 64 + 8 * c8); offb += *(const f32x4*)(seg + w * 64 + 8 * c8 + 4); } }
                  const f32x4 ca = *(const f32x4*)(cum + tr * 64 + 8 * c8) + offa, cb = *(const f32x4*)(cum + tr * 64 + 8 * c8 + 4) + offb;
                  float ea[8];
#pragma unroll
                  for (int j = 0; j < 4; ++j) { ea[j] = fexp_(ca[j]); ea[4 + j] = fexp_(cb[j]); }
                  v4u wq_, wk_;
                  wq_.x = pk2(bflo(qraw.x) * ea[0], bfhi(qraw.x) * ea[1]); wq_.y = pk2(bflo(qraw.y) * ea[2], bfhi(qraw.y) * ea[3]); wq_.z = pk2(bflo(qraw.z) * ea[4], bfhi(qraw.z) * ea[5]); wq_.w = pk2(bflo(qraw.w) * ea[6], bfhi(qraw.w) * ea[7]);
                  float ia[8];
#pragma unroll
                  for (int j = 0; j < 8; ++j) ia[j] = __builtin_amdgcn_rcpf(ea[j]);
                  wk_.x = pk2(bflo(kraw.x) * ia[0], bfhi(kraw.x) * ia[1]); wk_.y = pk2(bflo(kraw.y) * ia[2], bfhi(kraw.y) * ia[3]); wk_.z = pk2(bflo(kraw.z) * ia[4], bfhi(kraw.z) * ia[5]); wk_.w = pk2(bflo(kraw.w) * ia[6], bfhi(kraw.w) * ia[7]);
                  *(LAS v4u*)(qel + tr * 144 + c8 * 16) = wq_; *(LAS v4u*)(kel + tr * 144 + c8 * 16) = wk_;
                  LAS v4u* vd = (LAS v4u*)(vvl + tr * 272 + c8 * 32); vd[0] = x0; vd[1] = x1;
                  v4u w0, w1; w0.x = pk2(a0[0], a0[1]); w0.y = pk2(a0[2], a0[3]); w0.z = pk2(a1[0], a1[1]); w0.w = pk2(a1[2], a1[3]);
                  w1.x = pk2(a2[0], a2[1]); w1.y = pk2(a2[2], a2[3]); w1.z = pk2(a3[0], a3[1]); w1.w = pk2(a3[2], a3[3]);
                  LAS v4u* sd = (LAS v4u*)(stl + sv * 144 + skq * 2); sd[0] = w0; sd[1] = w1; }
                __syncthreads();
                { const int tt = wave & 3, vh = wave >> 2, ql = lane & 15, g4 = lane >> 4; const int t = 16 * tt + ql;
                  const bf16x8 qb0 = frag_rm(qel, 144, 16 * tt, 0, lane), qb1 = frag_rm(qel, 144, 16 * tt, 32, lane);
                  f32x4 sT[4];
#pragma unroll
                  for (int st = 0; st < 4; ++st) { sT[st] = (f32x4){0.f, 0.f, 0.f, 0.f};
                      if (st <= tt) { sT[st] = MFMA16(frag_rm(kel, 144, 16 * st, 0, lane), qb0, sT[st]); sT[st] = MFMA16(frag_rm(kel, 144, 16 * st, 32, lane), qb1, sT[st]);
#pragma unroll
                          for (int rg = 0; rg < 4; ++rg) if (16 * st + 4 * g4 + rg > t) sT[st][rg] = 0.f; } }
                  const bf16x8 pb0 = pack8(sT[0], sT[1]), pb1 = pack8(sT[2], sT[3]);
                  f32x4 acc[4]; float ss = 0.f;
#pragma unroll
                  for (int vt = 0; vt < 4; ++vt) { const int V0 = 16 * (4 * vh + vt); f32x4 a = (f32x4){0.f, 0.f, 0.f, 0.f};
                      a = MFMA16(frag_trp(vvl, 272, V0, 0, lane), pb0, a); a = MFMA16(frag_trp(vvl, 272, V0, 32, lane), pb1, a);
                      a = MFMA16(frag_rm(stl, 144, V0, 0, lane), qb0, a); a = MFMA16(frag_rm(stl, 144, V0, 32, lane), qb1, a);
                      acc[vt] = a; ss += (a[0] * a[0] + a[1] * a[1]) + (a[2] * a[2] + a[3] * a[3]); }
                  ss += __shfl_xor(ss, 16); ss += __shfl_xor(ss, 32);
                  if (g4 == 0) rsq[(tt * 2 + vh) * 16 + ql] = ss;
                  __syncthreads();
                  const float rs = 1.0f / sqrtf((rsq[(tt * 2) * 16 + ql] + rsq[(tt * 2 + 1) * 16 + ql]) * (1.0f / 128.0f) + pg8::RMS_EPS);
#pragma unroll
                  for (int vt = 0; vt < 4; ++vt) { const int v0 = 16 * (4 * vh + vt) + 4 * g4;
                      const pg8::u32x2 gr = *(const pg8::u32x2*)(U + (row0 + t) * NU + UGR + h * 128 + v0); const f32x4 gv = *(const f32x4*)(gn + v0);
                      const float o0 = acc[vt][0] * rs * gv[0] * pg8::silu_f(bflo(gr.x)), o1 = acc[vt][1] * rs * gv[1] * pg8::silu_f(bfhi(gr.x));
                      const float o2 = acc[vt][2] * rs * gv[2] * pg8::silu_f(bflo(gr.y)), o3 = acc[vt][3] * rs * gv[3] * pg8::silu_f(bfhi(gr.y));
                      pg8::u32x2 w; w.x = pg8::cvt_pk_bf16(o0, o1); w.y = pg8::cvt_pk_bf16(o2, o3);
                      *(pg8::u32x2*)(MIX + (row0 + t) * D + 256 + h * 128 + v0) = w; } }
                __syncthreads();
            }
        }
        SEAM(pb + 3);
        if (IN(pb + 4)) {
            pg8::Gemm g{MIX, (const bf16*)(ws + WS_WOUT) + (size_t)layer * D * D, M, D, D, D}; pg8::StaticOrder S; S.init(M, D, G, bx);
            if constexpr (layer == 0) { pg8::EpiRes<true> E{args.x, XBD, SSD}; pg8::gemm_phase<pg8::EpiRes<true>, pg8::StaticOrder, true, true>(ldsl, g, S, E, noepi); }
            else { pg8::EpiRes<false> E{XB, XBD, SSD}; pg8::gemm_phase<pg8::EpiRes<false>, pg8::StaticOrder, true, true>(ldsl, g, S, E, noepi); }
        }
        SEAM(pb + 4);
        if (layer == 0) {
            if (IN(pb + 5)) {
                pg8::Gemm g{XB, W13, M, 2 * FF, D, D}; pg8::StaticOrder S; S.init(M, 2 * FF, G, bx);
                pg8::EpiGlu<false> E{H, FF, SS};
                pg8::gemm_phase<pg8::EpiGlu<false>, pg8::StaticOrder, true, true>(ldsl, g, S, E, noepi);
            }
            SEAM(pb + 5);
            if (IN(pb + 6)) {
                pg8::Gemm g{H, W2, M, D, FF, FF}; pg8::StaticOrder S; S.init(M, D, G, bx);
#if defined(PROBE_EPI) && PROBE_EPI
                if (dry) { pg8::EpiRes<false, PROBE_EPI> E{XB, XBD, SSD}; pg8::gemm_phase<pg8::EpiRes<false, PROBE_EPI>, pg8::StaticOrder, true, true>(ldsl, g, S, E, noepi); } else
#endif
                { pg8::EpiRes<false> E{XB, XBD, SSD}; pg8::gemm_phase<pg8::EpiRes<false>, pg8::StaticOrder, true, true>(ldsl, g, S, E, noepi); }
            }
            SEAM(pb + 6);
        } else {
            for (int rp_ = 0; rp_ < 1 + ((pad_ >> 14) & 1); ++rp_)
            if (IN(pb + 5)) {
                const int tid = pg8::tid_here(), lane = tid & 63; (void)lane;
                float* wr_l = (float*)lds;
                int* cnt_l = (int*)(lds + 32768);
                const float* gf = args.g_ffn + D;
                { f32x4 ra[2][2]; float gk[2];
#pragma unroll
                  for (int j = 0; j < 2; ++j) { const int k = tid + NTHR * j; ra[j][0] = *(const f32x4*)(args.moe_router + k * 8); ra[j][1] = *(const f32x4*)(args.moe_router + k * 8 + 4); gk[j] = gf[k]; }
#pragma unroll
                  for (int j = 0; j < 2; ++j) { const int k = tid + NTHR * j;
#pragma unroll
                      for (int e = 0; e < 4; ++e) { wr_l[e * D + k] = ra[j][0][e] * gk[j]; wr_l[(4 + e) * D + k] = ra[j][1][e] * gk[j]; } } }
                if (tid < 8) cnt_l[tid] = 0;
                __syncthreads();
                for (int blk = bx; blk < 256; blk += G) {
                    if (blk != bx) { __syncthreads(); if (tid < 8) cnt_l[tid] = 0; __syncthreads(); }
                    v4u xpre[8][2];
#pragma unroll
                    for (int i = 0; i < 8; ++i) { const v4u* xr = (const v4u*)(XB + (size_t)(blk * 64 + wave * 8 + i) * D) + lane; xpre[i][0] = xr[0]; xpre[i][1] = xr[64]; }
                    const int mi = blk * 64 + wave * 8 + (lane >> 3);
                    typedef float f32x2_t __attribute__((ext_vector_type(2))); const f32x2_t ssp = *(const f32x2_t*)(SS + (size_t)mi * 16 + 2 * (lane & 7));
                    float v[64];
#pragma unroll
                    for (int q = 0; q < 64; ++q) v[q] = 0.f;
#pragma unroll
                    for (int eh = 0; eh < 2; ++eh) { f32x4 w[4][2][2];
#pragma unroll
                        for (int e = 0; e < 4; ++e)
#pragma unroll
                            for (int j = 0; j < 2; ++j) { const float* wp = wr_l + (4 * eh + e) * D + 8 * (lane + 64 * j); w[e][j][0] = *(const f32x4*)wp; w[e][j][1] = *(const f32x4*)(wp + 4); }
#pragma unroll
                        for (int i = 0; i < 8; ++i)
#pragma unroll
                            for (int j = 0; j < 2; ++j) { const v4u xw = xpre[i][j];
                                const f32x4 va = (f32x4){bflo(xw.x), bfhi(xw.x), bflo(xw.y), bfhi(xw.y)}, vb = (f32x4){bflo(xw.z), bfhi(xw.z), bflo(xw.w), bfhi(xw.w)};
#pragma unroll
                                for (int e = 0; e < 4; ++e) v[i * 8 + 4 * eh + e] += ((va[0] * w[e][j][0][0] + va[1] * w[e][j][0][1]) + (va[2] * w[e][j][0][2] + va[3] * w[e][j][0][3])) + ((vb[0] * w[e][j][1][0] + vb[1] * w[e][j][1][1]) + (vb[2] * w[e][j][1][2] + vb[3] * w[e][j][1][3])); } }
#pragma unroll
                    for (int st = 32; st >= 1; st >>= 1) { const bool up = (lane & st) != 0;
#pragma unroll
                        for (int q = 0; q < st; ++q) { const float send = up ? v[q] : v[q + st]; const float keep = up ? v[q + st] : v[q]; v[q] = keep + __shfl_xor(send, st); } }
                    float ssq = ssp[0] + ssp[1]; ssq += __shfl_xor(ssq, 1); ssq += __shfl_xor(ssq, 2); ssq += __shfl_xor(ssq, 4);
                    const float rs = 1.0f / sqrtf(ssq * (1.0f / 1024.0f) + pg8::RMS_EPS);
                    const float lg = v[0] * rs; const int me = lane & 7;
                    float bv = lg; int bi = me;
#pragma unroll
                    for (int st = 1; st < 8; st <<= 1) { const float ov = __shfl_xor(bv, st); const int oi = __shfl_xor(bi, st); if (ov > bv || (ov == bv && oi < bi)) { bv = ov; bi = oi; } }
                    float cv = (me == bi) ? -INFINITY : lg; int ci = me;
#pragma unroll
                    for (int st = 1; st < 8; st <<= 1) { const float ov = __shfl_xor(cv, st); const int oi = __shfl_xor(ci, st); if (ov > cv || (ov == cv && oi < ci)) { cv = ov; ci = oi; } }
                    if (me == 0) { const float w1 = 1.0f / (1.0f + fexp_(bv - cv)), w0 = 1.0f - w1;
                        TOPI[mi * 2] = bi; TOPI[mi * 2 + 1] = ci; TOPW[mi * 2] = w0; TOPW[mi * 2 + 1] = w1; RS3[mi] = rs; atomicAdd(&cnt_l[bi], 1); atomicAdd(&cnt_l[ci], 1); }
                    __syncthreads();
                    if (tid < 8) CNT[blk * 8 + tid] = cnt_l[tid];
                }
            }
            SEAM(pb + 5);
            for (int rp_ = 0; rp_ < 1 + ((pad_ >> 15) & 1); ++rp_)
            if (IN(pb + 6)) {
                const int tid = pg8::tid_here(), lane = tid & 63; (void)lane;
                int* base_l = (int*)lds;
                int* pre_l = base_l + 8;
                int* tot_l = pre_l + 8;
                int* pos_l = tot_l + 8;
                int* ent_l = pos_l + 128;
                for (int blk = bx; blk < 256; blk += G) {
                    __syncthreads();
                    if (tid < 8) { tot_l[tid] = 0; pre_l[tid] = 0; }
                    if (tid < 128) ent_l[tid] = TOPI[blk * 128 + tid];
                    __syncthreads();
                    { const int g2 = tid >> 1, e0 = (tid & 1) * 4; const int4 c = *(const int4*)(CNT + g2 * 8 + e0);
                      atomicAdd(&tot_l[e0], c.x); atomicAdd(&tot_l[e0 + 1], c.y); atomicAdd(&tot_l[e0 + 2], c.z); atomicAdd(&tot_l[e0 + 3], c.w);
                      if (g2 < blk) { atomicAdd(&pre_l[e0], c.x); atomicAdd(&pre_l[e0 + 1], c.y); atomicAdd(&pre_l[e0 + 2], c.z); atomicAdd(&pre_l[e0 + 3], c.w); } }
                    __syncthreads();
                    if (tid == 0) { int bs = 0; for (int e = 0; e < 8; ++e) { base_l[e] = bs; bs += (tot_l[e] + 255) & ~255; } }
                    __syncthreads();
                    if (tid < 128) { const int e = ent_l[tid]; int rank = 0; for (int j = 0; j < tid; ++j) rank += (ent_l[j] == e) ? 1 : 0;
                        const int p = base_l[e] + pre_l[e] + rank; pos_l[tid] = p; POS[blk * 128 + tid] = p; ROWGATE[p] = TOPW[blk * 128 + tid]; ROWRS[p] = RS3[blk * 64 + (tid >> 1)]; }
                    if (blk == 0) {
                        for (int e = 0; e < 8; ++e) { const int npe = (tot_l[e] + 255) >> 8; for (int p = base_l[e] + tot_l[e] + tid; p < base_l[e] + npe * 256; p += NTHR) { ROWGATE[p] = 0.f; ROWRS[p] = 0.f; } }
                        if (tid == 0) { int np = 0; for (int e = 0; e < 8; ++e) { const int npe = (tot_l[e] + 255) >> 8; for (int j = 0; j < npe; ++j) PANE[np++] = e; } PANE[MAXPAN] = np; } }
                    __syncthreads();
#pragma unroll
                    for (int hb = 0; hb < 2; ++hb) { v4u r0[4], r1[4];
#pragma unroll
                        for (int i = 0; i < 4; ++i) { const int m = blk * 64 + wave * 8 + hb * 4 + i; const v4u* s = (const v4u*)(XB + (size_t)m * D) + lane; r0[i] = s[0]; r1[i] = s[64]; }
#pragma unroll
                        for (int i = 0; i < 4; ++i)
#pragma unroll
                            for (int k = 0; k < 2; ++k) { const int p = pos_l[(wave * 8 + hb * 4 + i) * 2 + k]; v4u* d = (v4u*)(XS + (size_t)p * D) + lane; d[0] = r0[i]; d[64] = r1[i]; } }
                }
            }
            SEAM(pb + 6);
            if (IN(pb + 7)) {
                pg8::Gemm g{XS, WE13, MAXROWS, 2 * FE, D, D}; pg8::MoeOrder S{PANE, PANE[MAXPAN], 28, 4, G, bx};
                pg8::EpiGlu<true> E{HE, FE, ROWRS};
                pg8::gemm_phase<pg8::EpiGlu<true>, pg8::MoeOrder, true, true>(ldsl, g, S, E, noepi);
                { const int lane = pg8::tid_here() & 63; unsigned* scr = (unsigned*)(lds + wave * 8704); unsigned* qh = (unsigned*)(ws + WS_CTL) + CW_W2Q;
                  constexpr int T_J = 56 * 16, NTJ = 8 * T_J;
                  for (;;) { int t0 = 0; if (lane == 0) t0 = (int)__hip_atomic_fetch_add(qh, 4u, __ATOMIC_RELAXED, __HIP_MEMORY_SCOPE_AGENT); t0 = __builtin_amdgcn_readfirstlane(t0);
                      if (t0 >= NTJ) break;
                      for (int it = t0; it < t0 + 4 && it < NTJ; ++it) { const int e = it / T_J, r = it % T_J;
                          transpose_tile(args.moe_w2 + (size_t)e * FE * D, D, 64 * (r / 16), 64 * (r % 16), WE2 + (size_t)e * D * FE, FE, 64 * (r % 16), nullptr, scr, lane); } } }
            }
            SEAM(pb + 7);
            if (IN(pb + 9)) {
                const int npan = PANE[MAXPAN]; int npf = ((npan * 4) / G) * G / 4; if (npan - npf > 8 || npf == 0) npf = npan;
                { pg8::Gemm g{HE, WE2, MAXROWS, D, FE, FE}; pg8::MoeOrder S{PANE, npf, 4, 8, G, bx};
                  pg8::EpiMoeDown E{Y, ROWGATE};
                  pg8::gemm_phase<pg8::EpiMoeDown, pg8::MoeOrder, true, true>(ldsl, g, S, E, noepi); }
                if (npan > npf) { __syncthreads();
                  pg8::Gemm g{HE, WE2, MAXROWS, D, 896, FE}; pg8::MoeTailOrder S{PANE, npf, npan - npf, G, bx};
                  pg8::EpiMoeDownPart E{(float*)(ws + WS_YT), ROWGATE, npf * 256};
                  pg8::gemm_phase<pg8::EpiMoeDownPart, pg8::MoeTailOrder, true, true>(ldsl, g, S, E, noepi); }
            }
            SEAM(pb + 9);
            if (IN(pb + 10)) {
                const int tid = pg8::tid_here(), lane = tid & 63; (void)lane;
                const int npan_f = PANE[MAXPAN]; int npf_f = ((npan_f * 4) / G) * G / 4; if (npan_f - npf_f > 8 || npf_f == 0) npf_f = npan_f; const int tail0 = npf_f * 256;
                const f32x4* gf = (const f32x4*)args.g_final + lane;
                for (int rep_ = 0; rep_ < 1 + ((pad_ >> 12) & 1); ++rep_)
                for (int mb_ = gw; mb_ < M; mb_ += 2 * NGW) {
                    int pp[2][2]; unsigned long long xw[2][4], yw[2][2][4]; bool live[2];
#pragma unroll
                    for (int r = 0; r < 2; ++r) { const int m = mb_ + r * NGW; live[r] = m < M; const int mc = live[r] ? m : mb_; pp[r][0] = POS[mc * 2]; pp[r][1] = POS[mc * 2 + 1]; }
#pragma unroll
                    for (int r = 0; r < 2; ++r) { const int m = live[r] ? mb_ + r * NGW : mb_; const unsigned long long* xb = (const unsigned long long*)(XB + (size_t)m * D) + lane;
#pragma unroll
                        for (int j = 0; j < 4; ++j) xw[r][j] = xb[64 * j];
#pragma unroll
                        for (int sl = 0; sl < 2; ++sl) { const int pc = pp[r][sl] < tail0 ? pp[r][sl] : 0; const unsigned long long* yp = (const unsigned long long*)(Y + (size_t)pc * D) + lane;
#pragma unroll
                            for (int j = 0; j < 4; ++j) yw[r][sl][j] = yp[64 * j]; } }
#pragma unroll
                    for (int r = 0; r < 2; ++r) { if (!live[r]) continue; const int m = mb_ + r * NGW; f32x4 v[4]; float s = 0.f;
#pragma unroll
                        for (int j = 0; j < 4; ++j) { const unsigned long long x = xw[r][j]; v[j] = (f32x4){bflo((unsigned)x), bfhi((unsigned)x), bflo((unsigned)(x >> 32)), bfhi((unsigned)(x >> 32))}; }
#pragma unroll
                        for (int sl = 0; sl < 2; ++sl) { const int p = pp[r][sl];
                            if (p < tail0) {
#pragma unroll
                                for (int j = 0; j < 4; ++j) { const unsigned long long a = yw[r][sl][j]; v[j] += (f32x4){bflo((unsigned)a), bfhi((unsigned)a), bflo((unsigned)(a >> 32)), bfhi((unsigned)(a >> 32))}; } }
                            else { const f32x4* tp = (const f32x4*)((const float*)(ws + WS_YT) + (size_t)(p - tail0) * D) + lane;
#pragma unroll
                                for (int kq = 0; kq < 4; ++kq)
#pragma unroll
                                    for (int j = 0; j < 4; ++j) v[j] += tp[(size_t)kq * 2048 * (D / 4) + 64 * j]; } }
#pragma unroll
                        for (int j = 0; j < 4; ++j) s += (v[j][0] * v[j][0] + v[j][1] * v[j][1]) + (v[j][2] * v[j][2] + v[j][3] * v[j][3]);
                        const float rs = __builtin_amdgcn_rsqf(wave_sum(s) * (1.0f / D) + pg8::RMS_EPS);
                        f32x4* xr = (f32x4*)(X + (size_t)m * D) + lane;
#pragma unroll
                        for (int j = 0; j < 4; ++j) xr[64 * j] = v[j] * rs * gf[64 * j]; }
                }
            }
        }
}

__global__ void __launch_bounds__(NTHR, 2) hybrid_fwd(Args args) {
    extern __shared__ __attribute__((aligned(16))) unsigned char lds[];
    LAS unsigned char* ldsl = (LAS unsigned char*)lds;
    volatile LAS unsigned* MISC = (volatile LAS unsigned*)(ldsl + MISC_OFF);
    const int tid = threadIdx.x, lane = tid & 63, wave = __builtin_amdgcn_readfirstlane(tid >> 6);
    const int G = gridDim.x; const int bx = blockIdx.x;
    const int gw = bx * NWAVES + wave, NGW = G * NWAVES;
    unsigned char* ws = args.ws;
    for (int u = tid; u < (LDS_BYTES - LDSCTL_OFF) / 4; u += NTHR) ((LAS unsigned*)(ldsl + LDSCTL_OFF))[u] = 0u;
    __syncthreads();
    XcdBarrier bar; bar.bar = (unsigned*)(ws + WS_CTL) + CW_BAR + args.li * XCD_BAR_WORDS; bar.x = 0; bar.st = nullptr;
    if (MK_N_LAUNCHES == 1) bar = xcd_barrier_post((unsigned*)(ws + WS_CTL) + CW_BAR + args.li * XCD_BAR_WORDS, MISC + 8);
    const int lo = args.ph_lo, hi = args.ph_hi;

    WS_PTRS

    for (int rp_ = 0; rp_ < 1 + ((args.pad >> 6) & 1); ++rp_)
    if (IN(0)) {
        const int tid = pg8::tid_here(), lane = tid & 63;
        unsigned* scr = (unsigned*)(lds + wave * 8704);
        float* gsl = (float*)(lds + 73728);
        for (int i = tid; i < 4 * D; i += NTHR) gsl[i] = (i < 2 * D) ? args.g_mix[i] : args.g_ffn[i - 2 * D];
        __syncthreads();
        constexpr int T_A = 16 * 36, T_B = 16 * 12, T_D = 16 * 16, T_L = T_A + T_B + T_D;
        constexpr int T_F = 16 * 44, T_G = 44 * 16, T_E = 16 * 56;
        constexpr int NT0 = 2 * T_L + 2 * T_F + T_G + 16 * T_E;
#define P0_DESC(it_, T_) do { int r = (it_); \
            if (r < 2 * T_L) { const int l = r / T_L; r -= l * T_L; const float* win = args.w_mix_in + (size_t)l * D * INC; const float* gm = gsl + l * D; bf16* WIN = (bf16*)(ws + WS_WIN) + (size_t)l * NU * D; \
                if (r < T_A) { T_ = TileDesc{win, gm, WIN, INC, 64 * (r / 36), 64 * (r % 36), D, 64 * (r % 36)}; } \
                else if (r < T_A + T_B) { r -= T_A; T_ = TileDesc{win, gm, WIN, INC, 64 * (r / 12), 2320 + 64 * (r % 12), D, 2304 + 64 * (r % 12)}; } \
                else { r -= T_A + T_B; T_ = TileDesc{args.w_mix_out + (size_t)l * D * D, nullptr, (bf16*)(ws + WS_WOUT) + (size_t)l * D * D, D, 64 * (r / 16), 64 * (r % 16), D, 64 * (r % 16)}; } } \
            else if (r < 2 * T_L + 2 * T_F) { r -= 2 * T_L; const int w3 = r / T_F; r -= w3 * T_F; const int n0 = 64 * (r % 44); \
                T_ = TileDesc{w3 ? args.ffn_w3 : args.ffn_w1, gsl + 2 * D, W13, FF, 64 * (r / 44), n0, D, (n0 >> 7) * 256 + (n0 & 127) + 128 * w3}; } \
            else if (r < 2 * T_L + 2 * T_F + T_G) { r -= 2 * T_L + 2 * T_F; T_ = TileDesc{args.ffn_w2, nullptr, W2, D, 64 * (r / 16), 64 * (r % 16), FF, 64 * (r % 16)}; } \
            else { r -= 2 * T_L + 2 * T_F + T_G; const int ew = r / T_E; r -= ew * T_E; const int e = ew >> 1, w3 = ew & 1; const int n0 = 64 * (r % 56); \
                T_ = TileDesc{(w3 ? args.moe_w3 : args.moe_w1) + (size_t)e * D * FE, gsl + 3 * D, WE13 + (size_t)e * 2 * FE * D, FE, 64 * (r / 56), n0, D, (n0 >> 7) * 256 + (n0 & 127) + 128 * w3}; } } while (0)
        { TileDesc da, db; TileRegs ra, rb; int it = gw;
          if (it < NT0) { P0_DESC(it, da); tile_load(da, ra, lane); }
          while (it < NT0) {
              int itn = it + NGW; if (itn < NT0) { P0_DESC(itn, db); tile_load(db, rb, lane); }
              tile_store(da, ra, scr, lane);
              it = itn; if (it >= NT0) break;
              itn = it + NGW; if (itn < NT0) { P0_DESC(itn, da); tile_load(da, ra, lane); }
              tile_store(db, rb, scr, lane);
              it = itn; } }
#undef P0_DESC
        for (int m0 = gw; m0 < M; m0 += 4 * NGW) {
            f32x4 xv[4][4];
#pragma unroll
            for (int r = 0; r < 4; ++r) { const int m = (m0 + r * NGW < M) ? m0 + r * NGW : m0; const f32x4* xr = (const f32x4*)(args.x + (size_t)m * D) + lane;
#pragma unroll
                for (int j = 0; j < 4; ++j) xv[r][j] = xr[64 * j]; }
#pragma unroll
            for (int r = 0; r < 4; ++r) { const int m = m0 + r * NGW; if (m >= M) continue; float s = 0.f;
                unsigned long long* o8 = (unsigned long long*)(XB + (size_t)m * D) + lane;
#pragma unroll
                for (int j = 0; j < 4; ++j) { const f32x4 v = xv[r][j]; s += (v[0] * v[0] + v[1] * v[1]) + (v[2] * v[2] + v[3] * v[3]);
                    o8[64 * j] = (unsigned long long)pk2(v[0], v[1]) | ((unsigned long long)pk2(v[2], v[3]) << 32); }
                s = wave_sum(s);
                if (lane < 16) SS[(size_t)m * 16 + lane] = (lane == 0) ? s : 0.f; }
        }
        for (int i = bx * NTHR + tid; i < 2049 * 4; i += G * NTHR) { const int d = i >> 2, h = i & 3; BL[i] = args.rel_bias[rel_bucket(d) * 4 + h] * LOG2E; }
        for (int i = bx * NTHR + tid; i < 2 * 16 * D; i += G * NTHR) { const int k = i & (D - 1), r = (i >> 10) & 15, l = i >> 14;
            ((bf16*)(ws + WS_WGLR))[i] = (bf16)f2bf(args.g_mix[l * D + k] * args.w_mix_in[((size_t)l * D + k) * INC + 2304 + r]); }
    }
    SEAM(0);

    Ctx c; c.args = args; c.tid = tid; c.lane = lane; c.wave = wave; c.G = G; c.bx = bx; c.gw = gw; c.NGW = NGW; c.lo = lo; c.hi = hi; c.bar = bar;
    layer_phases<0>(c, lds);
    layer_phases<1>(c, lds);
}
#undef IN
#undef SEAM
#undef GRID_BAR


extern "C" void kernel_launch(void* const* d_in, const int* in_sizes, int n_in, void* d_out, int out_size, void* d_ws, size_t ws_size, hipStream_t stream) {
    static int grid = 0;
    if (grid == 0) {
        if (n_in != 18 || in_sizes[0] != M * D || out_size != M * D || ws_size < WS_END) { fprintf(stderr, "kernel_launch: unexpected shapes / workspace (%zu < %zu)\n", ws_size, (size_t)WS_END); grid = -1; return; }
        int dev = 0, cus = 0, per_cu = 0;
        if (hipGetDevice(&dev) != hipSuccess || hipDeviceGetAttribute(&cus, hipDeviceAttributeMultiprocessorCount, dev) != hipSuccess) { grid = -1; return; }
        if (hipFuncSetAttribute((const void*)hybrid_fwd, hipFuncAttributeMaxDynamicSharedMemorySize, LDS_BYTES) != hipSuccess) { fprintf(stderr, "kernel_launch: hipFuncSetAttribute failed\n"); grid = -1; return; }
        if (hipOccupancyMaxActiveBlocksPerMultiprocessor(&per_cu, (const void*)hybrid_fwd, NTHR, LDS_BYTES) != hipSuccess || per_cu < 1) { fprintf(stderr, "kernel_launch: occupancy query says %d\n", per_cu); }
        (void)hipGetLastError();
        grid = cus;
    }
    if (grid < 0) return;
    if (hipMemsetAsync((char*)d_ws + WS_CTL, 0, CTL_ZERO_BYTES, stream) != hipSuccess) return;
    Args a{};
    const float** f = (const float**)&a;
    for (int i = 0; i < 18; ++i) f[i] = (const float*)d_in[i];
    a.out = (float*)d_out; a.ws = (unsigned char*)d_ws;
    if (MK_N_LAUNCHES == 1) {
#ifndef PROBE_MODE
#define PROBE_MODE 0
#endif
#ifdef PROBE_PHASE
        const int cuts[4][2] = {{0, PROBE_PHASE}, {PROBE_PHASE, PROBE_PHASE + 1}, {PROBE_PHASE, 64}, {0, 0}};
        for (int li = 0; li < 3; ++li) { a.ph_lo = cuts[li][0]; a.ph_hi = cuts[li][1]; a.li = li; a.pad = (li == 1) ? PROBE_MODE : 0; hipLaunchKernelGGL(hybrid_fwd, dim3(grid), dim3(NTHR), LDS_BYTES, stream, a); }
#else
        a.ph_lo = 0; a.ph_hi = 64; a.li = 0;
#ifndef PROBE_LOW
#define PROBE_LOW 0
#endif
#ifdef PROBE_REP
        a.pad = (PROBE_REP << 8) | PROBE_LOW;
#endif
        hipLaunchKernelGGL(hybrid_fwd, dim3(grid), dim3(NTHR), LDS_BYTES, stream, a);
#endif
    }
    else {
        static const int phases[] = {0, 1, 2, 3, 4, 5, 6, 7, 17, 18, 19, 20, 21, 22, 23, 24, 25, 26, 27};
        for (int p : phases) { a.ph_lo = p; a.ph_hi = p + 1; hipLaunchKernelGGL(hybrid_fwd, dim3(grid), dim3(NTHR), LDS_BYTES, stream, a); }
    }
}
```
